# Optimizing an MI355X kernel written in HIP

```python
import math
import jax
import jax.numpy as jnp
from jax import lax
import numpy as np

D_MODEL = 1024
BATCH = 8
SEQ = 2048
DEPTH = 4

GRID_W = 64
CTX_LEN = 256
N_EVEN = (DEPTH + 1) // 2
N_ODD = DEPTH // 2

HGRN_HEADS = 4
HGRN_HEAD_DIM = 128
HGRN_WIDTH = HGRN_HEADS * HGRN_HEAD_DIM

MLA_HEADS = 8
MLA_Q_RANK = 384
MLA_KV_RANK = 256
MLA_NOPE = 64
MLA_ROPE = 32
MLA_V = 64

RET_HEADS = 4
RET_QK = 64
RET_V = 128

DIFF_HEADS = 4
DIFF_QK = 64
DIFF_V = 128

FFN_HIDDEN = -(-8 * D_MODEL // (3 * 256)) * 256

EVEN_SIZES = (HGRN_WIDTH,) * 5 + (MLA_Q_RANK, MLA_KV_RANK, MLA_ROPE)
ODD_SIZES = (RET_HEADS * RET_QK, RET_HEADS * RET_QK, RET_HEADS * RET_V, RET_HEADS * RET_V,
             DIFF_HEADS * 2 * DIFF_QK, DIFF_HEADS * 2 * DIFF_QK, DIFF_HEADS * DIFF_V)
EVEN_IN = sum(EVEN_SIZES)
ODD_IN = sum(ODD_SIZES)
MIX_WIDTH = HGRN_WIDTH + MLA_HEADS * MLA_V

CHUNK = 64
Q_BLOCK = 128
ROPE_BASE = 10000.0
EPS = 1e-6

kernel_name = 'hybrid_prefix_diffusion_trunk'


def rms_norm(x, g=None):
    xf = x.astype(jnp.float32)
    y = xf * lax.rsqrt(jnp.mean(xf * xf, axis=-1, keepdims=True) + EPS)
    if g is not None:
        y = y * g.astype(jnp.float32)
    return y.astype(x.dtype)


def split_cols(a, sizes):
    idx = [int(i) for i in np.cumsum(sizes)[:-1]]
    return jnp.split(a, idx, axis=-1)


def rope_1d(x, pos):
    half = x.shape[-1] // 2
    inv = ROPE_BASE ** (-jnp.arange(half, dtype=jnp.float32) / half)
    ang = pos.astype(jnp.float32)[:, None] * inv[None, :]
    shape = (1, x.shape[1]) + (1,) * (x.ndim - 3) + (half,)
    cos = jnp.cos(ang).reshape(shape).astype(x.dtype)
    sin = jnp.sin(ang).reshape(shape).astype(x.dtype)
    x1, x2 = x[..., :half], x[..., half:]
    return jnp.concatenate([x1 * cos - x2 * sin, x1 * sin + x2 * cos], axis=-1)


def rope_2d(x):
    n = x.shape[1]
    rows = n // GRID_W
    row = jnp.repeat(jnp.arange(rows), GRID_W)
    col = jnp.arange(rows * GRID_W) % GRID_W
    half = x.shape[-1] // 2
    return jnp.concatenate([rope_1d(x[..., :half], row), rope_1d(x[..., half:], col)], axis=-1)


def attend(q, k, v, scale):
    s = jnp.einsum('bqhd,bkhd->bhqk', q, k).astype(jnp.float32) * scale
    p = jax.nn.softmax(s, axis=-1).astype(v.dtype)
    return jnp.einsum('bhqk,bkhv->bqhv', p, v)


def diff_attend(q, k, v, scale, lam):
    s = jnp.einsum('bqhmd,bkhmd->bhmqk', q, k).astype(jnp.float32) * scale
    p = jax.nn.softmax(s, axis=-1)
    a = (p[:, :, 0] - lam * p[:, :, 1]).astype(v.dtype)
    return jnp.einsum('bhqk,bkhv->bqhv', a, v)


def sweep_query_blocks(fn, q):
    b, n = q.shape[:2]
    nb = n // Q_BLOCK
    qb = jnp.moveaxis(q.reshape((b, nb, Q_BLOCK) + q.shape[2:]), 1, 0)
    out = lax.map(fn, qb)
    return jnp.moveaxis(out, 0, 1).reshape((b, n) + out.shape[3:])


def gla_scan(q, k, v, log_f, s0):
    b, n, h, _ = q.shape
    dv = v.shape[-1]
    nc = n // CHUNK

    def chunks(a):
        return a.astype(jnp.float32).reshape(b, nc, CHUNK, h, a.shape[-1]).transpose(1, 0, 3, 2, 4)

    causal = jnp.tril(jnp.ones((CHUNK, CHUNK), dtype=bool))[:, :, None]

    def step(S, inp):
        qc, kc, vc, gc = inp
        bcum = jnp.cumsum(gc, axis=2)
        diff = bcum[:, :, :, None, :] - bcum[:, :, None, :, :]
        dec = jnp.where(causal, jnp.exp(jnp.where(causal, diff, 0.0)), 0.0)
        att = jnp.einsum('bhtd,bhsd,bhtsd->bhts', qc, kc, dec)
        o = (jnp.einsum('bhts,bhsv->bhtv', att, vc)
             + jnp.einsum('bhtd,bhdv->bhtv', qc * jnp.exp(bcum), S))
        b_last = bcum[:, :, -1:, :]
        S = (jnp.exp(b_last[:, :, 0, :, None]) * S
             + jnp.einsum('bhsd,bhsv->bhdv', kc * jnp.exp(b_last - bcum), vc))
        return S, o

    S, o = lax.scan(step, s0, (chunks(q), chunks(k), chunks(v), chunks(log_f)))
    o = o.transpose(1, 0, 3, 2, 4).reshape(b, n, h, dv)
    return o.astype(v.dtype), S


def retention_scan(q, k, v, log_gamma, s0):
    b, n, h, _ = q.shape
    dv = v.shape[-1]
    nc = n // CHUNK
    lg = log_gamma.astype(jnp.float32)
    t = jnp.arange(CHUNK, dtype=jnp.float32)
    rel = t[:, None] - t[None, :]
    dmat = jnp.where(rel >= 0, jnp.exp(jnp.maximum(rel, 0.0)[None] * lg[:, None, None]), 0.0)
    q_dec = jnp.exp((t + 1.0)[None, :] * lg[:, None])
    k_dec = jnp.exp((CHUNK - 1.0 - t)[None, :] * lg[:, None])
    c_dec = jnp.exp(CHUNK * lg)

    def chunks(a):
        return a.astype(jnp.float32).reshape(b, nc, CHUNK, h, a.shape[-1]).transpose(1, 0, 3, 2, 4)

    def step(S, inp):
        qc, kc, vc = inp
        att = jnp.einsum('bhtd,bhsd->bhts', qc, kc) * dmat
        o = (jnp.einsum('bhts,bhsv->bhtv', att, vc)
             + jnp.einsum('bhtd,bhdv->bhtv', qc * q_dec[:, :, None], S))
        S = c_dec[:, None, None] * S + jnp.einsum('bhsd,bhsv->bhdv', kc * k_dec[:, :, None], vc)
        return S, o

    S, o = lax.scan(step, s0, (chunks(q), chunks(k), chunks(v)))
    o = o.transpose(1, 0, 3, 2, 4).reshape(b, n, h, dv)
    return o.astype(v.dtype), S


def run_prefix_scan(scan_fn, ctx_seqs, lat_seqs, extra, s0, reverse):
    flip = (lambda a: jnp.flip(a, axis=1)) if reverse else (lambda a: a)
    o_ctx, s_ctx = scan_fn(*[flip(a) for a in ctx_seqs], *extra, s0)
    o_lat, _ = scan_fn(*[flip(a) for a in lat_seqs], *extra, s_ctx)
    return flip(o_ctx), flip(o_lat)


def hgrn2_group(z_lat, z_ctx, lb, norm_g, need_ctx):
    scale = HGRN_HEAD_DIM ** -0.5

    def heads(a):
        return a.reshape(a.shape[:2] + (HGRN_HEADS, HGRN_HEAD_DIM))

    def seqs(z, d):
        q, i, f_fwd, f_bwd, _ = z
        zf = (f_fwd, f_bwd)[d].astype(jnp.float32)
        lb_d = lb[d]
        k = (1.0 - lb_d) * jax.nn.sigmoid(-zf)
        log_f = jax.nn.log_sigmoid(zf) + jnp.log1p(lb_d * jnp.exp(-zf))
        return (heads(q) * scale, heads(k), heads(i), heads(log_f))

    b = z_lat[0].shape[0]
    s0 = jnp.zeros((b, HGRN_HEADS, HGRN_HEAD_DIM, HGRN_HEAD_DIM), jnp.float32)
    fwd = run_prefix_scan(gla_scan, seqs(z_ctx, 0), seqs(z_lat, 0), (), s0, False)
    bwd = run_prefix_scan(gla_scan, seqs(z_ctx, 1), seqs(z_lat, 1), (), s0, True)

    def readout(o, g):
        return (rms_norm(o, norm_g) * jax.nn.silu(heads(g))).reshape(g.shape)

    out_lat = readout(fwd[1] + bwd[1], z_lat[4])
    out_ctx = readout(fwd[0] + bwd[0], z_ctx[4]) if need_ctx else None
    return out_lat, out_ctx


def mla_group(p_lat, p_ctx, q_norm_g, w_uq, kv_norm_g, w_ukv, need_ctx):
    scale = (MLA_NOPE + MLA_ROPE) ** -0.5

    def qkv(p, rotate):
        c_q, c_kv, k_rope = p
        b, n = c_q.shape[:2]
        q = (rms_norm(c_q, q_norm_g) @ w_uq).reshape(b, n, MLA_HEADS, MLA_NOPE + MLA_ROPE)
        kv = (rms_norm(c_kv, kv_norm_g) @ w_ukv).reshape(b, n, MLA_HEADS, MLA_NOPE + MLA_V)
        q_nope, q_rope = q[..., :MLA_NOPE], q[..., MLA_NOPE:]
        k_nope, v = kv[..., :MLA_NOPE], kv[..., MLA_NOPE:]
        k_rope = k_rope[:, :, None, :]
        if rotate:
            q_rope, k_rope = rope_2d(q_rope), rope_2d(k_rope)
        q = jnp.concatenate([q_nope, q_rope], axis=-1)
        k = jnp.concatenate([k_nope, jnp.broadcast_to(k_rope, (b, n, MLA_HEADS, MLA_ROPE))], axis=-1)
        return q, k, v

    q_l, k_l, v_l = qkv(p_lat, True)
    q_c, k_c, v_c = qkv(p_ctx, False)
    k_all = jnp.concatenate([k_c, k_l], axis=1)
    v_all = jnp.concatenate([v_c, v_l], axis=1)
    o_lat = sweep_query_blocks(lambda qb: attend(qb, k_all, v_all, scale), q_l)
    out_lat = o_lat.reshape(o_lat.shape[:2] + (MLA_HEADS * MLA_V,))
    out_ctx = None
    if need_ctx:
        o_ctx = attend(q_c, k_c, v_c, scale)
        out_ctx = o_ctx.reshape(o_ctx.shape[:2] + (MLA_HEADS * MLA_V,))
    return out_lat, out_ctx


def retention_group(p_lat, p_ctx, decay_logits, need_ctx):
    log_gamma = jax.nn.log_sigmoid(decay_logits.astype(jnp.float32))

    def qkv(p, rotate):
        q, k, v, _ = p
        b, n = q.shape[:2]
        q = q.reshape(b, n, RET_HEADS, RET_QK)
        k = k.reshape(b, n, RET_HEADS, RET_QK) * (RET_QK ** -0.5)
        v = v.reshape(b, n, RET_HEADS, RET_V)
        if rotate:
            pos = jnp.arange(n)
            q, k = rope_1d(q, pos), rope_1d(k, pos)
        return q, k, v

    lat = qkv(p_lat, True)
    ctx = qkv(p_ctx, False)
    b = p_lat[0].shape[0]
    s0 = jnp.zeros((b, RET_HEADS, RET_QK, RET_V), jnp.float32)
    fwd = run_prefix_scan(retention_scan, ctx, lat, (log_gamma[0],), s0, False)
    bwd = run_prefix_scan(retention_scan, ctx, lat, (log_gamma[1],), s0, True)

    def readout(o, g):
        gh = g.reshape(g.shape[:2] + (RET_HEADS, RET_V))
        return (rms_norm(o) * jax.nn.silu(gh)).reshape(g.shape)

    out_lat = readout(fwd[1] + bwd[1], p_lat[3])
    out_ctx = readout(fwd[0] + bwd[0], p_ctx[3]) if need_ctx else None
    return out_lat, out_ctx


def diff_group(p_lat, p_ctx, lam_params, subln_g, layer_idx, need_ctx):
    scale = DIFF_QK ** -0.5
    lambda_init = 0.8 - 0.6 * math.exp(-0.3 * layer_idx)
    lp = lam_params.astype(jnp.float32)
    lam = jnp.exp(jnp.sum(lp[0] * lp[1])) - jnp.exp(jnp.sum(lp[2] * lp[3])) + lambda_init

    def qkv(p, rotate):
        q, k, v = p
        b, n = q.shape[:2]
        q = q.reshape(b, n, DIFF_HEADS, 2, DIFF_QK)
        k = k.reshape(b, n, DIFF_HEADS, 2, DIFF_QK)
        v = v.reshape(b, n, DIFF_HEADS, DIFF_V)
        if rotate:
            q, k = rope_2d(q), rope_2d(k)
        return q, k, v

    q_l, k_l, v_l = qkv(p_lat, True)
    q_c, k_c, v_c = qkv(p_ctx, False)
    k_all = jnp.concatenate([k_c, k_l], axis=1)
    v_all = jnp.concatenate([v_c, v_l], axis=1)

    def readout(o):
        return (rms_norm(o, subln_g) * (1.0 - lambda_init)).reshape(o.shape[:2] + (DIFF_HEADS * DIFF_V,))

    out_lat = readout(sweep_query_blocks(lambda qb: diff_attend(qb, k_all, v_all, scale, lam), q_l))
    out_ctx = readout(diff_attend(q_c, k_c, v_c, scale, lam)) if need_ctx else None
    return out_lat, out_ctx


def even_mixer(h_lat, h_ctx, w_in, w_out, lb, hgrn_norm_g, q_norm_g, w_uq, kv_norm_g, w_ukv, need_ctx):
    p_lat = split_cols(h_lat @ w_in, EVEN_SIZES)
    p_ctx = split_cols(h_ctx @ w_in, EVEN_SIZES)
    a_lat, a_ctx = hgrn2_group(p_lat[:5], p_ctx[:5], lb, hgrn_norm_g, need_ctx)
    b_lat, b_ctx = mla_group(p_lat[5:], p_ctx[5:], q_norm_g, w_uq, kv_norm_g, w_ukv, need_ctx)
    out_lat = jnp.concatenate([a_lat, b_lat], axis=-1) @ w_out
    out_ctx = (jnp.concatenate([a_ctx, b_ctx], axis=-1) @ w_out) if need_ctx else None
    return out_lat, out_ctx


def odd_mixer(h_lat, h_ctx, w_in, w_out, decay_logits, lam_params, subln_g, layer_idx, need_ctx):
    p_lat = split_cols(h_lat @ w_in, ODD_SIZES)
    p_ctx = split_cols(h_ctx @ w_in, ODD_SIZES)
    a_lat, a_ctx = retention_group(p_lat[:4], p_ctx[:4], decay_logits, need_ctx)
    b_lat, b_ctx = diff_group(p_lat[4:], p_ctx[4:], lam_params, subln_g, layer_idx, need_ctx)
    out_lat = jnp.concatenate([a_lat, b_lat], axis=-1) @ w_out
    out_ctx = (jnp.concatenate([a_ctx, b_ctx], axis=-1) @ w_out) if need_ctx else None
    return out_lat, out_ctx


def swiglu(h, w_gate, w_up, w_down):
    return (jax.nn.silu(h @ w_gate) * (h @ w_up)) @ w_down


def setup_inputs(seed: int = 0) -> dict:
    key = jax.random.key(seed)
    ks = jax.random.split(key, 24)
    f32 = jnp.float32

    def nrm(k, shape, fan_in, gain=1.0):
        return gain * (fan_in ** -0.5) * jax.random.normal(k, shape, f32)

    def gain_like(k, shape):
        return 1.0 + 0.05 * jax.random.normal(k, shape, f32)

    ret_base = jnp.log(2.0 ** (5.0 + jnp.arange(RET_HEADS, dtype=f32)) - 1.0)
    return {
        'x': jax.random.normal(ks[0], (BATCH, SEQ, D_MODEL), f32),
        'c': jax.random.normal(ks[1], (BATCH, D_MODEL), f32),
        'ctx': jax.random.normal(ks[2], (BATCH, CTX_LEN, D_MODEL), f32),
        'c_ctx': jax.random.normal(ks[3], (D_MODEL,), f32),
        'ada_w': nrm(ks[4], (DEPTH, D_MODEL, 6 * D_MODEL), D_MODEL, 0.5),
        'ada_b': 0.01 * jax.random.normal(ks[5], (DEPTH, 6 * D_MODEL), f32),
        'norm_g': gain_like(ks[6], (DEPTH, 2, D_MODEL)),
        'mix_w_out': nrm(ks[7], (DEPTH, MIX_WIDTH, D_MODEL), MIX_WIDTH),
        'ffn_w_gate': nrm(ks[8], (DEPTH, D_MODEL, FFN_HIDDEN), D_MODEL),
        'ffn_w_up': nrm(ks[9], (DEPTH, D_MODEL, FFN_HIDDEN), D_MODEL),
        'ffn_w_down': nrm(ks[10], (DEPTH, FFN_HIDDEN, D_MODEL), FFN_HIDDEN),
        'even_w_in': nrm(ks[11], (N_EVEN, D_MODEL, EVEN_IN), D_MODEL),
        'hgrn_lb_logits': 0.1 * jax.random.normal(ks[12], (N_EVEN, 2, HGRN_WIDTH), f32),
        'hgrn_norm_g': gain_like(ks[13], (N_EVEN, HGRN_HEAD_DIM)),
        'mla_q_norm_g': gain_like(ks[14], (N_EVEN, MLA_Q_RANK)),
        'mla_w_uq': nrm(ks[15], (N_EVEN, MLA_Q_RANK, MLA_HEADS * (MLA_NOPE + MLA_ROPE)), MLA_Q_RANK),
        'mla_kv_norm_g': gain_like(ks[16], (N_EVEN, MLA_KV_RANK)),
        'mla_w_ukv': nrm(ks[17], (N_EVEN, MLA_KV_RANK, MLA_HEADS * (MLA_NOPE + MLA_V)), MLA_KV_RANK),
        'odd_w_in': nrm(ks[18], (N_ODD, D_MODEL, ODD_IN), D_MODEL),
        'ret_decay_logits': ret_base[None, None, :] + 0.01 * jax.random.normal(ks[19], (N_ODD, 2, RET_HEADS), f32),
        'diff_lambda': 0.1 * jax.random.normal(ks[20], (N_ODD, 4, DIFF_QK), f32),
        'diff_subln_g': gain_like(ks[21], (N_ODD, DIFF_V)),
        'final_norm_g': gain_like(ks[22], (D_MODEL,)),
    }


def reference(x, c, ctx, c_ctx, ada_w, ada_b, norm_g, mix_w_out, ffn_w_gate, ffn_w_up, ffn_w_down,
              even_w_in, hgrn_lb_logits, hgrn_norm_g, mla_q_norm_g, mla_w_uq, mla_kv_norm_g, mla_w_ukv,
              odd_w_in, ret_decay_logits, diff_lambda, diff_subln_g, final_norm_g):
    lb_soft = jax.nn.softmax(hgrn_lb_logits.astype(jnp.float32), axis=0)
    lbs = jnp.cumsum(lb_soft, axis=0) - lb_soft[0:1]
    s_lat = jax.nn.silu(c)
    s_ctx = jax.nn.silu(c_ctx)
    for layer in range(DEPTH):
        need_ctx = layer < DEPTH - 1
        mod = (s_lat @ ada_w[layer] + ada_b[layer])[:, None, :]
        mod_c = (s_ctx @ ada_w[layer] + ada_b[layer])[None, None, :]
        sh1, sc1, g1, sh2, sc2, g2 = jnp.split(mod, 6, axis=-1)
        csh1, csc1, cg1, csh2, csc2, cg2 = jnp.split(mod_c, 6, axis=-1)
        h_lat = rms_norm(x, norm_g[layer, 0]) * (1.0 + sc1) + sh1
        h_ctx = rms_norm(ctx, norm_g[layer, 0]) * (1.0 + csc1) + csh1
        if layer % 2 == 0:
            e = layer // 2
            u_lat, u_ctx = even_mixer(h_lat, h_ctx, even_w_in[e], mix_w_out[layer], lbs[e], hgrn_norm_g[e],
                                      mla_q_norm_g[e], mla_w_uq[e], mla_kv_norm_g[e], mla_w_ukv[e], need_ctx)
        else:
            o = layer // 2
            u_lat, u_ctx = odd_mixer(h_lat, h_ctx, odd_w_in[o], mix_w_out[layer], ret_decay_logits[o],
                                     diff_lambda[o], diff_subln_g[o], layer, need_ctx)
        x = x + g1 * u_lat
        x = x + g2 * swiglu(rms_norm(x, norm_g[layer, 1]) * (1.0 + sc2) + sh2,
                            ffn_w_gate[layer], ffn_w_up[layer], ffn_w_down[layer])
        if need_ctx:
            ctx = ctx + cg1 * u_ctx
            ctx = ctx + cg2 * swiglu(rms_norm(ctx, norm_g[layer, 1]) * (1.0 + csc2) + csh2,
                                     ffn_w_gate[layer], ffn_w_up[layer], ffn_w_down[layer])
    return rms_norm(x, final_norm_g)
```

```cpp
#include <hip/hip_runtime.h>
#include <hip/hip_cooperative_groups.h>
#include <cstdio>
#include <cstdint>
namespace cg = cooperative_groups;
#define otid() ({ int t_ = (int)threadIdx.x; asm volatile("" : "+v"(t_)); t_; })
extern __shared__ __attribute__((aligned(16))) unsigned char g_lds_dyn[];
#define ptid() (*(volatile __attribute__((address_space(3))) int*)((__attribute__((address_space(3))) unsigned char*)g_lds_dyn + 131072 + 1024 + 4 * (int)threadIdx.x))
namespace pg8 {
#define PG8_LAS __attribute__((address_space(3)))
typedef unsigned short bf16_t;
typedef short bf16x8 __attribute__((ext_vector_type(8)));
typedef float f32x4 __attribute__((ext_vector_type(4)));
typedef unsigned u32x4 __attribute__((ext_vector_type(4)));
constexpr int BM = 256, BK = 64, HALF = 128, HTB = HALF * BK * 2  , STAGE_BYTES = 8 * HTB, NXCD = 8, WGM = 8;

__host__ __device__ __forceinline__ int lds_byte(int r, int c) { const int st = (r >> 4) * 2 + (c >> 5), rr = r & 15, cc = c & 31, ob = rr * 64 + cc * 2; return st * 1024 + (ob ^ (((ob >> 9) & 1) << 5)); }
__host__ __device__ __forceinline__ void stage_rc(int b, int& R, int& C) { const int st = b / 1024, sb = b % 1024, swz = sb ^ (((sb >> 9) & 1) << 5); R = (st >> 1) * 16 + swz / 64; C = (st & 1) * 32 + (swz % 64) / 2; }
__host__ __device__ __forceinline__ int perm32(int rho) { const int n = rho >> 4, i = rho & 15; return 8 * (i >> 2) + 4 * n + (i & 3); }

struct Unit { int pm, pn; };
struct Gemm { const bf16_t* A; const bf16_t* Bt; int M, N, K; };

struct StaticOrder {
    int nM, nN, nwg, G, c;
    __host__ __device__ void init(int M, int N, int G_, int c_) { nM = M / BM; nN = N / BM; nwg = nM * nN; G = G_; c = c_; }
    __host__ __device__ bool next(int i, Unit& u) const {
        const long L = (long)i * G + c; if (L >= nwg) return false;
        int wgid = (int)L; { const int q = nwg / NXCD, r = nwg % NXCD, xcd = wgid % NXCD, off = wgid / NXCD; wgid = (xcd < r ? xcd * (q + 1) : r * (q + 1) + (xcd - r) * q) + off; }
        const int nig = WGM * nN, gid = wgid / nig, fm = gid * WGM, gsz = (nM - fm) < WGM ? (nM - fm) : WGM;
        u.pm = fm + ((wgid % nig) % gsz); u.pn = (wgid % nig) / gsz; return true;
    }
    __device__ __forceinline__ void a_ready(const Unit&) const {}
    __device__ __forceinline__ void done(const Unit&) const {}
};

__device__ __forceinline__ unsigned cvt_pk_bf16(float lo, float hi) { unsigned r; asm volatile("v_cvt_pk_bf16_f32 %0, %1, %2" : "=v"(r) : "v"(lo), "v"(hi)); return r; }
typedef float f32x2 __attribute__((ext_vector_type(2)));
__device__ __forceinline__ f32x2 gelu_pk(f32x2 v) {
    const f32x2 av = __builtin_elementwise_abs(v), d = av * 0.2316418882f + 1.0f;
    f32x2 t; t.x = __builtin_amdgcn_rcpf(d.x); t.y = __builtin_amdgcn_rcpf(d.y);
    f32x2 q = t * 0.5307027145f + (-0.7265760135f); q = q * t + 0.7107068705f; q = q * t + (-0.142248368f); q = q * t + 0.127414796f; q = q * t;
    const f32x2 s = (v * v) * (-0.72134752044f);
    f32x2 e; e.x = __builtin_amdgcn_exp2f(s.x); e.y = __builtin_amdgcn_exp2f(s.y);
    const f32x2 m = v * (q * e), r = v - m;
    f32x2 o; o.x = v.x < 0.f ? m.x : r.x; o.y = v.y < 0.f ? m.y : r.y; return o;
}

template <int ACT  > struct EpiBf16 {
    static constexpr bool PERM = true, AFTER_DRAIN = false; static_assert(ACT == 0 || ACT == 1, "EpiBf16: ACT is 0 (none) or 1 (gelu_pk)");
    bf16_t* O; int ldc; const float* bias; int split_cols; size_t split_stride; float scale0;
    __device__ __forceinline__ void operator()(const f32x4 (&acc)[2][2][4][2], const Unit& u, int wr, int wc, int fr, int fq) const {
        const int row0 = u.pm * BM + wr * 64 + fr; int colt = u.pn * BM; bf16_t* base = O;
        float sc = 1.f; if (split_cols) { const int t = colt / split_cols; base += (size_t)t * split_stride; colt -= t * split_cols; if (t == 0) sc = scale0; }
        const int col0 = colt + wc * 32 + 8 * fq, bcol0 = u.pn * BM + wc * 32 + 8 * fq;
        f32x4 bv[2][2];
#pragma unroll
        for (int bj = 0; bj < 2; ++bj)
#pragma unroll
            for (int n = 0; n < 2; ++n) bv[bj][n] = bias ? *(const f32x4*)(bias + bcol0 + bj * HALF + 4 * n) : (f32x4){0.f, 0.f, 0.f, 0.f};
#pragma unroll
        for (int ai = 0; ai < 2; ++ai)
#pragma unroll
            for (int m = 0; m < 4; ++m) { bf16_t* rowp = base + (size_t)(row0 + ai * HALF + m * 16) * ldc + col0;
#pragma unroll
                for (int bj = 0; bj < 2; ++bj) { f32x4 v0 = acc[ai][bj][m][0] + bv[bj][0], v1 = acc[ai][bj][m][1] + bv[bj][1];
                    if (ACT == 1) { f32x2 a = gelu_pk((f32x2){v0[0], v0[1]}), b = gelu_pk((f32x2){v0[2], v0[3]}), c = gelu_pk((f32x2){v1[0], v1[1]}), d = gelu_pk((f32x2){v1[2], v1[3]});
                        v0 = (f32x4){a.x, a.y, b.x, b.y}; v1 = (f32x4){c.x, c.y, d.x, d.y}; }
                    v0 = v0 * sc; v1 = v1 * sc; u32x4 w; w.x = cvt_pk_bf16(v0[0], v0[1]); w.y = cvt_pk_bf16(v0[2], v0[3]); w.z = cvt_pk_bf16(v1[0], v1[1]); w.w = cvt_pk_bf16(v1[2], v1[3]);
                    *(u32x4*)(rowp + bj * HALF) = w; } }
    }
};
struct EpiSwiGLU {
    static constexpr bool PERM = true, AFTER_DRAIN = false;
    bf16_t* O; int ldc;
    __device__ __forceinline__ void operator()(const f32x4 (&acc)[2][2][4][2], const Unit& u, int wr, int wc, int fr, int fq) const {
        const int row0 = u.pm * BM + wr * 64 + fr; const int col0 = u.pn * HALF + wc * 32 + 8 * fq;
#pragma unroll
        for (int ai = 0; ai < 2; ++ai)
#pragma unroll
            for (int m = 0; m < 4; ++m) { bf16_t* rowp = O + (size_t)(row0 + ai * HALF + m * 16) * ldc + col0;
                float h[8];
#pragma unroll
                for (int n = 0; n < 2; ++n)
#pragma unroll
                    for (int i = 0; i < 4; ++i) { const float g = acc[ai][0][m][n][i], up = acc[ai][1][m][n][i];
                        h[n * 4 + i] = g * __builtin_amdgcn_rcpf(1.0f + __expf(-g)) * up; }
                u32x4 w; w.x = cvt_pk_bf16(h[0], h[1]); w.y = cvt_pk_bf16(h[2], h[3]); w.z = cvt_pk_bf16(h[4], h[5]); w.w = cvt_pk_bf16(h[6], h[7]);
                *(u32x4*)rowp = w; }
    }
};
struct EpiResid {
    static constexpr bool PERM = false, AFTER_DRAIN = false;
    float* X; const float* mod; int goff;
    __device__ __forceinline__ void operator()(const f32x4 (&acc)[2][2][4][2], const Unit& u, int wr, int wc, int fr, int fq) const {
        const int widx = (u.pm % 9 == 0) ? 8 : (u.pm / 9);
        const float* gp = mod + widx * 6144 + goff;
        const int col0 = u.pn * BM + wc * 32 + 4 * fq;
#pragma unroll
        for (int bj = 0; bj < 2; ++bj)
#pragma unroll
            for (int n = 0; n < 2; ++n) { const f32x4 gv = *(const f32x4*)(gp + col0 + bj * HALF + n * 16);
#pragma unroll
                for (int ai = 0; ai < 2; ++ai)
#pragma unroll
                    for (int m = 0; m < 4; ++m) { float* p = X + (size_t)(u.pm * BM + ai * HALF + wr * 64 + m * 16 + fr) * 1024 + col0 + bj * HALF + n * 16;
                        f32x4 x = *(const f32x4*)p; x = x + gv * acc[ai][bj][m][n]; *(f32x4*)p = x; } }
    }
};
template <class Epi, class Sched, bool ALIGN_EPI = false, bool SP2 = false>
__device__ __forceinline__ void gemm_phase(PG8_LAS unsigned char* lds, const Gemm g, const Sched& S, const Epi& E) {
    const int tid = otid(), wid = __builtin_amdgcn_readfirstlane(tid >> 6), lane = tid & 63, wr = wid >> 2, wc = wid & 3, fr = lane & 15, fq = lane >> 4;
    const int K = g.K, nt = K / BK;
    unsigned voffA[2], voffB[2];
#pragma unroll
    for (int i = 0; i < 2; ++i) { int R, C; stage_rc(tid * 16 + i * 8192, R, C); const int Rb = Epi::PERM ? ((R & ~31) + perm32(R & 31)) : R;
        voffA[i] = (unsigned)(R * K + C) * 2u; voffB[i] = (unsigned)(Rb * K + C) * 2u; }
    const size_t kstep = (size_t)(BK * 2);
    const size_t hstep = (size_t)HALF * K * 2;
    const size_t tstep = 2 * hstep;
    const unsigned ldsw = (unsigned)wid * 1024u;
    const int aoff = lds_byte(wr * 64 + fr, fq * 8), boff = lds_byte(wc * 32 + fr, fq * 8);
#define PG8_SA(b, h) (((b) * 2 + (h)) * HTB)
#define PG8_SB(b, h) ((4 + (b) * 2 + (h)) * HTB)
#define PG8_STAGE(bufoff, gbase, voff) do { _Pragma("unroll") for (int _i = 0; _i < 2; ++_i) \
        __builtin_amdgcn_global_load_lds((const unsigned*)((const char*)(gbase) + (voff)[_i]), (PG8_LAS unsigned*)(lds + (bufoff) + ldsw + _i * 8192), 16, 0, 0); } while (0)
#define PG8_LDA(dst, b, h) do { _Pragma("unroll") for (int m = 0; m < 4; ++m) _Pragma("unroll") for (int k = 0; k < 2; ++k) dst[m][k] = *(const PG8_LAS bf16x8*)(lds + PG8_SA(b, h) + aoff + m * 2048 + k * 1024); } while (0)
#define PG8_LDB(dst, b, h) do { _Pragma("unroll") for (int n = 0; n < 2; ++n) _Pragma("unroll") for (int k = 0; k < 2; ++k) dst[n][k] = *(const PG8_LAS bf16x8*)(lds + PG8_SB(b, h) + boff + n * 2048 + k * 1024); } while (0)
#define PG8_MMA(ai, bj, At, Bt) do { __builtin_amdgcn_s_setprio(1); _Pragma("unroll") for (int m = 0; m < 4; ++m) _Pragma("unroll") for (int n = 0; n < 2; ++n) _Pragma("unroll") for (int k = 0; k < 2; ++k) \
        acc[ai][bj][m][n] = __builtin_amdgcn_mfma_f32_16x16x32_bf16(Bt[n][k], At[m][k], acc[ai][bj][m][n], 0, 0, 0); __builtin_amdgcn_s_setprio(0); } while (0)
#define PG8_WAIT_V(n) asm volatile("s_waitcnt vmcnt(" #n ")" ::: "memory")
#define PG8_WAIT_L(n) asm volatile("s_waitcnt lgkmcnt(" #n ")" ::: "memory")
#define PG8_BAR __builtin_amdgcn_s_barrier()
#define PG8_SCHED __builtin_amdgcn_sched_barrier(0)
    Unit cur, nxt; int ui = 0;
    if (!S.next(0, cur)) return;
    f32x4 acc[2][2][4][2];
#pragma unroll
    for (int a = 0; a < 2; ++a)
#pragma unroll
        for (int b = 0; b < 2; ++b)
#pragma unroll
            for (int m = 0; m < 4; ++m)
#pragma unroll
                for (int n = 0; n < 2; ++n) acc[a][b][m][n] = (f32x4){0.f, 0.f, 0.f, 0.f};
    bf16x8 At[4][2], B0[2][2], B1[2][2];
    const char* cA = (const char*)g.A + (size_t)cur.pm * tstep; const char* cB = (const char*)g.Bt + (size_t)cur.pn * tstep;
    S.a_ready(cur);
    if constexpr (SP2) {
        PG8_STAGE(PG8_SB(0, 0), cB, voffB); PG8_STAGE(PG8_SB(0, 1), cB + hstep, voffB); PG8_STAGE(PG8_SA(0, 0), cA, voffA); PG8_STAGE(PG8_SA(0, 1), cA + hstep, voffA);
        if (wr == 1) PG8_BAR;
        PG8_WAIT_V(2); PG8_BAR;
        PG8_STAGE(PG8_SB(1, 0), cB + kstep, voffB); PG8_STAGE(PG8_SA(1, 0), cA + kstep, voffA); PG8_STAGE(PG8_SB(1, 1), cB + hstep + kstep, voffB);
        PG8_WAIT_V(6); PG8_BAR;
    } else {
        PG8_STAGE(PG8_SB(0, 0), cB, voffB); PG8_STAGE(PG8_SA(0, 0), cA, voffA); PG8_STAGE(PG8_SB(0, 1), cB + hstep, voffB); PG8_STAGE(PG8_SA(0, 1), cA + hstep, voffA);
        if (wr == 1) PG8_BAR;
        PG8_WAIT_V(4); PG8_BAR;
        PG8_STAGE(PG8_SB(1, 0), cB + kstep, voffB); PG8_STAGE(PG8_SA(1, 0), cA + kstep, voffA); PG8_STAGE(PG8_SB(1, 1), cB + hstep + kstep, voffB);
        PG8_WAIT_V(6); PG8_BAR;
    }
    for (;;) {
        const bool has_next = S.next(ui + 1, nxt);
        const char* nA = has_next ? (const char*)g.A + (size_t)nxt.pm * tstep : cA; const char* nB = has_next ? (const char*)g.Bt + (size_t)nxt.pn * tstep : cB;
        for (int t = 0; t < nt; t += 2) {
            const bool last = (t == nt - 2);
            const char* a1 = cA + (size_t)(t + 1) * kstep;
            const char* a2 = last ? nA : cA + (size_t)(t + 2) * kstep; const char* b2 = last ? nB : cB + (size_t)(t + 2) * kstep;
            const char* a3 = a2 + kstep; const char* b3 = b2 + kstep;
            if (last && has_next) S.a_ready(nxt);
            if constexpr (SP2) {
            PG8_LDB(B0, 0, 0); PG8_LDB(B1, 0, 1); PG8_SCHED; PG8_LDA(At, 0, 0); PG8_STAGE(PG8_SA(1, 1), a1 + hstep, voffA);
            PG8_WAIT_V(8); PG8_WAIT_L(0); PG8_BAR; PG8_MMA(0, 0, At, B0); PG8_MMA(0, 1, At, B1); PG8_BAR; PG8_SCHED;
            PG8_LDA(At, 0, 1); PG8_STAGE(PG8_SB(0, 0), b2, voffB); PG8_STAGE(PG8_SB(0, 1), b2 + hstep, voffB); PG8_STAGE(PG8_SA(0, 0), a2, voffA);
            PG8_WAIT_V(8); PG8_WAIT_L(0); PG8_BAR; PG8_MMA(1, 0, At, B0); PG8_MMA(1, 1, At, B1); PG8_BAR; PG8_SCHED;
            PG8_LDB(B0, 1, 0); PG8_LDB(B1, 1, 1); PG8_SCHED; PG8_LDA(At, 1, 0); PG8_STAGE(PG8_SA(0, 1), a2 + hstep, voffA);
            PG8_WAIT_V(8); PG8_WAIT_L(0); PG8_BAR; PG8_MMA(0, 0, At, B0); PG8_MMA(0, 1, At, B1); PG8_BAR; PG8_SCHED;
            PG8_LDA(At, 1, 1); PG8_STAGE(PG8_SB(1, 0), b3, voffB); PG8_STAGE(PG8_SB(1, 1), b3 + hstep, voffB); PG8_STAGE(PG8_SA(1, 0), a3, voffA);
            PG8_WAIT_V(8); PG8_WAIT_L(0); PG8_BAR; PG8_MMA(1, 0, At, B0); PG8_MMA(1, 1, At, B1); PG8_BAR; PG8_SCHED;
            } else {
            PG8_LDB(B0, 0, 0); PG8_SCHED; PG8_LDA(At, 0, 0); PG8_STAGE(PG8_SA(1, 1), a1 + hstep, voffA);
            PG8_WAIT_L(8); PG8_BAR; PG8_WAIT_L(0); PG8_MMA(0, 0, At, B0); PG8_BAR; PG8_SCHED;
            PG8_LDB(B1, 0, 1); PG8_STAGE(PG8_SB(0, 0), b2, voffB);
            PG8_BAR; PG8_WAIT_L(0); PG8_MMA(0, 1, At, B1); PG8_BAR;
            PG8_LDA(At, 0, 1); PG8_STAGE(PG8_SA(0, 0), a2, voffA);
            PG8_BAR; PG8_WAIT_L(0); PG8_MMA(1, 0, At, B0); PG8_BAR; PG8_SCHED;
            PG8_STAGE(PG8_SB(0, 1), b2 + hstep, voffB);
            PG8_WAIT_V(6); PG8_BAR; PG8_MMA(1, 1, At, B1); PG8_BAR;
            PG8_LDB(B0, 1, 0); PG8_SCHED; PG8_LDA(At, 1, 0); PG8_STAGE(PG8_SA(0, 1), a2 + hstep, voffA);
            PG8_WAIT_L(8); PG8_BAR; PG8_WAIT_L(0); PG8_MMA(0, 0, At, B0); PG8_BAR; PG8_SCHED;
            PG8_LDB(B1, 1, 1); PG8_STAGE(PG8_SB(1, 0), b3, voffB);
            PG8_BAR; PG8_WAIT_L(0); PG8_MMA(0, 1, At, B1); PG8_BAR;
            PG8_LDA(At, 1, 1); PG8_STAGE(PG8_SA(1, 0), a3, voffA);
            PG8_BAR; PG8_WAIT_L(0); PG8_MMA(1, 0, At, B0); PG8_BAR; PG8_SCHED;
            PG8_STAGE(PG8_SB(1, 1), b3 + hstep, voffB);
            PG8_WAIT_V(6); PG8_BAR; PG8_MMA(1, 1, At, B1); PG8_BAR;
            }
        }
        if constexpr (ALIGN_EPI) { if (wr == 0) PG8_BAR; }
        if constexpr (!Epi::AFTER_DRAIN) { E(acc, cur, wr, wc, fr, fq); S.done(cur); }
        if (!has_next) break;
#pragma unroll
        for (int a = 0; a < 2; ++a)
#pragma unroll
            for (int b = 0; b < 2; ++b)
#pragma unroll
                for (int m = 0; m < 4; ++m)
#pragma unroll
                    for (int n = 0; n < 2; ++n) acc[a][b][m][n] = (f32x4){0.f, 0.f, 0.f, 0.f};
        cur = nxt; cA = nA; cB = nB; ++ui;
        if constexpr (ALIGN_EPI) { if (wr == 1) PG8_BAR; }
    }
    PG8_WAIT_V(0);
    if constexpr (!ALIGN_EPI) { if (wr == 0) PG8_BAR; }
    PG8_BAR;
    if constexpr (Epi::AFTER_DRAIN) { E.fused(acc, cur, wr, wc, fr, fq, lds, wid, lane); S.done(cur); }
#undef PG8_SA
#undef PG8_SB
#undef PG8_STAGE
#undef PG8_LDA
#undef PG8_LDB
#undef PG8_MMA
#undef PG8_WAIT_V
#undef PG8_WAIT_L
#undef PG8_BAR
#undef PG8_SCHED
}
}

typedef unsigned short bf16;
typedef short bf16x8 __attribute__((ext_vector_type(8)));
typedef short s16x4 __attribute__((ext_vector_type(4)));
typedef float f32x4 __attribute__((ext_vector_type(4)));
typedef float f32x16 __attribute__((ext_vector_type(16)));
typedef unsigned u32x4 __attribute__((ext_vector_type(4)));
typedef unsigned u32x2 __attribute__((ext_vector_type(2)));
#define LAS __attribute__((address_space(3)))

constexpr int NB = 8, TPB = 2304, MT = NB * TPB, DM = 1024, NLAT = 2048;
constexpr int NP_E = 3328, NP_O = 3072, FF = 2816;
constexpr float EPSN = 1e-6f;
constexpr size_t MiB = 1u << 20;
constexpr size_t WS_CTL = 0, WS_MOD = 1 * MiB, WS_X = 2 * MiB, WS_H = 74 * MiB, WS_MIX = 110 * MiB, WS_P = 146 * MiB, WS_W = 263 * MiB,
                 WS_OSC = 290 * MiB, WS_KR = 326 * MiB, WS_END = 328 * MiB;
constexpr size_t WS_CQN = WS_MIX, WS_CKVN = WS_MIX + 14 * MiB, WS_DSCR = WS_H;
constexpr size_t W_IN = 0, W_OUT = 13 * MiB / 2, W_GU = 17 * MiB / 2, W_DN = 39 * MiB / 2, W_UQ = 25 * MiB, W_UKV = 25 * MiB + 768 * 1024;
constexpr size_t OUT_KV = 0, OUT_Q = 36 * MiB;
constexpr int LDS_MAIN = 131072, LDS_BYTES = LDS_MAIN + 1024 + 2048;

struct Args { const float* in[23]; float* out; unsigned char* ws; int lo, hi; };
typedef __attribute__((address_space(4))) const Args* KArgP;
__device__ __forceinline__ KArgP kargs() { KArgP p = (KArgP)__builtin_amdgcn_kernarg_segment_ptr(); asm volatile("" : "+s"(p)); return p; }

__device__ __forceinline__ float bf2f(unsigned short h) { return __uint_as_float((unsigned)h << 16); }
__device__ __forceinline__ unsigned f2bf(float f) { unsigned u = __float_as_uint(f); return (u + 0x7fffu + ((u >> 16) & 1u)) >> 16; }
__device__ __forceinline__ unsigned pk2(float lo, float hi) { return f2bf(lo) | (f2bf(hi) << 16); }
__device__ __forceinline__ float wave_sum(float v) {
#pragma unroll
    for (int o = 1; o < 64; o <<= 1) v += __shfl_xor(v, o);
    return v;
}
__device__ __forceinline__ float silu_f(float g) { return g / (1.0f + __expf(-g)); }
__device__ __forceinline__ void sincos_r(float ang, float& s, float& c) {
    float r = ang * 0.15915494309189535f; r = r - __builtin_floorf(r);
    s = __builtin_amdgcn_sinf(r); c = __builtin_amdgcn_cosf(r);
}
__device__ __forceinline__ float inv_freq(int i, int half) { return __builtin_amdgcn_exp2f(-(float)i / (float)half * 13.287712379549449f); }

__device__ __forceinline__ void phase_prep(KArgP a, LAS unsigned char* lds) {
    const int tid = otid(), G = gridDim.x;
    if (blockIdx.x == 0 && tid < 64) ((unsigned*)(a->ws + WS_CTL))[tid] = 0u;
    float* MOD = (float*)(a->ws + WS_MOD);
    LAS float* S = (LAS float*)lds;
    LAS float* R = S + 1024 * 12;
    for (int item = blockIdx.x; item < 192; item += G) {
        const int l = item / 48, n0 = (item % 48) * 128;
        for (int i = tid; i < 9 * 1024; i += 512) { const int w = i >> 10, k = i & 1023; const float v = (w < 8) ? a->in[1][w * 1024 + k] : a->in[3][k]; S[k * 12 + w] = silu_f(v); }
        __syncthreads();
        const int nl = tid & 127, kp = tid >> 7;
        float acc[9];
#pragma unroll
        for (int w = 0; w < 9; ++w) acc[w] = 0.f;
        const float* wp = a->in[4] + (size_t)l * 1024 * 6144 + n0 + nl;
#pragma unroll 4
        for (int k = kp * 256; k < kp * 256 + 256; ++k) {
            const float wv = wp[(size_t)k * 6144];
            const f32x4 s0 = *(const LAS f32x4*)(S + k * 12), s1 = *(const LAS f32x4*)(S + k * 12 + 4); const float s8 = S[k * 12 + 8];
            acc[0] += wv * s0[0]; acc[1] += wv * s0[1]; acc[2] += wv * s0[2]; acc[3] += wv * s0[3];
            acc[4] += wv * s1[0]; acc[5] += wv * s1[1]; acc[6] += wv * s1[2]; acc[7] += wv * s1[3]; acc[8] += wv * s8;
        }
#pragma unroll
        for (int w = 0; w < 9; ++w) R[(kp * 9 + w) * 128 + nl] = acc[w];
        __syncthreads();
        for (int i = tid; i < 9 * 128; i += 512) { const int w = i >> 7, n2 = i & 127;
            const float v = R[(0 * 9 + w) * 128 + n2] + R[(1 * 9 + w) * 128 + n2] + R[(2 * 9 + w) * 128 + n2] + R[(3 * 9 + w) * 128 + n2] + a->in[5][l * 6144 + n0 + n2];
            MOD[(size_t)(l * 9 + w) * 6144 + n0 + n2] = v; }
        __syncthreads();
    }
    f32x4* X4 = (f32x4*)(a->ws + WS_X);
    const size_t total = (size_t)MT * 256, stride = (size_t)G * 512;
    for (size_t i = (size_t)blockIdx.x * 512 + tid; i < total; i += stride) {
        const int row = (int)(i >> 8), c4 = (int)(i & 255); const int b = row / TPB, j = row - b * TPB;
        const f32x4 v = (j < 256) ? ((const f32x4*)a->in[2])[(size_t)(b * 256 + j) * 256 + c4] : ((const f32x4*)a->in[0])[(size_t)(b * NLAT + (j - 256)) * 256 + c4];
        X4[i] = v;
    }
}

__device__ __forceinline__ void transpose_item(const float* W, int K, int N, bf16* WT, int k0, int n0, int drow0, LAS float* scr, int lane) {
#pragma unroll 8
    for (int i = 0; i < 32; ++i) { const int kk = 2 * i + (lane >> 5); scr[kk * 33 + (lane & 31)] = W[(size_t)(k0 + kk) * N + n0 + (lane & 31)]; }
    asm volatile("s_waitcnt lgkmcnt(0)" ::: "memory");
    const int c = lane & 7;
#pragma unroll
    for (int j = 0; j < 4; ++j) { const int n = (lane >> 3) + 8 * j; const LAS float* s = scr + (8 * c) * 33 + n;
        u32x4 o; o.x = pk2(s[0 * 33], s[1 * 33]); o.y = pk2(s[2 * 33], s[3 * 33]); o.z = pk2(s[4 * 33], s[5 * 33]); o.w = pk2(s[6 * 33], s[7 * 33]);
        *(u32x4*)(WT + (size_t)(drow0 + n) * K + k0 + 8 * c) = o; }
    asm volatile("s_waitcnt lgkmcnt(0)" ::: "memory");
}
__device__ __forceinline__ void convert_weights(KArgP a, int layer, LAS unsigned char* lds) {
    const int lane = otid() & 63, wave = otid() >> 6;
    LAS float* scr = (LAS float*)(lds + wave * 8448);
    const int gw = blockIdx.x * 8 + wave, NGW = gridDim.x * 8;
    const bool even = !(layer & 1); const int e = layer >> 1;
    const int nin = even ? 3232 : 3072;
    const float* w_in = even ? a->in[11] + (size_t)e * 1024 * 3232 : a->in[18] + (size_t)e * 1024 * 3072;
    unsigned char* Wb = a->ws + WS_W;
    const int nbin = nin / 32;
    const int I_IN = 16 * nbin, I_OUT = 512, I_G = 16 * 88, I_D = 44 * 32, I_UQ = even ? 6 * 24 : 0, I_UKV = even ? 4 * 32 : 0;
    const int NIT = I_IN + I_OUT + 2 * I_G + I_D + I_UQ + I_UKV;
    for (int it = gw; it < NIT; it += NGW) {
        int r = it;
        if (r < I_IN) { const int kb = r / nbin, nb = r % nbin; transpose_item(w_in, 1024, nin, (bf16*)(Wb + W_IN), 64 * kb, 32 * nb, 32 * nb, scr, lane); continue; } r -= I_IN;
        if (r < I_OUT) { const int kb = r / 32, nb = r % 32; transpose_item(a->in[7] + (size_t)layer * 1024 * 1024, 1024, 1024, (bf16*)(Wb + W_OUT), 64 * kb, 32 * nb, 32 * nb, scr, lane); continue; } r -= I_OUT;
        if (r < I_G) { const int kb = r / 88, nb = r % 88, n0 = 32 * nb; transpose_item(a->in[8] + (size_t)layer * 1024 * FF, 1024, FF, (bf16*)(Wb + W_GU), 64 * kb, n0, (n0 >> 7) * 256 + (n0 & 127), scr, lane); continue; } r -= I_G;
        if (r < I_G) { const int kb = r / 88, nb = r % 88, n0 = 32 * nb; transpose_item(a->in[9] + (size_t)layer * 1024 * FF, 1024, FF, (bf16*)(Wb + W_GU), 64 * kb, n0, (n0 >> 7) * 256 + 128 + (n0 & 127), scr, lane); continue; } r -= I_G;
        if (r < I_D) { const int kb = r / 32, nb = r % 32; transpose_item(a->in[10] + (size_t)layer * FF * 1024, FF, 1024, (bf16*)(Wb + W_DN), 64 * kb, 32 * nb, 32 * nb, scr, lane); continue; } r -= I_D;
        if (r < I_UQ) { const int kb = r / 24, nb = r % 24; transpose_item(a->in[15] + (size_t)e * 384 * 768, 384, 768, (bf16*)(Wb + W_UQ), 64 * kb, 32 * nb, 32 * nb, scr, lane); continue; } r -= I_UQ;
        { const int kb = r / 32, nb = r % 32; transpose_item(a->in[17] + (size_t)e * 256 * 1024, 256, 1024, (bf16*)(Wb + W_UKV), 64 * kb, 32 * nb, 32 * nb, scr, lane); }
    }
}

__device__ __forceinline__ void phase_norm(KArgP a, int layer, int which) {
    const int lane = otid() & 63, wave = otid() >> 6;
    const int gw = blockIdx.x * 8 + wave, NGW = gridDim.x * 8;
    const float* X = (const float*)(a->ws + WS_X); bf16* H = (bf16*)(a->ws + WS_H);
    const float* g = a->in[6] + (layer * 2 + which) * 1024;
    const float* mod = (const float*)(a->ws + WS_MOD) + (size_t)layer * 9 * 6144;
    const int shoff = which ? 3072 : 0, scoff = which ? 4096 : 1024;
    for (int row = gw; row < MT; row += NGW) {
        const int b = row / TPB, j = row - b * TPB, widx = (j < 256) ? 8 : b;
        const f32x4* xr = (const f32x4*)(X + (size_t)row * 1024) + lane;
        f32x4 v[4]; float ss = 0.f;
#pragma unroll
        for (int q = 0; q < 4; ++q) { v[q] = xr[64 * q]; ss += (v[q][0] * v[q][0] + v[q][1] * v[q][1]) + (v[q][2] * v[q][2] + v[q][3] * v[q][3]); }
        const float rstd = __builtin_amdgcn_rsqf(wave_sum(ss) * (1.f / 1024.f) + EPSN);
#pragma unroll
        for (int q = 0; q < 4; ++q) { const int col = 4 * lane + 256 * q;
            const f32x4 gv = *(const f32x4*)(g + col), sc = *(const f32x4*)(mod + widx * 6144 + scoff + col), sh = *(const f32x4*)(mod + widx * 6144 + shoff + col);
            f32x4 y = v[q] * rstd * gv * (sc + 1.0f) + sh;
            u32x2 w; w.x = pk2(y[0], y[1]); w.y = pk2(y[2], y[3]);
            *(u32x2*)(H + (size_t)row * 1024 + col) = w; }
    }
}

__device__ __forceinline__ void phase_post_even(KArgP a, int layer) {
    const int lane = otid() & 63, wave = otid() >> 6;
    const int gw = blockIdx.x * 8 + wave, NGW = gridDim.x * 8, e = layer >> 1;
    const bf16* P = (const bf16*)(a->ws + WS_P); bf16* CQN = (bf16*)(a->ws + WS_CQN); bf16* CKVN = (bf16*)(a->ws + WS_CKVN); bf16* KR = (bf16*)(a->ws + WS_KR);
    const float* qg = a->in[14] + e * 384; const float* kg = a->in[16] + e * 256;
    for (int row = gw; row < MT; row += NGW) {
        const int b = row / TPB, j = row - b * TPB;
        const bf16* pr = P + (size_t)row * NP_E;
        {   float x[6]; float ss = 0.f;
#pragma unroll
            for (int k = 0; k < 3; ++k) { const unsigned w = *(const unsigned*)(pr + 2560 + 2 * lane + 128 * k); x[2 * k] = bf2f((unsigned short)(w & 0xffff)); x[2 * k + 1] = bf2f((unsigned short)(w >> 16)); ss += x[2 * k] * x[2 * k] + x[2 * k + 1] * x[2 * k + 1]; }
            const float rstd = __builtin_amdgcn_rsqf(wave_sum(ss) * (1.f / 384.f) + EPSN);
#pragma unroll
            for (int k = 0; k < 3; ++k) { const int col = 2 * lane + 128 * k; *(unsigned*)(CQN + (size_t)row * 384 + col) = pk2(x[2 * k] * rstd * qg[col], x[2 * k + 1] * rstd * qg[col + 1]); } }
        {   float x[4]; float ss = 0.f;
#pragma unroll
            for (int k = 0; k < 2; ++k) { const unsigned w = *(const unsigned*)(pr + 2944 + 2 * lane + 128 * k); x[2 * k] = bf2f((unsigned short)(w & 0xffff)); x[2 * k + 1] = bf2f((unsigned short)(w >> 16)); ss += x[2 * k] * x[2 * k] + x[2 * k + 1] * x[2 * k + 1]; }
            const float rstd = __builtin_amdgcn_rsqf(wave_sum(ss) * (1.f / 256.f) + EPSN);
#pragma unroll
            for (int k = 0; k < 2; ++k) { const int col = 2 * lane + 128 * k; *(unsigned*)(CKVN + (size_t)row * 256 + col) = pk2(x[2 * k] * rstd * kg[col], x[2 * k + 1] * rstd * kg[col + 1]); } }
        {   const int d = lane & 31; const float x = bf2f(pr[3200 + d]); const float xp = __shfl_xor(x, 8);
            float o = x;
            if (j >= 256) { const int t = j - 256, blk = d >> 4, wi = d & 15, i8 = wi & 7; const float pos = (float)(blk ? (t & 63) : (t >> 6));
                float s, c; sincos_r(pos * inv_freq(i8, 8), s, c);
                o = (wi < 8) ? (x * c - xp * s) : (xp * s + x * c); }
            if (lane < 32) KR[(size_t)row * 32 + d] = (bf16)f2bf(o); }
    }
}
__device__ __forceinline__ void phase_post_odd(KArgP a, int layer) {
    const int lane = otid() & 63, wave = otid() >> 6;
    const int gw = blockIdx.x * 8 + wave, NGW = gridDim.x * 8;
    bf16* P = (bf16*)(a->ws + WS_P);
    for (int row = gw; row < MT; row += NGW) {
        const int b = row / TPB, j = row - b * TPB; const bool lat = j >= 256; const int t = j - 256;
        bf16* pr = P + (size_t)row * NP_O;
#pragma unroll
        for (int u = 0; u < 2; ++u) { const int pid = lane + 64 * u, h = pid >> 5, i = pid & 31, d1 = h * 64 + i, d2 = d1 + 32;
            float s = 0.f, c = 1.f; if (lat) sincos_r((float)t * inv_freq(i, 32), s, c);
            const float q1 = bf2f(pr[d1]), q2 = bf2f(pr[d2]), k1 = bf2f(pr[256 + d1]) * 0.125f, k2 = bf2f(pr[256 + d2]) * 0.125f;
            if (lat) { pr[d1] = (bf16)f2bf(q1 * c - q2 * s); pr[d2] = (bf16)f2bf(q1 * s + q2 * c); }
            pr[256 + d1] = (bf16)f2bf(k1 * c - k2 * s); pr[256 + d2] = (bf16)f2bf(k1 * s + k2 * c); }
        if (lat) {
#pragma unroll
            for (int u = 0; u < 4; ++u) { const int pid = lane + 64 * u, vec = pid >> 5, pp = pid & 31, blk = pp >> 4, i = pp & 15, d1 = vec * 64 + blk * 32 + i, d2 = d1 + 16;
                const float pos = (float)(blk ? (t & 63) : (t >> 6)); float s, c; sincos_r(pos * inv_freq(i, 16), s, c);
                const float q1 = bf2f(pr[1536 + d1]), q2 = bf2f(pr[1536 + d2]), k1 = bf2f(pr[2048 + d1]), k2 = bf2f(pr[2048 + d2]);
                pr[1536 + d1] = (bf16)f2bf(q1 * c - q2 * s); pr[1536 + d2] = (bf16)f2bf(q1 * s + q2 * c);
                pr[2048 + d1] = (bf16)f2bf(k1 * c - k2 * s); pr[2048 + d2] = (bf16)f2bf(k1 * s + k2 * c); } }
    }
}

__device__ __forceinline__ void phase_readout(KArgP a, int layer) {
    const int lane = otid() & 63, wave = otid() >> 6;
    const int gw = blockIdx.x * 8 + wave, NGW = gridDim.x * 8;
    const bool even = !(layer & 1); const int np = even ? NP_E : NP_O, gcol = even ? 2048 : 1024;
    const bf16* P = (const bf16*)(a->ws + WS_P); const bf16* OF = (const bf16*)(a->ws + WS_OSC); const bf16* OB = OF + (size_t)MT * 512;
    bf16* MIX = (bf16*)(a->ws + WS_MIX);
    float g0 = 1.f, g1 = 1.f; if (even) { g0 = a->in[13][(layer >> 1) * 128 + 2 * lane]; g1 = a->in[13][(layer >> 1) * 128 + 2 * lane + 1]; }
    for (int row = gw; row < MT; row += NGW) {
#pragma unroll
        for (int h = 0; h < 4; ++h) { const int col = h * 128 + 2 * lane;
            const unsigned wf = *(const unsigned*)(OF + (size_t)row * 512 + col), wb = *(const unsigned*)(OB + (size_t)row * 512 + col), wg = *(const unsigned*)(P + (size_t)row * np + gcol + col);
            const float o0 = bf2f((unsigned short)(wf & 0xffff)) + bf2f((unsigned short)(wb & 0xffff)), o1 = bf2f((unsigned short)(wf >> 16)) + bf2f((unsigned short)(wb >> 16));
            const float rstd = __builtin_amdgcn_rsqf(wave_sum(o0 * o0 + o1 * o1) * (1.f / 128.f) + EPSN);
            const float y0 = o0 * rstd * g0 * silu_f(bf2f((unsigned short)(wg & 0xffff))), y1 = o1 * rstd * g1 * silu_f(bf2f((unsigned short)(wg >> 16)));
            *(unsigned*)(MIX + (size_t)row * 1024 + col) = pk2(y0, y1); }
    }
}
__device__ __forceinline__ void phase_final(KArgP a) {
    const int lane = otid() & 63, wave = otid() >> 6;
    const int gw = blockIdx.x * 8 + wave, NGW = gridDim.x * 8;
    const float* X = (const float*)(a->ws + WS_X); const float* g = a->in[22];
    for (int r = gw; r < NB * NLAT; r += NGW) {
        const int b = r >> 11, t = r & 2047, row = b * TPB + 256 + t;
        const f32x4* xr = (const f32x4*)(X + (size_t)row * 1024) + lane;
        f32x4 v[4]; float ss = 0.f;
#pragma unroll
        for (int q = 0; q < 4; ++q) { v[q] = xr[64 * q]; ss += (v[q][0] * v[q][0] + v[q][1] * v[q][1]) + (v[q][2] * v[q][2] + v[q][3] * v[q][3]); }
        const float rstd = __builtin_amdgcn_rsqf(wave_sum(ss) * (1.f / 1024.f) + EPSN);
#pragma unroll
        for (int q = 0; q < 4; ++q) { const int col = 4 * lane + 256 * q; const f32x4 gv = *(const f32x4*)(g + col);
            *(f32x4*)(a->out + (size_t)r * 1024 + col) = v[q] * rstd * gv; }
    }
}

__device__ __forceinline__ f32x4 mfma16(bf16x8 a, bf16x8 b, f32x4 c) { return __builtin_amdgcn_mfma_f32_16x16x32_bf16(a, b, c, 0, 0, 0); }

template <int DK, bool HG>
__device__ __forceinline__ void scan_item(KArgP a, int layer, int item, LAS unsigned char* lds) {
    const int tid = otid(), wid = tid >> 6, lane = tid & 63, l15 = lane & 15, q4 = lane >> 4;
    const int h = item & 3, dir = (item >> 2) & 1, b = item >> 3;
    constexpr int TPT = DK / 8, QS = DK * 2 + 16, TS = 144;
    constexpr int NP = HG ? NP_E : NP_O;
    LAS unsigned char* Lqt = lds; LAS unsigned char* Lkt = Lqt + 64 * QS; LAS unsigned char* Lqh = Lkt + 64 * QS;
    LAS unsigned char* LkhT = Lqh + 64 * QS; LAS unsigned char* LvT = LkhT + DK * TS; LAS unsigned char* Latt = LvT + 128 * TS;
    LAS float* Ltot = (LAS float*)(Latt + 64 * TS); LAS float* Lbl = Ltot + 512;
    const bf16* P = (const bf16*)(a->ws + WS_P);
    bf16* OSC = (bf16*)(a->ws + WS_OSC) + (size_t)dir * MT * 512;
    const int c = tid & (DK - 1), tq = tid / DK;
    float lb = 0.f, lg = 0.f, qscale = 1.f; int qcol, zcol;
    if (HG) { qscale = 0.08838834764831845f; qcol = h * 128 + c; zcol = (dir ? 1536 : 1024) + h * 128 + c;
        if (layer >= 2) { const float l0 = a->in[12][(0 * 2 + dir) * 512 + h * 128 + c], l1 = a->in[12][(1 * 2 + dir) * 512 + h * 128 + c]; lb = 1.f / (1.f + __expf(l0 - l1)); } }
    else { qcol = h * 64 + c; zcol = 256 + h * 64 + c; const float x = a->in[19][((layer >> 1) * 2 + dir) * 4 + h]; lg = -__logf(1.f + __expf(-x)); }
    const int vcol = 512 + h * 128;
    const int rowbase = b * TPB;
    const int tv = lane, c8v = wid;
    unsigned short rq[TPT], rz[TPT]; bf16x8 rv[2];
#define SC_JB(ci) (dir ? ((ci) < 4 ? 255 - 64 * (ci) : 2303 - 64 * ((ci) - 4)) : 64 * (ci))
#define SC_LOAD(ci) do { const int jb_ = SC_JB(ci), sg_ = dir ? -1 : 1; \
        _Pragma("unroll") for (int i = 0; i < TPT; ++i) { const bf16* pr_ = P + (size_t)(rowbase + jb_ + sg_ * (tq * TPT + i)) * NP; rq[i] = pr_[qcol]; rz[i] = pr_[zcol]; } \
        { const bf16* pv_ = P + (size_t)(rowbase + jb_ + sg_ * tv) * NP + vcol; rv[0] = *(const bf16x8*)(pv_ + c8v * 8); rv[1] = *(const bf16x8*)(pv_ + (c8v + 8) * 8); } } while (0)
    f32x4 Sacc[DK / 16];
#pragma unroll
    for (int i = 0; i < DK / 16; ++i) Sacc[i] = (f32x4){0.f, 0.f, 0.f, 0.f};
    SC_LOAD(0);
    for (int ci = 0; ci < 36; ++ci) {
        float kk_[TPT], bc[TPT]; float pre = 0.f, ref, blast;
        if (HG) {
            float run = 0.f;
#pragma unroll
            for (int i = 0; i < TPT; ++i) { float z = bf2f(rz[i]); z = fminf(fmaxf(z, -30.f), 30.f);
                const float ez = __expf(-fabsf(z)), enz = __expf(-z);
                kk_[i] = (1.f - lb) / (1.f + __expf(z));
                const float g = fminf(z, 0.f) - __logf(1.f + ez) + __logf(1.f + lb * enz);
                run += g; bc[i] = run; }
            Ltot[tq * 128 + c] = run;
            __syncthreads();
            const float t0 = Ltot[c], t1 = Ltot[128 + c], t2 = Ltot[256 + c], t3 = Ltot[384 + c];
            pre = (tq > 0 ? t0 : 0.f) + (tq > 1 ? t1 : 0.f) + (tq > 2 ? t2 : 0.f);
            ref = t0 + t1; blast = (t0 + t1) + (t2 + t3);
        } else {
#pragma unroll
            for (int i = 0; i < TPT; ++i) { kk_[i] = bf2f(rz[i]); bc[i] = (float)(tq * TPT + i + 1) * lg; }
            ref = 32.f * lg; blast = 64.f * lg;
        }
        unsigned short kh[TPT];
#pragma unroll
        for (int i = 0; i < TPT; ++i) { const int tau = tq * TPT + i; const float bcum = pre + bc[i]; const float qv = bf2f(rq[i]) * qscale, kv = kk_[i];
            const float e1 = fminf(bcum - ref, 80.f), e2 = fminf(ref - bcum, 80.f);
            *(LAS unsigned short*)(Lqt + tau * QS + c * 2) = (unsigned short)f2bf(qv * __expf(e1));
            *(LAS unsigned short*)(Lkt + tau * QS + c * 2) = (unsigned short)f2bf(kv * __expf(e2));
            *(LAS unsigned short*)(Lqh + tau * QS + c * 2) = (unsigned short)f2bf(qv * __expf(bcum));
            kh[i] = (unsigned short)f2bf(kv * __expf(blast - bcum)); }
#pragma unroll
        for (int i8 = 0; i8 < TPT / 8; ++i8) { u32x4 w; w.x = kh[8 * i8] | ((unsigned)kh[8 * i8 + 1] << 16); w.y = kh[8 * i8 + 2] | ((unsigned)kh[8 * i8 + 3] << 16);
            w.z = kh[8 * i8 + 4] | ((unsigned)kh[8 * i8 + 5] << 16); w.w = kh[8 * i8 + 6] | ((unsigned)kh[8 * i8 + 7] << 16);
            *(LAS u32x4*)(LkhT + c * TS + (tq * TPT + 8 * i8) * 2) = w; }
        if (tq == 0) Lbl[c] = __expf(blast);
#pragma unroll
        for (int u = 0; u < 2; ++u)
#pragma unroll
            for (int e = 0; e < 8; ++e) *(LAS unsigned short*)(LvT + ((c8v + 8 * u) * 8 + e) * TS + tv * 2) = (unsigned short)rv[u][e];
        __syncthreads();
        const int jb = SC_JB(ci), sg = dir ? -1 : 1;
        if (ci + 1 < 36) SC_LOAD(ci + 1);
#pragma unroll
        for (int tt = 0; tt < 2; ++tt) { const int idx = 2 * wid + tt, si = idx >> 2, ti = idx & 3;
            f32x4 acc = (f32x4){0.f, 0.f, 0.f, 0.f};
#pragma unroll
            for (int kk = 0; kk < DK / 32; ++kk) { const bf16x8 A = *(const LAS bf16x8*)(Lkt + (16 * si + l15) * QS + (32 * kk + 8 * q4) * 2);
                const bf16x8 B = *(const LAS bf16x8*)(Lqt + (16 * ti + l15) * QS + (32 * kk + 8 * q4) * 2); acc = mfma16(A, B, acc); }
            const int t = 16 * ti + l15, s0 = 16 * si + 4 * q4;
            u32x2 w; w.x = pk2(s0 + 0 <= t ? acc[0] : 0.f, s0 + 1 <= t ? acc[1] : 0.f); w.y = pk2(s0 + 2 <= t ? acc[2] : 0.f, s0 + 3 <= t ? acc[3] : 0.f);
            *(LAS u32x2*)(Latt + t * TS + s0 * 2) = w; }
        __syncthreads();
        const int dvl = 16 * wid + l15;
        const bf16x8 bv0 = *(const LAS bf16x8*)(LvT + dvl * TS + (8 * q4) * 2), bv1 = *(const LAS bf16x8*)(LvT + dvl * TS + (32 + 8 * q4) * 2);
        bf16x8 Sb[DK / 32];
#pragma unroll
        for (int kk = 0; kk < DK / 32; ++kk) { u32x4 w; w.x = pk2(Sacc[2 * kk][0], Sacc[2 * kk][1]); w.y = pk2(Sacc[2 * kk][2], Sacc[2 * kk][3]);
            w.z = pk2(Sacc[2 * kk + 1][0], Sacc[2 * kk + 1][1]); w.w = pk2(Sacc[2 * kk + 1][2], Sacc[2 * kk + 1][3]); Sb[kk] = __builtin_bit_cast(bf16x8, w); }
#pragma unroll
        for (int ti = 0; ti < 4; ++ti) {
            f32x4 acc = (f32x4){0.f, 0.f, 0.f, 0.f};
            { const bf16x8 A = *(const LAS bf16x8*)(Latt + (16 * ti + l15) * TS + (8 * q4) * 2); acc = mfma16(A, bv0, acc); }
            if (ti >= 2) { const bf16x8 A = *(const LAS bf16x8*)(Latt + (16 * ti + l15) * TS + (32 + 8 * q4) * 2); acc = mfma16(A, bv1, acc); }
#pragma unroll
            for (int kk = 0; kk < DK / 32; ++kk) {
                const s16x4 lo = *(const LAS s16x4*)(Lqh + (16 * ti + l15) * QS + (32 * kk + 4 * q4) * 2), hi = *(const LAS s16x4*)(Lqh + (16 * ti + l15) * QS + (32 * kk + 16 + 4 * q4) * 2);
                const bf16x8 A = (bf16x8){lo[0], lo[1], lo[2], lo[3], hi[0], hi[1], hi[2], hi[3]};
                acc = mfma16(A, Sb[kk], acc); }
#pragma unroll
            for (int r = 0; r < 4; ++r) { const int t = 16 * ti + 4 * q4 + r;
                OSC[(size_t)(rowbase + jb + sg * t) * 512 + h * 128 + dvl] = (bf16)f2bf(acc[r]); }
        }
#pragma unroll
        for (int i = 0; i < DK / 16; ++i) {
            const f32x4 d4 = *(const LAS f32x4*)(Lbl + 16 * i + 4 * q4);
            f32x4 s = Sacc[i] * d4;
            const bf16x8 A0 = *(const LAS bf16x8*)(LkhT + (16 * i + l15) * TS + (8 * q4) * 2), A1 = *(const LAS bf16x8*)(LkhT + (16 * i + l15) * TS + (32 + 8 * q4) * 2);
            s = mfma16(A0, bv0, s); s = mfma16(A1, bv1, s); Sacc[i] = s; }
        __syncthreads();
    }
#undef SC_JB
#undef SC_LOAD
}

#define SBAR() __builtin_amdgcn_sched_barrier(0)
__device__ __forceinline__ int crow(int r, int hi) { return (r & 3) + 8 * (r >> 2) + 4 * hi; }
__device__ __forceinline__ unsigned cvtpk(float lo, float hi) { unsigned r; asm volatile("v_cvt_pk_bf16_f32 %0, %1, %2" : "=v"(r) : "v"(lo), "v"(hi)); return r; }
__device__ __forceinline__ void partialSM(f32x16& p0, f32x16& p1, float& m_reg, float& mn, float& alpha, float C, float thr_raw) {
    float pmax = p0[0];
#pragma unroll
    for (int r = 1; r < 16; ++r) pmax = fmaxf(pmax, p0[r]);
#pragma unroll
    for (int r = 0; r < 16; ++r) pmax = fmaxf(pmax, p1[r]);
    { auto rr = __builtin_amdgcn_permlane32_swap(__float_as_uint(pmax), __float_as_uint(pmax), false, false);
      pmax = fmaxf(__uint_as_float(rr[0]), __uint_as_float(rr[1])); }
    if (__builtin_expect(__all(pmax - m_reg <= thr_raw), 1)) { mn = m_reg; alpha = 1.f; }
    else { mn = fmaxf(m_reg, pmax); alpha = __builtin_amdgcn_exp2f((m_reg - mn) * C); m_reg = mn; }
    const float mnC = -mn * C;
#pragma unroll
    for (int r = 0; r < 16; ++r) p0[r] = fmaf(p0[r], C, mnC);
#pragma unroll
    for (int r = 0; r < 16; ++r) p1[r] = fmaf(p1[r], C, mnC);
#pragma unroll
    for (int r = 0; r < 16; ++r) p0[r] = __builtin_amdgcn_exp2f(p0[r]);
}
__device__ __forceinline__ void finishSM(f32x16& p0, f32x16& p1, float alpha, float& l_reg, bf16x8& pa0, bf16x8& pa1, bf16x8& pa2, bf16x8& pa3) {
#pragma unroll
    for (int r = 0; r < 16; ++r) p1[r] = __builtin_amdgcn_exp2f(p1[r]);
    float ps = 0;
#pragma unroll
    for (int r = 0; r < 16; ++r) ps += p0[r];
#pragma unroll
    for (int r = 0; r < 16; ++r) ps += p1[r];
    { auto rr = __builtin_amdgcn_permlane32_swap(__float_as_uint(ps), __float_as_uint(ps), false, false);
      ps = __uint_as_float(rr[0]) + __uint_as_float(rr[1]); }
    l_reg = l_reg * alpha + ps;
#define PK4(P, BASE, OUT) do { unsigned a0 = cvtpk(P[BASE + 0], P[BASE + 1]), a1 = cvtpk(P[BASE + 2], P[BASE + 3]);   \
    unsigned b0 = cvtpk(P[BASE + 4], P[BASE + 5]), b1 = cvtpk(P[BASE + 6], P[BASE + 7]);                              \
    auto r0 = __builtin_amdgcn_permlane32_swap(a0, b0, false, false); auto r1 = __builtin_amdgcn_permlane32_swap(a1, b1, false, false); \
    u32x4 w = {r0[0], r1[0], r0[1], r1[1]}; OUT = __builtin_bit_cast(bf16x8, w); } while (0)
    PK4(p0, 0, pa0); PK4(p0, 8, pa1); PK4(p1, 0, pa2); PK4(p1, 8, pa3);
#undef PK4
}
template <int ND0, int KROWB>
__device__ __forceinline__ void qkt(f32x16& p0, f32x16& p1, const char* Ks, const bf16x8* qr, int r32, int hi) {
    p0 = f32x16{}; p1 = f32x16{};
#pragma unroll
    for (int d0 = 0; d0 < ND0; ++d0) { const int cb = (d0 * 16 + hi * 8) * 2;
        const bf16x8 b0 = *reinterpret_cast<const bf16x8*>(Ks + r32 * KROWB + (cb ^ ((r32 & 7) << 4)));
        const bf16x8 b1 = *reinterpret_cast<const bf16x8*>(Ks + (32 + r32) * KROWB + (cb ^ ((r32 & 7) << 4)));
        p0 = __builtin_amdgcn_mfma_f32_32x32x16_bf16(b0, qr[d0], p0, 0, 0, 0);
        p1 = __builtin_amdgcn_mfma_f32_32x32x16_bf16(b1, qr[d0], p1, 0, 0, 0); }
}
template <int NCB> __device__ __forceinline__ int v_st(int k, int c) { const int kk = (k & ~0xC) | ((k & 4) << 1) | ((k & 8) >> 1); return ((kk >> 3) * NCB + (c >> 5)) * 512 + ((kk & 7) * 32 + (c & 31)) * 2; }
__device__ __forceinline__ int v_rd_base(int lane) { return ((lane & 3) << 3) | (((lane >> 2) & 3) << 6) | (((lane >> 4) & 1) << 5) | (((lane >> 5) & 1) << 8); }
template <int OFF> __device__ __forceinline__ s16x4 tr_read(int vb) {
    s16x4 r; asm volatile("ds_read_b64_tr_b16 %0, %1 offset:%2" : "=&v"(r) : "v"(vb), "i"(OFF) : "memory"); return r;
}
template <int NCB, int D0> __device__ __forceinline__ void pv_one(f32x16& od, int vb, bf16x8 pa0, bf16x8 pa1, bf16x8 pa2, bf16x8 pa3) {
#define VOFF(ks, half) (D0 * 512 + (ks) * (NCB * 1024) + (half) * (NCB * 512))
    const s16x4 l0 = tr_read<VOFF(0, 0)>(vb), h0 = tr_read<VOFF(0, 1)>(vb), l1 = tr_read<VOFF(1, 0)>(vb), h1 = tr_read<VOFF(1, 1)>(vb);
    const s16x4 l2 = tr_read<VOFF(2, 0)>(vb), h2 = tr_read<VOFF(2, 1)>(vb), l3 = tr_read<VOFF(3, 0)>(vb), h3 = tr_read<VOFF(3, 1)>(vb);
#undef VOFF
    asm volatile("s_waitcnt lgkmcnt(0)" ::: "memory"); SBAR();
#define PK(L, H) (bf16x8){L[0], L[1], L[2], L[3], H[0], H[1], H[2], H[3]}
    od = __builtin_amdgcn_mfma_f32_32x32x16_bf16(pa0, PK(l0, h0), od, 0, 0, 0);
    od = __builtin_amdgcn_mfma_f32_32x32x16_bf16(pa1, PK(l1, h1), od, 0, 0, 0);
    od = __builtin_amdgcn_mfma_f32_32x32x16_bf16(pa2, PK(l2, h2), od, 0, 0, 0);
    od = __builtin_amdgcn_mfma_f32_32x32x16_bf16(pa3, PK(l3, h3), od, 0, 0, 0);
#undef PK
}
template <int NCB> __device__ __forceinline__ void pv_all(f32x16* o, int vb, bf16x8 pa0, bf16x8 pa1, bf16x8 pa2, bf16x8 pa3) {
    pv_one<NCB, 0>(o[0], vb, pa0, pa1, pa2, pa3); pv_one<NCB, 1>(o[1], vb, pa0, pa1, pa2, pa3);
    if constexpr (NCB == 4) { pv_one<NCB, 2>(o[2], vb, pa0, pa1, pa2, pa3); pv_one<NCB, 3>(o[3], vb, pa0, pa1, pa2, pa3); }
}

template <int DQK, int DV, int KROWB>
__device__ __forceinline__ void attn_core(const bf16x8* qr, const bf16* kA, int sA, const bf16* kB, int sB, const bf16* vP, int sV,
                                          int NT, float C, float thr_raw, char* lds, f32x16* o, float& l_out, const int tid) {
    constexpr int NCB = DV / 32, SHM_V = 64 * DV * 2, SHM_K = 64 * KROWB, ND0 = DQK / 16;
    constexpr int PPR = DQK / 8, NPK = 64 * PPR, NKS = (NPK + 511) / 512, VPR = DV / 8, NVS = 64 * VPR / 512;
    const int wid = tid >> 6, lane = tid & 63, r32 = lane & 31, hi = lane >> 5;
    char* V_lds = lds; char* K_lds = lds + 2 * SHM_V;
    float* wsf = (float*)(lds + 2 * SHM_V + 2 * SHM_K) + wid * 64; float* al_l = wsf + 32;
    float m_reg = -1e30f, l_reg = 0;
    const bf16* kp[NKS]; int kadv[NKS], kst[NKS]; bool kval[NKS];
#pragma unroll
    for (int i = 0; i < NKS; ++i) { int p = tid + 512 * i; kval[i] = p < NPK; if (!kval[i]) p -= 512; const int row = p / PPR, c8 = p - row * PPR;
        if (c8 < 8) { kp[i] = kA + (size_t)row * sA + c8 * 8; kadv[i] = 64 * sA; } else { kp[i] = kB + (size_t)row * sB + (c8 - 8) * 8; kadv[i] = 64 * sB; }
        kst[i] = row * KROWB + ((c8 * 16) ^ ((row & 7) << 4)); }
    const bf16* vp[NVS]; int vst[NVS];
#pragma unroll
    for (int i = 0; i < NVS; ++i) { const int p = tid + 512 * i, row = p / VPR, c8 = p % VPR; vp[i] = vP + (size_t)row * sV + c8 * 8; vst[i] = v_st<NCB>(row, c8 * 8); }
    const int vadv = 64 * sV;
    const int vb0 = (int)(uintptr_t)V_lds + v_rd_base(lane);
    struct { bf16x8 ks[NKS]; bf16x8 vs[NVS]; } sr_[1];
#define SLOAD(i, t) do { _Pragma("unroll") for (int s_ = 0; s_ < NKS; ++s_) sr_[i].ks[s_] = *(const bf16x8*)(kp[s_] + (size_t)(t) * kadv[s_]); \
        _Pragma("unroll") for (int s_ = 0; s_ < NVS; ++s_) sr_[i].vs[s_] = *(const bf16x8*)(vp[s_] + (size_t)(t) * vadv); } while (0)
#define SWRITE(b, i) do { _Pragma("unroll") for (int s_ = 0; s_ < NVS; ++s_) *(bf16x8*)(V_lds + (b) * SHM_V + vst[s_]) = sr_[i].vs[s_]; \
        _Pragma("unroll") for (int s_ = 0; s_ < NKS; ++s_) if (kval[s_]) *(bf16x8*)(K_lds + (b) * SHM_K + kst[s_]) = sr_[i].ks[s_]; } while (0)
#define RESC(a) do { if (__any((a) < 1.f)) { if (hi == 0) al_l[r32] = (a); asm volatile("s_waitcnt lgkmcnt(0)" ::: "memory"); \
        _Pragma("unroll") for (int d = 0; d < NCB; ++d) _Pragma("unroll") for (int r = 0; r < 16; ++r) o[d][r] *= al_l[crow(r, hi)]; } } while (0)
    f32x16 pA0, pA1, pB0, pB1; float mnA, mnB, alA, alB; bf16x8 pa0, pa1, pa2, pa3;
    constexpr int SE = 0, SO = 0;
    SLOAD(SE, 0); SWRITE(0, SE); __syncthreads();
    qkt<ND0, KROWB>(pA0, pA1, K_lds, qr, r32, hi); partialSM(pA0, pA1, m_reg, mnA, alA, C, thr_raw);
    SLOAD(SO, 1);
    SWRITE(1, SO); __syncthreads();
    for (int j = 1; j + 1 < NT; j += 2) {
        SBAR(); qkt<ND0, KROWB>(pB0, pB1, K_lds + SHM_K, qr, r32, hi);
        finishSM(pA0, pA1, alA, l_reg, pa0, pa1, pa2, pa3); SBAR();
        SLOAD(SO, j + 1); SBAR();
        pv_all<NCB>(o, vb0, pa0, pa1, pa2, pa3); partialSM(pB0, pB1, m_reg, mnB, alB, C, thr_raw);
        __syncthreads(); SWRITE(0, SE);
        RESC(alB); __syncthreads();
        SBAR(); qkt<ND0, KROWB>(pA0, pA1, K_lds, qr, r32, hi);
        finishSM(pB0, pB1, alB, l_reg, pa0, pa1, pa2, pa3); SBAR();
        SLOAD(SE, j + 2); SBAR();
        pv_all<NCB>(o, vb0 + SHM_V, pa0, pa1, pa2, pa3); partialSM(pA0, pA1, m_reg, mnA, alA, C, thr_raw);
        __syncthreads(); SWRITE(1, SO);
        RESC(alA); __syncthreads();
    }
    SBAR(); qkt<ND0, KROWB>(pB0, pB1, K_lds + SHM_K, qr, r32, hi);
    finishSM(pA0, pA1, alA, l_reg, pa0, pa1, pa2, pa3); SBAR();
    pv_all<NCB>(o, vb0, pa0, pa1, pa2, pa3); partialSM(pB0, pB1, m_reg, mnB, alB, C, thr_raw);
    __syncthreads(); RESC(alB);
    finishSM(pB0, pB1, alB, l_reg, pa0, pa1, pa2, pa3); SBAR();
    pv_all<NCB>(o, vb0 + SHM_V, pa0, pa1, pa2, pa3);
    l_out = l_reg;
#undef SLOAD
#undef SWRITE
#undef RESC
}

__device__ __forceinline__ void mla_item(KArgP a, int b, int h, int qb, char* lds) {
    const int tid = ptid(), wid = tid >> 6, lane = tid & 63, r32 = lane & 31, hi = lane >> 5;
    const bf16* Qb = (const bf16*)((const unsigned char*)a->out + OUT_Q); const bf16* KV = (const bf16*)((const unsigned char*)a->out + OUT_KV);
    const bf16* KR = (const bf16*)(a->ws + WS_KR); bf16* MIX = (bf16*)(a->ws + WS_MIX);
    const int row0 = b * TPB + qb * 256, krow0 = b * TPB, NT = qb ? 36 : 4;
    const int row = row0 + wid * 32 + r32;
    const bf16* Qw = Qb + (size_t)row * 768 + h * 96;
    bf16x8 qr[6];
#pragma unroll
    for (int d0 = 0; d0 < 4; ++d0) qr[d0] = *(const bf16x8*)(Qw + d0 * 16 + hi * 8);
    const int t = (qb - 1) * 256 + wid * 32 + r32;
#pragma unroll
    for (int d0 = 4; d0 < 6; ++d0) {
        const bf16x8 x1 = *(const bf16x8*)(Qw + d0 * 16), x2 = *(const bf16x8*)(Qw + d0 * 16 + 8);
        if (qb) { const float pos = (float)(d0 == 4 ? (t >> 6) : (t & 63)); unsigned short ov[8];
#pragma unroll
            for (int i = 0; i < 8; ++i) { float s, c; sincos_r(pos * inv_freq(i, 8), s, c); const float f1 = bf2f((unsigned short)x1[i]), f2 = bf2f((unsigned short)x2[i]);
                ov[i] = (unsigned short)f2bf(hi ? (f1 * s + f2 * c) : (f1 * c - f2 * s)); }
            qr[d0] = (bf16x8){(short)ov[0], (short)ov[1], (short)ov[2], (short)ov[3], (short)ov[4], (short)ov[5], (short)ov[6], (short)ov[7]};
        } else qr[d0] = hi ? x2 : x1;
    }
    f32x16 o[2] = {}; float l_reg;
    const float scale = 0.10206207261596575f;
    attn_core<96, 64, 256>(qr, KV + (size_t)krow0 * 1024 + h * 128, 1024, KR + (size_t)krow0 * 32, 32, KV + (size_t)krow0 * 1024 + h * 128 + 64, 1024,
                           NT, scale * 1.4426950408889634f, 8.f / scale, lds, o, l_reg, tid);
    float* li_l = (float*)(lds + 2 * 64 * 64 * 2 + 2 * 64 * 256) + wid * 64;
    if (hi == 0) li_l[r32] = l_reg; asm volatile("s_waitcnt lgkmcnt(0)" ::: "memory");
#pragma unroll
    for (int r = 0; r < 16; ++r) { const int orow = crow(r, hi); const float rl = __builtin_amdgcn_rcpf(li_l[orow]);
        bf16* op = MIX + (size_t)(row0 + wid * 32 + orow) * 1024 + 512 + h * 64 + r32;
        op[0] = (bf16)f2bf(o[0][r] * rl); op[32] = (bf16)f2bf(o[1][r] * rl); }
}
__device__ __forceinline__ void diff_item(KArgP a, int layer, int b, int h, int qb, char* lds) {
    const int tid = ptid(), wid = tid >> 6, lane = tid & 63, r32 = lane & 31, hi = lane >> 5;
    const bf16* P = (const bf16*)(a->ws + WS_P); bf16* MIX = (bf16*)(a->ws + WS_MIX);
    float* DS = (float*)a->out + (size_t)blockIdx.x * 80 * 512;
    const int row0 = b * TPB + qb * 256, krow0 = b * TPB, NT = qb ? 36 : 4, o_ = layer >> 1;
    const int row = row0 + wid * 32 + r32;
    const float* lp = a->in[20] + o_ * 256;
    const float lam_init = 0.8f - 0.6f * __expf(-0.3f * (float)layer);
    const float lam = __expf(wave_sum(lp[lane] * lp[64 + lane])) - __expf(wave_sum(lp[128 + lane] * lp[192 + lane])) + lam_init;
    const float scale = 0.125f;
    float* li_l = (float*)(lds + 2 * 64 * 64 * 2 + 2 * 64 * 128) + wid * 64;
#pragma unroll 1
    for (int pp = 0; pp < 4; ++pp) {
        const int m = pp >> 1, vh = pp & 1;
        const bf16* Qw = P + (size_t)row * NP_O + 1536 + h * 128 + m * 64;
        bf16x8 qr[4];
#pragma unroll
        for (int d0 = 0; d0 < 4; ++d0) qr[d0] = *(const bf16x8*)(Qw + d0 * 16 + hi * 8);
        f32x16 o[2] = {};
        float l_reg;
        const bf16* Kp = P + (size_t)krow0 * NP_O + 2048 + h * 128 + m * 64;
        attn_core<64, 64, 128>(qr, Kp, NP_O, Kp, NP_O, P + (size_t)krow0 * NP_O + 2560 + h * 128 + vh * 64, NP_O,
                               NT, scale * 1.4426950408889634f, 8.f / scale, lds, o, l_reg, tid);
        if (hi == 0) li_l[r32] = l_reg; asm volatile("s_waitcnt lgkmcnt(0)" ::: "memory");
        float* dsb = DS + tid; asm volatile("" : "+v"(dsb));
        if (m == 0) {
#pragma unroll
            for (int r = 0; r < 16; ++r) { const float rl = __builtin_amdgcn_rcpf(li_l[crow(r, hi)]);
#pragma unroll
                for (int d = 0; d < 2; ++d) dsb[(size_t)(vh * 32 + d * 16 + r) * 512] = o[d][r] * rl; }
        } else {
#pragma unroll
            for (int r = 0; r < 16; ++r) { const float rl = __builtin_amdgcn_rcpf(li_l[crow(r, hi)]); float s = 0.f;
#pragma unroll
                for (int d = 0; d < 2; ++d) { const float v = dsb[(size_t)(vh * 32 + d * 16 + r) * 512] - lam * (o[d][r] * rl); o[d][r] = v; s += v * v; }
                s += __shfl_xor(s, 16); s += __shfl_xor(s, 8); s += __shfl_xor(s, 4); s += __shfl_xor(s, 2); s += __shfl_xor(s, 1);
                if (vh == 0) { dsb[(size_t)(64 + r) * 512] = s; dsb[(size_t)(0 * 16 + r) * 512] = o[0][r]; dsb[(size_t)(1 * 16 + r) * 512] = o[1][r]; }
                else {
                    const float rs = __builtin_amdgcn_rsqf((s + dsb[(size_t)(64 + r) * 512]) * (1.f / 128.f) + EPSN) * (1.f - lam_init);
                    const float* sg = a->in[21] + o_ * 128;
                    bf16* op = MIX + (size_t)(row0 + wid * 32 + crow(r, hi)) * 1024 + 512 + h * 128 + r32;
                    op[0]  = (bf16)f2bf(dsb[(size_t)(0 * 16 + r) * 512] * rs * sg[r32]);
                    op[32] = (bf16)f2bf(dsb[(size_t)(1 * 16 + r) * 512] * rs * sg[32 + r32]);
                    op[64] = (bf16)f2bf(o[0][r] * rs * sg[64 + r32]);
                    op[96] = (bf16)f2bf(o[1][r] * rs * sg[96 + r32]); }
            }
        }
        asm volatile("s_waitcnt vmcnt(0) lgkmcnt(0)" ::: "memory");
    }
}

__device__ __forceinline__ void phase_mixer(KArgP a, int layer, unsigned char* ldsg) {
    LAS unsigned char* lds = (LAS unsigned char*)ldsg;
    volatile LAS unsigned* flag = (volatile LAS unsigned*)(lds + LDS_MAIN);
    unsigned* ctr = (unsigned*)(a->ws + WS_CTL) + layer;
    const bool even = !(layer & 1), need_ctx = layer < 3;
    const int n_lat = even ? 512 : 256, n_ctx = need_ctx ? (even ? 64 : 32) : 0, total = 64 + n_lat + n_ctx;
    for (;;) {
        __syncthreads();
        if (ptid() == 0) *flag = atomicAdd(ctr, 1u);
        __syncthreads();
        const int item = (int)*flag;
        if (item >= total) break;
#ifndef SKIP_SCAN
        if (item < 64) { if (even) scan_item<128, true>(a, layer, item, lds); else scan_item<64, false>(a, layer, item, lds); }
#else
        if (item < 64) {}
#endif
        else { int b_, h_, qb_;
            if (item < 64 + n_lat) { const int i = item - 64; qb_ = 1 + (i & 7); if (even) { b_ = i >> 6; h_ = (i >> 3) & 7; } else { b_ = i >> 5; h_ = (i >> 3) & 3; } }
            else { const int i = item - 64 - n_lat; qb_ = 0; if (even) { b_ = i >> 3; h_ = i & 7; } else { b_ = i >> 2; h_ = i & 3; } }
#ifndef SKIP_ATTN
            if (even) mla_item(a, b_, h_, qb_, (char*)ldsg); else diff_item(a, layer, b_, h_, qb_, (char*)ldsg);
#endif
        }
    }
}

__global__ void __launch_bounds__(512, 2) mega_fwd(Args a_) {
    extern __shared__ __attribute__((aligned(16))) unsigned char lds_raw[];
    LAS unsigned char* lds = (LAS unsigned char*)lds_raw;
    ((LAS int*)(lds + LDS_MAIN + 1024))[threadIdx.x] = (int)threadIdx.x;
    __syncthreads();
    cg::grid_group grid = cg::this_grid();
    int ph = 0;
    const int plo = a_.lo, phi = a_.hi;
#define PH_BEGIN if (ph >= plo && ph < phi) { KArgP a = kargs(); int bx = (int)blockIdx.x, G = (int)gridDim.x; asm volatile("" : "+s"(bx), "+s"(G)); (void)bx; (void)G;
#define PH_END   if (ph + 1 < phi) grid.sync(); } ++ph;

    PH_BEGIN phase_prep(a, lds); PH_END

    for (int layer = 0; layer < 4; ++layer) {
        const bool even = !(layer & 1);
        const int np = even ? NP_E : NP_O;
        PH_BEGIN phase_norm(a, layer, 0); convert_weights(a, layer, lds); PH_END
#ifndef SKIP_G1
        PH_BEGIN { bf16* H = (bf16*)(a->ws + WS_H); bf16* MIX = (bf16*)(a->ws + WS_MIX); bf16* P = (bf16*)(a->ws + WS_P); float* X = (float*)(a->ws + WS_X); unsigned char* Wb = a->ws + WS_W; const float* mod = (const float*)(a->ws + WS_MOD) + (size_t)layer * 9 * 6144; (void)H; (void)MIX; (void)P; (void)X; (void)mod; pg8::Gemm g{H, (const bf16*)(Wb + W_IN), MT, np, 1024}; pg8::StaticOrder S; S.init(MT, np, G, bx);
                   pg8::EpiBf16<0> E{P, np, nullptr, 0, 0, 1.f};
                   pg8::gemm_phase<pg8::EpiBf16<0>, pg8::StaticOrder, true, true>(lds, g, S, E); } PH_END
#else
        ++ph;
#endif
        PH_BEGIN if (even) phase_post_even(a, layer); else phase_post_odd(a, layer); PH_END
#ifndef SKIP_G3
        if (even) {
            PH_BEGIN { bf16* H = (bf16*)(a->ws + WS_H); bf16* MIX = (bf16*)(a->ws + WS_MIX); bf16* P = (bf16*)(a->ws + WS_P); float* X = (float*)(a->ws + WS_X); unsigned char* Wb = a->ws + WS_W; const float* mod = (const float*)(a->ws + WS_MOD) + (size_t)layer * 9 * 6144; (void)H; (void)MIX; (void)P; (void)X; (void)mod; pg8::Gemm g{(const bf16*)(a->ws + WS_CQN), (const bf16*)(Wb + W_UQ), MT, 768, 384}; pg8::StaticOrder S; S.init(MT, 768, G, bx);
                       pg8::EpiBf16<0> E{(bf16*)((unsigned char*)a->out + OUT_Q), 768, nullptr, 0, 0, 1.f};
                       pg8::gemm_phase<pg8::EpiBf16<0>, pg8::StaticOrder, true, true>(lds, g, S, E); }
                     { unsigned char* Wb = a->ws + WS_W; pg8::Gemm g{(const bf16*)(a->ws + WS_CKVN), (const bf16*)(Wb + W_UKV), MT, 1024, 256}; pg8::StaticOrder S; S.init(MT, 1024, G, bx);
                       pg8::EpiBf16<0> E{(bf16*)((unsigned char*)a->out + OUT_KV), 1024, nullptr, 0, 0, 1.f};
                       pg8::gemm_phase<pg8::EpiBf16<0>, pg8::StaticOrder, true, true>(lds, g, S, E); } PH_END
        } else { ++ph; }
#else
        ++ph;
#endif
        PH_BEGIN phase_mixer(a, layer, lds_raw); PH_END
        PH_BEGIN phase_readout(a, layer); PH_END
#ifndef SKIP_G6
        PH_BEGIN { bf16* H = (bf16*)(a->ws + WS_H); bf16* MIX = (bf16*)(a->ws + WS_MIX); bf16* P = (bf16*)(a->ws + WS_P); float* X = (float*)(a->ws + WS_X); unsigned char* Wb = a->ws + WS_W; const float* mod = (const float*)(a->ws + WS_MOD) + (size_t)layer * 9 * 6144; (void)H; (void)MIX; (void)P; (void)X; (void)mod; pg8::Gemm g{MIX, (const bf16*)(Wb + W_OUT), MT, 1024, 1024}; pg8::StaticOrder S; S.init(MT, 1024, G, bx);
                   pg8::EpiResid E{X, mod, 2048};
                   pg8::gemm_phase<pg8::EpiResid, pg8::StaticOrder, true, true>(lds, g, S, E); } PH_END
#else
        ++ph;
#endif
        PH_BEGIN phase_norm(a, layer, 1); PH_END
#ifndef SKIP_G8
        PH_BEGIN { bf16* H = (bf16*)(a->ws + WS_H); bf16* MIX = (bf16*)(a->ws + WS_MIX); bf16* P = (bf16*)(a->ws + WS_P); float* X = (float*)(a->ws + WS_X); unsigned char* Wb = a->ws + WS_W; const float* mod = (const float*)(a->ws + WS_MOD) + (size_t)layer * 9 * 6144; (void)H; (void)MIX; (void)P; (void)X; (void)mod; pg8::Gemm g{H, (const bf16*)(Wb + W_GU), MT, 2 * FF, 1024}; pg8::StaticOrder S; S.init(MT, 2 * FF, G, bx);
                   pg8::EpiSwiGLU E{P, FF};
                   pg8::gemm_phase<pg8::EpiSwiGLU, pg8::StaticOrder, true, true>(lds, g, S, E); } PH_END
#else
        ++ph;
#endif
#ifndef SKIP_G9
        PH_BEGIN { bf16* H = (bf16*)(a->ws + WS_H); bf16* MIX = (bf16*)(a->ws + WS_MIX); bf16* P = (bf16*)(a->ws + WS_P); float* X = (float*)(a->ws + WS_X); unsigned char* Wb = a->ws + WS_W; const float* mod = (const float*)(a->ws + WS_MOD) + (size_t)layer * 9 * 6144; (void)H; (void)MIX; (void)P; (void)X; (void)mod; pg8::Gemm g{P, (const bf16*)(Wb + W_DN), MT, 1024, FF}; pg8::StaticOrder S; S.init(MT, 1024, G, bx);
                   pg8::EpiResid E{X, mod, 5120};
                   pg8::gemm_phase<pg8::EpiResid, pg8::StaticOrder, true, true>(lds, g, S, E); } PH_END
#else
        ++ph;
#endif
    }
    PH_BEGIN phase_final(a); PH_END
#undef PH_BEGIN
#undef PH_END
}
constexpr int NPH = 1 + 4 * 10 + 1;

extern "C" void kernel_launch(void* const* d_in, const int* in_sizes, int n_in, void* d_out, int out_size, void* d_ws, size_t ws_size, hipStream_t stream) {
    static int grid = 0;
    if (grid == 0) {
        if (n_in != 23 || ws_size < WS_END || out_size != NB * NLAT * DM) { fprintf(stderr, "kernel_launch: unexpected shapes: n_in %d ws %zu (need %zu) out %d\n", n_in, ws_size, (size_t)WS_END, out_size); grid = -1; return; }
        int dev = 0, cus = 0, per_cu = 0;
        hipGetDevice(&dev); hipDeviceGetAttribute(&cus, hipDeviceAttributeMultiprocessorCount, dev);
        if (hipFuncSetAttribute((const void*)mega_fwd, hipFuncAttributeMaxDynamicSharedMemorySize, LDS_BYTES) != hipSuccess) { fprintf(stderr, "kernel_launch: hipFuncSetAttribute failed\n"); grid = -1; return; }
        if (hipOccupancyMaxActiveBlocksPerMultiprocessor(&per_cu, (const void*)mega_fwd, 512, LDS_BYTES) != hipSuccess || per_cu < 1) { fprintf(stderr, "kernel_launch: occupancy query says %d\n", per_cu); per_cu = 1; }
        (void)hipGetLastError();
        grid = cus;
    }
    if (grid < 0) return;
    Args a{};
    for (int i = 0; i < 23; ++i) a.in[i] = (const float*)d_in[i];
    a.out = (float*)d_out; a.ws = (unsigned char*)d_ws; a.lo = 0; a.hi = NPH;
    void* kargv[] = {&a};
    hipError_t e = hipLaunchCooperativeKernel((const void*)mega_fwd, dim3(grid), dim3(512), kargv, LDS_BYTES, stream);
    if (e != hipSuccess) fprintf(stderr, "kernel_launch: cooperative launch failed: %s (grid %d)\n", hipGetErrorString(e), grid);
}
```

```cpp
#include <hip/hip_runtime.h>
#include <hip/hip_cooperative_groups.h>
#include <cstdio>
#include <cstdint>
namespace cg = cooperative_groups;
#define otid() ({ int t_ = (int)threadIdx.x; asm volatile("" : "+v"(t_)); t_; })
extern __shared__ __attribute__((aligned(16))) unsigned char g_lds_dyn[];
#define ptid() (*(volatile __attribute__((address_space(3))) int*)((__attribute__((address_space(3))) unsigned char*)g_lds_dyn + 131072 + 1024 + 4 * (int)threadIdx.x))
namespace pg8 {
#define PG8_LAS __attribute__((address_space(3)))
typedef unsigned short bf16_t;
typedef short bf16x8 __attribute__((ext_vector_type(8)));
typedef float f32x4 __attribute__((ext_vector_type(4)));
typedef unsigned u32x4 __attribute__((ext_vector_type(4)));
constexpr int BM = 256, BK = 64, HALF = 128, HTB = HALF * BK * 2  , STAGE_BYTES = 8 * HTB, NXCD = 8, WGM = 8;

__host__ __device__ __forceinline__ int lds_byte(int r, int c) { const int st = (r >> 4) * 2 + (c >> 5), rr = r & 15, cc = c & 31, ob = rr * 64 + cc * 2; return st * 1024 + (ob ^ (((ob >> 9) & 1) << 5)); }
__host__ __device__ __forceinline__ void stage_rc(int b, int& R, int& C) { const int st = b / 1024, sb = b % 1024, swz = sb ^ (((sb >> 9) & 1) << 5); R = (st >> 1) * 16 + swz / 64; C = (st & 1) * 32 + (swz % 64) / 2; }
__host__ __device__ __forceinline__ int perm32(int rho) { const int n = rho >> 4, i = rho & 15; return 8 * (i >> 2) + 4 * n + (i & 3); }

struct Unit { int pm, pn; };
struct Gemm { const bf16_t* A; const bf16_t* Bt; int M, N, K; };

struct StaticOrder {
    int nM, nN, nwg, G, c;
    __host__ __device__ void init(int M, int N, int G_, int c_) { nM = M / BM; nN = N / BM; nwg = nM * nN; G = G_; c = c_; }
    __host__ __device__ bool next(int i, Unit& u) const {
        const long L = (long)i * G + c; if (L >= nwg) return false;
        int wgid = (int)L; { const int q = nwg / NXCD, r = nwg % NXCD, xcd = wgid % NXCD, off = wgid / NXCD; wgid = (xcd < r ? xcd * (q + 1) : r * (q + 1) + (xcd - r) * q) + off; }
        const int nig = WGM * nN, gid = wgid / nig, fm = gid * WGM, gsz = (nM - fm) < WGM ? (nM - fm) : WGM;
        u.pm = fm + ((wgid % nig) % gsz); u.pn = (wgid % nig) / gsz; return true;
    }
    __device__ __forceinline__ void a_ready(const Unit&) const {}
    __device__ __forceinline__ void done(const Unit&) const {}
};

__device__ __forceinline__ unsigned cvt_pk_bf16(float lo, float hi) { unsigned r; asm volatile("v_cvt_pk_bf16_f32 %0, %1, %2" : "=v"(r) : "v"(lo), "v"(hi)); return r; }
typedef float f32x2 __attribute__((ext_vector_type(2)));
__device__ __forceinline__ f32x2 gelu_pk(f32x2 v) {
    const f32x2 av = __builtin_elementwise_abs(v), d = av * 0.2316418882f + 1.0f;
    f32x2 t; t.x = __builtin_amdgcn_rcpf(d.x); t.y = __builtin_amdgcn_rcpf(d.y);
    f32x2 q = t * 0.5307027145f + (-0.7265760135f); q = q * t + 0.7107068705f; q = q * t + (-0.142248368f); q = q * t + 0.127414796f; q = q * t;
    const f32x2 s = (v * v) * (-0.72134752044f);
    f32x2 e; e.x = __builtin_amdgcn_exp2f(s.x); e.y = __builtin_amdgcn_exp2f(s.y);
    const f32x2 m = v * (q * e), r = v - m;
    f32x2 o; o.x = v.x < 0.f ? m.x : r.x; o.y = v.y < 0.f ? m.y : r.y; return o;
}

template <int ACT  > struct EpiBf16 {
    static constexpr bool PERM = true, AFTER_DRAIN = false; static_assert(ACT == 0 || ACT == 1, "EpiBf16: ACT is 0 (none) or 1 (gelu_pk)");
    bf16_t* O; int ldc; const float* bias; int split_cols; size_t split_stride; float scale0;
    __device__ __forceinline__ void operator()(const f32x4 (&acc)[2][2][4][2], const Unit& u, int wr, int wc, int fr, int fq) const {
        const int row0 = u.pm * BM + wr * 64 + fr; int colt = u.pn * BM; bf16_t* base = O;
        float sc = 1.f; if (split_cols) { const int t = colt / split_cols; base += (size_t)t * split_stride; colt -= t * split_cols; if (t == 0) sc = scale0; }
        const int col0 = colt + wc * 32 + 8 * fq, bcol0 = u.pn * BM + wc * 32 + 8 * fq;
        f32x4 bv[2][2];
#pragma unroll
        for (int bj = 0; bj < 2; ++bj)
#pragma unroll
            for (int n = 0; n < 2; ++n) bv[bj][n] = bias ? *(const f32x4*)(bias + bcol0 + bj * HALF + 4 * n) : (f32x4){0.f, 0.f, 0.f, 0.f};
#pragma unroll
        for (int ai = 0; ai < 2; ++ai)
#pragma unroll
            for (int m = 0; m < 4; ++m) { bf16_t* rowp = base + (size_t)(row0 + ai * HALF + m * 16) * ldc + col0;
#pragma unroll
                for (int bj = 0; bj < 2; ++bj) { f32x4 v0 = acc[ai][bj][m][0] + bv[bj][0], v1 = acc[ai][bj][m][1] + bv[bj][1];
                    if (ACT == 1) { f32x2 a = gelu_pk((f32x2){v0[0], v0[1]}), b = gelu_pk((f32x2){v0[2], v0[3]}), c = gelu_pk((f32x2){v1[0], v1[1]}), d = gelu_pk((f32x2){v1[2], v1[3]});
                        v0 = (f32x4){a.x, a.y, b.x, b.y}; v1 = (f32x4){c.x, c.y, d.x, d.y}; }
                    v0 = v0 * sc; v1 = v1 * sc; u32x4 w; w.x = cvt_pk_bf16(v0[0], v0[1]); w.y = cvt_pk_bf16(v0[2], v0[3]); w.z = cvt_pk_bf16(v1[0], v1[1]); w.w = cvt_pk_bf16(v1[2], v1[3]);
                    *(u32x4*)(rowp + bj * HALF) = w; } }
    }
};
struct EpiSwiGLU {
    static constexpr bool PERM = true, AFTER_DRAIN = false;
    bf16_t* O; int ldc;
    __device__ __forceinline__ void operator()(const f32x4 (&acc)[2][2][4][2], const Unit& u, int wr, int wc, int fr, int fq) const {
        const int row0 = u.pm * BM + wr * 64 + fr; const int col0 = u.pn * HALF + wc * 32 + 8 * fq;
#pragma unroll
        for (int ai = 0; ai < 2; ++ai)
#pragma unroll
            for (int m = 0; m < 4; ++m) { bf16_t* rowp = O + (size_t)(row0 + ai * HALF + m * 16) * ldc + col0;
                float h[8];
#pragma unroll
                for (int n = 0; n < 2; ++n)
#pragma unroll
                    for (int i = 0; i < 4; ++i) { const float g = acc[ai][0][m][n][i], up = acc[ai][1][m][n][i];
                        h[n * 4 + i] = g * __builtin_amdgcn_rcpf(1.0f + __expf(-g)) * up; }
                u32x4 w; w.x = cvt_pk_bf16(h[0], h[1]); w.y = cvt_pk_bf16(h[2], h[3]); w.z = cvt_pk_bf16(h[4], h[5]); w.w = cvt_pk_bf16(h[6], h[7]);
                *(u32x4*)rowp = w; }
    }
};
struct EpiResid {
    static constexpr bool PERM = false, AFTER_DRAIN = false;
    float* X; const float* mod; int goff;
    __device__ __forceinline__ void operator()(const f32x4 (&acc)[2][2][4][2], const Unit& u, int wr, int wc, int fr, int fq) const {
        const int widx = (u.pm % 9 == 0) ? 8 : (u.pm / 9);
        const float* gp = mod + widx * 6144 + goff;
        const int col0 = u.pn * BM + wc * 32 + 4 * fq;
#pragma unroll
        for (int bj = 0; bj < 2; ++bj)
#pragma unroll
            for (int n = 0; n < 2; ++n) { const f32x4 gv = *(const f32x4*)(gp + col0 + bj * HALF + n * 16);
#pragma unroll
                for (int ai = 0; ai < 2; ++ai)
#pragma unroll
                    for (int m = 0; m < 4; ++m) { float* p = X + (size_t)(u.pm * BM + ai * HALF + wr * 64 + m * 16 + fr) * 1024 + col0 + bj * HALF + n * 16;
                        f32x4 x = *(const f32x4*)p; x = x + gv * acc[ai][bj][m][n]; *(f32x4*)p = x; } }
    }
};
template <class Epi, class Sched, bool ALIGN_EPI = false, bool SP2 = false>
__device__ __forceinline__ void gemm_phase(PG8_LAS unsigned char* lds, const Gemm g, const Sched& S, const Epi& E) {
    const int tid = otid(), wid = __builtin_amdgcn_readfirstlane(tid >> 6), lane = tid & 63, wr = wid >> 2, wc = wid & 3, fr = lane & 15, fq = lane >> 4;
    const int K = g.K, nt = K / BK;
    unsigned voffA[2], voffB[2];
#pragma unroll
    for (int i = 0; i < 2; ++i) { int R, C; stage_rc(tid * 16 + i * 8192, R, C); const int Rb = Epi::PERM ? ((R & ~31) + perm32(R & 31)) : R;
        voffA[i] = (unsigned)(R * K + C) * 2u; voffB[i] = (unsigned)(Rb * K + C) * 2u; }
    const size_t kstep = (size_t)(BK * 2);
    const size_t hstep = (size_t)HALF * K * 2;
    const size_t tstep = 2 * hstep;
    const unsigned ldsw = (unsigned)wid * 1024u;
    const int aoff = lds_byte(wr * 64 + fr, fq * 8), boff = lds_byte(wc * 32 + fr, fq * 8);
#define PG8_SA(b, h) (((b) * 2 + (h)) * HTB)
#define PG8_SB(b, h) ((4 + (b) * 2 + (h)) * HTB)
#define PG8_STAGE(bufoff, gbase, voff) do { _Pragma("unroll") for (int _i = 0; _i < 2; ++_i) \
        __builtin_amdgcn_global_load_lds((const unsigned*)((const char*)(gbase) + (voff)[_i]), (PG8_LAS unsigned*)(lds + (bufoff) + ldsw + _i * 8192), 16, 0, 0); } while (0)
#define PG8_LDA(dst, b, h) do { _Pragma("unroll") for (int m = 0; m < 4; ++m) _Pragma("unroll") for (int k = 0; k < 2; ++k) dst[m][k] = *(const PG8_LAS bf16x8*)(lds + PG8_SA(b, h) + aoff + m * 2048 + k * 1024); } while (0)
#define PG8_LDB(dst, b, h) do { _Pragma("unroll") for (int n = 0; n < 2; ++n) _Pragma("unroll") for (int k = 0; k < 2; ++k) dst[n][k] = *(const PG8_LAS bf16x8*)(lds + PG8_SB(b, h) + boff + n * 2048 + k * 1024); } while (0)
#define PG8_MMA(ai, bj, At, Bt) do { __builtin_amdgcn_s_setprio(1); _Pragma("unroll") for (int m = 0; m < 4; ++m) _Pragma("unroll") for (int n = 0; n < 2; ++n) _Pragma("unroll") for (int k = 0; k < 2; ++k) \
        acc[ai][bj][m][n] = __builtin_amdgcn_mfma_f32_16x16x32_bf16(Bt[n][k], At[m][k], acc[ai][bj][m][n], 0, 0, 0); __builtin_amdgcn_s_setprio(0); } while (0)
#define PG8_WAIT_V(n) asm volatile("s_waitcnt vmcnt(" #n ")" ::: "memory")
#define PG8_WAIT_L(n) asm volatile("s_waitcnt lgkmcnt(" #n ")" ::: "memory")
#define PG8_BAR __builtin_amdgcn_s_barrier()
#define PG8_SCHED __builtin_amdgcn_sched_barrier(0)
    Unit cur, nxt; int ui = 0;
    if (!S.next(0, cur)) return;
    f32x4 acc[2][2][4][2];
#pragma unroll
    for (int a = 0; a < 2; ++a)
#pragma unroll
        for (int b = 0; b < 2; ++b)
#pragma unroll
            for (int m = 0; m < 4; ++m)
#pragma unroll
                for (int n = 0; n < 2; ++n) acc[a][b][m][n] = (f32x4){0.f, 0.f, 0.f, 0.f};
    bf16x8 At[4][2], B0[2][2], B1[2][2];
    const char* cA = (const char*)g.A + (size_t)cur.pm * tstep; const char* cB = (const char*)g.Bt + (size_t)cur.pn * tstep;
    S.a_ready(cur);
    if constexpr (SP2) {
        PG8_STAGE(PG8_SB(0, 0), cB, voffB); PG8_STAGE(PG8_SB(0, 1), cB + hstep, voffB); PG8_STAGE(PG8_SA(0, 0), cA, voffA); PG8_STAGE(PG8_SA(0, 1), cA + hstep, voffA);
        if (wr == 1) PG8_BAR;
        PG8_WAIT_V(2); PG8_BAR;
        PG8_STAGE(PG8_SB(1, 0), cB + kstep, voffB); PG8_STAGE(PG8_SA(1, 0), cA + kstep, voffA); PG8_STAGE(PG8_SB(1, 1), cB + hstep + kstep, voffB);
        PG8_WAIT_V(6); PG8_BAR;
    } else {
        PG8_STAGE(PG8_SB(0, 0), cB, voffB); PG8_STAGE(PG8_SA(0, 0), cA, voffA); PG8_STAGE(PG8_SB(0, 1), cB + hstep, voffB); PG8_STAGE(PG8_SA(0, 1), cA + hstep, voffA);
        if (wr == 1) PG8_BAR;
        PG8_WAIT_V(4); PG8_BAR;
        PG8_STAGE(PG8_SB(1, 0), cB + kstep, voffB); PG8_STAGE(PG8_SA(1, 0), cA + kstep, voffA); PG8_STAGE(PG8_SB(1, 1), cB + hstep + kstep, voffB);
        PG8_WAIT_V(6); PG8_BAR;
    }
    for (;;) {
        const bool has_next = S.next(ui + 1, nxt);
        const char* nA = has_next ? (const char*)g.A + (size_t)nxt.pm * tstep : cA; const char* nB = has_next ? (const char*)g.Bt + (size_t)nxt.pn * tstep : cB;
        for (int t = 0; t < nt; t += 2) {
            const bool last = (t == nt - 2);
            const char* a1 = cA + (size_t)(t + 1) * kstep;
            const char* a2 = last ? nA : cA + (size_t)(t + 2) * kstep; const char* b2 = last ? nB : cB + (size_t)(t + 2) * kstep;
            const char* a3 = a2 + kstep; const char* b3 = b2 + kstep;
            if (last && has_next) S.a_ready(nxt);
            if constexpr (SP2) {
            PG8_LDB(B0, 0, 0); PG8_LDB(B1, 0, 1); PG8_SCHED; PG8_LDA(At, 0, 0); PG8_STAGE(PG8_SA(1, 1), a1 + hstep, voffA);
            PG8_WAIT_V(8); PG8_WAIT_L(0); PG8_BAR; PG8_MMA(0, 0, At, B0); PG8_MMA(0, 1, At, B1); PG8_BAR; PG8_SCHED;
            PG8_LDA(At, 0, 1); PG8_STAGE(PG8_SB(0, 0), b2, voffB); PG8_STAGE(PG8_SB(0, 1), b2 + hstep, voffB); PG8_STAGE(PG8_SA(0, 0), a2, voffA);
            PG8_WAIT_V(8); PG8_WAIT_L(0); PG8_BAR; PG8_MMA(1, 0, At, B0); PG8_MMA(1, 1, At, B1); PG8_BAR; PG8_SCHED;
            PG8_LDB(B0, 1, 0); PG8_LDB(B1, 1, 1); PG8_SCHED; PG8_LDA(At, 1, 0); PG8_STAGE(PG8_SA(0, 1), a2 + hstep, voffA);
            PG8_WAIT_V(8); PG8_WAIT_L(0); PG8_BAR; PG8_MMA(0, 0, At, B0); PG8_MMA(0, 1, At, B1); PG8_BAR; PG8_SCHED;
            PG8_LDA(At, 1, 1); PG8_STAGE(PG8_SB(1, 0), b3, voffB); PG8_STAGE(PG8_SB(1, 1), b3 + hstep, voffB); PG8_STAGE(PG8_SA(1, 0), a3, voffA);
            PG8_WAIT_V(8); PG8_WAIT_L(0); PG8_BAR; PG8_MMA(1, 0, At, B0); PG8_MMA(1, 1, At, B1); PG8_BAR; PG8_SCHED;
            } else {
            PG8_LDB(B0, 0, 0); PG8_SCHED; PG8_LDA(At, 0, 0); PG8_STAGE(PG8_SA(1, 1), a1 + hstep, voffA);
            PG8_WAIT_L(8); PG8_BAR; PG8_WAIT_L(0); PG8_MMA(0, 0, At, B0); PG8_BAR; PG8_SCHED;
            PG8_LDB(B1, 0, 1); PG8_STAGE(PG8_SB(0, 0), b2, voffB);
            PG8_BAR; PG8_WAIT_L(0); PG8_MMA(0, 1, At, B1); PG8_BAR;
            PG8_LDA(At, 0, 1); PG8_STAGE(PG8_SA(0, 0), a2, voffA);
            PG8_BAR; PG8_WAIT_L(0); PG8_MMA(1, 0, At, B0); PG8_BAR; PG8_SCHED;
            PG8_STAGE(PG8_SB(0, 1), b2 + hstep, voffB);
            PG8_WAIT_V(6); PG8_BAR; PG8_MMA(1, 1, At, B1); PG8_BAR;
            PG8_LDB(B0, 1, 0); PG8_SCHED; PG8_LDA(At, 1, 0); PG8_STAGE(PG8_SA(0, 1), a2 + hstep, voffA);
            PG8_WAIT_L(8); PG8_BAR; PG8_WAIT_L(0); PG8_MMA(0, 0, At, B0); PG8_BAR; PG8_SCHED;
            PG8_LDB(B1, 1, 1); PG8_STAGE(PG8_SB(1, 0), b3, voffB);
            PG8_BAR; PG8_WAIT_L(0); PG8_MMA(0, 1, At, B1); PG8_BAR;
            PG8_LDA(At, 1, 1); PG8_STAGE(PG8_SA(1, 0), a3, voffA);
            PG8_BAR; PG8_WAIT_L(0); PG8_MMA(1, 0, At, B0); PG8_BAR; PG8_SCHED;
            PG8_STAGE(PG8_SB(1, 1), b3 + hstep, voffB);
            PG8_WAIT_V(6); PG8_BAR; PG8_MMA(1, 1, At, B1); PG8_BAR;
            }
        }
        if constexpr (ALIGN_EPI) { if (wr == 0) PG8_BAR; }
        if constexpr (!Epi::AFTER_DRAIN) { E(acc, cur, wr, wc, fr, fq); S.done(cur); }
        if (!has_next) break;
#pragma unroll
        for (int a = 0; a < 2; ++a)
#pragma unroll
            for (int b = 0; b < 2; ++b)
#pragma unroll
                for (int m = 0; m < 4; ++m)
#pragma unroll
                    for (int n = 0; n < 2; ++n) acc[a][b][m][n] = (f32x4){0.f, 0.f, 0.f, 0.f};
        cur = nxt; cA = nA; cB = nB; ++ui;
        if constexpr (ALIGN_EPI) { if (wr == 1) PG8_BAR; }
    }
    PG8_WAIT_V(0);
    if constexpr (!ALIGN_EPI) { if (wr == 0) PG8_BAR; }
    PG8_BAR;
    if constexpr (Epi::AFTER_DRAIN) { E.fused(acc, cur, wr, wc, fr, fq, lds, wid, lane); S.done(cur); }
#undef PG8_SA
#undef PG8_SB
#undef PG8_STAGE
#undef PG8_LDA
#undef PG8_LDB
#undef PG8_MMA
#undef PG8_WAIT_V
#undef PG8_WAIT_L
#undef PG8_BAR
#undef PG8_SCHED
}
}

typedef unsigned short bf16;
typedef short bf16x8 __attribute__((ext_vector_type(8)));
typedef short s16x4 __attribute__((ext_vector_type(4)));
typedef float f32x4 __attribute__((ext_vector_type(4)));
typedef float f32x16 __attribute__((ext_vector_type(16)));
typedef unsigned u32x4 __attribute__((ext_vector_type(4)));
typedef unsigned u32x2 __attribute__((ext_vector_type(2)));
#define LAS __attribute__((address_space(3)))

constexpr int NB = 8, TPB = 2304, MT = NB * TPB, DM = 1024, NLAT = 2048;
constexpr int NP_E = 3328, NP_O = 3072, FF = 2816;
constexpr float EPSN = 1e-6f;
constexpr size_t MiB = 1u << 20;
constexpr size_t WS_CTL = 0, WS_MOD = 1 * MiB, WS_X = 2 * MiB, WS_H = 74 * MiB, WS_MIX = 110 * MiB, WS_P = 146 * MiB, WS_W = 263 * MiB,
                 WS_OSC = 290 * MiB, WS_KR = 326 * MiB, WS_END = 328 * MiB;
constexpr size_t WS_CQN = WS_MIX, WS_CKVN = WS_MIX + 14 * MiB, WS_DSCR = WS_H;
constexpr size_t W_IN = 0, W_OUT = 13 * MiB / 2, W_GU = 17 * MiB / 2, W_DN = 39 * MiB / 2, W_UQ = 25 * MiB, W_UKV = 25 * MiB + 768 * 1024;
constexpr size_t OUT_KV = 0, OUT_Q = 36 * MiB;
constexpr int LDS_MAIN = 131072, LDS_BYTES = LDS_MAIN + 1024 + 2048;

struct Args { const float* in[23]; float* out; unsigned char* ws; int lo, hi; };
typedef __attribute__((address_space(4))) const Args* KArgP;
__device__ __forceinline__ KArgP kargs() { KArgP p = (KArgP)__builtin_amdgcn_kernarg_segment_ptr(); asm volatile("" : "+s"(p)); return p; }

__device__ __forceinline__ float bf2f(unsigned short h) { return __uint_as_float((unsigned)h << 16); }
__device__ __forceinline__ unsigned f2bf(float f) { unsigned u = __float_as_uint(f); return (u + 0x7fffu + ((u >> 16) & 1u)) >> 16; }
__device__ __forceinline__ unsigned pk2(float lo, float hi) { return f2bf(lo) | (f2bf(hi) << 16); }
__device__ __forceinline__ float wave_sum(float v) {
#pragma unroll
    for (int o = 1; o < 64; o <<= 1) v += __shfl_xor(v, o);
    return v;
}
__device__ __forceinline__ float silu_f(float g) { return g / (1.0f + __expf(-g)); }
__device__ __forceinline__ void sincos_r(float ang, float& s, float& c) {
    float r = ang * 0.15915494309189535f; r = r - __builtin_floorf(r);
    s = __builtin_amdgcn_sinf(r); c = __builtin_amdgcn_cosf(r);
}
__device__ __forceinline__ float inv_freq(int i, int half) { return __builtin_amdgcn_exp2f(-(float)i / (float)half * 13.287712379549449f); }

__device__ __forceinline__ void phase_prep(KArgP a, LAS unsigned char* lds) {
    const int tid = otid(), G = gridDim.x;
    if (blockIdx.x == 0) { if (tid < 64) ((unsigned*)(a->ws + WS_CTL))[tid] = 0u; for (int i = tid; i < 3456; i += 512) ((unsigned*)(a->ws + WS_CTL))[4096 + i] = 0u; }
    float* MOD = (float*)(a->ws + WS_MOD);
    LAS float* S = (LAS float*)lds;
    LAS float* R = S + 1024 * 12;
    for (int item = blockIdx.x; item < 192; item += G) {
        const int l = item / 48, n0 = (item % 48) * 128;
        for (int i = tid; i < 9 * 1024; i += 512) { const int w = i >> 10, k = i & 1023; const float v = (w < 8) ? a->in[1][w * 1024 + k] : a->in[3][k]; S[k * 12 + w] = silu_f(v); }
        __syncthreads();
        const int nl = tid & 127, kp = tid >> 7;
        float acc[9];
#pragma unroll
        for (int w = 0; w < 9; ++w) acc[w] = 0.f;
        const float* wp = a->in[4] + (size_t)l * 1024 * 6144 + n0 + nl;
#pragma unroll 4
        for (int k = kp * 256; k < kp * 256 + 256; ++k) {
            const float wv = wp[(size_t)k * 6144];
            const f32x4 s0 = *(const LAS f32x4*)(S + k * 12), s1 = *(const LAS f32x4*)(S + k * 12 + 4); const float s8 = S[k * 12 + 8];
            acc[0] += wv * s0[0]; acc[1] += wv * s0[1]; acc[2] += wv * s0[2]; acc[3] += wv * s0[3];
            acc[4] += wv * s1[0]; acc[5] += wv * s1[1]; acc[6] += wv * s1[2]; acc[7] += wv * s1[3]; acc[8] += wv * s8;
        }
#pragma unroll
        for (int w = 0; w < 9; ++w) R[(kp * 9 + w) * 128 + nl] = acc[w];
        __syncthreads();
        for (int i = tid; i < 9 * 128; i += 512) { const int w = i >> 7, n2 = i & 127;
            const float v = R[(0 * 9 + w) * 128 + n2] + R[(1 * 9 + w) * 128 + n2] + R[(2 * 9 + w) * 128 + n2] + R[(3 * 9 + w) * 128 + n2] + a->in[5][l * 6144 + n0 + n2];
            MOD[(size_t)(l * 9 + w) * 6144 + n0 + n2] = v; }
        __syncthreads();
    }
    f32x4* X4 = (f32x4*)(a->ws + WS_X);
    const size_t total = (size_t)MT * 256, stride = (size_t)G * 512;
    for (size_t i = (size_t)blockIdx.x * 512 + tid; i < total; i += stride) {
        const int row = (int)(i >> 8), c4 = (int)(i & 255); const int b = row / TPB, j = row - b * TPB;
        const f32x4 v = (j < 256) ? ((const f32x4*)a->in[2])[(size_t)(b * 256 + j) * 256 + c4] : ((const f32x4*)a->in[0])[(size_t)(b * NLAT + (j - 256)) * 256 + c4];
        X4[i] = v;
    }
}

__device__ __forceinline__ void transpose_item(const float* W, int K, int N, bf16* WT, int k0, int n0, int drow0, LAS float* scr, int lane) {
#pragma unroll 8
    for (int i = 0; i < 32; ++i) { const int kk = 2 * i + (lane >> 5); scr[kk * 33 + (lane & 31)] = W[(size_t)(k0 + kk) * N + n0 + (lane & 31)]; }
    asm volatile("s_waitcnt lgkmcnt(0)" ::: "memory");
    const int c = lane & 7;
#pragma unroll
    for (int j = 0; j < 4; ++j) { const int n = (lane >> 3) + 8 * j; const LAS float* s = scr + (8 * c) * 33 + n;
        u32x4 o; o.x = pk2(s[0 * 33], s[1 * 33]); o.y = pk2(s[2 * 33], s[3 * 33]); o.z = pk2(s[4 * 33], s[5 * 33]); o.w = pk2(s[6 * 33], s[7 * 33]);
        *(u32x4*)(WT + (size_t)(drow0 + n) * K + k0 + 8 * c) = o; }
    asm volatile("s_waitcnt lgkmcnt(0)" ::: "memory");
}
__device__ __forceinline__ void convert_weights(KArgP a, int layer, LAS unsigned char* lds) {
    const int lane = otid() & 63, wave = otid() >> 6;
    LAS float* scr = (LAS float*)(lds + wave * 8448);
    const int gw = blockIdx.x * 8 + wave, NGW = gridDim.x * 8;
    const bool even = !(layer & 1); const int e = layer >> 1;
    const int nin = even ? 3232 : 3072;
    const float* w_in = even ? a->in[11] + (size_t)e * 1024 * 3232 : a->in[18] + (size_t)e * 1024 * 3072;
    unsigned char* Wb = a->ws + WS_W;
    const int nbin = nin / 32;
    const int I_IN = 16 * nbin, I_OUT = 512, I_G = 16 * 88, I_D = 44 * 32, I_UQ = even ? 6 * 24 : 0, I_UKV = even ? 4 * 32 : 0;
    const int NIT = I_IN + I_OUT + 2 * I_G + I_D + I_UQ + I_UKV;
    for (int it = gw; it < NIT; it += NGW) {
        int r = it;
        if (r < I_IN) { const int kb = r / nbin, nb = r % nbin; transpose_item(w_in, 1024, nin, (bf16*)(Wb + W_IN), 64 * kb, 32 * nb, 32 * nb, scr, lane); continue; } r -= I_IN;
        if (r < I_OUT) { const int kb = r / 32, nb = r % 32; transpose_item(a->in[7] + (size_t)layer * 1024 * 1024, 1024, 1024, (bf16*)(Wb + W_OUT), 64 * kb, 32 * nb, 32 * nb, scr, lane); continue; } r -= I_OUT;
        if (r < I_G) { const int kb = r / 88, nb = r % 88, n0 = 32 * nb; transpose_item(a->in[8] + (size_t)layer * 1024 * FF, 1024, FF, (bf16*)(Wb + W_GU), 64 * kb, n0, (n0 >> 7) * 256 + (n0 & 127), scr, lane); continue; } r -= I_G;
        if (r < I_G) { const int kb = r / 88, nb = r % 88, n0 = 32 * nb; transpose_item(a->in[9] + (size_t)layer * 1024 * FF, 1024, FF, (bf16*)(Wb + W_GU), 64 * kb, n0, (n0 >> 7) * 256 + 128 + (n0 & 127), scr, lane); continue; } r -= I_G;
        if (r < I_D) { const int kb = r / 32, nb = r % 32; transpose_item(a->in[10] + (size_t)layer * FF * 1024, FF, 1024, (bf16*)(Wb + W_DN), 64 * kb, 32 * nb, 32 * nb, scr, lane); continue; } r -= I_D;
        if (r < I_UQ) { const int kb = r / 24, nb = r % 24; transpose_item(a->in[15] + (size_t)e * 384 * 768, 384, 768, (bf16*)(Wb + W_UQ), 64 * kb, 32 * nb, 32 * nb, scr, lane); continue; } r -= I_UQ;
        { const int kb = r / 32, nb = r % 32; transpose_item(a->in[17] + (size_t)e * 256 * 1024, 256, 1024, (bf16*)(Wb + W_UKV), 64 * kb, 32 * nb, 32 * nb, scr, lane); }
    }
}

__device__ __forceinline__ void phase_norm(KArgP a, int layer, int which) {
    const int lane = otid() & 63, wave = otid() >> 6;
    const int gw = blockIdx.x * 8 + wave, NGW = gridDim.x * 8;
    const float* X = (const float*)(a->ws + WS_X); bf16* H = (bf16*)(a->ws + WS_H);
    const float* g = a->in[6] + (layer * 2 + which) * 1024;
    const float* mod = (const float*)(a->ws + WS_MOD) + (size_t)layer * 9 * 6144;
    const int shoff = which ? 3072 : 0, scoff = which ? 4096 : 1024;
    for (int row = gw; row < MT; row += NGW) {
        const int b = row / TPB, j = row - b * TPB, widx = (j < 256) ? 8 : b;
        const f32x4* xr = (const f32x4*)(X + (size_t)row * 1024) + lane;
        f32x4 v[4]; float ss = 0.f;
#pragma unroll
        for (int q = 0; q < 4; ++q) { v[q] = xr[64 * q]; ss += (v[q][0] * v[q][0] + v[q][1] * v[q][1]) + (v[q][2] * v[q][2] + v[q][3] * v[q][3]); }
        const float rstd = __builtin_amdgcn_rsqf(wave_sum(ss) * (1.f / 1024.f) + EPSN);
#pragma unroll
        for (int q = 0; q < 4; ++q) { const int col = 4 * lane + 256 * q;
            const f32x4 gv = *(const f32x4*)(g + col), sc = *(const f32x4*)(mod + widx * 6144 + scoff + col), sh = *(const f32x4*)(mod + widx * 6144 + shoff + col);
            f32x4 y = v[q] * rstd * gv * (sc + 1.0f) + sh;
            u32x2 w; w.x = pk2(y[0], y[1]); w.y = pk2(y[2], y[3]);
            *(u32x2*)(H + (size_t)row * 1024 + col) = w; }
    }
}

__device__ __forceinline__ void phase_post_even(KArgP a, int layer) {
    const int lane = otid() & 63, wave = otid() >> 6;
    const int gw = blockIdx.x * 8 + wave, NGW = gridDim.x * 8, e = layer >> 1;
    const bf16* P = (const bf16*)(a->ws + WS_P); bf16* CQN = (bf16*)(a->ws + WS_CQN); bf16* CKVN = (bf16*)(a->ws + WS_CKVN); bf16* KR = (bf16*)(a->ws + WS_KR);
    const float* qg = a->in[14] + e * 384; const float* kg = a->in[16] + e * 256;
    for (int row = gw; row < MT; row += NGW) {
        const int b = row / TPB, j = row - b * TPB;
        const bf16* pr = P + (size_t)row * NP_E;
        {   float x[6]; float ss = 0.f;
#pragma unroll
            for (int k = 0; k < 3; ++k) { const unsigned w = *(const unsigned*)(pr + 2560 + 2 * lane + 128 * k); x[2 * k] = bf2f((unsigned short)(w & 0xffff)); x[2 * k + 1] = bf2f((unsigned short)(w >> 16)); ss += x[2 * k] * x[2 * k] + x[2 * k + 1] * x[2 * k + 1]; }
            const float rstd = __builtin_amdgcn_rsqf(wave_sum(ss) * (1.f / 384.f) + EPSN);
#pragma unroll
            for (int k = 0; k < 3; ++k) { const int col = 2 * lane + 128 * k; *(unsigned*)(CQN + (size_t)row * 384 + col) = pk2(x[2 * k] * rstd * qg[col], x[2 * k + 1] * rstd * qg[col + 1]); } }
        {   float x[4]; float ss = 0.f;
#pragma unroll
            for (int k = 0; k < 2; ++k) { const unsigned w = *(const unsigned*)(pr + 2944 + 2 * lane + 128 * k); x[2 * k] = bf2f((unsigned short)(w & 0xffff)); x[2 * k + 1] = bf2f((unsigned short)(w >> 16)); ss += x[2 * k] * x[2 * k] + x[2 * k + 1] * x[2 * k + 1]; }
            const float rstd = __builtin_amdgcn_rsqf(wave_sum(ss) * (1.f / 256.f) + EPSN);
#pragma unroll
            for (int k = 0; k < 2; ++k) { const int col = 2 * lane + 128 * k; *(unsigned*)(CKVN + (size_t)row * 256 + col) = pk2(x[2 * k] * rstd * kg[col], x[2 * k + 1] * rstd * kg[col + 1]); } }
        {   const int d = lane & 31; const float x = bf2f(pr[3200 + d]); const float xp = __shfl_xor(x, 8);
            float o = x;
            if (j >= 256) { const int t = j - 256, blk = d >> 4, wi = d & 15, i8 = wi & 7; const float pos = (float)(blk ? (t & 63) : (t >> 6));
                float s, c; sincos_r(pos * inv_freq(i8, 8), s, c);
                o = (wi < 8) ? (x * c - xp * s) : (xp * s + x * c); }
            if (lane < 32) KR[(size_t)row * 32 + d] = (bf16)f2bf(o); }
    }
}
__device__ __forceinline__ void phase_post_odd(KArgP a, int layer) {
    const int lane = otid() & 63, wave = otid() >> 6;
    const int gw = blockIdx.x * 8 + wave, NGW = gridDim.x * 8;
    bf16* P = (bf16*)(a->ws + WS_P);
    for (int row = gw; row < MT; row += NGW) {
        const int b = row / TPB, j = row - b * TPB; const bool lat = j >= 256; const int t = j - 256;
        bf16* pr = P + (size_t)row * NP_O;
#pragma unroll
        for (int u = 0; u < 2; ++u) { const int pid = lane + 64 * u, h = pid >> 5, i = pid & 31, d1 = h * 64 + i, d2 = d1 + 32;
            float s = 0.f, c = 1.f; if (lat) sincos_r((float)t * inv_freq(i, 32), s, c);
            const float q1 = bf2f(pr[d1]), q2 = bf2f(pr[d2]), k1 = bf2f(pr[256 + d1]) * 0.125f, k2 = bf2f(pr[256 + d2]) * 0.125f;
            if (lat) { pr[d1] = (bf16)f2bf(q1 * c - q2 * s); pr[d2] = (bf16)f2bf(q1 * s + q2 * c); }
            pr[256 + d1] = (bf16)f2bf(k1 * c - k2 * s); pr[256 + d2] = (bf16)f2bf(k1 * s + k2 * c); }
        if (lat) {
#pragma unroll
            for (int u = 0; u < 4; ++u) { const int pid = lane + 64 * u, vec = pid >> 5, pp = pid & 31, blk = pp >> 4, i = pp & 15, d1 = vec * 64 + blk * 32 + i, d2 = d1 + 16;
                const float pos = (float)(blk ? (t & 63) : (t >> 6)); float s, c; sincos_r(pos * inv_freq(i, 16), s, c);
                const float q1 = bf2f(pr[1536 + d1]), q2 = bf2f(pr[1536 + d2]), k1 = bf2f(pr[2048 + d1]), k2 = bf2f(pr[2048 + d2]);
                pr[1536 + d1] = (bf16)f2bf(q1 * c - q2 * s); pr[1536 + d2] = (bf16)f2bf(q1 * s + q2 * c);
                pr[2048 + d1] = (bf16)f2bf(k1 * c - k2 * s); pr[2048 + d2] = (bf16)f2bf(k1 * s + k2 * c); } }
    }
}

__device__ __forceinline__ void phase_readout(KArgP a, int layer) {
    const int lane = otid() & 63, wave = otid() >> 6;
    const int gw = blockIdx.x * 8 + wave, NGW = gridDim.x * 8;
    const bool even = !(layer & 1); const int np = even ? NP_E : NP_O, gcol = even ? 2048 : 1024;
    const bf16* P = (const bf16*)(a->ws + WS_P); const bf16* OF = (const bf16*)(a->ws + WS_OSC); const bf16* OB = OF + (size_t)MT * 512;
    bf16* MIX = (bf16*)(a->ws + WS_MIX);
    float g0 = 1.f, g1 = 1.f; if (even) { g0 = a->in[13][(layer >> 1) * 128 + 2 * lane]; g1 = a->in[13][(layer >> 1) * 128 + 2 * lane + 1]; }
    for (int row = gw; row < MT; row += NGW) {
#pragma unroll
        for (int h = 0; h < 4; ++h) { const int col = h * 128 + 2 * lane;
            const unsigned wf = *(const unsigned*)(OF + (size_t)row * 512 + col), wb = *(const unsigned*)(OB + (size_t)row * 512 + col), wg = *(const unsigned*)(P + (size_t)row * np + gcol + col);
            const float o0 = bf2f((unsigned short)(wf & 0xffff)) + bf2f((unsigned short)(wb & 0xffff)), o1 = bf2f((unsigned short)(wf >> 16)) + bf2f((unsigned short)(wb >> 16));
            const float rstd = __builtin_amdgcn_rsqf(wave_sum(o0 * o0 + o1 * o1) * (1.f / 128.f) + EPSN);
            const float y0 = o0 * rstd * g0 * silu_f(bf2f((unsigned short)(wg & 0xffff))), y1 = o1 * rstd * g1 * silu_f(bf2f((unsigned short)(wg >> 16)));
            *(unsigned*)(MIX + (size_t)row * 1024 + col) = pk2(y0, y1); }
    }
}
__device__ __forceinline__ void phase_final(KArgP a) {
    const int lane = otid() & 63, wave = otid() >> 6;
    const int gw = blockIdx.x * 8 + wave, NGW = gridDim.x * 8;
    const float* X = (const float*)(a->ws + WS_X); const float* g = a->in[22];
    for (int r = gw; r < NB * NLAT; r += NGW) {
        const int b = r >> 11, t = r & 2047, row = b * TPB + 256 + t;
        const f32x4* xr = (const f32x4*)(X + (size_t)row * 1024) + lane;
        f32x4 v[4]; float ss = 0.f;
#pragma unroll
        for (int q = 0; q < 4; ++q) { v[q] = xr[64 * q]; ss += (v[q][0] * v[q][0] + v[q][1] * v[q][1]) + (v[q][2] * v[q][2] + v[q][3] * v[q][3]); }
        const float rstd = __builtin_amdgcn_rsqf(wave_sum(ss) * (1.f / 1024.f) + EPSN);
#pragma unroll
        for (int q = 0; q < 4; ++q) { const int col = 4 * lane + 256 * q; const f32x4 gv = *(const f32x4*)(g + col);
            *(f32x4*)(a->out + (size_t)r * 1024 + col) = v[q] * rstd * gv; }
    }
}

__device__ __forceinline__ f32x4 mfma16(bf16x8 a, bf16x8 b, f32x4 c) { return __builtin_amdgcn_mfma_f32_16x16x32_bf16(a, b, c, 0, 0, 0); }

template <int DK, bool HG>
__device__ __forceinline__ void scan_item(KArgP a, int layer, int item, LAS unsigned char* lds) {
    const int tid = otid(), wid = tid >> 6, lane = tid & 63, l15 = lane & 15, q4 = lane >> 4;
    const int h = item & 3, dir = (item >> 2) & 1, b = item >> 3;
    constexpr int TPT = DK / 8, QS = DK * 2 + 16, TS = 144;
    constexpr int NP = HG ? NP_E : NP_O;
    LAS unsigned char* Lqt = lds; LAS unsigned char* Lkt = Lqt + 64 * QS; LAS unsigned char* Lqh = Lkt + 64 * QS;
    LAS unsigned char* LkhT = Lqh + 64 * QS; LAS unsigned char* LvT = LkhT + DK * TS; LAS unsigned char* Latt = LvT + 128 * TS;
    LAS float* Ltot = (LAS float*)(Latt + 64 * TS); LAS float* Lbl = Ltot + 512;
    const bf16* P = (const bf16*)(a->ws + WS_P);
    bf16* OSC = (bf16*)(a->ws + WS_OSC) + (size_t)dir * MT * 512;
    const int c = tid & (DK - 1), tq = tid / DK;
    float lb = 0.f, lg = 0.f, qscale = 1.f; int qcol, zcol;
    if (HG) { qscale = 0.08838834764831845f; qcol = h * 128 + c; zcol = (dir ? 1536 : 1024) + h * 128 + c;
        if (layer >= 2) { const float l0 = a->in[12][(0 * 2 + dir) * 512 + h * 128 + c], l1 = a->in[12][(1 * 2 + dir) * 512 + h * 128 + c]; lb = 1.f / (1.f + __expf(l0 - l1)); } }
    else { qcol = h * 64 + c; zcol = 256 + h * 64 + c; const float x = a->in[19][((layer >> 1) * 2 + dir) * 4 + h]; lg = -__logf(1.f + __expf(-x)); }
    const int vcol = 512 + h * 128;
    const int rowbase = b * TPB;
    const int tv = lane, c8v = wid;
    unsigned short rq[TPT], rz[TPT]; bf16x8 rv[2];
#define SC_JB(ci) (dir ? ((ci) < 4 ? 255 - 64 * (ci) : 2303 - 64 * ((ci) - 4)) : 64 * (ci))
#define SC_LOAD(ci) do { const int jb_ = SC_JB(ci), sg_ = dir ? -1 : 1; \
        _Pragma("unroll") for (int i = 0; i < TPT; ++i) { const bf16* pr_ = P + (size_t)(rowbase + jb_ + sg_ * (tq * TPT + i)) * NP; rq[i] = pr_[qcol]; rz[i] = pr_[zcol]; } \
        { const bf16* pv_ = P + (size_t)(rowbase + jb_ + sg_ * tv) * NP + vcol; rv[0] = *(const bf16x8*)(pv_ + c8v * 8); rv[1] = *(const bf16x8*)(pv_ + (c8v + 8) * 8); } } while (0)
    f32x4 Sacc[DK / 16];
#pragma unroll
    for (int i = 0; i < DK / 16; ++i) Sacc[i] = (f32x4){0.f, 0.f, 0.f, 0.f};
    SC_LOAD(0);
    for (int ci = 0; ci < 36; ++ci) {
        float kk_[TPT], bc[TPT]; float pre = 0.f, ref, blast;
        if (HG) {
            float run = 0.f;
#pragma unroll
            for (int i = 0; i < TPT; ++i) { float z = bf2f(rz[i]); z = fminf(fmaxf(z, -30.f), 30.f);
                const float ez = __expf(-fabsf(z)), enz = __expf(-z);
                kk_[i] = (1.f - lb) / (1.f + __expf(z));
                const float g = fminf(z, 0.f) - __logf(1.f + ez) + __logf(1.f + lb * enz);
                run += g; bc[i] = run; }
            Ltot[tq * 128 + c] = run;
            __syncthreads();
            const float t0 = Ltot[c], t1 = Ltot[128 + c], t2 = Ltot[256 + c], t3 = Ltot[384 + c];
            pre = (tq > 0 ? t0 : 0.f) + (tq > 1 ? t1 : 0.f) + (tq > 2 ? t2 : 0.f);
            ref = t0 + t1; blast = (t0 + t1) + (t2 + t3);
        } else {
#pragma unroll
            for (int i = 0; i < TPT; ++i) { kk_[i] = bf2f(rz[i]); bc[i] = (float)(tq * TPT + i + 1) * lg; }
            ref = 32.f * lg; blast = 64.f * lg;
        }
        unsigned short kh[TPT];
#pragma unroll
        for (int i = 0; i < TPT; ++i) { const int tau = tq * TPT + i; const float bcum = pre + bc[i]; const float qv = bf2f(rq[i]) * qscale, kv = kk_[i];
            const float e1 = fminf(bcum - ref, 80.f), e2 = fminf(ref - bcum, 80.f);
            *(LAS unsigned short*)(Lqt + tau * QS + c * 2) = (unsigned short)f2bf(qv * __expf(e1));
            *(LAS unsigned short*)(Lkt + tau * QS + c * 2) = (unsigned short)f2bf(kv * __expf(e2));
            *(LAS unsigned short*)(Lqh + tau * QS + c * 2) = (unsigned short)f2bf(qv * __expf(bcum));
            kh[i] = (unsigned short)f2bf(kv * __expf(blast - bcum)); }
#pragma unroll
        for (int i8 = 0; i8 < TPT / 8; ++i8) { u32x4 w; w.x = kh[8 * i8] | ((unsigned)kh[8 * i8 + 1] << 16); w.y = kh[8 * i8 + 2] | ((unsigned)kh[8 * i8 + 3] << 16);
            w.z = kh[8 * i8 + 4] | ((unsigned)kh[8 * i8 + 5] << 16); w.w = kh[8 * i8 + 6] | ((unsigned)kh[8 * i8 + 7] << 16);
            *(LAS u32x4*)(LkhT + c * TS + (tq * TPT + 8 * i8) * 2) = w; }
        if (tq == 0) Lbl[c] = __expf(blast);
#pragma unroll
        for (int u = 0; u < 2; ++u)
#pragma unroll
            for (int e = 0; e < 8; ++e) *(LAS unsigned short*)(LvT + ((c8v + 8 * u) * 8 + e) * TS + tv * 2) = (unsigned short)rv[u][e];
        __syncthreads();
        const int jb = SC_JB(ci), sg = dir ? -1 : 1;
        if (ci + 1 < 36) SC_LOAD(ci + 1);
#pragma unroll
        for (int tt = 0; tt < 2; ++tt) { const int idx = 2 * wid + tt, si = idx >> 2, ti = idx & 3;
            f32x4 acc = (f32x4){0.f, 0.f, 0.f, 0.f};
#pragma unroll
            for (int kk = 0; kk < DK / 32; ++kk) { const bf16x8 A = *(const LAS bf16x8*)(Lkt + (16 * si + l15) * QS + (32 * kk + 8 * q4) * 2);
                const bf16x8 B = *(const LAS bf16x8*)(Lqt + (16 * ti + l15) * QS + (32 * kk + 8 * q4) * 2); acc = mfma16(A, B, acc); }
            const int t = 16 * ti + l15, s0 = 16 * si + 4 * q4;
            u32x2 w; w.x = pk2(s0 + 0 <= t ? acc[0] : 0.f, s0 + 1 <= t ? acc[1] : 0.f); w.y = pk2(s0 + 2 <= t ? acc[2] : 0.f, s0 + 3 <= t ? acc[3] : 0.f);
            *(LAS u32x2*)(Latt + t * TS + s0 * 2) = w; }
        __syncthreads();
        const int dvl = 16 * wid + l15;
        const bf16x8 bv0 = *(const LAS bf16x8*)(LvT + dvl * TS + (8 * q4) * 2), bv1 = *(const LAS bf16x8*)(LvT + dvl * TS + (32 + 8 * q4) * 2);
        bf16x8 Sb[DK / 32];
#pragma unroll
        for (int kk = 0; kk < DK / 32; ++kk) { u32x4 w; w.x = pk2(Sacc[2 * kk][0], Sacc[2 * kk][1]); w.y = pk2(Sacc[2 * kk][2], Sacc[2 * kk][3]);
            w.z = pk2(Sacc[2 * kk + 1][0], Sacc[2 * kk + 1][1]); w.w = pk2(Sacc[2 * kk + 1][2], Sacc[2 * kk + 1][3]); Sb[kk] = __builtin_bit_cast(bf16x8, w); }
#pragma unroll
        for (int ti = 0; ti < 4; ++ti) {
            f32x4 acc = (f32x4){0.f, 0.f, 0.f, 0.f};
            { const bf16x8 A = *(const LAS bf16x8*)(Latt + (16 * ti + l15) * TS + (8 * q4) * 2); acc = mfma16(A, bv0, acc); }
            if (ti >= 2) { const bf16x8 A = *(const LAS bf16x8*)(Latt + (16 * ti + l15) * TS + (32 + 8 * q4) * 2); acc = mfma16(A, bv1, acc); }
#pragma unroll
            for (int kk = 0; kk < DK / 32; ++kk) {
                const s16x4 lo = *(const LAS s16x4*)(Lqh + (16 * ti + l15) * QS + (32 * kk + 4 * q4) * 2), hi = *(const LAS s16x4*)(Lqh + (16 * ti + l15) * QS + (32 * kk + 16 + 4 * q4) * 2);
                const bf16x8 A = (bf16x8){lo[0], lo[1], lo[2], lo[3], hi[0], hi[1], hi[2], hi[3]};
                acc = mfma16(A, Sb[kk], acc); }
#pragma unroll
            for (int r = 0; r < 4; ++r) { const int t = 16 * ti + 4 * q4 + r;
                OSC[(size_t)(rowbase + jb + sg * t) * 512 + h * 128 + dvl] = (bf16)f2bf(acc[r]); }
        }
#pragma unroll
        for (int i = 0; i < DK / 16; ++i) {
            const f32x4 d4 = *(const LAS f32x4*)(Lbl + 16 * i + 4 * q4);
            f32x4 s = Sacc[i] * d4;
            const bf16x8 A0 = *(const LAS bf16x8*)(LkhT + (16 * i + l15) * TS + (8 * q4) * 2), A1 = *(const LAS bf16x8*)(LkhT + (16 * i + l15) * TS + (32 + 8 * q4) * 2);
            s = mfma16(A0, bv0, s); s = mfma16(A1, bv1, s); Sacc[i] = s; }
        __syncthreads();
    }
#undef SC_JB
#undef SC_LOAD
}

#define SBAR() __builtin_amdgcn_sched_barrier(0)
__device__ __forceinline__ int crow(int r, int hi) { return (r & 3) + 8 * (r >> 2) + 4 * hi; }
__device__ __forceinline__ unsigned cvtpk(float lo, float hi) { unsigned r; asm volatile("v_cvt_pk_bf16_f32 %0, %1, %2" : "=v"(r) : "v"(lo), "v"(hi)); return r; }
__device__ __forceinline__ void partialSM(f32x16& p0, f32x16& p1, float& m_reg, float& mn, float& alpha, float C, float thr_raw) {
    float pmax = p0[0];
#pragma unroll
    for (int r = 1; r < 16; ++r) pmax = fmaxf(pmax, p0[r]);
#pragma unroll
    for (int r = 0; r < 16; ++r) pmax = fmaxf(pmax, p1[r]);
    { auto rr = __builtin_amdgcn_permlane32_swap(__float_as_uint(pmax), __float_as_uint(pmax), false, false);
      pmax = fmaxf(__uint_as_float(rr[0]), __uint_as_float(rr[1])); }
    if (__builtin_expect(__all(pmax - m_reg <= thr_raw), 1)) { mn = m_reg; alpha = 1.f; }
    else { mn = fmaxf(m_reg, pmax); alpha = __builtin_amdgcn_exp2f((m_reg - mn) * C); m_reg = mn; }
    const float mnC = -mn * C;
#pragma unroll
    for (int r = 0; r < 16; ++r) p0[r] = fmaf(p0[r], C, mnC);
#pragma unroll
    for (int r = 0; r < 16; ++r) p1[r] = fmaf(p1[r], C, mnC);
#pragma unroll
    for (int r = 0; r < 16; ++r) p0[r] = __builtin_amdgcn_exp2f(p0[r]);
}
__device__ __forceinline__ void finishSM(f32x16& p0, f32x16& p1, float alpha, float& l_reg, bf16x8& pa0, bf16x8& pa1, bf16x8& pa2, bf16x8& pa3) {
#pragma unroll
    for (int r = 0; r < 16; ++r) p1[r] = __builtin_amdgcn_exp2f(p1[r]);
    float ps = 0;
#pragma unroll
    for (int r = 0; r < 16; ++r) ps += p0[r];
#pragma unroll
    for (int r = 0; r < 16; ++r) ps += p1[r];
    { auto rr = __builtin_amdgcn_permlane32_swap(__float_as_uint(ps), __float_as_uint(ps), false, false);
      ps = __uint_as_float(rr[0]) + __uint_as_float(rr[1]); }
    l_reg = l_reg * alpha + ps;
#define PK4(P, BASE, OUT) do { unsigned a0 = cvtpk(P[BASE + 0], P[BASE + 1]), a1 = cvtpk(P[BASE + 2], P[BASE + 3]);   \
    unsigned b0 = cvtpk(P[BASE + 4], P[BASE + 5]), b1 = cvtpk(P[BASE + 6], P[BASE + 7]);                              \
    auto r0 = __builtin_amdgcn_permlane32_swap(a0, b0, false, false); auto r1 = __builtin_amdgcn_permlane32_swap(a1, b1, false, false); \
    u32x4 w = {r0[0], r1[0], r0[1], r1[1]}; OUT = __builtin_bit_cast(bf16x8, w); } while (0)
    PK4(p0, 0, pa0); PK4(p0, 8, pa1); PK4(p1, 0, pa2); PK4(p1, 8, pa3);
#undef PK4
}
template <int ND0, int KROWB>
__device__ __forceinline__ void qkt(f32x16& p0, f32x16& p1, const char* Ks, const bf16x8* qr, int r32, int hi) {
    p0 = f32x16{}; p1 = f32x16{};
#pragma unroll
    for (int d0 = 0; d0 < ND0; ++d0) { const int cb = (d0 * 16 + hi * 8) * 2;
        const bf16x8 b0 = *reinterpret_cast<const bf16x8*>(Ks + r32 * KROWB + (cb ^ ((r32 & 7) << 4)));
        const bf16x8 b1 = *reinterpret_cast<const bf16x8*>(Ks + (32 + r32) * KROWB + (cb ^ ((r32 & 7) << 4)));
        p0 = __builtin_amdgcn_mfma_f32_32x32x16_bf16(b0, qr[d0], p0, 0, 0, 0);
        p1 = __builtin_amdgcn_mfma_f32_32x32x16_bf16(b1, qr[d0], p1, 0, 0, 0); }
}
template <int NCB> __device__ __forceinline__ int v_st(int k, int c) { const int kk = (k & ~0xC) | ((k & 4) << 1) | ((k & 8) >> 1); return ((kk >> 3) * NCB + (c >> 5)) * 512 + ((kk & 7) * 32 + (c & 31)) * 2; }
__device__ __forceinline__ int v_rd_base(int lane) { return ((lane & 3) << 3) | (((lane >> 2) & 3) << 6) | (((lane >> 4) & 1) << 5) | (((lane >> 5) & 1) << 8); }
template <int OFF> __device__ __forceinline__ s16x4 tr_read(int vb) {
    s16x4 r; asm volatile("ds_read_b64_tr_b16 %0, %1 offset:%2" : "=&v"(r) : "v"(vb), "i"(OFF) : "memory"); return r;
}
template <int NCB, int D0> __device__ __forceinline__ void pv_one(f32x16& od, int vb, bf16x8 pa0, bf16x8 pa1, bf16x8 pa2, bf16x8 pa3) {
#define VOFF(ks, half) (D0 * 512 + (ks) * (NCB * 1024) + (half) * (NCB * 512))
    const s16x4 l0 = tr_read<VOFF(0, 0)>(vb), h0 = tr_read<VOFF(0, 1)>(vb), l1 = tr_read<VOFF(1, 0)>(vb), h1 = tr_read<VOFF(1, 1)>(vb);
    const s16x4 l2 = tr_read<VOFF(2, 0)>(vb), h2 = tr_read<VOFF(2, 1)>(vb), l3 = tr_read<VOFF(3, 0)>(vb), h3 = tr_read<VOFF(3, 1)>(vb);
#undef VOFF
    asm volatile("s_waitcnt lgkmcnt(0)" ::: "memory"); SBAR();
#define PK(L, H) (bf16x8){L[0], L[1], L[2], L[3], H[0], H[1], H[2], H[3]}
    od = __builtin_amdgcn_mfma_f32_32x32x16_bf16(pa0, PK(l0, h0), od, 0, 0, 0);
    od = __builtin_amdgcn_mfma_f32_32x32x16_bf16(pa1, PK(l1, h1), od, 0, 0, 0);
    od = __builtin_amdgcn_mfma_f32_32x32x16_bf16(pa2, PK(l2, h2), od, 0, 0, 0);
    od = __builtin_amdgcn_mfma_f32_32x32x16_bf16(pa3, PK(l3, h3), od, 0, 0, 0);
#undef PK
}
template <int NCB> __device__ __forceinline__ void pv_all(f32x16* o, int vb, bf16x8 pa0, bf16x8 pa1, bf16x8 pa2, bf16x8 pa3) {
    pv_one<NCB, 0>(o[0], vb, pa0, pa1, pa2, pa3); pv_one<NCB, 1>(o[1], vb, pa0, pa1, pa2, pa3);
    if constexpr (NCB == 4) { pv_one<NCB, 2>(o[2], vb, pa0, pa1, pa2, pa3); pv_one<NCB, 3>(o[3], vb, pa0, pa1, pa2, pa3); }
}

template <int DQK, int DV, int KROWB>
__device__ __forceinline__ void attn_core(const bf16x8* qr, const bf16* kA, int sA, const bf16* kB, int sB, const bf16* vP, int sV,
                                          int NT, float C, float thr_raw, char* lds, f32x16* o, float& l_out, const int tid) {
    constexpr int NCB = DV / 32, SHM_V = 64 * DV * 2, SHM_K = 64 * KROWB, ND0 = DQK / 16;
    constexpr int PPR = DQK / 8, NPK = 64 * PPR, NKS = (NPK + 511) / 512, VPR = DV / 8, NVS = 64 * VPR / 512;
    const int wid = tid >> 6, lane = tid & 63, r32 = lane & 31, hi = lane >> 5;
    char* V_lds = lds; char* K_lds = lds + 2 * SHM_V;
    float* wsf = (float*)(lds + 2 * SHM_V + 2 * SHM_K) + wid * 64; float* al_l = wsf + 32;
    float m_reg = -1e30f, l_reg = 0;
    const bf16* kp[NKS]; int kadv[NKS], kst[NKS]; bool kval[NKS];
#pragma unroll
    for (int i = 0; i < NKS; ++i) { int p = tid + 512 * i; kval[i] = p < NPK; if (!kval[i]) p -= 512; const int row = p / PPR, c8 = p - row * PPR;
        if (c8 < 8) { kp[i] = kA + (size_t)row * sA + c8 * 8; kadv[i] = 64 * sA; } else { kp[i] = kB + (size_t)row * sB + (c8 - 8) * 8; kadv[i] = 64 * sB; }
        kst[i] = row * KROWB + ((c8 * 16) ^ ((row & 7) << 4)); }
    const bf16* vp[NVS]; int vst[NVS];
#pragma unroll
    for (int i = 0; i < NVS; ++i) { const int p = tid + 512 * i, row = p / VPR, c8 = p % VPR; vp[i] = vP + (size_t)row * sV + c8 * 8; vst[i] = v_st<NCB>(row, c8 * 8); }
    const int vadv = 64 * sV;
    const int vb0 = (int)(uintptr_t)V_lds + v_rd_base(lane);
    struct { bf16x8 ks[NKS]; bf16x8 vs[NVS]; } sr_[1];
#define SLOAD(i, t) do { _Pragma("unroll") for (int s_ = 0; s_ < NKS; ++s_) sr_[i].ks[s_] = *(const bf16x8*)(kp[s_] + (size_t)(t) * kadv[s_]); \
        _Pragma("unroll") for (int s_ = 0; s_ < NVS; ++s_) sr_[i].vs[s_] = *(const bf16x8*)(vp[s_] + (size_t)(t) * vadv); } while (0)
#define SWRITE(b, i) do { _Pragma("unroll") for (int s_ = 0; s_ < NVS; ++s_) *(bf16x8*)(V_lds + (b) * SHM_V + vst[s_]) = sr_[i].vs[s_]; \
        _Pragma("unroll") for (int s_ = 0; s_ < NKS; ++s_) if (kval[s_]) *(bf16x8*)(K_lds + (b) * SHM_K + kst[s_]) = sr_[i].ks[s_]; } while (0)
#define RESC(a) do { if (__any((a) < 1.f)) { if (hi == 0) al_l[r32] = (a); asm volatile("s_waitcnt lgkmcnt(0)" ::: "memory"); \
        _Pragma("unroll") for (int d = 0; d < NCB; ++d) _Pragma("unroll") for (int r = 0; r < 16; ++r) o[d][r] *= al_l[crow(r, hi)]; } } while (0)
    f32x16 pA0, pA1, pB0, pB1; float mnA, mnB, alA, alB; bf16x8 pa0, pa1, pa2, pa3;
    constexpr int SE = 0, SO = 0;
    SLOAD(SE, 0); SWRITE(0, SE); __syncthreads();
    qkt<ND0, KROWB>(pA0, pA1, K_lds, qr, r32, hi); partialSM(pA0, pA1, m_reg, mnA, alA, C, thr_raw);
    SLOAD(SO, 1);
    SWRITE(1, SO); __syncthreads();
    for (int j = 1; j + 1 < NT; j += 2) {
        SBAR(); qkt<ND0, KROWB>(pB0, pB1, K_lds + SHM_K, qr, r32, hi);
        finishSM(pA0, pA1, alA, l_reg, pa0, pa1, pa2, pa3); SBAR();
        SLOAD(SO, j + 1); SBAR();
        pv_all<NCB>(o, vb0, pa0, pa1, pa2, pa3); partialSM(pB0, pB1, m_reg, mnB, alB, C, thr_raw);
        __syncthreads(); SWRITE(0, SE);
        RESC(alB); __syncthreads();
        SBAR(); qkt<ND0, KROWB>(pA0, pA1, K_lds, qr, r32, hi);
        finishSM(pB0, pB1, alB, l_reg, pa0, pa1, pa2, pa3); SBAR();
        SLOAD(SE, j + 2); SBAR();
        pv_all<NCB>(o, vb0 + SHM_V, pa0, pa1, pa2, pa3); partialSM(pA0, pA1, m_reg, mnA, alA, C, thr_raw);
        __syncthreads(); SWRITE(1, SO);
        RESC(alA); __syncthreads();
    }
    SBAR(); qkt<ND0, KROWB>(pB0, pB1, K_lds + SHM_K, qr, r32, hi);
    finishSM(pA0, pA1, alA, l_reg, pa0, pa1, pa2, pa3); SBAR();
    pv_all<NCB>(o, vb0, pa0, pa1, pa2, pa3); partialSM(pB0, pB1, m_reg, mnB, alB, C, thr_raw);
    __syncthreads(); RESC(alB);
    finishSM(pB0, pB1, alB, l_reg, pa0, pa1, pa2, pa3); SBAR();
    pv_all<NCB>(o, vb0 + SHM_V, pa0, pa1, pa2, pa3);
    l_out = l_reg;
#undef SLOAD
#undef SWRITE
#undef RESC
}

__device__ __forceinline__ void mla_item(KArgP a, int b, int h, int qb, char* lds) {
    const int tid = ptid(), wid = tid >> 6, lane = tid & 63, r32 = lane & 31, hi = lane >> 5;
    const bf16* Qb = (const bf16*)((const unsigned char*)a->out + OUT_Q); const bf16* KV = (const bf16*)((const unsigned char*)a->out + OUT_KV);
    const bf16* KR = (const bf16*)(a->ws + WS_KR); bf16* MIX = (bf16*)(a->ws + WS_MIX);
    const int row0 = b * TPB + qb * 256, krow0 = b * TPB, NT = qb ? 36 : 4;
    const int row = row0 + wid * 32 + r32;
    const bf16* Qw = Qb + (size_t)row * 768 + h * 96;
    bf16x8 qr[6];
#pragma unroll
    for (int d0 = 0; d0 < 4; ++d0) qr[d0] = *(const bf16x8*)(Qw + d0 * 16 + hi * 8);
    const int t = (qb - 1) * 256 + wid * 32 + r32;
#pragma unroll
    for (int d0 = 4; d0 < 6; ++d0) {
        const bf16x8 x1 = *(const bf16x8*)(Qw + d0 * 16), x2 = *(const bf16x8*)(Qw + d0 * 16 + 8);
        if (qb) { const float pos = (float)(d0 == 4 ? (t >> 6) : (t & 63)); unsigned short ov[8];
#pragma unroll
            for (int i = 0; i < 8; ++i) { float s, c; sincos_r(pos * inv_freq(i, 8), s, c); const float f1 = bf2f((unsigned short)x1[i]), f2 = bf2f((unsigned short)x2[i]);
                ov[i] = (unsigned short)f2bf(hi ? (f1 * s + f2 * c) : (f1 * c - f2 * s)); }
            qr[d0] = (bf16x8){(short)ov[0], (short)ov[1], (short)ov[2], (short)ov[3], (short)ov[4], (short)ov[5], (short)ov[6], (short)ov[7]};
        } else qr[d0] = hi ? x2 : x1;
    }
    f32x16 o[2] = {}; float l_reg;
    const float scale = 0.10206207261596575f;
    attn_core<96, 64, 256>(qr, KV + (size_t)krow0 * 1024 + h * 128, 1024, KR + (size_t)krow0 * 32, 32, KV + (size_t)krow0 * 1024 + h * 128 + 64, 1024,
                           NT, scale * 1.4426950408889634f, 8.f / scale, lds, o, l_reg, tid);
    float* li_l = (float*)(lds + 2 * 64 * 64 * 2 + 2 * 64 * 256) + wid * 64;
    if (hi == 0) li_l[r32] = l_reg; asm volatile("s_waitcnt lgkmcnt(0)" ::: "memory");
#pragma unroll
    for (int r = 0; r < 16; ++r) { const int orow = crow(r, hi); const float rl = __builtin_amdgcn_rcpf(li_l[orow]);
        bf16* op = MIX + (size_t)(row0 + wid * 32 + orow) * 1024 + 512 + h * 64 + r32;
        op[0] = (bf16)f2bf(o[0][r] * rl); op[32] = (bf16)f2bf(o[1][r] * rl); }
}
__device__ __forceinline__ void diff_item(KArgP a, int layer, int b, int h, int qb, char* lds) {
    const int tid = ptid(), wid = tid >> 6, lane = tid & 63, r32 = lane & 31, hi = lane >> 5;
    const bf16* P = (const bf16*)(a->ws + WS_P); bf16* MIX = (bf16*)(a->ws + WS_MIX);
    float* DS = (float*)a->out + (size_t)blockIdx.x * 80 * 512;
    const int row0 = b * TPB + qb * 256, krow0 = b * TPB, NT = qb ? 36 : 4, o_ = layer >> 1;
    const int row = row0 + wid * 32 + r32;
    const float* lp = a->in[20] + o_ * 256;
    const float lam_init = 0.8f - 0.6f * __expf(-0.3f * (float)layer);
    const float lam = __expf(wave_sum(lp[lane] * lp[64 + lane])) - __expf(wave_sum(lp[128 + lane] * lp[192 + lane])) + lam_init;
    const float scale = 0.125f;
    float* li_l = (float*)(lds + 2 * 64 * 64 * 2 + 2 * 64 * 128) + wid * 64;
#pragma unroll 1
    for (int pp = 0; pp < 4; ++pp) {
        const int m = pp >> 1, vh = pp & 1;
        const bf16* Qw = P + (size_t)row * NP_O + 1536 + h * 128 + m * 64;
        bf16x8 qr[4];
#pragma unroll
        for (int d0 = 0; d0 < 4; ++d0) qr[d0] = *(const bf16x8*)(Qw + d0 * 16 + hi * 8);
        f32x16 o[2] = {};
        float l_reg;
        const bf16* Kp = P + (size_t)krow0 * NP_O + 2048 + h * 128 + m * 64;
        attn_core<64, 64, 128>(qr, Kp, NP_O, Kp, NP_O, P + (size_t)krow0 * NP_O + 2560 + h * 128 + vh * 64, NP_O,
                               NT, scale * 1.4426950408889634f, 8.f / scale, lds, o, l_reg, tid);
        if (hi == 0) li_l[r32] = l_reg; asm volatile("s_waitcnt lgkmcnt(0)" ::: "memory");
        float* dsb = DS + tid; asm volatile("" : "+v"(dsb));
        if (m == 0) {
#pragma unroll
            for (int r = 0; r < 16; ++r) { const float rl = __builtin_amdgcn_rcpf(li_l[crow(r, hi)]);
#pragma unroll
                for (int d = 0; d < 2; ++d) dsb[(size_t)(vh * 32 + d * 16 + r) * 512] = o[d][r] * rl; }
        } else {
#pragma unroll
            for (int r = 0; r < 16; ++r) { const float rl = __builtin_amdgcn_rcpf(li_l[crow(r, hi)]); float s = 0.f;
#pragma unroll
                for (int d = 0; d < 2; ++d) { const float v = dsb[(size_t)(vh * 32 + d * 16 + r) * 512] - lam * (o[d][r] * rl); o[d][r] = v; s += v * v; }
                s += __shfl_xor(s, 16); s += __shfl_xor(s, 8); s += __shfl_xor(s, 4); s += __shfl_xor(s, 2); s += __shfl_xor(s, 1);
                if (vh == 0) { dsb[(size_t)(64 + r) * 512] = s; dsb[(size_t)(0 * 16 + r) * 512] = o[0][r]; dsb[(size_t)(1 * 16 + r) * 512] = o[1][r]; }
                else {
                    const float rs = __builtin_amdgcn_rsqf((s + dsb[(size_t)(64 + r) * 512]) * (1.f / 128.f) + EPSN) * (1.f - lam_init);
                    const float* sg = a->in[21] + o_ * 128;
                    bf16* op = MIX + (size_t)(row0 + wid * 32 + crow(r, hi)) * 1024 + 512 + h * 128 + r32;
                    op[0]  = (bf16)f2bf(dsb[(size_t)(0 * 16 + r) * 512] * rs * sg[r32]);
                    op[32] = (bf16)f2bf(dsb[(size_t)(1 * 16 + r) * 512] * rs * sg[32 + r32]);
                    op[64] = (bf16)f2bf(o[0][r] * rs * sg[64 + r32]);
                    op[96] = (bf16)f2bf(o[1][r] * rs * sg[96 + r32]); }
            }
        }
        asm volatile("s_waitcnt vmcnt(0) lgkmcnt(0)" ::: "memory");
    }
}

__device__ __forceinline__ void phase_mixer(KArgP a, int layer, unsigned char* ldsg) {
    LAS unsigned char* lds = (LAS unsigned char*)ldsg;
    volatile LAS unsigned* flag = (volatile LAS unsigned*)(lds + LDS_MAIN);
    unsigned* ctr = (unsigned*)(a->ws + WS_CTL) + layer; layer &= 7;
    const bool even = !(layer & 1), need_ctx = layer < 3;
    const int n_lat = even ? 512 : 256, n_ctx = need_ctx ? (even ? 64 : 32) : 0, total = 64 + n_lat + n_ctx;
    for (;;) {
        __syncthreads();
        if (ptid() == 0) *flag = atomicAdd(ctr, 1u);
        __syncthreads();
        const int item = (int)*flag;
        if (item >= total) break;
#ifndef SKIP_SCAN
        if (item < 64) { if (even) scan_item<128, true>(a, layer, item, lds); else scan_item<64, false>(a, layer, item, lds); }
#else
        if (item < 64) {}
#endif
        else { int b_, h_, qb_;
            if (item < 64 + n_lat) { const int i = item - 64; qb_ = 1 + (i & 7); if (even) { b_ = i >> 6; h_ = (i >> 3) & 7; } else { b_ = i >> 5; h_ = (i >> 3) & 3; } }
            else { const int i = item - 64 - n_lat; qb_ = 0; if (even) { b_ = i >> 3; h_ = i & 7; } else { b_ = i >> 2; h_ = i & 3; } }
#ifndef SKIP_ATTN
            if (even) mla_item(a, b_, h_, qb_, (char*)ldsg); else diff_item(a, layer, b_, h_, qb_, (char*)ldsg);
#endif
        }
    }
}

#define XB_TMO      128
#define XB_XCNT(j)  (256  + 64 * (j))
#define XB_XSUB(j)  (1280 + 64 * (j))
#define XB_XGEN(j)  (2304 + 64 * (j))
#define XB_TOP      3328
#define XB_TOPGEN   3392
#define XCD_BAR_WORDS 3456
#define XB_SPIN_CAP (1u << 18)

__device__ __forceinline__ unsigned xb_ld(unsigned* p)              { return __hip_atomic_load(p, __ATOMIC_RELAXED, __HIP_MEMORY_SCOPE_AGENT); }
__device__ __forceinline__ unsigned xb_add(unsigned* p, unsigned v) { return __hip_atomic_fetch_add(p, v, __ATOMIC_RELAXED, __HIP_MEMORY_SCOPE_AGENT); }
__device__ __forceinline__ unsigned xb_xcc_id() { return (unsigned)__builtin_amdgcn_s_getreg((3 << 11) | 20) & 0xFu; }
#define XB_SPIN(cond, bar) do { unsigned _sp = 0; while (cond) { __builtin_amdgcn_s_sleep(1); \
    if ((++_sp & 255u) == 0u) { if (xb_ld(&(bar)[XB_TMO])) break; if (_sp > XB_SPIN_CAP) { atomicAdd(&(bar)[XB_TMO], 1u); break; } } } } while (0)

struct XcdBarrier {
    unsigned* bar; unsigned x;
    volatile LAS unsigned* st;
};

__device__ __forceinline__ XcdBarrier xcd_barrier_post(unsigned* bar, volatile LAS unsigned* st) {
    XcdBarrier b; b.bar = bar; b.x = xb_xcc_id(); b.st = st;
    if (threadIdx.x == 0) (void)xb_add(&bar[XB_XCNT(b.x)], 1u);
    return b;
}
__device__ __forceinline__ void xcd_barrier_complete(unsigned* bar, unsigned x, unsigned& nloc, unsigned& nx) {
    const unsigned G = gridDim.x * gridDim.y * gridDim.z;
    unsigned sum, cnt, mine, sp = 0u;
    for (;;) {
        sum = 0u; cnt = 0u; mine = 0u;
#pragma unroll
        for (unsigned j = 0; j < 16; ++j) { const unsigned c = xb_ld(&bar[XB_XCNT(j)]); sum += c; cnt += (c > 0u) ? 1u : 0u; mine = (j == x) ? c : mine; }
        if (sum == G) break;
        __builtin_amdgcn_s_sleep(1);
        if ((++sp & 255u) == 0u) { if (xb_ld(&bar[XB_TMO])) break; if (sp > XB_SPIN_CAP) { atomicAdd(&bar[XB_TMO], 1u); break; } }
    }
    nloc = mine > 0u ? mine : 1u; nx = cnt > 0u ? cnt : 1u;
}

__device__ __forceinline__ void xcd_barrier(const XcdBarrier& b) {
    asm volatile("s_waitcnt vmcnt(0)" ::: "memory");
    __syncthreads();
    if (threadIdx.x == 0) {
        unsigned* bar = b.bar;
        __builtin_amdgcn_s_waitcnt(0);
        unsigned nloc = b.st[0], nx = b.st[1];
        if (nloc == 0u) { xcd_barrier_complete(bar, b.x, nloc, nx); b.st[0] = nloc; b.st[1] = nx; }
        const unsigned old = xb_add(&bar[XB_XSUB(b.x)], 1u);
        const unsigned gen = old / nloc;
        if (old + 1u == (gen + 1u) * nloc) {
            __builtin_amdgcn_fence(__ATOMIC_RELEASE, "agent");
            asm volatile("s_waitcnt vmcnt(0)" ::: "memory");
            const unsigned og = xb_add(&bar[XB_TOP], 1u);
            const unsigned tg = og / nx;
            if (og + 1u == (tg + 1u) * nx) xb_add(&bar[XB_TOPGEN], 1u);
            else XB_SPIN(xb_ld(&bar[XB_TOPGEN]) == tg, bar);
            __builtin_amdgcn_fence(__ATOMIC_ACQUIRE, "agent");
            xb_add(&bar[XB_XGEN(b.x)], 1u);
            asm volatile("s_waitcnt vmcnt(0)" ::: "memory");
        } else {
            XB_SPIN(xb_ld(&bar[XB_XGEN(b.x)]) == gen, bar);
            __builtin_amdgcn_fence(__ATOMIC_ACQUIRE, "agent");
            asm volatile("s_waitcnt vmcnt(0)" ::: "memory");
        }
    }
    __syncthreads();
}

__global__ void __launch_bounds__(512, 2) mega_fwd(Args a_) {
    extern __shared__ __attribute__((aligned(16))) unsigned char lds_raw[];
    LAS unsigned char* lds = (LAS unsigned char*)lds_raw;
    ((LAS int*)(lds + LDS_MAIN + 1024))[threadIdx.x] = (int)threadIdx.x;
    if (threadIdx.x < 4) ((LAS unsigned*)(lds + LDS_MAIN + 64))[threadIdx.x] = 0u;
    __syncthreads();
    XcdBarrier xbar; xbar.bar = nullptr; xbar.x = 0; xbar.st = nullptr; bool xb_ready = false;
    cg::grid_group grid = cg::this_grid();
    int ph = 0;
    const int plo = a_.lo, phi = a_.hi;
#define PH_BEGIN if (ph >= plo && ph < phi) { KArgP a = kargs(); int bx = (int)blockIdx.x, G = (int)gridDim.x; asm volatile("" : "+s"(bx), "+s"(G)); (void)bx; (void)G;
#ifdef PROBE_SYNC2
#define PH_END   if (ph + 1 < phi) { grid.sync(); grid.sync(); } } ++ph;
#else
#define PH_END   if (ph + 1 < phi) { if (!xb_ready) { grid.sync(); xbar = xcd_barrier_post((unsigned*)(a->ws + WS_CTL) + 4096, (volatile LAS unsigned*)(lds + LDS_MAIN + 64)); xb_ready = true; } else xcd_barrier(xbar); } } ++ph;
#endif

    PH_BEGIN phase_prep(a, lds); PH_END

    for (int layer = 0; layer < 4; ++layer) {
        const bool even = !(layer & 1);
        const int np = even ? NP_E : NP_O;
        PH_BEGIN phase_norm(a, layer, 0); convert_weights(a, layer, lds); PH_END
#ifndef SKIP_G1
        PH_BEGIN { bf16* H = (bf16*)(a->ws + WS_H); bf16* MIX = (bf16*)(a->ws + WS_MIX); bf16* P = (bf16*)(a->ws + WS_P); float* X = (float*)(a->ws + WS_X); unsigned char* Wb = a->ws + WS_W; const float* mod = (const float*)(a->ws + WS_MOD) + (size_t)layer * 9 * 6144; (void)H; (void)MIX; (void)P; (void)X; (void)mod; pg8::Gemm g{H, (const bf16*)(Wb + W_IN), MT, np, 1024}; pg8::StaticOrder S; S.init(MT, np, G, bx);
                   pg8::EpiBf16<0> E{P, np, nullptr, 0, 0, 1.f};
                   pg8::gemm_phase<pg8::EpiBf16<0>, pg8::StaticOrder, true, true>(lds, g, S, E); } PH_END
#else
        ++ph;
#endif
        PH_BEGIN if (even) phase_post_even(a, layer); else phase_post_odd(a, layer); PH_END
#ifndef SKIP_G3
        if (even) {
            PH_BEGIN { bf16* H = (bf16*)(a->ws + WS_H); bf16* MIX = (bf16*)(a->ws + WS_MIX); bf16* P = (bf16*)(a->ws + WS_P); float* X = (float*)(a->ws + WS_X); unsigned char* Wb = a->ws + WS_W; const float* mod = (const float*)(a->ws + WS_MOD) + (size_t)layer * 9 * 6144; (void)H; (void)MIX; (void)P; (void)X; (void)mod; pg8::Gemm g{(const bf16*)(a->ws + WS_CQN), (const bf16*)(Wb + W_UQ), MT, 768, 384}; pg8::StaticOrder S; S.init(MT, 768, G, bx);
                       pg8::EpiBf16<0> E{(bf16*)((unsigned char*)a->out + OUT_Q), 768, nullptr, 0, 0, 1.f};
                       pg8::gemm_phase<pg8::EpiBf16<0>, pg8::StaticOrder, true, true>(lds, g, S, E); }
                     { unsigned char* Wb = a->ws + WS_W; pg8::Gemm g{(const bf16*)(a->ws + WS_CKVN), (const bf16*)(Wb + W_UKV), MT, 1024, 256}; pg8::StaticOrder S; S.init(MT, 1024, G, bx);
                       pg8::EpiBf16<0> E{(bf16*)((unsigned char*)a->out + OUT_KV), 1024, nullptr, 0, 0, 1.f};
                       pg8::gemm_phase<pg8::EpiBf16<0>, pg8::StaticOrder, true, true>(lds, g, S, E); } PH_END
        } else { ++ph; }
#else
        ++ph;
#endif
#ifdef PROBE_MIX2
        PH_BEGIN phase_mixer(a, layer + 8, lds_raw); grid.sync(); PH_END
        --ph;
#endif
        PH_BEGIN phase_mixer(a, layer, lds_raw); PH_END
        PH_BEGIN phase_readout(a, layer); PH_END
#ifndef SKIP_G6
        PH_BEGIN { bf16* H = (bf16*)(a->ws + WS_H); bf16* MIX = (bf16*)(a->ws + WS_MIX); bf16* P = (bf16*)(a->ws + WS_P); float* X = (float*)(a->ws + WS_X); unsigned char* Wb = a->ws + WS_W; const float* mod = (const float*)(a->ws + WS_MOD) + (size_t)layer * 9 * 6144; (void)H; (void)MIX; (void)P; (void)X; (void)mod; pg8::Gemm g{MIX, (const bf16*)(Wb + W_OUT), MT, 1024, 1024}; pg8::StaticOrder S; S.init(MT, 1024, G, bx);
                   pg8::EpiResid E{X, mod, 2048};
                   pg8::gemm_phase<pg8::EpiResid, pg8::StaticOrder, true, true>(lds, g, S, E); } PH_END
#else
        ++ph;
#endif
        PH_BEGIN phase_norm(a, layer, 1); PH_END
#ifndef SKIP_G8
        PH_BEGIN { bf16* H = (bf16*)(a->ws + WS_H); bf16* MIX = (bf16*)(a->ws + WS_MIX); bf16* P = (bf16*)(a->ws + WS_P); float* X = (float*)(a->ws + WS_X); unsigned char* Wb = a->ws + WS_W; const float* mod = (const float*)(a->ws + WS_MOD) + (size_t)layer * 9 * 6144; (void)H; (void)MIX; (void)P; (void)X; (void)mod; pg8::Gemm g{H, (const bf16*)(Wb + W_GU), MT, 2 * FF, 1024}; pg8::StaticOrder S; S.init(MT, 2 * FF, G, bx);
                   pg8::EpiSwiGLU E{P, FF};
                   pg8::gemm_phase<pg8::EpiSwiGLU, pg8::StaticOrder, true, true>(lds, g, S, E); } PH_END
#else
        ++ph;
#endif
#ifndef SKIP_G9
        PH_BEGIN { bf16* H = (bf16*)(a->ws + WS_H); bf16* MIX = (bf16*)(a->ws + WS_MIX); bf16* P = (bf16*)(a->ws + WS_P); float* X = (float*)(a->ws + WS_X); unsigned char* Wb = a->ws + WS_W; const float* mod = (const float*)(a->ws + WS_MOD) + (size_t)layer * 9 * 6144; (void)H; (void)MIX; (void)P; (void)X; (void)mod; pg8::Gemm g{P, (const bf16*)(Wb + W_DN), MT, 1024, FF}; pg8::StaticOrder S; S.init(MT, 1024, G, bx);
                   pg8::EpiResid E{X, mod, 5120};
                   pg8::gemm_phase<pg8::EpiResid, pg8::StaticOrder, true, true>(lds, g, S, E); } PH_END
#else
        ++ph;
#endif
    }
    PH_BEGIN phase_final(a); PH_END
#undef PH_BEGIN
#undef PH_END
}
constexpr int NPH = 1 + 4 * 10 + 1;

extern "C" void kernel_launch(void* const* d_in, const int* in_sizes, int n_in, void* d_out, int out_size, void* d_ws, size_t ws_size, hipStream_t stream) {
    static int grid = 0;
    if (grid == 0) {
        if (n_in != 23 || ws_size < WS_END || out_size != NB * NLAT * DM) { fprintf(stderr, "kernel_launch: unexpected shapes: n_in %d ws %zu (need %zu) out %d\n", n_in, ws_size, (size_t)WS_END, out_size); grid = -1; return; }
        int dev = 0, cus = 0, per_cu = 0;
        hipGetDevice(&dev); hipDeviceGetAttribute(&cus, hipDeviceAttributeMultiprocessorCount, dev);
        if (hipFuncSetAttribute((const void*)mega_fwd, hipFuncAttributeMaxDynamicSharedMemorySize, LDS_BYTES) != hipSuccess) { fprintf(stderr, "kernel_launch: hipFuncSetAttribute failed\n"); grid = -1; return; }
        if (hipOccupancyMaxActiveBlocksPerMultiprocessor(&per_cu, (const void*)mega_fwd, 512, LDS_BYTES) != hipSuccess || per_cu < 1) { fprintf(stderr, "kernel_launch: occupancy query says %d\n", per_cu); per_cu = 1; }
        (void)hipGetLastError();
        grid = cus;
    }
    if (grid < 0) return;
    Args a{};
    for (int i = 0; i < 23; ++i) a.in[i] = (const float*)d_in[i];
    a.out = (float*)d_out; a.ws = (unsigned char*)d_ws; a.lo = 0; a.hi = NPH;
    void* kargv[] = {&a};
    hipError_t e = hipLaunchCooperativeKernel((const void*)mega_fwd, dim3(grid), dim3(512), kargv, LDS_BYTES, stream);
    if (e != hipSuccess) fprintf(stderr, "kernel_launch: cooperative launch failed: %s (grid %d)\n", hipGetErrorString(e), grid);
}
```

```cpp
#include <hip/hip_runtime.h>
#include <hip/hip_cooperative_groups.h>
#include <cstdio>
#include <cstdint>
namespace cg = cooperative_groups;
#define otid() ({ int t_ = (int)threadIdx.x; asm volatile("" : "+v"(t_)); t_; })
extern __shared__ __attribute__((aligned(16))) unsigned char g_lds_dyn[];
#define ptid() (*(volatile __attribute__((address_space(3))) int*)((__attribute__((address_space(3))) unsigned char*)g_lds_dyn + 131072 + 1024 + 4 * (int)threadIdx.x))
namespace pg8 {
#define PG8_LAS __attribute__((address_space(3)))
typedef unsigned short bf16_t;
typedef short bf16x8 __attribute__((ext_vector_type(8)));
typedef float f32x4 __attribute__((ext_vector_type(4)));
typedef unsigned u32x4 __attribute__((ext_vector_type(4)));
constexpr int BM = 256, BK = 64, HALF = 128, HTB = HALF * BK * 2  , STAGE_BYTES = 8 * HTB, NXCD = 8, WGM = 8;

__host__ __device__ __forceinline__ int lds_byte(int r, int c) { const int st = (r >> 4) * 2 + (c >> 5), rr = r & 15, cc = c & 31, ob = rr * 64 + cc * 2; return st * 1024 + (ob ^ (((ob >> 9) & 1) << 5)); }
__host__ __device__ __forceinline__ void stage_rc(int b, int& R, int& C) { const int st = b / 1024, sb = b % 1024, swz = sb ^ (((sb >> 9) & 1) << 5); R = (st >> 1) * 16 + swz / 64; C = (st & 1) * 32 + (swz % 64) / 2; }
__host__ __device__ __forceinline__ int perm32(int rho) { const int n = rho >> 4, i = rho & 15; return 8 * (i >> 2) + 4 * n + (i & 3); }

struct Unit { int pm, pn, koff; };
struct Gemm { const bf16_t* A; const bf16_t* Bt; int M, N, K, ld; };

struct StaticOrder {
    int nM, nN, nwg, G, c, mode;
    __host__ __device__ void init(int M, int N, int G_, int c_, int mode_ = 0) { nM = M / BM; nN = N / BM; nwg = nM * nN; G = G_; c = c_; mode = mode_; }
    __host__ __device__ bool next(int i, Unit& u) const {
        const long L = (long)i * G + c; if (L >= nwg) return false;
        int wgid = (int)L; { const int q = nwg / NXCD, r = nwg % NXCD, xcd = wgid % NXCD, off = wgid / NXCD; wgid = (xcd < r ? xcd * (q + 1) : r * (q + 1) + (xcd - r) * q) + off; }
        const int nig = WGM * nN, gid = wgid / nig, fm = gid * WGM, gsz = (nM - fm) < WGM ? (nM - fm) : WGM;
        u.pm = fm + ((wgid % nig) % gsz); u.pn = (wgid % nig) / gsz; u.koff = 0; if (mode == 1) u.pm = (u.pm >> 3) * 9 + 1 + (u.pm & 7); return true;
    }
    __device__ __forceinline__ void a_ready(const Unit&) const {}
    __device__ __forceinline__ void done(const Unit&) const {}
};
struct CtxSplitOrder {
    int G, c, khalf;
    __device__ bool next(int i, Unit& u) const { const int L = i * G + c; if (L >= 64) return false; u.koff = (L & 1) * khalf; u.pn = (L >> 1) & 3; u.pm = (L >> 3) * 9; return true; }
    __device__ __forceinline__ void a_ready(const Unit&) const {}
    __device__ __forceinline__ void done(const Unit&) const {}
};

__device__ __forceinline__ unsigned cvt_pk_bf16(float lo, float hi) { unsigned r; asm volatile("v_cvt_pk_bf16_f32 %0, %1, %2" : "=v"(r) : "v"(lo), "v"(hi)); return r; }
typedef float f32x2 __attribute__((ext_vector_type(2)));
__device__ __forceinline__ f32x2 gelu_pk(f32x2 v) {
    const f32x2 av = __builtin_elementwise_abs(v), d = av * 0.2316418882f + 1.0f;
    f32x2 t; t.x = __builtin_amdgcn_rcpf(d.x); t.y = __builtin_amdgcn_rcpf(d.y);
    f32x2 q = t * 0.5307027145f + (-0.7265760135f); q = q * t + 0.7107068705f; q = q * t + (-0.142248368f); q = q * t + 0.127414796f; q = q * t;
    const f32x2 s = (v * v) * (-0.72134752044f);
    f32x2 e; e.x = __builtin_amdgcn_exp2f(s.x); e.y = __builtin_amdgcn_exp2f(s.y);
    const f32x2 m = v * (q * e), r = v - m;
    f32x2 o; o.x = v.x < 0.f ? m.x : r.x; o.y = v.y < 0.f ? m.y : r.y; return o;
}

template <int ACT  > struct EpiBf16 {
    static constexpr bool PERM = true, AFTER_DRAIN = false; static_assert(ACT == 0 || ACT == 1, "EpiBf16: ACT is 0 (none) or 1 (gelu_pk)");
    bf16_t* O; int ldc; const float* bias; int split_cols; size_t split_stride; float scale0;
    __device__ __forceinline__ void operator()(const f32x4 (&acc)[2][2][4][2], const Unit& u, int wr, int wc, int fr, int fq) const {
        const int row0 = u.pm * BM + wr * 64 + fr; int colt = u.pn * BM; bf16_t* base = O;
        float sc = 1.f; if (split_cols) { const int t = colt / split_cols; base += (size_t)t * split_stride; colt -= t * split_cols; if (t == 0) sc = scale0; }
        const int col0 = colt + wc * 32 + 8 * fq, bcol0 = u.pn * BM + wc * 32 + 8 * fq;
        f32x4 bv[2][2];
#pragma unroll
        for (int bj = 0; bj < 2; ++bj)
#pragma unroll
            for (int n = 0; n < 2; ++n) bv[bj][n] = bias ? *(const f32x4*)(bias + bcol0 + bj * HALF + 4 * n) : (f32x4){0.f, 0.f, 0.f, 0.f};
#pragma unroll
        for (int ai = 0; ai < 2; ++ai)
#pragma unroll
            for (int m = 0; m < 4; ++m) { bf16_t* rowp = base + (size_t)(row0 + ai * HALF + m * 16) * ldc + col0;
#pragma unroll
                for (int bj = 0; bj < 2; ++bj) { f32x4 v0 = acc[ai][bj][m][0] + bv[bj][0], v1 = acc[ai][bj][m][1] + bv[bj][1];
                    if (ACT == 1) { f32x2 a = gelu_pk((f32x2){v0[0], v0[1]}), b = gelu_pk((f32x2){v0[2], v0[3]}), c = gelu_pk((f32x2){v1[0], v1[1]}), d = gelu_pk((f32x2){v1[2], v1[3]});
                        v0 = (f32x4){a.x, a.y, b.x, b.y}; v1 = (f32x4){c.x, c.y, d.x, d.y}; }
                    v0 = v0 * sc; v1 = v1 * sc; u32x4 w; w.x = cvt_pk_bf16(v0[0], v0[1]); w.y = cvt_pk_bf16(v0[2], v0[3]); w.z = cvt_pk_bf16(v1[0], v1[1]); w.w = cvt_pk_bf16(v1[2], v1[3]);
                    *(u32x4*)(rowp + bj * HALF) = w; } }
    }
};
struct EpiResidSplit {
    static constexpr bool PERM = false, AFTER_DRAIN = false;
    float* X; float* T; const float* mod; int goff;
    __device__ __forceinline__ void operator()(const f32x4 (&acc)[2][2][4][2], const Unit& u, int wr, int wc, int fr, int fq) const {
        const float* gp = mod + 8 * 6144 + goff;
        const int col0 = u.pn * BM + wc * 32 + 4 * fq;
        const bool first = (u.koff == 0);
        float* base = first ? X + (size_t)(u.pm * BM) * 1024 : T + (size_t)((u.pm / 9) * BM) * 1024;
#pragma unroll
        for (int bj = 0; bj < 2; ++bj)
#pragma unroll
            for (int n = 0; n < 2; ++n) { const f32x4 gv = *(const f32x4*)(gp + col0 + bj * HALF + n * 16);
#pragma unroll
                for (int ai = 0; ai < 2; ++ai)
#pragma unroll
                    for (int m = 0; m < 4; ++m) { float* p = base + (size_t)(ai * HALF + wr * 64 + m * 16 + fr) * 1024 + col0 + bj * HALF + n * 16;
                        f32x4 v = gv * acc[ai][bj][m][n];
                        if (first) v = v + *(const f32x4*)p;
                        *(f32x4*)p = v; } }
    }
};
struct EpiSwiGLU {
    static constexpr bool PERM = true, AFTER_DRAIN = false;
    bf16_t* O; int ldc;
    __device__ __forceinline__ void operator()(const f32x4 (&acc)[2][2][4][2], const Unit& u, int wr, int wc, int fr, int fq) const {
        const int row0 = u.pm * BM + wr * 64 + fr; const int col0 = u.pn * HALF + wc * 32 + 8 * fq;
#pragma unroll
        for (int ai = 0; ai < 2; ++ai)
#pragma unroll
            for (int m = 0; m < 4; ++m) { bf16_t* rowp = O + (size_t)(row0 + ai * HALF + m * 16) * ldc + col0;
                float h[8];
#pragma unroll
                for (int n = 0; n < 2; ++n)
#pragma unroll
                    for (int i = 0; i < 4; ++i) { const float g = acc[ai][0][m][n][i], up = acc[ai][1][m][n][i];
                        h[n * 4 + i] = g * __builtin_amdgcn_rcpf(1.0f + __expf(-g)) * up; }
                u32x4 w; w.x = cvt_pk_bf16(h[0], h[1]); w.y = cvt_pk_bf16(h[2], h[3]); w.z = cvt_pk_bf16(h[4], h[5]); w.w = cvt_pk_bf16(h[6], h[7]);
                *(u32x4*)rowp = w; }
    }
};
struct EpiResid {
    static constexpr bool PERM = false, AFTER_DRAIN = false;
    float* X; const float* mod; int goff;
    __device__ __forceinline__ void operator()(const f32x4 (&acc)[2][2][4][2], const Unit& u, int wr, int wc, int fr, int fq) const {
        const int widx = (u.pm % 9 == 0) ? 8 : (u.pm / 9);
        const float* gp = mod + widx * 6144 + goff;
        const int col0 = u.pn * BM + wc * 32 + 4 * fq;
#pragma unroll
        for (int bj = 0; bj < 2; ++bj)
#pragma unroll
            for (int n = 0; n < 2; ++n) { const f32x4 gv = *(const f32x4*)(gp + col0 + bj * HALF + n * 16);
#pragma unroll
                for (int ai = 0; ai < 2; ++ai)
#pragma unroll
                    for (int m = 0; m < 4; ++m) { float* p = X + (size_t)(u.pm * BM + ai * HALF + wr * 64 + m * 16 + fr) * 1024 + col0 + bj * HALF + n * 16;
                        f32x4 x = *(const f32x4*)p; x = x + gv * acc[ai][bj][m][n]; *(f32x4*)p = x; } }
    }
};
template <class Epi, class Sched, bool ALIGN_EPI = false, bool SP2 = false>
__device__ __forceinline__ void gemm_phase(PG8_LAS unsigned char* lds, const Gemm g, const Sched& S, const Epi& E) {
    const int tid = otid(), wid = __builtin_amdgcn_readfirstlane(tid >> 6), lane = tid & 63, wr = wid >> 2, wc = wid & 3, fr = lane & 15, fq = lane >> 4;
    const int K = g.ld, nt = g.K / BK;
    unsigned voffA[2], voffB[2];
#pragma unroll
    for (int i = 0; i < 2; ++i) { int R, C; stage_rc(tid * 16 + i * 8192, R, C); const int Rb = Epi::PERM ? ((R & ~31) + perm32(R & 31)) : R;
        voffA[i] = (unsigned)(R * K + C) * 2u; voffB[i] = (unsigned)(Rb * K + C) * 2u; }
    const size_t kstep = (size_t)(BK * 2);
    const size_t hstep = (size_t)HALF * K * 2;
    const size_t tstep = 2 * hstep;
    const unsigned ldsw = (unsigned)wid * 1024u;
    const int aoff = lds_byte(wr * 64 + fr, fq * 8), boff = lds_byte(wc * 32 + fr, fq * 8);
#define PG8_SA(b, h) (((b) * 2 + (h)) * HTB)
#define PG8_SB(b, h) ((4 + (b) * 2 + (h)) * HTB)
#define PG8_STAGE(bufoff, gbase, voff) do { _Pragma("unroll") for (int _i = 0; _i < 2; ++_i) \
        __builtin_amdgcn_global_load_lds((const unsigned*)((const char*)(gbase) + (voff)[_i]), (PG8_LAS unsigned*)(lds + (bufoff) + ldsw + _i * 8192), 16, 0, 0); } while (0)
#define PG8_LDA(dst, b, h) do { _Pragma("unroll") for (int m = 0; m < 4; ++m) _Pragma("unroll") for (int k = 0; k < 2; ++k) dst[m][k] = *(const PG8_LAS bf16x8*)(lds + PG8_SA(b, h) + aoff + m * 2048 + k * 1024); } while (0)
#define PG8_LDB(dst, b, h) do { _Pragma("unroll") for (int n = 0; n < 2; ++n) _Pragma("unroll") for (int k = 0; k < 2; ++k) dst[n][k] = *(const PG8_LAS bf16x8*)(lds + PG8_SB(b, h) + boff + n * 2048 + k * 1024); } while (0)
#define PG8_MMA(ai, bj, At, Bt) do { __builtin_amdgcn_s_setprio(1); _Pragma("unroll") for (int m = 0; m < 4; ++m) _Pragma("unroll") for (int n = 0; n < 2; ++n) _Pragma("unroll") for (int k = 0; k < 2; ++k) \
        acc[ai][bj][m][n] = __builtin_amdgcn_mfma_f32_16x16x32_bf16(Bt[n][k], At[m][k], acc[ai][bj][m][n], 0, 0, 0); __builtin_amdgcn_s_setprio(0); } while (0)
#define PG8_WAIT_V(n) asm volatile("s_waitcnt vmcnt(" #n ")" ::: "memory")
#define PG8_WAIT_L(n) asm volatile("s_waitcnt lgkmcnt(" #n ")" ::: "memory")
#define PG8_BAR __builtin_amdgcn_s_barrier()
#define PG8_SCHED __builtin_amdgcn_sched_barrier(0)
    Unit cur, nxt; int ui = 0;
    if (!S.next(0, cur)) return;
    f32x4 acc[2][2][4][2];
#pragma unroll
    for (int a = 0; a < 2; ++a)
#pragma unroll
        for (int b = 0; b < 2; ++b)
#pragma unroll
            for (int m = 0; m < 4; ++m)
#pragma unroll
                for (int n = 0; n < 2; ++n) acc[a][b][m][n] = (f32x4){0.f, 0.f, 0.f, 0.f};
    bf16x8 At[4][2], B0[2][2], B1[2][2];
    const char* cA = (const char*)g.A + (size_t)cur.pm * tstep + (size_t)cur.koff * 2; const char* cB = (const char*)g.Bt + (size_t)cur.pn * tstep + (size_t)cur.koff * 2;
    S.a_ready(cur);
    if constexpr (SP2) {
        PG8_STAGE(PG8_SB(0, 0), cB, voffB); PG8_STAGE(PG8_SB(0, 1), cB + hstep, voffB); PG8_STAGE(PG8_SA(0, 0), cA, voffA); PG8_STAGE(PG8_SA(0, 1), cA + hstep, voffA);
        if (wr == 1) PG8_BAR;
        PG8_WAIT_V(2); PG8_BAR;
        PG8_STAGE(PG8_SB(1, 0), cB + kstep, voffB); PG8_STAGE(PG8_SA(1, 0), cA + kstep, voffA); PG8_STAGE(PG8_SB(1, 1), cB + hstep + kstep, voffB);
        PG8_WAIT_V(6); PG8_BAR;
    } else {
        PG8_STAGE(PG8_SB(0, 0), cB, voffB); PG8_STAGE(PG8_SA(0, 0), cA, voffA); PG8_STAGE(PG8_SB(0, 1), cB + hstep, voffB); PG8_STAGE(PG8_SA(0, 1), cA + hstep, voffA);
        if (wr == 1) PG8_BAR;
        PG8_WAIT_V(4); PG8_BAR;
        PG8_STAGE(PG8_SB(1, 0), cB + kstep, voffB); PG8_STAGE(PG8_SA(1, 0), cA + kstep, voffA); PG8_STAGE(PG8_SB(1, 1), cB + hstep + kstep, voffB);
        PG8_WAIT_V(6); PG8_BAR;
    }
    for (;;) {
        const bool has_next = S.next(ui + 1, nxt);
        const char* nA = has_next ? (const char*)g.A + (size_t)nxt.pm * tstep + (size_t)nxt.koff * 2 : cA; const char* nB = has_next ? (const char*)g.Bt + (size_t)nxt.pn * tstep + (size_t)nxt.koff * 2 : cB;
        for (int t = 0; t < nt; t += 2) {
            const bool last = (t == nt - 2);
            const char* a1 = cA + (size_t)(t + 1) * kstep;
            const char* a2 = last ? nA : cA + (size_t)(t + 2) * kstep; const char* b2 = last ? nB : cB + (size_t)(t + 2) * kstep;
            const char* a3 = a2 + kstep; const char* b3 = b2 + kstep;
            if (last && has_next) S.a_ready(nxt);
            if constexpr (SP2) {
            PG8_LDB(B0, 0, 0); PG8_LDB(B1, 0, 1); PG8_SCHED; PG8_LDA(At, 0, 0); PG8_STAGE(PG8_SA(1, 1), a1 + hstep, voffA);
            PG8_WAIT_V(8); PG8_WAIT_L(0); PG8_BAR; PG8_MMA(0, 0, At, B0); PG8_MMA(0, 1, At, B1); PG8_BAR; PG8_SCHED;
            PG8_LDA(At, 0, 1); PG8_STAGE(PG8_SB(0, 0), b2, voffB); PG8_STAGE(PG8_SB(0, 1), b2 + hstep, voffB); PG8_STAGE(PG8_SA(0, 0), a2, voffA);
            PG8_WAIT_V(8); PG8_WAIT_L(0); PG8_BAR; PG8_MMA(1, 0, At, B0); PG8_MMA(1, 1, At, B1); PG8_BAR; PG8_SCHED;
            PG8_LDB(B0, 1, 0); PG8_LDB(B1, 1, 1); PG8_SCHED; PG8_LDA(At, 1, 0); PG8_STAGE(PG8_SA(0, 1), a2 + hstep, voffA);
            PG8_WAIT_V(8); PG8_WAIT_L(0); PG8_BAR; PG8_MMA(0, 0, At, B0); PG8_MMA(0, 1, At, B1); PG8_BAR; PG8_SCHED;
            PG8_LDA(At, 1, 1); PG8_STAGE(PG8_SB(1, 0), b3, voffB); PG8_STAGE(PG8_SB(1, 1), b3 + hstep, voffB); PG8_STAGE(PG8_SA(1, 0), a3, voffA);
            PG8_WAIT_V(8); PG8_WAIT_L(0); PG8_BAR; PG8_MMA(1, 0, At, B0); PG8_MMA(1, 1, At, B1); PG8_BAR; PG8_SCHED;
            } else {
            PG8_LDB(B0, 0, 0); PG8_SCHED; PG8_LDA(At, 0, 0); PG8_STAGE(PG8_SA(1, 1), a1 + hstep, voffA);
            PG8_WAIT_L(8); PG8_BAR; PG8_WAIT_L(0); PG8_MMA(0, 0, At, B0); PG8_BAR; PG8_SCHED;
            PG8_LDB(B1, 0, 1); PG8_STAGE(PG8_SB(0, 0), b2, voffB);
            PG8_BAR; PG8_WAIT_L(0); PG8_MMA(0, 1, At, B1); PG8_BAR;
            PG8_LDA(At, 0, 1); PG8_STAGE(PG8_SA(0, 0), a2, voffA);
            PG8_BAR; PG8_WAIT_L(0); PG8_MMA(1, 0, At, B0); PG8_BAR; PG8_SCHED;
            PG8_STAGE(PG8_SB(0, 1), b2 + hstep, voffB);
            PG8_WAIT_V(6); PG8_BAR; PG8_MMA(1, 1, At, B1); PG8_BAR;
            PG8_LDB(B0, 1, 0); PG8_SCHED; PG8_LDA(At, 1, 0); PG8_STAGE(PG8_SA(0, 1), a2 + hstep, voffA);
            PG8_WAIT_L(8); PG8_BAR; PG8_WAIT_L(0); PG8_MMA(0, 0, At, B0); PG8_BAR; PG8_SCHED;
            PG8_LDB(B1, 1, 1); PG8_STAGE(PG8_SB(1, 0), b3, voffB);
            PG8_BAR; PG8_WAIT_L(0); PG8_MMA(0, 1, At, B1); PG8_BAR;
            PG8_LDA(At, 1, 1); PG8_STAGE(PG8_SA(1, 0), a3, voffA);
            PG8_BAR; PG8_WAIT_L(0); PG8_MMA(1, 0, At, B0); PG8_BAR; PG8_SCHED;
            PG8_STAGE(PG8_SB(1, 1), b3 + hstep, voffB);
            PG8_WAIT_V(6); PG8_BAR; PG8_MMA(1, 1, At, B1); PG8_BAR;
            }
        }
        if constexpr (ALIGN_EPI) { if (wr == 0) PG8_BAR; }
        if constexpr (!Epi::AFTER_DRAIN) { E(acc, cur, wr, wc, fr, fq); S.done(cur); }
        if (!has_next) break;
#pragma unroll
        for (int a = 0; a < 2; ++a)
#pragma unroll
            for (int b = 0; b < 2; ++b)
#pragma unroll
                for (int m = 0; m < 4; ++m)
#pragma unroll
                    for (int n = 0; n < 2; ++n) acc[a][b][m][n] = (f32x4){0.f, 0.f, 0.f, 0.f};
        cur = nxt; cA = nA; cB = nB; ++ui;
        if constexpr (ALIGN_EPI) { if (wr == 1) PG8_BAR; }
    }
    PG8_WAIT_V(0);
    if constexpr (!ALIGN_EPI) { if (wr == 0) PG8_BAR; }
    PG8_BAR;
    if constexpr (Epi::AFTER_DRAIN) { E.fused(acc, cur, wr, wc, fr, fq, lds, wid, lane); S.done(cur); }
#undef PG8_SA
#undef PG8_SB
#undef PG8_STAGE
#undef PG8_LDA
#undef PG8_LDB
#undef PG8_MMA
#undef PG8_WAIT_V
#undef PG8_WAIT_L
#undef PG8_BAR
#undef PG8_SCHED
}
}

typedef unsigned short bf16;
typedef short bf16x8 __attribute__((ext_vector_type(8)));
typedef short s16x4 __attribute__((ext_vector_type(4)));
typedef float f32x4 __attribute__((ext_vector_type(4)));
typedef float f32x16 __attribute__((ext_vector_type(16)));
typedef unsigned u32x4 __attribute__((ext_vector_type(4)));
typedef unsigned u32x2 __attribute__((ext_vector_type(2)));
#define LAS __attribute__((address_space(3)))

constexpr int NB = 8, TPB = 2304, MT = NB * TPB, DM = 1024, NLAT = 2048;
constexpr int NP_E = 3328, NP_O = 3072, FF = 2816;
constexpr float EPSN = 1e-6f;
constexpr size_t MiB = 1u << 20;
constexpr size_t WS_CTL = 0, WS_MOD = 1 * MiB, WS_X = 2 * MiB, WS_H = 74 * MiB, WS_MIX = 110 * MiB, WS_P = 146 * MiB, WS_W = 263 * MiB,
                 WS_OSC = 290 * MiB, WS_KR = 326 * MiB, WS_U = 328 * MiB, WS_T = 342 * MiB, WS_END = 350 * MiB;
constexpr size_t WS_LSUM = 128 * 1024;
constexpr size_t WS_CQN = WS_MIX, WS_CKVN = WS_MIX + 14 * MiB, WS_DSCR = WS_H;
constexpr size_t W_IN = 0, W_OUT = 13 * MiB / 2, W_GU = 17 * MiB / 2, W_DN = 39 * MiB / 2, W_UQ = 25 * MiB, W_UKV = 25 * MiB + 768 * 1024;
constexpr size_t OUT_KV = 0, OUT_Q = 36 * MiB;
constexpr int LDS_MAIN = 131072, LDS_BYTES = LDS_MAIN + 1024 + 2048;

struct Args { const float* in[23]; float* out; unsigned char* ws; int lo, hi; };
typedef __attribute__((address_space(4))) const Args* KArgP;
__device__ __forceinline__ KArgP kargs() { KArgP p = (KArgP)__builtin_amdgcn_kernarg_segment_ptr(); asm volatile("" : "+s"(p)); return p; }

__device__ __forceinline__ float bf2f(unsigned short h) { return __uint_as_float((unsigned)h << 16); }
__device__ __forceinline__ unsigned f2bf(float f) { unsigned u = __float_as_uint(f); return (u + 0x7fffu + ((u >> 16) & 1u)) >> 16; }
__device__ __forceinline__ unsigned pk2(float lo, float hi) { return f2bf(lo) | (f2bf(hi) << 16); }
__device__ __forceinline__ float wave_sum(float v) {
#pragma unroll
    for (int o = 1; o < 64; o <<= 1) v += __shfl_xor(v, o);
    return v;
}
__device__ __forceinline__ float silu_f(float g) { return g / (1.0f + __expf(-g)); }
__device__ __forceinline__ void sincos_r(float ang, float& s, float& c) {
    float r = ang * 0.15915494309189535f; r = r - __builtin_floorf(r);
    s = __builtin_amdgcn_sinf(r); c = __builtin_amdgcn_cosf(r);
}
__device__ __forceinline__ float inv_freq(int i, int half) { return __builtin_amdgcn_exp2f(-(float)i / (float)half * 13.287712379549449f); }

__device__ __forceinline__ void phase_prep(KArgP a, LAS unsigned char* lds) {
    const int tid = otid(), G = gridDim.x;
    if (blockIdx.x == 0) { if (tid < 64) ((unsigned*)(a->ws + WS_CTL))[tid] = 0u; for (int i = tid; i < 3456; i += 512) ((unsigned*)(a->ws + WS_CTL))[4096 + i] = 0u; }
    float* MOD = (float*)(a->ws + WS_MOD);
    LAS float* S = (LAS float*)lds;
    LAS float* R = S + 1024 * 12;
    for (int item = blockIdx.x; item < 192; item += G) {
        const int l = item / 48, n0 = (item % 48) * 128;
        for (int i = tid; i < 9 * 1024; i += 512) { const int w = i >> 10, k = i & 1023; const float v = (w < 8) ? a->in[1][w * 1024 + k] : a->in[3][k]; S[k * 12 + w] = silu_f(v); }
        __syncthreads();
        const int nl = tid & 127, kp = tid >> 7;
        float acc[9];
#pragma unroll
        for (int w = 0; w < 9; ++w) acc[w] = 0.f;
        const float* wp = a->in[4] + (size_t)l * 1024 * 6144 + n0 + nl;
#pragma unroll 16
        for (int k = kp * 256; k < kp * 256 + 256; ++k) {
            const float wv = wp[(size_t)k * 6144];
            const f32x4 s0 = *(const LAS f32x4*)(S + k * 12), s1 = *(const LAS f32x4*)(S + k * 12 + 4); const float s8 = S[k * 12 + 8];
            acc[0] += wv * s0[0]; acc[1] += wv * s0[1]; acc[2] += wv * s0[2]; acc[3] += wv * s0[3];
            acc[4] += wv * s1[0]; acc[5] += wv * s1[1]; acc[6] += wv * s1[2]; acc[7] += wv * s1[3]; acc[8] += wv * s8;
        }
#pragma unroll
        for (int w = 0; w < 9; ++w) R[(kp * 9 + w) * 128 + nl] = acc[w];
        __syncthreads();
        for (int i = tid; i < 9 * 128; i += 512) { const int w = i >> 7, n2 = i & 127;
            const float v = R[(0 * 9 + w) * 128 + n2] + R[(1 * 9 + w) * 128 + n2] + R[(2 * 9 + w) * 128 + n2] + R[(3 * 9 + w) * 128 + n2] + a->in[5][l * 6144 + n0 + n2];
            MOD[(size_t)(l * 9 + w) * 6144 + n0 + n2] = v; }
        __syncthreads();
    }
    f32x4* X4 = (f32x4*)(a->ws + WS_X);
    const size_t total = (size_t)MT * 256, stride = (size_t)G * 512;
    for (size_t i0 = (size_t)blockIdx.x * 512 + tid; i0 < total; i0 += 8 * stride) {
        f32x4 v[8];
#pragma unroll
        for (int u = 0; u < 8; ++u) { const size_t i = i0 + u * stride; if (i < total) {
            const int row = (int)(i >> 8), c4 = (int)(i & 255); const int b = row / TPB, j = row - b * TPB;
            v[u] = (j < 256) ? ((const f32x4*)a->in[2])[(size_t)(b * 256 + j) * 256 + c4] : ((const f32x4*)a->in[0])[(size_t)(b * NLAT + (j - 256)) * 256 + c4]; } }
#pragma unroll
        for (int u = 0; u < 8; ++u) { const size_t i = i0 + u * stride; if (i < total) X4[i] = v[u]; }
    }
}

__device__ __forceinline__ void transpose_item(const float* W, int K, int N, bf16* WT, int k0, int n0, int drow0, LAS float* scr, int lane) {
#pragma unroll 8
    for (int i = 0; i < 32; ++i) { const int kk = 2 * i + (lane >> 5); scr[kk * 33 + (lane & 31)] = W[(size_t)(k0 + kk) * N + n0 + (lane & 31)]; }
    asm volatile("s_waitcnt lgkmcnt(0)" ::: "memory");
    const int c = lane & 7;
#pragma unroll
    for (int j = 0; j < 4; ++j) { const int n = (lane >> 3) + 8 * j; const LAS float* s = scr + (8 * c) * 33 + n;
        u32x4 o; o.x = pk2(s[0 * 33], s[1 * 33]); o.y = pk2(s[2 * 33], s[3 * 33]); o.z = pk2(s[4 * 33], s[5 * 33]); o.w = pk2(s[6 * 33], s[7 * 33]);
        *(u32x4*)(WT + (size_t)(drow0 + n) * K + k0 + 8 * c) = o; }
    asm volatile("s_waitcnt lgkmcnt(0)" ::: "memory");
}
__device__ __forceinline__ void convert_weights(KArgP a, int layer, LAS unsigned char* lds) {
    const int lane = otid() & 63, wave = otid() >> 6;
    LAS float* scr = (LAS float*)(lds + wave * 8448);
    const int gw = blockIdx.x * 8 + wave, NGW = gridDim.x * 8;
    const bool even = !(layer & 1); const int e = layer >> 1;
    const int nin = even ? 3232 : 3072;
    const float* w_in = even ? a->in[11] + (size_t)e * 1024 * 3232 : a->in[18] + (size_t)e * 1024 * 3072;
    unsigned char* Wb = a->ws + WS_W;
    const int nbin = nin / 32;
    const int I_IN = 16 * nbin, I_OUT = 512, I_G = 16 * 88, I_D = 44 * 32, I_UQ = even ? 6 * 24 : 0, I_UKV = even ? 4 * 32 : 0;
    const int NIT = I_IN + I_OUT + 2 * I_G + I_D + I_UQ + I_UKV;
    for (int it = gw; it < NIT; it += NGW) {
        int r = it;
        if (r < I_IN) { const int kb = r / nbin, nb = r % nbin; transpose_item(w_in, 1024, nin, (bf16*)(Wb + W_IN), 64 * kb, 32 * nb, 32 * nb, scr, lane); continue; } r -= I_IN;
        if (r < I_OUT) { const int kb = r / 32, nb = r % 32; transpose_item(a->in[7] + (size_t)layer * 1024 * 1024, 1024, 1024, (bf16*)(Wb + W_OUT), 64 * kb, 32 * nb, 32 * nb, scr, lane); continue; } r -= I_OUT;
        if (r < I_G) { const int kb = r / 88, nb = r % 88, n0 = 32 * nb; transpose_item(a->in[8] + (size_t)layer * 1024 * FF, 1024, FF, (bf16*)(Wb + W_GU), 64 * kb, n0, (n0 >> 7) * 256 + (n0 & 127), scr, lane); continue; } r -= I_G;
        if (r < I_G) { const int kb = r / 88, nb = r % 88, n0 = 32 * nb; transpose_item(a->in[9] + (size_t)layer * 1024 * FF, 1024, FF, (bf16*)(Wb + W_GU), 64 * kb, n0, (n0 >> 7) * 256 + 128 + (n0 & 127), scr, lane); continue; } r -= I_G;
        if (r < I_D) { const int kb = r / 32, nb = r % 32; transpose_item(a->in[10] + (size_t)layer * FF * 1024, FF, 1024, (bf16*)(Wb + W_DN), 64 * kb, 32 * nb, 32 * nb, scr, lane); continue; } r -= I_D;
        if (r < I_UQ) { const int kb = r / 24, nb = r % 24; transpose_item(a->in[15] + (size_t)e * 384 * 768, 384, 768, (bf16*)(Wb + W_UQ), 64 * kb, 32 * nb, 32 * nb, scr, lane); continue; } r -= I_UQ;
        { const int kb = r / 32, nb = r % 32; transpose_item(a->in[17] + (size_t)e * 256 * 1024, 256, 1024, (bf16*)(Wb + W_UKV), 64 * kb, 32 * nb, 32 * nb, scr, lane); }
    }
}

__device__ __forceinline__ void phase_norm(KArgP a, int layer, int which, bool addT) {
    const int lane = otid() & 63, wave = otid() >> 6;
    const int gw = blockIdx.x * 8 + wave, NGW = gridDim.x * 8;
    float* X = (float*)(a->ws + WS_X); bf16* H = (bf16*)(a->ws + WS_H); const float* T = (const float*)(a->ws + WS_T);
    const float* g = a->in[6] + (layer * 2 + which) * 1024;
    const float* mod = (const float*)(a->ws + WS_MOD) + (size_t)layer * 9 * 6144;
    const int shoff = which ? 3072 : 0, scoff = which ? 4096 : 1024;
    constexpr int RB = 3;
    for (int r0 = gw; r0 < MT; r0 += RB * NGW) {
        f32x4 v[RB][4];
#pragma unroll
        for (int k = 0; k < RB; ++k) { const int row = r0 + k * NGW; if (row < MT) { const f32x4* xr = (const f32x4*)(X + (size_t)row * 1024) + lane;
#pragma unroll
            for (int q = 0; q < 4; ++q) v[k][q] = xr[64 * q]; } }
#pragma unroll
        for (int k = 0; k < RB; ++k) { const int row = r0 + k * NGW; if (row < MT) {
            const int b = row / TPB, j = row - b * TPB, widx = (j < 256) ? 8 : b;
            if (addT && j < 256) { const f32x4* tr = (const f32x4*)(T + (size_t)(b * 256 + j) * 1024) + lane; f32x4* xr = (f32x4*)(X + (size_t)row * 1024) + lane;
#pragma unroll
                for (int q = 0; q < 4; ++q) { v[k][q] = v[k][q] + tr[64 * q]; xr[64 * q] = v[k][q]; } }
            float ss = 0.f;
#pragma unroll
            for (int q = 0; q < 4; ++q) ss += (v[k][q][0] * v[k][q][0] + v[k][q][1] * v[k][q][1]) + (v[k][q][2] * v[k][q][2] + v[k][q][3] * v[k][q][3]);
            const float rstd = __builtin_amdgcn_rsqf(wave_sum(ss) * (1.f / 1024.f) + EPSN);
#pragma unroll
            for (int q = 0; q < 4; ++q) { const int col = 4 * lane + 256 * q;
                const f32x4 gv = *(const f32x4*)(g + col), sc = *(const f32x4*)(mod + widx * 6144 + scoff + col), sh = *(const f32x4*)(mod + widx * 6144 + shoff + col);
                f32x4 y = v[k][q] * rstd * gv * (sc + 1.0f) + sh;
                u32x2 w; w.x = pk2(y[0], y[1]); w.y = pk2(y[2], y[3]);
                *(u32x2*)(H + (size_t)row * 1024 + col) = w; } } }
    }
}

__device__ __forceinline__ void phase_post_even(KArgP a, int layer) {
    const int lane = otid() & 63, wave = otid() >> 6;
    const int gw = blockIdx.x * 8 + wave, NGW = gridDim.x * 8, e = layer >> 1;
    const bf16* P = (const bf16*)(a->ws + WS_P); bf16* CQN = (bf16*)(a->ws + WS_CQN); bf16* CKVN = (bf16*)(a->ws + WS_CKVN); bf16* KR = (bf16*)(a->ws + WS_KR);
    const float* qg = a->in[14] + e * 384; const float* kg = a->in[16] + e * 256;
    for (int row = gw; row < MT; row += NGW) {
        const int b = row / TPB, j = row - b * TPB;
        const bf16* pr = P + (size_t)row * NP_E;
        {   float x[6]; float ss = 0.f;
#pragma unroll
            for (int k = 0; k < 3; ++k) { const unsigned w = *(const unsigned*)(pr + 2560 + 2 * lane + 128 * k); x[2 * k] = bf2f((unsigned short)(w & 0xffff)); x[2 * k + 1] = bf2f((unsigned short)(w >> 16)); ss += x[2 * k] * x[2 * k] + x[2 * k + 1] * x[2 * k + 1]; }
            const float rstd = __builtin_amdgcn_rsqf(wave_sum(ss) * (1.f / 384.f) + EPSN);
#pragma unroll
            for (int k = 0; k < 3; ++k) { const int col = 2 * lane + 128 * k; *(unsigned*)(CQN + (size_t)row * 384 + col) = pk2(x[2 * k] * rstd * qg[col], x[2 * k + 1] * rstd * qg[col + 1]); } }
        {   float x[4]; float ss = 0.f;
#pragma unroll
            for (int k = 0; k < 2; ++k) { const unsigned w = *(const unsigned*)(pr + 2944 + 2 * lane + 128 * k); x[2 * k] = bf2f((unsigned short)(w & 0xffff)); x[2 * k + 1] = bf2f((unsigned short)(w >> 16)); ss += x[2 * k] * x[2 * k] + x[2 * k + 1] * x[2 * k + 1]; }
            const float rstd = __builtin_amdgcn_rsqf(wave_sum(ss) * (1.f / 256.f) + EPSN);
#pragma unroll
            for (int k = 0; k < 2; ++k) { const int col = 2 * lane + 128 * k; *(unsigned*)(CKVN + (size_t)row * 256 + col) = pk2(x[2 * k] * rstd * kg[col], x[2 * k + 1] * rstd * kg[col + 1]); } }
        {   const int d = lane & 31; const float x = bf2f(pr[3200 + d]); const float xp = __shfl_xor(x, 8);
            float o = x;
            if (j >= 256) { const int t = j - 256, blk = d >> 4, wi = d & 15, i8 = wi & 7; const float pos = (float)(blk ? (t & 63) : (t >> 6));
                float s, c; sincos_r(pos * inv_freq(i8, 8), s, c);
                o = (wi < 8) ? (x * c - xp * s) : (xp * s + x * c); }
            if (lane < 32) KR[(size_t)row * 32 + d] = (bf16)f2bf(o); }
    }
}
__device__ __forceinline__ void phase_post_odd(KArgP a, int layer) {
    const int lane = otid() & 63, wave = otid() >> 6;
    const int gw = blockIdx.x * 8 + wave, NGW = gridDim.x * 8;
    bf16* P = (bf16*)(a->ws + WS_P);
    for (int row = gw; row < MT; row += NGW) {
        const int b = row / TPB, j = row - b * TPB; const bool lat = j >= 256; const int t = j - 256;
        bf16* pr = P + (size_t)row * NP_O;
#pragma unroll
        for (int u = 0; u < 2; ++u) { const int pid = lane + 64 * u, h = pid >> 5, i = pid & 31, d1 = h * 64 + i, d2 = d1 + 32;
            float s = 0.f, c = 1.f; if (lat) sincos_r((float)t * inv_freq(i, 32), s, c);
            const float q1 = bf2f(pr[d1]), q2 = bf2f(pr[d2]), k1 = bf2f(pr[256 + d1]) * 0.125f, k2 = bf2f(pr[256 + d2]) * 0.125f;
            if (lat) { pr[d1] = (bf16)f2bf(q1 * c - q2 * s); pr[d2] = (bf16)f2bf(q1 * s + q2 * c); }
            pr[256 + d1] = (bf16)f2bf(k1 * c - k2 * s); pr[256 + d2] = (bf16)f2bf(k1 * s + k2 * c); }
        if (lat) {
#pragma unroll
            for (int u = 0; u < 4; ++u) { const int pid = lane + 64 * u, vec = pid >> 5, pp = pid & 31, blk = pp >> 4, i = pp & 15, d1 = vec * 64 + blk * 32 + i, d2 = d1 + 16;
                const float pos = (float)(blk ? (t & 63) : (t >> 6)); float s, c; sincos_r(pos * inv_freq(i, 16), s, c);
                const float q1 = bf2f(pr[1536 + d1]), q2 = bf2f(pr[1536 + d2]), k1 = bf2f(pr[2048 + d1]), k2 = bf2f(pr[2048 + d2]);
                pr[1536 + d1] = (bf16)f2bf(q1 * c - q2 * s); pr[1536 + d2] = (bf16)f2bf(q1 * s + q2 * c);
                pr[2048 + d1] = (bf16)f2bf(k1 * c - k2 * s); pr[2048 + d2] = (bf16)f2bf(k1 * s + k2 * c); } }
    }
}

__device__ __forceinline__ void phase_readout(KArgP a, int layer) {
    const int lane = otid() & 63, wave = otid() >> 6;
    const int gw = blockIdx.x * 8 + wave, NGW = gridDim.x * 8;
    const bool even = !(layer & 1); const int np = even ? NP_E : NP_O, gcol = even ? 2048 : 1024;
    const bf16* P = (const bf16*)(a->ws + WS_P); const bf16* OF = (const bf16*)(a->ws + WS_OSC); const bf16* OB = OF + (size_t)MT * 512;
    bf16* MIX = (bf16*)(a->ws + WS_MIX);
    float g0 = 1.f, g1 = 1.f; if (even) { g0 = a->in[13][(layer >> 1) * 128 + 2 * lane]; g1 = a->in[13][(layer >> 1) * 128 + 2 * lane + 1]; }
    constexpr int RB = 3;
    for (int r0 = gw; r0 < MT; r0 += RB * NGW) {
        unsigned wf[RB][4], wb[RB][4], wg[RB][4];
#pragma unroll
        for (int k = 0; k < RB; ++k) { const int row = r0 + k * NGW; if (row < MT) {
#pragma unroll
            for (int h = 0; h < 4; ++h) { const int col = h * 128 + 2 * lane;
                wf[k][h] = *(const unsigned*)(OF + (size_t)row * 512 + col); wb[k][h] = *(const unsigned*)(OB + (size_t)row * 512 + col); wg[k][h] = *(const unsigned*)(P + (size_t)row * np + gcol + col); } } }
#pragma unroll
        for (int k = 0; k < RB; ++k) { const int row = r0 + k * NGW; if (row < MT) {
#pragma unroll
            for (int h = 0; h < 4; ++h) { const int col = h * 128 + 2 * lane;
                const float o0 = bf2f((unsigned short)(wf[k][h] & 0xffff)) + bf2f((unsigned short)(wb[k][h] & 0xffff)), o1 = bf2f((unsigned short)(wf[k][h] >> 16)) + bf2f((unsigned short)(wb[k][h] >> 16));
                const float rstd = __builtin_amdgcn_rsqf(wave_sum(o0 * o0 + o1 * o1) * (1.f / 128.f) + EPSN);
                const float y0 = o0 * rstd * g0 * silu_f(bf2f((unsigned short)(wg[k][h] & 0xffff))), y1 = o1 * rstd * g1 * silu_f(bf2f((unsigned short)(wg[k][h] >> 16)));
                *(unsigned*)(MIX + (size_t)row * 1024 + col) = pk2(y0, y1); } } }
    }
}
__device__ __forceinline__ void phase_final(KArgP a) {
    const int lane = otid() & 63, wave = otid() >> 6;
    const int gw = blockIdx.x * 8 + wave, NGW = gridDim.x * 8;
    const float* X = (const float*)(a->ws + WS_X); const float* g = a->in[22];
    constexpr int RB = 4;
    for (int r0 = gw; r0 < NB * NLAT; r0 += RB * NGW) {
        f32x4 v[RB][4];
#pragma unroll
        for (int k = 0; k < RB; ++k) { const int r = r0 + k * NGW; if (r < NB * NLAT) { const int row = (r >> 11) * TPB + 256 + (r & 2047); const f32x4* xr = (const f32x4*)(X + (size_t)row * 1024) + lane;
#pragma unroll
            for (int q = 0; q < 4; ++q) v[k][q] = xr[64 * q]; } }
#pragma unroll
        for (int k = 0; k < RB; ++k) { const int r = r0 + k * NGW; if (r < NB * NLAT) { float ss = 0.f;
#pragma unroll
            for (int q = 0; q < 4; ++q) ss += (v[k][q][0] * v[k][q][0] + v[k][q][1] * v[k][q][1]) + (v[k][q][2] * v[k][q][2] + v[k][q][3] * v[k][q][3]);
            const float rstd = __builtin_amdgcn_rsqf(wave_sum(ss) * (1.f / 1024.f) + EPSN);
#pragma unroll
            for (int q = 0; q < 4; ++q) { const int col = 4 * lane + 256 * q; const f32x4 gv = *(const f32x4*)(g + col);
                *(f32x4*)(a->out + (size_t)r * 1024 + col) = v[k][q] * rstd * gv; } } }
    }
}
__device__ __forceinline__ unsigned cvtpk2(float lo, float hi) { unsigned r; asm("v_cvt_pk_bf16_f32 %0, %1, %2" : "=v"(r) : "v"(lo), "v"(hi)); return r; }
__device__ __forceinline__ f32x4 mfma16(bf16x8 a, bf16x8 b, f32x4 c) { return __builtin_amdgcn_mfma_f32_16x16x32_bf16(a, b, c, 0, 0, 0); }

template <int DK, bool HG, int MODE>
__device__ __forceinline__ void scan_item(KArgP a, int layer, int item, int seg, LAS unsigned char* lds) {
    const int tid = otid(), wid = tid >> 6, lane = tid & 63, l15 = lane & 15, q4 = lane >> 4;
    const int h = item & 3, dir = (item >> 2) & 1, b = item >> 3;
    constexpr int TPT = DK / 8, QS = DK * 2 + 16, TS = 144;
    constexpr int NP = HG ? NP_E : NP_O;
    LAS unsigned char* Lqt = lds; LAS unsigned char* Lkt = Lqt + 64 * QS; LAS unsigned char* Lqh = Lkt + 64 * QS;
    LAS unsigned char* LkhT = Lqh + 64 * QS; LAS unsigned char* LvT = LkhT + DK * TS; LAS unsigned char* Latt = LvT + 128 * TS;
    LAS float* Ltot = (LAS float*)(Latt + 64 * TS); LAS float* Lbl = Ltot + 512;
    const bf16* P = (const bf16*)(a->ws + WS_P);
    bf16* OSC = (bf16*)(a->ws + WS_OSC) + (size_t)dir * MT * 512;
    f32x4* Ub = (f32x4*)(a->ws + WS_U); float* Lb = (float*)(a->ws + WS_LSUM);
    const int c = tid & (DK - 1), tq = tid / DK;
    float lb = 0.f, lg = 0.f, qscale = 1.f; int qcol, zcol;
    if (HG) { qscale = 0.08838834764831845f; qcol = h * 128 + c; zcol = (dir ? 1536 : 1024) + h * 128 + c;
        if (layer >= 2) { const float l0 = a->in[12][(0 * 2 + dir) * 512 + h * 128 + c], l1 = a->in[12][(1 * 2 + dir) * 512 + h * 128 + c]; lb = 1.f / (1.f + __expf(l0 - l1)); } }
    else { qcol = h * 64 + c; zcol = 256 + h * 64 + c; const float x = a->in[19][((layer >> 1) * 2 + dir) * 4 + h]; lg = -__logf(1.f + __expf(-x)); }
    const int vcol = 512 + h * 128;
    const int rowbase = b * TPB;
    const int tv = lane, c8v = wid;
    unsigned short rq[TPT], rz[TPT]; bf16x8 rv[2];
#define SC_JB(ci) (dir ? ((ci) < 4 ? 255 - 64 * (ci) : 2303 - 64 * ((ci) - 4)) : 64 * (ci))
#define SC_LOAD(ci) do { const int jb_ = SC_JB(ci), sg_ = dir ? -1 : 1; \
        _Pragma("unroll") for (int i = 0; i < TPT; ++i) { const bf16* pr_ = P + (size_t)(rowbase + jb_ + sg_ * (tq * TPT + i)) * NP; if (MODE) rq[i] = pr_[qcol]; rz[i] = pr_[zcol]; } \
        { const bf16* pv_ = P + (size_t)(rowbase + jb_ + sg_ * tv) * NP + vcol; rv[0] = *(const bf16x8*)(pv_ + c8v * 8); rv[1] = *(const bf16x8*)(pv_ + (c8v + 8) * 8); } } while (0)
    f32x4 Sacc[DK / 16];
#pragma unroll
    for (int i = 0; i < DK / 16; ++i) Sacc[i] = (f32x4){0.f, 0.f, 0.f, 0.f};
    const int c0 = 9 * seg;
    SC_LOAD(c0);
    if (MODE) {
        for (int s_ = 0; s_ < seg; ++s_) {
#pragma unroll
            for (int i = 0; i < DK / 16; ++i) { f32x4 v = Sacc[i];
                if (s_ > 0) { const f32x4 l4 = *(const f32x4*)(Lb + (size_t)(item * 3 + s_) * 128 + 16 * i + 4 * q4); v[0] *= __expf(l4[0]); v[1] *= __expf(l4[1]); v[2] *= __expf(l4[2]); v[3] *= __expf(l4[3]); }
                Sacc[i] = v + Ub[((size_t)(item * 3 + s_) * (DK / 16) + i) * 512 + tid]; }
        }
    }
    float lsum = 0.f;
    for (int ci = c0; ci < c0 + 9; ++ci) {
#pragma unroll
        for (int u = 0; u < 2; ++u)
#pragma unroll
            for (int e = 0; e < 8; ++e) *(LAS unsigned short*)(LvT + ((c8v + 8 * u) * 8 + e) * TS + tv * 2) = (unsigned short)rv[u][e];
        float zf[TPT], qf[TPT];
#pragma unroll
        for (int i = 0; i < TPT; ++i) { zf[i] = bf2f(rz[i]); if (MODE) qf[i] = bf2f(rq[i]) * qscale; }
        const int jb = SC_JB(ci), sg = dir ? -1 : 1;
        if (ci + 1 < c0 + 9) SC_LOAD(ci + 1);
        float kk_[TPT], e1v[TPT], e2v[TPT]; float Eref, Ebr, dlast;
        if (HG) {
            float fv[TPT];
#pragma unroll
            for (int i = 0; i < TPT; ++i) { const float z = fminf(fmaxf(zf[i], -30.f), 30.f);
                const float t = __expf(-fabsf(z)), r = __builtin_amdgcn_rcpf(1.f + t), tr = t * r;
                const float sig = z >= 0.f ? r : tr, sigm = z >= 0.f ? tr : r;
                kk_[i] = (1.f - lb) * sigm; fv[i] = lb + (1.f - lb) * sig; }
            float run = 1.f;
            if (tq < 2) {
#pragma unroll
                for (int i = TPT - 1; i >= 0; --i) { e2v[i] = run; run *= fv[i]; }
            } else {
#pragma unroll
                for (int i = 0; i < TPT; ++i) { run *= fv[i]; e1v[i] = run; }
            }
            Ltot[tq * 128 + c] = run;
            __syncthreads();
            const float t0 = Ltot[c], t1 = Ltot[128 + c], t2 = Ltot[256 + c], t3 = Ltot[384 + c];
            Eref = t0 * t1; Ebr = t2 * t3; dlast = Eref * Ebr;
            const float mul = (tq == 0) ? t1 : ((tq == 3) ? t2 : 1.f);
            if (tq < 2) {
#pragma unroll
                for (int i = 0; i < TPT; ++i) { e2v[i] = fmaxf(e2v[i] * mul, 1e-30f); if (MODE) e1v[i] = __builtin_amdgcn_rcpf(e2v[i]); }
            } else {
#pragma unroll
                for (int i = 0; i < TPT; ++i) { e1v[i] = fmaxf(e1v[i] * mul, 1e-30f); e2v[i] = __builtin_amdgcn_rcpf(e1v[i]); }
            }
            lsum += __logf(fmaxf(dlast, 1e-37f));
        } else {
#pragma unroll
            for (int i = 0; i < TPT; ++i) { kk_[i] = zf[i]; e1v[i] = __expf((float)(tq * TPT + i - 31) * lg); e2v[i] = __builtin_amdgcn_rcpf(e1v[i]); }
            Eref = __expf(32.f * lg); Ebr = Eref; dlast = Eref * Ebr;
            lsum += 64.f * lg;
        }
        unsigned short kh[TPT];
        if (MODE) {
#pragma unroll
            for (int i = 0; i < TPT; ++i) { const int tau = tq * TPT + i;
                const float qt = qf[i] * e1v[i], kt = kk_[i] * e2v[i];
                const unsigned wq = cvtpk2(qt, qt * Eref), wk = cvtpk2(kt, kt * Ebr);
                *(LAS unsigned short*)(Lqt + tau * QS + c * 2) = (unsigned short)(wq & 0xffff);
                *(LAS unsigned short*)(Lqh + tau * QS + c * 2) = (unsigned short)(wq >> 16);
                *(LAS unsigned short*)(Lkt + tau * QS + c * 2) = (unsigned short)(wk & 0xffff);
                kh[i] = (unsigned short)(wk >> 16); }
        } else {
#pragma unroll
            for (int i = 0; i < TPT; ++i) kh[i] = (unsigned short)(cvtpk2(kk_[i] * e2v[i] * Ebr, 0.f) & 0xffff);
        }
#pragma unroll
        for (int i8 = 0; i8 < TPT / 8; ++i8) { u32x4 w; w.x = kh[8 * i8] | ((unsigned)kh[8 * i8 + 1] << 16); w.y = kh[8 * i8 + 2] | ((unsigned)kh[8 * i8 + 3] << 16);
            w.z = kh[8 * i8 + 4] | ((unsigned)kh[8 * i8 + 5] << 16); w.w = kh[8 * i8 + 6] | ((unsigned)kh[8 * i8 + 7] << 16);
            *(LAS u32x4*)(LkhT + c * TS + (tq * TPT + 8 * i8) * 2) = w; }
        if (tq == 0) Lbl[c] = dlast;
        __syncthreads();
        const int dvl = 16 * wid + l15;
        const bf16x8 bv0 = *(const LAS bf16x8*)(LvT + dvl * TS + (8 * q4) * 2), bv1 = *(const LAS bf16x8*)(LvT + dvl * TS + (32 + 8 * q4) * 2);
        if (MODE) {
#pragma unroll
            for (int tt = 0; tt < 2; ++tt) { const int idx = 2 * wid + tt, si = idx >> 2, ti = idx & 3;
                f32x4 acc = (f32x4){0.f, 0.f, 0.f, 0.f};
#pragma unroll
                for (int kk = 0; kk < DK / 32; ++kk) { const bf16x8 A = *(const LAS bf16x8*)(Lkt + (16 * si + l15) * QS + (32 * kk + 8 * q4) * 2);
                    const bf16x8 B = *(const LAS bf16x8*)(Lqt + (16 * ti + l15) * QS + (32 * kk + 8 * q4) * 2); acc = mfma16(A, B, acc); }
                const int t = 16 * ti + l15, s0 = 16 * si + 4 * q4;
                u32x2 w; w.x = pk2(s0 + 0 <= t ? acc[0] : 0.f, s0 + 1 <= t ? acc[1] : 0.f); w.y = pk2(s0 + 2 <= t ? acc[2] : 0.f, s0 + 3 <= t ? acc[3] : 0.f);
                *(LAS u32x2*)(Latt + t * TS + s0 * 2) = w; }
            __syncthreads();
            bf16x8 Sb[DK / 32];
#pragma unroll
            for (int kk = 0; kk < DK / 32; ++kk) { u32x4 w; w.x = pk2(Sacc[2 * kk][0], Sacc[2 * kk][1]); w.y = pk2(Sacc[2 * kk][2], Sacc[2 * kk][3]);
                w.z = pk2(Sacc[2 * kk + 1][0], Sacc[2 * kk + 1][1]); w.w = pk2(Sacc[2 * kk + 1][2], Sacc[2 * kk + 1][3]); Sb[kk] = __builtin_bit_cast(bf16x8, w); }
#pragma unroll
            for (int ti = 0; ti < 4; ++ti) {
                f32x4 acc = (f32x4){0.f, 0.f, 0.f, 0.f};
                { const bf16x8 A = *(const LAS bf16x8*)(Latt + (16 * ti + l15) * TS + (8 * q4) * 2); acc = mfma16(A, bv0, acc); }
                if (ti >= 2) { const bf16x8 A = *(const LAS bf16x8*)(Latt + (16 * ti + l15) * TS + (32 + 8 * q4) * 2); acc = mfma16(A, bv1, acc); }
#pragma unroll
                for (int kk = 0; kk < DK / 32; ++kk) {
                    const s16x4 lo = *(const LAS s16x4*)(Lqh + (16 * ti + l15) * QS + (32 * kk + 4 * q4) * 2), hi = *(const LAS s16x4*)(Lqh + (16 * ti + l15) * QS + (32 * kk + 16 + 4 * q4) * 2);
                    const bf16x8 A = (bf16x8){lo[0], lo[1], lo[2], lo[3], hi[0], hi[1], hi[2], hi[3]};
                    acc = mfma16(A, Sb[kk], acc); }
#pragma unroll
                for (int r = 0; r < 4; ++r) { const int t = 16 * ti + 4 * q4 + r;
                    OSC[(size_t)(rowbase + jb + sg * t) * 512 + h * 128 + dvl] = (bf16)f2bf(acc[r]); }
            }
        }
#pragma unroll
        for (int i = 0; i < DK / 16; ++i) {
            const f32x4 d4 = *(const LAS f32x4*)(Lbl + 16 * i + 4 * q4);
            f32x4 s = Sacc[i] * d4;
            const bf16x8 A0 = *(const LAS bf16x8*)(LkhT + (16 * i + l15) * TS + (8 * q4) * 2), A1 = *(const LAS bf16x8*)(LkhT + (16 * i + l15) * TS + (32 + 8 * q4) * 2);
            s = mfma16(A0, bv0, s); s = mfma16(A1, bv1, s); Sacc[i] = s; }
        __syncthreads();
    }
    if (!MODE) {
#pragma unroll
        for (int i = 0; i < DK / 16; ++i) Ub[((size_t)(item * 3 + seg) * (DK / 16) + i) * 512 + tid] = Sacc[i];
        if (tq == 0) Lb[(size_t)(item * 3 + seg) * 128 + c] = lsum;
    }
#undef SC_JB
#undef SC_LOAD
}

#define SBAR() __builtin_amdgcn_sched_barrier(0)
__device__ __forceinline__ int crow(int r, int hi) { return (r & 3) + 8 * (r >> 2) + 4 * hi; }
__device__ __forceinline__ unsigned cvtpk(float lo, float hi) { unsigned r; asm volatile("v_cvt_pk_bf16_f32 %0, %1, %2" : "=v"(r) : "v"(lo), "v"(hi)); return r; }
__device__ __forceinline__ void partialSM(f32x16& p0, f32x16& p1, float& m_reg, float& mn, float& alpha, float C, float thr_raw) {
    float pmax = p0[0];
#pragma unroll
    for (int r = 1; r < 16; ++r) pmax = fmaxf(pmax, p0[r]);
#pragma unroll
    for (int r = 0; r < 16; ++r) pmax = fmaxf(pmax, p1[r]);
    { auto rr = __builtin_amdgcn_permlane32_swap(__float_as_uint(pmax), __float_as_uint(pmax), false, false);
      pmax = fmaxf(__uint_as_float(rr[0]), __uint_as_float(rr[1])); }
    if (__builtin_expect(__all(pmax - m_reg <= thr_raw), 1)) { mn = m_reg; alpha = 1.f; }
    else { mn = fmaxf(m_reg, pmax); alpha = __builtin_amdgcn_exp2f((m_reg - mn) * C); m_reg = mn; }
    const float mnC = -mn * C;
#pragma unroll
    for (int r = 0; r < 16; ++r) p0[r] = fmaf(p0[r], C, mnC);
#pragma unroll
    for (int r = 0; r < 16; ++r) p1[r] = fmaf(p1[r], C, mnC);
#pragma unroll
    for (int r = 0; r < 16; ++r) p0[r] = __builtin_amdgcn_exp2f(p0[r]);
}
__device__ __forceinline__ void finishSM(f32x16& p0, f32x16& p1, float alpha, float& l_reg, bf16x8& pa0, bf16x8& pa1, bf16x8& pa2, bf16x8& pa3) {
#pragma unroll
    for (int r = 0; r < 16; ++r) p1[r] = __builtin_amdgcn_exp2f(p1[r]);
    float ps = 0;
#pragma unroll
    for (int r = 0; r < 16; ++r) ps += p0[r];
#pragma unroll
    for (int r = 0; r < 16; ++r) ps += p1[r];
    { auto rr = __builtin_amdgcn_permlane32_swap(__float_as_uint(ps), __float_as_uint(ps), false, false);
      ps = __uint_as_float(rr[0]) + __uint_as_float(rr[1]); }
    l_reg = l_reg * alpha + ps;
#define PK4(P, BASE, OUT) do { unsigned a0 = cvtpk(P[BASE + 0], P[BASE + 1]), a1 = cvtpk(P[BASE + 2], P[BASE + 3]);   \
    unsigned b0 = cvtpk(P[BASE + 4], P[BASE + 5]), b1 = cvtpk(P[BASE + 6], P[BASE + 7]);                              \
    auto r0 = __builtin_amdgcn_permlane32_swap(a0, b0, false, false); auto r1 = __builtin_amdgcn_permlane32_swap(a1, b1, false, false); \
    u32x4 w = {r0[0], r1[0], r0[1], r1[1]}; OUT = __builtin_bit_cast(bf16x8, w); } while (0)
    PK4(p0, 0, pa0); PK4(p0, 8, pa1); PK4(p1, 0, pa2); PK4(p1, 8, pa3);
#undef PK4
}
template <int ND0, int KROWB>
__device__ __forceinline__ void qkt(f32x16& p0, f32x16& p1, const char* Ks, const bf16x8* qr, int r32, int hi) {
    p0 = f32x16{}; p1 = f32x16{};
#pragma unroll
    for (int d0 = 0; d0 < ND0; ++d0) { const int cb = (d0 * 16 + hi * 8) * 2;
        const bf16x8 b0 = *reinterpret_cast<const bf16x8*>(Ks + r32 * KROWB + (cb ^ ((r32 & 7) << 4)));
        const bf16x8 b1 = *reinterpret_cast<const bf16x8*>(Ks + (32 + r32) * KROWB + (cb ^ ((r32 & 7) << 4)));
        p0 = __builtin_amdgcn_mfma_f32_32x32x16_bf16(b0, qr[d0], p0, 0, 0, 0);
        p1 = __builtin_amdgcn_mfma_f32_32x32x16_bf16(b1, qr[d0], p1, 0, 0, 0); }
}
template <int NCB> __device__ __forceinline__ int v_st(int k, int c) { const int kk = (k & ~0xC) | ((k & 4) << 1) | ((k & 8) >> 1); return ((kk >> 3) * NCB + (c >> 5)) * 512 + ((kk & 7) * 32 + (c & 31)) * 2; }
__device__ __forceinline__ int v_rd_base(int lane) { return ((lane & 3) << 3) | (((lane >> 2) & 3) << 6) | (((lane >> 4) & 1) << 5) | (((lane >> 5) & 1) << 8); }
template <int OFF> __device__ __forceinline__ s16x4 tr_read(int vb) {
    s16x4 r; asm volatile("ds_read_b64_tr_b16 %0, %1 offset:%2" : "=&v"(r) : "v"(vb), "i"(OFF) : "memory"); return r;
}
template <int NCB, int D0> __device__ __forceinline__ void pv_one(f32x16& od, int vb, bf16x8 pa0, bf16x8 pa1, bf16x8 pa2, bf16x8 pa3) {
#define VOFF(ks, half) (D0 * 512 + (ks) * (NCB * 1024) + (half) * (NCB * 512))
    const s16x4 l0 = tr_read<VOFF(0, 0)>(vb), h0 = tr_read<VOFF(0, 1)>(vb), l1 = tr_read<VOFF(1, 0)>(vb), h1 = tr_read<VOFF(1, 1)>(vb);
    const s16x4 l2 = tr_read<VOFF(2, 0)>(vb), h2 = tr_read<VOFF(2, 1)>(vb), l3 = tr_read<VOFF(3, 0)>(vb), h3 = tr_read<VOFF(3, 1)>(vb);
#undef VOFF
    asm volatile("s_waitcnt lgkmcnt(0)" ::: "memory"); SBAR();
#define PK(L, H) (bf16x8){L[0], L[1], L[2], L[3], H[0], H[1], H[2], H[3]}
    od = __builtin_amdgcn_mfma_f32_32x32x16_bf16(pa0, PK(l0, h0), od, 0, 0, 0);
    od = __builtin_amdgcn_mfma_f32_32x32x16_bf16(pa1, PK(l1, h1), od, 0, 0, 0);
    od = __builtin_amdgcn_mfma_f32_32x32x16_bf16(pa2, PK(l2, h2), od, 0, 0, 0);
    od = __builtin_amdgcn_mfma_f32_32x32x16_bf16(pa3, PK(l3, h3), od, 0, 0, 0);
#undef PK
}
template <int NCB> __device__ __forceinline__ void pv_all(f32x16* o, int vb, bf16x8 pa0, bf16x8 pa1, bf16x8 pa2, bf16x8 pa3) {
    pv_one<NCB, 0>(o[0], vb, pa0, pa1, pa2, pa3); pv_one<NCB, 1>(o[1], vb, pa0, pa1, pa2, pa3);
    if constexpr (NCB == 4) { pv_one<NCB, 2>(o[2], vb, pa0, pa1, pa2, pa3); pv_one<NCB, 3>(o[3], vb, pa0, pa1, pa2, pa3); }
}

template <int DQK, int DV, int KROWB>
__device__ __forceinline__ void attn_core(const bf16x8* qr, const bf16* kA, int sA, const bf16* kB, int sB, const bf16* vP, int sV,
                                          int NT, float C, float thr_raw, char* lds, f32x16* o, float& l_out, const int tid) {
    constexpr int NCB = DV / 32, SHM_V = 64 * DV * 2, SHM_K = 64 * KROWB, ND0 = DQK / 16;
    constexpr int PPR = DQK / 8, NPK = 64 * PPR, NKS = (NPK + 511) / 512, VPR = DV / 8, NVS = 64 * VPR / 512;
    const int wid = tid >> 6, lane = tid & 63, r32 = lane & 31, hi = lane >> 5;
    char* V_lds = lds; char* K_lds = lds + 2 * SHM_V;
    float* wsf = (float*)(lds + 2 * SHM_V + 2 * SHM_K) + wid * 64; float* al_l = wsf + 32;
    float m_reg = -1e30f, l_reg = 0;
    const bf16* kp[NKS]; int kadv[NKS], kst[NKS]; bool kval[NKS];
#pragma unroll
    for (int i = 0; i < NKS; ++i) { int p = tid + 512 * i; kval[i] = p < NPK; if (!kval[i]) p -= 512; const int row = p / PPR, c8 = p - row * PPR;
        if (c8 < 8) { kp[i] = kA + (size_t)row * sA + c8 * 8; kadv[i] = 64 * sA; } else { kp[i] = kB + (size_t)row * sB + (c8 - 8) * 8; kadv[i] = 64 * sB; }
        kst[i] = row * KROWB + ((c8 * 16) ^ ((row & 7) << 4)); }
    const bf16* vp[NVS]; int vst[NVS];
#pragma unroll
    for (int i = 0; i < NVS; ++i) { const int p = tid + 512 * i, row = p / VPR, c8 = p % VPR; vp[i] = vP + (size_t)row * sV + c8 * 8; vst[i] = v_st<NCB>(row, c8 * 8); }
    const int vadv = 64 * sV;
    const int vb0 = (int)(uintptr_t)V_lds + v_rd_base(lane);
    struct { bf16x8 ks[NKS]; bf16x8 vs[NVS]; } sr_[1];
#define SLOAD(i, t) do { _Pragma("unroll") for (int s_ = 0; s_ < NKS; ++s_) sr_[i].ks[s_] = *(const bf16x8*)(kp[s_] + (size_t)(t) * kadv[s_]); \
        _Pragma("unroll") for (int s_ = 0; s_ < NVS; ++s_) sr_[i].vs[s_] = *(const bf16x8*)(vp[s_] + (size_t)(t) * vadv); } while (0)
#define SWRITE(b, i) do { _Pragma("unroll") for (int s_ = 0; s_ < NVS; ++s_) *(bf16x8*)(V_lds + (b) * SHM_V + vst[s_]) = sr_[i].vs[s_]; \
        _Pragma("unroll") for (int s_ = 0; s_ < NKS; ++s_) if (kval[s_]) *(bf16x8*)(K_lds + (b) * SHM_K + kst[s_]) = sr_[i].ks[s_]; } while (0)
#define RESC(a) do { if (__any((a) < 1.f)) { if (hi == 0) al_l[r32] = (a); asm volatile("s_waitcnt lgkmcnt(0)" ::: "memory"); \
        _Pragma("unroll") for (int d = 0; d < NCB; ++d) _Pragma("unroll") for (int r = 0; r < 16; ++r) o[d][r] *= al_l[crow(r, hi)]; } } while (0)
    f32x16 pA0, pA1, pB0, pB1; float mnA, mnB, alA, alB; bf16x8 pa0, pa1, pa2, pa3;
    constexpr int SE = 0, SO = 0;
    SLOAD(SE, 0); SWRITE(0, SE); __syncthreads();
    qkt<ND0, KROWB>(pA0, pA1, K_lds, qr, r32, hi); partialSM(pA0, pA1, m_reg, mnA, alA, C, thr_raw);
    SLOAD(SO, 1);
    SWRITE(1, SO); __syncthreads();
    for (int j = 1; j + 1 < NT; j += 2) {
        SBAR(); qkt<ND0, KROWB>(pB0, pB1, K_lds + SHM_K, qr, r32, hi);
        finishSM(pA0, pA1, alA, l_reg, pa0, pa1, pa2, pa3); SBAR();
        SLOAD(SO, j + 1); SBAR();
        pv_all<NCB>(o, vb0, pa0, pa1, pa2, pa3); partialSM(pB0, pB1, m_reg, mnB, alB, C, thr_raw);
        __syncthreads(); SWRITE(0, SE);
        RESC(alB); __syncthreads();
        SBAR(); qkt<ND0, KROWB>(pA0, pA1, K_lds, qr, r32, hi);
        finishSM(pB0, pB1, alB, l_reg, pa0, pa1, pa2, pa3); SBAR();
        SLOAD(SE, j + 2); SBAR();
        pv_all<NCB>(o, vb0 + SHM_V, pa0, pa1, pa2, pa3); partialSM(pA0, pA1, m_reg, mnA, alA, C, thr_raw);
        __syncthreads(); SWRITE(1, SO);
        RESC(alA); __syncthreads();
    }
    SBAR(); qkt<ND0, KROWB>(pB0, pB1, K_lds + SHM_K, qr, r32, hi);
    finishSM(pA0, pA1, alA, l_reg, pa0, pa1, pa2, pa3); SBAR();
    pv_all<NCB>(o, vb0, pa0, pa1, pa2, pa3); partialSM(pB0, pB1, m_reg, mnB, alB, C, thr_raw);
    __syncthreads(); RESC(alB);
    finishSM(pB0, pB1, alB, l_reg, pa0, pa1, pa2, pa3); SBAR();
    pv_all<NCB>(o, vb0 + SHM_V, pa0, pa1, pa2, pa3);
    l_out = l_reg;
#undef SLOAD
#undef SWRITE
#undef RESC
}

__device__ __forceinline__ void mla_item(KArgP a, int b, int h, int qb, char* lds) {
    const int tid = ptid(), wid = tid >> 6, lane = tid & 63, r32 = lane & 31, hi = lane >> 5;
    const bf16* Qb = (const bf16*)((const unsigned char*)a->out + OUT_Q); const bf16* KV = (const bf16*)((const unsigned char*)a->out + OUT_KV);
    const bf16* KR = (const bf16*)(a->ws + WS_KR); bf16* MIX = (bf16*)(a->ws + WS_MIX);
    const int row0 = b * TPB + qb * 256, krow0 = b * TPB, NT = qb ? 36 : 4;
    const int row = row0 + wid * 32 + r32;
    const bf16* Qw = Qb + (size_t)row * 768 + h * 96;
    bf16x8 qr[6];
#pragma unroll
    for (int d0 = 0; d0 < 4; ++d0) qr[d0] = *(const bf16x8*)(Qw + d0 * 16 + hi * 8);
    const int t = (qb - 1) * 256 + wid * 32 + r32;
#pragma unroll
    for (int d0 = 4; d0 < 6; ++d0) {
        const bf16x8 x1 = *(const bf16x8*)(Qw + d0 * 16), x2 = *(const bf16x8*)(Qw + d0 * 16 + 8);
        if (qb) { const float pos = (float)(d0 == 4 ? (t >> 6) : (t & 63)); unsigned short ov[8];
#pragma unroll
            for (int i = 0; i < 8; ++i) { float s, c; sincos_r(pos * inv_freq(i, 8), s, c); const float f1 = bf2f((unsigned short)x1[i]), f2 = bf2f((unsigned short)x2[i]);
                ov[i] = (unsigned short)f2bf(hi ? (f1 * s + f2 * c) : (f1 * c - f2 * s)); }
            qr[d0] = (bf16x8){(short)ov[0], (short)ov[1], (short)ov[2], (short)ov[3], (short)ov[4], (short)ov[5], (short)ov[6], (short)ov[7]};
        } else qr[d0] = hi ? x2 : x1;
    }
    f32x16 o[2] = {}; float l_reg;
    const float scale = 0.10206207261596575f;
    attn_core<96, 64, 256>(qr, KV + (size_t)krow0 * 1024 + h * 128, 1024, KR + (size_t)krow0 * 32, 32, KV + (size_t)krow0 * 1024 + h * 128 + 64, 1024,
                           NT, scale * 1.4426950408889634f, 8.f / scale, lds, o, l_reg, tid);
    float* li_l = (float*)(lds + 2 * 64 * 64 * 2 + 2 * 64 * 256) + wid * 64;
    if (hi == 0) li_l[r32] = l_reg; asm volatile("s_waitcnt lgkmcnt(0)" ::: "memory");
#pragma unroll
    for (int r = 0; r < 16; ++r) { const int orow = crow(r, hi); const float rl = __builtin_amdgcn_rcpf(li_l[orow]);
        bf16* op = MIX + (size_t)(row0 + wid * 32 + orow) * 1024 + 512 + h * 64 + r32;
        op[0] = (bf16)f2bf(o[0][r] * rl); op[32] = (bf16)f2bf(o[1][r] * rl); }
}
__device__ __forceinline__ void diff_item(KArgP a, int layer, int b, int h, int qb, char* lds) {
    const int row0 = b * TPB + qb * 256, krow0 = b * TPB, NT = qb ? 36 : 4, o_ = layer >> 1;
    const float scale = 0.125f;
#pragma unroll 1
    for (int m = 0; m < 2; ++m) {
        f32x16 o[4] = {};
        float l_reg;
        {
            const int tid = ptid(), wid = tid >> 6, lane = tid & 63, r32 = lane & 31, hi = lane >> 5;
            const bf16* P = (const bf16*)(a->ws + WS_P);
            const bf16* Qw = P + (size_t)(row0 + wid * 32 + r32) * NP_O + 1536 + h * 128 + m * 64;
            bf16x8 qr[4];
#pragma unroll
            for (int d0 = 0; d0 < 4; ++d0) qr[d0] = *(const bf16x8*)(Qw + d0 * 16 + hi * 8);
            const bf16* Kp = P + (size_t)krow0 * NP_O + 2048 + h * 128 + m * 64;
            attn_core<64, 128, 128>(qr, Kp, NP_O, Kp, NP_O, P + (size_t)krow0 * NP_O + 2560 + h * 128, NP_O,
                                    NT, scale * 1.4426950408889634f, 8.f / scale, lds, o, l_reg, tid);
        }
        const int tid = ptid(), wid = tid >> 6, lane = tid & 63, r32 = lane & 31, hi = lane >> 5;
        float* li_l = (float*)(lds + 2 * 64 * 128 * 2 + 2 * 64 * 128) + wid * 64;
        if (hi == 0) li_l[r32] = l_reg; asm volatile("s_waitcnt lgkmcnt(0)" ::: "memory");
        float* dsb = (float*)a->out + (size_t)blockIdx.x * 64 * 512 + tid; asm volatile("" : "+v"(dsb));
        if (m == 0) {
#pragma unroll
            for (int r = 0; r < 16; ++r) { const float rl = __builtin_amdgcn_rcpf(li_l[crow(r, hi)]);
#pragma unroll
                for (int d = 0; d < 4; ++d) dsb[(size_t)(d * 16 + r) * 512] = o[d][r] * rl; }
        } else {
            bf16* MIX = (bf16*)(a->ws + WS_MIX);
            const float* lp = a->in[20] + o_ * 256;
            const float lam_init = 0.8f - 0.6f * __expf(-0.3f * (float)layer);
            const float lam = __expf(wave_sum(lp[lane] * lp[64 + lane])) - __expf(wave_sum(lp[128 + lane] * lp[192 + lane])) + lam_init;
            const float* sg = a->in[21] + o_ * 128;
#pragma unroll
            for (int r = 0; r < 16; ++r) { const float rl = __builtin_amdgcn_rcpf(li_l[crow(r, hi)]); float s = 0.f; float v[4];
#pragma unroll
                for (int d = 0; d < 4; ++d) { v[d] = dsb[(size_t)(d * 16 + r) * 512] - lam * (o[d][r] * rl); s += v[d] * v[d]; }
                s += __shfl_xor(s, 16); s += __shfl_xor(s, 8); s += __shfl_xor(s, 4); s += __shfl_xor(s, 2); s += __shfl_xor(s, 1);
                const float rs = __builtin_amdgcn_rsqf(s * (1.f / 128.f) + EPSN) * (1.f - lam_init);
                bf16* op = MIX + (size_t)(row0 + wid * 32 + crow(r, hi)) * 1024 + 512 + h * 128 + r32;
#pragma unroll
                for (int d = 0; d < 4; ++d) op[32 * d] = (bf16)f2bf(v[d] * rs * sg[32 * d + r32]);
                asm volatile("" ::: "memory"); }
        }
        asm volatile("s_waitcnt vmcnt(0) lgkmcnt(0)" ::: "memory");
    }
}

__device__ __forceinline__ void phase_mixer(KArgP a, int layer, unsigned char* ldsg) {
    LAS unsigned char* lds = (LAS unsigned char*)ldsg;
    volatile LAS unsigned* flag = (volatile LAS unsigned*)(lds + LDS_MAIN);
    unsigned* ctr = (unsigned*)(a->ws + WS_CTL) + layer; layer &= 7;
    const bool even = !(layer & 1), need_ctx = layer < 3;
    constexpr int NSC = 256;
    const int n_lat = even ? 512 : 256, n_ctx = need_ctx ? (even ? 64 : 32) : 0, total = NSC + n_lat + n_ctx;
    for (;;) {
        __syncthreads();
        if (ptid() == 0) *flag = atomicAdd(ctr, 1u);
        __syncthreads();
        const int item = (int)*flag;
        if (item >= total) break;
#ifdef PROBE_ITEM
        const unsigned long long it0_ = __builtin_amdgcn_s_memrealtime();
#endif
#ifndef SKIP_SCAN
        if (item < NSC) { if (even) scan_item<128, true, 1>(a, layer, item & 63, item >> 6, lds); else scan_item<64, false, 1>(a, layer, item & 63, item >> 6, lds); }
#else
        if (item < NSC) {}
#endif
        else { int b_, h_, qb_;
            if (item < NSC + n_lat) { const int i = item - NSC; qb_ = 1 + (i & 7); if (even) { b_ = i >> 6; h_ = (i >> 3) & 7; } else { b_ = i >> 5; h_ = (i >> 3) & 3; } }
            else { const int i = item - NSC - n_lat; qb_ = 0; if (even) { b_ = i >> 3; h_ = i & 7; } else { b_ = i >> 2; h_ = i & 3; } }
#ifndef SKIP_ATTN
            if (even) mla_item(a, b_, h_, qb_, (char*)ldsg); else diff_item(a, layer, b_, h_, qb_, (char*)ldsg);
#endif
        }
#ifdef PROBE_ITEM
        __syncthreads();
        if (otid() == 0) { volatile LAS unsigned long long* pc_ = (volatile LAS unsigned long long*)(lds + LDS_MAIN + 128); const int k_ = item < NSC ? 0 : (even ? 1 : 2); pc_[k_] += __builtin_amdgcn_s_memrealtime() - it0_; }
#endif
    }
}

#define XB_TMO      128
#define XB_XCNT(j)  (256  + 64 * (j))
#define XB_XSUB(j)  (1280 + 64 * (j))
#define XB_XGEN(j)  (2304 + 64 * (j))
#define XB_TOP      3328
#define XB_TOPGEN   3392
#define XCD_BAR_WORDS 3456
#define XB_SPIN_CAP (1u << 18)

__device__ __forceinline__ unsigned xb_ld(unsigned* p)              { return __hip_atomic_load(p, __ATOMIC_RELAXED, __HIP_MEMORY_SCOPE_AGENT); }
__device__ __forceinline__ unsigned xb_add(unsigned* p, unsigned v) { return __hip_atomic_fetch_add(p, v, __ATOMIC_RELAXED, __HIP_MEMORY_SCOPE_AGENT); }
__device__ __forceinline__ unsigned xb_xcc_id() { return (unsigned)__builtin_amdgcn_s_getreg((3 << 11) | 20) & 0xFu; }
#define XB_SPIN(cond, bar) do { unsigned _sp = 0; while (cond) { __builtin_amdgcn_s_sleep(1); \
    if ((++_sp & 255u) == 0u) { if (xb_ld(&(bar)[XB_TMO])) break; if (_sp > XB_SPIN_CAP) { atomicAdd(&(bar)[XB_TMO], 1u); break; } } } } while (0)

struct XcdBarrier {
    unsigned* bar; unsigned x;
    volatile LAS unsigned* st;
};

__device__ __forceinline__ XcdBarrier xcd_barrier_post(unsigned* bar, volatile LAS unsigned* st) {
    XcdBarrier b; b.bar = bar; b.x = xb_xcc_id(); b.st = st;
    if (threadIdx.x == 0) (void)xb_add(&bar[XB_XCNT(b.x)], 1u);
    return b;
}
__device__ __forceinline__ void xcd_barrier_complete(unsigned* bar, unsigned x, unsigned& nloc, unsigned& nx) {
    const unsigned G = gridDim.x * gridDim.y * gridDim.z;
    unsigned sum, cnt, mine, sp = 0u;
    for (;;) {
        sum = 0u; cnt = 0u; mine = 0u;
#pragma unroll
        for (unsigned j = 0; j < 16; ++j) { const unsigned c = xb_ld(&bar[XB_XCNT(j)]); sum += c; cnt += (c > 0u) ? 1u : 0u; mine = (j == x) ? c : mine; }
        if (sum == G) break;
        __builtin_amdgcn_s_sleep(1);
        if ((++sp & 255u) == 0u) { if (xb_ld(&bar[XB_TMO])) break; if (sp > XB_SPIN_CAP) { atomicAdd(&bar[XB_TMO], 1u); break; } }
    }
    nloc = mine > 0u ? mine : 1u; nx = cnt > 0u ? cnt : 1u;
}

__device__ __forceinline__ void xcd_barrier(const XcdBarrier& b) {
    asm volatile("s_waitcnt vmcnt(0)" ::: "memory");
    __syncthreads();
    if (threadIdx.x == 0) {
        unsigned* bar = b.bar;
        __builtin_amdgcn_s_waitcnt(0);
        unsigned nloc = b.st[0], nx = b.st[1];
        if (nloc == 0u) { xcd_barrier_complete(bar, b.x, nloc, nx); b.st[0] = nloc; b.st[1] = nx; }
        const unsigned old = xb_add(&bar[XB_XSUB(b.x)], 1u);
        const unsigned gen = old / nloc;
        if (old + 1u == (gen + 1u) * nloc) {
            __builtin_amdgcn_fence(__ATOMIC_RELEASE, "agent");
            asm volatile("s_waitcnt vmcnt(0)" ::: "memory");
            const unsigned og = xb_add(&bar[XB_TOP], 1u);
            const unsigned tg = og / nx;
            if (og + 1u == (tg + 1u) * nx) xb_add(&bar[XB_TOPGEN], 1u);
            else XB_SPIN(xb_ld(&bar[XB_TOPGEN]) == tg, bar);
            __builtin_amdgcn_fence(__ATOMIC_ACQUIRE, "agent");
            xb_add(&bar[XB_XGEN(b.x)], 1u);
            asm volatile("s_waitcnt vmcnt(0)" ::: "memory");
        } else {
            XB_SPIN(xb_ld(&bar[XB_XGEN(b.x)]) == gen, bar);
            __builtin_amdgcn_fence(__ATOMIC_ACQUIRE, "agent");
            asm volatile("s_waitcnt vmcnt(0)" ::: "memory");
        }
    }
    __syncthreads();
}

__global__ void __launch_bounds__(512, 2) mega_fwd(Args a_) {
    extern __shared__ __attribute__((aligned(16))) unsigned char lds_raw[];
    LAS unsigned char* lds = (LAS unsigned char*)lds_raw;
    ((LAS int*)(lds + LDS_MAIN + 1024))[threadIdx.x] = (int)threadIdx.x;
    if (threadIdx.x < 4) ((LAS unsigned*)(lds + LDS_MAIN + 64))[threadIdx.x] = 0u;
    if (threadIdx.x < 8) ((LAS unsigned*)(lds + LDS_MAIN + 128))[threadIdx.x] = 0u;
    __syncthreads();
    XcdBarrier xbar; xbar.bar = nullptr; xbar.x = 0; xbar.st = nullptr; bool xb_ready = false;
    cg::grid_group grid = cg::this_grid();
    int ph = 0;
#ifdef PROBE_MASK
    unsigned long long pr_last = __builtin_amdgcn_s_memrealtime(), pr_acc = 0ull;
#define PROBE_STAMP(k) { const unsigned long long now_ = __builtin_amdgcn_s_memrealtime(); if ((PROBE_MASK >> (k)) & 1) pr_acc += now_ - pr_last; pr_last = now_; }
#else
#define PROBE_STAMP(k)
#endif
    const int plo = a_.lo, phi = a_.hi;
#define PH_BEGIN if (ph >= plo && ph < phi) { KArgP a = kargs(); int bx = (int)blockIdx.x, G = (int)gridDim.x; asm volatile("" : "+s"(bx), "+s"(G)); (void)bx; (void)G;
#ifdef PROBE_SYNC2
#define PH_ENDT(k)   if (ph + 1 < phi) { grid.sync(); grid.sync(); } } ++ph;
#else
#define PH_ENDT(k) if (ph + 1 < phi) { if (!xb_ready) { grid.sync(); xbar = xcd_barrier_post((unsigned*)(a->ws + WS_CTL) + 4096, (volatile LAS unsigned*)(lds + LDS_MAIN + 64)); xb_ready = true; } else xcd_barrier(xbar); } PROBE_STAMP(k) } ++ph;
#endif

    PH_BEGIN phase_prep(a, lds); PH_ENDT(0)

    for (int layer = 0; layer < 4; ++layer) {
        const bool even = !(layer & 1);
        const int np = even ? NP_E : NP_O;
        PH_BEGIN phase_norm(a, layer, 0, layer > 0); convert_weights(a, layer, lds); PH_ENDT(1)
#ifndef SKIP_G1
        PH_BEGIN { bf16* H = (bf16*)(a->ws + WS_H); bf16* MIX = (bf16*)(a->ws + WS_MIX); bf16* P = (bf16*)(a->ws + WS_P); float* X = (float*)(a->ws + WS_X); unsigned char* Wb = a->ws + WS_W; const float* mod = (const float*)(a->ws + WS_MOD) + (size_t)layer * 9 * 6144; (void)H; (void)MIX; (void)P; (void)X; (void)mod; pg8::Gemm g{H, (const bf16*)(Wb + W_IN), MT, np, 1024, 1024}; pg8::StaticOrder S; S.init(MT, np, G, bx);
                   pg8::EpiBf16<0> E{P, np, nullptr, 0, 0, 1.f};
                   pg8::gemm_phase<pg8::EpiBf16<0>, pg8::StaticOrder, true, true>(lds, g, S, E); } PH_ENDT(2)
#else
        ++ph;
#endif
        PH_BEGIN if (even) phase_post_even(a, layer); else phase_post_odd(a, layer); PH_ENDT(3)
#ifndef SKIP_G3
        if (even) {
            PH_BEGIN { bf16* H = (bf16*)(a->ws + WS_H); bf16* MIX = (bf16*)(a->ws + WS_MIX); bf16* P = (bf16*)(a->ws + WS_P); float* X = (float*)(a->ws + WS_X); unsigned char* Wb = a->ws + WS_W; const float* mod = (const float*)(a->ws + WS_MOD) + (size_t)layer * 9 * 6144; (void)H; (void)MIX; (void)P; (void)X; (void)mod; pg8::Gemm g{(const bf16*)(a->ws + WS_CQN), (const bf16*)(Wb + W_UQ), MT, 768, 384, 384}; pg8::StaticOrder S; S.init(MT, 768, G, bx);
                       pg8::EpiBf16<0> E{(bf16*)((unsigned char*)a->out + OUT_Q), 768, nullptr, 0, 0, 1.f};
                       pg8::gemm_phase<pg8::EpiBf16<0>, pg8::StaticOrder, true, true>(lds, g, S, E); }
                     { unsigned char* Wb = a->ws + WS_W; pg8::Gemm g{(const bf16*)(a->ws + WS_CKVN), (const bf16*)(Wb + W_UKV), MT, 1024, 256, 256}; pg8::StaticOrder S; S.init(MT, 1024, G, bx);
                       pg8::EpiBf16<0> E{(bf16*)((unsigned char*)a->out + OUT_KV), 1024, nullptr, 0, 0, 1.f};
                       pg8::gemm_phase<pg8::EpiBf16<0>, pg8::StaticOrder, true, true>(lds, g, S, E); }
                     for (int it = bx; it < 192; it += G) scan_item<128, true, 0>(a, layer, it & 63, it >> 6, lds);
            PH_ENDT(4)
        } else { ++ph; }
#else
        ++ph;
#endif
        if (!even) {
        PH_BEGIN for (int it = bx; it < 192; it += G) scan_item<64, false, 0>(a, layer, it & 63, it >> 6, lds); PH_ENDT(5)
        } else { ++ph; }
#ifdef PROBE_MIX2
        PH_BEGIN phase_mixer(a, layer + 8, lds_raw); grid.sync(); PH_ENDT(6)
        --ph;
#endif
        PH_BEGIN phase_mixer(a, layer, lds_raw); PH_ENDT(6 + 7 * (layer & 1))
        PH_BEGIN phase_readout(a, layer); PH_ENDT(7)
#ifndef SKIP_G6
        PH_BEGIN { bf16* H = (bf16*)(a->ws + WS_H); bf16* MIX = (bf16*)(a->ws + WS_MIX); bf16* P = (bf16*)(a->ws + WS_P); float* X = (float*)(a->ws + WS_X); unsigned char* Wb = a->ws + WS_W; const float* mod = (const float*)(a->ws + WS_MOD) + (size_t)layer * 9 * 6144; (void)H; (void)MIX; (void)P; (void)X; (void)mod; pg8::Gemm g{MIX, (const bf16*)(Wb + W_OUT), MT, 1024, 1024, 1024}; pg8::StaticOrder S; S.init(NB * NLAT, 1024, G, bx, 1);
                   pg8::EpiResid E{X, mod, 2048};
                   pg8::gemm_phase<pg8::EpiResid, pg8::StaticOrder, true, true>(lds, g, S, E);
                   if (layer < 3) { pg8::Gemm g2{MIX, (const bf16*)(Wb + W_OUT), MT, 1024, 512, 1024}; pg8::CtxSplitOrder S2{G, bx, 512};
                       pg8::EpiResidSplit E2{X, (float*)(a->ws + WS_T), mod, 2048};
                       pg8::gemm_phase<pg8::EpiResidSplit, pg8::CtxSplitOrder, true, true>(lds, g2, S2, E2); } } PH_ENDT(8)
#else
        ++ph;
#endif
        PH_BEGIN phase_norm(a, layer, 1, layer < 3); PH_ENDT(9)
#ifndef SKIP_G8
        PH_BEGIN { bf16* H = (bf16*)(a->ws + WS_H); bf16* MIX = (bf16*)(a->ws + WS_MIX); bf16* P = (bf16*)(a->ws + WS_P); float* X = (float*)(a->ws + WS_X); unsigned char* Wb = a->ws + WS_W; const float* mod = (const float*)(a->ws + WS_MOD) + (size_t)layer * 9 * 6144; (void)H; (void)MIX; (void)P; (void)X; (void)mod; pg8::Gemm g{H, (const bf16*)(Wb + W_GU), MT, 2 * FF, 1024, 1024}; pg8::StaticOrder S; if (layer < 3) S.init(MT, 2 * FF, G, bx); else S.init(NB * NLAT, 2 * FF, G, bx, 1);
                   pg8::EpiSwiGLU E{P, FF};
                   pg8::gemm_phase<pg8::EpiSwiGLU, pg8::StaticOrder, true, true>(lds, g, S, E); } PH_ENDT(10)
#else
        ++ph;
#endif
#ifndef SKIP_G9
        PH_BEGIN { bf16* H = (bf16*)(a->ws + WS_H); bf16* MIX = (bf16*)(a->ws + WS_MIX); bf16* P = (bf16*)(a->ws + WS_P); float* X = (float*)(a->ws + WS_X); unsigned char* Wb = a->ws + WS_W; const float* mod = (const float*)(a->ws + WS_MOD) + (size_t)layer * 9 * 6144; (void)H; (void)MIX; (void)P; (void)X; (void)mod; pg8::Gemm g{P, (const bf16*)(Wb + W_DN), MT, 1024, FF, FF}; pg8::StaticOrder S; S.init(NB * NLAT, 1024, G, bx, 1);
                   pg8::EpiResid E{X, mod, 5120};
                   pg8::gemm_phase<pg8::EpiResid, pg8::StaticOrder, true, true>(lds, g, S, E);
                   if (layer < 3) { pg8::Gemm g2{P, (const bf16*)(Wb + W_DN), MT, 1024, FF / 2, FF}; pg8::CtxSplitOrder S2{G, bx, FF / 2};
                       pg8::EpiResidSplit E2{X, (float*)(a->ws + WS_T), mod, 5120};
                       pg8::gemm_phase<pg8::EpiResidSplit, pg8::CtxSplitOrder, true, true>(lds, g2, S2, E2); } } PH_ENDT(11)
#else
        ++ph;
#endif
    }
    PH_BEGIN phase_final(a); PH_ENDT(12)
#undef PH_BEGIN
#undef PH_ENDT
#ifdef PROBE_ITEM
    pr_acc += ((volatile LAS unsigned long long*)(lds + LDS_MAIN + 128))[PROBE_ITEM - 1];
#endif
#ifdef PROBE_MASK
    if (blockIdx.x == 0) { const unsigned long long t0_ = __builtin_amdgcn_s_memrealtime(); while (__builtin_amdgcn_s_memrealtime() - t0_ < pr_acc) __builtin_amdgcn_s_sleep(8); }
#endif
}
constexpr int NPH = 1 + 4 * 11 + 1;

extern "C" void kernel_launch(void* const* d_in, const int* in_sizes, int n_in, void* d_out, int out_size, void* d_ws, size_t ws_size, hipStream_t stream) {
    static int grid = 0;
    if (grid == 0) {
        if (n_in != 23 || ws_size < WS_END || out_size != NB * NLAT * DM) { fprintf(stderr, "kernel_launch: unexpected shapes: n_in %d ws %zu (need %zu) out %d\n", n_in, ws_size, (size_t)WS_END, out_size); grid = -1; return; }
        int dev = 0, cus = 0, per_cu = 0;
        hipGetDevice(&dev); hipDeviceGetAttribute(&cus, hipDeviceAttributeMultiprocessorCount, dev);
        if (hipFuncSetAttribute((const void*)mega_fwd, hipFuncAttributeMaxDynamicSharedMemorySize, LDS_BYTES) != hipSuccess) { fprintf(stderr, "kernel_launch: hipFuncSetAttribute failed\n"); grid = -1; return; }
        if (hipOccupancyMaxActiveBlocksPerMultiprocessor(&per_cu, (const void*)mega_fwd, 512, LDS_BYTES) != hipSuccess || per_cu < 1) { fprintf(stderr, "kernel_launch: occupancy query says %d\n", per_cu); per_cu = 1; }
        (void)hipGetLastError();
        grid = cus;
    }
    if (grid < 0) return;
    Args a{};
    for (int i = 0; i < 23; ++i) a.in[i] = (const float*)d_in[i];
    a.out = (float*)d_out; a.ws = (unsigned char*)d_ws; a.lo = 0; a.hi = NPH;
    void* kargv[] = {&a};
    hipError_t e = hipLaunchCooperativeKernel((const void*)mega_fwd, dim3(grid), dim3(512), kargv, LDS_BYTES, stream);
    if (e != hipSuccess) fprintf(stderr, "kernel_launch: cooperative launch failed: %s (grid %d)\n", hipGetErrorString(e), grid);
}
```

```cpp
#include <hip/hip_runtime.h>
#include <hip/hip_cooperative_groups.h>
#include <cstdio>
#include <cstdint>
namespace cg = cooperative_groups;
#define otid() ({ int t_ = (int)threadIdx.x; asm volatile("" : "+v"(t_)); t_; })
extern __shared__ __attribute__((aligned(16))) unsigned char g_lds_dyn[];
#define ptid() (*(volatile __attribute__((address_space(3))) int*)((__attribute__((address_space(3))) unsigned char*)g_lds_dyn + 131072 + 1024 + 4 * (int)threadIdx.x))
namespace pg8 {
#define PG8_LAS __attribute__((address_space(3)))
typedef unsigned short bf16_t;
typedef short bf16x8 __attribute__((ext_vector_type(8)));
typedef float f32x4 __attribute__((ext_vector_type(4)));
typedef unsigned u32x4 __attribute__((ext_vector_type(4)));
constexpr int BM = 256, BK = 64, HALF = 128, HTB = HALF * BK * 2  , STAGE_BYTES = 8 * HTB, NXCD = 8, WGM = 8;

__host__ __device__ __forceinline__ int lds_byte(int r, int c) { const int st = (r >> 4) * 2 + (c >> 5), rr = r & 15, cc = c & 31, ob = rr * 64 + cc * 2; return st * 1024 + (ob ^ (((ob >> 9) & 1) << 5)); }
__host__ __device__ __forceinline__ void stage_rc(int b, int& R, int& C) { const int st = b / 1024, sb = b % 1024, swz = sb ^ (((sb >> 9) & 1) << 5); R = (st >> 1) * 16 + swz / 64; C = (st & 1) * 32 + (swz % 64) / 2; }
__host__ __device__ __forceinline__ int perm32(int rho) { const int n = rho >> 4, i = rho & 15; return 8 * (i >> 2) + 4 * n + (i & 3); }

struct Unit { int pm, pn, koff; };
struct Gemm { const bf16_t* A; const bf16_t* Bt; int M, N, K, ld; };

struct StaticOrder {
    int nM, nN, nwg, G, c, mode;
    __host__ __device__ void init(int M, int N, int G_, int c_, int mode_ = 0) { nM = M / BM; nN = N / BM; nwg = nM * nN; G = G_; c = c_; mode = mode_; }
    __host__ __device__ bool next(int i, Unit& u) const {
        const long L = (long)i * G + c; if (L >= nwg) return false;
        int wgid = (int)L; { const int q = nwg / NXCD, r = nwg % NXCD, xcd = wgid % NXCD, off = wgid / NXCD; wgid = (xcd < r ? xcd * (q + 1) : r * (q + 1) + (xcd - r) * q) + off; }
        const int nig = WGM * nN, gid = wgid / nig, fm = gid * WGM, gsz = (nM - fm) < WGM ? (nM - fm) : WGM;
        u.pm = fm + ((wgid % nig) % gsz); u.pn = (wgid % nig) / gsz; u.koff = 0; if (mode == 1) u.pm = (u.pm >> 3) * 9 + 1 + (u.pm & 7); return true;
    }
    __device__ __forceinline__ void a_ready(const Unit&) const {}
    __device__ __forceinline__ void done(const Unit&) const {}
};
struct CtxSplitOrder {
    int G, c, khalf;
    __device__ bool next(int i, Unit& u) const { const int L = i * G + c; if (L >= 64) return false; u.koff = (L & 1) * khalf; u.pn = (L >> 1) & 3; u.pm = (L >> 3) * 9; return true; }
    __device__ __forceinline__ void a_ready(const Unit&) const {}
    __device__ __forceinline__ void done(const Unit&) const {}
};

__device__ __forceinline__ unsigned cvt_pk_bf16(float lo, float hi) { unsigned r; asm volatile("v_cvt_pk_bf16_f32 %0, %1, %2" : "=v"(r) : "v"(lo), "v"(hi)); return r; }
typedef float f32x2 __attribute__((ext_vector_type(2)));
__device__ __forceinline__ f32x2 gelu_pk(f32x2 v) {
    const f32x2 av = __builtin_elementwise_abs(v), d = av * 0.2316418882f + 1.0f;
    f32x2 t; t.x = __builtin_amdgcn_rcpf(d.x); t.y = __builtin_amdgcn_rcpf(d.y);
    f32x2 q = t * 0.5307027145f + (-0.7265760135f); q = q * t + 0.7107068705f; q = q * t + (-0.142248368f); q = q * t + 0.127414796f; q = q * t;
    const f32x2 s = (v * v) * (-0.72134752044f);
    f32x2 e; e.x = __builtin_amdgcn_exp2f(s.x); e.y = __builtin_amdgcn_exp2f(s.y);
    const f32x2 m = v * (q * e), r = v - m;
    f32x2 o; o.x = v.x < 0.f ? m.x : r.x; o.y = v.y < 0.f ? m.y : r.y; return o;
}

template <int ACT  > struct EpiBf16 {
    static constexpr bool PERM = true, AFTER_DRAIN = false; static_assert(ACT == 0 || ACT == 1, "EpiBf16: ACT is 0 (none) or 1 (gelu_pk)");
    bf16_t* O; int ldc; const float* bias; int split_cols; size_t split_stride; float scale0;
    __device__ __forceinline__ void operator()(const f32x4 (&acc)[2][2][4][2], const Unit& u, int wr, int wc, int fr, int fq) const {
        const int row0 = u.pm * BM + wr * 64 + fr; int colt = u.pn * BM; bf16_t* base = O;
        float sc = 1.f; if (split_cols) { const int t = colt / split_cols; base += (size_t)t * split_stride; colt -= t * split_cols; if (t == 0) sc = scale0; }
        const int col0 = colt + wc * 32 + 8 * fq, bcol0 = u.pn * BM + wc * 32 + 8 * fq;
        f32x4 bv[2][2];
#pragma unroll
        for (int bj = 0; bj < 2; ++bj)
#pragma unroll
            for (int n = 0; n < 2; ++n) bv[bj][n] = bias ? *(const f32x4*)(bias + bcol0 + bj * HALF + 4 * n) : (f32x4){0.f, 0.f, 0.f, 0.f};
#pragma unroll
        for (int ai = 0; ai < 2; ++ai)
#pragma unroll
            for (int m = 0; m < 4; ++m) { bf16_t* rowp = base + (size_t)(row0 + ai * HALF + m * 16) * ldc + col0;
#pragma unroll
                for (int bj = 0; bj < 2; ++bj) { f32x4 v0 = acc[ai][bj][m][0] + bv[bj][0], v1 = acc[ai][bj][m][1] + bv[bj][1];
                    if (ACT == 1) { f32x2 a = gelu_pk((f32x2){v0[0], v0[1]}), b = gelu_pk((f32x2){v0[2], v0[3]}), c = gelu_pk((f32x2){v1[0], v1[1]}), d = gelu_pk((f32x2){v1[2], v1[3]});
                        v0 = (f32x4){a.x, a.y, b.x, b.y}; v1 = (f32x4){c.x, c.y, d.x, d.y}; }
                    v0 = v0 * sc; v1 = v1 * sc; u32x4 w; w.x = cvt_pk_bf16(v0[0], v0[1]); w.y = cvt_pk_bf16(v0[2], v0[3]); w.z = cvt_pk_bf16(v1[0], v1[1]); w.w = cvt_pk_bf16(v1[2], v1[3]);
                    *(u32x4*)(rowp + bj * HALF) = w; } }
    }
};
struct EpiResidSplit {
    static constexpr bool PERM = false, AFTER_DRAIN = false;
    float* X; float* T; const float* mod; int goff; const float* cin;
    __device__ __forceinline__ void operator()(const f32x4 (&acc)[2][2][4][2], const Unit& u, int wr, int wc, int fr, int fq) const {
        const float* gp = mod + 8 * 6144 + goff;
        const int col0 = u.pn * BM + wc * 32 + 4 * fq;
        const bool first = (u.koff == 0);
        float* base = first ? X + (size_t)(u.pm * BM) * 1024 : T + (size_t)((u.pm / 9) * BM) * 1024;
        const float* rbase = cin ? cin + (size_t)((u.pm / 9) * BM) * 1024 : base;
#pragma unroll
        for (int bj = 0; bj < 2; ++bj)
#pragma unroll
            for (int n = 0; n < 2; ++n) { const f32x4 gv = *(const f32x4*)(gp + col0 + bj * HALF + n * 16);
#pragma unroll
                for (int ai = 0; ai < 2; ++ai)
#pragma unroll
                    for (int m = 0; m < 4; ++m) { const size_t o = (size_t)(ai * HALF + wr * 64 + m * 16 + fr) * 1024 + col0 + bj * HALF + n * 16;
                        f32x4 v = gv * acc[ai][bj][m][n];
                        if (first) v = v + *(const f32x4*)(rbase + o);
                        *(f32x4*)(base + o) = v; } }
    }
};
struct EpiSwiGLU {
    static constexpr bool PERM = true, AFTER_DRAIN = false;
    bf16_t* O; int ldc;
    __device__ __forceinline__ void operator()(const f32x4 (&acc)[2][2][4][2], const Unit& u, int wr, int wc, int fr, int fq) const {
        const int row0 = u.pm * BM + wr * 64 + fr; const int col0 = u.pn * HALF + wc * 32 + 8 * fq;
#pragma unroll
        for (int ai = 0; ai < 2; ++ai)
#pragma unroll
            for (int m = 0; m < 4; ++m) { bf16_t* rowp = O + (size_t)(row0 + ai * HALF + m * 16) * ldc + col0;
                float h[8];
#pragma unroll
                for (int n = 0; n < 2; ++n)
#pragma unroll
                    for (int i = 0; i < 4; ++i) { const float g = acc[ai][0][m][n][i], up = acc[ai][1][m][n][i];
                        h[n * 4 + i] = g * __builtin_amdgcn_rcpf(1.0f + __expf(-g)) * up; }
                u32x4 w; w.x = cvt_pk_bf16(h[0], h[1]); w.y = cvt_pk_bf16(h[2], h[3]); w.z = cvt_pk_bf16(h[4], h[5]); w.w = cvt_pk_bf16(h[6], h[7]);
                *(u32x4*)rowp = w; }
    }
};
struct EpiResid {
    static constexpr bool PERM = false, AFTER_DRAIN = false;
    float* X; const float* mod; int goff; const float* xin;
    __device__ __forceinline__ void operator()(const f32x4 (&acc)[2][2][4][2], const Unit& u, int wr, int wc, int fr, int fq) const {
        const int widx = (u.pm % 9 == 0) ? 8 : (u.pm / 9);
        const float* gp = mod + widx * 6144 + goff;
        const int col0 = u.pn * BM + wc * 32 + 4 * fq;
        const float* rb = xin ? xin + (size_t)((u.pm / 9) * 2048 + (u.pm % 9 - 1) * 256) * 1024 : X + (size_t)(u.pm * BM) * 1024;
        float* wb = X + (size_t)(u.pm * BM) * 1024;
#pragma unroll
        for (int bj = 0; bj < 2; ++bj)
#pragma unroll
            for (int n = 0; n < 2; ++n) { const f32x4 gv = *(const f32x4*)(gp + col0 + bj * HALF + n * 16);
#pragma unroll
                for (int ai = 0; ai < 2; ++ai)
#pragma unroll
                    for (int m = 0; m < 4; ++m) { const size_t o = (size_t)(ai * HALF + wr * 64 + m * 16 + fr) * 1024 + col0 + bj * HALF + n * 16;
                        f32x4 x = *(const f32x4*)(rb + o); x = x + gv * acc[ai][bj][m][n]; *(f32x4*)(wb + o) = x; } }
    }
};
template <class Epi, class Sched, bool ALIGN_EPI = false, bool SP2 = false>
__device__ __forceinline__ void gemm_phase(PG8_LAS unsigned char* lds, const Gemm g, const Sched& S, const Epi& E) {
    const int tid = otid(), wid = __builtin_amdgcn_readfirstlane(tid >> 6), lane = tid & 63, wr = wid >> 2, wc = wid & 3, fr = lane & 15, fq = lane >> 4;
    const int K = g.ld, nt = g.K / BK;
    unsigned voffA[2], voffB[2];
#pragma unroll
    for (int i = 0; i < 2; ++i) { int R, C; stage_rc(tid * 16 + i * 8192, R, C); const int Rb = Epi::PERM ? ((R & ~31) + perm32(R & 31)) : R;
        voffA[i] = (unsigned)(R * K + C) * 2u; voffB[i] = (unsigned)(Rb * K + C) * 2u; }
    const size_t kstep = (size_t)(BK * 2);
    const size_t hstep = (size_t)HALF * K * 2;
    const size_t tstep = 2 * hstep;
    const unsigned ldsw = (unsigned)wid * 1024u;
    const int aoff = lds_byte(wr * 64 + fr, fq * 8), boff = lds_byte(wc * 32 + fr, fq * 8);
#define PG8_SA(b, h) (((b) * 2 + (h)) * HTB)
#define PG8_SB(b, h) ((4 + (b) * 2 + (h)) * HTB)
#define PG8_STAGE(bufoff, gbase, voff) do { _Pragma("unroll") for (int _i = 0; _i < 2; ++_i) \
        __builtin_amdgcn_global_load_lds((const unsigned*)((const char*)(gbase) + (voff)[_i]), (PG8_LAS unsigned*)(lds + (bufoff) + ldsw + _i * 8192), 16, 0, 0); } while (0)
#define PG8_LDA(dst, b, h) do { _Pragma("unroll") for (int m = 0; m < 4; ++m) _Pragma("unroll") for (int k = 0; k < 2; ++k) dst[m][k] = *(const PG8_LAS bf16x8*)(lds + PG8_SA(b, h) + aoff + m * 2048 + k * 1024); } while (0)
#define PG8_LDB(dst, b, h) do { _Pragma("unroll") for (int n = 0; n < 2; ++n) _Pragma("unroll") for (int k = 0; k < 2; ++k) dst[n][k] = *(const PG8_LAS bf16x8*)(lds + PG8_SB(b, h) + boff + n * 2048 + k * 1024); } while (0)
#define PG8_MMA(ai, bj, At, Bt) do { __builtin_amdgcn_s_setprio(1); _Pragma("unroll") for (int m = 0; m < 4; ++m) _Pragma("unroll") for (int n = 0; n < 2; ++n) _Pragma("unroll") for (int k = 0; k < 2; ++k) \
        acc[ai][bj][m][n] = __builtin_amdgcn_mfma_f32_16x16x32_bf16(Bt[n][k], At[m][k], acc[ai][bj][m][n], 0, 0, 0); __builtin_amdgcn_s_setprio(0); } while (0)
#define PG8_WAIT_V(n) asm volatile("s_waitcnt vmcnt(" #n ")" ::: "memory")
#define PG8_WAIT_L(n) asm volatile("s_waitcnt lgkmcnt(" #n ")" ::: "memory")
#define PG8_BAR __builtin_amdgcn_s_barrier()
#define PG8_SCHED __builtin_amdgcn_sched_barrier(0)
    Unit cur, nxt; int ui = 0;
    if (!S.next(0, cur)) return;
    f32x4 acc[2][2][4][2];
#pragma unroll
    for (int a = 0; a < 2; ++a)
#pragma unroll
        for (int b = 0; b < 2; ++b)
#pragma unroll
            for (int m = 0; m < 4; ++m)
#pragma unroll
                for (int n = 0; n < 2; ++n) acc[a][b][m][n] = (f32x4){0.f, 0.f, 0.f, 0.f};
    bf16x8 At[4][2], B0[2][2], B1[2][2];
    const char* cA = (const char*)g.A + (size_t)cur.pm * tstep + (size_t)cur.koff * 2; const char* cB = (const char*)g.Bt + (size_t)cur.pn * tstep + (size_t)cur.koff * 2;
    S.a_ready(cur);
    if constexpr (SP2) {
        PG8_STAGE(PG8_SB(0, 0), cB, voffB); PG8_STAGE(PG8_SB(0, 1), cB + hstep, voffB); PG8_STAGE(PG8_SA(0, 0), cA, voffA); PG8_STAGE(PG8_SA(0, 1), cA + hstep, voffA);
        if (wr == 1) PG8_BAR;
        PG8_WAIT_V(2); PG8_BAR;
        PG8_STAGE(PG8_SB(1, 0), cB + kstep, voffB); PG8_STAGE(PG8_SA(1, 0), cA + kstep, voffA); PG8_STAGE(PG8_SB(1, 1), cB + hstep + kstep, voffB);
        PG8_WAIT_V(6); PG8_BAR;
    } else {
        PG8_STAGE(PG8_SB(0, 0), cB, voffB); PG8_STAGE(PG8_SA(0, 0), cA, voffA); PG8_STAGE(PG8_SB(0, 1), cB + hstep, voffB); PG8_STAGE(PG8_SA(0, 1), cA + hstep, voffA);
        if (wr == 1) PG8_BAR;
        PG8_WAIT_V(4); PG8_BAR;
        PG8_STAGE(PG8_SB(1, 0), cB + kstep, voffB); PG8_STAGE(PG8_SA(1, 0), cA + kstep, voffA); PG8_STAGE(PG8_SB(1, 1), cB + hstep + kstep, voffB);
        PG8_WAIT_V(6); PG8_BAR;
    }
    for (;;) {
        const bool has_next = S.next(ui + 1, nxt);
        const char* nA = has_next ? (const char*)g.A + (size_t)nxt.pm * tstep + (size_t)nxt.koff * 2 : cA; const char* nB = has_next ? (const char*)g.Bt + (size_t)nxt.pn * tstep + (size_t)nxt.koff * 2 : cB;
        for (int t = 0; t < nt; t += 2) {
            const bool last = (t == nt - 2);
            const char* a1 = cA + (size_t)(t + 1) * kstep;
            const char* a2 = last ? nA : cA + (size_t)(t + 2) * kstep; const char* b2 = last ? nB : cB + (size_t)(t + 2) * kstep;
            const char* a3 = a2 + kstep; const char* b3 = b2 + kstep;
            if (last && has_next) S.a_ready(nxt);
            if constexpr (SP2) {
            PG8_LDB(B0, 0, 0); PG8_LDB(B1, 0, 1); PG8_SCHED; PG8_LDA(At, 0, 0); PG8_STAGE(PG8_SA(1, 1), a1 + hstep, voffA);
            PG8_WAIT_V(8); PG8_WAIT_L(0); PG8_BAR; PG8_MMA(0, 0, At, B0); PG8_MMA(0, 1, At, B1); PG8_BAR; PG8_SCHED;
            PG8_LDA(At, 0, 1); PG8_STAGE(PG8_SB(0, 0), b2, voffB); PG8_STAGE(PG8_SB(0, 1), b2 + hstep, voffB); PG8_STAGE(PG8_SA(0, 0), a2, voffA);
            PG8_WAIT_V(8); PG8_WAIT_L(0); PG8_BAR; PG8_MMA(1, 0, At, B0); PG8_MMA(1, 1, At, B1); PG8_BAR; PG8_SCHED;
            PG8_LDB(B0, 1, 0); PG8_LDB(B1, 1, 1); PG8_SCHED; PG8_LDA(At, 1, 0); PG8_STAGE(PG8_SA(0, 1), a2 + hstep, voffA);
            PG8_WAIT_V(8); PG8_WAIT_L(0); PG8_BAR; PG8_MMA(0, 0, At, B0); PG8_MMA(0, 1, At, B1); PG8_BAR; PG8_SCHED;
            PG8_LDA(At, 1, 1); PG8_STAGE(PG8_SB(1, 0), b3, voffB); PG8_STAGE(PG8_SB(1, 1), b3 + hstep, voffB); PG8_STAGE(PG8_SA(1, 0), a3, voffA);
            PG8_WAIT_V(8); PG8_WAIT_L(0); PG8_BAR; PG8_MMA(1, 0, At, B0); PG8_MMA(1, 1, At, B1); PG8_BAR; PG8_SCHED;
            } else {
            PG8_LDB(B0, 0, 0); PG8_SCHED; PG8_LDA(At, 0, 0); PG8_STAGE(PG8_SA(1, 1), a1 + hstep, voffA);
            PG8_WAIT_L(8); PG8_BAR; PG8_WAIT_L(0); PG8_MMA(0, 0, At, B0); PG8_BAR; PG8_SCHED;
            PG8_LDB(B1, 0, 1); PG8_STAGE(PG8_SB(0, 0), b2, voffB);
            PG8_BAR; PG8_WAIT_L(0); PG8_MMA(0, 1, At, B1); PG8_BAR;
            PG8_LDA(At, 0, 1); PG8_STAGE(PG8_SA(0, 0), a2, voffA);
            PG8_BAR; PG8_WAIT_L(0); PG8_MMA(1, 0, At, B0); PG8_BAR; PG8_SCHED;
            PG8_STAGE(PG8_SB(0, 1), b2 + hstep, voffB);
            PG8_WAIT_V(6); PG8_BAR; PG8_MMA(1, 1, At, B1); PG8_BAR;
            PG8_LDB(B0, 1, 0); PG8_SCHED; PG8_LDA(At, 1, 0); PG8_STAGE(PG8_SA(0, 1), a2 + hstep, voffA);
            PG8_WAIT_L(8); PG8_BAR; PG8_WAIT_L(0); PG8_MMA(0, 0, At, B0); PG8_BAR; PG8_SCHED;
            PG8_LDB(B1, 1, 1); PG8_STAGE(PG8_SB(1, 0), b3, voffB);
            PG8_BAR; PG8_WAIT_L(0); PG8_MMA(0, 1, At, B1); PG8_BAR;
            PG8_LDA(At, 1, 1); PG8_STAGE(PG8_SA(1, 0), a3, voffA);
            PG8_BAR; PG8_WAIT_L(0); PG8_MMA(1, 0, At, B0); PG8_BAR; PG8_SCHED;
            PG8_STAGE(PG8_SB(1, 1), b3 + hstep, voffB);
            PG8_WAIT_V(6); PG8_BAR; PG8_MMA(1, 1, At, B1); PG8_BAR;
            }
        }
        if constexpr (ALIGN_EPI) { if (wr == 0) PG8_BAR; }
        if constexpr (!Epi::AFTER_DRAIN) { E(acc, cur, wr, wc, fr, fq); S.done(cur); }
        if (!has_next) break;
#pragma unroll
        for (int a = 0; a < 2; ++a)
#pragma unroll
            for (int b = 0; b < 2; ++b)
#pragma unroll
                for (int m = 0; m < 4; ++m)
#pragma unroll
                    for (int n = 0; n < 2; ++n) acc[a][b][m][n] = (f32x4){0.f, 0.f, 0.f, 0.f};
        cur = nxt; cA = nA; cB = nB; ++ui;
        if constexpr (ALIGN_EPI) { if (wr == 1) PG8_BAR; }
    }
    PG8_WAIT_V(0);
    if constexpr (!ALIGN_EPI) { if (wr == 0) PG8_BAR; }
    PG8_BAR;
    if constexpr (Epi::AFTER_DRAIN) { E.fused(acc, cur, wr, wc, fr, fq, lds, wid, lane); S.done(cur); }
#undef PG8_SA
#undef PG8_SB
#undef PG8_STAGE
#undef PG8_LDA
#undef PG8_LDB
#undef PG8_MMA
#undef PG8_WAIT_V
#undef PG8_WAIT_L
#undef PG8_BAR
#undef PG8_SCHED
}
}

typedef unsigned short bf16;
typedef short bf16x8 __attribute__((ext_vector_type(8)));
typedef short s16x4 __attribute__((ext_vector_type(4)));
typedef float f32x4 __attribute__((ext_vector_type(4)));
typedef float f32x16 __attribute__((ext_vector_type(16)));
typedef unsigned u32x4 __attribute__((ext_vector_type(4)));
typedef unsigned u32x2 __attribute__((ext_vector_type(2)));
#define LAS __attribute__((address_space(3)))

constexpr int NB = 8, TPB = 2304, MT = NB * TPB, DM = 1024, NLAT = 2048;
constexpr int NP_E = 3328, NP_O = 3072, FF = 2816;
constexpr float EPSN = 1e-6f;
constexpr size_t MiB = 1u << 20;
constexpr size_t WS_CTL = 0, WS_MOD = 1 * MiB, WS_X = 2 * MiB, WS_H = 74 * MiB, WS_MIX = 110 * MiB, WS_P = 146 * MiB, WS_W = 263 * MiB,
                 WS_OSC = 290 * MiB, WS_KR = 326 * MiB, WS_U = 328 * MiB, WS_T = 342 * MiB, WS_END = 350 * MiB;
constexpr size_t WS_LSUM = 128 * 1024;
constexpr size_t WS_CQN = WS_MIX, WS_CKVN = WS_MIX + 14 * MiB, WS_DSCR = WS_H;
constexpr size_t W_IN = 0, W_OUT = 13 * MiB / 2, W_GU = 17 * MiB / 2, W_DN = 39 * MiB / 2, W_UQ = 25 * MiB, W_UKV = 25 * MiB + 768 * 1024;
constexpr size_t OUT_KV = 0, OUT_Q = 36 * MiB;
constexpr int LDS_MAIN = 131072, LDS_BYTES = LDS_MAIN + 1024 + 2048;

struct Args { const float* in[23]; float* out; unsigned char* ws; int lo, hi; };
typedef __attribute__((address_space(4))) const Args* KArgP;
__device__ __forceinline__ KArgP kargs() { KArgP p = (KArgP)__builtin_amdgcn_kernarg_segment_ptr(); asm volatile("" : "+s"(p)); return p; }

__device__ __forceinline__ float bf2f(unsigned short h) { return __uint_as_float((unsigned)h << 16); }
__device__ __forceinline__ unsigned f2bf(float f) { unsigned u = __float_as_uint(f); return (u + 0x7fffu + ((u >> 16) & 1u)) >> 16; }
__device__ __forceinline__ unsigned pk2(float lo, float hi) { return f2bf(lo) | (f2bf(hi) << 16); }
__device__ __forceinline__ float wave_sum(float v) {
#pragma unroll
    for (int o = 1; o < 64; o <<= 1) v += __shfl_xor(v, o);
    return v;
}
__device__ __forceinline__ float silu_f(float g) { return g / (1.0f + __expf(-g)); }
__device__ __forceinline__ void sincos_r(float ang, float& s, float& c) {
    float r = ang * 0.15915494309189535f; r = r - __builtin_floorf(r);
    s = __builtin_amdgcn_sinf(r); c = __builtin_amdgcn_cosf(r);
}
__device__ __forceinline__ float inv_freq(int i, int half) { return __builtin_amdgcn_exp2f(-(float)i / (float)half * 13.287712379549449f); }

__device__ __forceinline__ void mod_item(KArgP a, int l, int cg, LAS unsigned char* lds) {
    const int tid = otid();
    float* MOD = (float*)(a->ws + WS_MOD);
    LAS float* S = (LAS float*)lds;
    LAS float* R = S + 1024 * 12;
    for (int i = tid; i < 9 * 1024; i += 512) { const int w = i >> 10, k = i & 1023; const float v = (w < 8) ? a->in[1][w * 1024 + k] : a->in[3][k]; S[k * 12 + w] = silu_f(v); }
    __syncthreads();
    const int nl = tid & 63, kp = tid >> 6, n0 = cg * 256;
    f32x4 acc[9];
#pragma unroll
    for (int w = 0; w < 9; ++w) acc[w] = (f32x4){0.f, 0.f, 0.f, 0.f};
    const float* wp = a->in[4] + (size_t)l * 1024 * 6144 + n0 + 4 * nl;
#pragma unroll 8
    for (int k = kp * 128; k < kp * 128 + 128; ++k) {
        const f32x4 wv = *(const f32x4*)(wp + (size_t)k * 6144);
        const f32x4 s0 = *(const LAS f32x4*)(S + k * 12), s1 = *(const LAS f32x4*)(S + k * 12 + 4); const float s8 = S[k * 12 + 8];
        acc[0] += wv * s0[0]; acc[1] += wv * s0[1]; acc[2] += wv * s0[2]; acc[3] += wv * s0[3];
        acc[4] += wv * s1[0]; acc[5] += wv * s1[1]; acc[6] += wv * s1[2]; acc[7] += wv * s1[3]; acc[8] += wv * s8;
    }
#pragma unroll
    for (int w = 0; w < 9; ++w) *(LAS f32x4*)(R + (kp * 9 + w) * 256 + 4 * nl) = acc[w];
    __syncthreads();
    for (int i = tid; i < 9 * 256; i += 512) { const int w = i >> 8, n2 = i & 255; float v = a->in[5][l * 6144 + n0 + n2];
#pragma unroll
        for (int p = 0; p < 8; ++p) v += R[(p * 9 + w) * 256 + n2];
        MOD[(size_t)(l * 9 + w) * 6144 + n0 + n2] = v; }
    __syncthreads();
}
__device__ __forceinline__ void phase_prep(KArgP a, LAS unsigned char* lds) {
    const int tid = otid(), G = gridDim.x;
    if (blockIdx.x == 0) { if (tid < 64) ((unsigned*)(a->ws + WS_CTL))[tid] = 0u; for (int i = tid; i < 3456; i += 512) ((unsigned*)(a->ws + WS_CTL))[4096 + i] = 0u; }
    for (int item = blockIdx.x; item < 96; item += G) mod_item(a, item / 24, item % 24, lds);
}

__device__ __forceinline__ void transpose_item(const float* W, int K, int N, bf16* WT, int k0, int n0, int drow0, LAS float* scr, int lane) {
#pragma unroll 8
    for (int i = 0; i < 32; ++i) { const int kk = 2 * i + (lane >> 5); scr[kk * 33 + (lane & 31)] = W[(size_t)(k0 + kk) * N + n0 + (lane & 31)]; }
    asm volatile("s_waitcnt lgkmcnt(0)" ::: "memory");
    const int c = lane & 7;
#pragma unroll
    for (int j = 0; j < 4; ++j) { const int n = (lane >> 3) + 8 * j; const LAS float* s = scr + (8 * c) * 33 + n;
        u32x4 o; o.x = pk2(s[0 * 33], s[1 * 33]); o.y = pk2(s[2 * 33], s[3 * 33]); o.z = pk2(s[4 * 33], s[5 * 33]); o.w = pk2(s[6 * 33], s[7 * 33]);
        *(u32x4*)(WT + (size_t)(drow0 + n) * K + k0 + 8 * c) = o; }
    asm volatile("s_waitcnt lgkmcnt(0)" ::: "memory");
}
__device__ __forceinline__ void convert_weights(KArgP a, int layer, LAS unsigned char* lds) {
    const int lane = otid() & 63, wave = otid() >> 6;
    LAS float* scr = (LAS float*)(lds + wave * 8448);
    const int gw = blockIdx.x * 8 + wave, NGW = gridDim.x * 8;
    const bool even = !(layer & 1); const int e = layer >> 1;
    const int nin = even ? 3232 : 3072;
    const float* w_in = even ? a->in[11] + (size_t)e * 1024 * 3232 : a->in[18] + (size_t)e * 1024 * 3072;
    unsigned char* Wb = a->ws + WS_W;
    const int nbin = nin / 32;
    const int I_IN = 16 * nbin, I_OUT = 512, I_G = 16 * 88, I_D = 44 * 32, I_UQ = even ? 6 * 24 : 0, I_UKV = even ? 4 * 32 : 0;
    const int NIT = I_IN + I_OUT + 2 * I_G + I_D + I_UQ + I_UKV;
    for (int it = gw; it < NIT; it += NGW) {
        int r = it;
        if (r < I_IN) { const int kb = r / nbin, nb = r % nbin; transpose_item(w_in, 1024, nin, (bf16*)(Wb + W_IN), 64 * kb, 32 * nb, 32 * nb, scr, lane); continue; } r -= I_IN;
        if (r < I_OUT) { const int kb = r / 32, nb = r % 32; transpose_item(a->in[7] + (size_t)layer * 1024 * 1024, 1024, 1024, (bf16*)(Wb + W_OUT), 64 * kb, 32 * nb, 32 * nb, scr, lane); continue; } r -= I_OUT;
        if (r < I_G) { const int kb = r / 88, nb = r % 88, n0 = 32 * nb; transpose_item(a->in[8] + (size_t)layer * 1024 * FF, 1024, FF, (bf16*)(Wb + W_GU), 64 * kb, n0, (n0 >> 7) * 256 + (n0 & 127), scr, lane); continue; } r -= I_G;
        if (r < I_G) { const int kb = r / 88, nb = r % 88, n0 = 32 * nb; transpose_item(a->in[9] + (size_t)layer * 1024 * FF, 1024, FF, (bf16*)(Wb + W_GU), 64 * kb, n0, (n0 >> 7) * 256 + 128 + (n0 & 127), scr, lane); continue; } r -= I_G;
        if (r < I_D) { const int kb = r / 32, nb = r % 32; transpose_item(a->in[10] + (size_t)layer * FF * 1024, FF, 1024, (bf16*)(Wb + W_DN), 64 * kb, 32 * nb, 32 * nb, scr, lane); continue; } r -= I_D;
        if (r < I_UQ) { const int kb = r / 24, nb = r % 24; transpose_item(a->in[15] + (size_t)e * 384 * 768, 384, 768, (bf16*)(Wb + W_UQ), 64 * kb, 32 * nb, 32 * nb, scr, lane); continue; } r -= I_UQ;
        { const int kb = r / 32, nb = r % 32; transpose_item(a->in[17] + (size_t)e * 256 * 1024, 256, 1024, (bf16*)(Wb + W_UKV), 64 * kb, 32 * nb, 32 * nb, scr, lane); }
    }
}

__device__ __forceinline__ void phase_norm(KArgP a, int layer, int which, bool addT) {
    const int lane = otid() & 63, wave = otid() >> 6;
    const int gw = blockIdx.x * 8 + wave, NGW = gridDim.x * 8;
    float* X = (float*)(a->ws + WS_X); bf16* H = (bf16*)(a->ws + WS_H); const float* T = (const float*)(a->ws + WS_T);
    const float* g = a->in[6] + (layer * 2 + which) * 1024;
    const float* mod = (const float*)(a->ws + WS_MOD) + (size_t)layer * 9 * 6144;
    const int shoff = which ? 3072 : 0, scoff = which ? 4096 : 1024;
    const bool from_inputs = (layer == 0 && which == 0);
    constexpr int RB = 3;
    for (int r0 = gw; r0 < MT; r0 += RB * NGW) {
        f32x4 v[RB][4];
#pragma unroll
        for (int k = 0; k < RB; ++k) { const int row = r0 + k * NGW; if (row < MT) { const f32x4* xr = (const f32x4*)(X + (size_t)row * 1024) + lane;
            if (from_inputs) { const int b = row / TPB, j = row - b * TPB; xr = (const f32x4*)(j < 256 ? a->in[2] + (size_t)(b * 256 + j) * 1024 : a->in[0] + (size_t)(b * NLAT + j - 256) * 1024) + lane; }
#pragma unroll
            for (int q = 0; q < 4; ++q) v[k][q] = xr[64 * q]; } }
#pragma unroll
        for (int k = 0; k < RB; ++k) { const int row = r0 + k * NGW; if (row < MT) {
            const int b = row / TPB, j = row - b * TPB, widx = (j < 256) ? 8 : b;
            if (addT && j < 256) { const f32x4* tr = (const f32x4*)(T + (size_t)(b * 256 + j) * 1024) + lane; f32x4* xr = (f32x4*)(X + (size_t)row * 1024) + lane;
#pragma unroll
                for (int q = 0; q < 4; ++q) { v[k][q] = v[k][q] + tr[64 * q]; xr[64 * q] = v[k][q]; } }
            float ss = 0.f;
#pragma unroll
            for (int q = 0; q < 4; ++q) ss += (v[k][q][0] * v[k][q][0] + v[k][q][1] * v[k][q][1]) + (v[k][q][2] * v[k][q][2] + v[k][q][3] * v[k][q][3]);
            const float rstd = __builtin_amdgcn_rsqf(wave_sum(ss) * (1.f / 1024.f) + EPSN);
#pragma unroll
            for (int q = 0; q < 4; ++q) { const int col = 4 * lane + 256 * q;
                const f32x4 gv = *(const f32x4*)(g + col), sc = *(const f32x4*)(mod + widx * 6144 + scoff + col), sh = *(const f32x4*)(mod + widx * 6144 + shoff + col);
                f32x4 y = v[k][q] * rstd * gv * (sc + 1.0f) + sh;
                u32x2 w; w.x = pk2(y[0], y[1]); w.y = pk2(y[2], y[3]);
                *(u32x2*)(H + (size_t)row * 1024 + col) = w; } } }
    }
}

__device__ __forceinline__ void phase_post_even(KArgP a, int layer) {
    const int lane = otid() & 63, wave = otid() >> 6;
    const int gw = blockIdx.x * 8 + wave, NGW = gridDim.x * 8, e = layer >> 1;
    const bf16* P = (const bf16*)(a->ws + WS_P); bf16* CQN = (bf16*)(a->ws + WS_CQN); bf16* CKVN = (bf16*)(a->ws + WS_CKVN); bf16* KR = (bf16*)(a->ws + WS_KR);
    const float* qg = a->in[14] + e * 384; const float* kg = a->in[16] + e * 256;
    for (int row = gw; row < MT; row += NGW) {
        const int b = row / TPB, j = row - b * TPB;
        const bf16* pr = P + (size_t)row * NP_E;
        {   float x[6]; float ss = 0.f;
#pragma unroll
            for (int k = 0; k < 3; ++k) { const unsigned w = *(const unsigned*)(pr + 2560 + 2 * lane + 128 * k); x[2 * k] = bf2f((unsigned short)(w & 0xffff)); x[2 * k + 1] = bf2f((unsigned short)(w >> 16)); ss += x[2 * k] * x[2 * k] + x[2 * k + 1] * x[2 * k + 1]; }
            const float rstd = __builtin_amdgcn_rsqf(wave_sum(ss) * (1.f / 384.f) + EPSN);
#pragma unroll
            for (int k = 0; k < 3; ++k) { const int col = 2 * lane + 128 * k; *(unsigned*)(CQN + (size_t)row * 384 + col) = pk2(x[2 * k] * rstd * qg[col], x[2 * k + 1] * rstd * qg[col + 1]); } }
        {   float x[4]; float ss = 0.f;
#pragma unroll
            for (int k = 0; k < 2; ++k) { const unsigned w = *(const unsigned*)(pr + 2944 + 2 * lane + 128 * k); x[2 * k] = bf2f((unsigned short)(w & 0xffff)); x[2 * k + 1] = bf2f((unsigned short)(w >> 16)); ss += x[2 * k] * x[2 * k] + x[2 * k + 1] * x[2 * k + 1]; }
            const float rstd = __builtin_amdgcn_rsqf(wave_sum(ss) * (1.f / 256.f) + EPSN);
#pragma unroll
            for (int k = 0; k < 2; ++k) { const int col = 2 * lane + 128 * k; *(unsigned*)(CKVN + (size_t)row * 256 + col) = pk2(x[2 * k] * rstd * kg[col], x[2 * k + 1] * rstd * kg[col + 1]); } }
        {   const int d = lane & 31; const float x = bf2f(pr[3200 + d]); const float xp = __shfl_xor(x, 8);
            float o = x;
            if (j >= 256) { const int t = j - 256, blk = d >> 4, wi = d & 15, i8 = wi & 7; const float pos = (float)(blk ? (t & 63) : (t >> 6));
                float s, c; sincos_r(pos * inv_freq(i8, 8), s, c);
                o = (wi < 8) ? (x * c - xp * s) : (xp * s + x * c); }
            if (lane < 32) KR[(size_t)row * 32 + d] = (bf16)f2bf(o); }
    }
}
__device__ __forceinline__ void phase_post_odd(KArgP a, int layer) {
    const int lane = otid() & 63, wave = otid() >> 6;
    const int gw = blockIdx.x * 8 + wave, NGW = gridDim.x * 8;
    bf16* P = (bf16*)(a->ws + WS_P);
    for (int row = gw; row < MT; row += NGW) {
        const int b = row / TPB, j = row - b * TPB; const bool lat = j >= 256; const int t = j - 256;
        bf16* pr = P + (size_t)row * NP_O;
#pragma unroll
        for (int u = 0; u < 2; ++u) { const int pid = lane + 64 * u, h = pid >> 5, i = pid & 31, d1 = h * 64 + i, d2 = d1 + 32;
            float s = 0.f, c = 1.f; if (lat) sincos_r((float)t * inv_freq(i, 32), s, c);
            const float q1 = bf2f(pr[d1]), q2 = bf2f(pr[d2]), k1 = bf2f(pr[256 + d1]) * 0.125f, k2 = bf2f(pr[256 + d2]) * 0.125f;
            if (lat) { pr[d1] = (bf16)f2bf(q1 * c - q2 * s); pr[d2] = (bf16)f2bf(q1 * s + q2 * c); }
            pr[256 + d1] = (bf16)f2bf(k1 * c - k2 * s); pr[256 + d2] = (bf16)f2bf(k1 * s + k2 * c); }
        if (lat) {
#pragma unroll
            for (int u = 0; u < 4; ++u) { const int pid = lane + 64 * u, vec = pid >> 5, pp = pid & 31, blk = pp >> 4, i = pp & 15, d1 = vec * 64 + blk * 32 + i, d2 = d1 + 16;
                const float pos = (float)(blk ? (t & 63) : (t >> 6)); float s, c; sincos_r(pos * inv_freq(i, 16), s, c);
                const float q1 = bf2f(pr[1536 + d1]), q2 = bf2f(pr[1536 + d2]), k1 = bf2f(pr[2048 + d1]), k2 = bf2f(pr[2048 + d2]);
                pr[1536 + d1] = (bf16)f2bf(q1 * c - q2 * s); pr[1536 + d2] = (bf16)f2bf(q1 * s + q2 * c);
                pr[2048 + d1] = (bf16)f2bf(k1 * c - k2 * s); pr[2048 + d2] = (bf16)f2bf(k1 * s + k2 * c); } }
    }
}

__device__ __forceinline__ void phase_readout(KArgP a, int layer) {
    const int lane = otid() & 63, wave = otid() >> 6;
    const int gw = blockIdx.x * 8 + wave, NGW = gridDim.x * 8;
    const bool even = !(layer & 1); const int np = even ? NP_E : NP_O, gcol = even ? 2048 : 1024;
    const bf16* P = (const bf16*)(a->ws + WS_P); const bf16* OF = (const bf16*)(a->ws + WS_OSC); const bf16* OB = OF + (size_t)MT * 512;
    bf16* MIX = (bf16*)(a->ws + WS_MIX);
    float g0 = 1.f, g1 = 1.f; if (even) { g0 = a->in[13][(layer >> 1) * 128 + 2 * lane]; g1 = a->in[13][(layer >> 1) * 128 + 2 * lane + 1]; }
    constexpr int RB = 3;
    for (int r0 = gw; r0 < MT; r0 += RB * NGW) {
        unsigned wf[RB][4], wb[RB][4], wg[RB][4];
#pragma unroll
        for (int k = 0; k < RB; ++k) { const int row = r0 + k * NGW; if (row < MT) {
#pragma unroll
            for (int h = 0; h < 4; ++h) { const int col = h * 128 + 2 * lane;
                wf[k][h] = *(const unsigned*)(OF + (size_t)row * 512 + col); wb[k][h] = *(const unsigned*)(OB + (size_t)row * 512 + col); wg[k][h] = *(const unsigned*)(P + (size_t)row * np + gcol + col); } } }
#pragma unroll
        for (int k = 0; k < RB; ++k) { const int row = r0 + k * NGW; if (row < MT) {
#pragma unroll
            for (int h = 0; h < 4; ++h) { const int col = h * 128 + 2 * lane;
                const float o0 = bf2f((unsigned short)(wf[k][h] & 0xffff)) + bf2f((unsigned short)(wb[k][h] & 0xffff)), o1 = bf2f((unsigned short)(wf[k][h] >> 16)) + bf2f((unsigned short)(wb[k][h] >> 16));
                const float rstd = __builtin_amdgcn_rsqf(wave_sum(o0 * o0 + o1 * o1) * (1.f / 128.f) + EPSN);
                const float y0 = o0 * rstd * g0 * silu_f(bf2f((unsigned short)(wg[k][h] & 0xffff))), y1 = o1 * rstd * g1 * silu_f(bf2f((unsigned short)(wg[k][h] >> 16)));
                *(unsigned*)(MIX + (size_t)row * 1024 + col) = pk2(y0, y1); } } }
    }
}
__device__ __forceinline__ void phase_final(KArgP a) {
    const int lane = otid() & 63, wave = otid() >> 6;
    const int gw = blockIdx.x * 8 + wave, NGW = gridDim.x * 8;
    const float* X = (const float*)(a->ws + WS_X); const float* g = a->in[22];
    constexpr int RB = 4;
    for (int r0 = gw; r0 < NB * NLAT; r0 += RB * NGW) {
        f32x4 v[RB][4];
#pragma unroll
        for (int k = 0; k < RB; ++k) { const int r = r0 + k * NGW; if (r < NB * NLAT) { const int row = (r >> 11) * TPB + 256 + (r & 2047); const f32x4* xr = (const f32x4*)(X + (size_t)row * 1024) + lane;
#pragma unroll
            for (int q = 0; q < 4; ++q) v[k][q] = xr[64 * q]; } }
#pragma unroll
        for (int k = 0; k < RB; ++k) { const int r = r0 + k * NGW; if (r < NB * NLAT) { float ss = 0.f;
#pragma unroll
            for (int q = 0; q < 4; ++q) ss += (v[k][q][0] * v[k][q][0] + v[k][q][1] * v[k][q][1]) + (v[k][q][2] * v[k][q][2] + v[k][q][3] * v[k][q][3]);
            const float rstd = __builtin_amdgcn_rsqf(wave_sum(ss) * (1.f / 1024.f) + EPSN);
#pragma unroll
            for (int q = 0; q < 4; ++q) { const int col = 4 * lane + 256 * q; const f32x4 gv = *(const f32x4*)(g + col);
                *(f32x4*)(a->out + (size_t)r * 1024 + col) = v[k][q] * rstd * gv; } } }
    }
}
__device__ __forceinline__ unsigned cvtpk2(float lo, float hi) { unsigned r; asm("v_cvt_pk_bf16_f32 %0, %1, %2" : "=v"(r) : "v"(lo), "v"(hi)); return r; }
__device__ __forceinline__ f32x4 mfma16(bf16x8 a, bf16x8 b, f32x4 c) { return __builtin_amdgcn_mfma_f32_16x16x32_bf16(a, b, c, 0, 0, 0); }

template <int DK, bool HG, int MODE>
__device__ __forceinline__ void scan_item(KArgP a, int layer, int item, int seg, LAS unsigned char* lds) {
    const int tid = otid(), wid = tid >> 6, lane = tid & 63, l15 = lane & 15, q4 = lane >> 4;
    const int h = item & 3, dir = (item >> 2) & 1, b = item >> 3;
    constexpr int TPT = DK / 8, QS = DK * 2 + 16, TS = 144;
    constexpr int NP = HG ? NP_E : NP_O;
    LAS unsigned char* Lqt = lds; LAS unsigned char* Lkt = Lqt + 64 * QS; LAS unsigned char* Lqh = Lkt + 64 * QS;
    LAS unsigned char* LkhT = Lqh + 64 * QS; LAS unsigned char* LvT = LkhT + DK * TS; LAS unsigned char* Latt = LvT + 128 * TS;
    LAS float* Ltot = (LAS float*)(Latt + 64 * TS); LAS float* Lbl = Ltot + 512;
    const bf16* P = (const bf16*)(a->ws + WS_P);
    bf16* OSC = (bf16*)(a->ws + WS_OSC) + (size_t)dir * MT * 512;
    f32x4* Ub = (f32x4*)(a->ws + WS_U); float* Lb = (float*)(a->ws + WS_LSUM);
    const int c = tid & (DK - 1), tq = tid / DK;
    float lb = 0.f, lg = 0.f, qscale = 1.f; int qcol, zcol;
    if (HG) { qscale = 0.08838834764831845f; qcol = h * 128 + c; zcol = (dir ? 1536 : 1024) + h * 128 + c;
        if (layer >= 2) { const float l0 = a->in[12][(0 * 2 + dir) * 512 + h * 128 + c], l1 = a->in[12][(1 * 2 + dir) * 512 + h * 128 + c]; lb = 1.f / (1.f + __expf(l0 - l1)); } }
    else { qcol = h * 64 + c; zcol = 256 + h * 64 + c; const float x = a->in[19][((layer >> 1) * 2 + dir) * 4 + h]; lg = -__logf(1.f + __expf(-x)); }
    const int vcol = 512 + h * 128;
    const int rowbase = b * TPB;
    const int tv = lane, c8v = wid;
    unsigned short rq[TPT], rz[TPT]; bf16x8 rv[2];
#define SC_JB(ci) (dir ? ((ci) < 4 ? 255 - 64 * (ci) : 2303 - 64 * ((ci) - 4)) : 64 * (ci))
#define SC_LOAD(ci) do { const int jb_ = SC_JB(ci), sg_ = dir ? -1 : 1; \
        _Pragma("unroll") for (int i = 0; i < TPT; ++i) { const bf16* pr_ = P + (size_t)(rowbase + jb_ + sg_ * (tq * TPT + i)) * NP; if (MODE) rq[i] = pr_[qcol]; rz[i] = pr_[zcol]; } \
        { const bf16* pv_ = P + (size_t)(rowbase + jb_ + sg_ * tv) * NP + vcol; rv[0] = *(const bf16x8*)(pv_ + c8v * 8); rv[1] = *(const bf16x8*)(pv_ + (c8v + 8) * 8); } } while (0)
    f32x4 Sacc[DK / 16];
#pragma unroll
    for (int i = 0; i < DK / 16; ++i) Sacc[i] = (f32x4){0.f, 0.f, 0.f, 0.f};
    const int c0 = 9 * seg;
    SC_LOAD(c0);
    if (MODE) {
        for (int s_ = 0; s_ < seg; ++s_) {
#pragma unroll
            for (int i = 0; i < DK / 16; ++i) { f32x4 v = Sacc[i];
                if (s_ > 0) { const f32x4 l4 = *(const f32x4*)(Lb + (size_t)(item * 3 + s_) * 128 + 16 * i + 4 * q4); v[0] *= __expf(l4[0]); v[1] *= __expf(l4[1]); v[2] *= __expf(l4[2]); v[3] *= __expf(l4[3]); }
                Sacc[i] = v + Ub[((size_t)(item * 3 + s_) * (DK / 16) + i) * 512 + tid]; }
        }
    }
    float lsum = 0.f;
    for (int ci = c0; ci < c0 + 9; ++ci) {
#pragma unroll
        for (int u = 0; u < 2; ++u)
#pragma unroll
            for (int e = 0; e < 8; ++e) *(LAS unsigned short*)(LvT + ((c8v + 8 * u) * 8 + e) * TS + tv * 2) = (unsigned short)rv[u][e];
        float zf[TPT], qf[TPT];
#pragma unroll
        for (int i = 0; i < TPT; ++i) { zf[i] = bf2f(rz[i]); if (MODE) qf[i] = bf2f(rq[i]) * qscale; }
        const int jb = SC_JB(ci), sg = dir ? -1 : 1;
        if (ci + 1 < c0 + 9) SC_LOAD(ci + 1);
        float kk_[TPT], e1v[TPT], e2v[TPT]; float Eref, Ebr, dlast;
        if (HG) {
            float fv[TPT];
#pragma unroll
            for (int i = 0; i < TPT; ++i) { const float z = fminf(fmaxf(zf[i], -30.f), 30.f);
                const float t = __expf(-fabsf(z)), r = __builtin_amdgcn_rcpf(1.f + t), tr = t * r;
                const float sig = z >= 0.f ? r : tr, sigm = z >= 0.f ? tr : r;
                kk_[i] = (1.f - lb) * sigm; fv[i] = lb + (1.f - lb) * sig; }
            float run = 1.f;
            if (tq < 2) {
#pragma unroll
                for (int i = TPT - 1; i >= 0; --i) { e2v[i] = run; run *= fv[i]; }
            } else {
#pragma unroll
                for (int i = 0; i < TPT; ++i) { run *= fv[i]; e1v[i] = run; }
            }
            Ltot[tq * 128 + c] = run;
            __syncthreads();
            const float t0 = Ltot[c], t1 = Ltot[128 + c], t2 = Ltot[256 + c], t3 = Ltot[384 + c];
            Eref = t0 * t1; Ebr = t2 * t3; dlast = Eref * Ebr;
            const float mul = (tq == 0) ? t1 : ((tq == 3) ? t2 : 1.f);
            if (tq < 2) {
#pragma unroll
                for (int i = 0; i < TPT; ++i) { e2v[i] = fmaxf(e2v[i] * mul, 1e-30f); if (MODE) e1v[i] = __builtin_amdgcn_rcpf(e2v[i]); }
            } else {
#pragma unroll
                for (int i = 0; i < TPT; ++i) { e1v[i] = fmaxf(e1v[i] * mul, 1e-30f); e2v[i] = __builtin_amdgcn_rcpf(e1v[i]); }
            }
            lsum += __logf(fmaxf(dlast, 1e-37f));
        } else {
#pragma unroll
            for (int i = 0; i < TPT; ++i) { kk_[i] = zf[i]; e1v[i] = __expf((float)(tq * TPT + i - 31) * lg); e2v[i] = __builtin_amdgcn_rcpf(e1v[i]); }
            Eref = __expf(32.f * lg); Ebr = Eref; dlast = Eref * Ebr;
            lsum += 64.f * lg;
        }
        unsigned short kh[TPT];
        if (MODE) {
#pragma unroll
            for (int i = 0; i < TPT; ++i) { const int tau = tq * TPT + i;
                const float qt = qf[i] * e1v[i], kt = kk_[i] * e2v[i];
                const unsigned wq = cvtpk2(qt, qt * Eref), wk = cvtpk2(kt, kt * Ebr);
                *(LAS unsigned short*)(Lqt + tau * QS + c * 2) = (unsigned short)(wq & 0xffff);
                *(LAS unsigned short*)(Lqh + tau * QS + c * 2) = (unsigned short)(wq >> 16);
                *(LAS unsigned short*)(Lkt + tau * QS + c * 2) = (unsigned short)(wk & 0xffff);
                kh[i] = (unsigned short)(wk >> 16); }
        } else {
#pragma unroll
            for (int i = 0; i < TPT; ++i) kh[i] = (unsigned short)(cvtpk2(kk_[i] * e2v[i] * Ebr, 0.f) & 0xffff);
        }
#pragma unroll
        for (int i8 = 0; i8 < TPT / 8; ++i8) { u32x4 w; w.x = kh[8 * i8] | ((unsigned)kh[8 * i8 + 1] << 16); w.y = kh[8 * i8 + 2] | ((unsigned)kh[8 * i8 + 3] << 16);
            w.z = kh[8 * i8 + 4] | ((unsigned)kh[8 * i8 + 5] << 16); w.w = kh[8 * i8 + 6] | ((unsigned)kh[8 * i8 + 7] << 16);
            *(LAS u32x4*)(LkhT + c * TS + (tq * TPT + 8 * i8) * 2) = w; }
        if (tq == 0) Lbl[c] = dlast;
        __syncthreads();
        const int dvl = 16 * wid + l15;
        const bf16x8 bv0 = *(const LAS bf16x8*)(LvT + dvl * TS + (8 * q4) * 2), bv1 = *(const LAS bf16x8*)(LvT + dvl * TS + (32 + 8 * q4) * 2);
        if (MODE) {
#pragma unroll
            for (int tt = 0; tt < 2; ++tt) { const int idx = 2 * wid + tt, si = idx >> 2, ti = idx & 3;
                f32x4 acc = (f32x4){0.f, 0.f, 0.f, 0.f};
#pragma unroll
                for (int kk = 0; kk < DK / 32; ++kk) { const bf16x8 A = *(const LAS bf16x8*)(Lkt + (16 * si + l15) * QS + (32 * kk + 8 * q4) * 2);
                    const bf16x8 B = *(const LAS bf16x8*)(Lqt + (16 * ti + l15) * QS + (32 * kk + 8 * q4) * 2); acc = mfma16(A, B, acc); }
                const int t = 16 * ti + l15, s0 = 16 * si + 4 * q4;
                u32x2 w; w.x = pk2(s0 + 0 <= t ? acc[0] : 0.f, s0 + 1 <= t ? acc[1] : 0.f); w.y = pk2(s0 + 2 <= t ? acc[2] : 0.f, s0 + 3 <= t ? acc[3] : 0.f);
                *(LAS u32x2*)(Latt + t * TS + s0 * 2) = w; }
            __syncthreads();
            bf16x8 Sb[DK / 32];
#pragma unroll
            for (int kk = 0; kk < DK / 32; ++kk) { u32x4 w; w.x = pk2(Sacc[2 * kk][0], Sacc[2 * kk][1]); w.y = pk2(Sacc[2 * kk][2], Sacc[2 * kk][3]);
                w.z = pk2(Sacc[2 * kk + 1][0], Sacc[2 * kk + 1][1]); w.w = pk2(Sacc[2 * kk + 1][2], Sacc[2 * kk + 1][3]); Sb[kk] = __builtin_bit_cast(bf16x8, w); }
#pragma unroll
            for (int ti = 0; ti < 4; ++ti) {
                f32x4 acc = (f32x4){0.f, 0.f, 0.f, 0.f};
                { const bf16x8 A = *(const LAS bf16x8*)(Latt + (16 * ti + l15) * TS + (8 * q4) * 2); acc = mfma16(A, bv0, acc); }
                if (ti >= 2) { const bf16x8 A = *(const LAS bf16x8*)(Latt + (16 * ti + l15) * TS + (32 + 8 * q4) * 2); acc = mfma16(A, bv1, acc); }
#pragma unroll
                for (int kk = 0; kk < DK / 32; ++kk) {
                    const s16x4 lo = *(const LAS s16x4*)(Lqh + (16 * ti + l15) * QS + (32 * kk + 4 * q4) * 2), hi = *(const LAS s16x4*)(Lqh + (16 * ti + l15) * QS + (32 * kk + 16 + 4 * q4) * 2);
                    const bf16x8 A = (bf16x8){lo[0], lo[1], lo[2], lo[3], hi[0], hi[1], hi[2], hi[3]};
                    acc = mfma16(A, Sb[kk], acc); }
#pragma unroll
                for (int r = 0; r < 4; ++r) { const int t = 16 * ti + 4 * q4 + r;
                    OSC[(size_t)(rowbase + jb + sg * t) * 512 + h * 128 + dvl] = (bf16)f2bf(acc[r]); }
            }
        }
#pragma unroll
        for (int i = 0; i < DK / 16; ++i) {
            const f32x4 d4 = *(const LAS f32x4*)(Lbl + 16 * i + 4 * q4);
            f32x4 s = Sacc[i] * d4;
            const bf16x8 A0 = *(const LAS bf16x8*)(LkhT + (16 * i + l15) * TS + (8 * q4) * 2), A1 = *(const LAS bf16x8*)(LkhT + (16 * i + l15) * TS + (32 + 8 * q4) * 2);
            s = mfma16(A0, bv0, s); s = mfma16(A1, bv1, s); Sacc[i] = s; }
        __syncthreads();
    }
    if (!MODE) {
#pragma unroll
        for (int i = 0; i < DK / 16; ++i) Ub[((size_t)(item * 3 + seg) * (DK / 16) + i) * 512 + tid] = Sacc[i];
        if (tq == 0) Lb[(size_t)(item * 3 + seg) * 128 + c] = lsum;
    }
#undef SC_JB
#undef SC_LOAD
}

#define SBAR() __builtin_amdgcn_sched_barrier(0)
__device__ __forceinline__ int crow(int r, int hi) { return (r & 3) + 8 * (r >> 2) + 4 * hi; }
__device__ __forceinline__ unsigned cvtpk(float lo, float hi) { unsigned r; asm volatile("v_cvt_pk_bf16_f32 %0, %1, %2" : "=v"(r) : "v"(lo), "v"(hi)); return r; }
__device__ __forceinline__ void partialSM(f32x16& p0, f32x16& p1, float& m_reg, float& mn, float& alpha, float C, float thr_raw) {
    float pmax = p0[0];
#pragma unroll
    for (int r = 1; r < 16; ++r) pmax = fmaxf(pmax, p0[r]);
#pragma unroll
    for (int r = 0; r < 16; ++r) pmax = fmaxf(pmax, p1[r]);
    { auto rr = __builtin_amdgcn_permlane32_swap(__float_as_uint(pmax), __float_as_uint(pmax), false, false);
      pmax = fmaxf(__uint_as_float(rr[0]), __uint_as_float(rr[1])); }
    if (__builtin_expect(__all(pmax - m_reg <= thr_raw), 1)) { mn = m_reg; alpha = 1.f; }
    else { mn = fmaxf(m_reg, pmax); alpha = __builtin_amdgcn_exp2f((m_reg - mn) * C); m_reg = mn; }
    const float mnC = -mn * C;
#pragma unroll
    for (int r = 0; r < 16; ++r) p0[r] = fmaf(p0[r], C, mnC);
#pragma unroll
    for (int r = 0; r < 16; ++r) p1[r] = fmaf(p1[r], C, mnC);
#pragma unroll
    for (int r = 0; r < 16; ++r) p0[r] = __builtin_amdgcn_exp2f(p0[r]);
}
__device__ __forceinline__ void finishSM(f32x16& p0, f32x16& p1, float alpha, float& l_reg, bf16x8& pa0, bf16x8& pa1, bf16x8& pa2, bf16x8& pa3) {
#pragma unroll
    for (int r = 0; r < 16; ++r) p1[r] = __builtin_amdgcn_exp2f(p1[r]);
    float ps = 0;
#pragma unroll
    for (int r = 0; r < 16; ++r) ps += p0[r];
#pragma unroll
    for (int r = 0; r < 16; ++r) ps += p1[r];
    { auto rr = __builtin_amdgcn_permlane32_swap(__float_as_uint(ps), __float_as_uint(ps), false, false);
      ps = __uint_as_float(rr[0]) + __uint_as_float(rr[1]); }
    l_reg = l_reg * alpha + ps;
#define PK4(P, BASE, OUT) do { unsigned a0 = cvtpk(P[BASE + 0], P[BASE + 1]), a1 = cvtpk(P[BASE + 2], P[BASE + 3]);   \
    unsigned b0 = cvtpk(P[BASE + 4], P[BASE + 5]), b1 = cvtpk(P[BASE + 6], P[BASE + 7]);                              \
    auto r0 = __builtin_amdgcn_permlane32_swap(a0, b0, false, false); auto r1 = __builtin_amdgcn_permlane32_swap(a1, b1, false, false); \
    u32x4 w = {r0[0], r1[0], r0[1], r1[1]}; OUT = __builtin_bit_cast(bf16x8, w); } while (0)
    PK4(p0, 0, pa0); PK4(p0, 8, pa1); PK4(p1, 0, pa2); PK4(p1, 8, pa3);
#undef PK4
}
template <int ND0, int KROWB>
__device__ __forceinline__ void qkt(f32x16& p0, f32x16& p1, const char* Ks, const bf16x8* qr, int r32, int hi) {
    p0 = f32x16{}; p1 = f32x16{};
#pragma unroll
    for (int d0 = 0; d0 < ND0; ++d0) { const int cb = (d0 * 16 + hi * 8) * 2;
        const bf16x8 b0 = *reinterpret_cast<const bf16x8*>(Ks + r32 * KROWB + (cb ^ ((r32 & 7) << 4)));
        const bf16x8 b1 = *reinterpret_cast<const bf16x8*>(Ks + (32 + r32) * KROWB + (cb ^ ((r32 & 7) << 4)));
        p0 = __builtin_amdgcn_mfma_f32_32x32x16_bf16(b0, qr[d0], p0, 0, 0, 0);
        p1 = __builtin_amdgcn_mfma_f32_32x32x16_bf16(b1, qr[d0], p1, 0, 0, 0); }
}
template <int NCB> __device__ __forceinline__ int v_st(int k, int c) { const int kk = (k & ~0xC) | ((k & 4) << 1) | ((k & 8) >> 1); return ((kk >> 3) * NCB + (c >> 5)) * 512 + ((kk & 7) * 32 + (c & 31)) * 2; }
__device__ __forceinline__ int v_rd_base(int lane) { return ((lane & 3) << 3) | (((lane >> 2) & 3) << 6) | (((lane >> 4) & 1) << 5) | (((lane >> 5) & 1) << 8); }
template <int OFF> __device__ __forceinline__ s16x4 tr_read(int vb) {
    s16x4 r; asm volatile("ds_read_b64_tr_b16 %0, %1 offset:%2" : "=&v"(r) : "v"(vb), "i"(OFF) : "memory"); return r;
}
template <int NCB, int D0> __device__ __forceinline__ void pv_one(f32x16& od, int vb, bf16x8 pa0, bf16x8 pa1, bf16x8 pa2, bf16x8 pa3) {
#define VOFF(ks, half) (D0 * 512 + (ks) * (NCB * 1024) + (half) * (NCB * 512))
    const s16x4 l0 = tr_read<VOFF(0, 0)>(vb), h0 = tr_read<VOFF(0, 1)>(vb), l1 = tr_read<VOFF(1, 0)>(vb), h1 = tr_read<VOFF(1, 1)>(vb);
    const s16x4 l2 = tr_read<VOFF(2, 0)>(vb), h2 = tr_read<VOFF(2, 1)>(vb), l3 = tr_read<VOFF(3, 0)>(vb), h3 = tr_read<VOFF(3, 1)>(vb);
#undef VOFF
    asm volatile("s_waitcnt lgkmcnt(0)" ::: "memory"); SBAR();
#define PK(L, H) (bf16x8){L[0], L[1], L[2], L[3], H[0], H[1], H[2], H[3]}
    od = __builtin_amdgcn_mfma_f32_32x32x16_bf16(pa0, PK(l0, h0), od, 0, 0, 0);
    od = __builtin_amdgcn_mfma_f32_32x32x16_bf16(pa1, PK(l1, h1), od, 0, 0, 0);
    od = __builtin_amdgcn_mfma_f32_32x32x16_bf16(pa2, PK(l2, h2), od, 0, 0, 0);
    od = __builtin_amdgcn_mfma_f32_32x32x16_bf16(pa3, PK(l3, h3), od, 0, 0, 0);
#undef PK
}
template <int NCB> __device__ __forceinline__ void pv_all(f32x16* o, int vb, bf16x8 pa0, bf16x8 pa1, bf16x8 pa2, bf16x8 pa3) {
    pv_one<NCB, 0>(o[0], vb, pa0, pa1, pa2, pa3); pv_one<NCB, 1>(o[1], vb, pa0, pa1, pa2, pa3);
    if constexpr (NCB == 4) { pv_one<NCB, 2>(o[2], vb, pa0, pa1, pa2, pa3); pv_one<NCB, 3>(o[3], vb, pa0, pa1, pa2, pa3); }
}

template <int DQK, int DV, int KROWB>
__device__ __forceinline__ void attn_core(const bf16x8* qr, const bf16* kA, int sA, const bf16* kB, int sB, const bf16* vP, int sV,
                                          int NT, float C, float thr_raw, char* lds, f32x16* o, float& l_out, const int tid) {
    constexpr int NCB = DV / 32, SHM_V = 64 * DV * 2, SHM_K = 64 * KROWB, ND0 = DQK / 16;
    constexpr int PPR = DQK / 8, NPK = 64 * PPR, NKS = (NPK + 511) / 512, VPR = DV / 8, NVS = 64 * VPR / 512;
    const int wid = tid >> 6, lane = tid & 63, r32 = lane & 31, hi = lane >> 5;
    char* V_lds = lds; char* K_lds = lds + 2 * SHM_V;
    float* wsf = (float*)(lds + 2 * SHM_V + 2 * SHM_K) + wid * 64; float* al_l = wsf + 32;
    float m_reg = -1e30f, l_reg = 0;
    const bf16* kp[NKS]; int kadv[NKS], kst[NKS]; bool kval[NKS];
#pragma unroll
    for (int i = 0; i < NKS; ++i) { int p = tid + 512 * i; kval[i] = p < NPK; if (!kval[i]) p -= 512; const int row = p / PPR, c8 = p - row * PPR;
        if (c8 < 8) { kp[i] = kA + (size_t)row * sA + c8 * 8; kadv[i] = 64 * sA; } else { kp[i] = kB + (size_t)row * sB + (c8 - 8) * 8; kadv[i] = 64 * sB; }
        kst[i] = row * KROWB + ((c8 * 16) ^ ((row & 7) << 4)); }
    const bf16* vp[NVS]; int vst[NVS];
#pragma unroll
    for (int i = 0; i < NVS; ++i) { const int p = tid + 512 * i, row = p / VPR, c8 = p % VPR; vp[i] = vP + (size_t)row * sV + c8 * 8; vst[i] = v_st<NCB>(row, c8 * 8); }
    const int vadv = 64 * sV;
    const int vb0 = (int)(uintptr_t)V_lds + v_rd_base(lane);
    struct { bf16x8 ks[NKS]; bf16x8 vs[NVS]; } sr_[1];
#define SLOAD(i, t) do { _Pragma("unroll") for (int s_ = 0; s_ < NKS; ++s_) sr_[i].ks[s_] = *(const bf16x8*)(kp[s_] + (size_t)(t) * kadv[s_]); \
        _Pragma("unroll") for (int s_ = 0; s_ < NVS; ++s_) sr_[i].vs[s_] = *(const bf16x8*)(vp[s_] + (size_t)(t) * vadv); } while (0)
#define SWRITE(b, i) do { _Pragma("unroll") for (int s_ = 0; s_ < NVS; ++s_) *(bf16x8*)(V_lds + (b) * SHM_V + vst[s_]) = sr_[i].vs[s_]; \
        _Pragma("unroll") for (int s_ = 0; s_ < NKS; ++s_) if (kval[s_]) *(bf16x8*)(K_lds + (b) * SHM_K + kst[s_]) = sr_[i].ks[s_]; } while (0)
#define RESC(a) do { if (__any((a) < 1.f)) { if (hi == 0) al_l[r32] = (a); asm volatile("s_waitcnt lgkmcnt(0)" ::: "memory"); \
        _Pragma("unroll") for (int d = 0; d < NCB; ++d) _Pragma("unroll") for (int r = 0; r < 16; ++r) o[d][r] *= al_l[crow(r, hi)]; } } while (0)
    f32x16 pA0, pA1, pB0, pB1; float mnA, mnB, alA, alB; bf16x8 pa0, pa1, pa2, pa3;
    constexpr int SE = 0, SO = 0;
    SLOAD(SE, 0); SWRITE(0, SE); __syncthreads();
    qkt<ND0, KROWB>(pA0, pA1, K_lds, qr, r32, hi); partialSM(pA0, pA1, m_reg, mnA, alA, C, thr_raw);
    SLOAD(SO, 1);
    SWRITE(1, SO); __syncthreads();
    for (int j = 1; j + 1 < NT; j += 2) {
        SBAR(); qkt<ND0, KROWB>(pB0, pB1, K_lds + SHM_K, qr, r32, hi);
        finishSM(pA0, pA1, alA, l_reg, pa0, pa1, pa2, pa3); SBAR();
        SLOAD(SO, j + 1); SBAR();
        pv_all<NCB>(o, vb0, pa0, pa1, pa2, pa3); partialSM(pB0, pB1, m_reg, mnB, alB, C, thr_raw);
        __syncthreads(); SWRITE(0, SE);
        RESC(alB); __syncthreads();
        SBAR(); qkt<ND0, KROWB>(pA0, pA1, K_lds, qr, r32, hi);
        finishSM(pB0, pB1, alB, l_reg, pa0, pa1, pa2, pa3); SBAR();
        SLOAD(SE, j + 2); SBAR();
        pv_all<NCB>(o, vb0 + SHM_V, pa0, pa1, pa2, pa3); partialSM(pA0, pA1, m_reg, mnA, alA, C, thr_raw);
        __syncthreads(); SWRITE(1, SO);
        RESC(alA); __syncthreads();
    }
    SBAR(); qkt<ND0, KROWB>(pB0, pB1, K_lds + SHM_K, qr, r32, hi);
    finishSM(pA0, pA1, alA, l_reg, pa0, pa1, pa2, pa3); SBAR();
    pv_all<NCB>(o, vb0, pa0, pa1, pa2, pa3); partialSM(pB0, pB1, m_reg, mnB, alB, C, thr_raw);
    __syncthreads(); RESC(alB);
    finishSM(pB0, pB1, alB, l_reg, pa0, pa1, pa2, pa3); SBAR();
    pv_all<NCB>(o, vb0 + SHM_V, pa0, pa1, pa2, pa3);
    l_out = l_reg;
#undef SLOAD
#undef SWRITE
#undef RESC
}

__device__ __forceinline__ void mla_item(KArgP a, int b, int h, int qb, char* lds) {
    const int tid = ptid(), wid = tid >> 6, lane = tid & 63, r32 = lane & 31, hi = lane >> 5;
    const bf16* Qb = (const bf16*)((const unsigned char*)a->out + OUT_Q); const bf16* KV = (const bf16*)((const unsigned char*)a->out + OUT_KV);
    const bf16* KR = (const bf16*)(a->ws + WS_KR); bf16* MIX = (bf16*)(a->ws + WS_MIX);
    const int row0 = b * TPB + qb * 256, krow0 = b * TPB, NT = qb ? 36 : 4;
    const int row = row0 + wid * 32 + r32;
    const bf16* Qw = Qb + (size_t)row * 768 + h * 96;
    bf16x8 qr[6];
#pragma unroll
    for (int d0 = 0; d0 < 4; ++d0) qr[d0] = *(const bf16x8*)(Qw + d0 * 16 + hi * 8);
    const int t = (qb - 1) * 256 + wid * 32 + r32;
#pragma unroll
    for (int d0 = 4; d0 < 6; ++d0) {
        const bf16x8 x1 = *(const bf16x8*)(Qw + d0 * 16), x2 = *(const bf16x8*)(Qw + d0 * 16 + 8);
        if (qb) { const float pos = (float)(d0 == 4 ? (t >> 6) : (t & 63)); unsigned short ov[8];
#pragma unroll
            for (int i = 0; i < 8; ++i) { float s, c; sincos_r(pos * inv_freq(i, 8), s, c); const float f1 = bf2f((unsigned short)x1[i]), f2 = bf2f((unsigned short)x2[i]);
                ov[i] = (unsigned short)f2bf(hi ? (f1 * s + f2 * c) : (f1 * c - f2 * s)); }
            qr[d0] = (bf16x8){(short)ov[0], (short)ov[1], (short)ov[2], (short)ov[3], (short)ov[4], (short)ov[5], (short)ov[6], (short)ov[7]};
        } else qr[d0] = hi ? x2 : x1;
    }
    f32x16 o[2] = {}; float l_reg;
    const float scale = 0.10206207261596575f;
    attn_core<96, 64, 256>(qr, KV + (size_t)krow0 * 1024 + h * 128, 1024, KR + (size_t)krow0 * 32, 32, KV + (size_t)krow0 * 1024 + h * 128 + 64, 1024,
                           NT, scale * 1.4426950408889634f, 8.f / scale, lds, o, l_reg, tid);
    float* li_l = (float*)(lds + 2 * 64 * 64 * 2 + 2 * 64 * 256) + wid * 64;
    if (hi == 0) li_l[r32] = l_reg; asm volatile("s_waitcnt lgkmcnt(0)" ::: "memory");
#pragma unroll
    for (int r = 0; r < 16; ++r) { const int orow = crow(r, hi); const float rl = __builtin_amdgcn_rcpf(li_l[orow]);
        bf16* op = MIX + (size_t)(row0 + wid * 32 + orow) * 1024 + 512 + h * 64 + r32;
        op[0] = (bf16)f2bf(o[0][r] * rl); op[32] = (bf16)f2bf(o[1][r] * rl); }
}
__device__ __forceinline__ void diff_item(KArgP a, int layer, int b, int h, int qb, char* lds) {
    const int row0 = b * TPB + qb * 256, krow0 = b * TPB, NT = qb ? 36 : 4, o_ = layer >> 1;
    const float scale = 0.125f;
#pragma unroll 1
    for (int m = 0; m < 2; ++m) {
        f32x16 o[4] = {};
        float l_reg;
        {
            const int tid = ptid(), wid = tid >> 6, lane = tid & 63, r32 = lane & 31, hi = lane >> 5;
            const bf16* P = (const bf16*)(a->ws + WS_P);
            const bf16* Qw = P + (size_t)(row0 + wid * 32 + r32) * NP_O + 1536 + h * 128 + m * 64;
            bf16x8 qr[4];
#pragma unroll
            for (int d0 = 0; d0 < 4; ++d0) qr[d0] = *(const bf16x8*)(Qw + d0 * 16 + hi * 8);
            const bf16* Kp = P + (size_t)krow0 * NP_O + 2048 + h * 128 + m * 64;
            attn_core<64, 128, 128>(qr, Kp, NP_O, Kp, NP_O, P + (size_t)krow0 * NP_O + 2560 + h * 128, NP_O,
                                    NT, scale * 1.4426950408889634f, 8.f / scale, lds, o, l_reg, tid);
        }
        const int tid = ptid(), wid = tid >> 6, lane = tid & 63, r32 = lane & 31, hi = lane >> 5;
        float* li_l = (float*)(lds + 2 * 64 * 128 * 2 + 2 * 64 * 128) + wid * 64;
        if (hi == 0) li_l[r32] = l_reg; asm volatile("s_waitcnt lgkmcnt(0)" ::: "memory");
        float* dsb = (float*)a->out + (size_t)blockIdx.x * 64 * 512 + tid; asm volatile("" : "+v"(dsb));
        if (m == 0) {
#pragma unroll
            for (int r = 0; r < 16; ++r) { const float rl = __builtin_amdgcn_rcpf(li_l[crow(r, hi)]);
#pragma unroll
                for (int d = 0; d < 4; ++d) dsb[(size_t)(d * 16 + r) * 512] = o[d][r] * rl; }
        } else {
            bf16* MIX = (bf16*)(a->ws + WS_MIX);
            const float* lp = a->in[20] + o_ * 256;
            const float lam_init = 0.8f - 0.6f * __expf(-0.3f * (float)layer);
            const float lam = __expf(wave_sum(lp[lane] * lp[64 + lane])) - __expf(wave_sum(lp[128 + lane] * lp[192 + lane])) + lam_init;
            const float* sg = a->in[21] + o_ * 128;
#pragma unroll
            for (int r = 0; r < 16; ++r) { const float rl = __builtin_amdgcn_rcpf(li_l[crow(r, hi)]); float s = 0.f; float v[4];
#pragma unroll
                for (int d = 0; d < 4; ++d) { v[d] = dsb[(size_t)(d * 16 + r) * 512] - lam * (o[d][r] * rl); s += v[d] * v[d]; }
                s += __shfl_xor(s, 16); s += __shfl_xor(s, 8); s += __shfl_xor(s, 4); s += __shfl_xor(s, 2); s += __shfl_xor(s, 1);
                const float rs = __builtin_amdgcn_rsqf(s * (1.f / 128.f) + EPSN) * (1.f - lam_init);
                bf16* op = MIX + (size_t)(row0 + wid * 32 + crow(r, hi)) * 1024 + 512 + h * 128 + r32;
#pragma unroll
                for (int d = 0; d < 4; ++d) op[32 * d] = (bf16)f2bf(v[d] * rs * sg[32 * d + r32]);
                asm volatile("" ::: "memory"); }
        }
        asm volatile("s_waitcnt vmcnt(0) lgkmcnt(0)" ::: "memory");
    }
}

__device__ __forceinline__ void phase_mixer(KArgP a, int layer, unsigned char* ldsg) {
    LAS unsigned char* lds = (LAS unsigned char*)ldsg;
    volatile LAS unsigned* flag = (volatile LAS unsigned*)(lds + LDS_MAIN);
    unsigned* ctr = (unsigned*)(a->ws + WS_CTL) + layer; layer &= 7;
    const bool even = !(layer & 1), need_ctx = layer < 3;
    constexpr int NSC = 256;
    const int n_lat = even ? 512 : 256, n_ctx = need_ctx ? (even ? 64 : 32) : 0, total = NSC + n_lat + n_ctx;
    for (;;) {
        __syncthreads();
        if (ptid() == 0) *flag = atomicAdd(ctr, 1u);
        __syncthreads();
        const int item = (int)*flag;
        if (item >= total) break;
#ifdef PROBE_ITEM
        const unsigned long long it0_ = __builtin_amdgcn_s_memrealtime();
#endif
#ifndef SKIP_SCAN
        if (item < NSC) { if (even) scan_item<128, true, 1>(a, layer, item & 63, item >> 6, lds); else scan_item<64, false, 1>(a, layer, item & 63, item >> 6, lds); }
#else
        if (item < NSC) {}
#endif
        else { int b_, h_, qb_;
            if (item < NSC + n_lat) { const int i = item - NSC; qb_ = 1 + (i & 7); if (even) { b_ = i >> 6; h_ = (i >> 3) & 7; } else { b_ = i >> 5; h_ = (i >> 3) & 3; } }
            else { const int i = item - NSC - n_lat; qb_ = 0; if (even) { b_ = i >> 3; h_ = i & 7; } else { b_ = i >> 2; h_ = i & 3; } }
#ifndef SKIP_ATTN
            if (even) mla_item(a, b_, h_, qb_, (char*)ldsg); else diff_item(a, layer, b_, h_, qb_, (char*)ldsg);
#endif
        }
#ifdef PROBE_ITEM
        __syncthreads();
        if (otid() == 0) { volatile LAS unsigned long long* pc_ = (volatile LAS unsigned long long*)(lds + LDS_MAIN + 128); const int k_ = item < NSC ? 0 : (even ? 1 : 2); pc_[k_] += __builtin_amdgcn_s_memrealtime() - it0_; }
#endif
    }
}

#define XB_TMO      128
#define XB_XCNT(j)  (256  + 64 * (j))
#define XB_XSUB(j)  (1280 + 64 * (j))
#define XB_XGEN(j)  (2304 + 64 * (j))
#define XB_TOP      3328
#define XB_TOPGEN   3392
#define XCD_BAR_WORDS 3456
#define XB_SPIN_CAP (1u << 18)

__device__ __forceinline__ unsigned xb_ld(unsigned* p)              { return __hip_atomic_load(p, __ATOMIC_RELAXED, __HIP_MEMORY_SCOPE_AGENT); }
__device__ __forceinline__ unsigned xb_add(unsigned* p, unsigned v) { return __hip_atomic_fetch_add(p, v, __ATOMIC_RELAXED, __HIP_MEMORY_SCOPE_AGENT); }
__device__ __forceinline__ unsigned xb_xcc_id() { return (unsigned)__builtin_amdgcn_s_getreg((3 << 11) | 20) & 0xFu; }
#define XB_SPIN(cond, bar) do { unsigned _sp = 0; while (cond) { __builtin_amdgcn_s_sleep(1); \
    if ((++_sp & 255u) == 0u) { if (xb_ld(&(bar)[XB_TMO])) break; if (_sp > XB_SPIN_CAP) { atomicAdd(&(bar)[XB_TMO], 1u); break; } } } } while (0)

struct XcdBarrier {
    unsigned* bar; unsigned x;
    volatile LAS unsigned* st;
};

__device__ __forceinline__ XcdBarrier xcd_barrier_post(unsigned* bar, volatile LAS unsigned* st) {
    XcdBarrier b; b.bar = bar; b.x = xb_xcc_id(); b.st = st;
    if (threadIdx.x == 0) (void)xb_add(&bar[XB_XCNT(b.x)], 1u);
    return b;
}
__device__ __forceinline__ void xcd_barrier_complete(unsigned* bar, unsigned x, unsigned& nloc, unsigned& nx) {
    const unsigned G = gridDim.x * gridDim.y * gridDim.z;
    unsigned sum, cnt, mine, sp = 0u;
    for (;;) {
        sum = 0u; cnt = 0u; mine = 0u;
#pragma unroll
        for (unsigned j = 0; j < 16; ++j) { const unsigned c = xb_ld(&bar[XB_XCNT(j)]); sum += c; cnt += (c > 0u) ? 1u : 0u; mine = (j == x) ? c : mine; }
        if (sum == G) break;
        __builtin_amdgcn_s_sleep(1);
        if ((++sp & 255u) == 0u) { if (xb_ld(&bar[XB_TMO])) break; if (sp > XB_SPIN_CAP) { atomicAdd(&bar[XB_TMO], 1u); break; } }
    }
    nloc = mine > 0u ? mine : 1u; nx = cnt > 0u ? cnt : 1u;
}

__device__ __forceinline__ void xcd_barrier(const XcdBarrier& b) {
    asm volatile("s_waitcnt vmcnt(0)" ::: "memory");
    __syncthreads();
    if (threadIdx.x == 0) {
        unsigned* bar = b.bar;
        __builtin_amdgcn_s_waitcnt(0);
        unsigned nloc = b.st[0], nx = b.st[1];
        if (nloc == 0u) { xcd_barrier_complete(bar, b.x, nloc, nx); b.st[0] = nloc; b.st[1] = nx; }
        const unsigned old = xb_add(&bar[XB_XSUB(b.x)], 1u);
        const unsigned gen = old / nloc;
        if (old + 1u == (gen + 1u) * nloc) {
            __builtin_amdgcn_fence(__ATOMIC_RELEASE, "agent");
            asm volatile("s_waitcnt vmcnt(0)" ::: "memory");
            const unsigned og = xb_add(&bar[XB_TOP], 1u);
            const unsigned tg = og / nx;
            if (og + 1u == (tg + 1u) * nx) xb_add(&bar[XB_TOPGEN], 1u);
            else XB_SPIN(xb_ld(&bar[XB_TOPGEN]) == tg, bar);
            __builtin_amdgcn_fence(__ATOMIC_ACQUIRE, "agent");
            xb_add(&bar[XB_XGEN(b.x)], 1u);
            asm volatile("s_waitcnt vmcnt(0)" ::: "memory");
        } else {
            XB_SPIN(xb_ld(&bar[XB_XGEN(b.x)]) == gen, bar);
            __builtin_amdgcn_fence(__ATOMIC_ACQUIRE, "agent");
            asm volatile("s_waitcnt vmcnt(0)" ::: "memory");
        }
    }
    __syncthreads();
}

__global__ void __launch_bounds__(512, 2) mega_fwd(Args a_) {
    extern __shared__ __attribute__((aligned(16))) unsigned char lds_raw[];
    LAS unsigned char* lds = (LAS unsigned char*)lds_raw;
    ((LAS int*)(lds + LDS_MAIN + 1024))[threadIdx.x] = (int)threadIdx.x;
    if (threadIdx.x < 4) ((LAS unsigned*)(lds + LDS_MAIN + 64))[threadIdx.x] = 0u;
    if (threadIdx.x < 8) ((LAS unsigned*)(lds + LDS_MAIN + 128))[threadIdx.x] = 0u;
    __syncthreads();
    XcdBarrier xbar; xbar.bar = nullptr; xbar.x = 0; xbar.st = nullptr; bool xb_ready = false;
    cg::grid_group grid = cg::this_grid();
    int ph = 0;
#ifdef PROBE_MASK
    unsigned long long pr_last = __builtin_amdgcn_s_memrealtime(), pr_acc = 0ull;
#define PROBE_STAMP(k) { const unsigned long long now_ = __builtin_amdgcn_s_memrealtime(); if ((PROBE_MASK >> (k)) & 1) pr_acc += now_ - pr_last; pr_last = now_; }
#else
#define PROBE_STAMP(k)
#endif
    const int plo = a_.lo, phi = a_.hi;
#define PH_BEGIN if (ph >= plo && ph < phi) { KArgP a = kargs(); int bx = (int)blockIdx.x, G = (int)gridDim.x; asm volatile("" : "+s"(bx), "+s"(G)); (void)bx; (void)G;
#ifdef PROBE_SYNC2
#define PH_ENDT(k)   if (ph + 1 < phi) { grid.sync(); grid.sync(); } } ++ph;
#else
#define PH_ENDT(k) if (ph + 1 < phi) { if (!xb_ready) { grid.sync(); xbar = xcd_barrier_post((unsigned*)(a->ws + WS_CTL) + 4096, (volatile LAS unsigned*)(lds + LDS_MAIN + 64)); xb_ready = true; } else xcd_barrier(xbar); } PROBE_STAMP(k) } ++ph;
#endif

    PH_BEGIN phase_prep(a, lds); PH_ENDT(0)

    for (int layer = 0; layer < 4; ++layer) {
        const bool even = !(layer & 1);
        const int np = even ? NP_E : NP_O;
        PH_BEGIN phase_norm(a, layer, 0, layer > 0); convert_weights(a, layer, lds); PH_ENDT(1)
#ifndef SKIP_G1
        PH_BEGIN { bf16* H = (bf16*)(a->ws + WS_H); bf16* MIX = (bf16*)(a->ws + WS_MIX); bf16* P = (bf16*)(a->ws + WS_P); float* X = (float*)(a->ws + WS_X); unsigned char* Wb = a->ws + WS_W; const float* mod = (const float*)(a->ws + WS_MOD) + (size_t)layer * 9 * 6144; (void)H; (void)MIX; (void)P; (void)X; (void)mod; pg8::Gemm g{H, (const bf16*)(Wb + W_IN), MT, np, 1024, 1024}; pg8::StaticOrder S; S.init(MT, np, G, bx);
                   pg8::EpiBf16<0> E{P, np, nullptr, 0, 0, 1.f};
                   pg8::gemm_phase<pg8::EpiBf16<0>, pg8::StaticOrder, true, true>(lds, g, S, E); } PH_ENDT(2)
#else
        ++ph;
#endif
        PH_BEGIN if (even) phase_post_even(a, layer); else phase_post_odd(a, layer); PH_ENDT(3)
#ifndef SKIP_G3
        if (even) {
            PH_BEGIN { bf16* H = (bf16*)(a->ws + WS_H); bf16* MIX = (bf16*)(a->ws + WS_MIX); bf16* P = (bf16*)(a->ws + WS_P); float* X = (float*)(a->ws + WS_X); unsigned char* Wb = a->ws + WS_W; const float* mod = (const float*)(a->ws + WS_MOD) + (size_t)layer * 9 * 6144; (void)H; (void)MIX; (void)P; (void)X; (void)mod; pg8::Gemm g{(const bf16*)(a->ws + WS_CQN), (const bf16*)(Wb + W_UQ), MT, 768, 384, 384}; pg8::StaticOrder S; S.init(MT, 768, G, bx);
                       pg8::EpiBf16<0> E{(bf16*)((unsigned char*)a->out + OUT_Q), 768, nullptr, 0, 0, 1.f};
                       pg8::gemm_phase<pg8::EpiBf16<0>, pg8::StaticOrder, true, true>(lds, g, S, E); }
                     { unsigned char* Wb = a->ws + WS_W; pg8::Gemm g{(const bf16*)(a->ws + WS_CKVN), (const bf16*)(Wb + W_UKV), MT, 1024, 256, 256}; pg8::StaticOrder S; S.init(MT, 1024, G, bx);
                       pg8::EpiBf16<0> E{(bf16*)((unsigned char*)a->out + OUT_KV), 1024, nullptr, 0, 0, 1.f};
                       pg8::gemm_phase<pg8::EpiBf16<0>, pg8::StaticOrder, true, true>(lds, g, S, E); }
                     for (int it = bx; it < 192; it += G) scan_item<128, true, 0>(a, layer, it & 63, it >> 6, lds);
            PH_ENDT(4)
        } else { ++ph; }
#else
        ++ph;
#endif
        if (!even) {
        PH_BEGIN for (int it = bx; it < 192; it += G) scan_item<64, false, 0>(a, layer, it & 63, it >> 6, lds); PH_ENDT(5)
        } else { ++ph; }
#ifdef PROBE_MIX2
        PH_BEGIN phase_mixer(a, layer + 8, lds_raw); grid.sync(); PH_ENDT(6)
        --ph;
#endif
        PH_BEGIN phase_mixer(a, layer, lds_raw); PH_ENDT(6 + 7 * (layer & 1))
        PH_BEGIN phase_readout(a, layer); PH_ENDT(7)
#ifndef SKIP_G6
        PH_BEGIN { bf16* H = (bf16*)(a->ws + WS_H); bf16* MIX = (bf16*)(a->ws + WS_MIX); bf16* P = (bf16*)(a->ws + WS_P); float* X = (float*)(a->ws + WS_X); unsigned char* Wb = a->ws + WS_W; const float* mod = (const float*)(a->ws + WS_MOD) + (size_t)layer * 9 * 6144; (void)H; (void)MIX; (void)P; (void)X; (void)mod; pg8::Gemm g{MIX, (const bf16*)(Wb + W_OUT), MT, 1024, 1024, 1024}; pg8::StaticOrder S; S.init(NB * NLAT, 1024, G, bx, 1);
                   pg8::EpiResid E{X, mod, 2048, layer == 0 ? a->in[0] : nullptr};
                   pg8::gemm_phase<pg8::EpiResid, pg8::StaticOrder, true, true>(lds, g, S, E);
                   if (layer < 3) { pg8::Gemm g2{MIX, (const bf16*)(Wb + W_OUT), MT, 1024, 512, 1024}; pg8::CtxSplitOrder S2{G, bx, 512};
                       pg8::EpiResidSplit E2{X, (float*)(a->ws + WS_T), mod, 2048, layer == 0 ? a->in[2] : nullptr};
                       pg8::gemm_phase<pg8::EpiResidSplit, pg8::CtxSplitOrder, true, true>(lds, g2, S2, E2); } } PH_ENDT(8)
#else
        ++ph;
#endif
        PH_BEGIN phase_norm(a, layer, 1, layer < 3); PH_ENDT(9)
#ifndef SKIP_G8
        PH_BEGIN { bf16* H = (bf16*)(a->ws + WS_H); bf16* MIX = (bf16*)(a->ws + WS_MIX); bf16* P = (bf16*)(a->ws + WS_P); float* X = (float*)(a->ws + WS_X); unsigned char* Wb = a->ws + WS_W; const float* mod = (const float*)(a->ws + WS_MOD) + (size_t)layer * 9 * 6144; (void)H; (void)MIX; (void)P; (void)X; (void)mod; pg8::Gemm g{H, (const bf16*)(Wb + W_GU), MT, 2 * FF, 1024, 1024}; pg8::StaticOrder S; if (layer < 3) S.init(MT, 2 * FF, G, bx); else S.init(NB * NLAT, 2 * FF, G, bx, 1);
                   pg8::EpiSwiGLU E{P, FF};
                   pg8::gemm_phase<pg8::EpiSwiGLU, pg8::StaticOrder, true, true>(lds, g, S, E); } PH_ENDT(10)
#else
        ++ph;
#endif
#ifndef SKIP_G9
        PH_BEGIN { bf16* H = (bf16*)(a->ws + WS_H); bf16* MIX = (bf16*)(a->ws + WS_MIX); bf16* P = (bf16*)(a->ws + WS_P); float* X = (float*)(a->ws + WS_X); unsigned char* Wb = a->ws + WS_W; const float* mod = (const float*)(a->ws + WS_MOD) + (size_t)layer * 9 * 6144; (void)H; (void)MIX; (void)P; (void)X; (void)mod; pg8::Gemm g{P, (const bf16*)(Wb + W_DN), MT, 1024, FF, FF}; pg8::StaticOrder S; S.init(NB * NLAT, 1024, G, bx, 1);
                   pg8::EpiResid E{X, mod, 5120, nullptr};
                   pg8::gemm_phase<pg8::EpiResid, pg8::StaticOrder, true, true>(lds, g, S, E);
                   if (layer < 3) { pg8::Gemm g2{P, (const bf16*)(Wb + W_DN), MT, 1024, FF / 2, FF}; pg8::CtxSplitOrder S2{G, bx, FF / 2};
                       pg8::EpiResidSplit E2{X, (float*)(a->ws + WS_T), mod, 5120, nullptr};
                       pg8::gemm_phase<pg8::EpiResidSplit, pg8::CtxSplitOrder, true, true>(lds, g2, S2, E2); } } PH_ENDT(11)
#else
        ++ph;
#endif
    }
    PH_BEGIN phase_final(a); PH_ENDT(12)
#undef PH_BEGIN
#undef PH_ENDT
#ifdef PROBE_ITEM
    pr_acc += ((volatile LAS unsigned long long*)(lds + LDS_MAIN + 128))[PROBE_ITEM - 1];
#endif
#ifdef PROBE_MASK
    if (blockIdx.x == 0) { const unsigned long long t0_ = __builtin_amdgcn_s_memrealtime(); while (__builtin_amdgcn_s_memrealtime() - t0_ < pr_acc) __builtin_amdgcn_s_sleep(8); }
#endif
}
constexpr int NPH = 1 + 4 * 11 + 1;

extern "C" void kernel_launch(void* const* d_in, const int* in_sizes, int n_in, void* d_out, int out_size, void* d_ws, size_t ws_size, hipStream_t stream) {
    static int grid = 0;
    if (grid == 0) {
        if (n_in != 23 || ws_size < WS_END || out_size != NB * NLAT * DM) { fprintf(stderr, "kernel_launch: unexpected shapes: n_in %d ws %zu (need %zu) out %d\n", n_in, ws_size, (size_t)WS_END, out_size); grid = -1; return; }
        int dev = 0, cus = 0, per_cu = 0;
        hipGetDevice(&dev); hipDeviceGetAttribute(&cus, hipDeviceAttributeMultiprocessorCount, dev);
        if (hipFuncSetAttribute((const void*)mega_fwd, hipFuncAttributeMaxDynamicSharedMemorySize, LDS_BYTES) != hipSuccess) { fprintf(stderr, "kernel_launch: hipFuncSetAttribute failed\n"); grid = -1; return; }
        if (hipOccupancyMaxActiveBlocksPerMultiprocessor(&per_cu, (const void*)mega_fwd, 512, LDS_BYTES) != hipSuccess || per_cu < 1) { fprintf(stderr, "kernel_launch: occupancy query says %d\n", per_cu); per_cu = 1; }
        (void)hipGetLastError();
        grid = cus;
    }
    if (grid < 0) return;
    Args a{};
    for (int i = 0; i < 23; ++i) a.in[i] = (const float*)d_in[i];
    a.out = (float*)d_out; a.ws = (unsigned char*)d_ws; a.lo = 0; a.hi = NPH;
    void* kargv[] = {&a};
    hipError_t e = hipLaunchCooperativeKernel((const void*)mega_fwd, dim3(grid), dim3(512), kargv, LDS_BYTES, stream);
    if (e != hipSuccess) fprintf(stderr, "kernel_launch: cooperative launch failed: %s (grid %d)\n", hipGetErrorString(e), grid);
}
```

```cpp
#include <hip/hip_runtime.h>
#include <hip/hip_cooperative_groups.h>
#include <cstdio>
#include <cstdint>
namespace cg = cooperative_groups;
#define otid() ({ int t_ = (int)threadIdx.x; asm volatile("" : "+v"(t_)); t_; })
extern __shared__ __attribute__((aligned(16))) unsigned char g_lds_dyn[];
#define ptid() (*(volatile __attribute__((address_space(3))) int*)((__attribute__((address_space(3))) unsigned char*)g_lds_dyn + 131072 + 1024 + 4 * (int)threadIdx.x))
namespace pg8 {
#define PG8_LAS __attribute__((address_space(3)))
typedef unsigned short bf16_t;
typedef short bf16x8 __attribute__((ext_vector_type(8)));
typedef float f32x4 __attribute__((ext_vector_type(4)));
typedef unsigned u32x4 __attribute__((ext_vector_type(4)));
constexpr int BM = 256, BK = 64, HALF = 128, HTB = HALF * BK * 2  , STAGE_BYTES = 8 * HTB, NXCD = 8, WGM = 8;

__host__ __device__ __forceinline__ int lds_byte(int r, int c) { const int st = (r >> 4) * 2 + (c >> 5), rr = r & 15, cc = c & 31, ob = rr * 64 + cc * 2; return st * 1024 + (ob ^ (((ob >> 9) & 1) << 5)); }
__host__ __device__ __forceinline__ void stage_rc(int b, int& R, int& C) { const int st = b / 1024, sb = b % 1024, swz = sb ^ (((sb >> 9) & 1) << 5); R = (st >> 1) * 16 + swz / 64; C = (st & 1) * 32 + (swz % 64) / 2; }
__host__ __device__ __forceinline__ int perm32(int rho) { const int n = rho >> 4, i = rho & 15; return 8 * (i >> 2) + 4 * n + (i & 3); }

struct Unit { int pm, pn, koff; };
struct Gemm { const bf16_t* A; const bf16_t* Bt; int M, N, K, ld; };

struct StaticOrder {
    int nM, nN, nwg, G, c, mode;
    __host__ __device__ void init(int M, int N, int G_, int c_, int mode_ = 0) { nM = M / BM; nN = N / BM; nwg = nM * nN; G = G_; c = c_; mode = mode_; }
    __host__ __device__ bool next(int i, Unit& u) const {
        const long L = (long)i * G + c; if (L >= nwg) return false;
        int wgid = (int)L; { const int q = nwg / NXCD, r = nwg % NXCD, xcd = wgid % NXCD, off = wgid / NXCD; wgid = (xcd < r ? xcd * (q + 1) : r * (q + 1) + (xcd - r) * q) + off; }
        const int nig = WGM * nN, gid = wgid / nig, fm = gid * WGM, gsz = (nM - fm) < WGM ? (nM - fm) : WGM;
        u.pm = fm + ((wgid % nig) % gsz); u.pn = (wgid % nig) / gsz; u.koff = 0; if (mode == 1) u.pm = (u.pm >> 3) * 9 + 1 + (u.pm & 7); return true;
    }
    __device__ __forceinline__ void a_ready(const Unit&) const {}
    __device__ __forceinline__ void done(const Unit&) const {}
};
struct CtxSplitOrder {
    int G, c, khalf;
    __device__ bool next(int i, Unit& u) const { const int L = i * G + c; if (L >= 64) return false; u.koff = (L & 1) * khalf; u.pn = (L >> 1) & 3; u.pm = (L >> 3) * 9; return true; }
    __device__ __forceinline__ void a_ready(const Unit&) const {}
    __device__ __forceinline__ void done(const Unit&) const {}
};

__device__ __forceinline__ unsigned cvt_pk_bf16(float lo, float hi) { unsigned r; asm volatile("v_cvt_pk_bf16_f32 %0, %1, %2" : "=v"(r) : "v"(lo), "v"(hi)); return r; }
typedef float f32x2 __attribute__((ext_vector_type(2)));
__device__ __forceinline__ f32x2 gelu_pk(f32x2 v) {
    const f32x2 av = __builtin_elementwise_abs(v), d = av * 0.2316418882f + 1.0f;
    f32x2 t; t.x = __builtin_amdgcn_rcpf(d.x); t.y = __builtin_amdgcn_rcpf(d.y);
    f32x2 q = t * 0.5307027145f + (-0.7265760135f); q = q * t + 0.7107068705f; q = q * t + (-0.142248368f); q = q * t + 0.127414796f; q = q * t;
    const f32x2 s = (v * v) * (-0.72134752044f);
    f32x2 e; e.x = __builtin_amdgcn_exp2f(s.x); e.y = __builtin_amdgcn_exp2f(s.y);
    const f32x2 m = v * (q * e), r = v - m;
    f32x2 o; o.x = v.x < 0.f ? m.x : r.x; o.y = v.y < 0.f ? m.y : r.y; return o;
}

template <int ACT  > struct EpiBf16 {
    static constexpr bool PERM = true, AFTER_DRAIN = false; static_assert(ACT == 0 || ACT == 1, "EpiBf16: ACT is 0 (none) or 1 (gelu_pk)");
    bf16_t* O; int ldc; const float* bias; int split_cols; size_t split_stride; float scale0;
    __device__ __forceinline__ void operator()(const f32x4 (&acc)[2][2][4][2], const Unit& u, int wr, int wc, int fr, int fq) const {
        const int row0 = u.pm * BM + wr * 64 + fr; int colt = u.pn * BM; bf16_t* base = O;
        float sc = 1.f; if (split_cols) { const int t = colt / split_cols; base += (size_t)t * split_stride; colt -= t * split_cols; if (t == 0) sc = scale0; }
        const int col0 = colt + wc * 32 + 8 * fq, bcol0 = u.pn * BM + wc * 32 + 8 * fq;
        f32x4 bv[2][2];
#pragma unroll
        for (int bj = 0; bj < 2; ++bj)
#pragma unroll
            for (int n = 0; n < 2; ++n) bv[bj][n] = bias ? *(const f32x4*)(bias + bcol0 + bj * HALF + 4 * n) : (f32x4){0.f, 0.f, 0.f, 0.f};
#pragma unroll
        for (int ai = 0; ai < 2; ++ai)
#pragma unroll
            for (int m = 0; m < 4; ++m) { bf16_t* rowp = base + (size_t)(row0 + ai * HALF + m * 16) * ldc + col0;
#pragma unroll
                for (int bj = 0; bj < 2; ++bj) { f32x4 v0 = acc[ai][bj][m][0] + bv[bj][0], v1 = acc[ai][bj][m][1] + bv[bj][1];
                    if (ACT == 1) { f32x2 a = gelu_pk((f32x2){v0[0], v0[1]}), b = gelu_pk((f32x2){v0[2], v0[3]}), c = gelu_pk((f32x2){v1[0], v1[1]}), d = gelu_pk((f32x2){v1[2], v1[3]});
                        v0 = (f32x4){a.x, a.y, b.x, b.y}; v1 = (f32x4){c.x, c.y, d.x, d.y}; }
                    v0 = v0 * sc; v1 = v1 * sc; u32x4 w; w.x = cvt_pk_bf16(v0[0], v0[1]); w.y = cvt_pk_bf16(v0[2], v0[3]); w.z = cvt_pk_bf16(v1[0], v1[1]); w.w = cvt_pk_bf16(v1[2], v1[3]);
                    *(u32x4*)(rowp + bj * HALF) = w; } }
    }
};
struct EpiResidSplit {
    static constexpr bool PERM = false, AFTER_DRAIN = false;
    float* X; float* T; const float* mod; int goff; const float* cin;
    __device__ __forceinline__ void operator()(const f32x4 (&acc)[2][2][4][2], const Unit& u, int wr, int wc, int fr, int fq) const {
        const float* gp = mod + 8 * 6144 + goff;
        const int col0 = u.pn * BM + wc * 32 + 4 * fq;
        const bool first = (u.koff == 0);
        float* base = first ? X + (size_t)(u.pm * BM) * 1024 : T + (size_t)((u.pm / 9) * BM) * 1024;
        const float* rbase = cin ? cin + (size_t)((u.pm / 9) * BM) * 1024 : base;
#pragma unroll
        for (int bj = 0; bj < 2; ++bj)
#pragma unroll
            for (int n = 0; n < 2; ++n) { const f32x4 gv = *(const f32x4*)(gp + col0 + bj * HALF + n * 16);
#pragma unroll
                for (int ai = 0; ai < 2; ++ai)
#pragma unroll
                    for (int m = 0; m < 4; ++m) { const size_t o = (size_t)(ai * HALF + wr * 64 + m * 16 + fr) * 1024 + col0 + bj * HALF + n * 16;
                        f32x4 v = gv * acc[ai][bj][m][n];
                        if (first) v = v + *(const f32x4*)(rbase + o);
                        *(f32x4*)(base + o) = v; } }
    }
};
struct EpiSwiGLU {
    static constexpr bool PERM = true, AFTER_DRAIN = false;
    bf16_t* O; int ldc;
    __device__ __forceinline__ void operator()(const f32x4 (&acc)[2][2][4][2], const Unit& u, int wr, int wc, int fr, int fq) const {
        const int row0 = u.pm * BM + wr * 64 + fr; const int col0 = u.pn * HALF + wc * 32 + 8 * fq;
#pragma unroll
        for (int ai = 0; ai < 2; ++ai)
#pragma unroll
            for (int m = 0; m < 4; ++m) { bf16_t* rowp = O + (size_t)(row0 + ai * HALF + m * 16) * ldc + col0;
                float h[8];
#pragma unroll
                for (int n = 0; n < 2; ++n)
#pragma unroll
                    for (int i = 0; i < 4; ++i) { const float g = acc[ai][0][m][n][i], up = acc[ai][1][m][n][i];
                        h[n * 4 + i] = g * __builtin_amdgcn_rcpf(1.0f + __expf(-g)) * up; }
                u32x4 w; w.x = cvt_pk_bf16(h[0], h[1]); w.y = cvt_pk_bf16(h[2], h[3]); w.z = cvt_pk_bf16(h[4], h[5]); w.w = cvt_pk_bf16(h[6], h[7]);
                *(u32x4*)rowp = w; }
    }
};
struct EpiResid {
    static constexpr bool PERM = false, AFTER_DRAIN = false;
    float* X; const float* mod; int goff; const float* xin;
    __device__ __forceinline__ void operator()(const f32x4 (&acc)[2][2][4][2], const Unit& u, int wr, int wc, int fr, int fq) const {
        const int widx = (u.pm % 9 == 0) ? 8 : (u.pm / 9);
        const float* gp = mod + widx * 6144 + goff;
        const int col0 = u.pn * BM + wc * 32 + 4 * fq;
        const float* rb = xin ? xin + (size_t)((u.pm / 9) * 2048 + (u.pm % 9 - 1) * 256) * 1024 : X + (size_t)(u.pm * BM) * 1024;
        float* wb = X + (size_t)(u.pm * BM) * 1024;
#pragma unroll
        for (int bj = 0; bj < 2; ++bj)
#pragma unroll
            for (int n = 0; n < 2; ++n) { const f32x4 gv = *(const f32x4*)(gp + col0 + bj * HALF + n * 16);
#pragma unroll
                for (int ai = 0; ai < 2; ++ai)
#pragma unroll
                    for (int m = 0; m < 4; ++m) { const size_t o = (size_t)(ai * HALF + wr * 64 + m * 16 + fr) * 1024 + col0 + bj * HALF + n * 16;
                        f32x4 x = *(const f32x4*)(rb + o); x = x + gv * acc[ai][bj][m][n]; *(f32x4*)(wb + o) = x; } }
    }
};
template <class Epi, class Sched, bool ALIGN_EPI = false, bool SP2 = false>
__device__ __forceinline__ void gemm_phase(PG8_LAS unsigned char* lds, const Gemm g, const Sched& S, const Epi& E) {
    const int tid = otid(), wid = __builtin_amdgcn_readfirstlane(tid >> 6), lane = tid & 63, wr = wid >> 2, wc = wid & 3, fr = lane & 15, fq = lane >> 4;
    const int K = g.ld, nt = g.K / BK;
    unsigned voffA[2], voffB[2];
#pragma unroll
    for (int i = 0; i < 2; ++i) { int R, C; stage_rc(tid * 16 + i * 8192, R, C); const int Rb = Epi::PERM ? ((R & ~31) + perm32(R & 31)) : R;
        voffA[i] = (unsigned)(R * K + C) * 2u; voffB[i] = (unsigned)(Rb * K + C) * 2u; }
    const size_t kstep = (size_t)(BK * 2);
    const size_t hstep = (size_t)HALF * K * 2;
    const size_t tstep = 2 * hstep;
    const unsigned ldsw = (unsigned)wid * 1024u;
    const int aoff = lds_byte(wr * 64 + fr, fq * 8), boff = lds_byte(wc * 32 + fr, fq * 8);
#define PG8_SA(b, h) (((b) * 2 + (h)) * HTB)
#define PG8_SB(b, h) ((4 + (b) * 2 + (h)) * HTB)
#define PG8_STAGE(bufoff, gbase, voff) do { _Pragma("unroll") for (int _i = 0; _i < 2; ++_i) \
        __builtin_amdgcn_global_load_lds((const unsigned*)((const char*)(gbase) + (voff)[_i]), (PG8_LAS unsigned*)(lds + (bufoff) + ldsw + _i * 8192), 16, 0, 0); } while (0)
#define PG8_LDA(dst, b, h) do { _Pragma("unroll") for (int m = 0; m < 4; ++m) _Pragma("unroll") for (int k = 0; k < 2; ++k) dst[m][k] = *(const PG8_LAS bf16x8*)(lds + PG8_SA(b, h) + aoff + m * 2048 + k * 1024); } while (0)
#define PG8_LDB(dst, b, h) do { _Pragma("unroll") for (int n = 0; n < 2; ++n) _Pragma("unroll") for (int k = 0; k < 2; ++k) dst[n][k] = *(const PG8_LAS bf16x8*)(lds + PG8_SB(b, h) + boff + n * 2048 + k * 1024); } while (0)
#define PG8_MMA(ai, bj, At, Bt) do { __builtin_amdgcn_s_setprio(1); _Pragma("unroll") for (int m = 0; m < 4; ++m) _Pragma("unroll") for (int n = 0; n < 2; ++n) _Pragma("unroll") for (int k = 0; k < 2; ++k) \
        acc[ai][bj][m][n] = __builtin_amdgcn_mfma_f32_16x16x32_bf16(Bt[n][k], At[m][k], acc[ai][bj][m][n], 0, 0, 0); __builtin_amdgcn_s_setprio(0); } while (0)
#define PG8_WAIT_V(n) asm volatile("s_waitcnt vmcnt(" #n ")" ::: "memory")
#define PG8_WAIT_L(n) asm volatile("s_waitcnt lgkmcnt(" #n ")" ::: "memory")
#define PG8_BAR __builtin_amdgcn_s_barrier()
#define PG8_SCHED __builtin_amdgcn_sched_barrier(0)
    Unit cur, nxt; int ui = 0;
    if (!S.next(0, cur)) return;
    f32x4 acc[2][2][4][2];
#pragma unroll
    for (int a = 0; a < 2; ++a)
#pragma unroll
        for (int b = 0; b < 2; ++b)
#pragma unroll
            for (int m = 0; m < 4; ++m)
#pragma unroll
                for (int n = 0; n < 2; ++n) acc[a][b][m][n] = (f32x4){0.f, 0.f, 0.f, 0.f};
    bf16x8 At[4][2], B0[2][2], B1[2][2];
    const char* cA = (const char*)g.A + (size_t)cur.pm * tstep + (size_t)cur.koff * 2; const char* cB = (const char*)g.Bt + (size_t)cur.pn * tstep + (size_t)cur.koff * 2;
    S.a_ready(cur);
    if constexpr (SP2) {
        PG8_STAGE(PG8_SB(0, 0), cB, voffB); PG8_STAGE(PG8_SB(0, 1), cB + hstep, voffB); PG8_STAGE(PG8_SA(0, 0), cA, voffA); PG8_STAGE(PG8_SA(0, 1), cA + hstep, voffA);
        if (wr == 1) PG8_BAR;
        PG8_WAIT_V(2); PG8_BAR;
        PG8_STAGE(PG8_SB(1, 0), cB + kstep, voffB); PG8_STAGE(PG8_SA(1, 0), cA + kstep, voffA); PG8_STAGE(PG8_SB(1, 1), cB + hstep + kstep, voffB);
        PG8_WAIT_V(6); PG8_BAR;
    } else {
        PG8_STAGE(PG8_SB(0, 0), cB, voffB); PG8_STAGE(PG8_SA(0, 0), cA, voffA); PG8_STAGE(PG8_SB(0, 1), cB + hstep, voffB); PG8_STAGE(PG8_SA(0, 1), cA + hstep, voffA);
        if (wr == 1) PG8_BAR;
        PG8_WAIT_V(4); PG8_BAR;
        PG8_STAGE(PG8_SB(1, 0), cB + kstep, voffB); PG8_STAGE(PG8_SA(1, 0), cA + kstep, voffA); PG8_STAGE(PG8_SB(1, 1), cB + hstep + kstep, voffB);
        PG8_WAIT_V(6); PG8_BAR;
    }
    for (;;) {
        const bool has_next = S.next(ui + 1, nxt);
        const char* nA = has_next ? (const char*)g.A + (size_t)nxt.pm * tstep + (size_t)nxt.koff * 2 : cA; const char* nB = has_next ? (const char*)g.Bt + (size_t)nxt.pn * tstep + (size_t)nxt.koff * 2 : cB;
        for (int t = 0; t < nt; t += 2) {
            const bool last = (t == nt - 2);
            const char* a1 = cA + (size_t)(t + 1) * kstep;
            const char* a2 = last ? nA : cA + (size_t)(t + 2) * kstep; const char* b2 = last ? nB : cB + (size_t)(t + 2) * kstep;
            const char* a3 = a2 + kstep; const char* b3 = b2 + kstep;
            if (last && has_next) S.a_ready(nxt);
            if constexpr (SP2) {
            PG8_LDB(B0, 0, 0); PG8_LDB(B1, 0, 1); PG8_SCHED; PG8_LDA(At, 0, 0); PG8_STAGE(PG8_SA(1, 1), a1 + hstep, voffA);
            PG8_WAIT_V(8); PG8_WAIT_L(0); PG8_BAR; PG8_MMA(0, 0, At, B0); PG8_MMA(0, 1, At, B1); PG8_BAR; PG8_SCHED;
            PG8_LDA(At, 0, 1); PG8_STAGE(PG8_SB(0, 0), b2, voffB); PG8_STAGE(PG8_SB(0, 1), b2 + hstep, voffB); PG8_STAGE(PG8_SA(0, 0), a2, voffA);
            PG8_WAIT_V(8); PG8_WAIT_L(0); PG8_BAR; PG8_MMA(1, 0, At, B0); PG8_MMA(1, 1, At, B1); PG8_BAR; PG8_SCHED;
            PG8_LDB(B0, 1, 0); PG8_LDB(B1, 1, 1); PG8_SCHED; PG8_LDA(At, 1, 0); PG8_STAGE(PG8_SA(0, 1), a2 + hstep, voffA);
            PG8_WAIT_V(8); PG8_WAIT_L(0); PG8_BAR; PG8_MMA(0, 0, At, B0); PG8_MMA(0, 1, At, B1); PG8_BAR; PG8_SCHED;
            PG8_LDA(At, 1, 1); PG8_STAGE(PG8_SB(1, 0), b3, voffB); PG8_STAGE(PG8_SB(1, 1), b3 + hstep, voffB); PG8_STAGE(PG8_SA(1, 0), a3, voffA);
            PG8_WAIT_V(8); PG8_WAIT_L(0); PG8_BAR; PG8_MMA(1, 0, At, B0); PG8_MMA(1, 1, At, B1); PG8_BAR; PG8_SCHED;
            } else {
            PG8_LDB(B0, 0, 0); PG8_SCHED; PG8_LDA(At, 0, 0); PG8_STAGE(PG8_SA(1, 1), a1 + hstep, voffA);
            PG8_WAIT_L(8); PG8_BAR; PG8_WAIT_L(0); PG8_MMA(0, 0, At, B0); PG8_BAR; PG8_SCHED;
            PG8_LDB(B1, 0, 1); PG8_STAGE(PG8_SB(0, 0), b2, voffB);
            PG8_BAR; PG8_WAIT_L(0); PG8_MMA(0, 1, At, B1); PG8_BAR;
            PG8_LDA(At, 0, 1); PG8_STAGE(PG8_SA(0, 0), a2, voffA);
            PG8_BAR; PG8_WAIT_L(0); PG8_MMA(1, 0, At, B0); PG8_BAR; PG8_SCHED;
            PG8_STAGE(PG8_SB(0, 1), b2 + hstep, voffB);
            PG8_WAIT_V(6); PG8_BAR; PG8_MMA(1, 1, At, B1); PG8_BAR;
            PG8_LDB(B0, 1, 0); PG8_SCHED; PG8_LDA(At, 1, 0); PG8_STAGE(PG8_SA(0, 1), a2 + hstep, voffA);
            PG8_WAIT_L(8); PG8_BAR; PG8_WAIT_L(0); PG8_MMA(0, 0, At, B0); PG8_BAR; PG8_SCHED;
            PG8_LDB(B1, 1, 1); PG8_STAGE(PG8_SB(1, 0), b3, voffB);
            PG8_BAR; PG8_WAIT_L(0); PG8_MMA(0, 1, At, B1); PG8_BAR;
            PG8_LDA(At, 1, 1); PG8_STAGE(PG8_SA(1, 0), a3, voffA);
            PG8_BAR; PG8_WAIT_L(0); PG8_MMA(1, 0, At, B0); PG8_BAR; PG8_SCHED;
            PG8_STAGE(PG8_SB(1, 1), b3 + hstep, voffB);
            PG8_WAIT_V(6); PG8_BAR; PG8_MMA(1, 1, At, B1); PG8_BAR;
            }
        }
        if constexpr (ALIGN_EPI) { if (wr == 0) PG8_BAR; }
        if constexpr (!Epi::AFTER_DRAIN) { E(acc, cur, wr, wc, fr, fq); S.done(cur); }
        if (!has_next) break;
#pragma unroll
        for (int a = 0; a < 2; ++a)
#pragma unroll
            for (int b = 0; b < 2; ++b)
#pragma unroll
                for (int m = 0; m < 4; ++m)
#pragma unroll
                    for (int n = 0; n < 2; ++n) acc[a][b][m][n] = (f32x4){0.f, 0.f, 0.f, 0.f};
        cur = nxt; cA = nA; cB = nB; ++ui;
        if constexpr (ALIGN_EPI) { if (wr == 1) PG8_BAR; }
    }
    PG8_WAIT_V(0);
    if constexpr (!ALIGN_EPI) { if (wr == 0) PG8_BAR; }
    PG8_BAR;
    if constexpr (Epi::AFTER_DRAIN) { E.fused(acc, cur, wr, wc, fr, fq, lds, wid, lane); S.done(cur); }
#undef PG8_SA
#undef PG8_SB
#undef PG8_STAGE
#undef PG8_LDA
#undef PG8_LDB
#undef PG8_MMA
#undef PG8_WAIT_V
#undef PG8_WAIT_L
#undef PG8_BAR
#undef PG8_SCHED
}
}

typedef unsigned short bf16;
typedef short bf16x8 __attribute__((ext_vector_type(8)));
typedef short s16x4 __attribute__((ext_vector_type(4)));
typedef float f32x4 __attribute__((ext_vector_type(4)));
typedef float f32x16 __attribute__((ext_vector_type(16)));
typedef unsigned u32x4 __attribute__((ext_vector_type(4)));
typedef unsigned u32x2 __attribute__((ext_vector_type(2)));
#define LAS __attribute__((address_space(3)))

constexpr int NB = 8, TPB = 2304, MT = NB * TPB, DM = 1024, NLAT = 2048;
constexpr int NP_E = 3328, NP_O = 3072, FF = 2816;
constexpr float EPSN = 1e-6f;
constexpr size_t MiB = 1u << 20;
constexpr size_t WS_CTL = 0, WS_MOD = 1 * MiB, WS_X = 2 * MiB, WS_H = 74 * MiB, WS_MIX = 110 * MiB, WS_P = 146 * MiB, WS_W = 263 * MiB,
                 WS_OSC = 290 * MiB, WS_KR = 326 * MiB, WS_U = 328 * MiB, WS_T = 342 * MiB, WS_END = 350 * MiB;
constexpr size_t WS_LSUM = 128 * 1024;
constexpr size_t WS_CQN = WS_MIX, WS_CKVN = WS_MIX + 14 * MiB, WS_DSCR = WS_H;
constexpr size_t W_IN = 0, W_OUT = 13 * MiB / 2, W_GU = 17 * MiB / 2, W_DN = 39 * MiB / 2, W_UQ = 25 * MiB, W_UKV = 25 * MiB + 768 * 1024;
constexpr size_t OUT_KV = 0, OUT_Q = 36 * MiB;
constexpr int LDS_MAIN = 131072, LDS_BYTES = LDS_MAIN + 1024 + 2048;

struct Args { const float* in[23]; float* out; unsigned char* ws; int lo, hi; };
typedef __attribute__((address_space(4))) const Args* KArgP;
__device__ __forceinline__ KArgP kargs() { KArgP p = (KArgP)__builtin_amdgcn_kernarg_segment_ptr(); asm volatile("" : "+s"(p)); return p; }

__device__ __forceinline__ float bf2f(unsigned short h) { return __uint_as_float((unsigned)h << 16); }
__device__ __forceinline__ unsigned f2bf(float f) { unsigned u = __float_as_uint(f); return (u + 0x7fffu + ((u >> 16) & 1u)) >> 16; }
__device__ __forceinline__ unsigned pk2(float lo, float hi) { return f2bf(lo) | (f2bf(hi) << 16); }
__device__ __forceinline__ float wave_sum(float v) {
#pragma unroll
    for (int o = 1; o < 64; o <<= 1) v += __shfl_xor(v, o);
    return v;
}
__device__ __forceinline__ float silu_f(float g) { return g / (1.0f + __expf(-g)); }
__device__ __forceinline__ void sincos_r(float ang, float& s, float& c) {
    float r = ang * 0.15915494309189535f; r = r - __builtin_floorf(r);
    s = __builtin_amdgcn_sinf(r); c = __builtin_amdgcn_cosf(r);
}
__device__ __forceinline__ float inv_freq(int i, int half) { return __builtin_amdgcn_exp2f(-(float)i / (float)half * 13.287712379549449f); }

__device__ __forceinline__ void mod_item(KArgP a, int l, int cg, LAS unsigned char* lds) {
    const int tid = otid();
    float* MOD = (float*)(a->ws + WS_MOD);
    LAS float* S = (LAS float*)lds;
    LAS float* R = S + 1024 * 12;
    for (int i = tid; i < 9 * 1024; i += 512) { const int w = i >> 10, k = i & 1023; const float v = (w < 8) ? a->in[1][w * 1024 + k] : a->in[3][k]; S[k * 12 + w] = silu_f(v); }
    __syncthreads();
    const int nl = tid & 63, kp = tid >> 6, n0 = cg * 256;
    f32x4 acc[9];
#pragma unroll
    for (int w = 0; w < 9; ++w) acc[w] = (f32x4){0.f, 0.f, 0.f, 0.f};
    const float* wp = a->in[4] + (size_t)l * 1024 * 6144 + n0 + 4 * nl;
#pragma unroll 8
    for (int k = kp * 128; k < kp * 128 + 128; ++k) {
        const f32x4 wv = *(const f32x4*)(wp + (size_t)k * 6144);
        const f32x4 s0 = *(const LAS f32x4*)(S + k * 12), s1 = *(const LAS f32x4*)(S + k * 12 + 4); const float s8 = S[k * 12 + 8];
        acc[0] += wv * s0[0]; acc[1] += wv * s0[1]; acc[2] += wv * s0[2]; acc[3] += wv * s0[3];
        acc[4] += wv * s1[0]; acc[5] += wv * s1[1]; acc[6] += wv * s1[2]; acc[7] += wv * s1[3]; acc[8] += wv * s8;
    }
#pragma unroll
    for (int w = 0; w < 9; ++w) *(LAS f32x4*)(R + (kp * 9 + w) * 256 + 4 * nl) = acc[w];
    __syncthreads();
    for (int i = tid; i < 9 * 256; i += 512) { const int w = i >> 8, n2 = i & 255; float v = a->in[5][l * 6144 + n0 + n2];
#pragma unroll
        for (int p = 0; p < 8; ++p) v += R[(p * 9 + w) * 256 + n2];
        MOD[(size_t)(l * 9 + w) * 6144 + n0 + n2] = v; }
    __syncthreads();
}
__device__ __forceinline__ void phase_prep(KArgP a, LAS unsigned char* lds) {
    const int tid = otid(), G = gridDim.x;
    if (blockIdx.x == 0) { if (tid < 64) ((unsigned*)(a->ws + WS_CTL))[tid] = 0u; for (int i = tid; i < 3456; i += 512) ((unsigned*)(a->ws + WS_CTL))[4096 + i] = 0u; }
    for (int item = blockIdx.x; item < 96; item += G) mod_item(a, item / 24, item % 24, lds);
}

__device__ __forceinline__ void transpose_item(const float* W, int K, int N, bf16* WT, int k0, int n0, int drow0, LAS float* scr, int lane) {
#pragma unroll 8
    for (int i = 0; i < 32; ++i) { const int kk = 2 * i + (lane >> 5); scr[kk * 33 + (lane & 31)] = W[(size_t)(k0 + kk) * N + n0 + (lane & 31)]; }
    asm volatile("s_waitcnt lgkmcnt(0)" ::: "memory");
    const int c = lane & 7;
#pragma unroll
    for (int j = 0; j < 4; ++j) { const int n = (lane >> 3) + 8 * j; const LAS float* s = scr + (8 * c) * 33 + n;
        u32x4 o; o.x = pk2(s[0 * 33], s[1 * 33]); o.y = pk2(s[2 * 33], s[3 * 33]); o.z = pk2(s[4 * 33], s[5 * 33]); o.w = pk2(s[6 * 33], s[7 * 33]);
        *(u32x4*)(WT + (size_t)(drow0 + n) * K + k0 + 8 * c) = o; }
    asm volatile("s_waitcnt lgkmcnt(0)" ::: "memory");
}
__device__ __forceinline__ void convert_weights(KArgP a, int layer, LAS unsigned char* lds) {
    const int lane = otid() & 63, wave = otid() >> 6;
    LAS float* scr = (LAS float*)(lds + wave * 8448);
    const int gw = blockIdx.x * 8 + wave, NGW = gridDim.x * 8;
    const bool even = !(layer & 1); const int e = layer >> 1;
    const int nin = even ? 3232 : 3072;
    const float* w_in = even ? a->in[11] + (size_t)e * 1024 * 3232 : a->in[18] + (size_t)e * 1024 * 3072;
    unsigned char* Wb = a->ws + WS_W;
    const int nbin = nin / 32;
    const int I_IN = 16 * nbin, I_OUT = 512, I_G = 16 * 88, I_D = 44 * 32, I_UQ = even ? 6 * 24 : 0, I_UKV = even ? 4 * 32 : 0;
    const int NIT = I_IN + I_OUT + 2 * I_G + I_D + I_UQ + I_UKV;
    for (int it = gw; it < NIT; it += NGW) {
        int r = it;
        if (r < I_IN) { const int kb = r / nbin, nb = r % nbin; transpose_item(w_in, 1024, nin, (bf16*)(Wb + W_IN), 64 * kb, 32 * nb, 32 * nb, scr, lane); continue; } r -= I_IN;
        if (r < I_OUT) { const int kb = r / 32, nb = r % 32; transpose_item(a->in[7] + (size_t)layer * 1024 * 1024, 1024, 1024, (bf16*)(Wb + W_OUT), 64 * kb, 32 * nb, 32 * nb, scr, lane); continue; } r -= I_OUT;
        if (r < I_G) { const int kb = r / 88, nb = r % 88, n0 = 32 * nb; transpose_item(a->in[8] + (size_t)layer * 1024 * FF, 1024, FF, (bf16*)(Wb + W_GU), 64 * kb, n0, (n0 >> 7) * 256 + (n0 & 127), scr, lane); continue; } r -= I_G;
        if (r < I_G) { const int kb = r / 88, nb = r % 88, n0 = 32 * nb; transpose_item(a->in[9] + (size_t)layer * 1024 * FF, 1024, FF, (bf16*)(Wb + W_GU), 64 * kb, n0, (n0 >> 7) * 256 + 128 + (n0 & 127), scr, lane); continue; } r -= I_G;
        if (r < I_D) { const int kb = r / 32, nb = r % 32; transpose_item(a->in[10] + (size_t)layer * FF * 1024, FF, 1024, (bf16*)(Wb + W_DN), 64 * kb, 32 * nb, 32 * nb, scr, lane); continue; } r -= I_D;
        if (r < I_UQ) { const int kb = r / 24, nb = r % 24; transpose_item(a->in[15] + (size_t)e * 384 * 768, 384, 768, (bf16*)(Wb + W_UQ), 64 * kb, 32 * nb, 32 * nb, scr, lane); continue; } r -= I_UQ;
        { const int kb = r / 32, nb = r % 32; transpose_item(a->in[17] + (size_t)e * 256 * 1024, 256, 1024, (bf16*)(Wb + W_UKV), 64 * kb, 32 * nb, 32 * nb, scr, lane); }
    }
}

__device__ __forceinline__ void phase_norm(KArgP a, int layer, int which, bool addT) {
    const int lane = otid() & 63, wave = otid() >> 6;
    const int gw = blockIdx.x * 8 + wave, NGW = gridDim.x * 8;
    float* X = (float*)(a->ws + WS_X); bf16* H = (bf16*)(a->ws + WS_H); const float* T = (const float*)(a->ws + WS_T);
    const float* g = a->in[6] + (layer * 2 + which) * 1024;
    const float* mod = (const float*)(a->ws + WS_MOD) + (size_t)layer * 9 * 6144;
    const int shoff = which ? 3072 : 0, scoff = which ? 4096 : 1024;
    const bool from_inputs = (layer == 0 && which == 0);
    constexpr int RB = 3;
    for (int r0 = gw; r0 < MT; r0 += RB * NGW) {
        f32x4 v[RB][4];
#pragma unroll
        for (int k = 0; k < RB; ++k) { const int row = r0 + k * NGW; if (row < MT) { const f32x4* xr = (const f32x4*)(X + (size_t)row * 1024) + lane;
            if (from_inputs) { const int b = row / TPB, j = row - b * TPB; xr = (const f32x4*)(j < 256 ? a->in[2] + (size_t)(b * 256 + j) * 1024 : a->in[0] + (size_t)(b * NLAT + j - 256) * 1024) + lane; }
#pragma unroll
            for (int q = 0; q < 4; ++q) v[k][q] = xr[64 * q]; } }
#pragma unroll
        for (int k = 0; k < RB; ++k) { const int row = r0 + k * NGW; if (row < MT) {
            const int b = row / TPB, j = row - b * TPB, widx = (j < 256) ? 8 : b;
            if (addT && j < 256) { const f32x4* tr = (const f32x4*)(T + (size_t)(b * 256 + j) * 1024) + lane; f32x4* xr = (f32x4*)(X + (size_t)row * 1024) + lane;
#pragma unroll
                for (int q = 0; q < 4; ++q) { v[k][q] = v[k][q] + tr[64 * q]; xr[64 * q] = v[k][q]; } }
            float ss = 0.f;
#pragma unroll
            for (int q = 0; q < 4; ++q) ss += (v[k][q][0] * v[k][q][0] + v[k][q][1] * v[k][q][1]) + (v[k][q][2] * v[k][q][2] + v[k][q][3] * v[k][q][3]);
            const float rstd = __builtin_amdgcn_rsqf(wave_sum(ss) * (1.f / 1024.f) + EPSN);
#pragma unroll
            for (int q = 0; q < 4; ++q) { const int col = 4 * lane + 256 * q;
                const f32x4 gv = *(const f32x4*)(g + col), sc = *(const f32x4*)(mod + widx * 6144 + scoff + col), sh = *(const f32x4*)(mod + widx * 6144 + shoff + col);
                f32x4 y = v[k][q] * rstd * gv * (sc + 1.0f) + sh;
                u32x2 w; w.x = pk2(y[0], y[1]); w.y = pk2(y[2], y[3]);
                *(u32x2*)(H + (size_t)row * 1024 + col) = w; } } }
    }
}

__device__ __forceinline__ void phase_post_even(KArgP a, int layer) {
    const int lane = otid() & 63, wave = otid() >> 6;
    const int gw = blockIdx.x * 8 + wave, NGW = gridDim.x * 8, e = layer >> 1;
    const bf16* P = (const bf16*)(a->ws + WS_P); bf16* CQN = (bf16*)(a->ws + WS_CQN); bf16* CKVN = (bf16*)(a->ws + WS_CKVN); bf16* KR = (bf16*)(a->ws + WS_KR);
    const float* qg = a->in[14] + e * 384; const float* kg = a->in[16] + e * 256;
    for (int row = gw; row < MT; row += NGW) {
        const int b = row / TPB, j = row - b * TPB;
        const bf16* pr = P + (size_t)row * NP_E;
        {   float x[6]; float ss = 0.f;
#pragma unroll
            for (int k = 0; k < 3; ++k) { const unsigned w = *(const unsigned*)(pr + 2560 + 2 * lane + 128 * k); x[2 * k] = bf2f((unsigned short)(w & 0xffff)); x[2 * k + 1] = bf2f((unsigned short)(w >> 16)); ss += x[2 * k] * x[2 * k] + x[2 * k + 1] * x[2 * k + 1]; }
            const float rstd = __builtin_amdgcn_rsqf(wave_sum(ss) * (1.f / 384.f) + EPSN);
#pragma unroll
            for (int k = 0; k < 3; ++k) { const int col = 2 * lane + 128 * k; *(unsigned*)(CQN + (size_t)row * 384 + col) = pk2(x[2 * k] * rstd * qg[col], x[2 * k + 1] * rstd * qg[col + 1]); } }
        {   float x[4]; float ss = 0.f;
#pragma unroll
            for (int k = 0; k < 2; ++k) { const unsigned w = *(const unsigned*)(pr + 2944 + 2 * lane + 128 * k); x[2 * k] = bf2f((unsigned short)(w & 0xffff)); x[2 * k + 1] = bf2f((unsigned short)(w >> 16)); ss += x[2 * k] * x[2 * k] + x[2 * k + 1] * x[2 * k + 1]; }
            const float rstd = __builtin_amdgcn_rsqf(wave_sum(ss) * (1.f / 256.f) + EPSN);
#pragma unroll
            for (int k = 0; k < 2; ++k) { const int col = 2 * lane + 128 * k; *(unsigned*)(CKVN + (size_t)row * 256 + col) = pk2(x[2 * k] * rstd * kg[col], x[2 * k + 1] * rstd * kg[col + 1]); } }
        {   const int d = lane & 31; const float x = bf2f(pr[3200 + d]); const float xp = __shfl_xor(x, 8);
            float o = x;
            if (j >= 256) { const int t = j - 256, blk = d >> 4, wi = d & 15, i8 = wi & 7; const float pos = (float)(blk ? (t & 63) : (t >> 6));
                float s, c; sincos_r(pos * inv_freq(i8, 8), s, c);
                o = (wi < 8) ? (x * c - xp * s) : (xp * s + x * c); }
            if (lane < 32) KR[(size_t)row * 32 + d] = (bf16)f2bf(o); }
    }
}
__device__ __forceinline__ void phase_post_odd(KArgP a, int layer) {
    const int lane = otid() & 63, wave = otid() >> 6;
    const int gw = blockIdx.x * 8 + wave, NGW = gridDim.x * 8;
    bf16* P = (bf16*)(a->ws + WS_P);
    for (int row = gw; row < MT; row += NGW) {
        const int b = row / TPB, j = row - b * TPB; const bool lat = j >= 256; const int t = j - 256;
        bf16* pr = P + (size_t)row * NP_O;
#pragma unroll
        for (int u = 0; u < 2; ++u) { const int pid = lane + 64 * u, h = pid >> 5, i = pid & 31, d1 = h * 64 + i, d2 = d1 + 32;
            float s = 0.f, c = 1.f; if (lat) sincos_r((float)t * inv_freq(i, 32), s, c);
            const float q1 = bf2f(pr[d1]), q2 = bf2f(pr[d2]), k1 = bf2f(pr[256 + d1]) * 0.125f, k2 = bf2f(pr[256 + d2]) * 0.125f;
            if (lat) { pr[d1] = (bf16)f2bf(q1 * c - q2 * s); pr[d2] = (bf16)f2bf(q1 * s + q2 * c); }
            pr[256 + d1] = (bf16)f2bf(k1 * c - k2 * s); pr[256 + d2] = (bf16)f2bf(k1 * s + k2 * c); }
        if (lat) {
#pragma unroll
            for (int u = 0; u < 4; ++u) { const int pid = lane + 64 * u, vec = pid >> 5, pp = pid & 31, blk = pp >> 4, i = pp & 15, d1 = vec * 64 + blk * 32 + i, d2 = d1 + 16;
                const float pos = (float)(blk ? (t & 63) : (t >> 6)); float s, c; sincos_r(pos * inv_freq(i, 16), s, c);
                const float q1 = bf2f(pr[1536 + d1]), q2 = bf2f(pr[1536 + d2]), k1 = bf2f(pr[2048 + d1]), k2 = bf2f(pr[2048 + d2]);
                pr[1536 + d1] = (bf16)f2bf(q1 * c - q2 * s); pr[1536 + d2] = (bf16)f2bf(q1 * s + q2 * c);
                pr[2048 + d1] = (bf16)f2bf(k1 * c - k2 * s); pr[2048 + d2] = (bf16)f2bf(k1 * s + k2 * c); } }
    }
}

__device__ __forceinline__ void phase_readout(KArgP a, int layer) {
    const int lane = otid() & 63, wave = otid() >> 6;
    const int gw = blockIdx.x * 8 + wave, NGW = gridDim.x * 8;
    const bool even = !(layer & 1); const int np = even ? NP_E : NP_O, gcol = even ? 2048 : 1024;
    const bf16* P = (const bf16*)(a->ws + WS_P); const bf16* OF = (const bf16*)(a->ws + WS_OSC); const bf16* OB = OF + (size_t)MT * 512;
    bf16* MIX = (bf16*)(a->ws + WS_MIX);
    float g0 = 1.f, g1 = 1.f; if (even) { g0 = a->in[13][(layer >> 1) * 128 + 2 * lane]; g1 = a->in[13][(layer >> 1) * 128 + 2 * lane + 1]; }
    constexpr int RB = 3;
    for (int r0 = gw; r0 < MT; r0 += RB * NGW) {
        unsigned wf[RB][4], wb[RB][4], wg[RB][4];
#pragma unroll
        for (int k = 0; k < RB; ++k) { const int row = r0 + k * NGW; if (row < MT) {
#pragma unroll
            for (int h = 0; h < 4; ++h) { const int col = h * 128 + 2 * lane;
                wf[k][h] = *(const unsigned*)(OF + (size_t)row * 512 + col); wb[k][h] = *(const unsigned*)(OB + (size_t)row * 512 + col); wg[k][h] = *(const unsigned*)(P + (size_t)row * np + gcol + col); } } }
#pragma unroll
        for (int k = 0; k < RB; ++k) { const int row = r0 + k * NGW; if (row < MT) {
#pragma unroll
            for (int h = 0; h < 4; ++h) { const int col = h * 128 + 2 * lane;
                const float o0 = bf2f((unsigned short)(wf[k][h] & 0xffff)) + bf2f((unsigned short)(wb[k][h] & 0xffff)), o1 = bf2f((unsigned short)(wf[k][h] >> 16)) + bf2f((unsigned short)(wb[k][h] >> 16));
                const float rstd = __builtin_amdgcn_rsqf(wave_sum(o0 * o0 + o1 * o1) * (1.f / 128.f) + EPSN);
                const float y0 = o0 * rstd * g0 * silu_f(bf2f((unsigned short)(wg[k][h] & 0xffff))), y1 = o1 * rstd * g1 * silu_f(bf2f((unsigned short)(wg[k][h] >> 16)));
                *(unsigned*)(MIX + (size_t)row * 1024 + col) = pk2(y0, y1); } } }
    }
}
__device__ __forceinline__ void phase_final(KArgP a) {
    const int lane = otid() & 63, wave = otid() >> 6;
    const int gw = blockIdx.x * 8 + wave, NGW = gridDim.x * 8;
    const float* X = (const float*)(a->ws + WS_X); const float* g = a->in[22];
    constexpr int RB = 4;
    for (int r0 = gw; r0 < NB * NLAT; r0 += RB * NGW) {
        f32x4 v[RB][4];
#pragma unroll
        for (int k = 0; k < RB; ++k) { const int r = r0 + k * NGW; if (r < NB * NLAT) { const int row = (r >> 11) * TPB + 256 + (r & 2047); const f32x4* xr = (const f32x4*)(X + (size_t)row * 1024) + lane;
#pragma unroll
            for (int q = 0; q < 4; ++q) v[k][q] = xr[64 * q]; } }
#pragma unroll
        for (int k = 0; k < RB; ++k) { const int r = r0 + k * NGW; if (r < NB * NLAT) { float ss = 0.f;
#pragma unroll
            for (int q = 0; q < 4; ++q) ss += (v[k][q][0] * v[k][q][0] + v[k][q][1] * v[k][q][1]) + (v[k][q][2] * v[k][q][2] + v[k][q][3] * v[k][q][3]);
            const float rstd = __builtin_amdgcn_rsqf(wave_sum(ss) * (1.f / 1024.f) + EPSN);
#pragma unroll
            for (int q = 0; q < 4; ++q) { const int col = 4 * lane + 256 * q; const f32x4 gv = *(const f32x4*)(g + col);
                *(f32x4*)(a->out + (size_t)r * 1024 + col) = v[k][q] * rstd * gv; } } }
    }
}
__device__ __forceinline__ unsigned cvtpk2(float lo, float hi) { unsigned r; asm("v_cvt_pk_bf16_f32 %0, %1, %2" : "=v"(r) : "v"(lo), "v"(hi)); return r; }
__device__ __forceinline__ f32x4 mfma16(bf16x8 a, bf16x8 b, f32x4 c) { return __builtin_amdgcn_mfma_f32_16x16x32_bf16(a, b, c, 0, 0, 0); }

template <int DK, bool HG, int MODE>
__device__ __forceinline__ void scan_item(KArgP a, int layer, int item, int seg, LAS unsigned char* lds) {
    const int tid = otid(), wid = tid >> 6, lane = tid & 63, l15 = lane & 15, q4 = lane >> 4;
    const int h = item & 3, dir = (item >> 2) & 1, b = item >> 3;
    constexpr int TPT = DK / 8, QS = DK * 2 + 16, TS = 144;
    constexpr int NP = HG ? NP_E : NP_O;
    LAS unsigned char* Lqt = lds; LAS unsigned char* Lkt = Lqt + 64 * QS; LAS unsigned char* Lqh = Lkt + 64 * QS;
    LAS unsigned char* LkhT = Lqh + 64 * QS; LAS unsigned char* LvT = LkhT + DK * TS; LAS unsigned char* Latt = LvT + 128 * TS;
    LAS float* Ltot = (LAS float*)(Latt + 64 * TS); LAS float* Lbl = Ltot + 512;
    const bf16* P = (const bf16*)(a->ws + WS_P);
    bf16* OSC = (bf16*)(a->ws + WS_OSC) + (size_t)dir * MT * 512;
    f32x4* Ub = (f32x4*)(a->ws + WS_U); float* Lb = (float*)(a->ws + WS_LSUM);
    const int c = tid & (DK - 1), tq = tid / DK;
    float lb = 0.f, lg = 0.f, qscale = 1.f; int qcol, zcol;
    if (HG) { qscale = 0.08838834764831845f; qcol = h * 128 + c; zcol = (dir ? 1536 : 1024) + h * 128 + c;
        if (layer >= 2) { const float l0 = a->in[12][(0 * 2 + dir) * 512 + h * 128 + c], l1 = a->in[12][(1 * 2 + dir) * 512 + h * 128 + c]; lb = 1.f / (1.f + __expf(l0 - l1)); } }
    else { qcol = h * 64 + c; zcol = 256 + h * 64 + c; const float x = a->in[19][((layer >> 1) * 2 + dir) * 4 + h]; lg = -__logf(1.f + __expf(-x)); }
    const int vcol = 512 + h * 128;
    const int rowbase = b * TPB;
    const int tv = lane, c8v = wid;
    unsigned short rq[TPT], rz[TPT]; bf16x8 rv[2];
#define SC_JB(ci) (dir ? ((ci) < 4 ? 255 - 64 * (ci) : 2303 - 64 * ((ci) - 4)) : 64 * (ci))
#define SC_LOAD(ci) do { const int jb_ = SC_JB(ci), sg_ = dir ? -1 : 1; \
        _Pragma("unroll") for (int i = 0; i < TPT; ++i) { const bf16* pr_ = P + (size_t)(rowbase + jb_ + sg_ * (tq * TPT + i)) * NP; if (MODE) rq[i] = pr_[qcol]; rz[i] = pr_[zcol]; } \
        { const bf16* pv_ = P + (size_t)(rowbase + jb_ + sg_ * tv) * NP + vcol; rv[0] = *(const bf16x8*)(pv_ + c8v * 8); rv[1] = *(const bf16x8*)(pv_ + (c8v + 8) * 8); } } while (0)
    f32x4 Sacc[DK / 16];
#pragma unroll
    for (int i = 0; i < DK / 16; ++i) Sacc[i] = (f32x4){0.f, 0.f, 0.f, 0.f};
    const int c0 = 9 * seg;
    SC_LOAD(c0);
    if (MODE) {
        for (int s_ = 0; s_ < seg; ++s_) {
#pragma unroll
            for (int i = 0; i < DK / 16; ++i) { f32x4 v = Sacc[i];
                if (s_ > 0) { const f32x4 l4 = *(const f32x4*)(Lb + (size_t)(item * 3 + s_) * 128 + 16 * i + 4 * q4); v[0] *= __expf(l4[0]); v[1] *= __expf(l4[1]); v[2] *= __expf(l4[2]); v[3] *= __expf(l4[3]); }
                Sacc[i] = v + Ub[((size_t)(item * 3 + s_) * (DK / 16) + i) * 512 + tid]; }
        }
    }
    float lsum = 0.f;
    for (int ci = c0; ci < c0 + 9; ++ci) {
#pragma unroll
        for (int u = 0; u < 2; ++u)
#pragma unroll
            for (int e = 0; e < 8; ++e) *(LAS unsigned short*)(LvT + ((c8v + 8 * u) * 8 + e) * TS + tv * 2) = (unsigned short)rv[u][e];
        float zf[TPT], qf[TPT];
#pragma unroll
        for (int i = 0; i < TPT; ++i) { zf[i] = bf2f(rz[i]); if (MODE) qf[i] = bf2f(rq[i]) * qscale; }
        const int jb = SC_JB(ci), sg = dir ? -1 : 1;
        if (ci + 1 < c0 + 9) SC_LOAD(ci + 1);
        float kk_[TPT], e1v[TPT], e2v[TPT]; float Eref, Ebr, dlast;
        if (HG) {
            float fv[TPT];
#pragma unroll
            for (int i = 0; i < TPT; ++i) { const float z = fminf(fmaxf(zf[i], -30.f), 30.f);
                const float t = __expf(-fabsf(z)), r = __builtin_amdgcn_rcpf(1.f + t), tr = t * r;
                const float sig = z >= 0.f ? r : tr, sigm = z >= 0.f ? tr : r;
                kk_[i] = (1.f - lb) * sigm; fv[i] = lb + (1.f - lb) * sig; }
            float run = 1.f;
            if (tq < 2) {
#pragma unroll
                for (int i = TPT - 1; i >= 0; --i) { e2v[i] = run; run *= fv[i]; }
            } else {
#pragma unroll
                for (int i = 0; i < TPT; ++i) { run *= fv[i]; e1v[i] = run; }
            }
            Ltot[tq * 128 + c] = run;
            __syncthreads();
            const float t0 = Ltot[c], t1 = Ltot[128 + c], t2 = Ltot[256 + c], t3 = Ltot[384 + c];
            Eref = t0 * t1; Ebr = t2 * t3; dlast = Eref * Ebr;
            const float mul = (tq == 0) ? t1 : ((tq == 3) ? t2 : 1.f);
            if (tq < 2) {
#pragma unroll
                for (int i = 0; i < TPT; ++i) { e2v[i] = fmaxf(e2v[i] * mul, 1e-30f); if (MODE) e1v[i] = __builtin_amdgcn_rcpf(e2v[i]); }
            } else {
#pragma unroll
                for (int i = 0; i < TPT; ++i) { e1v[i] = fmaxf(e1v[i] * mul, 1e-30f); e2v[i] = __builtin_amdgcn_rcpf(e1v[i]); }
            }
            lsum += __logf(fmaxf(dlast, 1e-37f));
        } else {
#pragma unroll
            for (int i = 0; i < TPT; ++i) { kk_[i] = zf[i]; e1v[i] = __expf((float)(tq * TPT + i - 31) * lg); e2v[i] = __builtin_amdgcn_rcpf(e1v[i]); }
            Eref = __expf(32.f * lg); Ebr = Eref; dlast = Eref * Ebr;
            lsum += 64.f * lg;
        }
        unsigned short kh[TPT];
        if (MODE) {
#pragma unroll
            for (int i = 0; i < TPT; ++i) { const int tau = tq * TPT + i;
                const float qt = qf[i] * e1v[i], kt = kk_[i] * e2v[i];
                const unsigned wq = cvtpk2(qt, qt * Eref), wk = cvtpk2(kt, kt * Ebr);
                *(LAS unsigned short*)(Lqt + tau * QS + c * 2) = (unsigned short)(wq & 0xffff);
                *(LAS unsigned short*)(Lqh + tau * QS + c * 2) = (unsigned short)(wq >> 16);
                *(LAS unsigned short*)(Lkt + tau * QS + c * 2) = (unsigned short)(wk & 0xffff);
                kh[i] = (unsigned short)(wk >> 16); }
        } else {
#pragma unroll
            for (int i = 0; i < TPT; ++i) kh[i] = (unsigned short)(cvtpk2(kk_[i] * e2v[i] * Ebr, 0.f) & 0xffff);
        }
#pragma unroll
        for (int i8 = 0; i8 < TPT / 8; ++i8) { u32x4 w; w.x = kh[8 * i8] | ((unsigned)kh[8 * i8 + 1] << 16); w.y = kh[8 * i8 + 2] | ((unsigned)kh[8 * i8 + 3] << 16);
            w.z = kh[8 * i8 + 4] | ((unsigned)kh[8 * i8 + 5] << 16); w.w = kh[8 * i8 + 6] | ((unsigned)kh[8 * i8 + 7] << 16);
            *(LAS u32x4*)(LkhT + c * TS + (tq * TPT + 8 * i8) * 2) = w; }
        if (tq == 0) Lbl[c] = dlast;
        __syncthreads();
        const int dvl = 16 * wid + l15;
        const bf16x8 bv0 = *(const LAS bf16x8*)(LvT + dvl * TS + (8 * q4) * 2), bv1 = *(const LAS bf16x8*)(LvT + dvl * TS + (32 + 8 * q4) * 2);
        if (MODE) {
#pragma unroll
            for (int tt = 0; tt < 2; ++tt) { const int idx = 2 * wid + tt, si = idx >> 2, ti = idx & 3;
                f32x4 acc = (f32x4){0.f, 0.f, 0.f, 0.f};
#pragma unroll
                for (int kk = 0; kk < DK / 32; ++kk) { const bf16x8 A = *(const LAS bf16x8*)(Lkt + (16 * si + l15) * QS + (32 * kk + 8 * q4) * 2);
                    const bf16x8 B = *(const LAS bf16x8*)(Lqt + (16 * ti + l15) * QS + (32 * kk + 8 * q4) * 2); acc = mfma16(A, B, acc); }
                const int t = 16 * ti + l15, s0 = 16 * si + 4 * q4;
                u32x2 w; w.x = pk2(s0 + 0 <= t ? acc[0] : 0.f, s0 + 1 <= t ? acc[1] : 0.f); w.y = pk2(s0 + 2 <= t ? acc[2] : 0.f, s0 + 3 <= t ? acc[3] : 0.f);
                *(LAS u32x2*)(Latt + t * TS + s0 * 2) = w; }
            __syncthreads();
            bf16x8 Sb[DK / 32];
#pragma unroll
            for (int kk = 0; kk < DK / 32; ++kk) { u32x4 w; w.x = pk2(Sacc[2 * kk][0], Sacc[2 * kk][1]); w.y = pk2(Sacc[2 * kk][2], Sacc[2 * kk][3]);
                w.z = pk2(Sacc[2 * kk + 1][0], Sacc[2 * kk + 1][1]); w.w = pk2(Sacc[2 * kk + 1][2], Sacc[2 * kk + 1][3]); Sb[kk] = __builtin_bit_cast(bf16x8, w); }
#pragma unroll
            for (int ti = 0; ti < 4; ++ti) {
                f32x4 acc = (f32x4){0.f, 0.f, 0.f, 0.f};
                { const bf16x8 A = *(const LAS bf16x8*)(Latt + (16 * ti + l15) * TS + (8 * q4) * 2); acc = mfma16(A, bv0, acc); }
                if (ti >= 2) { const bf16x8 A = *(const LAS bf16x8*)(Latt + (16 * ti + l15) * TS + (32 + 8 * q4) * 2); acc = mfma16(A, bv1, acc); }
#pragma unroll
                for (int kk = 0; kk < DK / 32; ++kk) {
                    const s16x4 lo = *(const LAS s16x4*)(Lqh + (16 * ti + l15) * QS + (32 * kk + 4 * q4) * 2), hi = *(const LAS s16x4*)(Lqh + (16 * ti + l15) * QS + (32 * kk + 16 + 4 * q4) * 2);
                    const bf16x8 A = (bf16x8){lo[0], lo[1], lo[2], lo[3], hi[0], hi[1], hi[2], hi[3]};
                    acc = mfma16(A, Sb[kk], acc); }
#pragma unroll
                for (int r = 0; r < 4; ++r) { const int t = 16 * ti + 4 * q4 + r;
                    OSC[(size_t)(rowbase + jb + sg * t) * 512 + h * 128 + dvl] = (bf16)f2bf(acc[r]); }
            }
        }
#pragma unroll
        for (int i = 0; i < DK / 16; ++i) {
            const f32x4 d4 = *(const LAS f32x4*)(Lbl + 16 * i + 4 * q4);
            f32x4 s = Sacc[i] * d4;
            const bf16x8 A0 = *(const LAS bf16x8*)(LkhT + (16 * i + l15) * TS + (8 * q4) * 2), A1 = *(const LAS bf16x8*)(LkhT + (16 * i + l15) * TS + (32 + 8 * q4) * 2);
            s = mfma16(A0, bv0, s); s = mfma16(A1, bv1, s); Sacc[i] = s; }
        __syncthreads();
    }
    if (!MODE) {
#pragma unroll
        for (int i = 0; i < DK / 16; ++i) Ub[((size_t)(item * 3 + seg) * (DK / 16) + i) * 512 + tid] = Sacc[i];
        if (tq == 0) Lb[(size_t)(item * 3 + seg) * 128 + c] = lsum;
    }
#undef SC_JB
#undef SC_LOAD
}

#define SBAR() __builtin_amdgcn_sched_barrier(0)
__device__ __forceinline__ int crow(int r, int hi) { return (r & 3) + 8 * (r >> 2) + 4 * hi; }
__device__ __forceinline__ unsigned cvtpk(float lo, float hi) { unsigned r; asm volatile("v_cvt_pk_bf16_f32 %0, %1, %2" : "=v"(r) : "v"(lo), "v"(hi)); return r; }
__device__ __forceinline__ void partialSM(f32x16& p0, f32x16& p1, float& m_reg, float& mn, float& alpha, float C, float thr_raw) {
    float pmax = p0[0];
#pragma unroll
    for (int r = 1; r < 16; ++r) pmax = fmaxf(pmax, p0[r]);
#pragma unroll
    for (int r = 0; r < 16; ++r) pmax = fmaxf(pmax, p1[r]);
    { auto rr = __builtin_amdgcn_permlane32_swap(__float_as_uint(pmax), __float_as_uint(pmax), false, false);
      pmax = fmaxf(__uint_as_float(rr[0]), __uint_as_float(rr[1])); }
    if (__builtin_expect(__all(pmax - m_reg <= thr_raw), 1)) { mn = m_reg; alpha = 1.f; }
    else { mn = fmaxf(m_reg, pmax); alpha = __builtin_amdgcn_exp2f((m_reg - mn) * C); m_reg = mn; }
    const float mnC = -mn * C;
#pragma unroll
    for (int r = 0; r < 16; ++r) p0[r] = fmaf(p0[r], C, mnC);
#pragma unroll
    for (int r = 0; r < 16; ++r) p1[r] = fmaf(p1[r], C, mnC);
#pragma unroll
    for (int r = 0; r < 16; ++r) p0[r] = __builtin_amdgcn_exp2f(p0[r]);
}
__device__ __forceinline__ void finishSM(f32x16& p0, f32x16& p1, float alpha, float& l_reg, bf16x8& pa0, bf16x8& pa1, bf16x8& pa2, bf16x8& pa3) {
#pragma unroll
    for (int r = 0; r < 16; ++r) p1[r] = __builtin_amdgcn_exp2f(p1[r]);
    float ps = 0;
#pragma unroll
    for (int r = 0; r < 16; ++r) ps += p0[r];
#pragma unroll
    for (int r = 0; r < 16; ++r) ps += p1[r];
    { auto rr = __builtin_amdgcn_permlane32_swap(__float_as_uint(ps), __float_as_uint(ps), false, false);
      ps = __uint_as_float(rr[0]) + __uint_as_float(rr[1]); }
    l_reg = l_reg * alpha + ps;
#define PK4(P, BASE, OUT) do { unsigned a0 = cvtpk(P[BASE + 0], P[BASE + 1]), a1 = cvtpk(P[BASE + 2], P[BASE + 3]);   \
    unsigned b0 = cvtpk(P[BASE + 4], P[BASE + 5]), b1 = cvtpk(P[BASE + 6], P[BASE + 7]);                              \
    auto r0 = __builtin_amdgcn_permlane32_swap(a0, b0, false, false); auto r1 = __builtin_amdgcn_permlane32_swap(a1, b1, false, false); \
    u32x4 w = {r0[0], r1[0], r0[1], r1[1]}; OUT = __builtin_bit_cast(bf16x8, w); } while (0)
    PK4(p0, 0, pa0); PK4(p0, 8, pa1); PK4(p1, 0, pa2); PK4(p1, 8, pa3);
#undef PK4
}
template <int ND0, int KROWB>
__device__ __forceinline__ void qkt(f32x16& p0, f32x16& p1, const char* Ks, const bf16x8* qr, int r32, int hi) {
    p0 = f32x16{}; p1 = f32x16{};
#pragma unroll
    for (int d0 = 0; d0 < ND0; ++d0) { const int cb = (d0 * 16 + hi * 8) * 2;
        const bf16x8 b0 = *reinterpret_cast<const bf16x8*>(Ks + r32 * KROWB + (cb ^ ((r32 & 7) << 4)));
        const bf16x8 b1 = *reinterpret_cast<const bf16x8*>(Ks + (32 + r32) * KROWB + (cb ^ ((r32 & 7) << 4)));
        p0 = __builtin_amdgcn_mfma_f32_32x32x16_bf16(b0, qr[d0], p0, 0, 0, 0);
        p1 = __builtin_amdgcn_mfma_f32_32x32x16_bf16(b1, qr[d0], p1, 0, 0, 0); }
}
template <int NCB> __device__ __forceinline__ int v_st(int k, int c) { const int kk = (k & ~0xC) | ((k & 4) << 1) | ((k & 8) >> 1); return ((kk >> 3) * NCB + (c >> 5)) * 512 + ((kk & 7) * 32 + (c & 31)) * 2; }
__device__ __forceinline__ int v_rd_base(int lane) { return ((lane & 3) << 3) | (((lane >> 2) & 3) << 6) | (((lane >> 4) & 1) << 5) | (((lane >> 5) & 1) << 8); }
template <int OFF> __device__ __forceinline__ s16x4 tr_read(int vb) {
    s16x4 r; asm volatile("ds_read_b64_tr_b16 %0, %1 offset:%2" : "=&v"(r) : "v"(vb), "i"(OFF) : "memory"); return r;
}
template <int NCB, int D0> __device__ __forceinline__ void pv_one(f32x16& od, int vb, bf16x8 pa0, bf16x8 pa1, bf16x8 pa2, bf16x8 pa3) {
#define VOFF(ks, half) (D0 * 512 + (ks) * (NCB * 1024) + (half) * (NCB * 512))
    const s16x4 l0 = tr_read<VOFF(0, 0)>(vb), h0 = tr_read<VOFF(0, 1)>(vb), l1 = tr_read<VOFF(1, 0)>(vb), h1 = tr_read<VOFF(1, 1)>(vb);
    const s16x4 l2 = tr_read<VOFF(2, 0)>(vb), h2 = tr_read<VOFF(2, 1)>(vb), l3 = tr_read<VOFF(3, 0)>(vb), h3 = tr_read<VOFF(3, 1)>(vb);
#undef VOFF
    asm volatile("s_waitcnt lgkmcnt(0)" ::: "memory"); SBAR();
#define PK(L, H) (bf16x8){L[0], L[1], L[2], L[3], H[0], H[1], H[2], H[3]}
    od = __builtin_amdgcn_mfma_f32_32x32x16_bf16(pa0, PK(l0, h0), od, 0, 0, 0);
    od = __builtin_amdgcn_mfma_f32_32x32x16_bf16(pa1, PK(l1, h1), od, 0, 0, 0);
    od = __builtin_amdgcn_mfma_f32_32x32x16_bf16(pa2, PK(l2, h2), od, 0, 0, 0);
    od = __builtin_amdgcn_mfma_f32_32x32x16_bf16(pa3, PK(l3, h3), od, 0, 0, 0);
#undef PK
}
template <int NCB> __device__ __forceinline__ void pv_all(f32x16* o, int vb, bf16x8 pa0, bf16x8 pa1, bf16x8 pa2, bf16x8 pa3) {
    pv_one<NCB, 0>(o[0], vb, pa0, pa1, pa2, pa3); pv_one<NCB, 1>(o[1], vb, pa0, pa1, pa2, pa3);
    if constexpr (NCB == 4) { pv_one<NCB, 2>(o[2], vb, pa0, pa1, pa2, pa3); pv_one<NCB, 3>(o[3], vb, pa0, pa1, pa2, pa3); }
}

template <int DQK, int DV, int KROWB>
__device__ __forceinline__ void attn_core(const bf16x8* qr, const bf16* kA, int sA, const bf16* kB, int sB, const bf16* vP, int sV,
                                          int NT, float C, float thr_raw, char* lds, f32x16* o, float& l_out, const int tid) {
    constexpr int NCB = DV / 32, SHM_V = 64 * DV * 2, SHM_K = 64 * KROWB, ND0 = DQK / 16;
    constexpr int PPR = DQK / 8, NPK = 64 * PPR, NKS = (NPK + 511) / 512, VPR = DV / 8, NVS = 64 * VPR / 512;
    const int wid = tid >> 6, lane = tid & 63, r32 = lane & 31, hi = lane >> 5;
    char* V_lds = lds; char* K_lds = lds + 2 * SHM_V;
    float* wsf = (float*)(lds + 2 * SHM_V + 2 * SHM_K) + wid * 64; float* al_l = wsf + 32;
    float m_reg = -1e30f, l_reg = 0;
    const bf16* kp[NKS]; int kadv[NKS], kst[NKS]; bool kval[NKS];
#pragma unroll
    for (int i = 0; i < NKS; ++i) { int p = tid + 512 * i; kval[i] = p < NPK; if (!kval[i]) p -= 512; const int row = p / PPR, c8 = p - row * PPR;
        if (c8 < 8) { kp[i] = kA + (size_t)row * sA + c8 * 8; kadv[i] = 64 * sA; } else { kp[i] = kB + (size_t)row * sB + (c8 - 8) * 8; kadv[i] = 64 * sB; }
        kst[i] = row * KROWB + ((c8 * 16) ^ ((row & 7) << 4)); }
    const bf16* vp[NVS]; int vst[NVS];
#pragma unroll
    for (int i = 0; i < NVS; ++i) { const int p = tid + 512 * i, row = p / VPR, c8 = p % VPR; vp[i] = vP + (size_t)row * sV + c8 * 8; vst[i] = v_st<NCB>(row, c8 * 8); }
    const int vadv = 64 * sV;
    const int vb0 = (int)(uintptr_t)V_lds + v_rd_base(lane);
    struct { bf16x8 ks[NKS]; bf16x8 vs[NVS]; } sr_[1];
#define SLOAD(i, t) do { _Pragma("unroll") for (int s_ = 0; s_ < NKS; ++s_) sr_[i].ks[s_] = *(const bf16x8*)(kp[s_] + (size_t)(t) * kadv[s_]); \
        _Pragma("unroll") for (int s_ = 0; s_ < NVS; ++s_) sr_[i].vs[s_] = *(const bf16x8*)(vp[s_] + (size_t)(t) * vadv); } while (0)
#define SWRITE(b, i) do { _Pragma("unroll") for (int s_ = 0; s_ < NVS; ++s_) *(bf16x8*)(V_lds + (b) * SHM_V + vst[s_]) = sr_[i].vs[s_]; \
        _Pragma("unroll") for (int s_ = 0; s_ < NKS; ++s_) if (kval[s_]) *(bf16x8*)(K_lds + (b) * SHM_K + kst[s_]) = sr_[i].ks[s_]; } while (0)
#define RESC(a) do { if (__any((a) < 1.f)) { if (hi == 0) al_l[r32] = (a); asm volatile("s_waitcnt lgkmcnt(0)" ::: "memory"); \
        _Pragma("unroll") for (int d = 0; d < NCB; ++d) _Pragma("unroll") for (int r = 0; r < 16; ++r) o[d][r] *= al_l[crow(r, hi)]; } } while (0)
    f32x16 pA0, pA1, pB0, pB1; float mnA, mnB, alA, alB; bf16x8 pa0, pa1, pa2, pa3;
    constexpr int SE = 0, SO = 0;
    SLOAD(SE, 0); SWRITE(0, SE); __syncthreads();
    qkt<ND0, KROWB>(pA0, pA1, K_lds, qr, r32, hi); partialSM(pA0, pA1, m_reg, mnA, alA, C, thr_raw);
    SLOAD(SO, 1);
    SWRITE(1, SO); __syncthreads();
    for (int j = 1; j + 1 < NT; j += 2) {
        SBAR(); qkt<ND0, KROWB>(pB0, pB1, K_lds + SHM_K, qr, r32, hi);
        finishSM(pA0, pA1, alA, l_reg, pa0, pa1, pa2, pa3); SBAR();
        SLOAD(SO, j + 1); SBAR();
        pv_all<NCB>(o, vb0, pa0, pa1, pa2, pa3); partialSM(pB0, pB1, m_reg, mnB, alB, C, thr_raw);
        __syncthreads(); SWRITE(0, SE);
        RESC(alB); __syncthreads();
        SBAR(); qkt<ND0, KROWB>(pA0, pA1, K_lds, qr, r32, hi);
        finishSM(pB0, pB1, alB, l_reg, pa0, pa1, pa2, pa3); SBAR();
        SLOAD(SE, j + 2); SBAR();
        pv_all<NCB>(o, vb0 + SHM_V, pa0, pa1, pa2, pa3); partialSM(pA0, pA1, m_reg, mnA, alA, C, thr_raw);
        __syncthreads(); SWRITE(1, SO);
        RESC(alA); __syncthreads();
    }
    SBAR(); qkt<ND0, KROWB>(pB0, pB1, K_lds + SHM_K, qr, r32, hi);
    finishSM(pA0, pA1, alA, l_reg, pa0, pa1, pa2, pa3); SBAR();
    pv_all<NCB>(o, vb0, pa0, pa1, pa2, pa3); partialSM(pB0, pB1, m_reg, mnB, alB, C, thr_raw);
    __syncthreads(); RESC(alB);
    finishSM(pB0, pB1, alB, l_reg, pa0, pa1, pa2, pa3); SBAR();
    pv_all<NCB>(o, vb0 + SHM_V, pa0, pa1, pa2, pa3);
    l_out = l_reg;
#undef SLOAD
#undef SWRITE
#undef RESC
}

__device__ __forceinline__ void mla_item(KArgP a, int b, int h, int qb, char* lds) {
    const int tid = ptid(), wid = tid >> 6, lane = tid & 63, r32 = lane & 31, hi = lane >> 5;
    const bf16* Qb = (const bf16*)((const unsigned char*)a->out + OUT_Q); const bf16* KV = (const bf16*)((const unsigned char*)a->out + OUT_KV);
    const bf16* KR = (const bf16*)(a->ws + WS_KR); bf16* MIX = (bf16*)(a->ws + WS_MIX);
    const int row0 = b * TPB + qb * 256, krow0 = b * TPB, NT = qb ? 36 : 4;
    const int row = row0 + wid * 32 + r32;
    const bf16* Qw = Qb + (size_t)row * 768 + h * 96;
    bf16x8 qr[6];
#pragma unroll
    for (int d0 = 0; d0 < 4; ++d0) qr[d0] = *(const bf16x8*)(Qw + d0 * 16 + hi * 8);
    const int t = (qb - 1) * 256 + wid * 32 + r32;
#pragma unroll
    for (int d0 = 4; d0 < 6; ++d0) {
        const bf16x8 x1 = *(const bf16x8*)(Qw + d0 * 16), x2 = *(const bf16x8*)(Qw + d0 * 16 + 8);
        if (qb) { const float pos = (float)(d0 == 4 ? (t >> 6) : (t & 63)); unsigned short ov[8];
#pragma unroll
            for (int i = 0; i < 8; ++i) { float s, c; sincos_r(pos * inv_freq(i, 8), s, c); const float f1 = bf2f((unsigned short)x1[i]), f2 = bf2f((unsigned short)x2[i]);
                ov[i] = (unsigned short)f2bf(hi ? (f1 * s + f2 * c) : (f1 * c - f2 * s)); }
            qr[d0] = (bf16x8){(short)ov[0], (short)ov[1], (short)ov[2], (short)ov[3], (short)ov[4], (short)ov[5], (short)ov[6], (short)ov[7]};
        } else qr[d0] = hi ? x2 : x1;
    }
    f32x16 o[2] = {}; float l_reg;
    const float scale = 0.10206207261596575f;
    attn_core<96, 64, 256>(qr, KV + (size_t)krow0 * 1024 + h * 128, 1024, KR + (size_t)krow0 * 32, 32, KV + (size_t)krow0 * 1024 + h * 128 + 64, 1024,
                           NT, scale * 1.4426950408889634f, 8.f / scale, lds, o, l_reg, tid);
    float* li_l = (float*)(lds + 2 * 64 * 64 * 2 + 2 * 64 * 256) + wid * 64;
    if (hi == 0) li_l[r32] = l_reg; asm volatile("s_waitcnt lgkmcnt(0)" ::: "memory");
#pragma unroll
    for (int r = 0; r < 16; ++r) { const int orow = crow(r, hi); const float rl = __builtin_amdgcn_rcpf(li_l[orow]);
        bf16* op = MIX + (size_t)(row0 + wid * 32 + orow) * 1024 + 512 + h * 64 + r32;
        op[0] = (bf16)f2bf(o[0][r] * rl); op[32] = (bf16)f2bf(o[1][r] * rl); }
}
__device__ __forceinline__ void diff_item(KArgP a, int layer, int b, int h, int qb, char* lds) {
    const int row0 = b * TPB + qb * 256, krow0 = b * TPB, NT = qb ? 36 : 4, o_ = layer >> 1;
    const float scale = 0.125f;
#pragma unroll 1
    for (int m = 0; m < 2; ++m) {
        f32x16 o[4] = {};
        float l_reg;
        {
            const int tid = ptid(), wid = tid >> 6, lane = tid & 63, r32 = lane & 31, hi = lane >> 5;
            const bf16* P = (const bf16*)(a->ws + WS_P);
            const bf16* Qw = P + (size_t)(row0 + wid * 32 + r32) * NP_O + 1536 + h * 128 + m * 64;
            bf16x8 qr[4];
#pragma unroll
            for (int d0 = 0; d0 < 4; ++d0) qr[d0] = *(const bf16x8*)(Qw + d0 * 16 + hi * 8);
            const bf16* Kp = P + (size_t)krow0 * NP_O + 2048 + h * 128 + m * 64;
            attn_core<64, 128, 128>(qr, Kp, NP_O, Kp, NP_O, P + (size_t)krow0 * NP_O + 2560 + h * 128, NP_O,
                                    NT, scale * 1.4426950408889634f, 8.f / scale, lds, o, l_reg, tid);
        }
        const int tid = ptid(), wid = tid >> 6, lane = tid & 63, r32 = lane & 31, hi = lane >> 5;
        float* li_l = (float*)(lds + 2 * 64 * 128 * 2 + 2 * 64 * 128) + wid * 64;
        if (hi == 0) li_l[r32] = l_reg; asm volatile("s_waitcnt lgkmcnt(0)" ::: "memory");
        float* dsb = (float*)a->out + (size_t)blockIdx.x * 64 * 512 + tid; asm volatile("" : "+v"(dsb));
        if (m == 0) {
#pragma unroll
            for (int r = 0; r < 16; ++r) { const float rl = __builtin_amdgcn_rcpf(li_l[crow(r, hi)]);
#pragma unroll
                for (int d = 0; d < 4; ++d) dsb[(size_t)(d * 16 + r) * 512] = o[d][r] * rl; }
        } else {
            bf16* MIX = (bf16*)(a->ws + WS_MIX);
            const float* lp = a->in[20] + o_ * 256;
            const float lam_init = 0.8f - 0.6f * __expf(-0.3f * (float)layer);
            const float lam = __expf(wave_sum(lp[lane] * lp[64 + lane])) - __expf(wave_sum(lp[128 + lane] * lp[192 + lane])) + lam_init;
            const float* sg = a->in[21] + o_ * 128;
#pragma unroll
            for (int r = 0; r < 16; ++r) { const float rl = __builtin_amdgcn_rcpf(li_l[crow(r, hi)]); float s = 0.f; float v[4];
#pragma unroll
                for (int d = 0; d < 4; ++d) { v[d] = dsb[(size_t)(d * 16 + r) * 512] - lam * (o[d][r] * rl); s += v[d] * v[d]; }
                s += __shfl_xor(s, 16); s += __shfl_xor(s, 8); s += __shfl_xor(s, 4); s += __shfl_xor(s, 2); s += __shfl_xor(s, 1);
                const float rs = __builtin_amdgcn_rsqf(s * (1.f / 128.f) + EPSN) * (1.f - lam_init);
                bf16* op = MIX + (size_t)(row0 + wid * 32 + crow(r, hi)) * 1024 + 512 + h * 128 + r32;
#pragma unroll
                for (int d = 0; d < 4; ++d) op[32 * d] = (bf16)f2bf(v[d] * rs * sg[32 * d + r32]);
                asm volatile("" ::: "memory"); }
        }
        asm volatile("s_waitcnt vmcnt(0) lgkmcnt(0)" ::: "memory");
    }
}

__device__ __forceinline__ void phase_mixer(KArgP a, int layer, unsigned char* ldsg) {
    LAS unsigned char* lds = (LAS unsigned char*)ldsg;
    volatile LAS unsigned* flag = (volatile LAS unsigned*)(lds + LDS_MAIN);
    unsigned* ctr = (unsigned*)(a->ws + WS_CTL) + layer; layer &= 7;
    const bool even = !(layer & 1), need_ctx = layer < 3;
    constexpr int NSC = 256;
    const int n_lat = even ? 512 : 256, n_ctx = need_ctx ? (even ? 64 : 32) : 0, total = NSC + n_lat + n_ctx;
    for (;;) {
        __syncthreads();
        if (ptid() == 0) *flag = atomicAdd(ctr, 1u);
        __syncthreads();
        const int qi_ = (int)*flag;
        if (qi_ >= total) break;
        const int item = qi_ < n_lat ? NSC + qi_ : (qi_ < n_lat + NSC ? qi_ - n_lat : qi_);
#ifdef PROBE_ITEM
        const unsigned long long it0_ = __builtin_amdgcn_s_memrealtime();
#endif
#ifndef SKIP_SCAN
        if (item < NSC) { if (even) scan_item<128, true, 1>(a, layer, item & 63, item >> 6, lds); else scan_item<64, false, 1>(a, layer, item & 63, item >> 6, lds); }
#else
        if (item < NSC) {}
#endif
        else { int b_, h_, qb_;
            if (item < NSC + n_lat) { const int i = item - NSC; qb_ = 1 + (i & 7); if (even) { b_ = i >> 6; h_ = (i >> 3) & 7; } else { b_ = i >> 5; h_ = (i >> 3) & 3; } }
            else { const int i = item - NSC - n_lat; qb_ = 0; if (even) { b_ = i >> 3; h_ = i & 7; } else { b_ = i >> 2; h_ = i & 3; } }
#ifndef SKIP_ATTN
            if (even) mla_item(a, b_, h_, qb_, (char*)ldsg); else diff_item(a, layer, b_, h_, qb_, (char*)ldsg);
#endif
        }
#ifdef PROBE_ITEM
        __syncthreads();
        if (otid() == 0) { volatile LAS unsigned long long* pc_ = (volatile LAS unsigned long long*)(lds + LDS_MAIN + 128); const int k_ = item < NSC ? 0 : (even ? 1 : 2); pc_[k_] += __builtin_amdgcn_s_memrealtime() - it0_; }
#endif
    }
}

#define XB_TMO      128
#define XB_XCNT(j)  (256  + 64 * (j))
#define XB_XSUB(j)  (1280 + 64 * (j))
#define XB_XGEN(j)  (2304 + 64 * (j))
#define XB_TOP      3328
#define XB_TOPGEN   3392
#define XCD_BAR_WORDS 3456
#define XB_SPIN_CAP (1u << 18)

__device__ __forceinline__ unsigned xb_ld(unsigned* p)              { return __hip_atomic_load(p, __ATOMIC_RELAXED, __HIP_MEMORY_SCOPE_AGENT); }
__device__ __forceinline__ unsigned xb_add(unsigned* p, unsigned v) { return __hip_atomic_fetch_add(p, v, __ATOMIC_RELAXED, __HIP_MEMORY_SCOPE_AGENT); }
__device__ __forceinline__ unsigned xb_xcc_id() { return (unsigned)__builtin_amdgcn_s_getreg((3 << 11) | 20) & 0xFu; }
#define XB_SPIN(cond, bar) do { unsigned _sp = 0; while (cond) { __builtin_amdgcn_s_sleep(1); \
    if ((++_sp & 255u) == 0u) { if (xb_ld(&(bar)[XB_TMO])) break; if (_sp > XB_SPIN_CAP) { atomicAdd(&(bar)[XB_TMO], 1u); break; } } } } while (0)

struct XcdBarrier {
    unsigned* bar; unsigned x;
    volatile LAS unsigned* st;
};

__device__ __forceinline__ XcdBarrier xcd_barrier_post(unsigned* bar, volatile LAS unsigned* st) {
    XcdBarrier b; b.bar = bar; b.x = xb_xcc_id(); b.st = st;
    if (threadIdx.x == 0) (void)xb_add(&bar[XB_XCNT(b.x)], 1u);
    return b;
}
__device__ __forceinline__ void xcd_barrier_complete(unsigned* bar, unsigned x, unsigned& nloc, unsigned& nx) {
    const unsigned G = gridDim.x * gridDim.y * gridDim.z;
    unsigned sum, cnt, mine, sp = 0u;
    for (;;) {
        sum = 0u; cnt = 0u; mine = 0u;
#pragma unroll
        for (unsigned j = 0; j < 16; ++j) { const unsigned c = xb_ld(&bar[XB_XCNT(j)]); sum += c; cnt += (c > 0u) ? 1u : 0u; mine = (j == x) ? c : mine; }
        if (sum == G) break;
        __builtin_amdgcn_s_sleep(1);
        if ((++sp & 255u) == 0u) { if (xb_ld(&bar[XB_TMO])) break; if (sp > XB_SPIN_CAP) { atomicAdd(&bar[XB_TMO], 1u); break; } }
    }
    nloc = mine > 0u ? mine : 1u; nx = cnt > 0u ? cnt : 1u;
}

__device__ __forceinline__ void xcd_barrier(const XcdBarrier& b) {
    asm volatile("s_waitcnt vmcnt(0)" ::: "memory");
    __syncthreads();
    if (threadIdx.x == 0) {
        unsigned* bar = b.bar;
        __builtin_amdgcn_s_waitcnt(0);
        unsigned nloc = b.st[0], nx = b.st[1];
        if (nloc == 0u) { xcd_barrier_complete(bar, b.x, nloc, nx); b.st[0] = nloc; b.st[1] = nx; }
        const unsigned old = xb_add(&bar[XB_XSUB(b.x)], 1u);
        const unsigned gen = old / nloc;
        if (old + 1u == (gen + 1u) * nloc) {
            __builtin_amdgcn_fence(__ATOMIC_RELEASE, "agent");
            asm volatile("s_waitcnt vmcnt(0)" ::: "memory");
            const unsigned og = xb_add(&bar[XB_TOP], 1u);
            const unsigned tg = og / nx;
            if (og + 1u == (tg + 1u) * nx) xb_add(&bar[XB_TOPGEN], 1u);
            else XB_SPIN(xb_ld(&bar[XB_TOPGEN]) == tg, bar);
            __builtin_amdgcn_fence(__ATOMIC_ACQUIRE, "agent");
            xb_add(&bar[XB_XGEN(b.x)], 1u);
            asm volatile("s_waitcnt vmcnt(0)" ::: "memory");
        } else {
            XB_SPIN(xb_ld(&bar[XB_XGEN(b.x)]) == gen, bar);
            __builtin_amdgcn_fence(__ATOMIC_ACQUIRE, "agent");
            asm volatile("s_waitcnt vmcnt(0)" ::: "memory");
        }
    }
    __syncthreads();
}

__global__ void __launch_bounds__(512, 2) mega_fwd(Args a_) {
    extern __shared__ __attribute__((aligned(16))) unsigned char lds_raw[];
    LAS unsigned char* lds = (LAS unsigned char*)lds_raw;
    ((LAS int*)(lds + LDS_MAIN + 1024))[threadIdx.x] = (int)threadIdx.x;
    if (threadIdx.x < 4) ((LAS unsigned*)(lds + LDS_MAIN + 64))[threadIdx.x] = 0u;
    if (threadIdx.x < 8) ((LAS unsigned*)(lds + LDS_MAIN + 128))[threadIdx.x] = 0u;
    __syncthreads();
    XcdBarrier xbar; xbar.bar = nullptr; xbar.x = 0; xbar.st = nullptr; bool xb_ready = false;
    cg::grid_group grid = cg::this_grid();
    int ph = 0;
#ifdef PROBE_MASK
    unsigned long long pr_last = __builtin_amdgcn_s_memrealtime(), pr_acc = 0ull;
#define PROBE_STAMP(k) { const unsigned long long now_ = __builtin_amdgcn_s_memrealtime(); if ((PROBE_MASK >> (k)) & 1) pr_acc += now_ - pr_last; pr_last = now_; }
#else
#define PROBE_STAMP(k)
#endif
    const int plo = a_.lo, phi = a_.hi;
#define PH_BEGIN if (ph >= plo && ph < phi) { KArgP a = kargs(); int bx = (int)blockIdx.x, G = (int)gridDim.x; asm volatile("" : "+s"(bx), "+s"(G)); (void)bx; (void)G;
#ifdef PROBE_SYNC2
#define PH_ENDT(k)   if (ph + 1 < phi) { grid.sync(); grid.sync(); } } ++ph;
#else
#define PH_ENDT(k) if (ph + 1 < phi) { if (!xb_ready) { grid.sync(); xbar = xcd_barrier_post((unsigned*)(a->ws + WS_CTL) + 4096, (volatile LAS unsigned*)(lds + LDS_MAIN + 64)); xb_ready = true; } else xcd_barrier(xbar); } PROBE_STAMP(k) } ++ph;
#endif

    PH_BEGIN phase_prep(a, lds); PH_ENDT(0)

    for (int layer = 0; layer < 4; ++layer) {
        const bool even = !(layer & 1);
        const int np = even ? NP_E : NP_O;
        PH_BEGIN phase_norm(a, layer, 0, layer > 0); convert_weights(a, layer, lds); PH_ENDT(1)
#ifndef SKIP_G1
        PH_BEGIN { bf16* H = (bf16*)(a->ws + WS_H); bf16* MIX = (bf16*)(a->ws + WS_MIX); bf16* P = (bf16*)(a->ws + WS_P); float* X = (float*)(a->ws + WS_X); unsigned char* Wb = a->ws + WS_W; const float* mod = (const float*)(a->ws + WS_MOD) + (size_t)layer * 9 * 6144; (void)H; (void)MIX; (void)P; (void)X; (void)mod; pg8::Gemm g{H, (const bf16*)(Wb + W_IN), MT, np, 1024, 1024}; pg8::StaticOrder S; S.init(MT, np, G, bx);
                   pg8::EpiBf16<0> E{P, np, nullptr, 0, 0, 1.f};
                   pg8::gemm_phase<pg8::EpiBf16<0>, pg8::StaticOrder, true, true>(lds, g, S, E); } PH_ENDT(2)
#else
        ++ph;
#endif
        PH_BEGIN if (even) phase_post_even(a, layer); else phase_post_odd(a, layer); PH_ENDT(3)
#ifndef SKIP_G3
        if (even) {
            PH_BEGIN { bf16* H = (bf16*)(a->ws + WS_H); bf16* MIX = (bf16*)(a->ws + WS_MIX); bf16* P = (bf16*)(a->ws + WS_P); float* X = (float*)(a->ws + WS_X); unsigned char* Wb = a->ws + WS_W; const float* mod = (const float*)(a->ws + WS_MOD) + (size_t)layer * 9 * 6144; (void)H; (void)MIX; (void)P; (void)X; (void)mod; pg8::Gemm g{(const bf16*)(a->ws + WS_CQN), (const bf16*)(Wb + W_UQ), MT, 768, 384, 384}; pg8::StaticOrder S; S.init(MT, 768, G, bx);
                       pg8::EpiBf16<0> E{(bf16*)((unsigned char*)a->out + OUT_Q), 768, nullptr, 0, 0, 1.f};
                       pg8::gemm_phase<pg8::EpiBf16<0>, pg8::StaticOrder, true, true>(lds, g, S, E); }
                     { unsigned char* Wb = a->ws + WS_W; pg8::Gemm g{(const bf16*)(a->ws + WS_CKVN), (const bf16*)(Wb + W_UKV), MT, 1024, 256, 256}; pg8::StaticOrder S; S.init(MT, 1024, G, bx);
                       pg8::EpiBf16<0> E{(bf16*)((unsigned char*)a->out + OUT_KV), 1024, nullptr, 0, 0, 1.f};
                       pg8::gemm_phase<pg8::EpiBf16<0>, pg8::StaticOrder, true, true>(lds, g, S, E); }
                     for (int it = bx; it < 192; it += G) scan_item<128, true, 0>(a, layer, it & 63, it >> 6, lds);
            PH_ENDT(4)
        } else { ++ph; }
#else
        ++ph;
#endif
        if (!even) {
        PH_BEGIN for (int it = bx; it < 192; it += G) scan_item<64, false, 0>(a, layer, it & 63, it >> 6, lds); PH_ENDT(5)
        } else { ++ph; }
#ifdef PROBE_MIX2
        PH_BEGIN phase_mixer(a, layer + 8, lds_raw); grid.sync(); PH_ENDT(6)
        --ph;
#endif
        PH_BEGIN phase_mixer(a, layer, lds_raw); PH_ENDT(6 + 7 * (layer & 1))
        PH_BEGIN phase_readout(a, layer); PH_ENDT(7)
#ifndef SKIP_G6
        PH_BEGIN { bf16* H = (bf16*)(a->ws + WS_H); bf16* MIX = (bf16*)(a->ws + WS_MIX); bf16* P = (bf16*)(a->ws + WS_P); float* X = (float*)(a->ws + WS_X); unsigned char* Wb = a->ws + WS_W; const float* mod = (const float*)(a->ws + WS_MOD) + (size_t)layer * 9 * 6144; (void)H; (void)MIX; (void)P; (void)X; (void)mod; pg8::Gemm g{MIX, (const bf16*)(Wb + W_OUT), MT, 1024, 1024, 1024}; pg8::StaticOrder S; S.init(NB * NLAT, 1024, G, bx, 1);
                   pg8::EpiResid E{X, mod, 2048, layer == 0 ? a->in[0] : nullptr};
                   pg8::gemm_phase<pg8::EpiResid, pg8::StaticOrder, true, true>(lds, g, S, E);
                   if (layer < 3) { pg8::Gemm g2{MIX, (const bf16*)(Wb + W_OUT), MT, 1024, 512, 1024}; pg8::CtxSplitOrder S2{G, bx, 512};
                       pg8::EpiResidSplit E2{X, (float*)(a->ws + WS_T), mod, 2048, layer == 0 ? a->in[2] : nullptr};
                       pg8::gemm_phase<pg8::EpiResidSplit, pg8::CtxSplitOrder, true, true>(lds, g2, S2, E2); } } PH_ENDT(8)
#else
        ++ph;
#endif
        PH_BEGIN phase_norm(a, layer, 1, layer < 3); PH_ENDT(9)
#ifndef SKIP_G8
        PH_BEGIN { bf16* H = (bf16*)(a->ws + WS_H); bf16* MIX = (bf16*)(a->ws + WS_MIX); bf16* P = (bf16*)(a->ws + WS_P); float* X = (float*)(a->ws + WS_X); unsigned char* Wb = a->ws + WS_W; const float* mod = (const float*)(a->ws + WS_MOD) + (size_t)layer * 9 * 6144; (void)H; (void)MIX; (void)P; (void)X; (void)mod; pg8::Gemm g{H, (const bf16*)(Wb + W_GU), MT, 2 * FF, 1024, 1024}; pg8::StaticOrder S; if (layer < 3) S.init(MT, 2 * FF, G, bx); else S.init(NB * NLAT, 2 * FF, G, bx, 1);
                   pg8::EpiSwiGLU E{P, FF};
                   pg8::gemm_phase<pg8::EpiSwiGLU, pg8::StaticOrder, true, true>(lds, g, S, E); } PH_ENDT(10)
#else
        ++ph;
#endif
#ifndef SKIP_G9
        PH_BEGIN { bf16* H = (bf16*)(a->ws + WS_H); bf16* MIX = (bf16*)(a->ws + WS_MIX); bf16* P = (bf16*)(a->ws + WS_P); float* X = (float*)(a->ws + WS_X); unsigned char* Wb = a->ws + WS_W; const float* mod = (const float*)(a->ws + WS_MOD) + (size_t)layer * 9 * 6144; (void)H; (void)MIX; (void)P; (void)X; (void)mod; pg8::Gemm g{P, (const bf16*)(Wb + W_DN), MT, 1024, FF, FF}; pg8::StaticOrder S; S.init(NB * NLAT, 1024, G, bx, 1);
                   pg8::EpiResid E{X, mod, 5120, nullptr};
                   pg8::gemm_phase<pg8::EpiResid, pg8::StaticOrder, true, true>(lds, g, S, E);
                   if (layer < 3) { pg8::Gemm g2{P, (const bf16*)(Wb + W_DN), MT, 1024, FF / 2, FF}; pg8::CtxSplitOrder S2{G, bx, FF / 2};
                       pg8::EpiResidSplit E2{X, (float*)(a->ws + WS_T), mod, 5120, nullptr};
                       pg8::gemm_phase<pg8::EpiResidSplit, pg8::CtxSplitOrder, true, true>(lds, g2, S2, E2); } } PH_ENDT(11)
#else
        ++ph;
#endif
    }
    PH_BEGIN phase_final(a); PH_ENDT(12)
#undef PH_BEGIN
#undef PH_ENDT
#ifdef PROBE_ITEM
    pr_acc += ((volatile LAS unsigned long long*)(lds + LDS_MAIN + 128))[PROBE_ITEM - 1];
#endif
#ifdef PROBE_MASK
    if (blockIdx.x == 0) { const unsigned long long t0_ = __builtin_amdgcn_s_memrealtime(); while (__builtin_amdgcn_s_memrealtime() - t0_ < pr_acc) __builtin_amdgcn_s_sleep(8); }
#endif
}
constexpr int NPH = 1 + 4 * 11 + 1;

extern "C" void kernel_launch(void* const* d_in, const int* in_sizes, int n_in, void* d_out, int out_size, void* d_ws, size_t ws_size, hipStream_t stream) {
    static int grid = 0;
    if (grid == 0) {
        if (n_in != 23 || ws_size < WS_END || out_size != NB * NLAT * DM) { fprintf(stderr, "kernel_launch: unexpected shapes: n_in %d ws %zu (need %zu) out %d\n", n_in, ws_size, (size_t)WS_END, out_size); grid = -1; return; }
        int dev = 0, cus = 0, per_cu = 0;
        hipGetDevice(&dev); hipDeviceGetAttribute(&cus, hipDeviceAttributeMultiprocessorCount, dev);
        if (hipFuncSetAttribute((const void*)mega_fwd, hipFuncAttributeMaxDynamicSharedMemorySize, LDS_BYTES) != hipSuccess) { fprintf(stderr, "kernel_launch: hipFuncSetAttribute failed\n"); grid = -1; return; }
        if (hipOccupancyMaxActiveBlocksPerMultiprocessor(&per_cu, (const void*)mega_fwd, 512, LDS_BYTES) != hipSuccess || per_cu < 1) { fprintf(stderr, "kernel_launch: occupancy query says %d\n", per_cu); per_cu = 1; }
        (void)hipGetLastError();
        grid = cus;
    }
    if (grid < 0) return;
    Args a{};
    for (int i = 0; i < 23; ++i) a.in[i] = (const float*)d_in[i];
    a.out = (float*)d_out; a.ws = (unsigned char*)d_ws; a.lo = 0; a.hi = NPH;
    void* kargv[] = {&a};
    hipError_t e = hipLaunchCooperativeKernel((const void*)mega_fwd, dim3(grid), dim3(512), kargv, LDS_BYTES, stream);
    if (e != hipSuccess) fprintf(stderr, "kernel_launch: cooperative launch failed: %s (grid %d)\n", hipGetErrorString(e), grid);
}
```

```cpp
#include <hip/hip_runtime.h>
#include <hip/hip_cooperative_groups.h>
#include <cstdio>
#include <cstdint>
namespace cg = cooperative_groups;
#define otid() ({ int t_ = (int)threadIdx.x; asm volatile("" : "+v"(t_)); t_; })
extern __shared__ __attribute__((aligned(16))) unsigned char g_lds_dyn[];
#define ptid() (*(volatile __attribute__((address_space(3))) int*)((__attribute__((address_space(3))) unsigned char*)g_lds_dyn + 131072 + 1024 + 4 * (int)threadIdx.x))
namespace pg8 {
#define PG8_LAS __attribute__((address_space(3)))
typedef unsigned short bf16_t;
typedef short bf16x8 __attribute__((ext_vector_type(8)));
typedef float f32x4 __attribute__((ext_vector_type(4)));
typedef unsigned u32x4 __attribute__((ext_vector_type(4)));
constexpr int BM = 256, BK = 64, HALF = 128, HTB = HALF * BK * 2  , STAGE_BYTES = 8 * HTB, NXCD = 8, WGM = 8;

__host__ __device__ __forceinline__ int lds_byte(int r, int c) { const int st = (r >> 4) * 2 + (c >> 5), rr = r & 15, cc = c & 31, ob = rr * 64 + cc * 2; return st * 1024 + (ob ^ (((ob >> 9) & 1) << 5)); }
__host__ __device__ __forceinline__ void stage_rc(int b, int& R, int& C) { const int st = b / 1024, sb = b % 1024, swz = sb ^ (((sb >> 9) & 1) << 5); R = (st >> 1) * 16 + swz / 64; C = (st & 1) * 32 + (swz % 64) / 2; }
__host__ __device__ __forceinline__ int perm32(int rho) { const int n = rho >> 4, i = rho & 15; return 8 * (i >> 2) + 4 * n + (i & 3); }

struct Unit { int pm, pn, koff; };
struct Gemm { const bf16_t* A; const bf16_t* Bt; int M, N, K, ld; };

struct StaticOrder {
    int nM, nN, nwg, G, c, mode;
    __host__ __device__ void init(int M, int N, int G_, int c_, int mode_ = 0) { nM = M / BM; nN = N / BM; nwg = nM * nN; G = G_; c = c_; mode = mode_; }
    __host__ __device__ bool next(int i, Unit& u) const {
        const long L = (long)i * G + c; if (L >= nwg) return false;
        int wgid = (int)L; { const int q = nwg / NXCD, r = nwg % NXCD, xcd = wgid % NXCD, off = wgid / NXCD; wgid = (xcd < r ? xcd * (q + 1) : r * (q + 1) + (xcd - r) * q) + off; }
        const int nig = WGM * nN, gid = wgid / nig, fm = gid * WGM, gsz = (nM - fm) < WGM ? (nM - fm) : WGM;
        u.pm = fm + ((wgid % nig) % gsz); u.pn = (wgid % nig) / gsz; u.koff = 0; if (mode == 1) u.pm = (u.pm >> 3) * 9 + 1 + (u.pm & 7); return true;
    }
    __device__ __forceinline__ void a_ready(const Unit&) const {}
    __device__ __forceinline__ void done(const Unit&) const {}
};
struct CtxSplitOrder {
    int G, c, khalf;
    __device__ bool next(int i, Unit& u) const { const int L = i * G + c; if (L >= 64) return false; u.koff = (L & 1) * khalf; u.pn = (L >> 1) & 3; u.pm = (L >> 3) * 9; return true; }
    __device__ __forceinline__ void a_ready(const Unit&) const {}
    __device__ __forceinline__ void done(const Unit&) const {}
};

__device__ __forceinline__ unsigned cvt_pk_bf16(float lo, float hi) { unsigned r; asm volatile("v_cvt_pk_bf16_f32 %0, %1, %2" : "=v"(r) : "v"(lo), "v"(hi)); return r; }
typedef float f32x2 __attribute__((ext_vector_type(2)));
__device__ __forceinline__ f32x2 gelu_pk(f32x2 v) {
    const f32x2 av = __builtin_elementwise_abs(v), d = av * 0.2316418882f + 1.0f;
    f32x2 t; t.x = __builtin_amdgcn_rcpf(d.x); t.y = __builtin_amdgcn_rcpf(d.y);
    f32x2 q = t * 0.5307027145f + (-0.7265760135f); q = q * t + 0.7107068705f; q = q * t + (-0.142248368f); q = q * t + 0.127414796f; q = q * t;
    const f32x2 s = (v * v) * (-0.72134752044f);
    f32x2 e; e.x = __builtin_amdgcn_exp2f(s.x); e.y = __builtin_amdgcn_exp2f(s.y);
    const f32x2 m = v * (q * e), r = v - m;
    f32x2 o; o.x = v.x < 0.f ? m.x : r.x; o.y = v.y < 0.f ? m.y : r.y; return o;
}

template <int ACT  > struct EpiBf16 {
    static constexpr bool PERM = true, AFTER_DRAIN = false; static_assert(ACT == 0 || ACT == 1, "EpiBf16: ACT is 0 (none) or 1 (gelu_pk)");
    bf16_t* O; int ldc; const float* bias; int split_cols; size_t split_stride; float scale0;
    __device__ __forceinline__ void operator()(const f32x4 (&acc)[2][2][4][2], const Unit& u, int wr, int wc, int fr, int fq) const {
        const int row0 = u.pm * BM + wr * 64 + fr; int colt = u.pn * BM; bf16_t* base = O;
        float sc = 1.f; if (split_cols) { const int t = colt / split_cols; base += (size_t)t * split_stride; colt -= t * split_cols; if (t == 0) sc = scale0; }
        const int col0 = colt + wc * 32 + 8 * fq, bcol0 = u.pn * BM + wc * 32 + 8 * fq;
        f32x4 bv[2][2];
#pragma unroll
        for (int bj = 0; bj < 2; ++bj)
#pragma unroll
            for (int n = 0; n < 2; ++n) bv[bj][n] = bias ? *(const f32x4*)(bias + bcol0 + bj * HALF + 4 * n) : (f32x4){0.f, 0.f, 0.f, 0.f};
#pragma unroll
        for (int ai = 0; ai < 2; ++ai)
#pragma unroll
            for (int m = 0; m < 4; ++m) { bf16_t* rowp = base + (size_t)(row0 + ai * HALF + m * 16) * ldc + col0;
#pragma unroll
                for (int bj = 0; bj < 2; ++bj) { f32x4 v0 = acc[ai][bj][m][0] + bv[bj][0], v1 = acc[ai][bj][m][1] + bv[bj][1];
                    if (ACT == 1) { f32x2 a = gelu_pk((f32x2){v0[0], v0[1]}), b = gelu_pk((f32x2){v0[2], v0[3]}), c = gelu_pk((f32x2){v1[0], v1[1]}), d = gelu_pk((f32x2){v1[2], v1[3]});
                        v0 = (f32x4){a.x, a.y, b.x, b.y}; v1 = (f32x4){c.x, c.y, d.x, d.y}; }
                    v0 = v0 * sc; v1 = v1 * sc; u32x4 w; w.x = cvt_pk_bf16(v0[0], v0[1]); w.y = cvt_pk_bf16(v0[2], v0[3]); w.z = cvt_pk_bf16(v1[0], v1[1]); w.w = cvt_pk_bf16(v1[2], v1[3]);
                    *(u32x4*)(rowp + bj * HALF) = w; } }
    }
};
struct EpiResidSplit {
    static constexpr bool PERM = false, AFTER_DRAIN = false;
    bf16_t* X; float* T; const float* mod; int goff; const float* cin;
    __device__ __forceinline__ void operator()(const f32x4 (&acc)[2][2][4][2], const Unit& u, int wr, int wc, int fr, int fq) const {
        typedef unsigned u32x2_t __attribute__((ext_vector_type(2)));
        const float* gp = mod + 8 * 6144 + goff;
        const int col0 = u.pn * BM + wc * 32 + 4 * fq;
        const bool first = (u.koff == 0);
        bf16_t* xb = X + (size_t)(u.pm * BM) * 1024; float* tb = T + (size_t)((u.pm / 9) * BM) * 1024;
        const float* rbase = cin ? cin + (size_t)((u.pm / 9) * BM) * 1024 : nullptr;
#pragma unroll
        for (int bj = 0; bj < 2; ++bj)
#pragma unroll
            for (int n = 0; n < 2; ++n) { const f32x4 gv = *(const f32x4*)(gp + col0 + bj * HALF + n * 16);
#pragma unroll
                for (int ai = 0; ai < 2; ++ai)
#pragma unroll
                    for (int m = 0; m < 4; ++m) { const size_t o = (size_t)(ai * HALF + wr * 64 + m * 16 + fr) * 1024 + col0 + bj * HALF + n * 16;
                        f32x4 v = gv * acc[ai][bj][m][n];
                        if (first) { f32x4 x;
                            if (rbase) x = *(const f32x4*)(rbase + o);
                            else { const u32x2_t w = *(const u32x2_t*)(xb + o); x = (f32x4){__uint_as_float(w.x << 16), __uint_as_float(w.x & 0xffff0000u), __uint_as_float(w.y << 16), __uint_as_float(w.y & 0xffff0000u)}; }
                            v = v + x; u32x2_t r; r.x = cvt_pk_bf16(v[0], v[1]); r.y = cvt_pk_bf16(v[2], v[3]); *(u32x2_t*)(xb + o) = r; }
                        else *(f32x4*)(tb + o) = v; } }
    }
};
struct EpiSwiGLU {
    static constexpr bool PERM = true, AFTER_DRAIN = false;
    bf16_t* O; int ldc;
    __device__ __forceinline__ void operator()(const f32x4 (&acc)[2][2][4][2], const Unit& u, int wr, int wc, int fr, int fq) const {
        const int row0 = u.pm * BM + wr * 64 + fr; const int col0 = u.pn * HALF + wc * 32 + 8 * fq;
#pragma unroll
        for (int ai = 0; ai < 2; ++ai)
#pragma unroll
            for (int m = 0; m < 4; ++m) { bf16_t* rowp = O + (size_t)(row0 + ai * HALF + m * 16) * ldc + col0;
                float h[8];
#pragma unroll
                for (int n = 0; n < 2; ++n)
#pragma unroll
                    for (int i = 0; i < 4; ++i) { const float g = acc[ai][0][m][n][i], up = acc[ai][1][m][n][i];
                        h[n * 4 + i] = g * __builtin_amdgcn_rcpf(1.0f + __expf(-g)) * up; }
                u32x4 w; w.x = cvt_pk_bf16(h[0], h[1]); w.y = cvt_pk_bf16(h[2], h[3]); w.z = cvt_pk_bf16(h[4], h[5]); w.w = cvt_pk_bf16(h[6], h[7]);
                *(u32x4*)rowp = w; }
    }
};
struct EpiResid {
    static constexpr bool PERM = false, AFTER_DRAIN = false;
    bf16_t* X; const float* mod; int goff; const float* xin;
    __device__ __forceinline__ void operator()(const f32x4 (&acc)[2][2][4][2], const Unit& u, int wr, int wc, int fr, int fq) const {
        typedef unsigned u32x2_t __attribute__((ext_vector_type(2)));
        const int widx = (u.pm % 9 == 0) ? 8 : (u.pm / 9);
        const float* gp = mod + widx * 6144 + goff;
        const int col0 = u.pn * BM + wc * 32 + 4 * fq;
        const float* rb = xin ? xin + (size_t)((u.pm / 9) * 2048 + (u.pm % 9 - 1) * 256) * 1024 : nullptr;
        bf16_t* wb = X + (size_t)(u.pm * BM) * 1024;
#pragma unroll
        for (int bj = 0; bj < 2; ++bj)
#pragma unroll
            for (int n = 0; n < 2; ++n) { const f32x4 gv = *(const f32x4*)(gp + col0 + bj * HALF + n * 16);
#pragma unroll
                for (int ai = 0; ai < 2; ++ai)
#pragma unroll
                    for (int m = 0; m < 4; ++m) { const size_t o = (size_t)(ai * HALF + wr * 64 + m * 16 + fr) * 1024 + col0 + bj * HALF + n * 16;
                        f32x4 x;
                        if (rb) x = *(const f32x4*)(rb + o);
                        else { const u32x2_t w = *(const u32x2_t*)(wb + o); x = (f32x4){__uint_as_float(w.x << 16), __uint_as_float(w.x & 0xffff0000u), __uint_as_float(w.y << 16), __uint_as_float(w.y & 0xffff0000u)}; }
                        x = x + gv * acc[ai][bj][m][n];
                        u32x2_t r; r.x = cvt_pk_bf16(x[0], x[1]); r.y = cvt_pk_bf16(x[2], x[3]); *(u32x2_t*)(wb + o) = r; } }
    }
};
template <class Epi, class Sched, bool ALIGN_EPI = false, bool SP2 = false>
__device__ __forceinline__ void gemm_phase(PG8_LAS unsigned char* lds, const Gemm g, const Sched& S, const Epi& E) {
    const int tid = otid(), wid = __builtin_amdgcn_readfirstlane(tid >> 6), lane = tid & 63, wr = wid >> 2, wc = wid & 3, fr = lane & 15, fq = lane >> 4;
    const int K = g.ld, nt = g.K / BK;
    unsigned voffA[2], voffB[2];
#pragma unroll
    for (int i = 0; i < 2; ++i) { int R, C; stage_rc(tid * 16 + i * 8192, R, C); const int Rb = Epi::PERM ? ((R & ~31) + perm32(R & 31)) : R;
        voffA[i] = (unsigned)(R * K + C) * 2u; voffB[i] = (unsigned)(Rb * K + C) * 2u; }
    const size_t kstep = (size_t)(BK * 2);
    const size_t hstep = (size_t)HALF * K * 2;
    const size_t tstep = 2 * hstep;
    const unsigned ldsw = (unsigned)wid * 1024u;
    const int aoff = lds_byte(wr * 64 + fr, fq * 8), boff = lds_byte(wc * 32 + fr, fq * 8);
#define PG8_SA(b, h) (((b) * 2 + (h)) * HTB)
#define PG8_SB(b, h) ((4 + (b) * 2 + (h)) * HTB)
#define PG8_STAGE(bufoff, gbase, voff) do { _Pragma("unroll") for (int _i = 0; _i < 2; ++_i) \
        __builtin_amdgcn_global_load_lds((const unsigned*)((const char*)(gbase) + (voff)[_i]), (PG8_LAS unsigned*)(lds + (bufoff) + ldsw + _i * 8192), 16, 0, 0); } while (0)
#define PG8_LDA(dst, b, h) do { _Pragma("unroll") for (int m = 0; m < 4; ++m) _Pragma("unroll") for (int k = 0; k < 2; ++k) dst[m][k] = *(const PG8_LAS bf16x8*)(lds + PG8_SA(b, h) + aoff + m * 2048 + k * 1024); } while (0)
#define PG8_LDB(dst, b, h) do { _Pragma("unroll") for (int n = 0; n < 2; ++n) _Pragma("unroll") for (int k = 0; k < 2; ++k) dst[n][k] = *(const PG8_LAS bf16x8*)(lds + PG8_SB(b, h) + boff + n * 2048 + k * 1024); } while (0)
#define PG8_MMA(ai, bj, At, Bt) do { __builtin_amdgcn_s_setprio(1); _Pragma("unroll") for (int m = 0; m < 4; ++m) _Pragma("unroll") for (int n = 0; n < 2; ++n) _Pragma("unroll") for (int k = 0; k < 2; ++k) \
        acc[ai][bj][m][n] = __builtin_amdgcn_mfma_f32_16x16x32_bf16(Bt[n][k], At[m][k], acc[ai][bj][m][n], 0, 0, 0); __builtin_amdgcn_s_setprio(0); } while (0)
#define PG8_WAIT_V(n) asm volatile("s_waitcnt vmcnt(" #n ")" ::: "memory")
#define PG8_WAIT_L(n) asm volatile("s_waitcnt lgkmcnt(" #n ")" ::: "memory")
#define PG8_BAR __builtin_amdgcn_s_barrier()
#define PG8_SCHED __builtin_amdgcn_sched_barrier(0)
    Unit cur, nxt; int ui = 0;
    if (!S.next(0, cur)) return;
    f32x4 acc[2][2][4][2];
#pragma unroll
    for (int a = 0; a < 2; ++a)
#pragma unroll
        for (int b = 0; b < 2; ++b)
#pragma unroll
            for (int m = 0; m < 4; ++m)
#pragma unroll
                for (int n = 0; n < 2; ++n) acc[a][b][m][n] = (f32x4){0.f, 0.f, 0.f, 0.f};
    bf16x8 At[4][2], B0[2][2], B1[2][2];
    const char* cA = (const char*)g.A + (size_t)cur.pm * tstep + (size_t)cur.koff * 2; const char* cB = (const char*)g.Bt + (size_t)cur.pn * tstep + (size_t)cur.koff * 2;
    S.a_ready(cur);
    if constexpr (SP2) {
        PG8_STAGE(PG8_SB(0, 0), cB, voffB); PG8_STAGE(PG8_SB(0, 1), cB + hstep, voffB); PG8_STAGE(PG8_SA(0, 0), cA, voffA); PG8_STAGE(PG8_SA(0, 1), cA + hstep, voffA);
        if (wr == 1) PG8_BAR;
        PG8_WAIT_V(2); PG8_BAR;
        PG8_STAGE(PG8_SB(1, 0), cB + kstep, voffB); PG8_STAGE(PG8_SA(1, 0), cA + kstep, voffA); PG8_STAGE(PG8_SB(1, 1), cB + hstep + kstep, voffB);
        PG8_WAIT_V(6); PG8_BAR;
    } else {
        PG8_STAGE(PG8_SB(0, 0), cB, voffB); PG8_STAGE(PG8_SA(0, 0), cA, voffA); PG8_STAGE(PG8_SB(0, 1), cB + hstep, voffB); PG8_STAGE(PG8_SA(0, 1), cA + hstep, voffA);
        if (wr == 1) PG8_BAR;
        PG8_WAIT_V(4); PG8_BAR;
        PG8_STAGE(PG8_SB(1, 0), cB + kstep, voffB); PG8_STAGE(PG8_SA(1, 0), cA + kstep, voffA); PG8_STAGE(PG8_SB(1, 1), cB + hstep + kstep, voffB);
        PG8_WAIT_V(6); PG8_BAR;
    }
    for (;;) {
        const bool has_next = S.next(ui + 1, nxt);
        const char* nA = has_next ? (const char*)g.A + (size_t)nxt.pm * tstep + (size_t)nxt.koff * 2 : cA; const char* nB = has_next ? (const char*)g.Bt + (size_t)nxt.pn * tstep + (size_t)nxt.koff * 2 : cB;
        for (int t = 0; t < nt; t += 2) {
            const bool last = (t == nt - 2);
            const char* a1 = cA + (size_t)(t + 1) * kstep;
            const char* a2 = last ? nA : cA + (size_t)(t + 2) * kstep; const char* b2 = last ? nB : cB + (size_t)(t + 2) * kstep;
            const char* a3 = a2 + kstep; const char* b3 = b2 + kstep;
            if (last && has_next) S.a_ready(nxt);
            if constexpr (SP2) {
            PG8_LDB(B0, 0, 0); PG8_LDB(B1, 0, 1); PG8_SCHED; PG8_LDA(At, 0, 0); PG8_STAGE(PG8_SA(1, 1), a1 + hstep, voffA);
            PG8_WAIT_V(8); PG8_WAIT_L(0); PG8_BAR; PG8_MMA(0, 0, At, B0); PG8_MMA(0, 1, At, B1); PG8_BAR; PG8_SCHED;
            PG8_LDA(At, 0, 1); PG8_STAGE(PG8_SB(0, 0), b2, voffB); PG8_STAGE(PG8_SB(0, 1), b2 + hstep, voffB); PG8_STAGE(PG8_SA(0, 0), a2, voffA);
            PG8_WAIT_V(8); PG8_WAIT_L(0); PG8_BAR; PG8_MMA(1, 0, At, B0); PG8_MMA(1, 1, At, B1); PG8_BAR; PG8_SCHED;
            PG8_LDB(B0, 1, 0); PG8_LDB(B1, 1, 1); PG8_SCHED; PG8_LDA(At, 1, 0); PG8_STAGE(PG8_SA(0, 1), a2 + hstep, voffA);
            PG8_WAIT_V(8); PG8_WAIT_L(0); PG8_BAR; PG8_MMA(0, 0, At, B0); PG8_MMA(0, 1, At, B1); PG8_BAR; PG8_SCHED;
            PG8_LDA(At, 1, 1); PG8_STAGE(PG8_SB(1, 0), b3, voffB); PG8_STAGE(PG8_SB(1, 1), b3 + hstep, voffB); PG8_STAGE(PG8_SA(1, 0), a3, voffA);
            PG8_WAIT_V(8); PG8_WAIT_L(0); PG8_BAR; PG8_MMA(1, 0, At, B0); PG8_MMA(1, 1, At, B1); PG8_BAR; PG8_SCHED;
            } else {
            PG8_LDB(B0, 0, 0); PG8_SCHED; PG8_LDA(At, 0, 0); PG8_STAGE(PG8_SA(1, 1), a1 + hstep, voffA);
            PG8_WAIT_L(8); PG8_BAR; PG8_WAIT_L(0); PG8_MMA(0, 0, At, B0); PG8_BAR; PG8_SCHED;
            PG8_LDB(B1, 0, 1); PG8_STAGE(PG8_SB(0, 0), b2, voffB);
            PG8_BAR; PG8_WAIT_L(0); PG8_MMA(0, 1, At, B1); PG8_BAR;
            PG8_LDA(At, 0, 1); PG8_STAGE(PG8_SA(0, 0), a2, voffA);
            PG8_BAR; PG8_WAIT_L(0); PG8_MMA(1, 0, At, B0); PG8_BAR; PG8_SCHED;
            PG8_STAGE(PG8_SB(0, 1), b2 + hstep, voffB);
            PG8_WAIT_V(6); PG8_BAR; PG8_MMA(1, 1, At, B1); PG8_BAR;
            PG8_LDB(B0, 1, 0); PG8_SCHED; PG8_LDA(At, 1, 0); PG8_STAGE(PG8_SA(0, 1), a2 + hstep, voffA);
            PG8_WAIT_L(8); PG8_BAR; PG8_WAIT_L(0); PG8_MMA(0, 0, At, B0); PG8_BAR; PG8_SCHED;
            PG8_LDB(B1, 1, 1); PG8_STAGE(PG8_SB(1, 0), b3, voffB);
            PG8_BAR; PG8_WAIT_L(0); PG8_MMA(0, 1, At, B1); PG8_BAR;
            PG8_LDA(At, 1, 1); PG8_STAGE(PG8_SA(1, 0), a3, voffA);
            PG8_BAR; PG8_WAIT_L(0); PG8_MMA(1, 0, At, B0); PG8_BAR; PG8_SCHED;
            PG8_STAGE(PG8_SB(1, 1), b3 + hstep, voffB);
            PG8_WAIT_V(6); PG8_BAR; PG8_MMA(1, 1, At, B1); PG8_BAR;
            }
        }
        if constexpr (ALIGN_EPI) { if (wr == 0) PG8_BAR; }
        if constexpr (!Epi::AFTER_DRAIN) { E(acc, cur, wr, wc, fr, fq); S.done(cur); }
        if (!has_next) break;
#pragma unroll
        for (int a = 0; a < 2; ++a)
#pragma unroll
            for (int b = 0; b < 2; ++b)
#pragma unroll
                for (int m = 0; m < 4; ++m)
#pragma unroll
                    for (int n = 0; n < 2; ++n) acc[a][b][m][n] = (f32x4){0.f, 0.f, 0.f, 0.f};
        cur = nxt; cA = nA; cB = nB; ++ui;
        if constexpr (ALIGN_EPI) { if (wr == 1) PG8_BAR; }
    }
    PG8_WAIT_V(0);
    if constexpr (!ALIGN_EPI) { if (wr == 0) PG8_BAR; }
    PG8_BAR;
    if constexpr (Epi::AFTER_DRAIN) { E.fused(acc, cur, wr, wc, fr, fq, lds, wid, lane); S.done(cur); }
#undef PG8_SA
#undef PG8_SB
#undef PG8_STAGE
#undef PG8_LDA
#undef PG8_LDB
#undef PG8_MMA
#undef PG8_WAIT_V
#undef PG8_WAIT_L
#undef PG8_BAR
#undef PG8_SCHED
}
}

typedef unsigned short bf16;
typedef short bf16x8 __attribute__((ext_vector_type(8)));
typedef short s16x4 __attribute__((ext_vector_type(4)));
typedef float f32x4 __attribute__((ext_vector_type(4)));
typedef float f32x16 __attribute__((ext_vector_type(16)));
typedef unsigned u32x4 __attribute__((ext_vector_type(4)));
typedef unsigned u32x2 __attribute__((ext_vector_type(2)));
#define LAS __attribute__((address_space(3)))

constexpr int NB = 8, TPB = 2304, MT = NB * TPB, DM = 1024, NLAT = 2048;
constexpr int NP_E = 3328, NP_O = 3072, FF = 2816;
constexpr float EPSN = 1e-6f;
constexpr size_t MiB = 1u << 20;
constexpr size_t WS_CTL = 0, WS_MOD = 1 * MiB, WS_X = 2 * MiB, WS_H = 74 * MiB, WS_MIX = 110 * MiB, WS_P = 146 * MiB, WS_W = 263 * MiB,
                 WS_OSC = 290 * MiB, WS_KR = 326 * MiB, WS_U = 328 * MiB, WS_T = 342 * MiB, WS_END = 350 * MiB;
constexpr size_t WS_LSUM = 128 * 1024;
constexpr size_t WS_CQN = WS_MIX, WS_CKVN = WS_MIX + 14 * MiB, WS_DSCR = WS_H;
constexpr size_t W_IN = 0, W_OUT = 13 * MiB / 2, W_GU = 17 * MiB / 2, W_DN = 39 * MiB / 2, W_UQ = 25 * MiB, W_UKV = 25 * MiB + 768 * 1024;
constexpr size_t OUT_KV = 0, OUT_Q = 36 * MiB;
constexpr int LDS_MAIN = 131072, LDS_BYTES = LDS_MAIN + 1024 + 2048;

struct Args { const float* in[23]; float* out; unsigned char* ws; int lo, hi; };
typedef __attribute__((address_space(4))) const Args* KArgP;
__device__ __forceinline__ KArgP kargs() { KArgP p = (KArgP)__builtin_amdgcn_kernarg_segment_ptr(); asm volatile("" : "+s"(p)); return p; }

__device__ __forceinline__ float bf2f(unsigned short h) { return __uint_as_float((unsigned)h << 16); }
__device__ __forceinline__ unsigned f2bf(float f) { unsigned u = __float_as_uint(f); return (u + 0x7fffu + ((u >> 16) & 1u)) >> 16; }
__device__ __forceinline__ unsigned pk2(float lo, float hi) { return f2bf(lo) | (f2bf(hi) << 16); }
__device__ __forceinline__ float wave_sum(float v) {
#pragma unroll
    for (int o = 1; o < 64; o <<= 1) v += __shfl_xor(v, o);
    return v;
}
__device__ __forceinline__ float silu_f(float g) { return g / (1.0f + __expf(-g)); }
__device__ __forceinline__ void sincos_r(float ang, float& s, float& c) {
    float r = ang * 0.15915494309189535f; r = r - __builtin_floorf(r);
    s = __builtin_amdgcn_sinf(r); c = __builtin_amdgcn_cosf(r);
}
__device__ __forceinline__ float inv_freq(int i, int half) { return __builtin_amdgcn_exp2f(-(float)i / (float)half * 13.287712379549449f); }

__device__ __forceinline__ void mod_item(KArgP a, int l, int cg, LAS unsigned char* lds) {
    const int tid = otid();
    float* MOD = (float*)(a->ws + WS_MOD);
    LAS float* S = (LAS float*)lds;
    LAS float* R = S + 1024 * 12;
    for (int i = tid; i < 9 * 1024; i += 512) { const int w = i >> 10, k = i & 1023; const float v = (w < 8) ? a->in[1][w * 1024 + k] : a->in[3][k]; S[k * 12 + w] = silu_f(v); }
    __syncthreads();
    const int nl = tid & 63, kp = tid >> 6, n0 = cg * 256;
    f32x4 acc[9];
#pragma unroll
    for (int w = 0; w < 9; ++w) acc[w] = (f32x4){0.f, 0.f, 0.f, 0.f};
    const float* wp = a->in[4] + (size_t)l * 1024 * 6144 + n0 + 4 * nl;
#pragma unroll 8
    for (int k = kp * 128; k < kp * 128 + 128; ++k) {
        const f32x4 wv = *(const f32x4*)(wp + (size_t)k * 6144);
        const f32x4 s0 = *(const LAS f32x4*)(S + k * 12), s1 = *(const LAS f32x4*)(S + k * 12 + 4); const float s8 = S[k * 12 + 8];
        acc[0] += wv * s0[0]; acc[1] += wv * s0[1]; acc[2] += wv * s0[2]; acc[3] += wv * s0[3];
        acc[4] += wv * s1[0]; acc[5] += wv * s1[1]; acc[6] += wv * s1[2]; acc[7] += wv * s1[3]; acc[8] += wv * s8;
    }
#pragma unroll
    for (int w = 0; w < 9; ++w) *(LAS f32x4*)(R + (kp * 9 + w) * 256 + 4 * nl) = acc[w];
    __syncthreads();
    for (int i = tid; i < 9 * 256; i += 512) { const int w = i >> 8, n2 = i & 255; float v = a->in[5][l * 6144 + n0 + n2];
#pragma unroll
        for (int p = 0; p < 8; ++p) v += R[(p * 9 + w) * 256 + n2];
        MOD[(size_t)(l * 9 + w) * 6144 + n0 + n2] = v; }
    __syncthreads();
}
__device__ __forceinline__ void phase_prep(KArgP a, LAS unsigned char* lds) {
    const int tid = otid(), G = gridDim.x;
    if (blockIdx.x == 0) { if (tid < 64) ((unsigned*)(a->ws + WS_CTL))[tid] = 0u; for (int i = tid; i < 3456; i += 512) ((unsigned*)(a->ws + WS_CTL))[4096 + i] = 0u; }
    for (int item = blockIdx.x; item < 96; item += G) mod_item(a, item / 24, item % 24, lds);
}

__device__ __forceinline__ void transpose_item(const float* W, int K, int N, bf16* WT, int k0, int n0, int drow0, LAS float* scr, int lane) {
#pragma unroll 8
    for (int i = 0; i < 32; ++i) { const int kk = 2 * i + (lane >> 5); scr[kk * 33 + (lane & 31)] = W[(size_t)(k0 + kk) * N + n0 + (lane & 31)]; }
    asm volatile("s_waitcnt lgkmcnt(0)" ::: "memory");
    const int c = lane & 7;
#pragma unroll
    for (int j = 0; j < 4; ++j) { const int n = (lane >> 3) + 8 * j; const LAS float* s = scr + (8 * c) * 33 + n;
        u32x4 o; o.x = pk2(s[0 * 33], s[1 * 33]); o.y = pk2(s[2 * 33], s[3 * 33]); o.z = pk2(s[4 * 33], s[5 * 33]); o.w = pk2(s[6 * 33], s[7 * 33]);
        *(u32x4*)(WT + (size_t)(drow0 + n) * K + k0 + 8 * c) = o; }
    asm volatile("s_waitcnt lgkmcnt(0)" ::: "memory");
}
__device__ __forceinline__ void convert_weights(KArgP a, int layer, LAS unsigned char* lds) {
    const int lane = otid() & 63, wave = otid() >> 6;
    LAS float* scr = (LAS float*)(lds + wave * 8448);
    const int gw = blockIdx.x * 8 + wave, NGW = gridDim.x * 8;
    const bool even = !(layer & 1); const int e = layer >> 1;
    const int nin = even ? 3232 : 3072;
    const float* w_in = even ? a->in[11] + (size_t)e * 1024 * 3232 : a->in[18] + (size_t)e * 1024 * 3072;
    unsigned char* Wb = a->ws + WS_W;
    const int nbin = nin / 32;
    const int I_IN = 16 * nbin, I_OUT = 512, I_G = 16 * 88, I_D = 44 * 32, I_UQ = even ? 6 * 24 : 0, I_UKV = even ? 4 * 32 : 0;
    const int NIT = I_IN + I_OUT + 2 * I_G + I_D + I_UQ + I_UKV;
    for (int it = gw; it < NIT; it += NGW) {
        int r = it;
        if (r < I_IN) { const int kb = r / nbin, nb = r % nbin; transpose_item(w_in, 1024, nin, (bf16*)(Wb + W_IN), 64 * kb, 32 * nb, 32 * nb, scr, lane); continue; } r -= I_IN;
        if (r < I_OUT) { const int kb = r / 32, nb = r % 32; transpose_item(a->in[7] + (size_t)layer * 1024 * 1024, 1024, 1024, (bf16*)(Wb + W_OUT), 64 * kb, 32 * nb, 32 * nb, scr, lane); continue; } r -= I_OUT;
        if (r < I_G) { const int kb = r / 88, nb = r % 88, n0 = 32 * nb; transpose_item(a->in[8] + (size_t)layer * 1024 * FF, 1024, FF, (bf16*)(Wb + W_GU), 64 * kb, n0, (n0 >> 7) * 256 + (n0 & 127), scr, lane); continue; } r -= I_G;
        if (r < I_G) { const int kb = r / 88, nb = r % 88, n0 = 32 * nb; transpose_item(a->in[9] + (size_t)layer * 1024 * FF, 1024, FF, (bf16*)(Wb + W_GU), 64 * kb, n0, (n0 >> 7) * 256 + 128 + (n0 & 127), scr, lane); continue; } r -= I_G;
        if (r < I_D) { const int kb = r / 32, nb = r % 32; transpose_item(a->in[10] + (size_t)layer * FF * 1024, FF, 1024, (bf16*)(Wb + W_DN), 64 * kb, 32 * nb, 32 * nb, scr, lane); continue; } r -= I_D;
        if (r < I_UQ) { const int kb = r / 24, nb = r % 24; transpose_item(a->in[15] + (size_t)e * 384 * 768, 384, 768, (bf16*)(Wb + W_UQ), 64 * kb, 32 * nb, 32 * nb, scr, lane); continue; } r -= I_UQ;
        { const int kb = r / 32, nb = r % 32; transpose_item(a->in[17] + (size_t)e * 256 * 1024, 256, 1024, (bf16*)(Wb + W_UKV), 64 * kb, 32 * nb, 32 * nb, scr, lane); }
    }
}

__device__ __forceinline__ f32x4 ld4_bf16(const bf16* p) { const u32x2 w = *(const u32x2*)p; return (f32x4){__uint_as_float(w.x << 16), __uint_as_float(w.x & 0xffff0000u), __uint_as_float(w.y << 16), __uint_as_float(w.y & 0xffff0000u)}; }
__device__ __forceinline__ void phase_norm(KArgP a, int layer, int which, bool addT) {
    const int lane = otid() & 63, wave = otid() >> 6;
    const int gw = blockIdx.x * 8 + wave, NGW = gridDim.x * 8;
    bf16* X = (bf16*)(a->ws + WS_X); bf16* H = (bf16*)(a->ws + WS_H); const float* T = (const float*)(a->ws + WS_T);
    const float* g = a->in[6] + (layer * 2 + which) * 1024;
    const float* mod = (const float*)(a->ws + WS_MOD) + (size_t)layer * 9 * 6144;
    const int shoff = which ? 3072 : 0, scoff = which ? 4096 : 1024;
    const bool from_inputs = (layer == 0 && which == 0);
    constexpr int RB = 3;
    for (int r0 = gw; r0 < MT; r0 += RB * NGW) {
        f32x4 v[RB][4];
#pragma unroll
        for (int k = 0; k < RB; ++k) { const int row = r0 + k * NGW; if (row < MT) {
            if (from_inputs) { const int b = row / TPB, j = row - b * TPB; const f32x4* xr = (const f32x4*)(j < 256 ? a->in[2] + (size_t)(b * 256 + j) * 1024 : a->in[0] + (size_t)(b * NLAT + j - 256) * 1024) + lane;
#pragma unroll
                for (int q = 0; q < 4; ++q) v[k][q] = xr[64 * q]; }
            else {
#pragma unroll
                for (int q = 0; q < 4; ++q) v[k][q] = ld4_bf16(X + (size_t)row * 1024 + 4 * lane + 256 * q); } } }
#pragma unroll
        for (int k = 0; k < RB; ++k) { const int row = r0 + k * NGW; if (row < MT) {
            const int b = row / TPB, j = row - b * TPB, widx = (j < 256) ? 8 : b;
            if (addT && j < 256) { const f32x4* tr = (const f32x4*)(T + (size_t)(b * 256 + j) * 1024) + lane;
#pragma unroll
                for (int q = 0; q < 4; ++q) { v[k][q] = v[k][q] + tr[64 * q]; u32x2 w; w.x = pk2(v[k][q][0], v[k][q][1]); w.y = pk2(v[k][q][2], v[k][q][3]); *(u32x2*)(X + (size_t)row * 1024 + 4 * lane + 256 * q) = w; } }
            float ss = 0.f;
#pragma unroll
            for (int q = 0; q < 4; ++q) ss += (v[k][q][0] * v[k][q][0] + v[k][q][1] * v[k][q][1]) + (v[k][q][2] * v[k][q][2] + v[k][q][3] * v[k][q][3]);
            const float rstd = __builtin_amdgcn_rsqf(wave_sum(ss) * (1.f / 1024.f) + EPSN);
#pragma unroll
            for (int q = 0; q < 4; ++q) { const int col = 4 * lane + 256 * q;
                const f32x4 gv = *(const f32x4*)(g + col), sc = *(const f32x4*)(mod + widx * 6144 + scoff + col), sh = *(const f32x4*)(mod + widx * 6144 + shoff + col);
                f32x4 y = v[k][q] * rstd * gv * (sc + 1.0f) + sh;
                u32x2 w; w.x = pk2(y[0], y[1]); w.y = pk2(y[2], y[3]);
                *(u32x2*)(H + (size_t)row * 1024 + col) = w; } } }
    }
}

__device__ __forceinline__ void phase_post_even(KArgP a, int layer) {
    const int lane = otid() & 63, wave = otid() >> 6;
    const int gw = blockIdx.x * 8 + wave, NGW = gridDim.x * 8, e = layer >> 1;
    const bf16* P = (const bf16*)(a->ws + WS_P); bf16* CQN = (bf16*)(a->ws + WS_CQN); bf16* CKVN = (bf16*)(a->ws + WS_CKVN); bf16* KR = (bf16*)(a->ws + WS_KR);
    const float* qg = a->in[14] + e * 384; const float* kg = a->in[16] + e * 256;
    for (int row = gw; row < MT; row += NGW) {
        const int b = row / TPB, j = row - b * TPB;
        const bf16* pr = P + (size_t)row * NP_E;
        {   float x[6]; float ss = 0.f;
#pragma unroll
            for (int k = 0; k < 3; ++k) { const unsigned w = *(const unsigned*)(pr + 2560 + 2 * lane + 128 * k); x[2 * k] = bf2f((unsigned short)(w & 0xffff)); x[2 * k + 1] = bf2f((unsigned short)(w >> 16)); ss += x[2 * k] * x[2 * k] + x[2 * k + 1] * x[2 * k + 1]; }
            const float rstd = __builtin_amdgcn_rsqf(wave_sum(ss) * (1.f / 384.f) + EPSN);
#pragma unroll
            for (int k = 0; k < 3; ++k) { const int col = 2 * lane + 128 * k; *(unsigned*)(CQN + (size_t)row * 384 + col) = pk2(x[2 * k] * rstd * qg[col], x[2 * k + 1] * rstd * qg[col + 1]); } }
        {   float x[4]; float ss = 0.f;
#pragma unroll
            for (int k = 0; k < 2; ++k) { const unsigned w = *(const unsigned*)(pr + 2944 + 2 * lane + 128 * k); x[2 * k] = bf2f((unsigned short)(w & 0xffff)); x[2 * k + 1] = bf2f((unsigned short)(w >> 16)); ss += x[2 * k] * x[2 * k] + x[2 * k + 1] * x[2 * k + 1]; }
            const float rstd = __builtin_amdgcn_rsqf(wave_sum(ss) * (1.f / 256.f) + EPSN);
#pragma unroll
            for (int k = 0; k < 2; ++k) { const int col = 2 * lane + 128 * k; *(unsigned*)(CKVN + (size_t)row * 256 + col) = pk2(x[2 * k] * rstd * kg[col], x[2 * k + 1] * rstd * kg[col + 1]); } }
        {   const int d = lane & 31; const float x = bf2f(pr[3200 + d]); const float xp = __shfl_xor(x, 8);
            float o = x;
            if (j >= 256) { const int t = j - 256, blk = d >> 4, wi = d & 15, i8 = wi & 7; const float pos = (float)(blk ? (t & 63) : (t >> 6));
                float s, c; sincos_r(pos * inv_freq(i8, 8), s, c);
                o = (wi < 8) ? (x * c - xp * s) : (xp * s + x * c); }
            if (lane < 32) KR[(size_t)row * 32 + d] = (bf16)f2bf(o); }
    }
}
__device__ __forceinline__ void phase_post_odd(KArgP a, int layer) {
    const int lane = otid() & 63, wave = otid() >> 6;
    const int gw = blockIdx.x * 8 + wave, NGW = gridDim.x * 8;
    bf16* P = (bf16*)(a->ws + WS_P);
    for (int row = gw; row < MT; row += NGW) {
        const int b = row / TPB, j = row - b * TPB; const bool lat = j >= 256; const int t = j - 256;
        bf16* pr = P + (size_t)row * NP_O;
#pragma unroll
        for (int u = 0; u < 2; ++u) { const int pid = lane + 64 * u, h = pid >> 5, i = pid & 31, d1 = h * 64 + i, d2 = d1 + 32;
            float s = 0.f, c = 1.f; if (lat) sincos_r((float)t * inv_freq(i, 32), s, c);
            const float q1 = bf2f(pr[d1]), q2 = bf2f(pr[d2]), k1 = bf2f(pr[256 + d1]) * 0.125f, k2 = bf2f(pr[256 + d2]) * 0.125f;
            if (lat) { pr[d1] = (bf16)f2bf(q1 * c - q2 * s); pr[d2] = (bf16)f2bf(q1 * s + q2 * c); }
            pr[256 + d1] = (bf16)f2bf(k1 * c - k2 * s); pr[256 + d2] = (bf16)f2bf(k1 * s + k2 * c); }
        if (lat) {
#pragma unroll
            for (int u = 0; u < 4; ++u) { const int pid = lane + 64 * u, vec = pid >> 5, pp = pid & 31, blk = pp >> 4, i = pp & 15, d1 = vec * 64 + blk * 32 + i, d2 = d1 + 16;
                const float pos = (float)(blk ? (t & 63) : (t >> 6)); float s, c; sincos_r(pos * inv_freq(i, 16), s, c);
                const float q1 = bf2f(pr[1536 + d1]), q2 = bf2f(pr[1536 + d2]), k1 = bf2f(pr[2048 + d1]), k2 = bf2f(pr[2048 + d2]);
                pr[1536 + d1] = (bf16)f2bf(q1 * c - q2 * s); pr[1536 + d2] = (bf16)f2bf(q1 * s + q2 * c);
                pr[2048 + d1] = (bf16)f2bf(k1 * c - k2 * s); pr[2048 + d2] = (bf16)f2bf(k1 * s + k2 * c); } }
    }
}

__device__ __forceinline__ void phase_readout(KArgP a, int layer) {
    const int lane = otid() & 63, wave = otid() >> 6;
    const int gw = blockIdx.x * 8 + wave, NGW = gridDim.x * 8;
    const bool even = !(layer & 1); const int np = even ? NP_E : NP_O, gcol = even ? 2048 : 1024;
    const bf16* P = (const bf16*)(a->ws + WS_P); const bf16* OF = (const bf16*)(a->ws + WS_OSC); const bf16* OB = OF + (size_t)MT * 512;
    bf16* MIX = (bf16*)(a->ws + WS_MIX);
    float g0 = 1.f, g1 = 1.f; if (even) { g0 = a->in[13][(layer >> 1) * 128 + 2 * lane]; g1 = a->in[13][(layer >> 1) * 128 + 2 * lane + 1]; }
    constexpr int RB = 3;
    for (int r0 = gw; r0 < MT; r0 += RB * NGW) {
        unsigned wf[RB][4], wb[RB][4], wg[RB][4];
#pragma unroll
        for (int k = 0; k < RB; ++k) { const int row = r0 + k * NGW; if (row < MT) {
#pragma unroll
            for (int h = 0; h < 4; ++h) { const int col = h * 128 + 2 * lane;
                wf[k][h] = *(const unsigned*)(OF + (size_t)row * 512 + col); wb[k][h] = *(const unsigned*)(OB + (size_t)row * 512 + col); wg[k][h] = *(const unsigned*)(P + (size_t)row * np + gcol + col); } } }
#pragma unroll
        for (int k = 0; k < RB; ++k) { const int row = r0 + k * NGW; if (row < MT) {
#pragma unroll
            for (int h = 0; h < 4; ++h) { const int col = h * 128 + 2 * lane;
                const float o0 = bf2f((unsigned short)(wf[k][h] & 0xffff)) + bf2f((unsigned short)(wb[k][h] & 0xffff)), o1 = bf2f((unsigned short)(wf[k][h] >> 16)) + bf2f((unsigned short)(wb[k][h] >> 16));
                const float rstd = __builtin_amdgcn_rsqf(wave_sum(o0 * o0 + o1 * o1) * (1.f / 128.f) + EPSN);
                const float y0 = o0 * rstd * g0 * silu_f(bf2f((unsigned short)(wg[k][h] & 0xffff))), y1 = o1 * rstd * g1 * silu_f(bf2f((unsigned short)(wg[k][h] >> 16)));
                *(unsigned*)(MIX + (size_t)row * 1024 + col) = pk2(y0, y1); } } }
    }
}
__device__ __forceinline__ void phase_final(KArgP a) {
    const int lane = otid() & 63, wave = otid() >> 6;
    const int gw = blockIdx.x * 8 + wave, NGW = gridDim.x * 8;
    const bf16* X = (const bf16*)(a->ws + WS_X); const float* g = a->in[22];
    constexpr int RB = 4;
    for (int r0 = gw; r0 < NB * NLAT; r0 += RB * NGW) {
        f32x4 v[RB][4];
#pragma unroll
        for (int k = 0; k < RB; ++k) { const int r = r0 + k * NGW; if (r < NB * NLAT) { const int row = (r >> 11) * TPB + 256 + (r & 2047);
#pragma unroll
            for (int q = 0; q < 4; ++q) v[k][q] = ld4_bf16(X + (size_t)row * 1024 + 4 * lane + 256 * q); } }
#pragma unroll
        for (int k = 0; k < RB; ++k) { const int r = r0 + k * NGW; if (r < NB * NLAT) { float ss = 0.f;
#pragma unroll
            for (int q = 0; q < 4; ++q) ss += (v[k][q][0] * v[k][q][0] + v[k][q][1] * v[k][q][1]) + (v[k][q][2] * v[k][q][2] + v[k][q][3] * v[k][q][3]);
            const float rstd = __builtin_amdgcn_rsqf(wave_sum(ss) * (1.f / 1024.f) + EPSN);
#pragma unroll
            for (int q = 0; q < 4; ++q) { const int col = 4 * lane + 256 * q; const f32x4 gv = *(const f32x4*)(g + col);
                *(f32x4*)(a->out + (size_t)r * 1024 + col) = v[k][q] * rstd * gv; } } }
    }
}
__device__ __forceinline__ unsigned cvtpk2(float lo, float hi) { unsigned r; asm("v_cvt_pk_bf16_f32 %0, %1, %2" : "=v"(r) : "v"(lo), "v"(hi)); return r; }
__device__ __forceinline__ f32x4 mfma16(bf16x8 a, bf16x8 b, f32x4 c) { return __builtin_amdgcn_mfma_f32_16x16x32_bf16(a, b, c, 0, 0, 0); }

template <int DK, bool HG, int MODE>
__device__ __forceinline__ void scan_item(KArgP a, int layer, int item, int seg, LAS unsigned char* lds) {
    const int tid = otid(), wid = tid >> 6, lane = tid & 63, l15 = lane & 15, q4 = lane >> 4;
    const int h = item & 3, dir = (item >> 2) & 1, b = item >> 3;
    constexpr int TPT = DK / 8, QS = DK * 2 + 16, TS = 144;
    constexpr int NP = HG ? NP_E : NP_O;
    LAS unsigned char* Lqt = lds; LAS unsigned char* Lkt = Lqt + 64 * QS; LAS unsigned char* Lqh = Lkt + 64 * QS;
    LAS unsigned char* LkhT = Lqh + 64 * QS; LAS unsigned char* LvT = LkhT + DK * TS; LAS unsigned char* Latt = LvT + 128 * TS;
    LAS float* Ltot = (LAS float*)(Latt + 64 * TS); LAS float* Lbl = Ltot + 512;
    const bf16* P = (const bf16*)(a->ws + WS_P);
    bf16* OSC = (bf16*)(a->ws + WS_OSC) + (size_t)dir * MT * 512;
    f32x4* Ub = (f32x4*)(a->ws + WS_U); float* Lb = (float*)(a->ws + WS_LSUM);
    const int c = tid & (DK - 1), tq = tid / DK;
    float lb = 0.f, lg = 0.f, qscale = 1.f; int qcol, zcol;
    if (HG) { qscale = 0.08838834764831845f; qcol = h * 128 + c; zcol = (dir ? 1536 : 1024) + h * 128 + c;
        if (layer >= 2) { const float l0 = a->in[12][(0 * 2 + dir) * 512 + h * 128 + c], l1 = a->in[12][(1 * 2 + dir) * 512 + h * 128 + c]; lb = 1.f / (1.f + __expf(l0 - l1)); } }
    else { qcol = h * 64 + c; zcol = 256 + h * 64 + c; const float x = a->in[19][((layer >> 1) * 2 + dir) * 4 + h]; lg = -__logf(1.f + __expf(-x)); }
    const int vcol = 512 + h * 128;
    const int rowbase = b * TPB;
    const int tv = lane, c8v = wid;
    unsigned short rq[TPT], rz[TPT]; bf16x8 rv[2];
#define SC_JB(ci) (dir ? ((ci) < 4 ? 255 - 64 * (ci) : 2303 - 64 * ((ci) - 4)) : 64 * (ci))
#define SC_LOAD(ci) do { const int jb_ = SC_JB(ci), sg_ = dir ? -1 : 1; \
        _Pragma("unroll") for (int i = 0; i < TPT; ++i) { const bf16* pr_ = P + (size_t)(rowbase + jb_ + sg_ * (tq * TPT + i)) * NP; if (MODE) rq[i] = pr_[qcol]; rz[i] = pr_[zcol]; } \
        { const bf16* pv_ = P + (size_t)(rowbase + jb_ + sg_ * tv) * NP + vcol; rv[0] = *(const bf16x8*)(pv_ + c8v * 8); rv[1] = *(const bf16x8*)(pv_ + (c8v + 8) * 8); } } while (0)
    f32x4 Sacc[DK / 16];
#pragma unroll
    for (int i = 0; i < DK / 16; ++i) Sacc[i] = (f32x4){0.f, 0.f, 0.f, 0.f};
    const int c0 = 9 * seg;
    SC_LOAD(c0);
    if (MODE) {
        for (int s_ = 0; s_ < seg; ++s_) {
#pragma unroll
            for (int i = 0; i < DK / 16; ++i) { f32x4 v = Sacc[i];
                if (s_ > 0) { const f32x4 l4 = *(const f32x4*)(Lb + (size_t)(item * 3 + s_) * 128 + 16 * i + 4 * q4); v[0] *= __expf(l4[0]); v[1] *= __expf(l4[1]); v[2] *= __expf(l4[2]); v[3] *= __expf(l4[3]); }
                Sacc[i] = v + Ub[((size_t)(item * 3 + s_) * (DK / 16) + i) * 512 + tid]; }
        }
    }
    float lsum = 0.f;
    for (int ci = c0; ci < c0 + 9; ++ci) {
#pragma unroll
        for (int u = 0; u < 2; ++u)
#pragma unroll
            for (int e = 0; e < 8; ++e) *(LAS unsigned short*)(LvT + ((c8v + 8 * u) * 8 + e) * TS + tv * 2) = (unsigned short)rv[u][e];
        float zf[TPT], qf[TPT];
#pragma unroll
        for (int i = 0; i < TPT; ++i) { zf[i] = bf2f(rz[i]); if (MODE) qf[i] = bf2f(rq[i]) * qscale; }
        const int jb = SC_JB(ci), sg = dir ? -1 : 1;
        if (ci + 1 < c0 + 9) SC_LOAD(ci + 1);
        float kk_[TPT], e1v[TPT], e2v[TPT]; float Eref, Ebr, dlast;
        if (HG) {
            float fv[TPT];
#pragma unroll
            for (int i = 0; i < TPT; ++i) { const float z = fminf(fmaxf(zf[i], -30.f), 30.f);
                const float t = __expf(-fabsf(z)), r = __builtin_amdgcn_rcpf(1.f + t), tr = t * r;
                const float sig = z >= 0.f ? r : tr, sigm = z >= 0.f ? tr : r;
                kk_[i] = (1.f - lb) * sigm; fv[i] = lb + (1.f - lb) * sig; }
            float run = 1.f;
            if (tq < 2) {
#pragma unroll
                for (int i = TPT - 1; i >= 0; --i) { e2v[i] = run; run *= fv[i]; }
            } else {
#pragma unroll
                for (int i = 0; i < TPT; ++i) { run *= fv[i]; e1v[i] = run; }
            }
            Ltot[tq * 128 + c] = run;
            __syncthreads();
            const float t0 = Ltot[c], t1 = Ltot[128 + c], t2 = Ltot[256 + c], t3 = Ltot[384 + c];
            Eref = t0 * t1; Ebr = t2 * t3; dlast = Eref * Ebr;
            const float mul = (tq == 0) ? t1 : ((tq == 3) ? t2 : 1.f);
            if (tq < 2) {
#pragma unroll
                for (int i = 0; i < TPT; ++i) { e2v[i] = fmaxf(e2v[i] * mul, 1e-30f); if (MODE) e1v[i] = __builtin_amdgcn_rcpf(e2v[i]); }
            } else {
#pragma unroll
                for (int i = 0; i < TPT; ++i) { e1v[i] = fmaxf(e1v[i] * mul, 1e-30f); e2v[i] = __builtin_amdgcn_rcpf(e1v[i]); }
            }
            lsum += __logf(fmaxf(dlast, 1e-37f));
        } else {
#pragma unroll
            for (int i = 0; i < TPT; ++i) { kk_[i] = zf[i]; e1v[i] = __expf((float)(tq * TPT + i - 31) * lg); e2v[i] = __builtin_amdgcn_rcpf(e1v[i]); }
            Eref = __expf(32.f * lg); Ebr = Eref; dlast = Eref * Ebr;
            lsum += 64.f * lg;
        }
        unsigned short kh[TPT];
        if (MODE) {
#pragma unroll
            for (int i = 0; i < TPT; ++i) { const int tau = tq * TPT + i;
                const float qt = qf[i] * e1v[i], kt = kk_[i] * e2v[i];
                const unsigned wq = cvtpk2(qt, qt * Eref), wk = cvtpk2(kt, kt * Ebr);
                *(LAS unsigned short*)(Lqt + tau * QS + c * 2) = (unsigned short)(wq & 0xffff);
                *(LAS unsigned short*)(Lqh + tau * QS + c * 2) = (unsigned short)(wq >> 16);
                *(LAS unsigned short*)(Lkt + tau * QS + c * 2) = (unsigned short)(wk & 0xffff);
                kh[i] = (unsigned short)(wk >> 16); }
        } else {
#pragma unroll
            for (int i = 0; i < TPT; ++i) kh[i] = (unsigned short)(cvtpk2(kk_[i] * e2v[i] * Ebr, 0.f) & 0xffff);
        }
#pragma unroll
        for (int i8 = 0; i8 < TPT / 8; ++i8) { u32x4 w; w.x = kh[8 * i8] | ((unsigned)kh[8 * i8 + 1] << 16); w.y = kh[8 * i8 + 2] | ((unsigned)kh[8 * i8 + 3] << 16);
            w.z = kh[8 * i8 + 4] | ((unsigned)kh[8 * i8 + 5] << 16); w.w = kh[8 * i8 + 6] | ((unsigned)kh[8 * i8 + 7] << 16);
            *(LAS u32x4*)(LkhT + c * TS + (tq * TPT + 8 * i8) * 2) = w; }
        if (tq == 0) Lbl[c] = dlast;
        __syncthreads();
        const int dvl = 16 * wid + l15;
        const bf16x8 bv0 = *(const LAS bf16x8*)(LvT + dvl * TS + (8 * q4) * 2), bv1 = *(const LAS bf16x8*)(LvT + dvl * TS + (32 + 8 * q4) * 2);
        if (MODE) {
#pragma unroll
            for (int tt = 0; tt < 2; ++tt) { const int idx = 2 * wid + tt, si = idx >> 2, ti = idx & 3;
                f32x4 acc = (f32x4){0.f, 0.f, 0.f, 0.f};
#pragma unroll
                for (int kk = 0; kk < DK / 32; ++kk) { const bf16x8 A = *(const LAS bf16x8*)(Lkt + (16 * si + l15) * QS + (32 * kk + 8 * q4) * 2);
                    const bf16x8 B = *(const LAS bf16x8*)(Lqt + (16 * ti + l15) * QS + (32 * kk + 8 * q4) * 2); acc = mfma16(A, B, acc); }
                const int t = 16 * ti + l15, s0 = 16 * si + 4 * q4;
                u32x2 w; w.x = pk2(s0 + 0 <= t ? acc[0] : 0.f, s0 + 1 <= t ? acc[1] : 0.f); w.y = pk2(s0 + 2 <= t ? acc[2] : 0.f, s0 + 3 <= t ? acc[3] : 0.f);
                *(LAS u32x2*)(Latt + t * TS + s0 * 2) = w; }
            __syncthreads();
            bf16x8 Sb[DK / 32];
#pragma unroll
            for (int kk = 0; kk < DK / 32; ++kk) { u32x4 w; w.x = pk2(Sacc[2 * kk][0], Sacc[2 * kk][1]); w.y = pk2(Sacc[2 * kk][2], Sacc[2 * kk][3]);
                w.z = pk2(Sacc[2 * kk + 1][0], Sacc[2 * kk + 1][1]); w.w = pk2(Sacc[2 * kk + 1][2], Sacc[2 * kk + 1][3]); Sb[kk] = __builtin_bit_cast(bf16x8, w); }
#pragma unroll
            for (int ti = 0; ti < 4; ++ti) {
                f32x4 acc = (f32x4){0.f, 0.f, 0.f, 0.f};
                { const bf16x8 A = *(const LAS bf16x8*)(Latt + (16 * ti + l15) * TS + (8 * q4) * 2); acc = mfma16(A, bv0, acc); }
                if (ti >= 2) { const bf16x8 A = *(const LAS bf16x8*)(Latt + (16 * ti + l15) * TS + (32 + 8 * q4) * 2); acc = mfma16(A, bv1, acc); }
#pragma unroll
                for (int kk = 0; kk < DK / 32; ++kk) {
                    const s16x4 lo = *(const LAS s16x4*)(Lqh + (16 * ti + l15) * QS + (32 * kk + 4 * q4) * 2), hi = *(const LAS s16x4*)(Lqh + (16 * ti + l15) * QS + (32 * kk + 16 + 4 * q4) * 2);
                    const bf16x8 A = (bf16x8){lo[0], lo[1], lo[2], lo[3], hi[0], hi[1], hi[2], hi[3]};
                    acc = mfma16(A, Sb[kk], acc); }
#pragma unroll
                for (int r = 0; r < 4; ++r) { const int t = 16 * ti + 4 * q4 + r;
                    OSC[(size_t)(rowbase + jb + sg * t) * 512 + h * 128 + dvl] = (bf16)f2bf(acc[r]); }
            }
        }
#pragma unroll
        for (int i = 0; i < DK / 16; ++i) {
            const f32x4 d4 = *(const LAS f32x4*)(Lbl + 16 * i + 4 * q4);
            f32x4 s = Sacc[i] * d4;
            const bf16x8 A0 = *(const LAS bf16x8*)(LkhT + (16 * i + l15) * TS + (8 * q4) * 2), A1 = *(const LAS bf16x8*)(LkhT + (16 * i + l15) * TS + (32 + 8 * q4) * 2);
            s = mfma16(A0, bv0, s); s = mfma16(A1, bv1, s); Sacc[i] = s; }
        __syncthreads();
    }
    if (!MODE) {
#pragma unroll
        for (int i = 0; i < DK / 16; ++i) Ub[((size_t)(item * 3 + seg) * (DK / 16) + i) * 512 + tid] = Sacc[i];
        if (tq == 0) Lb[(size_t)(item * 3 + seg) * 128 + c] = lsum;
    }
#undef SC_JB
#undef SC_LOAD
}

#define SBAR() __builtin_amdgcn_sched_barrier(0)
__device__ __forceinline__ int crow(int r, int hi) { return (r & 3) + 8 * (r >> 2) + 4 * hi; }
__device__ __forceinline__ unsigned cvtpk(float lo, float hi) { unsigned r; asm volatile("v_cvt_pk_bf16_f32 %0, %1, %2" : "=v"(r) : "v"(lo), "v"(hi)); return r; }
__device__ __forceinline__ void partialSM(f32x16& p0, f32x16& p1, float& m_reg, float& mn, float& alpha, float C, float thr_raw) {
    float pmax = p0[0];
#pragma unroll
    for (int r = 1; r < 16; ++r) pmax = fmaxf(pmax, p0[r]);
#pragma unroll
    for (int r = 0; r < 16; ++r) pmax = fmaxf(pmax, p1[r]);
    { auto rr = __builtin_amdgcn_permlane32_swap(__float_as_uint(pmax), __float_as_uint(pmax), false, false);
      pmax = fmaxf(__uint_as_float(rr[0]), __uint_as_float(rr[1])); }
    if (__builtin_expect(__all(pmax - m_reg <= thr_raw), 1)) { mn = m_reg; alpha = 1.f; }
    else { mn = fmaxf(m_reg, pmax); alpha = __builtin_amdgcn_exp2f((m_reg - mn) * C); m_reg = mn; }
    const float mnC = -mn * C;
#pragma unroll
    for (int r = 0; r < 16; ++r) p0[r] = fmaf(p0[r], C, mnC);
#pragma unroll
    for (int r = 0; r < 16; ++r) p1[r] = fmaf(p1[r], C, mnC);
#pragma unroll
    for (int r = 0; r < 16; ++r) p0[r] = __builtin_amdgcn_exp2f(p0[r]);
}
__device__ __forceinline__ void finishSM(f32x16& p0, f32x16& p1, float alpha, float& l_reg, bf16x8& pa0, bf16x8& pa1, bf16x8& pa2, bf16x8& pa3) {
#pragma unroll
    for (int r = 0; r < 16; ++r) p1[r] = __builtin_amdgcn_exp2f(p1[r]);
    float ps = 0;
#pragma unroll
    for (int r = 0; r < 16; ++r) ps += p0[r];
#pragma unroll
    for (int r = 0; r < 16; ++r) ps += p1[r];
    { auto rr = __builtin_amdgcn_permlane32_swap(__float_as_uint(ps), __float_as_uint(ps), false, false);
      ps = __uint_as_float(rr[0]) + __uint_as_float(rr[1]); }
    l_reg = l_reg * alpha + ps;
#define PK4(P, BASE, OUT) do { unsigned a0 = cvtpk(P[BASE + 0], P[BASE + 1]), a1 = cvtpk(P[BASE + 2], P[BASE + 3]);   \
    unsigned b0 = cvtpk(P[BASE + 4], P[BASE + 5]), b1 = cvtpk(P[BASE + 6], P[BASE + 7]);                              \
    auto r0 = __builtin_amdgcn_permlane32_swap(a0, b0, false, false); auto r1 = __builtin_amdgcn_permlane32_swap(a1, b1, false, false); \
    u32x4 w = {r0[0], r1[0], r0[1], r1[1]}; OUT = __builtin_bit_cast(bf16x8, w); } while (0)
    PK4(p0, 0, pa0); PK4(p0, 8, pa1); PK4(p1, 0, pa2); PK4(p1, 8, pa3);
#undef PK4
}
template <int ND0, int KROWB>
__device__ __forceinline__ void qkt(f32x16& p0, f32x16& p1, const char* Ks, const bf16x8* qr, int r32, int hi) {
    p0 = f32x16{}; p1 = f32x16{};
#pragma unroll
    for (int d0 = 0; d0 < ND0; ++d0) { const int cb = (d0 * 16 + hi * 8) * 2;
        const bf16x8 b0 = *reinterpret_cast<const bf16x8*>(Ks + r32 * KROWB + (cb ^ ((r32 & 7) << 4)));
        const bf16x8 b1 = *reinterpret_cast<const bf16x8*>(Ks + (32 + r32) * KROWB + (cb ^ ((r32 & 7) << 4)));
        p0 = __builtin_amdgcn_mfma_f32_32x32x16_bf16(b0, qr[d0], p0, 0, 0, 0);
        p1 = __builtin_amdgcn_mfma_f32_32x32x16_bf16(b1, qr[d0], p1, 0, 0, 0); }
}
template <int NCB> __device__ __forceinline__ int v_st(int k, int c) { const int kk = (k & ~0xC) | ((k & 4) << 1) | ((k & 8) >> 1); return ((kk >> 3) * NCB + (c >> 5)) * 512 + ((kk & 7) * 32 + (c & 31)) * 2; }
__device__ __forceinline__ int v_rd_base(int lane) { return ((lane & 3) << 3) | (((lane >> 2) & 3) << 6) | (((lane >> 4) & 1) << 5) | (((lane >> 5) & 1) << 8); }
template <int OFF> __device__ __forceinline__ s16x4 tr_read(int vb) {
    s16x4 r; asm volatile("ds_read_b64_tr_b16 %0, %1 offset:%2" : "=&v"(r) : "v"(vb), "i"(OFF) : "memory"); return r;
}
template <int NCB, int D0> __device__ __forceinline__ void pv_one(f32x16& od, int vb, bf16x8 pa0, bf16x8 pa1, bf16x8 pa2, bf16x8 pa3) {
#define VOFF(ks, half) (D0 * 512 + (ks) * (NCB * 1024) + (half) * (NCB * 512))
    const s16x4 l0 = tr_read<VOFF(0, 0)>(vb), h0 = tr_read<VOFF(0, 1)>(vb), l1 = tr_read<VOFF(1, 0)>(vb), h1 = tr_read<VOFF(1, 1)>(vb);
    const s16x4 l2 = tr_read<VOFF(2, 0)>(vb), h2 = tr_read<VOFF(2, 1)>(vb), l3 = tr_read<VOFF(3, 0)>(vb), h3 = tr_read<VOFF(3, 1)>(vb);
#undef VOFF
    asm volatile("s_waitcnt lgkmcnt(0)" ::: "memory"); SBAR();
#define PK(L, H) (bf16x8){L[0], L[1], L[2], L[3], H[0], H[1], H[2], H[3]}
    od = __builtin_amdgcn_mfma_f32_32x32x16_bf16(pa0, PK(l0, h0), od, 0, 0, 0);
    od = __builtin_amdgcn_mfma_f32_32x32x16_bf16(pa1, PK(l1, h1), od, 0, 0, 0);
    od = __builtin_amdgcn_mfma_f32_32x32x16_bf16(pa2, PK(l2, h2), od, 0, 0, 0);
    od = __builtin_amdgcn_mfma_f32_32x32x16_bf16(pa3, PK(l3, h3), od, 0, 0, 0);
#undef PK
}
template <int NCB> __device__ __forceinline__ void pv_all(f32x16* o, int vb, bf16x8 pa0, bf16x8 pa1, bf16x8 pa2, bf16x8 pa3) {
    pv_one<NCB, 0>(o[0], vb, pa0, pa1, pa2, pa3); pv_one<NCB, 1>(o[1], vb, pa0, pa1, pa2, pa3);
    if constexpr (NCB == 4) { pv_one<NCB, 2>(o[2], vb, pa0, pa1, pa2, pa3); pv_one<NCB, 3>(o[3], vb, pa0, pa1, pa2, pa3); }
}

template <int DQK, int DV, int KROWB>
__device__ __forceinline__ void attn_core(const bf16x8* qr, const bf16* kA, int sA, const bf16* kB, int sB, const bf16* vP, int sV,
                                          int NT, float C, float thr_raw, char* lds, f32x16* o, float& l_out, const int tid) {
    constexpr int NCB = DV / 32, SHM_V = 64 * DV * 2, SHM_K = 64 * KROWB, ND0 = DQK / 16;
    constexpr int PPR = DQK / 8, NPK = 64 * PPR, NKS = (NPK + 511) / 512, VPR = DV / 8, NVS = 64 * VPR / 512;
    const int wid = tid >> 6, lane = tid & 63, r32 = lane & 31, hi = lane >> 5;
    char* V_lds = lds; char* K_lds = lds + 2 * SHM_V;
    float* wsf = (float*)(lds + 2 * SHM_V + 2 * SHM_K) + wid * 64; float* al_l = wsf + 32;
    float m_reg = -1e30f, l_reg = 0;
    const bf16* kp[NKS]; int kadv[NKS], kst[NKS]; bool kval[NKS];
#pragma unroll
    for (int i = 0; i < NKS; ++i) { int p = tid + 512 * i; kval[i] = p < NPK; if (!kval[i]) p -= 512; const int row = p / PPR, c8 = p - row * PPR;
        if (c8 < 8) { kp[i] = kA + (size_t)row * sA + c8 * 8; kadv[i] = 64 * sA; } else { kp[i] = kB + (size_t)row * sB + (c8 - 8) * 8; kadv[i] = 64 * sB; }
        kst[i] = row * KROWB + ((c8 * 16) ^ ((row & 7) << 4)); }
    const bf16* vp[NVS]; int vst[NVS];
#pragma unroll
    for (int i = 0; i < NVS; ++i) { const int p = tid + 512 * i, row = p / VPR, c8 = p % VPR; vp[i] = vP + (size_t)row * sV + c8 * 8; vst[i] = v_st<NCB>(row, c8 * 8); }
    const int vadv = 64 * sV;
    const int vb0 = (int)(uintptr_t)V_lds + v_rd_base(lane);
    struct { bf16x8 ks[NKS]; bf16x8 vs[NVS]; } sr_[1];
#define SLOAD(i, t) do { _Pragma("unroll") for (int s_ = 0; s_ < NKS; ++s_) sr_[i].ks[s_] = *(const bf16x8*)(kp[s_] + (size_t)(t) * kadv[s_]); \
        _Pragma("unroll") for (int s_ = 0; s_ < NVS; ++s_) sr_[i].vs[s_] = *(const bf16x8*)(vp[s_] + (size_t)(t) * vadv); } while (0)
#define SWRITE(b, i) do { _Pragma("unroll") for (int s_ = 0; s_ < NVS; ++s_) *(bf16x8*)(V_lds + (b) * SHM_V + vst[s_]) = sr_[i].vs[s_]; \
        _Pragma("unroll") for (int s_ = 0; s_ < NKS; ++s_) if (kval[s_]) *(bf16x8*)(K_lds + (b) * SHM_K + kst[s_]) = sr_[i].ks[s_]; } while (0)
#define RESC(a) do { if (__any((a) < 1.f)) { if (hi == 0) al_l[r32] = (a); asm volatile("s_waitcnt lgkmcnt(0)" ::: "memory"); \
        _Pragma("unroll") for (int d = 0; d < NCB; ++d) _Pragma("unroll") for (int r = 0; r < 16; ++r) o[d][r] *= al_l[crow(r, hi)]; } } while (0)
    f32x16 pA0, pA1, pB0, pB1; float mnA, mnB, alA, alB; bf16x8 pa0, pa1, pa2, pa3;
    constexpr int SE = 0, SO = 0;
    SLOAD(SE, 0); SWRITE(0, SE); __syncthreads();
    qkt<ND0, KROWB>(pA0, pA1, K_lds, qr, r32, hi); partialSM(pA0, pA1, m_reg, mnA, alA, C, thr_raw);
    SLOAD(SO, 1);
    SWRITE(1, SO); __syncthreads();
    for (int j = 1; j + 1 < NT; j += 2) {
        SBAR(); qkt<ND0, KROWB>(pB0, pB1, K_lds + SHM_K, qr, r32, hi);
        finishSM(pA0, pA1, alA, l_reg, pa0, pa1, pa2, pa3); SBAR();
        SLOAD(SO, j + 1); SBAR();
        pv_all<NCB>(o, vb0, pa0, pa1, pa2, pa3); partialSM(pB0, pB1, m_reg, mnB, alB, C, thr_raw);
        __syncthreads(); SWRITE(0, SE);
        RESC(alB); __syncthreads();
        SBAR(); qkt<ND0, KROWB>(pA0, pA1, K_lds, qr, r32, hi);
        finishSM(pB0, pB1, alB, l_reg, pa0, pa1, pa2, pa3); SBAR();
        SLOAD(SE, j + 2); SBAR();
        pv_all<NCB>(o, vb0 + SHM_V, pa0, pa1, pa2, pa3); partialSM(pA0, pA1, m_reg, mnA, alA, C, thr_raw);
        __syncthreads(); SWRITE(1, SO);
        RESC(alA); __syncthreads();
    }
    SBAR(); qkt<ND0, KROWB>(pB0, pB1, K_lds + SHM_K, qr, r32, hi);
    finishSM(pA0, pA1, alA, l_reg, pa0, pa1, pa2, pa3); SBAR();
    pv_all<NCB>(o, vb0, pa0, pa1, pa2, pa3); partialSM(pB0, pB1, m_reg, mnB, alB, C, thr_raw);
    __syncthreads(); RESC(alB);
    finishSM(pB0, pB1, alB, l_reg, pa0, pa1, pa2, pa3); SBAR();
    pv_all<NCB>(o, vb0 + SHM_V, pa0, pa1, pa2, pa3);
    l_out = l_reg;
#undef SLOAD
#undef SWRITE
#undef RESC
}

__device__ __forceinline__ void mla_item(KArgP a, int b, int h, int qb, char* lds) {
    const int tid = ptid(), wid = tid >> 6, lane = tid & 63, r32 = lane & 31, hi = lane >> 5;
    const bf16* Qb = (const bf16*)((const unsigned char*)a->out + OUT_Q); const bf16* KV = (const bf16*)((const unsigned char*)a->out + OUT_KV);
    const bf16* KR = (const bf16*)(a->ws + WS_KR); bf16* MIX = (bf16*)(a->ws + WS_MIX);
    const int row0 = b * TPB + qb * 256, krow0 = b * TPB, NT = qb ? 36 : 4;
    const int row = row0 + wid * 32 + r32;
    const bf16* Qw = Qb + (size_t)row * 768 + h * 96;
    bf16x8 qr[6];
#pragma unroll
    for (int d0 = 0; d0 < 4; ++d0) qr[d0] = *(const bf16x8*)(Qw + d0 * 16 + hi * 8);
    const int t = (qb - 1) * 256 + wid * 32 + r32;
#pragma unroll
    for (int d0 = 4; d0 < 6; ++d0) {
        const bf16x8 x1 = *(const bf16x8*)(Qw + d0 * 16), x2 = *(const bf16x8*)(Qw + d0 * 16 + 8);
        if (qb) { const float pos = (float)(d0 == 4 ? (t >> 6) : (t & 63)); unsigned short ov[8];
#pragma unroll
            for (int i = 0; i < 8; ++i) { float s, c; sincos_r(pos * inv_freq(i, 8), s, c); const float f1 = bf2f((unsigned short)x1[i]), f2 = bf2f((unsigned short)x2[i]);
                ov[i] = (unsigned short)f2bf(hi ? (f1 * s + f2 * c) : (f1 * c - f2 * s)); }
            qr[d0] = (bf16x8){(short)ov[0], (short)ov[1], (short)ov[2], (short)ov[3], (short)ov[4], (short)ov[5], (short)ov[6], (short)ov[7]};
        } else qr[d0] = hi ? x2 : x1;
    }
    f32x16 o[2] = {}; float l_reg;
    const float scale = 0.10206207261596575f;
    attn_core<96, 64, 256>(qr, KV + (size_t)krow0 * 1024 + h * 128, 1024, KR + (size_t)krow0 * 32, 32, KV + (size_t)krow0 * 1024 + h * 128 + 64, 1024,
                           NT, scale * 1.4426950408889634f, 8.f / scale, lds, o, l_reg, tid);
    float* li_l = (float*)(lds + 2 * 64 * 64 * 2 + 2 * 64 * 256) + wid * 64;
    if (hi == 0) li_l[r32] = l_reg; asm volatile("s_waitcnt lgkmcnt(0)" ::: "memory");
#pragma unroll
    for (int r = 0; r < 16; ++r) { const int orow = crow(r, hi); const float rl = __builtin_amdgcn_rcpf(li_l[orow]);
        bf16* op = MIX + (size_t)(row0 + wid * 32 + orow) * 1024 + 512 + h * 64 + r32;
        op[0] = (bf16)f2bf(o[0][r] * rl); op[32] = (bf16)f2bf(o[1][r] * rl); }
}
__device__ __forceinline__ void diff_item(KArgP a, int layer, int b, int h, int qb, char* lds) {
    const int row0 = b * TPB + qb * 256, krow0 = b * TPB, NT = qb ? 36 : 4, o_ = layer >> 1;
    const float scale = 0.125f;
#pragma unroll 1
    for (int m = 0; m < 2; ++m) {
        f32x16 o[4] = {};
        float l_reg;
        {
            const int tid = ptid(), wid = tid >> 6, lane = tid & 63, r32 = lane & 31, hi = lane >> 5;
            const bf16* P = (const bf16*)(a->ws + WS_P);
            const bf16* Qw = P + (size_t)(row0 + wid * 32 + r32) * NP_O + 1536 + h * 128 + m * 64;
            bf16x8 qr[4];
#pragma unroll
            for (int d0 = 0; d0 < 4; ++d0) qr[d0] = *(const bf16x8*)(Qw + d0 * 16 + hi * 8);
            const bf16* Kp = P + (size_t)krow0 * NP_O + 2048 + h * 128 + m * 64;
            attn_core<64, 128, 128>(qr, Kp, NP_O, Kp, NP_O, P + (size_t)krow0 * NP_O + 2560 + h * 128, NP_O,
                                    NT, scale * 1.4426950408889634f, 8.f / scale, lds, o, l_reg, tid);
        }
        const int tid = ptid(), wid = tid >> 6, lane = tid & 63, r32 = lane & 31, hi = lane >> 5;
        float* li_l = (float*)(lds + 2 * 64 * 128 * 2 + 2 * 64 * 128) + wid * 64;
        if (hi == 0) li_l[r32] = l_reg; asm volatile("s_waitcnt lgkmcnt(0)" ::: "memory");
        float* dsb = (float*)a->out + (size_t)blockIdx.x * 64 * 512 + tid; asm volatile("" : "+v"(dsb));
        if (m == 0) {
#pragma unroll
            for (int r = 0; r < 16; ++r) { const float rl = __builtin_amdgcn_rcpf(li_l[crow(r, hi)]);
#pragma unroll
                for (int d = 0; d < 4; ++d) dsb[(size_t)(d * 16 + r) * 512] = o[d][r] * rl; }
        } else {
            bf16* MIX = (bf16*)(a->ws + WS_MIX);
            const float* lp = a->in[20] + o_ * 256;
            const float lam_init = 0.8f - 0.6f * __expf(-0.3f * (float)layer);
            const float lam = __expf(wave_sum(lp[lane] * lp[64 + lane])) - __expf(wave_sum(lp[128 + lane] * lp[192 + lane])) + lam_init;
            const float* sg = a->in[21] + o_ * 128;
#pragma unroll
            for (int r = 0; r < 16; ++r) { const float rl = __builtin_amdgcn_rcpf(li_l[crow(r, hi)]); float s = 0.f; float v[4];
#pragma unroll
                for (int d = 0; d < 4; ++d) { v[d] = dsb[(size_t)(d * 16 + r) * 512] - lam * (o[d][r] * rl); s += v[d] * v[d]; }
                s += __shfl_xor(s, 16); s += __shfl_xor(s, 8); s += __shfl_xor(s, 4); s += __shfl_xor(s, 2); s += __shfl_xor(s, 1);
                const float rs = __builtin_amdgcn_rsqf(s * (1.f / 128.f) + EPSN) * (1.f - lam_init);
                bf16* op = MIX + (size_t)(row0 + wid * 32 + crow(r, hi)) * 1024 + 512 + h * 128 + r32;
#pragma unroll
                for (int d = 0; d < 4; ++d) op[32 * d] = (bf16)f2bf(v[d] * rs * sg[32 * d + r32]);
                asm volatile("" ::: "memory"); }
        }
        asm volatile("s_waitcnt vmcnt(0) lgkmcnt(0)" ::: "memory");
    }
}

__device__ __forceinline__ void phase_mixer(KArgP a, int layer, unsigned char* ldsg) {
    LAS unsigned char* lds = (LAS unsigned char*)ldsg;
    volatile LAS unsigned* flag = (volatile LAS unsigned*)(lds + LDS_MAIN);
    unsigned* ctr = (unsigned*)(a->ws + WS_CTL) + layer; layer &= 7;
    const bool even = !(layer & 1), need_ctx = layer < 3;
    constexpr int NSC = 256;
    const int n_lat = even ? 512 : 256, n_ctx = need_ctx ? (even ? 64 : 32) : 0, total = NSC + n_lat + n_ctx;
    for (;;) {
        __syncthreads();
        if (ptid() == 0) *flag = atomicAdd(ctr, 1u);
        __syncthreads();
        const int qi_ = (int)*flag;
        if (qi_ >= total) break;
        const int item = qi_ < n_lat ? NSC + qi_ : (qi_ < n_lat + NSC ? qi_ - n_lat : qi_);
#ifdef PROBE_ITEM
        const unsigned long long it0_ = __builtin_amdgcn_s_memrealtime();
#endif
#ifndef SKIP_SCAN
        if (item < NSC) { if (even) scan_item<128, true, 1>(a, layer, item & 63, item >> 6, lds); else scan_item<64, false, 1>(a, layer, item & 63, item >> 6, lds); }
#else
        if (item < NSC) {}
#endif
        else { int b_, h_, qb_;
            if (item < NSC + n_lat) { const int i = item - NSC; qb_ = 1 + (i & 7); if (even) { b_ = i >> 6; h_ = (i >> 3) & 7; } else { b_ = i >> 5; h_ = (i >> 3) & 3; } }
            else { const int i = item - NSC - n_lat; qb_ = 0; if (even) { b_ = i >> 3; h_ = i & 7; } else { b_ = i >> 2; h_ = i & 3; } }
#ifndef SKIP_ATTN
            if (even) mla_item(a, b_, h_, qb_, (char*)ldsg); else diff_item(a, layer, b_, h_, qb_, (char*)ldsg);
#endif
        }
#ifdef PROBE_ITEM
        __syncthreads();
        if (otid() == 0) { volatile LAS unsigned long long* pc_ = (volatile LAS unsigned long long*)(lds + LDS_MAIN + 128); const int k_ = item < NSC ? 0 : (even ? 1 : 2); pc_[k_] += __builtin_amdgcn_s_memrealtime() - it0_; }
#endif
    }
}

#define XB_TMO      128
#define XB_XCNT(j)  (256  + 64 * (j))
#define XB_XSUB(j)  (1280 + 64 * (j))
#define XB_XGEN(j)  (2304 + 64 * (j))
#define XB_TOP      3328
#define XB_TOPGEN   3392
#define XCD_BAR_WORDS 3456
#define XB_SPIN_CAP (1u << 18)

__device__ __forceinline__ unsigned xb_ld(unsigned* p)              { return __hip_atomic_load(p, __ATOMIC_RELAXED, __HIP_MEMORY_SCOPE_AGENT); }
__device__ __forceinline__ unsigned xb_add(unsigned* p, unsigned v) { return __hip_atomic_fetch_add(p, v, __ATOMIC_RELAXED, __HIP_MEMORY_SCOPE_AGENT); }
__device__ __forceinline__ unsigned xb_xcc_id() { return (unsigned)__builtin_amdgcn_s_getreg((3 << 11) | 20) & 0xFu; }
#define XB_SPIN(cond, bar) do { unsigned _sp = 0; while (cond) { __builtin_amdgcn_s_sleep(1); \
    if ((++_sp & 255u) == 0u) { if (xb_ld(&(bar)[XB_TMO])) break; if (_sp > XB_SPIN_CAP) { atomicAdd(&(bar)[XB_TMO], 1u); break; } } } } while (0)

struct XcdBarrier {
    unsigned* bar; unsigned x;
    volatile LAS unsigned* st;
};

__device__ __forceinline__ XcdBarrier xcd_barrier_post(unsigned* bar, volatile LAS unsigned* st) {
    XcdBarrier b; b.bar = bar; b.x = xb_xcc_id(); b.st = st;
    if (threadIdx.x == 0) (void)xb_add(&bar[XB_XCNT(b.x)], 1u);
    return b;
}
__device__ __forceinline__ void xcd_barrier_complete(unsigned* bar, unsigned x, unsigned& nloc, unsigned& nx) {
    const unsigned G = gridDim.x * gridDim.y * gridDim.z;
    unsigned sum, cnt, mine, sp = 0u;
    for (;;) {
        sum = 0u; cnt = 0u; mine = 0u;
#pragma unroll
        for (unsigned j = 0; j < 16; ++j) { const unsigned c = xb_ld(&bar[XB_XCNT(j)]); sum += c; cnt += (c > 0u) ? 1u : 0u; mine = (j == x) ? c : mine; }
        if (sum == G) break;
        __builtin_amdgcn_s_sleep(1);
        if ((++sp & 255u) == 0u) { if (xb_ld(&bar[XB_TMO])) break; if (sp > XB_SPIN_CAP) { atomicAdd(&bar[XB_TMO], 1u); break; } }
    }
    nloc = mine > 0u ? mine : 1u; nx = cnt > 0u ? cnt : 1u;
}

__device__ __forceinline__ void xcd_barrier(const XcdBarrier& b) {
    asm volatile("s_waitcnt vmcnt(0)" ::: "memory");
    __syncthreads();
    if (threadIdx.x == 0) {
        unsigned* bar = b.bar;
        __builtin_amdgcn_s_waitcnt(0);
        unsigned nloc = b.st[0], nx = b.st[1];
        if (nloc == 0u) { xcd_barrier_complete(bar, b.x, nloc, nx); b.st[0] = nloc; b.st[1] = nx; }
        const unsigned old = xb_add(&bar[XB_XSUB(b.x)], 1u);
        const unsigned gen = old / nloc;
        if (old + 1u == (gen + 1u) * nloc) {
            __builtin_amdgcn_fence(__ATOMIC_RELEASE, "agent");
            asm volatile("s_waitcnt vmcnt(0)" ::: "memory");
            const unsigned og = xb_add(&bar[XB_TOP], 1u);
            const unsigned tg = og / nx;
            if (og + 1u == (tg + 1u) * nx) xb_add(&bar[XB_TOPGEN], 1u);
            else XB_SPIN(xb_ld(&bar[XB_TOPGEN]) == tg, bar);
            __builtin_amdgcn_fence(__ATOMIC_ACQUIRE, "agent");
            xb_add(&bar[XB_XGEN(b.x)], 1u);
            asm volatile("s_waitcnt vmcnt(0)" ::: "memory");
        } else {
            XB_SPIN(xb_ld(&bar[XB_XGEN(b.x)]) == gen, bar);
            __builtin_amdgcn_fence(__ATOMIC_ACQUIRE, "agent");
            asm volatile("s_waitcnt vmcnt(0)" ::: "memory");
        }
    }
    __syncthreads();
}

__global__ void __launch_bounds__(512, 2) mega_fwd(Args a_) {
    extern __shared__ __attribute__((aligned(16))) unsigned char lds_raw[];
    LAS unsigned char* lds = (LAS unsigned char*)lds_raw;
    ((LAS int*)(lds + LDS_MAIN + 1024))[threadIdx.x] = (int)threadIdx.x;
    if (threadIdx.x < 4) ((LAS unsigned*)(lds + LDS_MAIN + 64))[threadIdx.x] = 0u;
    if (threadIdx.x < 8) ((LAS unsigned*)(lds + LDS_MAIN + 128))[threadIdx.x] = 0u;
    __syncthreads();
    XcdBarrier xbar; xbar.bar = nullptr; xbar.x = 0; xbar.st = nullptr; bool xb_ready = false;
    cg::grid_group grid = cg::this_grid();
    int ph = 0;
#ifdef PROBE_MASK
    unsigned long long pr_last = __builtin_amdgcn_s_memrealtime(), pr_acc = 0ull;
#define PROBE_STAMP(k) { const unsigned long long now_ = __builtin_amdgcn_s_memrealtime(); if ((PROBE_MASK >> (k)) & 1) pr_acc += now_ - pr_last; pr_last = now_; }
#else
#define PROBE_STAMP(k)
#endif
    const int plo = a_.lo, phi = a_.hi;
#define PH_BEGIN if (ph >= plo && ph < phi) { KArgP a = kargs(); int bx = (int)blockIdx.x, G = (int)gridDim.x; asm volatile("" : "+s"(bx), "+s"(G)); (void)bx; (void)G;
#ifdef PROBE_SYNC2
#define PH_ENDT(k)   if (ph + 1 < phi) { grid.sync(); grid.sync(); } } ++ph;
#else
#define PH_ENDT(k) if (ph + 1 < phi) { if (!xb_ready) { grid.sync(); xbar = xcd_barrier_post((unsigned*)(a->ws + WS_CTL) + 4096, (volatile LAS unsigned*)(lds + LDS_MAIN + 64)); xb_ready = true; } else xcd_barrier(xbar); } PROBE_STAMP(k) } ++ph;
#endif

    PH_BEGIN phase_prep(a, lds); PH_ENDT(0)

    for (int layer = 0; layer < 4; ++layer) {
        const bool even = !(layer & 1);
        const int np = even ? NP_E : NP_O;
        PH_BEGIN phase_norm(a, layer, 0, layer > 0); convert_weights(a, layer, lds); PH_ENDT(1)
#ifndef SKIP_G1
        PH_BEGIN { bf16* H = (bf16*)(a->ws + WS_H); bf16* MIX = (bf16*)(a->ws + WS_MIX); bf16* P = (bf16*)(a->ws + WS_P); bf16* X = (bf16*)(a->ws + WS_X); unsigned char* Wb = a->ws + WS_W; const float* mod = (const float*)(a->ws + WS_MOD) + (size_t)layer * 9 * 6144; (void)H; (void)MIX; (void)P; (void)X; (void)mod; pg8::Gemm g{H, (const bf16*)(Wb + W_IN), MT, np, 1024, 1024}; pg8::StaticOrder S; S.init(MT, np, G, bx);
                   pg8::EpiBf16<0> E{P, np, nullptr, 0, 0, 1.f};
                   pg8::gemm_phase<pg8::EpiBf16<0>, pg8::StaticOrder, true, true>(lds, g, S, E); } PH_ENDT(2)
#else
        ++ph;
#endif
        PH_BEGIN if (even) phase_post_even(a, layer); else phase_post_odd(a, layer); PH_ENDT(3)
#ifndef SKIP_G3
        if (even) {
            PH_BEGIN { bf16* H = (bf16*)(a->ws + WS_H); bf16* MIX = (bf16*)(a->ws + WS_MIX); bf16* P = (bf16*)(a->ws + WS_P); bf16* X = (bf16*)(a->ws + WS_X); unsigned char* Wb = a->ws + WS_W; const float* mod = (const float*)(a->ws + WS_MOD) + (size_t)layer * 9 * 6144; (void)H; (void)MIX; (void)P; (void)X; (void)mod; pg8::Gemm g{(const bf16*)(a->ws + WS_CQN), (const bf16*)(Wb + W_UQ), MT, 768, 384, 384}; pg8::StaticOrder S; S.init(MT, 768, G, bx);
                       pg8::EpiBf16<0> E{(bf16*)((unsigned char*)a->out + OUT_Q), 768, nullptr, 0, 0, 1.f};
                       pg8::gemm_phase<pg8::EpiBf16<0>, pg8::StaticOrder, true, true>(lds, g, S, E); }
                     { unsigned char* Wb = a->ws + WS_W; pg8::Gemm g{(const bf16*)(a->ws + WS_CKVN), (const bf16*)(Wb + W_UKV), MT, 1024, 256, 256}; pg8::StaticOrder S; S.init(MT, 1024, G, bx);
                       pg8::EpiBf16<0> E{(bf16*)((unsigned char*)a->out + OUT_KV), 1024, nullptr, 0, 0, 1.f};
                       pg8::gemm_phase<pg8::EpiBf16<0>, pg8::StaticOrder, true, true>(lds, g, S, E); }
                     for (int it = bx; it < 192; it += G) scan_item<128, true, 0>(a, layer, it & 63, it >> 6, lds);
            PH_ENDT(4)
        } else { ++ph; }
#else
        ++ph;
#endif
        if (!even) {
        PH_BEGIN for (int it = bx; it < 192; it += G) scan_item<64, false, 0>(a, layer, it & 63, it >> 6, lds); PH_ENDT(5)
        } else { ++ph; }
#ifdef PROBE_MIX2
        PH_BEGIN phase_mixer(a, layer + 8, lds_raw); grid.sync(); PH_ENDT(6)
        --ph;
#endif
        PH_BEGIN phase_mixer(a, layer, lds_raw); PH_ENDT(6 + 7 * (layer & 1))
        PH_BEGIN phase_readout(a, layer); PH_ENDT(7)
#ifndef SKIP_G6
        PH_BEGIN { bf16* H = (bf16*)(a->ws + WS_H); bf16* MIX = (bf16*)(a->ws + WS_MIX); bf16* P = (bf16*)(a->ws + WS_P); bf16* X = (bf16*)(a->ws + WS_X); unsigned char* Wb = a->ws + WS_W; const float* mod = (const float*)(a->ws + WS_MOD) + (size_t)layer * 9 * 6144; (void)H; (void)MIX; (void)P; (void)X; (void)mod; pg8::Gemm g{MIX, (const bf16*)(Wb + W_OUT), MT, 1024, 1024, 1024}; pg8::StaticOrder S; S.init(NB * NLAT, 1024, G, bx, 1);
                   pg8::EpiResid E{X, mod, 2048, layer == 0 ? a->in[0] : nullptr};
                   pg8::gemm_phase<pg8::EpiResid, pg8::StaticOrder, true, true>(lds, g, S, E);
                   if (layer < 3) { pg8::Gemm g2{MIX, (const bf16*)(Wb + W_OUT), MT, 1024, 512, 1024}; pg8::CtxSplitOrder S2{G, bx, 512};
                       pg8::EpiResidSplit E2{X, (float*)(a->ws + WS_T), mod, 2048, layer == 0 ? a->in[2] : nullptr};
                       pg8::gemm_phase<pg8::EpiResidSplit, pg8::CtxSplitOrder, true, true>(lds, g2, S2, E2); } } PH_ENDT(8)
#else
        ++ph;
#endif
        PH_BEGIN phase_norm(a, layer, 1, layer < 3); PH_ENDT(9)
#ifndef SKIP_G8
        PH_BEGIN { bf16* H = (bf16*)(a->ws + WS_H); bf16* MIX = (bf16*)(a->ws + WS_MIX); bf16* P = (bf16*)(a->ws + WS_P); bf16* X = (bf16*)(a->ws + WS_X); unsigned char* Wb = a->ws + WS_W; const float* mod = (const float*)(a->ws + WS_MOD) + (size_t)layer * 9 * 6144; (void)H; (void)MIX; (void)P; (void)X; (void)mod; pg8::Gemm g{H, (const bf16*)(Wb + W_GU), MT, 2 * FF, 1024, 1024}; pg8::StaticOrder S; if (layer < 3) S.init(MT, 2 * FF, G, bx); else S.init(NB * NLAT, 2 * FF, G, bx, 1);
                   pg8::EpiSwiGLU E{P, FF};
                   pg8::gemm_phase<pg8::EpiSwiGLU, pg8::StaticOrder, true, true>(lds, g, S, E); } PH_ENDT(10)
#else
        ++ph;
#endif
#ifndef SKIP_G9
        PH_BEGIN { bf16* H = (bf16*)(a->ws + WS_H); bf16* MIX = (bf16*)(a->ws + WS_MIX); bf16* P = (bf16*)(a->ws + WS_P); bf16* X = (bf16*)(a->ws + WS_X); unsigned char* Wb = a->ws + WS_W; const float* mod = (const float*)(a->ws + WS_MOD) + (size_t)layer * 9 * 6144; (void)H; (void)MIX; (void)P; (void)X; (void)mod; pg8::Gemm g{P, (const bf16*)(Wb + W_DN), MT, 1024, FF, FF}; pg8::StaticOrder S; S.init(NB * NLAT, 1024, G, bx, 1);
                   pg8::EpiResid E{X, mod, 5120, nullptr};
                   pg8::gemm_phase<pg8::EpiResid, pg8::StaticOrder, true, true>(lds, g, S, E);
                   if (layer < 3) { pg8::Gemm g2{P, (const bf16*)(Wb + W_DN), MT, 1024, FF / 2, FF}; pg8::CtxSplitOrder S2{G, bx, FF / 2};
                       pg8::EpiResidSplit E2{X, (float*)(a->ws + WS_T), mod, 5120, nullptr};
                       pg8::gemm_phase<pg8::EpiResidSplit, pg8::CtxSplitOrder, true, true>(lds, g2, S2, E2); } } PH_ENDT(11)
#else
        ++ph;
#endif
    }
    PH_BEGIN phase_final(a); PH_ENDT(12)
#undef PH_BEGIN
#undef PH_ENDT
#ifdef PROBE_ITEM
    pr_acc += ((volatile LAS unsigned long long*)(lds + LDS_MAIN + 128))[PROBE_ITEM - 1];
#endif
#ifdef PROBE_MASK
    if (blockIdx.x == 0) { const unsigned long long t0_ = __builtin_amdgcn_s_memrealtime(); while (__builtin_amdgcn_s_memrealtime() - t0_ < pr_acc) __builtin_amdgcn_s_sleep(8); }
#endif
}
constexpr int NPH = 1 + 4 * 11 + 1;

extern "C" void kernel_launch(void* const* d_in, const int* in_sizes, int n_in, void* d_out, int out_size, void* d_ws, size_t ws_size, hipStream_t stream) {
    static int grid = 0;
    if (grid == 0) {
        if (n_in != 23 || ws_size < WS_END || out_size != NB * NLAT * DM) { fprintf(stderr, "kernel_launch: unexpected shapes: n_in %d ws %zu (need %zu) out %d\n", n_in, ws_size, (size_t)WS_END, out_size); grid = -1; return; }
        int dev = 0, cus = 0, per_cu = 0;
        hipGetDevice(&dev); hipDeviceGetAttribute(&cus, hipDeviceAttributeMultiprocessorCount, dev);
        if (hipFuncSetAttribute((const void*)mega_fwd, hipFuncAttributeMaxDynamicSharedMemorySize, LDS_BYTES) != hipSuccess) { fprintf(stderr, "kernel_launch: hipFuncSetAttribute failed\n"); grid = -1; return; }
        if (hipOccupancyMaxActiveBlocksPerMultiprocessor(&per_cu, (const void*)mega_fwd, 512, LDS_BYTES) != hipSuccess || per_cu < 1) { fprintf(stderr, "kernel_launch: occupancy query says %d\n", per_cu); per_cu = 1; }
        (void)hipGetLastError();
        grid = cus;
    }
    if (grid < 0) return;
    Args a{};
    for (int i = 0; i < 23; ++i) a.in[i] = (const float*)d_in[i];
    a.out = (float*)d_out; a.ws = (unsigned char*)d_ws; a.lo = 0; a.hi = NPH;
    void* kargv[] = {&a};
    hipError_t e = hipLaunchCooperativeKernel((const void*)mega_fwd, dim3(grid), dim3(512), kargv, LDS_BYTES, stream);
    if (e != hipSuccess) fprintf(stderr, "kernel_launch: cooperative launch failed: %s (grid %d)\n", hipGetErrorString(e), grid);
}
```

```cpp
#include <hip/hip_runtime.h>
#include <hip/hip_cooperative_groups.h>
#include <cstdio>
#include <cstdint>
namespace cg = cooperative_groups;
#define otid() ({ int t_ = (int)threadIdx.x; asm volatile("" : "+v"(t_)); t_; })
extern __shared__ __attribute__((aligned(16))) unsigned char g_lds_dyn[];
#define ptid() (*(volatile __attribute__((address_space(3))) int*)((__attribute__((address_space(3))) unsigned char*)g_lds_dyn + 131072 + 1024 + 4 * (int)threadIdx.x))
namespace pg8 {
#define PG8_LAS __attribute__((address_space(3)))
typedef unsigned short bf16_t;
typedef short bf16x8 __attribute__((ext_vector_type(8)));
typedef float f32x4 __attribute__((ext_vector_type(4)));
typedef unsigned u32x4 __attribute__((ext_vector_type(4)));
constexpr int BM = 256, BK = 64, HALF = 128, HTB = HALF * BK * 2  , STAGE_BYTES = 8 * HTB, NXCD = 8, WGM = 8;

__host__ __device__ __forceinline__ int lds_byte(int r, int c) { const int st = (r >> 4) * 2 + (c >> 5), rr = r & 15, cc = c & 31, ob = rr * 64 + cc * 2; return st * 1024 + (ob ^ (((ob >> 9) & 1) << 5)); }
__host__ __device__ __forceinline__ void stage_rc(int b, int& R, int& C) { const int st = b / 1024, sb = b % 1024, swz = sb ^ (((sb >> 9) & 1) << 5); R = (st >> 1) * 16 + swz / 64; C = (st & 1) * 32 + (swz % 64) / 2; }
__host__ __device__ __forceinline__ int perm32(int rho) { const int n = rho >> 4, i = rho & 15; return 8 * (i >> 2) + 4 * n + (i & 3); }

struct Unit { int pm, pn, koff; };
struct Gemm { const bf16_t* A; const bf16_t* Bt; int M, N, K, ld; };

struct StaticOrder {
    int nM, nN, nwg, G, c, mode;
    __host__ __device__ void init(int M, int N, int G_, int c_, int mode_ = 0) { nM = M / BM; nN = N / BM; nwg = nM * nN; G = G_; c = c_; mode = mode_; }
    __host__ __device__ bool next(int i, Unit& u) const {
        const long L = (long)i * G + c; if (L >= nwg) return false;
        int wgid = (int)L; { const int q = nwg / NXCD, r = nwg % NXCD, xcd = wgid % NXCD, off = wgid / NXCD; wgid = (xcd < r ? xcd * (q + 1) : r * (q + 1) + (xcd - r) * q) + off; }
        const int nig = WGM * nN, gid = wgid / nig, fm = gid * WGM, gsz = (nM - fm) < WGM ? (nM - fm) : WGM;
        u.pm = fm + ((wgid % nig) % gsz); u.pn = (wgid % nig) / gsz; u.koff = 0; if (mode == 1) u.pm = (u.pm >> 3) * 9 + 1 + (u.pm & 7); return true;
    }
    __device__ __forceinline__ void a_ready(const Unit&) const {}
    __device__ __forceinline__ void done(const Unit&) const {}
};
struct CtxSplitOrder {
    int G, c, khalf;
    __device__ bool next(int i, Unit& u) const { const int L = i * G + c; if (L >= 64) return false; u.koff = (L & 1) * khalf; u.pn = (L >> 1) & 3; u.pm = (L >> 3) * 9; return true; }
    __device__ __forceinline__ void a_ready(const Unit&) const {}
    __device__ __forceinline__ void done(const Unit&) const {}
};

__device__ __forceinline__ unsigned cvt_pk_bf16(float lo, float hi) { unsigned r; asm volatile("v_cvt_pk_bf16_f32 %0, %1, %2" : "=v"(r) : "v"(lo), "v"(hi)); return r; }
typedef float f32x2 __attribute__((ext_vector_type(2)));
__device__ __forceinline__ f32x2 gelu_pk(f32x2 v) {
    const f32x2 av = __builtin_elementwise_abs(v), d = av * 0.2316418882f + 1.0f;
    f32x2 t; t.x = __builtin_amdgcn_rcpf(d.x); t.y = __builtin_amdgcn_rcpf(d.y);
    f32x2 q = t * 0.5307027145f + (-0.7265760135f); q = q * t + 0.7107068705f; q = q * t + (-0.142248368f); q = q * t + 0.127414796f; q = q * t;
    const f32x2 s = (v * v) * (-0.72134752044f);
    f32x2 e; e.x = __builtin_amdgcn_exp2f(s.x); e.y = __builtin_amdgcn_exp2f(s.y);
    const f32x2 m = v * (q * e), r = v - m;
    f32x2 o; o.x = v.x < 0.f ? m.x : r.x; o.y = v.y < 0.f ? m.y : r.y; return o;
}

template <int ACT  > struct EpiBf16 {
    static constexpr bool PERM = true, AFTER_DRAIN = false; static_assert(ACT == 0 || ACT == 1, "EpiBf16: ACT is 0 (none) or 1 (gelu_pk)");
    bf16_t* O; int ldc; const float* bias; int split_cols; size_t split_stride; float scale0;
    __device__ __forceinline__ void operator()(const f32x4 (&acc)[2][2][4][2], const Unit& u, int wr, int wc, int fr, int fq) const {
        const int row0 = u.pm * BM + wr * 64 + fr; int colt = u.pn * BM; bf16_t* base = O;
        float sc = 1.f; if (split_cols) { const int t = colt / split_cols; base += (size_t)t * split_stride; colt -= t * split_cols; if (t == 0) sc = scale0; }
        const int col0 = colt + wc * 32 + 8 * fq, bcol0 = u.pn * BM + wc * 32 + 8 * fq;
        f32x4 bv[2][2];
#pragma unroll
        for (int bj = 0; bj < 2; ++bj)
#pragma unroll
            for (int n = 0; n < 2; ++n) bv[bj][n] = bias ? *(const f32x4*)(bias + bcol0 + bj * HALF + 4 * n) : (f32x4){0.f, 0.f, 0.f, 0.f};
#pragma unroll
        for (int ai = 0; ai < 2; ++ai)
#pragma unroll
            for (int m = 0; m < 4; ++m) { bf16_t* rowp = base + (size_t)(row0 + ai * HALF + m * 16) * ldc + col0;
#pragma unroll
                for (int bj = 0; bj < 2; ++bj) { f32x4 v0 = acc[ai][bj][m][0] + bv[bj][0], v1 = acc[ai][bj][m][1] + bv[bj][1];
                    if (ACT == 1) { f32x2 a = gelu_pk((f32x2){v0[0], v0[1]}), b = gelu_pk((f32x2){v0[2], v0[3]}), c = gelu_pk((f32x2){v1[0], v1[1]}), d = gelu_pk((f32x2){v1[2], v1[3]});
                        v0 = (f32x4){a.x, a.y, b.x, b.y}; v1 = (f32x4){c.x, c.y, d.x, d.y}; }
                    v0 = v0 * sc; v1 = v1 * sc; u32x4 w; w.x = cvt_pk_bf16(v0[0], v0[1]); w.y = cvt_pk_bf16(v0[2], v0[3]); w.z = cvt_pk_bf16(v1[0], v1[1]); w.w = cvt_pk_bf16(v1[2], v1[3]);
                    { bf16_t* sp_ = rowp + bj * HALF; asm volatile("global_store_dwordx4 %0, %1, off sc1\n\ts_nop 1" :: "v"(sp_), "v"(w) : "memory"); } } }
    }
};
struct EpiResidSplit {
    static constexpr bool PERM = false, AFTER_DRAIN = false;
    bf16_t* X; float* T; const float* mod; int goff; const float* cin;
    __device__ __forceinline__ void operator()(const f32x4 (&acc)[2][2][4][2], const Unit& u, int wr, int wc, int fr, int fq) const {
        typedef unsigned u32x2_t __attribute__((ext_vector_type(2)));
        const float* gp = mod + 8 * 6144 + goff;
        const int col0 = u.pn * BM + wc * 32 + 4 * fq;
        const bool first = (u.koff == 0);
        bf16_t* xb = X + (size_t)(u.pm * BM) * 1024; float* tb = T + (size_t)((u.pm / 9) * BM) * 1024;
        const float* rbase = cin ? cin + (size_t)((u.pm / 9) * BM) * 1024 : nullptr;
#pragma unroll
        for (int bj = 0; bj < 2; ++bj)
#pragma unroll
            for (int n = 0; n < 2; ++n) { const f32x4 gv = *(const f32x4*)(gp + col0 + bj * HALF + n * 16);
#pragma unroll
                for (int ai = 0; ai < 2; ++ai)
#pragma unroll
                    for (int m = 0; m < 4; ++m) { const size_t o = (size_t)(ai * HALF + wr * 64 + m * 16 + fr) * 1024 + col0 + bj * HALF + n * 16;
                        f32x4 v = gv * acc[ai][bj][m][n];
                        if (first) { f32x4 x;
                            if (rbase) x = *(const f32x4*)(rbase + o);
                            else { const u32x2_t w = *(const u32x2_t*)(xb + o); x = (f32x4){__uint_as_float(w.x << 16), __uint_as_float(w.x & 0xffff0000u), __uint_as_float(w.y << 16), __uint_as_float(w.y & 0xffff0000u)}; }
                            v = v + x; u32x2_t r; r.x = cvt_pk_bf16(v[0], v[1]); r.y = cvt_pk_bf16(v[2], v[3]); *(u32x2_t*)(xb + o) = r; }
                        else *(f32x4*)(tb + o) = v; } }
    }
};
struct EpiSwiGLU {
    static constexpr bool PERM = true, AFTER_DRAIN = false;
    bf16_t* O; int ldc;
    __device__ __forceinline__ void operator()(const f32x4 (&acc)[2][2][4][2], const Unit& u, int wr, int wc, int fr, int fq) const {
        const int row0 = u.pm * BM + wr * 64 + fr; const int col0 = u.pn * HALF + wc * 32 + 8 * fq;
#pragma unroll
        for (int ai = 0; ai < 2; ++ai)
#pragma unroll
            for (int m = 0; m < 4; ++m) { bf16_t* rowp = O + (size_t)(row0 + ai * HALF + m * 16) * ldc + col0;
                float h[8];
#pragma unroll
                for (int n = 0; n < 2; ++n)
#pragma unroll
                    for (int i = 0; i < 4; ++i) { const float g = acc[ai][0][m][n][i], up = acc[ai][1][m][n][i];
                        h[n * 4 + i] = g * __builtin_amdgcn_rcpf(1.0f + __expf(-g)) * up; }
                u32x4 w; w.x = cvt_pk_bf16(h[0], h[1]); w.y = cvt_pk_bf16(h[2], h[3]); w.z = cvt_pk_bf16(h[4], h[5]); w.w = cvt_pk_bf16(h[6], h[7]);
                asm volatile("global_store_dwordx4 %0, %1, off sc1\n\ts_nop 1" :: "v"(rowp), "v"(w) : "memory"); }
    }
};
struct EpiResid {
    static constexpr bool PERM = false, AFTER_DRAIN = false;
    bf16_t* X; const float* mod; int goff; const float* xin;
    __device__ __forceinline__ void operator()(const f32x4 (&acc)[2][2][4][2], const Unit& u, int wr, int wc, int fr, int fq) const {
        typedef unsigned u32x2_t __attribute__((ext_vector_type(2)));
        const int widx = (u.pm % 9 == 0) ? 8 : (u.pm / 9);
        const float* gp = mod + widx * 6144 + goff;
        const int col0 = u.pn * BM + wc * 32 + 4 * fq;
        const float* rb = xin ? xin + (size_t)((u.pm / 9) * 2048 + (u.pm % 9 - 1) * 256) * 1024 : nullptr;
        bf16_t* wb = X + (size_t)(u.pm * BM) * 1024;
#pragma unroll
        for (int bj = 0; bj < 2; ++bj)
#pragma unroll
            for (int n = 0; n < 2; ++n) { const f32x4 gv = *(const f32x4*)(gp + col0 + bj * HALF + n * 16);
#pragma unroll
                for (int ai = 0; ai < 2; ++ai)
#pragma unroll
                    for (int m = 0; m < 4; ++m) { const size_t o = (size_t)(ai * HALF + wr * 64 + m * 16 + fr) * 1024 + col0 + bj * HALF + n * 16;
                        f32x4 x;
                        if (rb) x = *(const f32x4*)(rb + o);
                        else { const u32x2_t w = *(const u32x2_t*)(wb + o); x = (f32x4){__uint_as_float(w.x << 16), __uint_as_float(w.x & 0xffff0000u), __uint_as_float(w.y << 16), __uint_as_float(w.y & 0xffff0000u)}; }
                        x = x + gv * acc[ai][bj][m][n];
                        u32x2_t r; r.x = cvt_pk_bf16(x[0], x[1]); r.y = cvt_pk_bf16(x[2], x[3]); *(u32x2_t*)(wb + o) = r; } }
    }
};
template <class Epi, class Sched, bool ALIGN_EPI = false, bool SP2 = false>
__device__ __forceinline__ void gemm_phase(PG8_LAS unsigned char* lds, const Gemm g, const Sched& S, const Epi& E) {
    const int tid = otid(), wid = __builtin_amdgcn_readfirstlane(tid >> 6), lane = tid & 63, wr = wid >> 2, wc = wid & 3, fr = lane & 15, fq = lane >> 4;
    const int K = g.ld, nt = g.K / BK;
    unsigned voffA[2], voffB[2];
#pragma unroll
    for (int i = 0; i < 2; ++i) { int R, C; stage_rc(tid * 16 + i * 8192, R, C); const int Rb = Epi::PERM ? ((R & ~31) + perm32(R & 31)) : R;
        voffA[i] = (unsigned)(R * K + C) * 2u; voffB[i] = (unsigned)(Rb * K + C) * 2u; }
    const size_t kstep = (size_t)(BK * 2);
    const size_t hstep = (size_t)HALF * K * 2;
    const size_t tstep = 2 * hstep;
    const unsigned ldsw = (unsigned)wid * 1024u;
    const int aoff = lds_byte(wr * 64 + fr, fq * 8), boff = lds_byte(wc * 32 + fr, fq * 8);
#define PG8_SA(b, h) (((b) * 2 + (h)) * HTB)
#define PG8_SB(b, h) ((4 + (b) * 2 + (h)) * HTB)
#define PG8_STAGE(bufoff, gbase, voff) do { _Pragma("unroll") for (int _i = 0; _i < 2; ++_i) \
        __builtin_amdgcn_global_load_lds((const unsigned*)((const char*)(gbase) + (voff)[_i]), (PG8_LAS unsigned*)(lds + (bufoff) + ldsw + _i * 8192), 16, 0, 0); } while (0)
#define PG8_LDA(dst, b, h) do { _Pragma("unroll") for (int m = 0; m < 4; ++m) _Pragma("unroll") for (int k = 0; k < 2; ++k) dst[m][k] = *(const PG8_LAS bf16x8*)(lds + PG8_SA(b, h) + aoff + m * 2048 + k * 1024); } while (0)
#define PG8_LDB(dst, b, h) do { _Pragma("unroll") for (int n = 0; n < 2; ++n) _Pragma("unroll") for (int k = 0; k < 2; ++k) dst[n][k] = *(const PG8_LAS bf16x8*)(lds + PG8_SB(b, h) + boff + n * 2048 + k * 1024); } while (0)
#define PG8_MMA(ai, bj, At, Bt) do { __builtin_amdgcn_s_setprio(1); _Pragma("unroll") for (int m = 0; m < 4; ++m) _Pragma("unroll") for (int n = 0; n < 2; ++n) _Pragma("unroll") for (int k = 0; k < 2; ++k) \
        acc[ai][bj][m][n] = __builtin_amdgcn_mfma_f32_16x16x32_bf16(Bt[n][k], At[m][k], acc[ai][bj][m][n], 0, 0, 0); __builtin_amdgcn_s_setprio(0); } while (0)
#define PG8_WAIT_V(n) asm volatile("s_waitcnt vmcnt(" #n ")" ::: "memory")
#define PG8_WAIT_L(n) asm volatile("s_waitcnt lgkmcnt(" #n ")" ::: "memory")
#define PG8_BAR __builtin_amdgcn_s_barrier()
#define PG8_SCHED __builtin_amdgcn_sched_barrier(0)
    Unit cur, nxt; int ui = 0;
    if (!S.next(0, cur)) return;
    f32x4 acc[2][2][4][2];
#pragma unroll
    for (int a = 0; a < 2; ++a)
#pragma unroll
        for (int b = 0; b < 2; ++b)
#pragma unroll
            for (int m = 0; m < 4; ++m)
#pragma unroll
                for (int n = 0; n < 2; ++n) acc[a][b][m][n] = (f32x4){0.f, 0.f, 0.f, 0.f};
    bf16x8 At[4][2], B0[2][2], B1[2][2];
    const char* cA = (const char*)g.A + (size_t)cur.pm * tstep + (size_t)cur.koff * 2; const char* cB = (const char*)g.Bt + (size_t)cur.pn * tstep + (size_t)cur.koff * 2;
    S.a_ready(cur);
    if constexpr (SP2) {
        PG8_STAGE(PG8_SB(0, 0), cB, voffB); PG8_STAGE(PG8_SB(0, 1), cB + hstep, voffB); PG8_STAGE(PG8_SA(0, 0), cA, voffA); PG8_STAGE(PG8_SA(0, 1), cA + hstep, voffA);
        if (wr == 1) PG8_BAR;
        PG8_WAIT_V(2); PG8_BAR;
        PG8_STAGE(PG8_SB(1, 0), cB + kstep, voffB); PG8_STAGE(PG8_SA(1, 0), cA + kstep, voffA); PG8_STAGE(PG8_SB(1, 1), cB + hstep + kstep, voffB);
        PG8_WAIT_V(6); PG8_BAR;
    } else {
        PG8_STAGE(PG8_SB(0, 0), cB, voffB); PG8_STAGE(PG8_SA(0, 0), cA, voffA); PG8_STAGE(PG8_SB(0, 1), cB + hstep, voffB); PG8_STAGE(PG8_SA(0, 1), cA + hstep, voffA);
        if (wr == 1) PG8_BAR;
        PG8_WAIT_V(4); PG8_BAR;
        PG8_STAGE(PG8_SB(1, 0), cB + kstep, voffB); PG8_STAGE(PG8_SA(1, 0), cA + kstep, voffA); PG8_STAGE(PG8_SB(1, 1), cB + hstep + kstep, voffB);
        PG8_WAIT_V(6); PG8_BAR;
    }
    for (;;) {
        const bool has_next = S.next(ui + 1, nxt);
        const char* nA = has_next ? (const char*)g.A + (size_t)nxt.pm * tstep + (size_t)nxt.koff * 2 : cA; const char* nB = has_next ? (const char*)g.Bt + (size_t)nxt.pn * tstep + (size_t)nxt.koff * 2 : cB;
        for (int t = 0; t < nt; t += 2) {
            const bool last = (t == nt - 2);
            const char* a1 = cA + (size_t)(t + 1) * kstep;
            const char* a2 = last ? nA : cA + (size_t)(t + 2) * kstep; const char* b2 = last ? nB : cB + (size_t)(t + 2) * kstep;
            const char* a3 = a2 + kstep; const char* b3 = b2 + kstep;
            if (last && has_next) S.a_ready(nxt);
            if constexpr (SP2) {
            PG8_LDB(B0, 0, 0); PG8_LDB(B1, 0, 1); PG8_SCHED; PG8_LDA(At, 0, 0); PG8_STAGE(PG8_SA(1, 1), a1 + hstep, voffA);
            PG8_WAIT_V(8); PG8_WAIT_L(0); PG8_BAR; PG8_MMA(0, 0, At, B0); PG8_MMA(0, 1, At, B1); PG8_BAR; PG8_SCHED;
            PG8_LDA(At, 0, 1); PG8_STAGE(PG8_SB(0, 0), b2, voffB); PG8_STAGE(PG8_SB(0, 1), b2 + hstep, voffB); PG8_STAGE(PG8_SA(0, 0), a2, voffA);
            PG8_WAIT_V(8); PG8_WAIT_L(0); PG8_BAR; PG8_MMA(1, 0, At, B0); PG8_MMA(1, 1, At, B1); PG8_BAR; PG8_SCHED;
            PG8_LDB(B0, 1, 0); PG8_LDB(B1, 1, 1); PG8_SCHED; PG8_LDA(At, 1, 0); PG8_STAGE(PG8_SA(0, 1), a2 + hstep, voffA);
            PG8_WAIT_V(8); PG8_WAIT_L(0); PG8_BAR; PG8_MMA(0, 0, At, B0); PG8_MMA(0, 1, At, B1); PG8_BAR; PG8_SCHED;
            PG8_LDA(At, 1, 1); PG8_STAGE(PG8_SB(1, 0), b3, voffB); PG8_STAGE(PG8_SB(1, 1), b3 + hstep, voffB); PG8_STAGE(PG8_SA(1, 0), a3, voffA);
            PG8_WAIT_V(8); PG8_WAIT_L(0); PG8_BAR; PG8_MMA(1, 0, At, B0); PG8_MMA(1, 1, At, B1); PG8_BAR; PG8_SCHED;
            } else {
            PG8_LDB(B0, 0, 0); PG8_SCHED; PG8_LDA(At, 0, 0); PG8_STAGE(PG8_SA(1, 1), a1 + hstep, voffA);
            PG8_WAIT_L(8); PG8_BAR; PG8_WAIT_L(0); PG8_MMA(0, 0, At, B0); PG8_BAR; PG8_SCHED;
            PG8_LDB(B1, 0, 1); PG8_STAGE(PG8_SB(0, 0), b2, voffB);
            PG8_BAR; PG8_WAIT_L(0); PG8_MMA(0, 1, At, B1); PG8_BAR;
            PG8_LDA(At, 0, 1); PG8_STAGE(PG8_SA(0, 0), a2, voffA);
            PG8_BAR; PG8_WAIT_L(0); PG8_MMA(1, 0, At, B0); PG8_BAR; PG8_SCHED;
            PG8_STAGE(PG8_SB(0, 1), b2 + hstep, voffB);
            PG8_WAIT_V(6); PG8_BAR; PG8_MMA(1, 1, At, B1); PG8_BAR;
            PG8_LDB(B0, 1, 0); PG8_SCHED; PG8_LDA(At, 1, 0); PG8_STAGE(PG8_SA(0, 1), a2 + hstep, voffA);
            PG8_WAIT_L(8); PG8_BAR; PG8_WAIT_L(0); PG8_MMA(0, 0, At, B0); PG8_BAR; PG8_SCHED;
            PG8_LDB(B1, 1, 1); PG8_STAGE(PG8_SB(1, 0), b3, voffB);
            PG8_BAR; PG8_WAIT_L(0); PG8_MMA(0, 1, At, B1); PG8_BAR;
            PG8_LDA(At, 1, 1); PG8_STAGE(PG8_SA(1, 0), a3, voffA);
            PG8_BAR; PG8_WAIT_L(0); PG8_MMA(1, 0, At, B0); PG8_BAR; PG8_SCHED;
            PG8_STAGE(PG8_SB(1, 1), b3 + hstep, voffB);
            PG8_WAIT_V(6); PG8_BAR; PG8_MMA(1, 1, At, B1); PG8_BAR;
            }
        }
        if constexpr (ALIGN_EPI) { if (wr == 0) PG8_BAR; }
        if constexpr (!Epi::AFTER_DRAIN) { E(acc, cur, wr, wc, fr, fq); S.done(cur); }
        if (!has_next) break;
#pragma unroll
        for (int a = 0; a < 2; ++a)
#pragma unroll
            for (int b = 0; b < 2; ++b)
#pragma unroll
                for (int m = 0; m < 4; ++m)
#pragma unroll
                    for (int n = 0; n < 2; ++n) acc[a][b][m][n] = (f32x4){0.f, 0.f, 0.f, 0.f};
        cur = nxt; cA = nA; cB = nB; ++ui;
        if constexpr (ALIGN_EPI) { if (wr == 1) PG8_BAR; }
    }
    PG8_WAIT_V(0);
    if constexpr (!ALIGN_EPI) { if (wr == 0) PG8_BAR; }
    PG8_BAR;
    if constexpr (Epi::AFTER_DRAIN) { E.fused(acc, cur, wr, wc, fr, fq, lds, wid, lane); S.done(cur); }
#undef PG8_SA
#undef PG8_SB
#undef PG8_STAGE
#undef PG8_LDA
#undef PG8_LDB
#undef PG8_MMA
#undef PG8_WAIT_V
#undef PG8_WAIT_L
#undef PG8_BAR
#undef PG8_SCHED
}
}

typedef unsigned short bf16;
typedef short bf16x8 __attribute__((ext_vector_type(8)));
typedef short s16x4 __attribute__((ext_vector_type(4)));
typedef float f32x4 __attribute__((ext_vector_type(4)));
typedef float f32x16 __attribute__((ext_vector_type(16)));
typedef unsigned u32x4 __attribute__((ext_vector_type(4)));
typedef unsigned u32x2 __attribute__((ext_vector_type(2)));
#define LAS __attribute__((address_space(3)))

constexpr int NB = 8, TPB = 2304, MT = NB * TPB, DM = 1024, NLAT = 2048;
constexpr int NP_E = 3328, NP_O = 3072, FF = 2816;
constexpr float EPSN = 1e-6f;
constexpr size_t MiB = 1u << 20;
constexpr size_t WS_CTL = 0, WS_MOD = 1 * MiB, WS_X = 2 * MiB, WS_H = 74 * MiB, WS_MIX = 110 * MiB, WS_P = 146 * MiB, WS_W = 263 * MiB,
                 WS_OSC = 290 * MiB, WS_KR = 326 * MiB, WS_U = 328 * MiB, WS_T = 342 * MiB, WS_END = 350 * MiB;
constexpr size_t WS_LSUM = 128 * 1024;
constexpr size_t WS_CQN = WS_MIX, WS_CKVN = WS_MIX + 14 * MiB, WS_DSCR = WS_H;
constexpr size_t W_IN = 0, W_OUT = 13 * MiB / 2, W_GU = 17 * MiB / 2, W_DN = 39 * MiB / 2, W_UQ = 25 * MiB, W_UKV = 25 * MiB + 768 * 1024;
constexpr size_t OUT_KV = 0, OUT_Q = 36 * MiB;
constexpr int LDS_MAIN = 131072, LDS_BYTES = LDS_MAIN + 1024 + 2048;

struct Args { const float* in[23]; float* out; unsigned char* ws; int lo, hi; };
typedef __attribute__((address_space(4))) const Args* KArgP;
__device__ __forceinline__ KArgP kargs() { KArgP p = (KArgP)__builtin_amdgcn_kernarg_segment_ptr(); asm volatile("" : "+s"(p)); return p; }

__device__ __forceinline__ float bf2f(unsigned short h) { return __uint_as_float((unsigned)h << 16); }
__device__ __forceinline__ unsigned f2bf(float f) { unsigned u = __float_as_uint(f); return (u + 0x7fffu + ((u >> 16) & 1u)) >> 16; }
__device__ __forceinline__ unsigned pk2(float lo, float hi) { return f2bf(lo) | (f2bf(hi) << 16); }
__device__ __forceinline__ float wave_sum(float v) {
#pragma unroll
    for (int o = 1; o < 64; o <<= 1) v += __shfl_xor(v, o);
    return v;
}
__device__ __forceinline__ float silu_f(float g) { return g / (1.0f + __expf(-g)); }
__device__ __forceinline__ void sincos_r(float ang, float& s, float& c) {
    float r = ang * 0.15915494309189535f; r = r - __builtin_floorf(r);
    s = __builtin_amdgcn_sinf(r); c = __builtin_amdgcn_cosf(r);
}
__device__ __forceinline__ float inv_freq(int i, int half) { return __builtin_amdgcn_exp2f(-(float)i / (float)half * 13.287712379549449f); }

__device__ __forceinline__ void mod_item(KArgP a, int l, int cg, LAS unsigned char* lds) {
    const int tid = otid();
    float* MOD = (float*)(a->ws + WS_MOD);
    LAS float* S = (LAS float*)lds;
    LAS float* R = S + 1024 * 12;
    for (int i = tid; i < 9 * 1024; i += 512) { const int w = i >> 10, k = i & 1023; const float v = (w < 8) ? a->in[1][w * 1024 + k] : a->in[3][k]; S[k * 12 + w] = silu_f(v); }
    __syncthreads();
    const int nl = tid & 63, kp = tid >> 6, n0 = cg * 256;
    f32x4 acc[9];
#pragma unroll
    for (int w = 0; w < 9; ++w) acc[w] = (f32x4){0.f, 0.f, 0.f, 0.f};
    const float* wp = a->in[4] + (size_t)l * 1024 * 6144 + n0 + 4 * nl;
#pragma unroll 8
    for (int k = kp * 128; k < kp * 128 + 128; ++k) {
        const f32x4 wv = *(const f32x4*)(wp + (size_t)k * 6144);
        const f32x4 s0 = *(const LAS f32x4*)(S + k * 12), s1 = *(const LAS f32x4*)(S + k * 12 + 4); const float s8 = S[k * 12 + 8];
        acc[0] += wv * s0[0]; acc[1] += wv * s0[1]; acc[2] += wv * s0[2]; acc[3] += wv * s0[3];
        acc[4] += wv * s1[0]; acc[5] += wv * s1[1]; acc[6] += wv * s1[2]; acc[7] += wv * s1[3]; acc[8] += wv * s8;
    }
#pragma unroll
    for (int w = 0; w < 9; ++w) *(LAS f32x4*)(R + (kp * 9 + w) * 256 + 4 * nl) = acc[w];
    __syncthreads();
    for (int i = tid; i < 9 * 256; i += 512) { const int w = i >> 8, n2 = i & 255; float v = a->in[5][l * 6144 + n0 + n2];
#pragma unroll
        for (int p = 0; p < 8; ++p) v += R[(p * 9 + w) * 256 + n2];
        MOD[(size_t)(l * 9 + w) * 6144 + n0 + n2] = v; }
    __syncthreads();
}
__device__ __forceinline__ void phase_prep(KArgP a, LAS unsigned char* lds) {
    const int tid = otid(), G = gridDim.x;
    if (blockIdx.x == 0) { if (tid < 64) ((unsigned*)(a->ws + WS_CTL))[tid] = 0u; for (int i = tid; i < 3456; i += 512) ((unsigned*)(a->ws + WS_CTL))[4096 + i] = 0u; }
    for (int item = blockIdx.x; item < 96; item += G) mod_item(a, item / 24, item % 24, lds);
}

__device__ __forceinline__ void transpose_item(const float* W, int K, int N, bf16* WT, int k0, int n0, int drow0, LAS float* scr, int lane) {
#pragma unroll 8
    for (int i = 0; i < 32; ++i) { const int kk = 2 * i + (lane >> 5); scr[kk * 33 + (lane & 31)] = W[(size_t)(k0 + kk) * N + n0 + (lane & 31)]; }
    asm volatile("s_waitcnt lgkmcnt(0)" ::: "memory");
    const int c = lane & 7;
#pragma unroll
    for (int j = 0; j < 4; ++j) { const int n = (lane >> 3) + 8 * j; const LAS float* s = scr + (8 * c) * 33 + n;
        u32x4 o; o.x = pk2(s[0 * 33], s[1 * 33]); o.y = pk2(s[2 * 33], s[3 * 33]); o.z = pk2(s[4 * 33], s[5 * 33]); o.w = pk2(s[6 * 33], s[7 * 33]);
        *(u32x4*)(WT + (size_t)(drow0 + n) * K + k0 + 8 * c) = o; }
    asm volatile("s_waitcnt lgkmcnt(0)" ::: "memory");
}
__device__ __forceinline__ void convert_weights(KArgP a, int layer, LAS unsigned char* lds) {
    const int lane = otid() & 63, wave = otid() >> 6;
    LAS float* scr = (LAS float*)(lds + wave * 8448);
    const int gw = blockIdx.x * 8 + wave, NGW = gridDim.x * 8;
    const bool even = !(layer & 1); const int e = layer >> 1;
    const int nin = even ? 3232 : 3072;
    const float* w_in = even ? a->in[11] + (size_t)e * 1024 * 3232 : a->in[18] + (size_t)e * 1024 * 3072;
    unsigned char* Wb = a->ws + WS_W;
    const int nbin = nin / 32;
    const int I_IN = 16 * nbin, I_OUT = 512, I_G = 16 * 88, I_D = 44 * 32, I_UQ = even ? 6 * 24 : 0, I_UKV = even ? 4 * 32 : 0;
    const int NIT = I_IN + I_OUT + 2 * I_G + I_D + I_UQ + I_UKV;
    for (int it = gw; it < NIT; it += NGW) {
        int r = it;
        if (r < I_IN) { const int kb = r / nbin, nb = r % nbin; transpose_item(w_in, 1024, nin, (bf16*)(Wb + W_IN), 64 * kb, 32 * nb, 32 * nb, scr, lane); continue; } r -= I_IN;
        if (r < I_OUT) { const int kb = r / 32, nb = r % 32; transpose_item(a->in[7] + (size_t)layer * 1024 * 1024, 1024, 1024, (bf16*)(Wb + W_OUT), 64 * kb, 32 * nb, 32 * nb, scr, lane); continue; } r -= I_OUT;
        if (r < I_G) { const int kb = r / 88, nb = r % 88, n0 = 32 * nb; transpose_item(a->in[8] + (size_t)layer * 1024 * FF, 1024, FF, (bf16*)(Wb + W_GU), 64 * kb, n0, (n0 >> 7) * 256 + (n0 & 127), scr, lane); continue; } r -= I_G;
        if (r < I_G) { const int kb = r / 88, nb = r % 88, n0 = 32 * nb; transpose_item(a->in[9] + (size_t)layer * 1024 * FF, 1024, FF, (bf16*)(Wb + W_GU), 64 * kb, n0, (n0 >> 7) * 256 + 128 + (n0 & 127), scr, lane); continue; } r -= I_G;
        if (r < I_D) { const int kb = r / 32, nb = r % 32; transpose_item(a->in[10] + (size_t)layer * FF * 1024, FF, 1024, (bf16*)(Wb + W_DN), 64 * kb, 32 * nb, 32 * nb, scr, lane); continue; } r -= I_D;
        if (r < I_UQ) { const int kb = r / 24, nb = r % 24; transpose_item(a->in[15] + (size_t)e * 384 * 768, 384, 768, (bf16*)(Wb + W_UQ), 64 * kb, 32 * nb, 32 * nb, scr, lane); continue; } r -= I_UQ;
        { const int kb = r / 32, nb = r % 32; transpose_item(a->in[17] + (size_t)e * 256 * 1024, 256, 1024, (bf16*)(Wb + W_UKV), 64 * kb, 32 * nb, 32 * nb, scr, lane); }
    }
}

__device__ __forceinline__ f32x4 ld4_bf16(const bf16* p) { const u32x2 w = *(const u32x2*)p; return (f32x4){__uint_as_float(w.x << 16), __uint_as_float(w.x & 0xffff0000u), __uint_as_float(w.y << 16), __uint_as_float(w.y & 0xffff0000u)}; }
__device__ __forceinline__ void phase_norm(KArgP a, int layer, int which, bool addT) {
    const int lane = otid() & 63, wave = otid() >> 6;
    const int gw = blockIdx.x * 8 + wave, NGW = gridDim.x * 8;
    bf16* X = (bf16*)(a->ws + WS_X); bf16* H = (bf16*)(a->ws + WS_H); const float* T = (const float*)(a->ws + WS_T);
    const float* g = a->in[6] + (layer * 2 + which) * 1024;
    const float* mod = (const float*)(a->ws + WS_MOD) + (size_t)layer * 9 * 6144;
    const int shoff = which ? 3072 : 0, scoff = which ? 4096 : 1024;
    const bool from_inputs = (layer == 0 && which == 0);
    constexpr int RB = 3;
    for (int r0 = gw; r0 < MT; r0 += RB * NGW) {
        f32x4 v[RB][4];
#pragma unroll
        for (int k = 0; k < RB; ++k) { const int row = r0 + k * NGW; if (row < MT) {
            if (from_inputs) { const int b = row / TPB, j = row - b * TPB; const f32x4* xr = (const f32x4*)(j < 256 ? a->in[2] + (size_t)(b * 256 + j) * 1024 : a->in[0] + (size_t)(b * NLAT + j - 256) * 1024) + lane;
#pragma unroll
                for (int q = 0; q < 4; ++q) v[k][q] = xr[64 * q]; }
            else {
#pragma unroll
                for (int q = 0; q < 4; ++q) v[k][q] = ld4_bf16(X + (size_t)row * 1024 + 4 * lane + 256 * q); } } }
#pragma unroll
        for (int k = 0; k < RB; ++k) { const int row = r0 + k * NGW; if (row < MT) {
            const int b = row / TPB, j = row - b * TPB, widx = (j < 256) ? 8 : b;
            if (addT && j < 256) { const f32x4* tr = (const f32x4*)(T + (size_t)(b * 256 + j) * 1024) + lane;
#pragma unroll
                for (int q = 0; q < 4; ++q) { v[k][q] = v[k][q] + tr[64 * q]; u32x2 w; w.x = pk2(v[k][q][0], v[k][q][1]); w.y = pk2(v[k][q][2], v[k][q][3]); *(u32x2*)(X + (size_t)row * 1024 + 4 * lane + 256 * q) = w; } }
            float ss = 0.f;
#pragma unroll
            for (int q = 0; q < 4; ++q) ss += (v[k][q][0] * v[k][q][0] + v[k][q][1] * v[k][q][1]) + (v[k][q][2] * v[k][q][2] + v[k][q][3] * v[k][q][3]);
            const float rstd = __builtin_amdgcn_rsqf(wave_sum(ss) * (1.f / 1024.f) + EPSN);
#pragma unroll
            for (int q = 0; q < 4; ++q) { const int col = 4 * lane + 256 * q;
                const f32x4 gv = *(const f32x4*)(g + col), sc = *(const f32x4*)(mod + widx * 6144 + scoff + col), sh = *(const f32x4*)(mod + widx * 6144 + shoff + col);
                f32x4 y = v[k][q] * rstd * gv * (sc + 1.0f) + sh;
                u32x2 w; w.x = pk2(y[0], y[1]); w.y = pk2(y[2], y[3]);
                *(u32x2*)(H + (size_t)row * 1024 + col) = w; } } }
    }
}

__device__ __forceinline__ void phase_post_even(KArgP a, int layer) {
    const int lane = otid() & 63, wave = otid() >> 6;
    const int gw = blockIdx.x * 8 + wave, NGW = gridDim.x * 8, e = layer >> 1;
    const bf16* P = (const bf16*)(a->ws + WS_P); bf16* CQN = (bf16*)(a->ws + WS_CQN); bf16* CKVN = (bf16*)(a->ws + WS_CKVN); bf16* KR = (bf16*)(a->ws + WS_KR);
    const float* qg = a->in[14] + e * 384; const float* kg = a->in[16] + e * 256;
    for (int row = gw; row < MT; row += NGW) {
        const int b = row / TPB, j = row - b * TPB;
        const bf16* pr = P + (size_t)row * NP_E;
        {   float x[6]; float ss = 0.f;
#pragma unroll
            for (int k = 0; k < 3; ++k) { const unsigned w = *(const unsigned*)(pr + 2560 + 2 * lane + 128 * k); x[2 * k] = bf2f((unsigned short)(w & 0xffff)); x[2 * k + 1] = bf2f((unsigned short)(w >> 16)); ss += x[2 * k] * x[2 * k] + x[2 * k + 1] * x[2 * k + 1]; }
            const float rstd = __builtin_amdgcn_rsqf(wave_sum(ss) * (1.f / 384.f) + EPSN);
#pragma unroll
            for (int k = 0; k < 3; ++k) { const int col = 2 * lane + 128 * k; *(unsigned*)(CQN + (size_t)row * 384 + col) = pk2(x[2 * k] * rstd * qg[col], x[2 * k + 1] * rstd * qg[col + 1]); } }
        {   float x[4]; float ss = 0.f;
#pragma unroll
            for (int k = 0; k < 2; ++k) { const unsigned w = *(const unsigned*)(pr + 2944 + 2 * lane + 128 * k); x[2 * k] = bf2f((unsigned short)(w & 0xffff)); x[2 * k + 1] = bf2f((unsigned short)(w >> 16)); ss += x[2 * k] * x[2 * k] + x[2 * k + 1] * x[2 * k + 1]; }
            const float rstd = __builtin_amdgcn_rsqf(wave_sum(ss) * (1.f / 256.f) + EPSN);
#pragma unroll
            for (int k = 0; k < 2; ++k) { const int col = 2 * lane + 128 * k; *(unsigned*)(CKVN + (size_t)row * 256 + col) = pk2(x[2 * k] * rstd * kg[col], x[2 * k + 1] * rstd * kg[col + 1]); } }
        {   const int d = lane & 31; const float x = bf2f(pr[3200 + d]); const float xp = __shfl_xor(x, 8);
            float o = x;
            if (j >= 256) { const int t = j - 256, blk = d >> 4, wi = d & 15, i8 = wi & 7; const float pos = (float)(blk ? (t & 63) : (t >> 6));
                float s, c; sincos_r(pos * inv_freq(i8, 8), s, c);
                o = (wi < 8) ? (x * c - xp * s) : (xp * s + x * c); }
            if (lane < 32) KR[(size_t)row * 32 + d] = (bf16)f2bf(o); }
    }
}
__device__ __forceinline__ void phase_post_odd(KArgP a, int layer) {
    const int lane = otid() & 63, wave = otid() >> 6;
    const int gw = blockIdx.x * 8 + wave, NGW = gridDim.x * 8;
    bf16* P = (bf16*)(a->ws + WS_P);
    for (int row = gw; row < MT; row += NGW) {
        const int b = row / TPB, j = row - b * TPB; const bool lat = j >= 256; const int t = j - 256;
        bf16* pr = P + (size_t)row * NP_O;
#pragma unroll
        for (int u = 0; u < 2; ++u) { const int pid = lane + 64 * u, h = pid >> 5, i = pid & 31, d1 = h * 64 + i, d2 = d1 + 32;
            float s = 0.f, c = 1.f; if (lat) sincos_r((float)t * inv_freq(i, 32), s, c);
            const float q1 = bf2f(pr[d1]), q2 = bf2f(pr[d2]), k1 = bf2f(pr[256 + d1]) * 0.125f, k2 = bf2f(pr[256 + d2]) * 0.125f;
            if (lat) { pr[d1] = (bf16)f2bf(q1 * c - q2 * s); pr[d2] = (bf16)f2bf(q1 * s + q2 * c); }
            pr[256 + d1] = (bf16)f2bf(k1 * c - k2 * s); pr[256 + d2] = (bf16)f2bf(k1 * s + k2 * c); }
        if (lat) {
#pragma unroll
            for (int u = 0; u < 4; ++u) { const int pid = lane + 64 * u, vec = pid >> 5, pp = pid & 31, blk = pp >> 4, i = pp & 15, d1 = vec * 64 + blk * 32 + i, d2 = d1 + 16;
                const float pos = (float)(blk ? (t & 63) : (t >> 6)); float s, c; sincos_r(pos * inv_freq(i, 16), s, c);
                const float q1 = bf2f(pr[1536 + d1]), q2 = bf2f(pr[1536 + d2]), k1 = bf2f(pr[2048 + d1]), k2 = bf2f(pr[2048 + d2]);
                pr[1536 + d1] = (bf16)f2bf(q1 * c - q2 * s); pr[1536 + d2] = (bf16)f2bf(q1 * s + q2 * c);
                pr[2048 + d1] = (bf16)f2bf(k1 * c - k2 * s); pr[2048 + d2] = (bf16)f2bf(k1 * s + k2 * c); } }
    }
}

__device__ __forceinline__ void phase_readout(KArgP a, int layer) {
    const int lane = otid() & 63, wave = otid() >> 6;
    const int gw = blockIdx.x * 8 + wave, NGW = gridDim.x * 8;
    const bool even = !(layer & 1); const int np = even ? NP_E : NP_O, gcol = even ? 2048 : 1024;
    const bf16* P = (const bf16*)(a->ws + WS_P); const bf16* OF = (const bf16*)(a->ws + WS_OSC); const bf16* OB = OF + (size_t)MT * 512;
    bf16* MIX = (bf16*)(a->ws + WS_MIX);
    float g0 = 1.f, g1 = 1.f; if (even) { g0 = a->in[13][(layer >> 1) * 128 + 2 * lane]; g1 = a->in[13][(layer >> 1) * 128 + 2 * lane + 1]; }
    constexpr int RB = 3;
    for (int r0 = gw; r0 < MT; r0 += RB * NGW) {
        unsigned wf[RB][4], wb[RB][4], wg[RB][4];
#pragma unroll
        for (int k = 0; k < RB; ++k) { const int row = r0 + k * NGW; if (row < MT) {
#pragma unroll
            for (int h = 0; h < 4; ++h) { const int col = h * 128 + 2 * lane;
                wf[k][h] = *(const unsigned*)(OF + (size_t)row * 512 + col); wb[k][h] = *(const unsigned*)(OB + (size_t)row * 512 + col); wg[k][h] = *(const unsigned*)(P + (size_t)row * np + gcol + col); } } }
#pragma unroll
        for (int k = 0; k < RB; ++k) { const int row = r0 + k * NGW; if (row < MT) {
#pragma unroll
            for (int h = 0; h < 4; ++h) { const int col = h * 128 + 2 * lane;
                const float o0 = bf2f((unsigned short)(wf[k][h] & 0xffff)) + bf2f((unsigned short)(wb[k][h] & 0xffff)), o1 = bf2f((unsigned short)(wf[k][h] >> 16)) + bf2f((unsigned short)(wb[k][h] >> 16));
                const float rstd = __builtin_amdgcn_rsqf(wave_sum(o0 * o0 + o1 * o1) * (1.f / 128.f) + EPSN);
                const float y0 = o0 * rstd * g0 * silu_f(bf2f((unsigned short)(wg[k][h] & 0xffff))), y1 = o1 * rstd * g1 * silu_f(bf2f((unsigned short)(wg[k][h] >> 16)));
                *(unsigned*)(MIX + (size_t)row * 1024 + col) = pk2(y0, y1); } } }
    }
}
__device__ __forceinline__ void phase_final(KArgP a) {
    const int lane = otid() & 63, wave = otid() >> 6;
    const int gw = blockIdx.x * 8 + wave, NGW = gridDim.x * 8;
    const bf16* X = (const bf16*)(a->ws + WS_X); const float* g = a->in[22];
    constexpr int RB = 4;
    for (int r0 = gw; r0 < NB * NLAT; r0 += RB * NGW) {
        f32x4 v[RB][4];
#pragma unroll
        for (int k = 0; k < RB; ++k) { const int r = r0 + k * NGW; if (r < NB * NLAT) { const int row = (r >> 11) * TPB + 256 + (r & 2047);
#pragma unroll
            for (int q = 0; q < 4; ++q) v[k][q] = ld4_bf16(X + (size_t)row * 1024 + 4 * lane + 256 * q); } }
#pragma unroll
        for (int k = 0; k < RB; ++k) { const int r = r0 + k * NGW; if (r < NB * NLAT) { float ss = 0.f;
#pragma unroll
            for (int q = 0; q < 4; ++q) ss += (v[k][q][0] * v[k][q][0] + v[k][q][1] * v[k][q][1]) + (v[k][q][2] * v[k][q][2] + v[k][q][3] * v[k][q][3]);
            const float rstd = __builtin_amdgcn_rsqf(wave_sum(ss) * (1.f / 1024.f) + EPSN);
#pragma unroll
            for (int q = 0; q < 4; ++q) { const int col = 4 * lane + 256 * q; const f32x4 gv = *(const f32x4*)(g + col);
                *(f32x4*)(a->out + (size_t)r * 1024 + col) = v[k][q] * rstd * gv; } } }
    }
}
__device__ __forceinline__ unsigned cvtpk2(float lo, float hi) { unsigned r; asm("v_cvt_pk_bf16_f32 %0, %1, %2" : "=v"(r) : "v"(lo), "v"(hi)); return r; }
__device__ __forceinline__ f32x4 mfma16(bf16x8 a, bf16x8 b, f32x4 c) { return __builtin_amdgcn_mfma_f32_16x16x32_bf16(a, b, c, 0, 0, 0); }

template <int DK, bool HG, int MODE>
__device__ __forceinline__ void scan_item(KArgP a, int layer, int item, int seg, LAS unsigned char* lds) {
    const int tid = otid(), wid = tid >> 6, lane = tid & 63, l15 = lane & 15, q4 = lane >> 4;
    const int h = item & 3, dir = (item >> 2) & 1, b = item >> 3;
    constexpr int TPT = DK / 8, QS = DK * 2 + 16, TS = 144;
    constexpr int NP = HG ? NP_E : NP_O;
    LAS unsigned char* Lqt = lds; LAS unsigned char* Lkt = Lqt + 64 * QS; LAS unsigned char* Lqh = Lkt + 64 * QS;
    LAS unsigned char* LkhT = Lqh + 64 * QS; LAS unsigned char* LvT = LkhT + DK * TS; LAS unsigned char* Latt = LvT + 128 * TS;
    LAS float* Ltot = (LAS float*)(Latt + 64 * TS); LAS float* Lbl = Ltot + 512;
    const bf16* P = (const bf16*)(a->ws + WS_P);
    bf16* OSC = (bf16*)(a->ws + WS_OSC) + (size_t)dir * MT * 512;
    f32x4* Ub = (f32x4*)(a->ws + WS_U); float* Lb = (float*)(a->ws + WS_LSUM);
    const int c = tid & (DK - 1), tq = tid / DK;
    float lb = 0.f, lg = 0.f, qscale = 1.f; int qcol, zcol;
    if (HG) { qscale = 0.08838834764831845f; qcol = h * 128 + c; zcol = (dir ? 1536 : 1024) + h * 128 + c;
        if (layer >= 2) { const float l0 = a->in[12][(0 * 2 + dir) * 512 + h * 128 + c], l1 = a->in[12][(1 * 2 + dir) * 512 + h * 128 + c]; lb = 1.f / (1.f + __expf(l0 - l1)); } }
    else { qcol = h * 64 + c; zcol = 256 + h * 64 + c; const float x = a->in[19][((layer >> 1) * 2 + dir) * 4 + h]; lg = -__logf(1.f + __expf(-x)); }
    const int vcol = 512 + h * 128;
    const int rowbase = b * TPB;
    const int tv = lane, c8v = wid;
    unsigned short rq[TPT], rz[TPT]; bf16x8 rv[2];
#define SC_JB(ci) (dir ? ((ci) < 4 ? 255 - 64 * (ci) : 2303 - 64 * ((ci) - 4)) : 64 * (ci))
#define SC_LOAD(ci) do { const int jb_ = SC_JB(ci), sg_ = dir ? -1 : 1; \
        _Pragma("unroll") for (int i = 0; i < TPT; ++i) { const bf16* pr_ = P + (size_t)(rowbase + jb_ + sg_ * (tq * TPT + i)) * NP; if (MODE) rq[i] = pr_[qcol]; rz[i] = pr_[zcol]; } \
        { const bf16* pv_ = P + (size_t)(rowbase + jb_ + sg_ * tv) * NP + vcol; rv[0] = *(const bf16x8*)(pv_ + c8v * 8); rv[1] = *(const bf16x8*)(pv_ + (c8v + 8) * 8); } } while (0)
    f32x4 Sacc[DK / 16];
#pragma unroll
    for (int i = 0; i < DK / 16; ++i) Sacc[i] = (f32x4){0.f, 0.f, 0.f, 0.f};
    const int c0 = 9 * seg;
    SC_LOAD(c0);
    if (MODE) {
        for (int s_ = 0; s_ < seg; ++s_) {
#pragma unroll
            for (int i = 0; i < DK / 16; ++i) { f32x4 v = Sacc[i];
                if (s_ > 0) { const f32x4 l4 = *(const f32x4*)(Lb + (size_t)(item * 3 + s_) * 128 + 16 * i + 4 * q4); v[0] *= __expf(l4[0]); v[1] *= __expf(l4[1]); v[2] *= __expf(l4[2]); v[3] *= __expf(l4[3]); }
                Sacc[i] = v + Ub[((size_t)(item * 3 + s_) * (DK / 16) + i) * 512 + tid]; }
        }
    }
    float lsum = 0.f;
    for (int ci = c0; ci < c0 + 9; ++ci) {
#pragma unroll
        for (int u = 0; u < 2; ++u)
#pragma unroll
            for (int e = 0; e < 8; ++e) *(LAS unsigned short*)(LvT + ((c8v + 8 * u) * 8 + e) * TS + tv * 2) = (unsigned short)rv[u][e];
        float zf[TPT], qf[TPT];
#pragma unroll
        for (int i = 0; i < TPT; ++i) { zf[i] = bf2f(rz[i]); if (MODE) qf[i] = bf2f(rq[i]) * qscale; }
        const int jb = SC_JB(ci), sg = dir ? -1 : 1;
        if (ci + 1 < c0 + 9) SC_LOAD(ci + 1);
        float kk_[TPT], e1v[TPT], e2v[TPT]; float Eref, Ebr, dlast;
        if (HG) {
            float fv[TPT];
#pragma unroll
            for (int i = 0; i < TPT; ++i) { const float z = fminf(fmaxf(zf[i], -30.f), 30.f);
                const float t = __expf(-fabsf(z)), r = __builtin_amdgcn_rcpf(1.f + t), tr = t * r;
                const float sig = z >= 0.f ? r : tr, sigm = z >= 0.f ? tr : r;
                kk_[i] = (1.f - lb) * sigm; fv[i] = lb + (1.f - lb) * sig; }
            float run = 1.f;
            if (tq < 2) {
#pragma unroll
                for (int i = TPT - 1; i >= 0; --i) { e2v[i] = run; run *= fv[i]; }
            } else {
#pragma unroll
                for (int i = 0; i < TPT; ++i) { run *= fv[i]; e1v[i] = run; }
            }
            Ltot[tq * 128 + c] = run;
            __syncthreads();
            const float t0 = Ltot[c], t1 = Ltot[128 + c], t2 = Ltot[256 + c], t3 = Ltot[384 + c];
            Eref = t0 * t1; Ebr = t2 * t3; dlast = Eref * Ebr;
            const float mul = (tq == 0) ? t1 : ((tq == 3) ? t2 : 1.f);
            if (tq < 2) {
#pragma unroll
                for (int i = 0; i < TPT; ++i) { e2v[i] = fmaxf(e2v[i] * mul, 1e-30f); if (MODE) e1v[i] = __builtin_amdgcn_rcpf(e2v[i]); }
            } else {
#pragma unroll
                for (int i = 0; i < TPT; ++i) { e1v[i] = fmaxf(e1v[i] * mul, 1e-30f); e2v[i] = __builtin_amdgcn_rcpf(e1v[i]); }
            }
            lsum += __logf(fmaxf(dlast, 1e-37f));
        } else {
#pragma unroll
            for (int i = 0; i < TPT; ++i) { kk_[i] = zf[i]; e1v[i] = __expf((float)(tq * TPT + i - 31) * lg); e2v[i] = __builtin_amdgcn_rcpf(e1v[i]); }
            Eref = __expf(32.f * lg); Ebr = Eref; dlast = Eref * Ebr;
            lsum += 64.f * lg;
        }
        unsigned short kh[TPT];
        if (MODE) {
#pragma unroll
            for (int i = 0; i < TPT; ++i) { const int tau = tq * TPT + i;
                const float qt = qf[i] * e1v[i], kt = kk_[i] * e2v[i];
                const unsigned wq = cvtpk2(qt, qt * Eref), wk = cvtpk2(kt, kt * Ebr);
                *(LAS unsigned short*)(Lqt + tau * QS + c * 2) = (unsigned short)(wq & 0xffff);
                *(LAS unsigned short*)(Lqh + tau * QS + c * 2) = (unsigned short)(wq >> 16);
                *(LAS unsigned short*)(Lkt + tau * QS + c * 2) = (unsigned short)(wk & 0xffff);
                kh[i] = (unsigned short)(wk >> 16); }
        } else {
#pragma unroll
            for (int i = 0; i < TPT; ++i) kh[i] = (unsigned short)(cvtpk2(kk_[i] * e2v[i] * Ebr, 0.f) & 0xffff);
        }
#pragma unroll
        for (int i8 = 0; i8 < TPT / 8; ++i8) { u32x4 w; w.x = kh[8 * i8] | ((unsigned)kh[8 * i8 + 1] << 16); w.y = kh[8 * i8 + 2] | ((unsigned)kh[8 * i8 + 3] << 16);
            w.z = kh[8 * i8 + 4] | ((unsigned)kh[8 * i8 + 5] << 16); w.w = kh[8 * i8 + 6] | ((unsigned)kh[8 * i8 + 7] << 16);
            *(LAS u32x4*)(LkhT + c * TS + (tq * TPT + 8 * i8) * 2) = w; }
        if (tq == 0) Lbl[c] = dlast;
        __syncthreads();
        const int dvl = 16 * wid + l15;
        const bf16x8 bv0 = *(const LAS bf16x8*)(LvT + dvl * TS + (8 * q4) * 2), bv1 = *(const LAS bf16x8*)(LvT + dvl * TS + (32 + 8 * q4) * 2);
        if (MODE) {
#pragma unroll
            for (int tt = 0; tt < 2; ++tt) { const int idx = 2 * wid + tt, si = idx >> 2, ti = idx & 3;
                f32x4 acc = (f32x4){0.f, 0.f, 0.f, 0.f};
#pragma unroll
                for (int kk = 0; kk < DK / 32; ++kk) { const bf16x8 A = *(const LAS bf16x8*)(Lkt + (16 * si + l15) * QS + (32 * kk + 8 * q4) * 2);
                    const bf16x8 B = *(const LAS bf16x8*)(Lqt + (16 * ti + l15) * QS + (32 * kk + 8 * q4) * 2); acc = mfma16(A, B, acc); }
                const int t = 16 * ti + l15, s0 = 16 * si + 4 * q4;
                u32x2 w; w.x = pk2(s0 + 0 <= t ? acc[0] : 0.f, s0 + 1 <= t ? acc[1] : 0.f); w.y = pk2(s0 + 2 <= t ? acc[2] : 0.f, s0 + 3 <= t ? acc[3] : 0.f);
                *(LAS u32x2*)(Latt + t * TS + s0 * 2) = w; }
            __syncthreads();
            bf16x8 Sb[DK / 32];
#pragma unroll
            for (int kk = 0; kk < DK / 32; ++kk) { u32x4 w; w.x = pk2(Sacc[2 * kk][0], Sacc[2 * kk][1]); w.y = pk2(Sacc[2 * kk][2], Sacc[2 * kk][3]);
                w.z = pk2(Sacc[2 * kk + 1][0], Sacc[2 * kk + 1][1]); w.w = pk2(Sacc[2 * kk + 1][2], Sacc[2 * kk + 1][3]); Sb[kk] = __builtin_bit_cast(bf16x8, w); }
#pragma unroll
            for (int ti = 0; ti < 4; ++ti) {
                f32x4 acc = (f32x4){0.f, 0.f, 0.f, 0.f};
                { const bf16x8 A = *(const LAS bf16x8*)(Latt + (16 * ti + l15) * TS + (8 * q4) * 2); acc = mfma16(A, bv0, acc); }
                if (ti >= 2) { const bf16x8 A = *(const LAS bf16x8*)(Latt + (16 * ti + l15) * TS + (32 + 8 * q4) * 2); acc = mfma16(A, bv1, acc); }
#pragma unroll
                for (int kk = 0; kk < DK / 32; ++kk) {
                    const s16x4 lo = *(const LAS s16x4*)(Lqh + (16 * ti + l15) * QS + (32 * kk + 4 * q4) * 2), hi = *(const LAS s16x4*)(Lqh + (16 * ti + l15) * QS + (32 * kk + 16 + 4 * q4) * 2);
                    const bf16x8 A = (bf16x8){lo[0], lo[1], lo[2], lo[3], hi[0], hi[1], hi[2], hi[3]};
                    acc = mfma16(A, Sb[kk], acc); }
#pragma unroll
                for (int r = 0; r < 4; ++r) { const int t = 16 * ti + 4 * q4 + r;
                    OSC[(size_t)(rowbase + jb + sg * t) * 512 + h * 128 + dvl] = (bf16)f2bf(acc[r]); }
            }
        }
#pragma unroll
        for (int i = 0; i < DK / 16; ++i) {
            const f32x4 d4 = *(const LAS f32x4*)(Lbl + 16 * i + 4 * q4);
            f32x4 s = Sacc[i] * d4;
            const bf16x8 A0 = *(const LAS bf16x8*)(LkhT + (16 * i + l15) * TS + (8 * q4) * 2), A1 = *(const LAS bf16x8*)(LkhT + (16 * i + l15) * TS + (32 + 8 * q4) * 2);
            s = mfma16(A0, bv0, s); s = mfma16(A1, bv1, s); Sacc[i] = s; }
        __syncthreads();
    }
    if (!MODE) {
#pragma unroll
        for (int i = 0; i < DK / 16; ++i) Ub[((size_t)(item * 3 + seg) * (DK / 16) + i) * 512 + tid] = Sacc[i];
        if (tq == 0) Lb[(size_t)(item * 3 + seg) * 128 + c] = lsum;
    }
#undef SC_JB
#undef SC_LOAD
}

#define SBAR() __builtin_amdgcn_sched_barrier(0)
__device__ __forceinline__ int crow(int r, int hi) { return (r & 3) + 8 * (r >> 2) + 4 * hi; }
__device__ __forceinline__ unsigned cvtpk(float lo, float hi) { unsigned r; asm volatile("v_cvt_pk_bf16_f32 %0, %1, %2" : "=v"(r) : "v"(lo), "v"(hi)); return r; }
__device__ __forceinline__ void partialSM(f32x16& p0, f32x16& p1, float& m_reg, float& mn, float& alpha, float C, float thr_raw) {
    float pmax = p0[0];
#pragma unroll
    for (int r = 1; r < 16; ++r) pmax = fmaxf(pmax, p0[r]);
#pragma unroll
    for (int r = 0; r < 16; ++r) pmax = fmaxf(pmax, p1[r]);
    { auto rr = __builtin_amdgcn_permlane32_swap(__float_as_uint(pmax), __float_as_uint(pmax), false, false);
      pmax = fmaxf(__uint_as_float(rr[0]), __uint_as_float(rr[1])); }
    if (__builtin_expect(__all(pmax - m_reg <= thr_raw), 1)) { mn = m_reg; alpha = 1.f; }
    else { mn = fmaxf(m_reg, pmax); alpha = __builtin_amdgcn_exp2f((m_reg - mn) * C); m_reg = mn; }
    const float mnC = -mn * C;
#pragma unroll
    for (int r = 0; r < 16; ++r) p0[r] = fmaf(p0[r], C, mnC);
#pragma unroll
    for (int r = 0; r < 16; ++r) p1[r] = fmaf(p1[r], C, mnC);
#pragma unroll
    for (int r = 0; r < 16; ++r) p0[r] = __builtin_amdgcn_exp2f(p0[r]);
}
__device__ __forceinline__ void finishSM(f32x16& p0, f32x16& p1, float alpha, float& l_reg, bf16x8& pa0, bf16x8& pa1, bf16x8& pa2, bf16x8& pa3) {
#pragma unroll
    for (int r = 0; r < 16; ++r) p1[r] = __builtin_amdgcn_exp2f(p1[r]);
    float ps = 0;
#pragma unroll
    for (int r = 0; r < 16; ++r) ps += p0[r];
#pragma unroll
    for (int r = 0; r < 16; ++r) ps += p1[r];
    { auto rr = __builtin_amdgcn_permlane32_swap(__float_as_uint(ps), __float_as_uint(ps), false, false);
      ps = __uint_as_float(rr[0]) + __uint_as_float(rr[1]); }
    l_reg = l_reg * alpha + ps;
#define PK4(P, BASE, OUT) do { unsigned a0 = cvtpk(P[BASE + 0], P[BASE + 1]), a1 = cvtpk(P[BASE + 2], P[BASE + 3]);   \
    unsigned b0 = cvtpk(P[BASE + 4], P[BASE + 5]), b1 = cvtpk(P[BASE + 6], P[BASE + 7]);                              \
    auto r0 = __builtin_amdgcn_permlane32_swap(a0, b0, false, false); auto r1 = __builtin_amdgcn_permlane32_swap(a1, b1, false, false); \
    u32x4 w = {r0[0], r1[0], r0[1], r1[1]}; OUT = __builtin_bit_cast(bf16x8, w); } while (0)
    PK4(p0, 0, pa0); PK4(p0, 8, pa1); PK4(p1, 0, pa2); PK4(p1, 8, pa3);
#undef PK4
}
template <int ND0, int KROWB>
__device__ __forceinline__ void qkt(f32x16& p0, f32x16& p1, const char* Ks, const bf16x8* qr, int r32, int hi) {
    p0 = f32x16{}; p1 = f32x16{};
#pragma unroll
    for (int d0 = 0; d0 < ND0; ++d0) { const int cb = (d0 * 16 + hi * 8) * 2;
        const bf16x8 b0 = *reinterpret_cast<const bf16x8*>(Ks + r32 * KROWB + (cb ^ ((r32 & 7) << 4)));
        const bf16x8 b1 = *reinterpret_cast<const bf16x8*>(Ks + (32 + r32) * KROWB + (cb ^ ((r32 & 7) << 4)));
        p0 = __builtin_amdgcn_mfma_f32_32x32x16_bf16(b0, qr[d0], p0, 0, 0, 0);
        p1 = __builtin_amdgcn_mfma_f32_32x32x16_bf16(b1, qr[d0], p1, 0, 0, 0); }
}
template <int NCB> __device__ __forceinline__ int v_st(int k, int c) { const int kk = (k & ~0xC) | ((k & 4) << 1) | ((k & 8) >> 1); return ((kk >> 3) * NCB + (c >> 5)) * 512 + ((kk & 7) * 32 + (c & 31)) * 2; }
__device__ __forceinline__ int v_rd_base(int lane) { return ((lane & 3) << 3) | (((lane >> 2) & 3) << 6) | (((lane >> 4) & 1) << 5) | (((lane >> 5) & 1) << 8); }
template <int OFF> __device__ __forceinline__ s16x4 tr_read(int vb) {
    s16x4 r; asm volatile("ds_read_b64_tr_b16 %0, %1 offset:%2" : "=&v"(r) : "v"(vb), "i"(OFF) : "memory"); return r;
}
template <int NCB, int D0> __device__ __forceinline__ void pv_one(f32x16& od, int vb, bf16x8 pa0, bf16x8 pa1, bf16x8 pa2, bf16x8 pa3) {
#define VOFF(ks, half) (D0 * 512 + (ks) * (NCB * 1024) + (half) * (NCB * 512))
    const s16x4 l0 = tr_read<VOFF(0, 0)>(vb), h0 = tr_read<VOFF(0, 1)>(vb), l1 = tr_read<VOFF(1, 0)>(vb), h1 = tr_read<VOFF(1, 1)>(vb);
    const s16x4 l2 = tr_read<VOFF(2, 0)>(vb), h2 = tr_read<VOFF(2, 1)>(vb), l3 = tr_read<VOFF(3, 0)>(vb), h3 = tr_read<VOFF(3, 1)>(vb);
#undef VOFF
    asm volatile("s_waitcnt lgkmcnt(0)" ::: "memory"); SBAR();
#define PK(L, H) (bf16x8){L[0], L[1], L[2], L[3], H[0], H[1], H[2], H[3]}
    od = __builtin_amdgcn_mfma_f32_32x32x16_bf16(pa0, PK(l0, h0), od, 0, 0, 0);
    od = __builtin_amdgcn_mfma_f32_32x32x16_bf16(pa1, PK(l1, h1), od, 0, 0, 0);
    od = __builtin_amdgcn_mfma_f32_32x32x16_bf16(pa2, PK(l2, h2), od, 0, 0, 0);
    od = __builtin_amdgcn_mfma_f32_32x32x16_bf16(pa3, PK(l3, h3), od, 0, 0, 0);
#undef PK
}
template <int NCB> __device__ __forceinline__ void pv_all(f32x16* o, int vb, bf16x8 pa0, bf16x8 pa1, bf16x8 pa2, bf16x8 pa3) {
    pv_one<NCB, 0>(o[0], vb, pa0, pa1, pa2, pa3); pv_one<NCB, 1>(o[1], vb, pa0, pa1, pa2, pa3);
    if constexpr (NCB == 4) { pv_one<NCB, 2>(o[2], vb, pa0, pa1, pa2, pa3); pv_one<NCB, 3>(o[3], vb, pa0, pa1, pa2, pa3); }
}

template <int DQK, int DV, int KROWB>
__device__ __forceinline__ void attn_core(const bf16x8* qr, const bf16* kA, int sA, const bf16* kB, int sB, const bf16* vP, int sV,
                                          int NT, float C, float thr_raw, char* lds, f32x16* o, float& l_out, const int tid) {
    constexpr int NCB = DV / 32, SHM_V = 64 * DV * 2, SHM_K = 64 * KROWB, ND0 = DQK / 16;
    constexpr int PPR = DQK / 8, NPK = 64 * PPR, NKS = (NPK + 511) / 512, VPR = DV / 8, NVS = 64 * VPR / 512;
    const int wid = tid >> 6, lane = tid & 63, r32 = lane & 31, hi = lane >> 5;
    char* V_lds = lds; char* K_lds = lds + 2 * SHM_V;
    float* wsf = (float*)(lds + 2 * SHM_V + 2 * SHM_K) + wid * 64; float* al_l = wsf + 32;
    float m_reg = -1e30f, l_reg = 0;
    const bf16* kp[NKS]; int kadv[NKS], kst[NKS]; bool kval[NKS];
#pragma unroll
    for (int i = 0; i < NKS; ++i) { int p = tid + 512 * i; kval[i] = p < NPK; if (!kval[i]) p -= 512; const int row = p / PPR, c8 = p - row * PPR;
        if (c8 < 8) { kp[i] = kA + (size_t)row * sA + c8 * 8; kadv[i] = 64 * sA; } else { kp[i] = kB + (size_t)row * sB + (c8 - 8) * 8; kadv[i] = 64 * sB; }
        kst[i] = row * KROWB + ((c8 * 16) ^ ((row & 7) << 4)); }
    const bf16* vp[NVS]; int vst[NVS];
#pragma unroll
    for (int i = 0; i < NVS; ++i) { const int p = tid + 512 * i, row = p / VPR, c8 = p % VPR; vp[i] = vP + (size_t)row * sV + c8 * 8; vst[i] = v_st<NCB>(row, c8 * 8); }
    const int vadv = 64 * sV;
    const int vb0 = (int)(uintptr_t)V_lds + v_rd_base(lane);
    struct { bf16x8 ks[NKS]; bf16x8 vs[NVS]; } sr_[1];
#define SLOAD(i, t) do { _Pragma("unroll") for (int s_ = 0; s_ < NKS; ++s_) sr_[i].ks[s_] = *(const bf16x8*)(kp[s_] + (size_t)(t) * kadv[s_]); \
        _Pragma("unroll") for (int s_ = 0; s_ < NVS; ++s_) sr_[i].vs[s_] = *(const bf16x8*)(vp[s_] + (size_t)(t) * vadv); } while (0)
#define SWRITE(b, i) do { _Pragma("unroll") for (int s_ = 0; s_ < NVS; ++s_) *(bf16x8*)(V_lds + (b) * SHM_V + vst[s_]) = sr_[i].vs[s_]; \
        _Pragma("unroll") for (int s_ = 0; s_ < NKS; ++s_) if (kval[s_]) *(bf16x8*)(K_lds + (b) * SHM_K + kst[s_]) = sr_[i].ks[s_]; } while (0)
#define RESC(a) do { if (__any((a) < 1.f)) { if (hi == 0) al_l[r32] = (a); asm volatile("s_waitcnt lgkmcnt(0)" ::: "memory"); \
        _Pragma("unroll") for (int d = 0; d < NCB; ++d) _Pragma("unroll") for (int r = 0; r < 16; ++r) o[d][r] *= al_l[crow(r, hi)]; } } while (0)
    f32x16 pA0, pA1, pB0, pB1; float mnA, mnB, alA, alB; bf16x8 pa0, pa1, pa2, pa3;
    constexpr int SE = 0, SO = 0;
    SLOAD(SE, 0); SWRITE(0, SE); __syncthreads();
    qkt<ND0, KROWB>(pA0, pA1, K_lds, qr, r32, hi); partialSM(pA0, pA1, m_reg, mnA, alA, C, thr_raw);
    SLOAD(SO, 1);
    SWRITE(1, SO); __syncthreads();
    for (int j = 1; j + 1 < NT; j += 2) {
        SBAR(); qkt<ND0, KROWB>(pB0, pB1, K_lds + SHM_K, qr, r32, hi);
        finishSM(pA0, pA1, alA, l_reg, pa0, pa1, pa2, pa3); SBAR();
        SLOAD(SO, j + 1); SBAR();
        pv_all<NCB>(o, vb0, pa0, pa1, pa2, pa3); partialSM(pB0, pB1, m_reg, mnB, alB, C, thr_raw);
        __syncthreads(); SWRITE(0, SE);
        RESC(alB); __syncthreads();
        SBAR(); qkt<ND0, KROWB>(pA0, pA1, K_lds, qr, r32, hi);
        finishSM(pB0, pB1, alB, l_reg, pa0, pa1, pa2, pa3); SBAR();
        SLOAD(SE, j + 2); SBAR();
        pv_all<NCB>(o, vb0 + SHM_V, pa0, pa1, pa2, pa3); partialSM(pA0, pA1, m_reg, mnA, alA, C, thr_raw);
        __syncthreads(); SWRITE(1, SO);
        RESC(alA); __syncthreads();
    }
    SBAR(); qkt<ND0, KROWB>(pB0, pB1, K_lds + SHM_K, qr, r32, hi);
    finishSM(pA0, pA1, alA, l_reg, pa0, pa1, pa2, pa3); SBAR();
    pv_all<NCB>(o, vb0, pa0, pa1, pa2, pa3); partialSM(pB0, pB1, m_reg, mnB, alB, C, thr_raw);
    __syncthreads(); RESC(alB);
    finishSM(pB0, pB1, alB, l_reg, pa0, pa1, pa2, pa3); SBAR();
    pv_all<NCB>(o, vb0 + SHM_V, pa0, pa1, pa2, pa3);
    l_out = l_reg;
#undef SLOAD
#undef SWRITE
#undef RESC
}

__device__ __forceinline__ void mla_item(KArgP a, int b, int h, int qb, char* lds) {
    const int tid = ptid(), wid = tid >> 6, lane = tid & 63, r32 = lane & 31, hi = lane >> 5;
    const bf16* Qb = (const bf16*)((const unsigned char*)a->out + OUT_Q); const bf16* KV = (const bf16*)((const unsigned char*)a->out + OUT_KV);
    const bf16* KR = (const bf16*)(a->ws + WS_KR); bf16* MIX = (bf16*)(a->ws + WS_MIX);
    const int row0 = b * TPB + qb * 256, krow0 = b * TPB, NT = qb ? 36 : 4;
    const int row = row0 + wid * 32 + r32;
    const bf16* Qw = Qb + (size_t)row * 768 + h * 96;
    bf16x8 qr[6];
#pragma unroll
    for (int d0 = 0; d0 < 4; ++d0) qr[d0] = *(const bf16x8*)(Qw + d0 * 16 + hi * 8);
    const int t = (qb - 1) * 256 + wid * 32 + r32;
#pragma unroll
    for (int d0 = 4; d0 < 6; ++d0) {
        const bf16x8 x1 = *(const bf16x8*)(Qw + d0 * 16), x2 = *(const bf16x8*)(Qw + d0 * 16 + 8);
        if (qb) { const float pos = (float)(d0 == 4 ? (t >> 6) : (t & 63)); unsigned short ov[8];
#pragma unroll
            for (int i = 0; i < 8; ++i) { float s, c; sincos_r(pos * inv_freq(i, 8), s, c); const float f1 = bf2f((unsigned short)x1[i]), f2 = bf2f((unsigned short)x2[i]);
                ov[i] = (unsigned short)f2bf(hi ? (f1 * s + f2 * c) : (f1 * c - f2 * s)); }
            qr[d0] = (bf16x8){(short)ov[0], (short)ov[1], (short)ov[2], (short)ov[3], (short)ov[4], (short)ov[5], (short)ov[6], (short)ov[7]};
        } else qr[d0] = hi ? x2 : x1;
    }
    f32x16 o[2] = {}; float l_reg;
    const float scale = 0.10206207261596575f;
    attn_core<96, 64, 256>(qr, KV + (size_t)krow0 * 1024 + h * 128, 1024, KR + (size_t)krow0 * 32, 32, KV + (size_t)krow0 * 1024 + h * 128 + 64, 1024,
                           NT, scale * 1.4426950408889634f, 8.f / scale, lds, o, l_reg, tid);
    float* li_l = (float*)(lds + 2 * 64 * 64 * 2 + 2 * 64 * 256) + wid * 64;
    if (hi == 0) li_l[r32] = l_reg; asm volatile("s_waitcnt lgkmcnt(0)" ::: "memory");
#pragma unroll
    for (int r = 0; r < 16; ++r) { const int orow = crow(r, hi); const float rl = __builtin_amdgcn_rcpf(li_l[orow]);
        bf16* op = MIX + (size_t)(row0 + wid * 32 + orow) * 1024 + 512 + h * 64 + r32;
        op[0] = (bf16)f2bf(o[0][r] * rl); op[32] = (bf16)f2bf(o[1][r] * rl); }
}
__device__ __forceinline__ void diff_item(KArgP a, int layer, int b, int h, int qb, char* lds) {
    const int row0 = b * TPB + qb * 256, krow0 = b * TPB, NT = qb ? 36 : 4, o_ = layer >> 1;
    const float scale = 0.125f;
#pragma unroll 1
    for (int m = 0; m < 2; ++m) {
        f32x16 o[4] = {};
        float l_reg;
        {
            const int tid = ptid(), wid = tid >> 6, lane = tid & 63, r32 = lane & 31, hi = lane >> 5;
            const bf16* P = (const bf16*)(a->ws + WS_P);
            const bf16* Qw = P + (size_t)(row0 + wid * 32 + r32) * NP_O + 1536 + h * 128 + m * 64;
            bf16x8 qr[4];
#pragma unroll
            for (int d0 = 0; d0 < 4; ++d0) qr[d0] = *(const bf16x8*)(Qw + d0 * 16 + hi * 8);
            const bf16* Kp = P + (size_t)krow0 * NP_O + 2048 + h * 128 + m * 64;
            attn_core<64, 128, 128>(qr, Kp, NP_O, Kp, NP_O, P + (size_t)krow0 * NP_O + 2560 + h * 128, NP_O,
                                    NT, scale * 1.4426950408889634f, 8.f / scale, lds, o, l_reg, tid);
        }
        const int tid = ptid(), wid = tid >> 6, lane = tid & 63, r32 = lane & 31, hi = lane >> 5;
        float* li_l = (float*)(lds + 2 * 64 * 128 * 2 + 2 * 64 * 128) + wid * 64;
        if (hi == 0) li_l[r32] = l_reg; asm volatile("s_waitcnt lgkmcnt(0)" ::: "memory");
        float* dsb = (float*)a->out + (size_t)blockIdx.x * 64 * 512 + tid; asm volatile("" : "+v"(dsb));
        if (m == 0) {
#pragma unroll
            for (int r = 0; r < 16; ++r) { const float rl = __builtin_amdgcn_rcpf(li_l[crow(r, hi)]);
#pragma unroll
                for (int d = 0; d < 4; ++d) dsb[(size_t)(d * 16 + r) * 512] = o[d][r] * rl; }
        } else {
            bf16* MIX = (bf16*)(a->ws + WS_MIX);
            const float* lp = a->in[20] + o_ * 256;
            const float lam_init = 0.8f - 0.6f * __expf(-0.3f * (float)layer);
            const float lam = __expf(wave_sum(lp[lane] * lp[64 + lane])) - __expf(wave_sum(lp[128 + lane] * lp[192 + lane])) + lam_init;
            const float* sg = a->in[21] + o_ * 128;
#pragma unroll
            for (int r = 0; r < 16; ++r) { const float rl = __builtin_amdgcn_rcpf(li_l[crow(r, hi)]); float s = 0.f; float v[4];
#pragma unroll
                for (int d = 0; d < 4; ++d) { v[d] = dsb[(size_t)(d * 16 + r) * 512] - lam * (o[d][r] * rl); s += v[d] * v[d]; }
                s += __shfl_xor(s, 16); s += __shfl_xor(s, 8); s += __shfl_xor(s, 4); s += __shfl_xor(s, 2); s += __shfl_xor(s, 1);
                const float rs = __builtin_amdgcn_rsqf(s * (1.f / 128.f) + EPSN) * (1.f - lam_init);
                bf16* op = MIX + (size_t)(row0 + wid * 32 + crow(r, hi)) * 1024 + 512 + h * 128 + r32;
#pragma unroll
                for (int d = 0; d < 4; ++d) op[32 * d] = (bf16)f2bf(v[d] * rs * sg[32 * d + r32]);
                asm volatile("" ::: "memory"); }
        }
        asm volatile("s_waitcnt vmcnt(0) lgkmcnt(0)" ::: "memory");
    }
}

__device__ __forceinline__ void phase_mixer(KArgP a, int layer, unsigned char* ldsg) {
    LAS unsigned char* lds = (LAS unsigned char*)ldsg;
    volatile LAS unsigned* flag = (volatile LAS unsigned*)(lds + LDS_MAIN);
    unsigned* ctr = (unsigned*)(a->ws + WS_CTL) + layer; layer &= 7;
    const bool even = !(layer & 1), need_ctx = layer < 3;
    constexpr int NSC = 256;
    const int n_lat = even ? 512 : 256, n_ctx = need_ctx ? (even ? 64 : 32) : 0, total = NSC + n_lat + n_ctx;
    for (;;) {
        __syncthreads();
        if (ptid() == 0) *flag = atomicAdd(ctr, 1u);
        __syncthreads();
        const int qi_ = (int)*flag;
        if (qi_ >= total) break;
        const int item = qi_ < n_lat ? NSC + qi_ : (qi_ < n_lat + NSC ? qi_ - n_lat : qi_);
#ifdef PROBE_ITEM
        const unsigned long long it0_ = __builtin_amdgcn_s_memrealtime();
#endif
#ifndef SKIP_SCAN
        if (item < NSC) { if (even) scan_item<128, true, 1>(a, layer, item & 63, item >> 6, lds); else scan_item<64, false, 1>(a, layer, item & 63, item >> 6, lds); }
#else
        if (item < NSC) {}
#endif
        else { int b_, h_, qb_;
            if (item < NSC + n_lat) { const int i = item - NSC; qb_ = 1 + (i & 7); if (even) { b_ = i >> 6; h_ = (i >> 3) & 7; } else { b_ = i >> 5; h_ = (i >> 3) & 3; } }
            else { const int i = item - NSC - n_lat; qb_ = 0; if (even) { b_ = i >> 3; h_ = i & 7; } else { b_ = i >> 2; h_ = i & 3; } }
#ifndef SKIP_ATTN
            if (even) mla_item(a, b_, h_, qb_, (char*)ldsg); else diff_item(a, layer, b_, h_, qb_, (char*)ldsg);
#endif
        }
#ifdef PROBE_ITEM
        __syncthreads();
        if (otid() == 0) { volatile LAS unsigned long long* pc_ = (volatile LAS unsigned long long*)(lds + LDS_MAIN + 128); const int k_ = item < NSC ? 0 : (even ? 1 : 2); pc_[k_] += __builtin_amdgcn_s_memrealtime() - it0_; }
#endif
    }
}

#define XB_TMO      128
#define XB_XCNT(j)  (256  + 64 * (j))
#define XB_XSUB(j)  (1280 + 64 * (j))
#define XB_XGEN(j)  (2304 + 64 * (j))
#define XB_TOP      3328
#define XB_TOPGEN   3392
#define XCD_BAR_WORDS 3456
#define XB_SPIN_CAP (1u << 18)

__device__ __forceinline__ unsigned xb_ld(unsigned* p)              { return __hip_atomic_load(p, __ATOMIC_RELAXED, __HIP_MEMORY_SCOPE_AGENT); }
__device__ __forceinline__ unsigned xb_add(unsigned* p, unsigned v) { return __hip_atomic_fetch_add(p, v, __ATOMIC_RELAXED, __HIP_MEMORY_SCOPE_AGENT); }
__device__ __forceinline__ unsigned xb_xcc_id() { return (unsigned)__builtin_amdgcn_s_getreg((3 << 11) | 20) & 0xFu; }
#define XB_SPIN(cond, bar) do { unsigned _sp = 0; while (cond) { __builtin_amdgcn_s_sleep(1); \
    if ((++_sp & 255u) == 0u) { if (xb_ld(&(bar)[XB_TMO])) break; if (_sp > XB_SPIN_CAP) { atomicAdd(&(bar)[XB_TMO], 1u); break; } } } } while (0)

struct XcdBarrier {
    unsigned* bar; unsigned x;
    volatile LAS unsigned* st;
};

__device__ __forceinline__ XcdBarrier xcd_barrier_post(unsigned* bar, volatile LAS unsigned* st) {
    XcdBarrier b; b.bar = bar; b.x = xb_xcc_id(); b.st = st;
    if (threadIdx.x == 0) (void)xb_add(&bar[XB_XCNT(b.x)], 1u);
    return b;
}
__device__ __forceinline__ void xcd_barrier_complete(unsigned* bar, unsigned x, unsigned& nloc, unsigned& nx) {
    const unsigned G = gridDim.x * gridDim.y * gridDim.z;
    unsigned sum, cnt, mine, sp = 0u;
    for (;;) {
        sum = 0u; cnt = 0u; mine = 0u;
#pragma unroll
        for (unsigned j = 0; j < 16; ++j) { const unsigned c = xb_ld(&bar[XB_XCNT(j)]); sum += c; cnt += (c > 0u) ? 1u : 0u; mine = (j == x) ? c : mine; }
        if (sum == G) break;
        __builtin_amdgcn_s_sleep(1);
        if ((++sp & 255u) == 0u) { if (xb_ld(&bar[XB_TMO])) break; if (sp > XB_SPIN_CAP) { atomicAdd(&bar[XB_TMO], 1u); break; } }
    }
    nloc = mine > 0u ? mine : 1u; nx = cnt > 0u ? cnt : 1u;
}

__device__ __forceinline__ void xcd_barrier(const XcdBarrier& b) {
    asm volatile("s_waitcnt vmcnt(0)" ::: "memory");
    __syncthreads();
    if (threadIdx.x == 0) {
        unsigned* bar = b.bar;
        __builtin_amdgcn_s_waitcnt(0);
        unsigned nloc = b.st[0], nx = b.st[1];
        if (nloc == 0u) { xcd_barrier_complete(bar, b.x, nloc, nx); b.st[0] = nloc; b.st[1] = nx; }
        const unsigned old = xb_add(&bar[XB_XSUB(b.x)], 1u);
        const unsigned gen = old / nloc;
        if (old + 1u == (gen + 1u) * nloc) {
            __builtin_amdgcn_fence(__ATOMIC_RELEASE, "agent");
            asm volatile("s_waitcnt vmcnt(0)" ::: "memory");
            const unsigned og = xb_add(&bar[XB_TOP], 1u);
            const unsigned tg = og / nx;
            if (og + 1u == (tg + 1u) * nx) xb_add(&bar[XB_TOPGEN], 1u);
            else XB_SPIN(xb_ld(&bar[XB_TOPGEN]) == tg, bar);
            __builtin_amdgcn_fence(__ATOMIC_ACQUIRE, "agent");
            xb_add(&bar[XB_XGEN(b.x)], 1u);
            asm volatile("s_waitcnt vmcnt(0)" ::: "memory");
        } else {
            XB_SPIN(xb_ld(&bar[XB_XGEN(b.x)]) == gen, bar);
            __builtin_amdgcn_fence(__ATOMIC_ACQUIRE, "agent");
            asm volatile("s_waitcnt vmcnt(0)" ::: "memory");
        }
    }
    __syncthreads();
}

__global__ void __launch_bounds__(512, 2) mega_fwd(Args a_) {
    extern __shared__ __attribute__((aligned(16))) unsigned char lds_raw[];
    LAS unsigned char* lds = (LAS unsigned char*)lds_raw;
    ((LAS int*)(lds + LDS_MAIN + 1024))[threadIdx.x] = (int)threadIdx.x;
    if (threadIdx.x < 4) ((LAS unsigned*)(lds + LDS_MAIN + 64))[threadIdx.x] = 0u;
    if (threadIdx.x < 8) ((LAS unsigned*)(lds + LDS_MAIN + 128))[threadIdx.x] = 0u;
    __syncthreads();
    XcdBarrier xbar; xbar.bar = nullptr; xbar.x = 0; xbar.st = nullptr; bool xb_ready = false;
    cg::grid_group grid = cg::this_grid();
    int ph = 0;
#ifdef PROBE_MASK
    unsigned long long pr_last = __builtin_amdgcn_s_memrealtime(), pr_acc = 0ull;
#define PROBE_STAMP(k) { const unsigned long long now_ = __builtin_amdgcn_s_memrealtime(); if ((PROBE_MASK >> (k)) & 1) pr_acc += now_ - pr_last; pr_last = now_; }
#else
#define PROBE_STAMP(k)
#endif
    const int plo = a_.lo, phi = a_.hi;
#define PH_BEGIN if (ph >= plo && ph < phi) { KArgP a = kargs(); int bx = (int)blockIdx.x, G = (int)gridDim.x; asm volatile("" : "+s"(bx), "+s"(G)); (void)bx; (void)G;
#ifdef PROBE_SYNC2
#define PH_ENDT(k)   if (ph + 1 < phi) { grid.sync(); grid.sync(); } } ++ph;
#else
#define PH_ENDT(k) if (ph + 1 < phi) { if (!xb_ready) { grid.sync(); xbar = xcd_barrier_post((unsigned*)(a->ws + WS_CTL) + 4096, (volatile LAS unsigned*)(lds + LDS_MAIN + 64)); xb_ready = true; } else xcd_barrier(xbar); } PROBE_STAMP(k) } ++ph;
#endif

    PH_BEGIN phase_prep(a, lds); PH_ENDT(0)

    for (int layer = 0; layer < 4; ++layer) {
        const bool even = !(layer & 1);
        const int np = even ? NP_E : NP_O;
        PH_BEGIN phase_norm(a, layer, 0, layer > 0); convert_weights(a, layer, lds); PH_ENDT(1)
#ifndef SKIP_G1
        PH_BEGIN { bf16* H = (bf16*)(a->ws + WS_H); bf16* MIX = (bf16*)(a->ws + WS_MIX); bf16* P = (bf16*)(a->ws + WS_P); bf16* X = (bf16*)(a->ws + WS_X); unsigned char* Wb = a->ws + WS_W; const float* mod = (const float*)(a->ws + WS_MOD) + (size_t)layer * 9 * 6144; (void)H; (void)MIX; (void)P; (void)X; (void)mod; pg8::Gemm g{H, (const bf16*)(Wb + W_IN), MT, np, 1024, 1024}; pg8::StaticOrder S; S.init(MT, np, G, bx);
                   pg8::EpiBf16<0> E{P, np, nullptr, 0, 0, 1.f};
                   pg8::gemm_phase<pg8::EpiBf16<0>, pg8::StaticOrder, true, true>(lds, g, S, E); } PH_ENDT(2)
#else
        ++ph;
#endif
        PH_BEGIN if (even) phase_post_even(a, layer); else phase_post_odd(a, layer); PH_ENDT(3)
#ifndef SKIP_G3
        if (even) {
            PH_BEGIN { bf16* H = (bf16*)(a->ws + WS_H); bf16* MIX = (bf16*)(a->ws + WS_MIX); bf16* P = (bf16*)(a->ws + WS_P); bf16* X = (bf16*)(a->ws + WS_X); unsigned char* Wb = a->ws + WS_W; const float* mod = (const float*)(a->ws + WS_MOD) + (size_t)layer * 9 * 6144; (void)H; (void)MIX; (void)P; (void)X; (void)mod; pg8::Gemm g{(const bf16*)(a->ws + WS_CQN), (const bf16*)(Wb + W_UQ), MT, 768, 384, 384}; pg8::StaticOrder S; S.init(MT, 768, G, bx);
                       pg8::EpiBf16<0> E{(bf16*)((unsigned char*)a->out + OUT_Q), 768, nullptr, 0, 0, 1.f};
                       pg8::gemm_phase<pg8::EpiBf16<0>, pg8::StaticOrder, true, true>(lds, g, S, E); }
                     { unsigned char* Wb = a->ws + WS_W; pg8::Gemm g{(const bf16*)(a->ws + WS_CKVN), (const bf16*)(Wb + W_UKV), MT, 1024, 256, 256}; pg8::StaticOrder S; S.init(MT, 1024, G, bx);
                       pg8::EpiBf16<0> E{(bf16*)((unsigned char*)a->out + OUT_KV), 1024, nullptr, 0, 0, 1.f};
                       pg8::gemm_phase<pg8::EpiBf16<0>, pg8::StaticOrder, true, true>(lds, g, S, E); }
                     for (int it = bx; it < 192; it += G) scan_item<128, true, 0>(a, layer, it & 63, it >> 6, lds);
            PH_ENDT(4)
        } else { ++ph; }
#else
        ++ph;
#endif
        if (!even) {
        PH_BEGIN for (int it = bx; it < 192; it += G) scan_item<64, false, 0>(a, layer, it & 63, it >> 6, lds); PH_ENDT(5)
        } else { ++ph; }
#ifdef PROBE_MIX2
        PH_BEGIN phase_mixer(a, layer + 8, lds_raw); grid.sync(); PH_ENDT(6)
        --ph;
#endif
        PH_BEGIN phase_mixer(a, layer, lds_raw); PH_ENDT(6 + 7 * (layer & 1))
        PH_BEGIN phase_readout(a, layer); PH_ENDT(7)
#ifndef SKIP_G6
        PH_BEGIN { bf16* H = (bf16*)(a->ws + WS_H); bf16* MIX = (bf16*)(a->ws + WS_MIX); bf16* P = (bf16*)(a->ws + WS_P); bf16* X = (bf16*)(a->ws + WS_X); unsigned char* Wb = a->ws + WS_W; const float* mod = (const float*)(a->ws + WS_MOD) + (size_t)layer * 9 * 6144; (void)H; (void)MIX; (void)P; (void)X; (void)mod; pg8::Gemm g{MIX, (const bf16*)(Wb + W_OUT), MT, 1024, 1024, 1024}; pg8::StaticOrder S; S.init(NB * NLAT, 1024, G, bx, 1);
                   pg8::EpiResid E{X, mod, 2048, layer == 0 ? a->in[0] : nullptr};
                   pg8::gemm_phase<pg8::EpiResid, pg8::StaticOrder, true, true>(lds, g, S, E);
                   if (layer < 3) { pg8::Gemm g2{MIX, (const bf16*)(Wb + W_OUT), MT, 1024, 512, 1024}; pg8::CtxSplitOrder S2{G, bx, 512};
                       pg8::EpiResidSplit E2{X, (float*)(a->ws + WS_T), mod, 2048, layer == 0 ? a->in[2] : nullptr};
                       pg8::gemm_phase<pg8::EpiResidSplit, pg8::CtxSplitOrder, true, true>(lds, g2, S2, E2); } } PH_ENDT(8)
#else
        ++ph;
#endif
        PH_BEGIN phase_norm(a, layer, 1, layer < 3); PH_ENDT(9)
#ifndef SKIP_G8
        PH_BEGIN { bf16* H = (bf16*)(a->ws + WS_H); bf16* MIX = (bf16*)(a->ws + WS_MIX); bf16* P = (bf16*)(a->ws + WS_P); bf16* X = (bf16*)(a->ws + WS_X); unsigned char* Wb = a->ws + WS_W; const float* mod = (const float*)(a->ws + WS_MOD) + (size_t)layer * 9 * 6144; (void)H; (void)MIX; (void)P; (void)X; (void)mod; pg8::Gemm g{H, (const bf16*)(Wb + W_GU), MT, 2 * FF, 1024, 1024}; pg8::StaticOrder S; if (layer < 3) S.init(MT, 2 * FF, G, bx); else S.init(NB * NLAT, 2 * FF, G, bx, 1);
                   pg8::EpiSwiGLU E{P, FF};
                   pg8::gemm_phase<pg8::EpiSwiGLU, pg8::StaticOrder, true, true>(lds, g, S, E); } PH_ENDT(10)
#else
        ++ph;
#endif
#ifndef SKIP_G9
        PH_BEGIN { bf16* H = (bf16*)(a->ws + WS_H); bf16* MIX = (bf16*)(a->ws + WS_MIX); bf16* P = (bf16*)(a->ws + WS_P); bf16* X = (bf16*)(a->ws + WS_X); unsigned char* Wb = a->ws + WS_W; const float* mod = (const float*)(a->ws + WS_MOD) + (size_t)layer * 9 * 6144; (void)H; (void)MIX; (void)P; (void)X; (void)mod; pg8::Gemm g{P, (const bf16*)(Wb + W_DN), MT, 1024, FF, FF}; pg8::StaticOrder S; S.init(NB * NLAT, 1024, G, bx, 1);
                   pg8::EpiResid E{X, mod, 5120, nullptr};
                   pg8::gemm_phase<pg8::EpiResid, pg8::StaticOrder, true, true>(lds, g, S, E);
                   if (layer < 3) { pg8::Gemm g2{P, (const bf16*)(Wb + W_DN), MT, 1024, FF / 2, FF}; pg8::CtxSplitOrder S2{G, bx, FF / 2};
                       pg8::EpiResidSplit E2{X, (float*)(a->ws + WS_T), mod, 5120, nullptr};
                       pg8::gemm_phase<pg8::EpiResidSplit, pg8::CtxSplitOrder, true, true>(lds, g2, S2, E2); } } PH_ENDT(11)
#else
        ++ph;
#endif
    }
    PH_BEGIN phase_final(a); PH_ENDT(12)
#undef PH_BEGIN
#undef PH_ENDT
#ifdef PROBE_ITEM
    pr_acc += ((volatile LAS unsigned long long*)(lds + LDS_MAIN + 128))[PROBE_ITEM - 1];
#endif
#ifdef PROBE_MASK
    if (blockIdx.x == 0) { const unsigned long long t0_ = __builtin_amdgcn_s_memrealtime(); while (__builtin_amdgcn_s_memrealtime() - t0_ < pr_acc) __builtin_amdgcn_s_sleep(8); }
#endif
}
constexpr int NPH = 1 + 4 * 11 + 1;

extern "C" void kernel_launch(void* const* d_in, const int* in_sizes, int n_in, void* d_out, int out_size, void* d_ws, size_t ws_size, hipStream_t stream) {
    static int grid = 0;
    if (grid == 0) {
        if (n_in != 23 || ws_size < WS_END || out_size != NB * NLAT * DM) { fprintf(stderr, "kernel_launch: unexpected shapes: n_in %d ws %zu (need %zu) out %d\n", n_in, ws_size, (size_t)WS_END, out_size); grid = -1; return; }
        int dev = 0, cus = 0, per_cu = 0;
        hipGetDevice(&dev); hipDeviceGetAttribute(&cus, hipDeviceAttributeMultiprocessorCount, dev);
        if (hipFuncSetAttribute((const void*)mega_fwd, hipFuncAttributeMaxDynamicSharedMemorySize, LDS_BYTES) != hipSuccess) { fprintf(stderr, "kernel_launch: hipFuncSetAttribute failed\n"); grid = -1; return; }
        if (hipOccupancyMaxActiveBlocksPerMultiprocessor(&per_cu, (const void*)mega_fwd, 512, LDS_BYTES) != hipSuccess || per_cu < 1) { fprintf(stderr, "kernel_launch: occupancy query says %d\n", per_cu); per_cu = 1; }
        (void)hipGetLastError();
        grid = cus;
    }
    if (grid < 0) return;
    Args a{};
    for (int i = 0; i < 23; ++i) a.in[i] = (const float*)d_in[i];
    a.out = (float*)d_out; a.ws = (unsigned char*)d_ws; a.lo = 0; a.hi = NPH;
    void* kargv[] = {&a};
    hipError_t e = hipLaunchCooperativeKernel((const void*)mega_fwd, dim3(grid), dim3(512), kargv, LDS_BYTES, stream);
    if (e != hipSuccess) fprintf(stderr, "kernel_launch: cooperative launch failed: %s (grid %d)\n", hipGetErrorString(e), grid);
}
```

```cpp
#include <hip/hip_runtime.h>
#include <hip/hip_cooperative_groups.h>
#include <cstdio>
#include <cstdint>
namespace cg = cooperative_groups;
#define otid() ({ int t_ = (int)threadIdx.x; asm volatile("" : "+v"(t_)); t_; })
extern __shared__ __attribute__((aligned(16))) unsigned char g_lds_dyn[];
#define ptid() (*(volatile __attribute__((address_space(3))) int*)((__attribute__((address_space(3))) unsigned char*)g_lds_dyn + 131072 + 1024 + 4 * (int)threadIdx.x))
namespace pg8 {
#define PG8_LAS __attribute__((address_space(3)))
typedef unsigned short bf16_t;
typedef short bf16x8 __attribute__((ext_vector_type(8)));
typedef float f32x4 __attribute__((ext_vector_type(4)));
typedef unsigned u32x4 __attribute__((ext_vector_type(4)));
constexpr int BM = 256, BK = 64, HALF = 128, HTB = HALF * BK * 2  , STAGE_BYTES = 8 * HTB, NXCD = 8, WGM = 8;

__host__ __device__ __forceinline__ int lds_byte(int r, int c) { const int st = (r >> 4) * 2 + (c >> 5), rr = r & 15, cc = c & 31, ob = rr * 64 + cc * 2; return st * 1024 + (ob ^ (((ob >> 9) & 1) << 5)); }
__host__ __device__ __forceinline__ void stage_rc(int b, int& R, int& C) { const int st = b / 1024, sb = b % 1024, swz = sb ^ (((sb >> 9) & 1) << 5); R = (st >> 1) * 16 + swz / 64; C = (st & 1) * 32 + (swz % 64) / 2; }
__host__ __device__ __forceinline__ int perm32(int rho) { const int n = rho >> 4, i = rho & 15; return 8 * (i >> 2) + 4 * n + (i & 3); }

struct Unit { int pm, pn, koff; };
struct Gemm { const bf16_t* A; const bf16_t* Bt; int M, N, K, ld; };

struct StaticOrder {
    int nM, nN, nwg, G, c, mode;
    __host__ __device__ void init(int M, int N, int G_, int c_, int mode_ = 0) { nM = M / BM; nN = N / BM; nwg = nM * nN; G = G_; c = c_; mode = mode_; }
    __host__ __device__ bool next(int i, Unit& u) const {
        const long L = (long)i * G + c; if (L >= nwg) return false;
        int wgid = (int)L; { const int q = nwg / NXCD, r = nwg % NXCD, xcd = wgid % NXCD, off = wgid / NXCD; wgid = (xcd < r ? xcd * (q + 1) : r * (q + 1) + (xcd - r) * q) + off; }
        const int nig = WGM * nN, gid = wgid / nig, fm = gid * WGM, gsz = (nM - fm) < WGM ? (nM - fm) : WGM;
        u.pm = fm + ((wgid % nig) % gsz); u.pn = (wgid % nig) / gsz; u.koff = 0; if (mode == 1) u.pm = (u.pm >> 3) * 9 + 1 + (u.pm & 7); return true;
    }
    __device__ __forceinline__ void a_ready(const Unit&) const {}
    __device__ __forceinline__ void done(const Unit&) const {}
};
struct CtxSplitOrder {
    int G, c, khalf;
    __device__ bool next(int i, Unit& u) const { const int L = i * G + c; if (L >= 64) return false; u.koff = (L & 1) * khalf; u.pn = (L >> 1) & 3; u.pm = (L >> 3) * 9; return true; }
    __device__ __forceinline__ void a_ready(const Unit&) const {}
    __device__ __forceinline__ void done(const Unit&) const {}
};

__device__ __forceinline__ unsigned cvt_pk_bf16(float lo, float hi) { unsigned r; asm volatile("v_cvt_pk_bf16_f32 %0, %1, %2" : "=v"(r) : "v"(lo), "v"(hi)); return r; }
typedef float f32x2 __attribute__((ext_vector_type(2)));
__device__ __forceinline__ f32x2 gelu_pk(f32x2 v) {
    const f32x2 av = __builtin_elementwise_abs(v), d = av * 0.2316418882f + 1.0f;
    f32x2 t; t.x = __builtin_amdgcn_rcpf(d.x); t.y = __builtin_amdgcn_rcpf(d.y);
    f32x2 q = t * 0.5307027145f + (-0.7265760135f); q = q * t + 0.7107068705f; q = q * t + (-0.142248368f); q = q * t + 0.127414796f; q = q * t;
    const f32x2 s = (v * v) * (-0.72134752044f);
    f32x2 e; e.x = __builtin_amdgcn_exp2f(s.x); e.y = __builtin_amdgcn_exp2f(s.y);
    const f32x2 m = v * (q * e), r = v - m;
    f32x2 o; o.x = v.x < 0.f ? m.x : r.x; o.y = v.y < 0.f ? m.y : r.y; return o;
}

template <int ACT  > struct EpiBf16 {
    static constexpr bool PERM = true, AFTER_DRAIN = false; static_assert(ACT == 0 || ACT == 1, "EpiBf16: ACT is 0 (none) or 1 (gelu_pk)");
    bf16_t* O; int ldc; const float* bias; int split_cols; size_t split_stride; float scale0;
    __device__ __forceinline__ void operator()(const f32x4 (&acc)[2][2][4][2], const Unit& u, int wr, int wc, int fr, int fq) const {
        const int row0 = u.pm * BM + wr * 64 + fr; int colt = u.pn * BM; bf16_t* base = O;
        float sc = 1.f; if (split_cols) { const int t = colt / split_cols; base += (size_t)t * split_stride; colt -= t * split_cols; if (t == 0) sc = scale0; }
        const int col0 = colt + wc * 32 + 8 * fq, bcol0 = u.pn * BM + wc * 32 + 8 * fq;
        f32x4 bv[2][2];
#pragma unroll
        for (int bj = 0; bj < 2; ++bj)
#pragma unroll
            for (int n = 0; n < 2; ++n) bv[bj][n] = bias ? *(const f32x4*)(bias + bcol0 + bj * HALF + 4 * n) : (f32x4){0.f, 0.f, 0.f, 0.f};
#pragma unroll
        for (int ai = 0; ai < 2; ++ai)
#pragma unroll
            for (int m = 0; m < 4; ++m) { bf16_t* rowp = base + (size_t)(row0 + ai * HALF + m * 16) * ldc + col0;
#pragma unroll
                for (int bj = 0; bj < 2; ++bj) { f32x4 v0 = acc[ai][bj][m][0] + bv[bj][0], v1 = acc[ai][bj][m][1] + bv[bj][1];
                    if (ACT == 1) { f32x2 a = gelu_pk((f32x2){v0[0], v0[1]}), b = gelu_pk((f32x2){v0[2], v0[3]}), c = gelu_pk((f32x2){v1[0], v1[1]}), d = gelu_pk((f32x2){v1[2], v1[3]});
                        v0 = (f32x4){a.x, a.y, b.x, b.y}; v1 = (f32x4){c.x, c.y, d.x, d.y}; }
                    v0 = v0 * sc; v1 = v1 * sc; u32x4 w; w.x = cvt_pk_bf16(v0[0], v0[1]); w.y = cvt_pk_bf16(v0[2], v0[3]); w.z = cvt_pk_bf16(v1[0], v1[1]); w.w = cvt_pk_bf16(v1[2], v1[3]);
                    { bf16_t* sp_ = rowp + bj * HALF; asm volatile("global_store_dwordx4 %0, %1, off sc1\n\ts_nop 1" :: "v"(sp_), "v"(w) : "memory"); } } }
    }
};
struct EpiResidSplit {
    static constexpr bool PERM = false, AFTER_DRAIN = false;
    bf16_t* X; float* T; const float* mod; int goff; const float* cin;
    __device__ __forceinline__ void operator()(const f32x4 (&acc)[2][2][4][2], const Unit& u, int wr, int wc, int fr, int fq) const {
        typedef unsigned u32x2_t __attribute__((ext_vector_type(2)));
        const float* gp = mod + 8 * 6144 + goff;
        const int col0 = u.pn * BM + wc * 32 + 4 * fq;
        const bool first = (u.koff == 0);
        bf16_t* xb = X + (size_t)(u.pm * BM) * 1024; float* tb = T + (size_t)((u.pm / 9) * BM) * 1024;
        const float* rbase = cin ? cin + (size_t)((u.pm / 9) * BM) * 1024 : nullptr;
#pragma unroll
        for (int bj = 0; bj < 2; ++bj)
#pragma unroll
            for (int n = 0; n < 2; ++n) { const f32x4 gv = *(const f32x4*)(gp + col0 + bj * HALF + n * 16);
#pragma unroll
                for (int ai = 0; ai < 2; ++ai)
#pragma unroll
                    for (int m = 0; m < 4; ++m) { const size_t o = (size_t)(ai * HALF + wr * 64 + m * 16 + fr) * 1024 + col0 + bj * HALF + n * 16;
                        f32x4 v = gv * acc[ai][bj][m][n];
                        if (first) { f32x4 x;
                            if (rbase) x = *(const f32x4*)(rbase + o);
                            else { const u32x2_t w = *(const u32x2_t*)(xb + o); x = (f32x4){__uint_as_float(w.x << 16), __uint_as_float(w.x & 0xffff0000u), __uint_as_float(w.y << 16), __uint_as_float(w.y & 0xffff0000u)}; }
                            v = v + x; u32x2_t r; r.x = cvt_pk_bf16(v[0], v[1]); r.y = cvt_pk_bf16(v[2], v[3]); *(u32x2_t*)(xb + o) = r; }
                        else *(f32x4*)(tb + o) = v; } }
    }
};
struct EpiSwiGLU {
    static constexpr bool PERM = true, AFTER_DRAIN = false;
    bf16_t* O; int ldc;
    __device__ __forceinline__ void operator()(const f32x4 (&acc)[2][2][4][2], const Unit& u, int wr, int wc, int fr, int fq) const {
        const int row0 = u.pm * BM + wr * 64 + fr; const int col0 = u.pn * HALF + wc * 32 + 8 * fq;
#pragma unroll
        for (int ai = 0; ai < 2; ++ai)
#pragma unroll
            for (int m = 0; m < 4; ++m) { bf16_t* rowp = O + (size_t)(row0 + ai * HALF + m * 16) * ldc + col0;
                float h[8];
#pragma unroll
                for (int n = 0; n < 2; ++n)
#pragma unroll
                    for (int i = 0; i < 4; ++i) { const float g = acc[ai][0][m][n][i], up = acc[ai][1][m][n][i];
                        h[n * 4 + i] = g * __builtin_amdgcn_rcpf(1.0f + __expf(-g)) * up; }
                u32x4 w; w.x = cvt_pk_bf16(h[0], h[1]); w.y = cvt_pk_bf16(h[2], h[3]); w.z = cvt_pk_bf16(h[4], h[5]); w.w = cvt_pk_bf16(h[6], h[7]);
                asm volatile("global_store_dwordx4 %0, %1, off sc1\n\ts_nop 1" :: "v"(rowp), "v"(w) : "memory"); }
    }
};
struct EpiResid {
    static constexpr bool PERM = false, AFTER_DRAIN = false;
    bf16_t* X; const float* mod; int goff; const float* xin;
    __device__ __forceinline__ void operator()(const f32x4 (&acc)[2][2][4][2], const Unit& u, int wr, int wc, int fr, int fq) const {
        typedef unsigned u32x2_t __attribute__((ext_vector_type(2)));
        const int widx = (u.pm % 9 == 0) ? 8 : (u.pm / 9);
        const float* gp = mod + widx * 6144 + goff;
        const int col0 = u.pn * BM + wc * 32 + 4 * fq;
        const float* rb = xin ? xin + (size_t)((u.pm / 9) * 2048 + (u.pm % 9 - 1) * 256) * 1024 : nullptr;
        bf16_t* wb = X + (size_t)(u.pm * BM) * 1024;
#pragma unroll
        for (int bj = 0; bj < 2; ++bj)
#pragma unroll
            for (int n = 0; n < 2; ++n) { const f32x4 gv = *(const f32x4*)(gp + col0 + bj * HALF + n * 16);
#pragma unroll
                for (int ai = 0; ai < 2; ++ai)
#pragma unroll
                    for (int m = 0; m < 4; ++m) { const size_t o = (size_t)(ai * HALF + wr * 64 + m * 16 + fr) * 1024 + col0 + bj * HALF + n * 16;
                        f32x4 x;
                        if (rb) x = *(const f32x4*)(rb + o);
                        else { const u32x2_t w = *(const u32x2_t*)(wb + o); x = (f32x4){__uint_as_float(w.x << 16), __uint_as_float(w.x & 0xffff0000u), __uint_as_float(w.y << 16), __uint_as_float(w.y & 0xffff0000u)}; }
                        x = x + gv * acc[ai][bj][m][n];
                        u32x2_t r; r.x = cvt_pk_bf16(x[0], x[1]); r.y = cvt_pk_bf16(x[2], x[3]); *(u32x2_t*)(wb + o) = r; } }
    }
};
template <class Epi, class Sched, bool ALIGN_EPI = false, bool SP2 = false>
__device__ __forceinline__ void gemm_phase(PG8_LAS unsigned char* lds, const Gemm g, const Sched& S, const Epi& E) {
    const int tid = otid(), wid = __builtin_amdgcn_readfirstlane(tid >> 6), lane = tid & 63, wr = wid >> 2, wc = wid & 3, fr = lane & 15, fq = lane >> 4;
    const int K = g.ld, nt = g.K / BK;
    unsigned voffA[2], voffB[2];
#pragma unroll
    for (int i = 0; i < 2; ++i) { int R, C; stage_rc(tid * 16 + i * 8192, R, C); const int Rb = Epi::PERM ? ((R & ~31) + perm32(R & 31)) : R;
        voffA[i] = (unsigned)(R * K + C) * 2u; voffB[i] = (unsigned)(Rb * K + C) * 2u; }
    const size_t kstep = (size_t)(BK * 2);
    const size_t hstep = (size_t)HALF * K * 2;
    const size_t tstep = 2 * hstep;
    const unsigned ldsw = (unsigned)wid * 1024u;
    const int aoff = lds_byte(wr * 64 + fr, fq * 8), boff = lds_byte(wc * 32 + fr, fq * 8);
#define PG8_SA(b, h) (((b) * 2 + (h)) * HTB)
#define PG8_SB(b, h) ((4 + (b) * 2 + (h)) * HTB)
#define PG8_STAGE(bufoff, gbase, voff) do { _Pragma("unroll") for (int _i = 0; _i < 2; ++_i) \
        __builtin_amdgcn_global_load_lds((const unsigned*)((const char*)(gbase) + (voff)[_i]), (PG8_LAS unsigned*)(lds + (bufoff) + ldsw + _i * 8192), 16, 0, 0); } while (0)
#define PG8_LDA(dst, b, h) do { _Pragma("unroll") for (int m = 0; m < 4; ++m) _Pragma("unroll") for (int k = 0; k < 2; ++k) dst[m][k] = *(const PG8_LAS bf16x8*)(lds + PG8_SA(b, h) + aoff + m * 2048 + k * 1024); } while (0)
#define PG8_LDB(dst, b, h) do { _Pragma("unroll") for (int n = 0; n < 2; ++n) _Pragma("unroll") for (int k = 0; k < 2; ++k) dst[n][k] = *(const PG8_LAS bf16x8*)(lds + PG8_SB(b, h) + boff + n * 2048 + k * 1024); } while (0)
#define PG8_MMA(ai, bj, At, Bt) do { __builtin_amdgcn_s_setprio(1); _Pragma("unroll") for (int m = 0; m < 4; ++m) _Pragma("unroll") for (int n = 0; n < 2; ++n) _Pragma("unroll") for (int k = 0; k < 2; ++k) \
        acc[ai][bj][m][n] = __builtin_amdgcn_mfma_f32_16x16x32_bf16(Bt[n][k], At[m][k], acc[ai][bj][m][n], 0, 0, 0); __builtin_amdgcn_s_setprio(0); } while (0)
#define PG8_WAIT_V(n) asm volatile("s_waitcnt vmcnt(" #n ")" ::: "memory")
#define PG8_WAIT_L(n) asm volatile("s_waitcnt lgkmcnt(" #n ")" ::: "memory")
#define PG8_BAR __builtin_amdgcn_s_barrier()
#define PG8_SCHED __builtin_amdgcn_sched_barrier(0)
    Unit cur, nxt; int ui = 0;
    if (!S.next(0, cur)) return;
    f32x4 acc[2][2][4][2];
#pragma unroll
    for (int a = 0; a < 2; ++a)
#pragma unroll
        for (int b = 0; b < 2; ++b)
#pragma unroll
            for (int m = 0; m < 4; ++m)
#pragma unroll
                for (int n = 0; n < 2; ++n) acc[a][b][m][n] = (f32x4){0.f, 0.f, 0.f, 0.f};
    bf16x8 At[4][2], B0[2][2], B1[2][2];
    const char* cA = (const char*)g.A + (size_t)cur.pm * tstep + (size_t)cur.koff * 2; const char* cB = (const char*)g.Bt + (size_t)cur.pn * tstep + (size_t)cur.koff * 2;
    S.a_ready(cur);
    if constexpr (SP2) {
        PG8_STAGE(PG8_SB(0, 0), cB, voffB); PG8_STAGE(PG8_SB(0, 1), cB + hstep, voffB); PG8_STAGE(PG8_SA(0, 0), cA, voffA); PG8_STAGE(PG8_SA(0, 1), cA + hstep, voffA);
        if (wr == 1) PG8_BAR;
        PG8_WAIT_V(2); PG8_BAR;
        PG8_STAGE(PG8_SB(1, 0), cB + kstep, voffB); PG8_STAGE(PG8_SA(1, 0), cA + kstep, voffA); PG8_STAGE(PG8_SB(1, 1), cB + hstep + kstep, voffB);
        PG8_WAIT_V(6); PG8_BAR;
    } else {
        PG8_STAGE(PG8_SB(0, 0), cB, voffB); PG8_STAGE(PG8_SA(0, 0), cA, voffA); PG8_STAGE(PG8_SB(0, 1), cB + hstep, voffB); PG8_STAGE(PG8_SA(0, 1), cA + hstep, voffA);
        if (wr == 1) PG8_BAR;
        PG8_WAIT_V(4); PG8_BAR;
        PG8_STAGE(PG8_SB(1, 0), cB + kstep, voffB); PG8_STAGE(PG8_SA(1, 0), cA + kstep, voffA); PG8_STAGE(PG8_SB(1, 1), cB + hstep + kstep, voffB);
        PG8_WAIT_V(6); PG8_BAR;
    }
    for (;;) {
        const bool has_next = S.next(ui + 1, nxt);
        const char* nA = has_next ? (const char*)g.A + (size_t)nxt.pm * tstep + (size_t)nxt.koff * 2 : cA; const char* nB = has_next ? (const char*)g.Bt + (size_t)nxt.pn * tstep + (size_t)nxt.koff * 2 : cB;
        for (int t = 0; t < nt; t += 2) {
            const bool last = (t == nt - 2);
            const char* a1 = cA + (size_t)(t + 1) * kstep;
            const char* a2 = last ? nA : cA + (size_t)(t + 2) * kstep; const char* b2 = last ? nB : cB + (size_t)(t + 2) * kstep;
            const char* a3 = a2 + kstep; const char* b3 = b2 + kstep;
            if (last && has_next) S.a_ready(nxt);
            if constexpr (SP2) {
            PG8_LDB(B0, 0, 0); PG8_LDB(B1, 0, 1); PG8_SCHED; PG8_LDA(At, 0, 0); PG8_STAGE(PG8_SA(1, 1), a1 + hstep, voffA);
            PG8_WAIT_V(8); PG8_WAIT_L(0); PG8_BAR; PG8_MMA(0, 0, At, B0); PG8_MMA(0, 1, At, B1); PG8_BAR; PG8_SCHED;
            PG8_LDA(At, 0, 1); PG8_STAGE(PG8_SB(0, 0), b2, voffB); PG8_STAGE(PG8_SB(0, 1), b2 + hstep, voffB); PG8_STAGE(PG8_SA(0, 0), a2, voffA);
            PG8_WAIT_V(8); PG8_WAIT_L(0); PG8_BAR; PG8_MMA(1, 0, At, B0); PG8_MMA(1, 1, At, B1); PG8_BAR; PG8_SCHED;
            PG8_LDB(B0, 1, 0); PG8_LDB(B1, 1, 1); PG8_SCHED; PG8_LDA(At, 1, 0); PG8_STAGE(PG8_SA(0, 1), a2 + hstep, voffA);
            PG8_WAIT_V(8); PG8_WAIT_L(0); PG8_BAR; PG8_MMA(0, 0, At, B0); PG8_MMA(0, 1, At, B1); PG8_BAR; PG8_SCHED;
            PG8_LDA(At, 1, 1); PG8_STAGE(PG8_SB(1, 0), b3, voffB); PG8_STAGE(PG8_SB(1, 1), b3 + hstep, voffB); PG8_STAGE(PG8_SA(1, 0), a3, voffA);
            PG8_WAIT_V(8); PG8_WAIT_L(0); PG8_BAR; PG8_MMA(1, 0, At, B0); PG8_MMA(1, 1, At, B1); PG8_BAR; PG8_SCHED;
            } else {
            PG8_LDB(B0, 0, 0); PG8_SCHED; PG8_LDA(At, 0, 0); PG8_STAGE(PG8_SA(1, 1), a1 + hstep, voffA);
            PG8_WAIT_L(8); PG8_BAR; PG8_WAIT_L(0); PG8_MMA(0, 0, At, B0); PG8_BAR; PG8_SCHED;
            PG8_LDB(B1, 0, 1); PG8_STAGE(PG8_SB(0, 0), b2, voffB);
            PG8_BAR; PG8_WAIT_L(0); PG8_MMA(0, 1, At, B1); PG8_BAR;
            PG8_LDA(At, 0, 1); PG8_STAGE(PG8_SA(0, 0), a2, voffA);
            PG8_BAR; PG8_WAIT_L(0); PG8_MMA(1, 0, At, B0); PG8_BAR; PG8_SCHED;
            PG8_STAGE(PG8_SB(0, 1), b2 + hstep, voffB);
            PG8_WAIT_V(6); PG8_BAR; PG8_MMA(1, 1, At, B1); PG8_BAR;
            PG8_LDB(B0, 1, 0); PG8_SCHED; PG8_LDA(At, 1, 0); PG8_STAGE(PG8_SA(0, 1), a2 + hstep, voffA);
            PG8_WAIT_L(8); PG8_BAR; PG8_WAIT_L(0); PG8_MMA(0, 0, At, B0); PG8_BAR; PG8_SCHED;
            PG8_LDB(B1, 1, 1); PG8_STAGE(PG8_SB(1, 0), b3, voffB);
            PG8_BAR; PG8_WAIT_L(0); PG8_MMA(0, 1, At, B1); PG8_BAR;
            PG8_LDA(At, 1, 1); PG8_STAGE(PG8_SA(1, 0), a3, voffA);
            PG8_BAR; PG8_WAIT_L(0); PG8_MMA(1, 0, At, B0); PG8_BAR; PG8_SCHED;
            PG8_STAGE(PG8_SB(1, 1), b3 + hstep, voffB);
            PG8_WAIT_V(6); PG8_BAR; PG8_MMA(1, 1, At, B1); PG8_BAR;
            }
        }
        if constexpr (ALIGN_EPI) { if (wr == 0) PG8_BAR; }
        if constexpr (!Epi::AFTER_DRAIN) { E(acc, cur, wr, wc, fr, fq); S.done(cur); }
        if (!has_next) break;
#pragma unroll
        for (int a = 0; a < 2; ++a)
#pragma unroll
            for (int b = 0; b < 2; ++b)
#pragma unroll
                for (int m = 0; m < 4; ++m)
#pragma unroll
                    for (int n = 0; n < 2; ++n) acc[a][b][m][n] = (f32x4){0.f, 0.f, 0.f, 0.f};
        cur = nxt; cA = nA; cB = nB; ++ui;
        if constexpr (ALIGN_EPI) { if (wr == 1) PG8_BAR; }
    }
    PG8_WAIT_V(0);
    if constexpr (!ALIGN_EPI) { if (wr == 0) PG8_BAR; }
    PG8_BAR;
    if constexpr (Epi::AFTER_DRAIN) { E.fused(acc, cur, wr, wc, fr, fq, lds, wid, lane); S.done(cur); }
#undef PG8_SA
#undef PG8_SB
#undef PG8_STAGE
#undef PG8_LDA
#undef PG8_LDB
#undef PG8_MMA
#undef PG8_WAIT_V
#undef PG8_WAIT_L
#undef PG8_BAR
#undef PG8_SCHED
}
}

typedef unsigned short bf16;
typedef short bf16x8 __attribute__((ext_vector_type(8)));
typedef short s16x4 __attribute__((ext_vector_type(4)));
typedef float f32x4 __attribute__((ext_vector_type(4)));
typedef float f32x16 __attribute__((ext_vector_type(16)));
typedef unsigned u32x4 __attribute__((ext_vector_type(4)));
typedef unsigned u32x2 __attribute__((ext_vector_type(2)));
#define LAS __attribute__((address_space(3)))

constexpr int NB = 8, TPB = 2304, MT = NB * TPB, DM = 1024, NLAT = 2048;
constexpr int NP_E = 3328, NP_O = 3072, FF = 2816;
constexpr float EPSN = 1e-6f;
constexpr size_t MiB = 1u << 20;
constexpr size_t WS_CTL = 0, WS_MOD = 1 * MiB, WS_X = 2 * MiB, WS_H = 74 * MiB, WS_MIX = 110 * MiB, WS_P = 146 * MiB, WS_W = 263 * MiB,
                 WS_OSC = 290 * MiB, WS_KR = 326 * MiB, WS_U = 328 * MiB, WS_T = 342 * MiB, WS_END = 350 * MiB;
constexpr size_t WS_LSUM = 128 * 1024;
constexpr size_t WS_CQN = WS_MIX, WS_CKVN = WS_MIX + 14 * MiB, WS_DSCR = WS_H;
constexpr size_t W_IN = 0, W_OUT = 13 * MiB / 2, W_GU = 17 * MiB / 2, W_DN = 39 * MiB / 2, W_UQ = 25 * MiB, W_UKV = 25 * MiB + 768 * 1024;
constexpr size_t OUT_KV = 0, OUT_Q = 36 * MiB;
constexpr int LDS_MAIN = 131072, LDS_BYTES = LDS_MAIN + 1024 + 2048;

struct Args { const float* in[23]; float* out; unsigned char* ws; int lo, hi; };
typedef __attribute__((address_space(4))) const Args* KArgP;
__device__ __forceinline__ KArgP kargs() { KArgP p = (KArgP)__builtin_amdgcn_kernarg_segment_ptr(); asm volatile("" : "+s"(p)); return p; }

__device__ __forceinline__ float bf2f(unsigned short h) { return __uint_as_float((unsigned)h << 16); }
__device__ __forceinline__ unsigned f2bf(float f) { unsigned u = __float_as_uint(f); return (u + 0x7fffu + ((u >> 16) & 1u)) >> 16; }
__device__ __forceinline__ unsigned pk2(float lo, float hi) { return f2bf(lo) | (f2bf(hi) << 16); }
__device__ __forceinline__ float wave_sum(float v) {
#pragma unroll
    for (int o = 1; o < 64; o <<= 1) v += __shfl_xor(v, o);
    return v;
}
__device__ __forceinline__ float silu_f(float g) { return g / (1.0f + __expf(-g)); }
__device__ __forceinline__ void sincos_r(float ang, float& s, float& c) {
    float r = ang * 0.15915494309189535f; r = r - __builtin_floorf(r);
    s = __builtin_amdgcn_sinf(r); c = __builtin_amdgcn_cosf(r);
}
__device__ __forceinline__ float inv_freq(int i, int half) { return __builtin_amdgcn_exp2f(-(float)i / (float)half * 13.287712379549449f); }

__device__ __forceinline__ void mod_item(KArgP a, int l, int cg, LAS unsigned char* lds) {
    const int tid = otid();
    float* MOD = (float*)(a->ws + WS_MOD);
    LAS float* S = (LAS float*)lds;
    LAS float* R = S + 1024 * 12;
    for (int i = tid; i < 9 * 1024; i += 512) { const int w = i >> 10, k = i & 1023; const float v = (w < 8) ? a->in[1][w * 1024 + k] : a->in[3][k]; S[k * 12 + w] = silu_f(v); }
    __syncthreads();
    const int nl = tid & 63, kp = tid >> 6, n0 = cg * 256;
    f32x4 acc[9];
#pragma unroll
    for (int w = 0; w < 9; ++w) acc[w] = (f32x4){0.f, 0.f, 0.f, 0.f};
    const float* wp = a->in[4] + (size_t)l * 1024 * 6144 + n0 + 4 * nl;
#pragma unroll 8
    for (int k = kp * 128; k < kp * 128 + 128; ++k) {
        const f32x4 wv = *(const f32x4*)(wp + (size_t)k * 6144);
        const f32x4 s0 = *(const LAS f32x4*)(S + k * 12), s1 = *(const LAS f32x4*)(S + k * 12 + 4); const float s8 = S[k * 12 + 8];
        acc[0] += wv * s0[0]; acc[1] += wv * s0[1]; acc[2] += wv * s0[2]; acc[3] += wv * s0[3];
        acc[4] += wv * s1[0]; acc[5] += wv * s1[1]; acc[6] += wv * s1[2]; acc[7] += wv * s1[3]; acc[8] += wv * s8;
    }
#pragma unroll
    for (int w = 0; w < 9; ++w) *(LAS f32x4*)(R + (kp * 9 + w) * 256 + 4 * nl) = acc[w];
    __syncthreads();
    for (int i = tid; i < 9 * 256; i += 512) { const int w = i >> 8, n2 = i & 255; float v = a->in[5][l * 6144 + n0 + n2];
#pragma unroll
        for (int p = 0; p < 8; ++p) v += R[(p * 9 + w) * 256 + n2];
        MOD[(size_t)(l * 9 + w) * 6144 + n0 + n2] = v; }
    __syncthreads();
}
__device__ __forceinline__ void phase_prep(KArgP a, LAS unsigned char* lds) {
    const int tid = otid(), G = gridDim.x;
    if (blockIdx.x == 0) { if (tid < 64) ((unsigned*)(a->ws + WS_CTL))[tid] = 0u; for (int i = tid; i < 3456; i += 512) ((unsigned*)(a->ws + WS_CTL))[4096 + i] = 0u; }
    for (int item = blockIdx.x; item < 96; item += G) mod_item(a, item / 24, item % 24, lds);
}

__device__ __forceinline__ void transpose_item(const float* W, int K, int N, bf16* WT, int k0, int n0, int drow0, LAS float* scr, int lane) {
#pragma unroll 8
    for (int i = 0; i < 32; ++i) { const int kk = 2 * i + (lane >> 5); scr[kk * 33 + (lane & 31)] = W[(size_t)(k0 + kk) * N + n0 + (lane & 31)]; }
    asm volatile("s_waitcnt lgkmcnt(0)" ::: "memory");
    const int c = lane & 7;
#pragma unroll
    for (int j = 0; j < 4; ++j) { const int n = (lane >> 3) + 8 * j; const LAS float* s = scr + (8 * c) * 33 + n;
        u32x4 o; o.x = pk2(s[0 * 33], s[1 * 33]); o.y = pk2(s[2 * 33], s[3 * 33]); o.z = pk2(s[4 * 33], s[5 * 33]); o.w = pk2(s[6 * 33], s[7 * 33]);
        *(u32x4*)(WT + (size_t)(drow0 + n) * K + k0 + 8 * c) = o; }
    asm volatile("s_waitcnt lgkmcnt(0)" ::: "memory");
}
__device__ __forceinline__ void convert_weights(KArgP a, int layer, LAS unsigned char* lds) {
    const int lane = otid() & 63, wave = otid() >> 6;
    LAS float* scr = (LAS float*)(lds + wave * 8448);
    const int gw = blockIdx.x * 8 + wave, NGW = gridDim.x * 8;
    const bool even = !(layer & 1); const int e = layer >> 1;
    const int nin = even ? 3232 : 3072;
    const float* w_in = even ? a->in[11] + (size_t)e * 1024 * 3232 : a->in[18] + (size_t)e * 1024 * 3072;
    unsigned char* Wb = a->ws + WS_W;
    const int nbin = nin / 32;
    const int I_IN = 16 * nbin, I_OUT = 512, I_G = 16 * 88, I_D = 44 * 32, I_UQ = even ? 6 * 24 : 0, I_UKV = even ? 4 * 32 : 0;
    const int NIT = I_IN + I_OUT + 2 * I_G + I_D + I_UQ + I_UKV;
    for (int it = gw; it < NIT; it += NGW) {
        int r = it;
        if (r < I_IN) { const int kb = r / nbin, nb = r % nbin; transpose_item(w_in, 1024, nin, (bf16*)(Wb + W_IN), 64 * kb, 32 * nb, 32 * nb, scr, lane); continue; } r -= I_IN;
        if (r < I_OUT) { const int kb = r / 32, nb = r % 32; transpose_item(a->in[7] + (size_t)layer * 1024 * 1024, 1024, 1024, (bf16*)(Wb + W_OUT), 64 * kb, 32 * nb, 32 * nb, scr, lane); continue; } r -= I_OUT;
        if (r < I_G) { const int kb = r / 88, nb = r % 88, n0 = 32 * nb; transpose_item(a->in[8] + (size_t)layer * 1024 * FF, 1024, FF, (bf16*)(Wb + W_GU), 64 * kb, n0, (n0 >> 7) * 256 + (n0 & 127), scr, lane); continue; } r -= I_G;
        if (r < I_G) { const int kb = r / 88, nb = r % 88, n0 = 32 * nb; transpose_item(a->in[9] + (size_t)layer * 1024 * FF, 1024, FF, (bf16*)(Wb + W_GU), 64 * kb, n0, (n0 >> 7) * 256 + 128 + (n0 & 127), scr, lane); continue; } r -= I_G;
        if (r < I_D) { const int kb = r / 32, nb = r % 32; transpose_item(a->in[10] + (size_t)layer * FF * 1024, FF, 1024, (bf16*)(Wb + W_DN), 64 * kb, 32 * nb, 32 * nb, scr, lane); continue; } r -= I_D;
        if (r < I_UQ) { const int kb = r / 24, nb = r % 24; transpose_item(a->in[15] + (size_t)e * 384 * 768, 384, 768, (bf16*)(Wb + W_UQ), 64 * kb, 32 * nb, 32 * nb, scr, lane); continue; } r -= I_UQ;
        { const int kb = r / 32, nb = r % 32; transpose_item(a->in[17] + (size_t)e * 256 * 1024, 256, 1024, (bf16*)(Wb + W_UKV), 64 * kb, 32 * nb, 32 * nb, scr, lane); }
    }
}

__device__ __forceinline__ f32x4 ld4_bf16(const bf16* p) { const u32x2 w = *(const u32x2*)p; return (f32x4){__uint_as_float(w.x << 16), __uint_as_float(w.x & 0xffff0000u), __uint_as_float(w.y << 16), __uint_as_float(w.y & 0xffff0000u)}; }
__device__ __forceinline__ void phase_norm(KArgP a, int layer, int which, bool addT) {
    const int lane = otid() & 63, wave = otid() >> 6;
    const int gw = blockIdx.x * 8 + wave, NGW = gridDim.x * 8;
    bf16* X = (bf16*)(a->ws + WS_X); bf16* H = (bf16*)(a->ws + WS_H); const float* T = (const float*)(a->ws + WS_T);
    const float* g = a->in[6] + (layer * 2 + which) * 1024;
    const float* mod = (const float*)(a->ws + WS_MOD) + (size_t)layer * 9 * 6144;
    const int shoff = which ? 3072 : 0, scoff = which ? 4096 : 1024;
    const bool from_inputs = (layer == 0 && which == 0);
    constexpr int RB = 3;
    for (int r0 = gw; r0 < MT; r0 += RB * NGW) {
        f32x4 v[RB][4];
#pragma unroll
        for (int k = 0; k < RB; ++k) { const int row = r0 + k * NGW; if (row < MT) {
            if (from_inputs) { const int b = row / TPB, j = row - b * TPB; const float* xr = (j < 256 ? a->in[2] + (size_t)(b * 256 + j) * 1024 : a->in[0] + (size_t)(b * NLAT + j - 256) * 1024) + 8 * lane;
#pragma unroll
                for (int q = 0; q < 2; ++q) { v[k][2 * q] = *(const f32x4*)(xr + 512 * q); v[k][2 * q + 1] = *(const f32x4*)(xr + 512 * q + 4); } }
            else {
#pragma unroll
                for (int q = 0; q < 2; ++q) { const u32x4 w = *(const u32x4*)(X + (size_t)row * 1024 + 8 * lane + 512 * q);
                    v[k][2 * q] = (f32x4){__uint_as_float(w.x << 16), __uint_as_float(w.x & 0xffff0000u), __uint_as_float(w.y << 16), __uint_as_float(w.y & 0xffff0000u)};
                    v[k][2 * q + 1] = (f32x4){__uint_as_float(w.z << 16), __uint_as_float(w.z & 0xffff0000u), __uint_as_float(w.w << 16), __uint_as_float(w.w & 0xffff0000u)}; } } } }
#pragma unroll
        for (int k = 0; k < RB; ++k) { const int row = r0 + k * NGW; if (row < MT) {
            const int b = row / TPB, j = row - b * TPB, widx = (j < 256) ? 8 : b;
            if (addT && j < 256) { const float* tr = T + (size_t)(b * 256 + j) * 1024 + 8 * lane;
#pragma unroll
                for (int q = 0; q < 2; ++q) { v[k][2 * q] = v[k][2 * q] + *(const f32x4*)(tr + 512 * q); v[k][2 * q + 1] = v[k][2 * q + 1] + *(const f32x4*)(tr + 512 * q + 4);
                    u32x4 w; w.x = pk2(v[k][2 * q][0], v[k][2 * q][1]); w.y = pk2(v[k][2 * q][2], v[k][2 * q][3]); w.z = pk2(v[k][2 * q + 1][0], v[k][2 * q + 1][1]); w.w = pk2(v[k][2 * q + 1][2], v[k][2 * q + 1][3]);
                    *(u32x4*)(X + (size_t)row * 1024 + 8 * lane + 512 * q) = w; } }
            float ss = 0.f;
#pragma unroll
            for (int q = 0; q < 4; ++q) ss += (v[k][q][0] * v[k][q][0] + v[k][q][1] * v[k][q][1]) + (v[k][q][2] * v[k][q][2] + v[k][q][3] * v[k][q][3]);
            const float rstd = __builtin_amdgcn_rsqf(wave_sum(ss) * (1.f / 1024.f) + EPSN);
#pragma unroll
            for (int q = 0; q < 2; ++q) { const int col = 8 * lane + 512 * q; f32x4 y[2];
#pragma unroll
                for (int hh = 0; hh < 2; ++hh) { const f32x4 gv = *(const f32x4*)(g + col + 4 * hh), sc = *(const f32x4*)(mod + widx * 6144 + scoff + col + 4 * hh), sh = *(const f32x4*)(mod + widx * 6144 + shoff + col + 4 * hh);
                    y[hh] = v[k][2 * q + hh] * rstd * gv * (sc + 1.0f) + sh; }
                u32x4 w; w.x = pk2(y[0][0], y[0][1]); w.y = pk2(y[0][2], y[0][3]); w.z = pk2(y[1][0], y[1][1]); w.w = pk2(y[1][2], y[1][3]);
                { bf16* sp_ = H + (size_t)row * 1024 + col; asm volatile("global_store_dwordx4 %0, %1, off sc1\n\ts_nop 1" :: "v"(sp_), "v"(w) : "memory"); } } } }
    }
}

__device__ __forceinline__ void phase_post_even(KArgP a, int layer) {
    const int lane = otid() & 63, wave = otid() >> 6;
    const int gw = blockIdx.x * 8 + wave, NGW = gridDim.x * 8, e = layer >> 1;
    const bf16* P = (const bf16*)(a->ws + WS_P); bf16* CQN = (bf16*)(a->ws + WS_CQN); bf16* CKVN = (bf16*)(a->ws + WS_CKVN); bf16* KR = (bf16*)(a->ws + WS_KR);
    const float* qg = a->in[14] + e * 384; const float* kg = a->in[16] + e * 256;
    for (int row = gw; row < MT; row += NGW) {
        const int b = row / TPB, j = row - b * TPB;
        const bf16* pr = P + (size_t)row * NP_E;
        {   float x[6]; float ss = 0.f;
#pragma unroll
            for (int k = 0; k < 3; ++k) { const unsigned w = *(const unsigned*)(pr + 2560 + 2 * lane + 128 * k); x[2 * k] = bf2f((unsigned short)(w & 0xffff)); x[2 * k + 1] = bf2f((unsigned short)(w >> 16)); ss += x[2 * k] * x[2 * k] + x[2 * k + 1] * x[2 * k + 1]; }
            const float rstd = __builtin_amdgcn_rsqf(wave_sum(ss) * (1.f / 384.f) + EPSN);
#pragma unroll
            for (int k = 0; k < 3; ++k) { const int col = 2 * lane + 128 * k; *(unsigned*)(CQN + (size_t)row * 384 + col) = pk2(x[2 * k] * rstd * qg[col], x[2 * k + 1] * rstd * qg[col + 1]); } }
        {   float x[4]; float ss = 0.f;
#pragma unroll
            for (int k = 0; k < 2; ++k) { const unsigned w = *(const unsigned*)(pr + 2944 + 2 * lane + 128 * k); x[2 * k] = bf2f((unsigned short)(w & 0xffff)); x[2 * k + 1] = bf2f((unsigned short)(w >> 16)); ss += x[2 * k] * x[2 * k] + x[2 * k + 1] * x[2 * k + 1]; }
            const float rstd = __builtin_amdgcn_rsqf(wave_sum(ss) * (1.f / 256.f) + EPSN);
#pragma unroll
            for (int k = 0; k < 2; ++k) { const int col = 2 * lane + 128 * k; *(unsigned*)(CKVN + (size_t)row * 256 + col) = pk2(x[2 * k] * rstd * kg[col], x[2 * k + 1] * rstd * kg[col + 1]); } }
        {   const int d = lane & 31; const float x = bf2f(pr[3200 + d]); const float xp = __shfl_xor(x, 8);
            float o = x;
            if (j >= 256) { const int t = j - 256, blk = d >> 4, wi = d & 15, i8 = wi & 7; const float pos = (float)(blk ? (t & 63) : (t >> 6));
                float s, c; sincos_r(pos * inv_freq(i8, 8), s, c);
                o = (wi < 8) ? (x * c - xp * s) : (xp * s + x * c); }
            if (lane < 32) KR[(size_t)row * 32 + d] = (bf16)f2bf(o); }
    }
}
__device__ __forceinline__ void phase_post_odd(KArgP a, int layer) {
    const int lane = otid() & 63, wave = otid() >> 6;
    const int gw = blockIdx.x * 8 + wave, NGW = gridDim.x * 8;
    bf16* P = (bf16*)(a->ws + WS_P);
    for (int row = gw; row < MT; row += NGW) {
        const int b = row / TPB, j = row - b * TPB; const bool lat = j >= 256; const int t = j - 256;
        bf16* pr = P + (size_t)row * NP_O;
#pragma unroll
        for (int u = 0; u < 2; ++u) { const int pid = lane + 64 * u, h = pid >> 5, i = pid & 31, d1 = h * 64 + i, d2 = d1 + 32;
            float s = 0.f, c = 1.f; if (lat) sincos_r((float)t * inv_freq(i, 32), s, c);
            const float q1 = bf2f(pr[d1]), q2 = bf2f(pr[d2]), k1 = bf2f(pr[256 + d1]) * 0.125f, k2 = bf2f(pr[256 + d2]) * 0.125f;
            if (lat) { pr[d1] = (bf16)f2bf(q1 * c - q2 * s); pr[d2] = (bf16)f2bf(q1 * s + q2 * c); }
            pr[256 + d1] = (bf16)f2bf(k1 * c - k2 * s); pr[256 + d2] = (bf16)f2bf(k1 * s + k2 * c); }
        if (lat) {
#pragma unroll
            for (int u = 0; u < 4; ++u) { const int pid = lane + 64 * u, vec = pid >> 5, pp = pid & 31, blk = pp >> 4, i = pp & 15, d1 = vec * 64 + blk * 32 + i, d2 = d1 + 16;
                const float pos = (float)(blk ? (t & 63) : (t >> 6)); float s, c; sincos_r(pos * inv_freq(i, 16), s, c);
                const float q1 = bf2f(pr[1536 + d1]), q2 = bf2f(pr[1536 + d2]), k1 = bf2f(pr[2048 + d1]), k2 = bf2f(pr[2048 + d2]);
                pr[1536 + d1] = (bf16)f2bf(q1 * c - q2 * s); pr[1536 + d2] = (bf16)f2bf(q1 * s + q2 * c);
                pr[2048 + d1] = (bf16)f2bf(k1 * c - k2 * s); pr[2048 + d2] = (bf16)f2bf(k1 * s + k2 * c); } }
    }
}

__device__ __forceinline__ void phase_readout(KArgP a, int layer) {
    const int lane = otid() & 63, wave = otid() >> 6;
    const int gw = blockIdx.x * 8 + wave, NGW = gridDim.x * 8;
    const bool even = !(layer & 1); const int np = even ? NP_E : NP_O, gcol = even ? 2048 : 1024;
    const bf16* P = (const bf16*)(a->ws + WS_P); const bf16* OF = (const bf16*)(a->ws + WS_OSC); const bf16* OB = OF + (size_t)MT * 512;
    bf16* MIX = (bf16*)(a->ws + WS_MIX);
    float g0 = 1.f, g1 = 1.f; if (even) { g0 = a->in[13][(layer >> 1) * 128 + 2 * lane]; g1 = a->in[13][(layer >> 1) * 128 + 2 * lane + 1]; }
    constexpr int RB = 3;
    for (int r0 = gw; r0 < MT; r0 += RB * NGW) {
        unsigned wf[RB][4], wb[RB][4], wg[RB][4];
#pragma unroll
        for (int k = 0; k < RB; ++k) { const int row = r0 + k * NGW; if (row < MT) {
#pragma unroll
            for (int h = 0; h < 4; ++h) { const int col = h * 128 + 2 * lane;
                wf[k][h] = *(const unsigned*)(OF + (size_t)row * 512 + col); wb[k][h] = *(const unsigned*)(OB + (size_t)row * 512 + col); wg[k][h] = *(const unsigned*)(P + (size_t)row * np + gcol + col); } } }
#pragma unroll
        for (int k = 0; k < RB; ++k) { const int row = r0 + k * NGW; if (row < MT) {
#pragma unroll
            for (int h = 0; h < 4; ++h) { const int col = h * 128 + 2 * lane;
                const float o0 = bf2f((unsigned short)(wf[k][h] & 0xffff)) + bf2f((unsigned short)(wb[k][h] & 0xffff)), o1 = bf2f((unsigned short)(wf[k][h] >> 16)) + bf2f((unsigned short)(wb[k][h] >> 16));
                const float rstd = __builtin_amdgcn_rsqf(wave_sum(o0 * o0 + o1 * o1) * (1.f / 128.f) + EPSN);
                const float y0 = o0 * rstd * g0 * silu_f(bf2f((unsigned short)(wg[k][h] & 0xffff))), y1 = o1 * rstd * g1 * silu_f(bf2f((unsigned short)(wg[k][h] >> 16)));
                *(unsigned*)(MIX + (size_t)row * 1024 + col) = pk2(y0, y1); } } }
    }
}
__device__ __forceinline__ void phase_final(KArgP a) {
    const int lane = otid() & 63, wave = otid() >> 6;
    const int gw = blockIdx.x * 8 + wave, NGW = gridDim.x * 8;
    const bf16* X = (const bf16*)(a->ws + WS_X); const float* g = a->in[22];
    constexpr int RB = 4;
    for (int r0 = gw; r0 < NB * NLAT; r0 += RB * NGW) {
        f32x4 v[RB][4];
#pragma unroll
        for (int k = 0; k < RB; ++k) { const int r = r0 + k * NGW; if (r < NB * NLAT) { const int row = (r >> 11) * TPB + 256 + (r & 2047);
#pragma unroll
            for (int q = 0; q < 4; ++q) v[k][q] = ld4_bf16(X + (size_t)row * 1024 + 4 * lane + 256 * q); } }
#pragma unroll
        for (int k = 0; k < RB; ++k) { const int r = r0 + k * NGW; if (r < NB * NLAT) { float ss = 0.f;
#pragma unroll
            for (int q = 0; q < 4; ++q) ss += (v[k][q][0] * v[k][q][0] + v[k][q][1] * v[k][q][1]) + (v[k][q][2] * v[k][q][2] + v[k][q][3] * v[k][q][3]);
            const float rstd = __builtin_amdgcn_rsqf(wave_sum(ss) * (1.f / 1024.f) + EPSN);
#pragma unroll
            for (int q = 0; q < 4; ++q) { const int col = 4 * lane + 256 * q; const f32x4 gv = *(const f32x4*)(g + col);
                *(f32x4*)(a->out + (size_t)r * 1024 + col) = v[k][q] * rstd * gv; } } }
    }
}
__device__ __forceinline__ unsigned cvtpk2(float lo, float hi) { unsigned r; asm("v_cvt_pk_bf16_f32 %0, %1, %2" : "=v"(r) : "v"(lo), "v"(hi)); return r; }
__device__ __forceinline__ f32x4 mfma16(bf16x8 a, bf16x8 b, f32x4 c) { return __builtin_amdgcn_mfma_f32_16x16x32_bf16(a, b, c, 0, 0, 0); }

template <int DK, bool HG, int MODE>
__device__ __forceinline__ void scan_item(KArgP a, int layer, int item, int seg, LAS unsigned char* lds) {
    const int tid = otid(), wid = tid >> 6, lane = tid & 63, l15 = lane & 15, q4 = lane >> 4;
    const int h = item & 3, dir = (item >> 2) & 1, b = item >> 3;
    constexpr int TPT = DK / 8, QS = DK * 2 + 16, TS = 144;
    constexpr int NP = HG ? NP_E : NP_O;
    LAS unsigned char* Lqt = lds; LAS unsigned char* Lkt = Lqt + 64 * QS; LAS unsigned char* Lqh = Lkt + 64 * QS;
    LAS unsigned char* LkhT = Lqh + 64 * QS; LAS unsigned char* LvT = LkhT + DK * TS; LAS unsigned char* Latt = LvT + 128 * TS;
    LAS float* Ltot = (LAS float*)(Latt + 64 * TS); LAS float* Lbl = Ltot + 512;
    const bf16* P = (const bf16*)(a->ws + WS_P);
    bf16* OSC = (bf16*)(a->ws + WS_OSC) + (size_t)dir * MT * 512;
    f32x4* Ub = (f32x4*)(a->ws + WS_U); float* Lb = (float*)(a->ws + WS_LSUM);
    const int c = tid & (DK - 1), tq = tid / DK;
    float lb = 0.f, lg = 0.f, qscale = 1.f; int qcol, zcol;
    if (HG) { qscale = 0.08838834764831845f; qcol = h * 128 + c; zcol = (dir ? 1536 : 1024) + h * 128 + c;
        if (layer >= 2) { const float l0 = a->in[12][(0 * 2 + dir) * 512 + h * 128 + c], l1 = a->in[12][(1 * 2 + dir) * 512 + h * 128 + c]; lb = 1.f / (1.f + __expf(l0 - l1)); } }
    else { qcol = h * 64 + c; zcol = 256 + h * 64 + c; const float x = a->in[19][((layer >> 1) * 2 + dir) * 4 + h]; lg = -__logf(1.f + __expf(-x)); }
    const int vcol = 512 + h * 128;
    const int rowbase = b * TPB;
    const int tv = lane, c8v = wid;
    unsigned short rq[TPT], rz[TPT]; bf16x8 rv[2];
#define SC_JB(ci) (dir ? ((ci) < 4 ? 255 - 64 * (ci) : 2303 - 64 * ((ci) - 4)) : 64 * (ci))
#define SC_LOAD(ci) do { const int jb_ = SC_JB(ci), sg_ = dir ? -1 : 1; \
        _Pragma("unroll") for (int i = 0; i < TPT; ++i) { const bf16* pr_ = P + (size_t)(rowbase + jb_ + sg_ * (tq * TPT + i)) * NP; if (MODE) rq[i] = pr_[qcol]; rz[i] = pr_[zcol]; } \
        { const bf16* pv_ = P + (size_t)(rowbase + jb_ + sg_ * tv) * NP + vcol; rv[0] = *(const bf16x8*)(pv_ + c8v * 8); rv[1] = *(const bf16x8*)(pv_ + (c8v + 8) * 8); } } while (0)
    f32x4 Sacc[DK / 16];
#pragma unroll
    for (int i = 0; i < DK / 16; ++i) Sacc[i] = (f32x4){0.f, 0.f, 0.f, 0.f};
    const int c0 = 9 * seg;
    SC_LOAD(c0);
    if (MODE) {
        for (int s_ = 0; s_ < seg; ++s_) {
#pragma unroll
            for (int i = 0; i < DK / 16; ++i) { f32x4 v = Sacc[i];
                if (s_ > 0) { const f32x4 l4 = *(const f32x4*)(Lb + (size_t)(item * 3 + s_) * 128 + 16 * i + 4 * q4); v[0] *= __expf(l4[0]); v[1] *= __expf(l4[1]); v[2] *= __expf(l4[2]); v[3] *= __expf(l4[3]); }
                Sacc[i] = v + Ub[((size_t)(item * 3 + s_) * (DK / 16) + i) * 512 + tid]; }
        }
    }
    float lsum = 0.f;
    for (int ci = c0; ci < c0 + 9; ++ci) {
#pragma unroll
        for (int u = 0; u < 2; ++u)
#pragma unroll
            for (int e = 0; e < 8; ++e) *(LAS unsigned short*)(LvT + ((c8v + 8 * u) * 8 + e) * TS + tv * 2) = (unsigned short)rv[u][e];
        float zf[TPT], qf[TPT];
#pragma unroll
        for (int i = 0; i < TPT; ++i) { zf[i] = bf2f(rz[i]); if (MODE) qf[i] = bf2f(rq[i]) * qscale; }
        const int jb = SC_JB(ci), sg = dir ? -1 : 1;
        if (ci + 1 < c0 + 9) SC_LOAD(ci + 1);
        float kk_[TPT], e1v[TPT], e2v[TPT]; float Eref, Ebr, dlast;
        if (HG) {
            float fv[TPT];
#pragma unroll
            for (int i = 0; i < TPT; ++i) { const float z = fminf(fmaxf(zf[i], -30.f), 30.f);
                const float t = __expf(-fabsf(z)), r = __builtin_amdgcn_rcpf(1.f + t), tr = t * r;
                const float sig = z >= 0.f ? r : tr, sigm = z >= 0.f ? tr : r;
                kk_[i] = (1.f - lb) * sigm; fv[i] = lb + (1.f - lb) * sig; }
            float run = 1.f;
            if (tq < 2) {
#pragma unroll
                for (int i = TPT - 1; i >= 0; --i) { e2v[i] = run; run *= fv[i]; }
            } else {
#pragma unroll
                for (int i = 0; i < TPT; ++i) { run *= fv[i]; e1v[i] = run; }
            }
            Ltot[tq * 128 + c] = run;
            __syncthreads();
            const float t0 = Ltot[c], t1 = Ltot[128 + c], t2 = Ltot[256 + c], t3 = Ltot[384 + c];
            Eref = t0 * t1; Ebr = t2 * t3; dlast = Eref * Ebr;
            const float mul = (tq == 0) ? t1 : ((tq == 3) ? t2 : 1.f);
            if (tq < 2) {
#pragma unroll
                for (int i = 0; i < TPT; ++i) { e2v[i] = fmaxf(e2v[i] * mul, 1e-30f); if (MODE) e1v[i] = __builtin_amdgcn_rcpf(e2v[i]); }
            } else {
#pragma unroll
                for (int i = 0; i < TPT; ++i) { e1v[i] = fmaxf(e1v[i] * mul, 1e-30f); e2v[i] = __builtin_amdgcn_rcpf(e1v[i]); }
            }
            lsum += __logf(fmaxf(dlast, 1e-37f));
        } else {
#pragma unroll
            for (int i = 0; i < TPT; ++i) { kk_[i] = zf[i]; e1v[i] = __expf((float)(tq * TPT + i - 31) * lg); e2v[i] = __builtin_amdgcn_rcpf(e1v[i]); }
            Eref = __expf(32.f * lg); Ebr = Eref; dlast = Eref * Ebr;
            lsum += 64.f * lg;
        }
        unsigned short kh[TPT];
        if (MODE) {
#pragma unroll
            for (int i = 0; i < TPT; ++i) { const int tau = tq * TPT + i;
                const float qt = qf[i] * e1v[i], kt = kk_[i] * e2v[i];
                const unsigned wq = cvtpk2(qt, qt * Eref), wk = cvtpk2(kt, kt * Ebr);
                *(LAS unsigned short*)(Lqt + tau * QS + c * 2) = (unsigned short)(wq & 0xffff);
                *(LAS unsigned short*)(Lqh + tau * QS + c * 2) = (unsigned short)(wq >> 16);
                *(LAS unsigned short*)(Lkt + tau * QS + c * 2) = (unsigned short)(wk & 0xffff);
                kh[i] = (unsigned short)(wk >> 16); }
        } else {
#pragma unroll
            for (int i = 0; i < TPT; ++i) kh[i] = (unsigned short)(cvtpk2(kk_[i] * e2v[i] * Ebr, 0.f) & 0xffff);
        }
#pragma unroll
        for (int i8 = 0; i8 < TPT / 8; ++i8) { u32x4 w; w.x = kh[8 * i8] | ((unsigned)kh[8 * i8 + 1] << 16); w.y = kh[8 * i8 + 2] | ((unsigned)kh[8 * i8 + 3] << 16);
            w.z = kh[8 * i8 + 4] | ((unsigned)kh[8 * i8 + 5] << 16); w.w = kh[8 * i8 + 6] | ((unsigned)kh[8 * i8 + 7] << 16);
            *(LAS u32x4*)(LkhT + c * TS + (tq * TPT + 8 * i8) * 2) = w; }
        if (tq == 0) Lbl[c] = dlast;
        __syncthreads();
        const int dvl = 16 * wid + l15;
        const bf16x8 bv0 = *(const LAS bf16x8*)(LvT + dvl * TS + (8 * q4) * 2), bv1 = *(const LAS bf16x8*)(LvT + dvl * TS + (32 + 8 * q4) * 2);
        if (MODE) {
#pragma unroll
            for (int tt = 0; tt < 2; ++tt) { const int idx = 2 * wid + tt, si = idx >> 2, ti = idx & 3;
                f32x4 acc = (f32x4){0.f, 0.f, 0.f, 0.f};
#pragma unroll
                for (int kk = 0; kk < DK / 32; ++kk) { const bf16x8 A = *(const LAS bf16x8*)(Lkt + (16 * si + l15) * QS + (32 * kk + 8 * q4) * 2);
                    const bf16x8 B = *(const LAS bf16x8*)(Lqt + (16 * ti + l15) * QS + (32 * kk + 8 * q4) * 2); acc = mfma16(A, B, acc); }
                const int t = 16 * ti + l15, s0 = 16 * si + 4 * q4;
                u32x2 w; w.x = pk2(s0 + 0 <= t ? acc[0] : 0.f, s0 + 1 <= t ? acc[1] : 0.f); w.y = pk2(s0 + 2 <= t ? acc[2] : 0.f, s0 + 3 <= t ? acc[3] : 0.f);
                *(LAS u32x2*)(Latt + t * TS + s0 * 2) = w; }
            __syncthreads();
            bf16x8 Sb[DK / 32];
#pragma unroll
            for (int kk = 0; kk < DK / 32; ++kk) { u32x4 w; w.x = pk2(Sacc[2 * kk][0], Sacc[2 * kk][1]); w.y = pk2(Sacc[2 * kk][2], Sacc[2 * kk][3]);
                w.z = pk2(Sacc[2 * kk + 1][0], Sacc[2 * kk + 1][1]); w.w = pk2(Sacc[2 * kk + 1][2], Sacc[2 * kk + 1][3]); Sb[kk] = __builtin_bit_cast(bf16x8, w); }
#pragma unroll
            for (int ti = 0; ti < 4; ++ti) {
                f32x4 acc = (f32x4){0.f, 0.f, 0.f, 0.f};
                { const bf16x8 A = *(const LAS bf16x8*)(Latt + (16 * ti + l15) * TS + (8 * q4) * 2); acc = mfma16(A, bv0, acc); }
                if (ti >= 2) { const bf16x8 A = *(const LAS bf16x8*)(Latt + (16 * ti + l15) * TS + (32 + 8 * q4) * 2); acc = mfma16(A, bv1, acc); }
#pragma unroll
                for (int kk = 0; kk < DK / 32; ++kk) {
                    const s16x4 lo = *(const LAS s16x4*)(Lqh + (16 * ti + l15) * QS + (32 * kk + 4 * q4) * 2), hi = *(const LAS s16x4*)(Lqh + (16 * ti + l15) * QS + (32 * kk + 16 + 4 * q4) * 2);
                    const bf16x8 A = (bf16x8){lo[0], lo[1], lo[2], lo[3], hi[0], hi[1], hi[2], hi[3]};
                    acc = mfma16(A, Sb[kk], acc); }
#pragma unroll
                for (int r = 0; r < 4; ++r) { const int t = 16 * ti + 4 * q4 + r;
                    OSC[(size_t)(rowbase + jb + sg * t) * 512 + h * 128 + dvl] = (bf16)f2bf(acc[r]); }
            }
        }
#pragma unroll
        for (int i = 0; i < DK / 16; ++i) {
            const f32x4 d4 = *(const LAS f32x4*)(Lbl + 16 * i + 4 * q4);
            f32x4 s = Sacc[i] * d4;
            const bf16x8 A0 = *(const LAS bf16x8*)(LkhT + (16 * i + l15) * TS + (8 * q4) * 2), A1 = *(const LAS bf16x8*)(LkhT + (16 * i + l15) * TS + (32 + 8 * q4) * 2);
            s = mfma16(A0, bv0, s); s = mfma16(A1, bv1, s); Sacc[i] = s; }
        __syncthreads();
    }
    if (!MODE) {
#pragma unroll
        for (int i = 0; i < DK / 16; ++i) Ub[((size_t)(item * 3 + seg) * (DK / 16) + i) * 512 + tid] = Sacc[i];
        if (tq == 0) Lb[(size_t)(item * 3 + seg) * 128 + c] = lsum;
    }
#undef SC_JB
#undef SC_LOAD
}

#define SBAR() __builtin_amdgcn_sched_barrier(0)
__device__ __forceinline__ int crow(int r, int hi) { return (r & 3) + 8 * (r >> 2) + 4 * hi; }
__device__ __forceinline__ unsigned cvtpk(float lo, float hi) { unsigned r; asm volatile("v_cvt_pk_bf16_f32 %0, %1, %2" : "=v"(r) : "v"(lo), "v"(hi)); return r; }
__device__ __forceinline__ void partialSM(f32x16& p0, f32x16& p1, float& m_reg, float& mn, float& alpha, float C, float thr_raw) {
    float pmax = p0[0];
#pragma unroll
    for (int r = 1; r < 16; ++r) pmax = fmaxf(pmax, p0[r]);
#pragma unroll
    for (int r = 0; r < 16; ++r) pmax = fmaxf(pmax, p1[r]);
    { auto rr = __builtin_amdgcn_permlane32_swap(__float_as_uint(pmax), __float_as_uint(pmax), false, false);
      pmax = fmaxf(__uint_as_float(rr[0]), __uint_as_float(rr[1])); }
    if (__builtin_expect(__all(pmax - m_reg <= thr_raw), 1)) { mn = m_reg; alpha = 1.f; }
    else { mn = fmaxf(m_reg, pmax); alpha = __builtin_amdgcn_exp2f((m_reg - mn) * C); m_reg = mn; }
    const float mnC = -mn * C;
#pragma unroll
    for (int r = 0; r < 16; ++r) p0[r] = fmaf(p0[r], C, mnC);
#pragma unroll
    for (int r = 0; r < 16; ++r) p1[r] = fmaf(p1[r], C, mnC);
#pragma unroll
    for (int r = 0; r < 16; ++r) p0[r] = __builtin_amdgcn_exp2f(p0[r]);
}
__device__ __forceinline__ void finishSM(f32x16& p0, f32x16& p1, float alpha, float& l_reg, bf16x8& pa0, bf16x8& pa1, bf16x8& pa2, bf16x8& pa3) {
#pragma unroll
    for (int r = 0; r < 16; ++r) p1[r] = __builtin_amdgcn_exp2f(p1[r]);
    float ps = 0;
#pragma unroll
    for (int r = 0; r < 16; ++r) ps += p0[r];
#pragma unroll
    for (int r = 0; r < 16; ++r) ps += p1[r];
    { auto rr = __builtin_amdgcn_permlane32_swap(__float_as_uint(ps), __float_as_uint(ps), false, false);
      ps = __uint_as_float(rr[0]) + __uint_as_float(rr[1]); }
    l_reg = l_reg * alpha + ps;
#define PK4(P, BASE, OUT) do { unsigned a0 = cvtpk(P[BASE + 0], P[BASE + 1]), a1 = cvtpk(P[BASE + 2], P[BASE + 3]);   \
    unsigned b0 = cvtpk(P[BASE + 4], P[BASE + 5]), b1 = cvtpk(P[BASE + 6], P[BASE + 7]);                              \
    auto r0 = __builtin_amdgcn_permlane32_swap(a0, b0, false, false); auto r1 = __builtin_amdgcn_permlane32_swap(a1, b1, false, false); \
    u32x4 w = {r0[0], r1[0], r0[1], r1[1]}; OUT = __builtin_bit_cast(bf16x8, w); } while (0)
    PK4(p0, 0, pa0); PK4(p0, 8, pa1); PK4(p1, 0, pa2); PK4(p1, 8, pa3);
#undef PK4
}
template <int ND0, int KROWB>
__device__ __forceinline__ void qkt(f32x16& p0, f32x16& p1, const char* Ks, const bf16x8* qr, int r32, int hi) {
    p0 = f32x16{}; p1 = f32x16{};
#pragma unroll
    for (int d0 = 0; d0 < ND0; ++d0) { const int cb = (d0 * 16 + hi * 8) * 2;
        const bf16x8 b0 = *reinterpret_cast<const bf16x8*>(Ks + r32 * KROWB + (cb ^ ((r32 & 7) << 4)));
        const bf16x8 b1 = *reinterpret_cast<const bf16x8*>(Ks + (32 + r32) * KROWB + (cb ^ ((r32 & 7) << 4)));
        p0 = __builtin_amdgcn_mfma_f32_32x32x16_bf16(b0, qr[d0], p0, 0, 0, 0);
        p1 = __builtin_amdgcn_mfma_f32_32x32x16_bf16(b1, qr[d0], p1, 0, 0, 0); }
}
template <int NCB> __device__ __forceinline__ int v_st(int k, int c) { const int kk = (k & ~0xC) | ((k & 4) << 1) | ((k & 8) >> 1); return ((kk >> 3) * NCB + (c >> 5)) * 512 + ((kk & 7) * 32 + (c & 31)) * 2; }
__device__ __forceinline__ int v_rd_base(int lane) { return ((lane & 3) << 3) | (((lane >> 2) & 3) << 6) | (((lane >> 4) & 1) << 5) | (((lane >> 5) & 1) << 8); }
template <int OFF> __device__ __forceinline__ s16x4 tr_read(int vb) {
    s16x4 r; asm volatile("ds_read_b64_tr_b16 %0, %1 offset:%2" : "=&v"(r) : "v"(vb), "i"(OFF) : "memory"); return r;
}
template <int NCB, int D0> __device__ __forceinline__ void pv_one(f32x16& od, int vb, bf16x8 pa0, bf16x8 pa1, bf16x8 pa2, bf16x8 pa3) {
#define VOFF(ks, half) (D0 * 512 + (ks) * (NCB * 1024) + (half) * (NCB * 512))
    const s16x4 l0 = tr_read<VOFF(0, 0)>(vb), h0 = tr_read<VOFF(0, 1)>(vb), l1 = tr_read<VOFF(1, 0)>(vb), h1 = tr_read<VOFF(1, 1)>(vb);
    const s16x4 l2 = tr_read<VOFF(2, 0)>(vb), h2 = tr_read<VOFF(2, 1)>(vb), l3 = tr_read<VOFF(3, 0)>(vb), h3 = tr_read<VOFF(3, 1)>(vb);
#undef VOFF
    asm volatile("s_waitcnt lgkmcnt(0)" ::: "memory"); SBAR();
#define PK(L, H) (bf16x8){L[0], L[1], L[2], L[3], H[0], H[1], H[2], H[3]}
    od = __builtin_amdgcn_mfma_f32_32x32x16_bf16(pa0, PK(l0, h0), od, 0, 0, 0);
    od = __builtin_amdgcn_mfma_f32_32x32x16_bf16(pa1, PK(l1, h1), od, 0, 0, 0);
    od = __builtin_amdgcn_mfma_f32_32x32x16_bf16(pa2, PK(l2, h2), od, 0, 0, 0);
    od = __builtin_amdgcn_mfma_f32_32x32x16_bf16(pa3, PK(l3, h3), od, 0, 0, 0);
#undef PK
}
template <int NCB> __device__ __forceinline__ void pv_all(f32x16* o, int vb, bf16x8 pa0, bf16x8 pa1, bf16x8 pa2, bf16x8 pa3) {
    pv_one<NCB, 0>(o[0], vb, pa0, pa1, pa2, pa3); pv_one<NCB, 1>(o[1], vb, pa0, pa1, pa2, pa3);
    if constexpr (NCB == 4) { pv_one<NCB, 2>(o[2], vb, pa0, pa1, pa2, pa3); pv_one<NCB, 3>(o[3], vb, pa0, pa1, pa2, pa3); }
}

template <int DQK, int DV, int KROWB>
__device__ __forceinline__ void attn_core(const bf16x8* qr, const bf16* kA, int sA, const bf16* kB, int sB, const bf16* vP, int sV,
                                          int NT, float C, float thr_raw, char* lds, f32x16* o, float& l_out, const int tid) {
    constexpr int NCB = DV / 32, SHM_V = 64 * DV * 2, SHM_K = 64 * KROWB, ND0 = DQK / 16;
    constexpr int PPR = DQK / 8, NPK = 64 * PPR, NKS = (NPK + 511) / 512, VPR = DV / 8, NVS = 64 * VPR / 512;
    const int wid = tid >> 6, lane = tid & 63, r32 = lane & 31, hi = lane >> 5;
    char* V_lds = lds; char* K_lds = lds + 2 * SHM_V;
    float* wsf = (float*)(lds + 2 * SHM_V + 2 * SHM_K) + wid * 64; float* al_l = wsf + 32;
    float m_reg = -1e30f, l_reg = 0;
    const bf16* kp[NKS]; int kadv[NKS], kst[NKS]; bool kval[NKS];
#pragma unroll
    for (int i = 0; i < NKS; ++i) { int p = tid + 512 * i; kval[i] = p < NPK; if (!kval[i]) p -= 512; const int row = p / PPR, c8 = p - row * PPR;
        if (c8 < 8) { kp[i] = kA + (size_t)row * sA + c8 * 8; kadv[i] = 64 * sA; } else { kp[i] = kB + (size_t)row * sB + (c8 - 8) * 8; kadv[i] = 64 * sB; }
        kst[i] = row * KROWB + ((c8 * 16) ^ ((row & 7) << 4)); }
    const bf16* vp[NVS]; int vst[NVS];
#pragma unroll
    for (int i = 0; i < NVS; ++i) { const int p = tid + 512 * i, row = p / VPR, c8 = p % VPR; vp[i] = vP + (size_t)row * sV + c8 * 8; vst[i] = v_st<NCB>(row, c8 * 8); }
    const int vadv = 64 * sV;
    const int vb0 = (int)(uintptr_t)V_lds + v_rd_base(lane);
    struct { bf16x8 ks[NKS]; bf16x8 vs[NVS]; } sr_[1];
#define SLOAD(i, t) do { _Pragma("unroll") for (int s_ = 0; s_ < NKS; ++s_) sr_[i].ks[s_] = *(const bf16x8*)(kp[s_] + (size_t)(t) * kadv[s_]); \
        _Pragma("unroll") for (int s_ = 0; s_ < NVS; ++s_) sr_[i].vs[s_] = *(const bf16x8*)(vp[s_] + (size_t)(t) * vadv); } while (0)
#define SWRITE(b, i) do { _Pragma("unroll") for (int s_ = 0; s_ < NVS; ++s_) *(bf16x8*)(V_lds + (b) * SHM_V + vst[s_]) = sr_[i].vs[s_]; \
        _Pragma("unroll") for (int s_ = 0; s_ < NKS; ++s_) if (kval[s_]) *(bf16x8*)(K_lds + (b) * SHM_K + kst[s_]) = sr_[i].ks[s_]; } while (0)
#define RESC(a) do { if (__any((a) < 1.f)) { if (hi == 0) al_l[r32] = (a); asm volatile("s_waitcnt lgkmcnt(0)" ::: "memory"); \
        _Pragma("unroll") for (int d = 0; d < NCB; ++d) _Pragma("unroll") for (int r = 0; r < 16; ++r) o[d][r] *= al_l[crow(r, hi)]; } } while (0)
    f32x16 pA0, pA1, pB0, pB1; float mnA, mnB, alA, alB; bf16x8 pa0, pa1, pa2, pa3;
    constexpr int SE = 0, SO = 0;
    SLOAD(SE, 0); SWRITE(0, SE); __syncthreads();
    qkt<ND0, KROWB>(pA0, pA1, K_lds, qr, r32, hi); partialSM(pA0, pA1, m_reg, mnA, alA, C, thr_raw);
    SLOAD(SO, 1);
    SWRITE(1, SO); __syncthreads();
    for (int j = 1; j + 1 < NT; j += 2) {
        SBAR(); qkt<ND0, KROWB>(pB0, pB1, K_lds + SHM_K, qr, r32, hi);
        finishSM(pA0, pA1, alA, l_reg, pa0, pa1, pa2, pa3); SBAR();
        SLOAD(SO, j + 1); SBAR();
        pv_all<NCB>(o, vb0, pa0, pa1, pa2, pa3); partialSM(pB0, pB1, m_reg, mnB, alB, C, thr_raw);
        __syncthreads(); SWRITE(0, SE);
        RESC(alB); __syncthreads();
        SBAR(); qkt<ND0, KROWB>(pA0, pA1, K_lds, qr, r32, hi);
        finishSM(pB0, pB1, alB, l_reg, pa0, pa1, pa2, pa3); SBAR();
        SLOAD(SE, j + 2); SBAR();
        pv_all<NCB>(o, vb0 + SHM_V, pa0, pa1, pa2, pa3); partialSM(pA0, pA1, m_reg, mnA, alA, C, thr_raw);
        __syncthreads(); SWRITE(1, SO);
        RESC(alA); __syncthreads();
    }
    SBAR(); qkt<ND0, KROWB>(pB0, pB1, K_lds + SHM_K, qr, r32, hi);
    finishSM(pA0, pA1, alA, l_reg, pa0, pa1, pa2, pa3); SBAR();
    pv_all<NCB>(o, vb0, pa0, pa1, pa2, pa3); partialSM(pB0, pB1, m_reg, mnB, alB, C, thr_raw);
    __syncthreads(); RESC(alB);
    finishSM(pB0, pB1, alB, l_reg, pa0, pa1, pa2, pa3); SBAR();
    pv_all<NCB>(o, vb0 + SHM_V, pa0, pa1, pa2, pa3);
    l_out = l_reg;
#undef SLOAD
#undef SWRITE
#undef RESC
}

__device__ __forceinline__ void mla_item(KArgP a, int b, int h, int qb, char* lds) {
    const int tid = ptid(), wid = tid >> 6, lane = tid & 63, r32 = lane & 31, hi = lane >> 5;
    const bf16* Qb = (const bf16*)((const unsigned char*)a->out + OUT_Q); const bf16* KV = (const bf16*)((const unsigned char*)a->out + OUT_KV);
    const bf16* KR = (const bf16*)(a->ws + WS_KR); bf16* MIX = (bf16*)(a->ws + WS_MIX);
    const int row0 = b * TPB + qb * 256, krow0 = b * TPB, NT = qb ? 36 : 4;
    const int row = row0 + wid * 32 + r32;
    const bf16* Qw = Qb + (size_t)row * 768 + h * 96;
    bf16x8 qr[6];
#pragma unroll
    for (int d0 = 0; d0 < 4; ++d0) qr[d0] = *(const bf16x8*)(Qw + d0 * 16 + hi * 8);
    const int t = (qb - 1) * 256 + wid * 32 + r32;
#pragma unroll
    for (int d0 = 4; d0 < 6; ++d0) {
        const bf16x8 x1 = *(const bf16x8*)(Qw + d0 * 16), x2 = *(const bf16x8*)(Qw + d0 * 16 + 8);
        if (qb) { const float pos = (float)(d0 == 4 ? (t >> 6) : (t & 63)); unsigned short ov[8];
#pragma unroll
            for (int i = 0; i < 8; ++i) { float s, c; sincos_r(pos * inv_freq(i, 8), s, c); const float f1 = bf2f((unsigned short)x1[i]), f2 = bf2f((unsigned short)x2[i]);
                ov[i] = (unsigned short)f2bf(hi ? (f1 * s + f2 * c) : (f1 * c - f2 * s)); }
            qr[d0] = (bf16x8){(short)ov[0], (short)ov[1], (short)ov[2], (short)ov[3], (short)ov[4], (short)ov[5], (short)ov[6], (short)ov[7]};
        } else qr[d0] = hi ? x2 : x1;
    }
    f32x16 o[2] = {}; float l_reg;
    const float scale = 0.10206207261596575f;
    attn_core<96, 64, 256>(qr, KV + (size_t)krow0 * 1024 + h * 128, 1024, KR + (size_t)krow0 * 32, 32, KV + (size_t)krow0 * 1024 + h * 128 + 64, 1024,
                           NT, scale * 1.4426950408889634f, 8.f / scale, lds, o, l_reg, tid);
    float* li_l = (float*)(lds + 2 * 64 * 64 * 2 + 2 * 64 * 256) + wid * 64;
    if (hi == 0) li_l[r32] = l_reg; asm volatile("s_waitcnt lgkmcnt(0)" ::: "memory");
#pragma unroll
    for (int r = 0; r < 16; ++r) { const int orow = crow(r, hi); const float rl = __builtin_amdgcn_rcpf(li_l[orow]);
        bf16* op = MIX + (size_t)(row0 + wid * 32 + orow) * 1024 + 512 + h * 64 + r32;
        op[0] = (bf16)f2bf(o[0][r] * rl); op[32] = (bf16)f2bf(o[1][r] * rl); }
}
__device__ __forceinline__ void diff_item(KArgP a, int layer, int b, int h, int qb, char* lds) {
    const int row0 = b * TPB + qb * 256, krow0 = b * TPB, NT = qb ? 36 : 4, o_ = layer >> 1;
    const float scale = 0.125f;
#pragma unroll 1
    for (int m = 0; m < 2; ++m) {
        f32x16 o[4] = {};
        float l_reg;
        {
            const int tid = ptid(), wid = tid >> 6, lane = tid & 63, r32 = lane & 31, hi = lane >> 5;
            const bf16* P = (const bf16*)(a->ws + WS_P);
            const bf16* Qw = P + (size_t)(row0 + wid * 32 + r32) * NP_O + 1536 + h * 128 + m * 64;
            bf16x8 qr[4];
#pragma unroll
            for (int d0 = 0; d0 < 4; ++d0) qr[d0] = *(const bf16x8*)(Qw + d0 * 16 + hi * 8);
            const bf16* Kp = P + (size_t)krow0 * NP_O + 2048 + h * 128 + m * 64;
            attn_core<64, 128, 128>(qr, Kp, NP_O, Kp, NP_O, P + (size_t)krow0 * NP_O + 2560 + h * 128, NP_O,
                                    NT, scale * 1.4426950408889634f, 8.f / scale, lds, o, l_reg, tid);
        }
        const int tid = ptid(), wid = tid >> 6, lane = tid & 63, r32 = lane & 31, hi = lane >> 5;
        float* li_l = (float*)(lds + 2 * 64 * 128 * 2 + 2 * 64 * 128) + wid * 64;
        if (hi == 0) li_l[r32] = l_reg; asm volatile("s_waitcnt lgkmcnt(0)" ::: "memory");
        float* dsb = (float*)a->out + (size_t)blockIdx.x * 64 * 512 + tid; asm volatile("" : "+v"(dsb));
        if (m == 0) {
#pragma unroll
            for (int r = 0; r < 16; ++r) { const float rl = __builtin_amdgcn_rcpf(li_l[crow(r, hi)]);
#pragma unroll
                for (int d = 0; d < 4; ++d) dsb[(size_t)(d * 16 + r) * 512] = o[d][r] * rl; }
        } else {
            bf16* MIX = (bf16*)(a->ws + WS_MIX);
            const float* lp = a->in[20] + o_ * 256;
            const float lam_init = 0.8f - 0.6f * __expf(-0.3f * (float)layer);
            const float lam = __expf(wave_sum(lp[lane] * lp[64 + lane])) - __expf(wave_sum(lp[128 + lane] * lp[192 + lane])) + lam_init;
            const float* sg = a->in[21] + o_ * 128;
#pragma unroll
            for (int r = 0; r < 16; ++r) { const float rl = __builtin_amdgcn_rcpf(li_l[crow(r, hi)]); float s = 0.f; float v[4];
#pragma unroll
                for (int d = 0; d < 4; ++d) { v[d] = dsb[(size_t)(d * 16 + r) * 512] - lam * (o[d][r] * rl); s += v[d] * v[d]; }
                s += __shfl_xor(s, 16); s += __shfl_xor(s, 8); s += __shfl_xor(s, 4); s += __shfl_xor(s, 2); s += __shfl_xor(s, 1);
                const float rs = __builtin_amdgcn_rsqf(s * (1.f / 128.f) + EPSN) * (1.f - lam_init);
                bf16* op = MIX + (size_t)(row0 + wid * 32 + crow(r, hi)) * 1024 + 512 + h * 128 + r32;
#pragma unroll
                for (int d = 0; d < 4; ++d) op[32 * d] = (bf16)f2bf(v[d] * rs * sg[32 * d + r32]);
                asm volatile("" ::: "memory"); }
        }
        asm volatile("s_waitcnt vmcnt(0) lgkmcnt(0)" ::: "memory");
    }
}

__device__ __forceinline__ void phase_mixer(KArgP a, int layer, unsigned char* ldsg) {
    LAS unsigned char* lds = (LAS unsigned char*)ldsg;
    volatile LAS unsigned* flag = (volatile LAS unsigned*)(lds + LDS_MAIN);
    unsigned* ctr = (unsigned*)(a->ws + WS_CTL) + layer; layer &= 7;
    const bool even = !(layer & 1), need_ctx = layer < 3;
    constexpr int NSC = 256;
    const int n_lat = even ? 512 : 256, n_ctx = need_ctx ? (even ? 64 : 32) : 0, total = NSC + n_lat + n_ctx;
    for (;;) {
        __syncthreads();
        if (ptid() == 0) *flag = atomicAdd(ctr, 1u);
        __syncthreads();
        const int qi_ = (int)*flag;
        if (qi_ >= total) break;
        const int item = qi_ < n_lat ? NSC + qi_ : (qi_ < n_lat + NSC ? qi_ - n_lat : qi_);
#ifdef PROBE_ITEM
        const unsigned long long it0_ = __builtin_amdgcn_s_memrealtime();
#endif
#ifndef SKIP_SCAN
        if (item < NSC) { if (even) scan_item<128, true, 1>(a, layer, item & 63, item >> 6, lds); else scan_item<64, false, 1>(a, layer, item & 63, item >> 6, lds); }
#else
        if (item < NSC) {}
#endif
        else { int b_, h_, qb_;
            if (item < NSC + n_lat) { const int i = item - NSC; qb_ = 1 + (i & 7); if (even) { b_ = i >> 6; h_ = (i >> 3) & 7; } else { b_ = i >> 5; h_ = (i >> 3) & 3; } }
            else { const int i = item - NSC - n_lat; qb_ = 0; if (even) { b_ = i >> 3; h_ = i & 7; } else { b_ = i >> 2; h_ = i & 3; } }
#ifndef SKIP_ATTN
            if (even) mla_item(a, b_, h_, qb_, (char*)ldsg); else diff_item(a, layer, b_, h_, qb_, (char*)ldsg);
#endif
        }
#ifdef PROBE_ITEM
        __syncthreads();
        if (otid() == 0) { volatile LAS unsigned long long* pc_ = (volatile LAS unsigned long long*)(lds + LDS_MAIN + 128); const int k_ = item < NSC ? 0 : (even ? 1 : 2); pc_[k_] += __builtin_amdgcn_s_memrealtime() - it0_; }
#endif
    }
}

#define XB_TMO      128
#define XB_XCNT(j)  (256  + 64 * (j))
#define XB_XSUB(j)  (1280 + 64 * (j))
#define XB_XGEN(j)  (2304 + 64 * (j))
#define XB_TOP      3328
#define XB_TOPGEN   3392
#define XCD_BAR_WORDS 3456
#define XB_SPIN_CAP (1u << 18)

__device__ __forceinline__ unsigned xb_ld(unsigned* p)              { return __hip_atomic_load(p, __ATOMIC_RELAXED, __HIP_MEMORY_SCOPE_AGENT); }
__device__ __forceinline__ unsigned xb_add(unsigned* p, unsigned v) { return __hip_atomic_fetch_add(p, v, __ATOMIC_RELAXED, __HIP_MEMORY_SCOPE_AGENT); }
__device__ __forceinline__ unsigned xb_xcc_id() { return (unsigned)__builtin_amdgcn_s_getreg((3 << 11) | 20) & 0xFu; }
#define XB_SPIN(cond, bar) do { unsigned _sp = 0; while (cond) { __builtin_amdgcn_s_sleep(1); \
    if ((++_sp & 255u) == 0u) { if (xb_ld(&(bar)[XB_TMO])) break; if (_sp > XB_SPIN_CAP) { atomicAdd(&(bar)[XB_TMO], 1u); break; } } } } while (0)

struct XcdBarrier {
    unsigned* bar; unsigned x;
    volatile LAS unsigned* st;
};

__device__ __forceinline__ XcdBarrier xcd_barrier_post(unsigned* bar, volatile LAS unsigned* st) {
    XcdBarrier b; b.bar = bar; b.x = xb_xcc_id(); b.st = st;
    if (threadIdx.x == 0) (void)xb_add(&bar[XB_XCNT(b.x)], 1u);
    return b;
}
__device__ __forceinline__ void xcd_barrier_complete(unsigned* bar, unsigned x, unsigned& nloc, unsigned& nx) {
    const unsigned G = gridDim.x * gridDim.y * gridDim.z;
    unsigned sum, cnt, mine, sp = 0u;
    for (;;) {
        sum = 0u; cnt = 0u; mine = 0u;
#pragma unroll
        for (unsigned j = 0; j < 16; ++j) { const unsigned c = xb_ld(&bar[XB_XCNT(j)]); sum += c; cnt += (c > 0u) ? 1u : 0u; mine = (j == x) ? c : mine; }
        if (sum == G) break;
        __builtin_amdgcn_s_sleep(1);
        if ((++sp & 255u) == 0u) { if (xb_ld(&bar[XB_TMO])) break; if (sp > XB_SPIN_CAP) { atomicAdd(&bar[XB_TMO], 1u); break; } }
    }
    nloc = mine > 0u ? mine : 1u; nx = cnt > 0u ? cnt : 1u;
}

__device__ __forceinline__ void xcd_barrier(const XcdBarrier& b) {
    asm volatile("s_waitcnt vmcnt(0)" ::: "memory");
    __syncthreads();
    if (threadIdx.x == 0) {
        unsigned* bar = b.bar;
        __builtin_amdgcn_s_waitcnt(0);
        unsigned nloc = b.st[0], nx = b.st[1];
        if (nloc == 0u) { xcd_barrier_complete(bar, b.x, nloc, nx); b.st[0] = nloc; b.st[1] = nx; }
        const unsigned old = xb_add(&bar[XB_XSUB(b.x)], 1u);
        const unsigned gen = old / nloc;
        if (old + 1u == (gen + 1u) * nloc) {
            __builtin_amdgcn_fence(__ATOMIC_RELEASE, "agent");
            asm volatile("s_waitcnt vmcnt(0)" ::: "memory");
            const unsigned og = xb_add(&bar[XB_TOP], 1u);
            const unsigned tg = og / nx;
            if (og + 1u == (tg + 1u) * nx) xb_add(&bar[XB_TOPGEN], 1u);
            else XB_SPIN(xb_ld(&bar[XB_TOPGEN]) == tg, bar);
            __builtin_amdgcn_fence(__ATOMIC_ACQUIRE, "agent");
            xb_add(&bar[XB_XGEN(b.x)], 1u);
            asm volatile("s_waitcnt vmcnt(0)" ::: "memory");
        } else {
            XB_SPIN(xb_ld(&bar[XB_XGEN(b.x)]) == gen, bar);
            __builtin_amdgcn_fence(__ATOMIC_ACQUIRE, "agent");
            asm volatile("s_waitcnt vmcnt(0)" ::: "memory");
        }
    }
    __syncthreads();
}

__global__ void __launch_bounds__(512, 2) mega_fwd(Args a_) {
    extern __shared__ __attribute__((aligned(16))) unsigned char lds_raw[];
    LAS unsigned char* lds = (LAS unsigned char*)lds_raw;
    ((LAS int*)(lds + LDS_MAIN + 1024))[threadIdx.x] = (int)threadIdx.x;
    if (threadIdx.x < 4) ((LAS unsigned*)(lds + LDS_MAIN + 64))[threadIdx.x] = 0u;
    if (threadIdx.x < 8) ((LAS unsigned*)(lds + LDS_MAIN + 128))[threadIdx.x] = 0u;
    __syncthreads();
    XcdBarrier xbar; xbar.bar = nullptr; xbar.x = 0; xbar.st = nullptr; bool xb_ready = false;
    cg::grid_group grid = cg::this_grid();
    int ph = 0;
#ifdef PROBE_MASK
    unsigned long long pr_last = __builtin_amdgcn_s_memrealtime(), pr_acc = 0ull;
#define PROBE_STAMP(k) { const unsigned long long now_ = __builtin_amdgcn_s_memrealtime(); if ((PROBE_MASK >> (k)) & 1) pr_acc += now_ - pr_last; pr_last = now_; }
#else
#define PROBE_STAMP(k)
#endif
    const int plo = a_.lo, phi = a_.hi;
#define PH_BEGIN if (ph >= plo && ph < phi) { KArgP a = kargs(); int bx = (int)blockIdx.x, G = (int)gridDim.x; asm volatile("" : "+s"(bx), "+s"(G)); (void)bx; (void)G;
#ifdef PROBE_SYNC2
#define PH_ENDT(k)   if (ph + 1 < phi) { grid.sync(); grid.sync(); } } ++ph;
#else
#define PH_ENDT(k) if (ph + 1 < phi) { if (!xb_ready) { grid.sync(); xbar = xcd_barrier_post((unsigned*)(a->ws + WS_CTL) + 4096, (volatile LAS unsigned*)(lds + LDS_MAIN + 64)); xb_ready = true; } else xcd_barrier(xbar); } PROBE_STAMP(k) } ++ph;
#endif

    PH_BEGIN phase_prep(a, lds); PH_ENDT(0)

    for (int layer = 0; layer < 4; ++layer) {
        const bool even = !(layer & 1);
        const int np = even ? NP_E : NP_O;
        PH_BEGIN phase_norm(a, layer, 0, layer > 0); convert_weights(a, layer, lds); PH_ENDT(1)
#ifndef SKIP_G1
        PH_BEGIN { bf16* H = (bf16*)(a->ws + WS_H); bf16* MIX = (bf16*)(a->ws + WS_MIX); bf16* P = (bf16*)(a->ws + WS_P); bf16* X = (bf16*)(a->ws + WS_X); unsigned char* Wb = a->ws + WS_W; const float* mod = (const float*)(a->ws + WS_MOD) + (size_t)layer * 9 * 6144; (void)H; (void)MIX; (void)P; (void)X; (void)mod; pg8::Gemm g{H, (const bf16*)(Wb + W_IN), MT, np, 1024, 1024}; pg8::StaticOrder S; S.init(MT, np, G, bx);
                   pg8::EpiBf16<0> E{P, np, nullptr, 0, 0, 1.f};
                   pg8::gemm_phase<pg8::EpiBf16<0>, pg8::StaticOrder, true, true>(lds, g, S, E); } PH_ENDT(2)
#else
        ++ph;
#endif
        PH_BEGIN if (even) phase_post_even(a, layer); else phase_post_odd(a, layer); PH_ENDT(3)
#ifndef SKIP_G3
        if (even) {
            PH_BEGIN { bf16* H = (bf16*)(a->ws + WS_H); bf16* MIX = (bf16*)(a->ws + WS_MIX); bf16* P = (bf16*)(a->ws + WS_P); bf16* X = (bf16*)(a->ws + WS_X); unsigned char* Wb = a->ws + WS_W; const float* mod = (const float*)(a->ws + WS_MOD) + (size_t)layer * 9 * 6144; (void)H; (void)MIX; (void)P; (void)X; (void)mod; pg8::Gemm g{(const bf16*)(a->ws + WS_CQN), (const bf16*)(Wb + W_UQ), MT, 768, 384, 384}; pg8::StaticOrder S; S.init(MT, 768, G, bx);
                       pg8::EpiBf16<0> E{(bf16*)((unsigned char*)a->out + OUT_Q), 768, nullptr, 0, 0, 1.f};
                       pg8::gemm_phase<pg8::EpiBf16<0>, pg8::StaticOrder, true, true>(lds, g, S, E); }
                     { unsigned char* Wb = a->ws + WS_W; pg8::Gemm g{(const bf16*)(a->ws + WS_CKVN), (const bf16*)(Wb + W_UKV), MT, 1024, 256, 256}; pg8::StaticOrder S; S.init(MT, 1024, G, bx);
                       pg8::EpiBf16<0> E{(bf16*)((unsigned char*)a->out + OUT_KV), 1024, nullptr, 0, 0, 1.f};
                       pg8::gemm_phase<pg8::EpiBf16<0>, pg8::StaticOrder, true, true>(lds, g, S, E); }
                     for (int it = bx; it < 192; it += G) scan_item<128, true, 0>(a, layer, it & 63, it >> 6, lds);
            PH_ENDT(4)
        } else { ++ph; }
#else
        ++ph;
#endif
        if (!even) {
        PH_BEGIN for (int it = bx; it < 192; it += G) scan_item<64, false, 0>(a, layer, it & 63, it >> 6, lds); PH_ENDT(5)
        } else { ++ph; }
#ifdef PROBE_MIX2
        PH_BEGIN phase_mixer(a, layer + 8, lds_raw); grid.sync(); PH_ENDT(6)
        --ph;
#endif
        PH_BEGIN phase_mixer(a, layer, lds_raw); PH_ENDT(6 + 7 * (layer & 1))
        PH_BEGIN phase_readout(a, layer); PH_ENDT(7)
#ifndef SKIP_G6
        PH_BEGIN { bf16* H = (bf16*)(a->ws + WS_H); bf16* MIX = (bf16*)(a->ws + WS_MIX); bf16* P = (bf16*)(a->ws + WS_P); bf16* X = (bf16*)(a->ws + WS_X); unsigned char* Wb = a->ws + WS_W; const float* mod = (const float*)(a->ws + WS_MOD) + (size_t)layer * 9 * 6144; (void)H; (void)MIX; (void)P; (void)X; (void)mod; pg8::Gemm g{MIX, (const bf16*)(Wb + W_OUT), MT, 1024, 1024, 1024}; pg8::StaticOrder S; S.init(NB * NLAT, 1024, G, bx, 1);
                   pg8::EpiResid E{X, mod, 2048, layer == 0 ? a->in[0] : nullptr};
                   pg8::gemm_phase<pg8::EpiResid, pg8::StaticOrder, true, true>(lds, g, S, E);
                   if (layer < 3) { pg8::Gemm g2{MIX, (const bf16*)(Wb + W_OUT), MT, 1024, 512, 1024}; pg8::CtxSplitOrder S2{G, bx, 512};
                       pg8::EpiResidSplit E2{X, (float*)(a->ws + WS_T), mod, 2048, layer == 0 ? a->in[2] : nullptr};
                       pg8::gemm_phase<pg8::EpiResidSplit, pg8::CtxSplitOrder, true, true>(lds, g2, S2, E2); } } PH_ENDT(8)
#else
        ++ph;
#endif
        PH_BEGIN phase_norm(a, layer, 1, layer < 3); PH_ENDT(9)
#ifndef SKIP_G8
        PH_BEGIN { bf16* H = (bf16*)(a->ws + WS_H); bf16* MIX = (bf16*)(a->ws + WS_MIX); bf16* P = (bf16*)(a->ws + WS_P); bf16* X = (bf16*)(a->ws + WS_X); unsigned char* Wb = a->ws + WS_W; const float* mod = (const float*)(a->ws + WS_MOD) + (size_t)layer * 9 * 6144; (void)H; (void)MIX; (void)P; (void)X; (void)mod; pg8::Gemm g{H, (const bf16*)(Wb + W_GU), MT, 2 * FF, 1024, 1024}; pg8::StaticOrder S; if (layer < 3) S.init(MT, 2 * FF, G, bx); else S.init(NB * NLAT, 2 * FF, G, bx, 1);
                   pg8::EpiSwiGLU E{P, FF};
                   pg8::gemm_phase<pg8::EpiSwiGLU, pg8::StaticOrder, true, true>(lds, g, S, E); } PH_ENDT(10)
#else
        ++ph;
#endif
#ifndef SKIP_G9
        PH_BEGIN { bf16* H = (bf16*)(a->ws + WS_H); bf16* MIX = (bf16*)(a->ws + WS_MIX); bf16* P = (bf16*)(a->ws + WS_P); bf16* X = (bf16*)(a->ws + WS_X); unsigned char* Wb = a->ws + WS_W; const float* mod = (const float*)(a->ws + WS_MOD) + (size_t)layer * 9 * 6144; (void)H; (void)MIX; (void)P; (void)X; (void)mod; pg8::Gemm g{P, (const bf16*)(Wb + W_DN), MT, 1024, FF, FF}; pg8::StaticOrder S; S.init(NB * NLAT, 1024, G, bx, 1);
                   pg8::EpiResid E{X, mod, 5120, nullptr};
                   pg8::gemm_phase<pg8::EpiResid, pg8::StaticOrder, true, true>(lds, g, S, E);
                   if (layer < 3) { pg8::Gemm g2{P, (const bf16*)(Wb + W_DN), MT, 1024, FF / 2, FF}; pg8::CtxSplitOrder S2{G, bx, FF / 2};
                       pg8::EpiResidSplit E2{X, (float*)(a->ws + WS_T), mod, 5120, nullptr};
                       pg8::gemm_phase<pg8::EpiResidSplit, pg8::CtxSplitOrder, true, true>(lds, g2, S2, E2); } } PH_ENDT(11)
#else
        ++ph;
#endif
    }
    PH_BEGIN phase_final(a); PH_ENDT(12)
#undef PH_BEGIN
#undef PH_ENDT
#ifdef PROBE_ITEM
    pr_acc += ((volatile LAS unsigned long long*)(lds + LDS_MAIN + 128))[PROBE_ITEM - 1];
#endif
#ifdef PROBE_MASK
    if (blockIdx.x == 0) { const unsigned long long t0_ = __builtin_amdgcn_s_memrealtime(); while (__builtin_amdgcn_s_memrealtime() - t0_ < pr_acc) __builtin_amdgcn_s_sleep(8); }
#endif
}
constexpr int NPH = 1 + 4 * 11 + 1;

extern "C" void kernel_launch(void* const* d_in, const int* in_sizes, int n_in, void* d_out, int out_size, void* d_ws, size_t ws_size, hipStream_t stream) {
    static int grid = 0;
    if (grid == 0) {
        if (n_in != 23 || ws_size < WS_END || out_size != NB * NLAT * DM) { fprintf(stderr, "kernel_launch: unexpected shapes: n_in %d ws %zu (need %zu) out %d\n", n_in, ws_size, (size_t)WS_END, out_size); grid = -1; return; }
        int dev = 0, cus = 0, per_cu = 0;
        hipGetDevice(&dev); hipDeviceGetAttribute(&cus, hipDeviceAttributeMultiprocessorCount, dev);
        if (hipFuncSetAttribute((const void*)mega_fwd, hipFuncAttributeMaxDynamicSharedMemorySize, LDS_BYTES) != hipSuccess) { fprintf(stderr, "kernel_launch: hipFuncSetAttribute failed\n"); grid = -1; return; }
        if (hipOccupancyMaxActiveBlocksPerMultiprocessor(&per_cu, (const void*)mega_fwd, 512, LDS_BYTES) != hipSuccess || per_cu < 1) { fprintf(stderr, "kernel_launch: occupancy query says %d\n", per_cu); per_cu = 1; }
        (void)hipGetLastError();
        grid = cus;
    }
    if (grid < 0) return;
    Args a{};
    for (int i = 0; i < 23; ++i) a.in[i] = (const float*)d_in[i];
    a.out = (float*)d_out; a.ws = (unsigned char*)d_ws; a.lo = 0; a.hi = NPH;
    void* kargv[] = {&a};
    hipError_t e = hipLaunchCooperativeKernel((const void*)mega_fwd, dim3(grid), dim3(512), kargv, LDS_BYTES, stream);
    if (e != hipSuccess) fprintf(stderr, "kernel_launch: cooperative launch failed: %s (grid %d)\n", hipGetErrorString(e), grid);
}
```

```cpp
#include <hip/hip_runtime.h>
#include <hip/hip_cooperative_groups.h>
#include <cstdio>
#include <cstdint>
namespace cg = cooperative_groups;
#define otid() ({ int t_ = (int)threadIdx.x; asm volatile("" : "+v"(t_)); t_; })
extern __shared__ __attribute__((aligned(16))) unsigned char g_lds_dyn[];
#define ptid() (*(volatile __attribute__((address_space(3))) int*)((__attribute__((address_space(3))) unsigned char*)g_lds_dyn + 131072 + 1024 + 4 * (int)threadIdx.x))
namespace pg8 {
#define PG8_LAS __attribute__((address_space(3)))
typedef unsigned short bf16_t;
typedef short bf16x8 __attribute__((ext_vector_type(8)));
typedef float f32x4 __attribute__((ext_vector_type(4)));
typedef unsigned u32x4 __attribute__((ext_vector_type(4)));
constexpr int BM = 256, BK = 64, HALF = 128, HTB = HALF * BK * 2  , STAGE_BYTES = 8 * HTB, NXCD = 8, WGM = 8;

__host__ __device__ __forceinline__ int lds_byte(int r, int c) { const int st = (r >> 4) * 2 + (c >> 5), rr = r & 15, cc = c & 31, ob = rr * 64 + cc * 2; return st * 1024 + (ob ^ (((ob >> 9) & 1) << 5)); }
__host__ __device__ __forceinline__ void stage_rc(int b, int& R, int& C) { const int st = b / 1024, sb = b % 1024, swz = sb ^ (((sb >> 9) & 1) << 5); R = (st >> 1) * 16 + swz / 64; C = (st & 1) * 32 + (swz % 64) / 2; }
__host__ __device__ __forceinline__ int perm32(int rho) { const int n = rho >> 4, i = rho & 15; return 8 * (i >> 2) + 4 * n + (i & 3); }

struct Unit { int pm, pn, koff; };
struct Gemm { const bf16_t* A; const bf16_t* Bt; int M, N, K, ld; };

struct StaticOrder {
    int nM, nN, nwg, G, c, mode;
    __host__ __device__ void init(int M, int N, int G_, int c_, int mode_ = 0) { nM = M / BM; nN = N / BM; nwg = nM * nN; G = G_; c = c_; mode = mode_; }
    __host__ __device__ bool next(int i, Unit& u) const {
        const long L = (long)i * G + c; if (L >= nwg) return false;
        int wgid = (int)L; { const int q = nwg / NXCD, r = nwg % NXCD, xcd = wgid % NXCD, off = wgid / NXCD; wgid = (xcd < r ? xcd * (q + 1) : r * (q + 1) + (xcd - r) * q) + off; }
        const int nig = WGM * nN, gid = wgid / nig, fm = gid * WGM, gsz = (nM - fm) < WGM ? (nM - fm) : WGM;
        u.pm = fm + ((wgid % nig) % gsz); u.pn = (wgid % nig) / gsz; u.koff = 0; if (mode == 1) u.pm = (u.pm >> 3) * 9 + 1 + (u.pm & 7); return true;
    }
    __device__ __forceinline__ void a_ready(const Unit&) const {}
    __device__ __forceinline__ void done(const Unit&) const {}
};
struct CtxSplitOrder {
    int G, c, khalf;
    __device__ bool next(int i, Unit& u) const { const int L = i * G + c; if (L >= 64) return false; u.koff = (L & 1) * khalf; u.pn = (L >> 1) & 3; u.pm = (L >> 3) * 9; return true; }
    __device__ __forceinline__ void a_ready(const Unit&) const {}
    __device__ __forceinline__ void done(const Unit&) const {}
};

__device__ __forceinline__ unsigned cvt_pk_bf16(float lo, float hi) { unsigned r; asm volatile("v_cvt_pk_bf16_f32 %0, %1, %2" : "=v"(r) : "v"(lo), "v"(hi)); return r; }
typedef float f32x2 __attribute__((ext_vector_type(2)));
__device__ __forceinline__ f32x2 gelu_pk(f32x2 v) {
    const f32x2 av = __builtin_elementwise_abs(v), d = av * 0.2316418882f + 1.0f;
    f32x2 t; t.x = __builtin_amdgcn_rcpf(d.x); t.y = __builtin_amdgcn_rcpf(d.y);
    f32x2 q = t * 0.5307027145f + (-0.7265760135f); q = q * t + 0.7107068705f; q = q * t + (-0.142248368f); q = q * t + 0.127414796f; q = q * t;
    const f32x2 s = (v * v) * (-0.72134752044f);
    f32x2 e; e.x = __builtin_amdgcn_exp2f(s.x); e.y = __builtin_amdgcn_exp2f(s.y);
    const f32x2 m = v * (q * e), r = v - m;
    f32x2 o; o.x = v.x < 0.f ? m.x : r.x; o.y = v.y < 0.f ? m.y : r.y; return o;
}

template <int ACT  > struct EpiBf16 {
    static constexpr bool PERM = true, AFTER_DRAIN = false; static_assert(ACT == 0 || ACT == 1, "EpiBf16: ACT is 0 (none) or 1 (gelu_pk)");
    bf16_t* O; int ldc; const float* bias; int split_cols; size_t split_stride; float scale0;
    __device__ __forceinline__ void operator()(const f32x4 (&acc)[2][2][4][2], const Unit& u, int wr, int wc, int fr, int fq) const {
        const int row0 = u.pm * BM + wr * 64 + fr; int colt = u.pn * BM; bf16_t* base = O;
        float sc = 1.f; if (split_cols) { const int t = colt / split_cols; base += (size_t)t * split_stride; colt -= t * split_cols; if (t == 0) sc = scale0; }
        const int col0 = colt + wc * 32 + 8 * fq, bcol0 = u.pn * BM + wc * 32 + 8 * fq;
        f32x4 bv[2][2];
#pragma unroll
        for (int bj = 0; bj < 2; ++bj)
#pragma unroll
            for (int n = 0; n < 2; ++n) bv[bj][n] = bias ? *(const f32x4*)(bias + bcol0 + bj * HALF + 4 * n) : (f32x4){0.f, 0.f, 0.f, 0.f};
#pragma unroll
        for (int ai = 0; ai < 2; ++ai)
#pragma unroll
            for (int m = 0; m < 4; ++m) { bf16_t* rowp = base + (size_t)(row0 + ai * HALF + m * 16) * ldc + col0;
#pragma unroll
                for (int bj = 0; bj < 2; ++bj) { f32x4 v0 = acc[ai][bj][m][0] + bv[bj][0], v1 = acc[ai][bj][m][1] + bv[bj][1];
                    if (ACT == 1) { f32x2 a = gelu_pk((f32x2){v0[0], v0[1]}), b = gelu_pk((f32x2){v0[2], v0[3]}), c = gelu_pk((f32x2){v1[0], v1[1]}), d = gelu_pk((f32x2){v1[2], v1[3]});
                        v0 = (f32x4){a.x, a.y, b.x, b.y}; v1 = (f32x4){c.x, c.y, d.x, d.y}; }
                    v0 = v0 * sc; v1 = v1 * sc; u32x4 w; w.x = cvt_pk_bf16(v0[0], v0[1]); w.y = cvt_pk_bf16(v0[2], v0[3]); w.z = cvt_pk_bf16(v1[0], v1[1]); w.w = cvt_pk_bf16(v1[2], v1[3]);
                    { bf16_t* sp_ = rowp + bj * HALF; asm volatile("global_store_dwordx4 %0, %1, off sc1\n\ts_nop 1" :: "v"(sp_), "v"(w) : "memory"); } } }
    }
};
struct EpiResidSplit {
    static constexpr bool PERM = false, AFTER_DRAIN = false;
    bf16_t* X; float* T; const float* mod; int goff; const float* cin;
    __device__ __forceinline__ void operator()(const f32x4 (&acc)[2][2][4][2], const Unit& u, int wr, int wc, int fr, int fq) const {
        typedef unsigned u32x2_t __attribute__((ext_vector_type(2)));
        const float* gp = mod + 8 * 6144 + goff;
        const int col0 = u.pn * BM + wc * 32 + 4 * fq;
        const bool first = (u.koff == 0);
        bf16_t* xb = X + (size_t)(u.pm * BM) * 1024; float* tb = T + (size_t)((u.pm / 9) * BM) * 1024;
        const float* rbase = cin ? cin + (size_t)((u.pm / 9) * BM) * 1024 : nullptr;
#pragma unroll
        for (int bj = 0; bj < 2; ++bj)
#pragma unroll
            for (int n = 0; n < 2; ++n) { const f32x4 gv = *(const f32x4*)(gp + col0 + bj * HALF + n * 16);
#pragma unroll
                for (int ai = 0; ai < 2; ++ai)
#pragma unroll
                    for (int m = 0; m < 4; ++m) { const size_t o = (size_t)(ai * HALF + wr * 64 + m * 16 + fr) * 1024 + col0 + bj * HALF + n * 16;
                        f32x4 v = gv * acc[ai][bj][m][n];
                        if (first) { f32x4 x;
                            if (rbase) x = *(const f32x4*)(rbase + o);
                            else { const u32x2_t w = *(const u32x2_t*)(xb + o); x = (f32x4){__uint_as_float(w.x << 16), __uint_as_float(w.x & 0xffff0000u), __uint_as_float(w.y << 16), __uint_as_float(w.y & 0xffff0000u)}; }
                            v = v + x; u32x2_t r; r.x = cvt_pk_bf16(v[0], v[1]); r.y = cvt_pk_bf16(v[2], v[3]); *(u32x2_t*)(xb + o) = r; }
                        else *(f32x4*)(tb + o) = v; } }
    }
};
struct EpiSwiGLU {
    static constexpr bool PERM = true, AFTER_DRAIN = false;
    bf16_t* O; int ldc;
    __device__ __forceinline__ void operator()(const f32x4 (&acc)[2][2][4][2], const Unit& u, int wr, int wc, int fr, int fq) const {
        const int row0 = u.pm * BM + wr * 64 + fr; const int col0 = u.pn * HALF + wc * 32 + 8 * fq;
#pragma unroll
        for (int ai = 0; ai < 2; ++ai)
#pragma unroll
            for (int m = 0; m < 4; ++m) { bf16_t* rowp = O + (size_t)(row0 + ai * HALF + m * 16) * ldc + col0;
                float h[8];
#pragma unroll
                for (int n = 0; n < 2; ++n)
#pragma unroll
                    for (int i = 0; i < 4; ++i) { const float g = acc[ai][0][m][n][i], up = acc[ai][1][m][n][i];
                        h[n * 4 + i] = g * __builtin_amdgcn_rcpf(1.0f + __expf(-g)) * up; }
                u32x4 w; w.x = cvt_pk_bf16(h[0], h[1]); w.y = cvt_pk_bf16(h[2], h[3]); w.z = cvt_pk_bf16(h[4], h[5]); w.w = cvt_pk_bf16(h[6], h[7]);
                asm volatile("global_store_dwordx4 %0, %1, off sc1\n\ts_nop 1" :: "v"(rowp), "v"(w) : "memory"); }
    }
};
struct EpiResid {
    static constexpr bool PERM = false, AFTER_DRAIN = false;
    bf16_t* X; const float* mod; int goff; const float* xin;
    __device__ __forceinline__ void operator()(const f32x4 (&acc)[2][2][4][2], const Unit& u, int wr, int wc, int fr, int fq) const {
        typedef unsigned u32x2_t __attribute__((ext_vector_type(2)));
        const int widx = (u.pm % 9 == 0) ? 8 : (u.pm / 9);
        const float* gp = mod + widx * 6144 + goff;
        const int col0 = u.pn * BM + wc * 32 + 4 * fq;
        const float* rb = xin ? xin + (size_t)((u.pm / 9) * 2048 + (u.pm % 9 - 1) * 256) * 1024 : nullptr;
        bf16_t* wb = X + (size_t)(u.pm * BM) * 1024;
#pragma unroll
        for (int bj = 0; bj < 2; ++bj)
#pragma unroll
            for (int n = 0; n < 2; ++n) { const f32x4 gv = *(const f32x4*)(gp + col0 + bj * HALF + n * 16);
#pragma unroll
                for (int ai = 0; ai < 2; ++ai)
#pragma unroll
                    for (int m = 0; m < 4; ++m) { const size_t o = (size_t)(ai * HALF + wr * 64 + m * 16 + fr) * 1024 + col0 + bj * HALF + n * 16;
                        f32x4 x;
                        if (rb) x = *(const f32x4*)(rb + o);
                        else { const u32x2_t w = *(const u32x2_t*)(wb + o); x = (f32x4){__uint_as_float(w.x << 16), __uint_as_float(w.x & 0xffff0000u), __uint_as_float(w.y << 16), __uint_as_float(w.y & 0xffff0000u)}; }
                        x = x + gv * acc[ai][bj][m][n];
                        u32x2_t r; r.x = cvt_pk_bf16(x[0], x[1]); r.y = cvt_pk_bf16(x[2], x[3]); *(u32x2_t*)(wb + o) = r; } }
    }
};
template <class Epi, class Sched, bool ALIGN_EPI = false, bool SP2 = false>
__device__ __forceinline__ void gemm_phase(PG8_LAS unsigned char* lds, const Gemm g, const Sched& S, const Epi& E) {
    const int tid = otid(), wid = __builtin_amdgcn_readfirstlane(tid >> 6), lane = tid & 63, wr = wid >> 2, wc = wid & 3, fr = lane & 15, fq = lane >> 4;
    const int K = g.ld, nt = g.K / BK;
    unsigned voffA[2], voffB[2];
#pragma unroll
    for (int i = 0; i < 2; ++i) { int R, C; stage_rc(tid * 16 + i * 8192, R, C); const int Rb = Epi::PERM ? ((R & ~31) + perm32(R & 31)) : R;
        voffA[i] = (unsigned)(R * K + C) * 2u; voffB[i] = (unsigned)(Rb * K + C) * 2u; }
    const size_t kstep = (size_t)(BK * 2);
    const size_t hstep = (size_t)HALF * K * 2;
    const size_t tstep = 2 * hstep;
    const unsigned ldsw = (unsigned)wid * 1024u;
    const int aoff = lds_byte(wr * 64 + fr, fq * 8), boff = lds_byte(wc * 32 + fr, fq * 8);
#define PG8_SA(b, h) (((b) * 2 + (h)) * HTB)
#define PG8_SB(b, h) ((4 + (b) * 2 + (h)) * HTB)
#define PG8_STAGE(bufoff, gbase, voff) do { _Pragma("unroll") for (int _i = 0; _i < 2; ++_i) \
        __builtin_amdgcn_global_load_lds((const unsigned*)((const char*)(gbase) + (voff)[_i]), (PG8_LAS unsigned*)(lds + (bufoff) + ldsw + _i * 8192), 16, 0, 0); } while (0)
#define PG8_LDA(dst, b, h) do { _Pragma("unroll") for (int m = 0; m < 4; ++m) _Pragma("unroll") for (int k = 0; k < 2; ++k) dst[m][k] = *(const PG8_LAS bf16x8*)(lds + PG8_SA(b, h) + aoff + m * 2048 + k * 1024); } while (0)
#define PG8_LDB(dst, b, h) do { _Pragma("unroll") for (int n = 0; n < 2; ++n) _Pragma("unroll") for (int k = 0; k < 2; ++k) dst[n][k] = *(const PG8_LAS bf16x8*)(lds + PG8_SB(b, h) + boff + n * 2048 + k * 1024); } while (0)
#define PG8_MMA(ai, bj, At, Bt) do { __builtin_amdgcn_s_setprio(1); _Pragma("unroll") for (int m = 0; m < 4; ++m) _Pragma("unroll") for (int n = 0; n < 2; ++n) _Pragma("unroll") for (int k = 0; k < 2; ++k) \
        acc[ai][bj][m][n] = __builtin_amdgcn_mfma_f32_16x16x32_bf16(Bt[n][k], At[m][k], acc[ai][bj][m][n], 0, 0, 0); __builtin_amdgcn_s_setprio(0); } while (0)
#define PG8_WAIT_V(n) asm volatile("s_waitcnt vmcnt(" #n ")" ::: "memory")
#define PG8_WAIT_L(n) asm volatile("s_waitcnt lgkmcnt(" #n ")" ::: "memory")
#define PG8_BAR __builtin_amdgcn_s_barrier()
#define PG8_SCHED __builtin_amdgcn_sched_barrier(0)
    Unit cur, nxt; int ui = 0;
    if (!S.next(0, cur)) return;
    f32x4 acc[2][2][4][2];
#pragma unroll
    for (int a = 0; a < 2; ++a)
#pragma unroll
        for (int b = 0; b < 2; ++b)
#pragma unroll
            for (int m = 0; m < 4; ++m)
#pragma unroll
                for (int n = 0; n < 2; ++n) acc[a][b][m][n] = (f32x4){0.f, 0.f, 0.f, 0.f};
    bf16x8 At[4][2], B0[2][2], B1[2][2];
    const char* cA = (const char*)g.A + (size_t)cur.pm * tstep + (size_t)cur.koff * 2; const char* cB = (const char*)g.Bt + (size_t)cur.pn * tstep + (size_t)cur.koff * 2;
    S.a_ready(cur);
    if constexpr (SP2) {
        PG8_STAGE(PG8_SB(0, 0), cB, voffB); PG8_STAGE(PG8_SB(0, 1), cB + hstep, voffB); PG8_STAGE(PG8_SA(0, 0), cA, voffA); PG8_STAGE(PG8_SA(0, 1), cA + hstep, voffA);
        if (wr == 1) PG8_BAR;
        PG8_WAIT_V(2); PG8_BAR;
        PG8_STAGE(PG8_SB(1, 0), cB + kstep, voffB); PG8_STAGE(PG8_SA(1, 0), cA + kstep, voffA); PG8_STAGE(PG8_SB(1, 1), cB + hstep + kstep, voffB);
        PG8_WAIT_V(6); PG8_BAR;
    } else {
        PG8_STAGE(PG8_SB(0, 0), cB, voffB); PG8_STAGE(PG8_SA(0, 0), cA, voffA); PG8_STAGE(PG8_SB(0, 1), cB + hstep, voffB); PG8_STAGE(PG8_SA(0, 1), cA + hstep, voffA);
        if (wr == 1) PG8_BAR;
        PG8_WAIT_V(4); PG8_BAR;
        PG8_STAGE(PG8_SB(1, 0), cB + kstep, voffB); PG8_STAGE(PG8_SA(1, 0), cA + kstep, voffA); PG8_STAGE(PG8_SB(1, 1), cB + hstep + kstep, voffB);
        PG8_WAIT_V(6); PG8_BAR;
    }
    for (;;) {
        const bool has_next = S.next(ui + 1, nxt);
        const char* nA = has_next ? (const char*)g.A + (size_t)nxt.pm * tstep + (size_t)nxt.koff * 2 : cA; const char* nB = has_next ? (const char*)g.Bt + (size_t)nxt.pn * tstep + (size_t)nxt.koff * 2 : cB;
        for (int t = 0; t < nt; t += 2) {
            const bool last = (t == nt - 2);
            const char* a1 = cA + (size_t)(t + 1) * kstep;
            const char* a2 = last ? nA : cA + (size_t)(t + 2) * kstep; const char* b2 = last ? nB : cB + (size_t)(t + 2) * kstep;
            const char* a3 = a2 + kstep; const char* b3 = b2 + kstep;
            if (last && has_next) S.a_ready(nxt);
            if constexpr (SP2) {
            PG8_LDB(B0, 0, 0); PG8_LDB(B1, 0, 1); PG8_SCHED; PG8_LDA(At, 0, 0); PG8_STAGE(PG8_SA(1, 1), a1 + hstep, voffA);
            PG8_WAIT_V(8); PG8_WAIT_L(0); PG8_BAR; PG8_MMA(0, 0, At, B0); PG8_MMA(0, 1, At, B1); PG8_BAR; PG8_SCHED;
            PG8_LDA(At, 0, 1); PG8_STAGE(PG8_SB(0, 0), b2, voffB); PG8_STAGE(PG8_SB(0, 1), b2 + hstep, voffB); PG8_STAGE(PG8_SA(0, 0), a2, voffA);
            PG8_WAIT_V(8); PG8_WAIT_L(0); PG8_BAR; PG8_MMA(1, 0, At, B0); PG8_MMA(1, 1, At, B1); PG8_BAR; PG8_SCHED;
            PG8_LDB(B0, 1, 0); PG8_LDB(B1, 1, 1); PG8_SCHED; PG8_LDA(At, 1, 0); PG8_STAGE(PG8_SA(0, 1), a2 + hstep, voffA);
            PG8_WAIT_V(8); PG8_WAIT_L(0); PG8_BAR; PG8_MMA(0, 0, At, B0); PG8_MMA(0, 1, At, B1); PG8_BAR; PG8_SCHED;
            PG8_LDA(At, 1, 1); PG8_STAGE(PG8_SB(1, 0), b3, voffB); PG8_STAGE(PG8_SB(1, 1), b3 + hstep, voffB); PG8_STAGE(PG8_SA(1, 0), a3, voffA);
            PG8_WAIT_V(8); PG8_WAIT_L(0); PG8_BAR; PG8_MMA(1, 0, At, B0); PG8_MMA(1, 1, At, B1); PG8_BAR; PG8_SCHED;
            } else {
            PG8_LDB(B0, 0, 0); PG8_SCHED; PG8_LDA(At, 0, 0); PG8_STAGE(PG8_SA(1, 1), a1 + hstep, voffA);
            PG8_WAIT_L(8); PG8_BAR; PG8_WAIT_L(0); PG8_MMA(0, 0, At, B0); PG8_BAR; PG8_SCHED;
            PG8_LDB(B1, 0, 1); PG8_STAGE(PG8_SB(0, 0), b2, voffB);
            PG8_BAR; PG8_WAIT_L(0); PG8_MMA(0, 1, At, B1); PG8_BAR;
            PG8_LDA(At, 0, 1); PG8_STAGE(PG8_SA(0, 0), a2, voffA);
            PG8_BAR; PG8_WAIT_L(0); PG8_MMA(1, 0, At, B0); PG8_BAR; PG8_SCHED;
            PG8_STAGE(PG8_SB(0, 1), b2 + hstep, voffB);
            PG8_WAIT_V(6); PG8_BAR; PG8_MMA(1, 1, At, B1); PG8_BAR;
            PG8_LDB(B0, 1, 0); PG8_SCHED; PG8_LDA(At, 1, 0); PG8_STAGE(PG8_SA(0, 1), a2 + hstep, voffA);
            PG8_WAIT_L(8); PG8_BAR; PG8_WAIT_L(0); PG8_MMA(0, 0, At, B0); PG8_BAR; PG8_SCHED;
            PG8_LDB(B1, 1, 1); PG8_STAGE(PG8_SB(1, 0), b3, voffB);
            PG8_BAR; PG8_WAIT_L(0); PG8_MMA(0, 1, At, B1); PG8_BAR;
            PG8_LDA(At, 1, 1); PG8_STAGE(PG8_SA(1, 0), a3, voffA);
            PG8_BAR; PG8_WAIT_L(0); PG8_MMA(1, 0, At, B0); PG8_BAR; PG8_SCHED;
            PG8_STAGE(PG8_SB(1, 1), b3 + hstep, voffB);
            PG8_WAIT_V(6); PG8_BAR; PG8_MMA(1, 1, At, B1); PG8_BAR;
            }
        }
        if constexpr (ALIGN_EPI) { if (wr == 0) PG8_BAR; }
        if constexpr (!Epi::AFTER_DRAIN) { E(acc, cur, wr, wc, fr, fq); S.done(cur); }
        if (!has_next) break;
#pragma unroll
        for (int a = 0; a < 2; ++a)
#pragma unroll
            for (int b = 0; b < 2; ++b)
#pragma unroll
                for (int m = 0; m < 4; ++m)
#pragma unroll
                    for (int n = 0; n < 2; ++n) acc[a][b][m][n] = (f32x4){0.f, 0.f, 0.f, 0.f};
        cur = nxt; cA = nA; cB = nB; ++ui;
        if constexpr (ALIGN_EPI) { if (wr == 1) PG8_BAR; }
    }
    PG8_WAIT_V(0);
    if constexpr (!ALIGN_EPI) { if (wr == 0) PG8_BAR; }
    PG8_BAR;
    if constexpr (Epi::AFTER_DRAIN) { E.fused(acc, cur, wr, wc, fr, fq, lds, wid, lane); S.done(cur); }
#undef PG8_SA
#undef PG8_SB
#undef PG8_STAGE
#undef PG8_LDA
#undef PG8_LDB
#undef PG8_MMA
#undef PG8_WAIT_V
#undef PG8_WAIT_L
#undef PG8_BAR
#undef PG8_SCHED
}
}

typedef unsigned short bf16;
typedef short bf16x8 __attribute__((ext_vector_type(8)));
typedef short s16x4 __attribute__((ext_vector_type(4)));
typedef float f32x4 __attribute__((ext_vector_type(4)));
typedef float f32x16 __attribute__((ext_vector_type(16)));
typedef unsigned u32x4 __attribute__((ext_vector_type(4)));
typedef unsigned u32x2 __attribute__((ext_vector_type(2)));
#define LAS __attribute__((address_space(3)))

constexpr int NB = 8, TPB = 2304, MT = NB * TPB, DM = 1024, NLAT = 2048;
constexpr int NP_E = 3328, NP_O = 3072, FF = 2816;
constexpr float EPSN = 1e-6f;
constexpr size_t MiB = 1u << 20;
constexpr size_t WS_CTL = 0, WS_MOD = 1 * MiB, WS_X = 2 * MiB, WS_H = 74 * MiB, WS_MIX = 110 * MiB, WS_P = 146 * MiB, WS_W = 263 * MiB,
                 WS_OSC = 290 * MiB, WS_KR = 326 * MiB, WS_U = 328 * MiB, WS_T = 342 * MiB, WS_END = 350 * MiB;
constexpr size_t WS_LSUM = 128 * 1024;
constexpr size_t WS_CQN = WS_MIX, WS_CKVN = WS_MIX + 14 * MiB, WS_DSCR = WS_H;
constexpr size_t W_IN = 0, W_OUT = 13 * MiB / 2, W_GU = 17 * MiB / 2, W_DN = 39 * MiB / 2, W_UQ = 25 * MiB, W_UKV = 25 * MiB + 768 * 1024;
constexpr size_t OUT_KV = 0, OUT_Q = 36 * MiB;
constexpr int LDS_MAIN = 131072, LDS_BYTES = LDS_MAIN + 1024 + 2048;

struct Args { const float* in[23]; float* out; unsigned char* ws; int lo, hi; };
typedef __attribute__((address_space(4))) const Args* KArgP;
__device__ __forceinline__ KArgP kargs() { KArgP p = (KArgP)__builtin_amdgcn_kernarg_segment_ptr(); asm volatile("" : "+s"(p)); return p; }

__device__ __forceinline__ float bf2f(unsigned short h) { return __uint_as_float((unsigned)h << 16); }
__device__ __forceinline__ unsigned f2bf(float f) { unsigned u = __float_as_uint(f); return (u + 0x7fffu + ((u >> 16) & 1u)) >> 16; }
__device__ __forceinline__ unsigned pk2(float lo, float hi) { return f2bf(lo) | (f2bf(hi) << 16); }
__device__ __forceinline__ float wave_sum(float v) {
#pragma unroll
    for (int o = 1; o < 64; o <<= 1) v += __shfl_xor(v, o);
    return v;
}
__device__ __forceinline__ float silu_f(float g) { return g / (1.0f + __expf(-g)); }
__device__ __forceinline__ void sincos_r(float ang, float& s, float& c) {
    float r = ang * 0.15915494309189535f; r = r - __builtin_floorf(r);
    s = __builtin_amdgcn_sinf(r); c = __builtin_amdgcn_cosf(r);
}
__device__ __forceinline__ float inv_freq(int i, int half) { return __builtin_amdgcn_exp2f(-(float)i / (float)half * 13.287712379549449f); }

__device__ __forceinline__ void mod_item(KArgP a, int l, int cg, LAS unsigned char* lds) {
    const int tid = otid();
    float* MOD = (float*)(a->ws + WS_MOD);
    LAS float* S = (LAS float*)lds;
    LAS float* R = S + 1024 * 12;
    for (int i = tid; i < 9 * 1024; i += 512) { const int w = i >> 10, k = i & 1023; const float v = (w < 8) ? a->in[1][w * 1024 + k] : a->in[3][k]; S[k * 12 + w] = silu_f(v); }
    __syncthreads();
    const int nl = tid & 63, kp = tid >> 6, n0 = cg * 256;
    f32x4 acc[9];
#pragma unroll
    for (int w = 0; w < 9; ++w) acc[w] = (f32x4){0.f, 0.f, 0.f, 0.f};
    const float* wp = a->in[4] + (size_t)l * 1024 * 6144 + n0 + 4 * nl;
#pragma unroll 8
    for (int k = kp * 128; k < kp * 128 + 128; ++k) {
        const f32x4 wv = *(const f32x4*)(wp + (size_t)k * 6144);
        const f32x4 s0 = *(const LAS f32x4*)(S + k * 12), s1 = *(const LAS f32x4*)(S + k * 12 + 4); const float s8 = S[k * 12 + 8];
        acc[0] += wv * s0[0]; acc[1] += wv * s0[1]; acc[2] += wv * s0[2]; acc[3] += wv * s0[3];
        acc[4] += wv * s1[0]; acc[5] += wv * s1[1]; acc[6] += wv * s1[2]; acc[7] += wv * s1[3]; acc[8] += wv * s8;
    }
#pragma unroll
    for (int w = 0; w < 9; ++w) *(LAS f32x4*)(R + (kp * 9 + w) * 256 + 4 * nl) = acc[w];
    __syncthreads();
    for (int i = tid; i < 9 * 256; i += 512) { const int w = i >> 8, n2 = i & 255; float v = a->in[5][l * 6144 + n0 + n2];
#pragma unroll
        for (int p = 0; p < 8; ++p) v += R[(p * 9 + w) * 256 + n2];
        MOD[(size_t)(l * 9 + w) * 6144 + n0 + n2] = v; }
    __syncthreads();
}
__device__ __forceinline__ void phase_prep(KArgP a, LAS unsigned char* lds) {
    const int tid = otid(), G = gridDim.x;
    if (blockIdx.x == 0) { if (tid < 64) ((unsigned*)(a->ws + WS_CTL))[tid] = 0u; for (int i = tid; i < 3456; i += 512) ((unsigned*)(a->ws + WS_CTL))[4096 + i] = 0u; }
    for (int item = blockIdx.x; item < 96; item += G) mod_item(a, item / 24, item % 24, lds);
}

__device__ __forceinline__ void transpose_item(const float* W, int K, int N, bf16* WT, int k0, int n0, int drow0, LAS float* scr, int lane) {
    float tv_[32];
#pragma unroll
    for (int i = 0; i < 32; ++i) { const int kk = 2 * i + (lane >> 5); tv_[i] = W[(size_t)(k0 + kk) * N + n0 + (lane & 31)]; }
#pragma unroll
    for (int i = 0; i < 32; ++i) { const int kk = 2 * i + (lane >> 5); scr[kk * 33 + (lane & 31)] = tv_[i]; }
    asm volatile("s_waitcnt lgkmcnt(0)" ::: "memory");
    const int c = lane & 7;
#pragma unroll
    for (int j = 0; j < 4; ++j) { const int n = (lane >> 3) + 8 * j; const LAS float* s = scr + (8 * c) * 33 + n;
        u32x4 o; o.x = pk2(s[0 * 33], s[1 * 33]); o.y = pk2(s[2 * 33], s[3 * 33]); o.z = pk2(s[4 * 33], s[5 * 33]); o.w = pk2(s[6 * 33], s[7 * 33]);
        *(u32x4*)(WT + (size_t)(drow0 + n) * K + k0 + 8 * c) = o; }
    asm volatile("s_waitcnt lgkmcnt(0)" ::: "memory");
}
__device__ __forceinline__ void convert_weights(KArgP a, int layer, LAS unsigned char* lds, int part, int gw, int NGW) {
    const int lane = otid() & 63, wave = otid() >> 6;
    LAS float* scr = (LAS float*)(lds + wave * 8448);
    const bool even = !(layer & 1); const int e = layer >> 1;
    unsigned char* Wb = a->ws + WS_W;
    if (part == 0) {
        const int nin = even ? 3232 : 3072;
        const float* w_in = even ? a->in[11] + (size_t)e * 1024 * 3232 : a->in[18] + (size_t)e * 1024 * 3072;
        const int nbin = nin / 32;
        const int I_IN = 16 * nbin, I_OUT = 512, I_UQ = even ? 6 * 24 : 0, I_UKV = even ? 4 * 32 : 0;
        const int NIT = I_IN + I_OUT + I_UQ + I_UKV;
        for (int it = gw; it < NIT; it += NGW) {
            int r = it;
            if (r < I_IN) { const int kb = r / nbin, nb = r % nbin; transpose_item(w_in, 1024, nin, (bf16*)(Wb + W_IN), 64 * kb, 32 * nb, 32 * nb, scr, lane); continue; } r -= I_IN;
            if (r < I_OUT) { const int kb = r / 32, nb = r % 32; transpose_item(a->in[7] + (size_t)layer * 1024 * 1024, 1024, 1024, (bf16*)(Wb + W_OUT), 64 * kb, 32 * nb, 32 * nb, scr, lane); continue; } r -= I_OUT;
            if (r < I_UQ) { const int kb = r / 24, nb = r % 24; transpose_item(a->in[15] + (size_t)e * 384 * 768, 384, 768, (bf16*)(Wb + W_UQ), 64 * kb, 32 * nb, 32 * nb, scr, lane); continue; } r -= I_UQ;
            { const int kb = r / 32, nb = r % 32; transpose_item(a->in[17] + (size_t)e * 256 * 1024, 256, 1024, (bf16*)(Wb + W_UKV), 64 * kb, 32 * nb, 32 * nb, scr, lane); }
        }
    } else {
        constexpr int I_G = 16 * 88, I_D = 44 * 32;
        for (int it = gw; it < 2 * I_G + I_D; it += NGW) {
            int r = it;
            if (r < I_G) { const int kb = r / 88, nb = r % 88, n0 = 32 * nb; transpose_item(a->in[8] + (size_t)layer * 1024 * FF, 1024, FF, (bf16*)(Wb + W_GU), 64 * kb, n0, (n0 >> 7) * 256 + (n0 & 127), scr, lane); continue; } r -= I_G;
            if (r < I_G) { const int kb = r / 88, nb = r % 88, n0 = 32 * nb; transpose_item(a->in[9] + (size_t)layer * 1024 * FF, 1024, FF, (bf16*)(Wb + W_GU), 64 * kb, n0, (n0 >> 7) * 256 + 128 + (n0 & 127), scr, lane); continue; } r -= I_G;
            { const int kb = r / 32, nb = r % 32; transpose_item(a->in[10] + (size_t)layer * FF * 1024, FF, 1024, (bf16*)(Wb + W_DN), 64 * kb, 32 * nb, 32 * nb, scr, lane); }
        }
    }
}

__device__ __forceinline__ f32x4 ld4_bf16(const bf16* p) { const u32x2 w = *(const u32x2*)p; return (f32x4){__uint_as_float(w.x << 16), __uint_as_float(w.x & 0xffff0000u), __uint_as_float(w.y << 16), __uint_as_float(w.y & 0xffff0000u)}; }
__device__ __forceinline__ void phase_norm(KArgP a, int layer, int which, bool addT) {
    const int lane = otid() & 63, wave = otid() >> 6;
    const int gw = blockIdx.x * 8 + wave, NGW = gridDim.x * 8;
    bf16* X = (bf16*)(a->ws + WS_X); bf16* H = (bf16*)(a->ws + WS_H); const float* T = (const float*)(a->ws + WS_T);
    const float* g = a->in[6] + (layer * 2 + which) * 1024;
    const float* mod = (const float*)(a->ws + WS_MOD) + (size_t)layer * 9 * 6144;
    const int shoff = which ? 3072 : 0, scoff = which ? 4096 : 1024;
    const bool from_inputs = (layer == 0 && which == 0);
    constexpr int RB = 3;
    for (int r0 = gw; r0 < MT; r0 += RB * NGW) {
        f32x4 v[RB][4];
#pragma unroll
        for (int k = 0; k < RB; ++k) { const int row = r0 + k * NGW; if (row < MT) {
            if (from_inputs) { const int b = row / TPB, j = row - b * TPB; const float* xr = (j < 256 ? a->in[2] + (size_t)(b * 256 + j) * 1024 : a->in[0] + (size_t)(b * NLAT + j - 256) * 1024) + 8 * lane;
#pragma unroll
                for (int q = 0; q < 2; ++q) { v[k][2 * q] = *(const f32x4*)(xr + 512 * q); v[k][2 * q + 1] = *(const f32x4*)(xr + 512 * q + 4); } }
            else {
#pragma unroll
                for (int q = 0; q < 2; ++q) { const u32x4 w = *(const u32x4*)(X + (size_t)row * 1024 + 8 * lane + 512 * q);
                    v[k][2 * q] = (f32x4){__uint_as_float(w.x << 16), __uint_as_float(w.x & 0xffff0000u), __uint_as_float(w.y << 16), __uint_as_float(w.y & 0xffff0000u)};
                    v[k][2 * q + 1] = (f32x4){__uint_as_float(w.z << 16), __uint_as_float(w.z & 0xffff0000u), __uint_as_float(w.w << 16), __uint_as_float(w.w & 0xffff0000u)}; } } } }
#pragma unroll
        for (int k = 0; k < RB; ++k) { const int row = r0 + k * NGW; if (row < MT) {
            const int b = row / TPB, j = row - b * TPB, widx = (j < 256) ? 8 : b;
            if (addT && j < 256) { const float* tr = T + (size_t)(b * 256 + j) * 1024 + 8 * lane;
#pragma unroll
                for (int q = 0; q < 2; ++q) { v[k][2 * q] = v[k][2 * q] + *(const f32x4*)(tr + 512 * q); v[k][2 * q + 1] = v[k][2 * q + 1] + *(const f32x4*)(tr + 512 * q + 4);
                    u32x4 w; w.x = pk2(v[k][2 * q][0], v[k][2 * q][1]); w.y = pk2(v[k][2 * q][2], v[k][2 * q][3]); w.z = pk2(v[k][2 * q + 1][0], v[k][2 * q + 1][1]); w.w = pk2(v[k][2 * q + 1][2], v[k][2 * q + 1][3]);
                    *(u32x4*)(X + (size_t)row * 1024 + 8 * lane + 512 * q) = w; } }
            float ss = 0.f;
#pragma unroll
            for (int q = 0; q < 4; ++q) ss += (v[k][q][0] * v[k][q][0] + v[k][q][1] * v[k][q][1]) + (v[k][q][2] * v[k][q][2] + v[k][q][3] * v[k][q][3]);
            const float rstd = __builtin_amdgcn_rsqf(wave_sum(ss) * (1.f / 1024.f) + EPSN);
#pragma unroll
            for (int q = 0; q < 2; ++q) { const int col = 8 * lane + 512 * q; f32x4 y[2];
#pragma unroll
                for (int hh = 0; hh < 2; ++hh) { const f32x4 gv = *(const f32x4*)(g + col + 4 * hh), sc = *(const f32x4*)(mod + widx * 6144 + scoff + col + 4 * hh), sh = *(const f32x4*)(mod + widx * 6144 + shoff + col + 4 * hh);
                    y[hh] = v[k][2 * q + hh] * rstd * gv * (sc + 1.0f) + sh; }
                u32x4 w; w.x = pk2(y[0][0], y[0][1]); w.y = pk2(y[0][2], y[0][3]); w.z = pk2(y[1][0], y[1][1]); w.w = pk2(y[1][2], y[1][3]);
                { bf16* sp_ = H + (size_t)row * 1024 + col; asm volatile("global_store_dwordx4 %0, %1, off sc1\n\ts_nop 1" :: "v"(sp_), "v"(w) : "memory"); } } } }
    }
}

__device__ __forceinline__ void phase_post_even(KArgP a, int layer) {
    const int lane = otid() & 63, wave = otid() >> 6;
    const int gw = blockIdx.x * 8 + wave, NGW = gridDim.x * 8, e = layer >> 1;
    const bf16* P = (const bf16*)(a->ws + WS_P); bf16* CQN = (bf16*)(a->ws + WS_CQN); bf16* CKVN = (bf16*)(a->ws + WS_CKVN); bf16* KR = (bf16*)(a->ws + WS_KR);
    const float* qg = a->in[14] + e * 384; const float* kg = a->in[16] + e * 256;
    for (int row = gw; row < MT; row += NGW) {
        const int b = row / TPB, j = row - b * TPB;
        const bf16* pr = P + (size_t)row * NP_E;
        {   float x[6]; float ss = 0.f;
#pragma unroll
            for (int k = 0; k < 3; ++k) { const unsigned w = *(const unsigned*)(pr + 2560 + 2 * lane + 128 * k); x[2 * k] = bf2f((unsigned short)(w & 0xffff)); x[2 * k + 1] = bf2f((unsigned short)(w >> 16)); ss += x[2 * k] * x[2 * k] + x[2 * k + 1] * x[2 * k + 1]; }
            const float rstd = __builtin_amdgcn_rsqf(wave_sum(ss) * (1.f / 384.f) + EPSN);
#pragma unroll
            for (int k = 0; k < 3; ++k) { const int col = 2 * lane + 128 * k; *(unsigned*)(CQN + (size_t)row * 384 + col) = pk2(x[2 * k] * rstd * qg[col], x[2 * k + 1] * rstd * qg[col + 1]); } }
        {   float x[4]; float ss = 0.f;
#pragma unroll
            for (int k = 0; k < 2; ++k) { const unsigned w = *(const unsigned*)(pr + 2944 + 2 * lane + 128 * k); x[2 * k] = bf2f((unsigned short)(w & 0xffff)); x[2 * k + 1] = bf2f((unsigned short)(w >> 16)); ss += x[2 * k] * x[2 * k] + x[2 * k + 1] * x[2 * k + 1]; }
            const float rstd = __builtin_amdgcn_rsqf(wave_sum(ss) * (1.f / 256.f) + EPSN);
#pragma unroll
            for (int k = 0; k < 2; ++k) { const int col = 2 * lane + 128 * k; *(unsigned*)(CKVN + (size_t)row * 256 + col) = pk2(x[2 * k] * rstd * kg[col], x[2 * k + 1] * rstd * kg[col + 1]); } }
        {   const int d = lane & 31; const float x = bf2f(pr[3200 + d]); const float xp = __shfl_xor(x, 8);
            float o = x;
            if (j >= 256) { const int t = j - 256, blk = d >> 4, wi = d & 15, i8 = wi & 7; const float pos = (float)(blk ? (t & 63) : (t >> 6));
                float s, c; sincos_r(pos * inv_freq(i8, 8), s, c);
                o = (wi < 8) ? (x * c - xp * s) : (xp * s + x * c); }
            if (lane < 32) KR[(size_t)row * 32 + d] = (bf16)f2bf(o); }
    }
}
__device__ __forceinline__ void phase_post_odd(KArgP a, int layer) {
    const int lane = otid() & 63, wave = otid() >> 6;
    const int gw = blockIdx.x * 8 + wave, NGW = gridDim.x * 8;
    bf16* P = (bf16*)(a->ws + WS_P);
    for (int row = gw; row < MT; row += NGW) {
        const int b = row / TPB, j = row - b * TPB; const bool lat = j >= 256; const int t = j - 256;
        bf16* pr = P + (size_t)row * NP_O;
#pragma unroll
        for (int u = 0; u < 2; ++u) { const int pid = lane + 64 * u, h = pid >> 5, i = pid & 31, d1 = h * 64 + i, d2 = d1 + 32;
            float s = 0.f, c = 1.f; if (lat) sincos_r((float)t * inv_freq(i, 32), s, c);
            const float q1 = bf2f(pr[d1]), q2 = bf2f(pr[d2]), k1 = bf2f(pr[256 + d1]) * 0.125f, k2 = bf2f(pr[256 + d2]) * 0.125f;
            if (lat) { pr[d1] = (bf16)f2bf(q1 * c - q2 * s); pr[d2] = (bf16)f2bf(q1 * s + q2 * c); }
            pr[256 + d1] = (bf16)f2bf(k1 * c - k2 * s); pr[256 + d2] = (bf16)f2bf(k1 * s + k2 * c); }
        if (lat) {
#pragma unroll
            for (int u = 0; u < 4; ++u) { const int pid = lane + 64 * u, vec = pid >> 5, pp = pid & 31, blk = pp >> 4, i = pp & 15, d1 = vec * 64 + blk * 32 + i, d2 = d1 + 16;
                const float pos = (float)(blk ? (t & 63) : (t >> 6)); float s, c; sincos_r(pos * inv_freq(i, 16), s, c);
                const float q1 = bf2f(pr[1536 + d1]), q2 = bf2f(pr[1536 + d2]), k1 = bf2f(pr[2048 + d1]), k2 = bf2f(pr[2048 + d2]);
                pr[1536 + d1] = (bf16)f2bf(q1 * c - q2 * s); pr[1536 + d2] = (bf16)f2bf(q1 * s + q2 * c);
                pr[2048 + d1] = (bf16)f2bf(k1 * c - k2 * s); pr[2048 + d2] = (bf16)f2bf(k1 * s + k2 * c); } }
    }
}

__device__ __forceinline__ void phase_readout(KArgP a, int layer) {
    const int lane = otid() & 63, wave = otid() >> 6;
    const int gw = blockIdx.x * 8 + wave, NGW = gridDim.x * 8;
    const bool even = !(layer & 1); const int np = even ? NP_E : NP_O, gcol = even ? 2048 : 1024;
    const bf16* P = (const bf16*)(a->ws + WS_P); const bf16* OF = (const bf16*)(a->ws + WS_OSC); const bf16* OB = OF + (size_t)MT * 512;
    bf16* MIX = (bf16*)(a->ws + WS_MIX);
    float g0 = 1.f, g1 = 1.f; if (even) { g0 = a->in[13][(layer >> 1) * 128 + 2 * lane]; g1 = a->in[13][(layer >> 1) * 128 + 2 * lane + 1]; }
    constexpr int RB = 3;
    for (int r0 = gw; r0 < MT; r0 += RB * NGW) {
        unsigned wf[RB][4], wb[RB][4], wg[RB][4];
#pragma unroll
        for (int k = 0; k < RB; ++k) { const int row = r0 + k * NGW; if (row < MT) {
#pragma unroll
            for (int h = 0; h < 4; ++h) { const int col = h * 128 + 2 * lane;
                wf[k][h] = *(const unsigned*)(OF + (size_t)row * 512 + col); wb[k][h] = *(const unsigned*)(OB + (size_t)row * 512 + col); wg[k][h] = *(const unsigned*)(P + (size_t)row * np + gcol + col); } } }
#pragma unroll
        for (int k = 0; k < RB; ++k) { const int row = r0 + k * NGW; if (row < MT) {
#pragma unroll
            for (int h = 0; h < 4; ++h) { const int col = h * 128 + 2 * lane;
                const float o0 = bf2f((unsigned short)(wf[k][h] & 0xffff)) + bf2f((unsigned short)(wb[k][h] & 0xffff)), o1 = bf2f((unsigned short)(wf[k][h] >> 16)) + bf2f((unsigned short)(wb[k][h] >> 16));
                const float rstd = __builtin_amdgcn_rsqf(wave_sum(o0 * o0 + o1 * o1) * (1.f / 128.f) + EPSN);
                const float y0 = o0 * rstd * g0 * silu_f(bf2f((unsigned short)(wg[k][h] & 0xffff))), y1 = o1 * rstd * g1 * silu_f(bf2f((unsigned short)(wg[k][h] >> 16)));
                *(unsigned*)(MIX + (size_t)row * 1024 + col) = pk2(y0, y1); } } }
    }
}
__device__ __forceinline__ void phase_final(KArgP a) {
    const int lane = otid() & 63, wave = otid() >> 6;
    const int gw = blockIdx.x * 8 + wave, NGW = gridDim.x * 8;
    const bf16* X = (const bf16*)(a->ws + WS_X); const float* g = a->in[22];
    constexpr int RB = 4;
    for (int r0 = gw; r0 < NB * NLAT; r0 += RB * NGW) {
        f32x4 v[RB][4];
#pragma unroll
        for (int k = 0; k < RB; ++k) { const int r = r0 + k * NGW; if (r < NB * NLAT) { const int row = (r >> 11) * TPB + 256 + (r & 2047);
#pragma unroll
            for (int q = 0; q < 4; ++q) v[k][q] = ld4_bf16(X + (size_t)row * 1024 + 4 * lane + 256 * q); } }
#pragma unroll
        for (int k = 0; k < RB; ++k) { const int r = r0 + k * NGW; if (r < NB * NLAT) { float ss = 0.f;
#pragma unroll
            for (int q = 0; q < 4; ++q) ss += (v[k][q][0] * v[k][q][0] + v[k][q][1] * v[k][q][1]) + (v[k][q][2] * v[k][q][2] + v[k][q][3] * v[k][q][3]);
            const float rstd = __builtin_amdgcn_rsqf(wave_sum(ss) * (1.f / 1024.f) + EPSN);
#pragma unroll
            for (int q = 0; q < 4; ++q) { const int col = 4 * lane + 256 * q; const f32x4 gv = *(const f32x4*)(g + col);
                *(f32x4*)(a->out + (size_t)r * 1024 + col) = v[k][q] * rstd * gv; } } }
    }
}
__device__ __forceinline__ unsigned cvtpk2(float lo, float hi) { unsigned r; asm("v_cvt_pk_bf16_f32 %0, %1, %2" : "=v"(r) : "v"(lo), "v"(hi)); return r; }
__device__ __forceinline__ f32x4 mfma16(bf16x8 a, bf16x8 b, f32x4 c) { return __builtin_amdgcn_mfma_f32_16x16x32_bf16(a, b, c, 0, 0, 0); }

template <int DK, bool HG, int MODE>
__device__ __forceinline__ void scan_item(KArgP a, int layer, int item, int seg, LAS unsigned char* lds) {
    const int tid = otid(), wid = tid >> 6, lane = tid & 63, l15 = lane & 15, q4 = lane >> 4;
    const int h = item & 3, dir = (item >> 2) & 1, b = item >> 3;
    constexpr int TPT = DK / 8, QS = DK * 2 + 16, TS = 144;
    constexpr int NP = HG ? NP_E : NP_O;
    LAS unsigned char* Lqt = lds; LAS unsigned char* Lkt = Lqt + 64 * QS; LAS unsigned char* Lqh = Lkt + 64 * QS;
    LAS unsigned char* LkhT = Lqh + 64 * QS; LAS unsigned char* LvT = LkhT + DK * TS; LAS unsigned char* Latt = LvT + 128 * TS;
    LAS float* Ltot = (LAS float*)(Latt + 64 * TS); LAS float* Lbl = Ltot + 512;
    const bf16* P = (const bf16*)(a->ws + WS_P);
    bf16* OSC = (bf16*)(a->ws + WS_OSC) + (size_t)dir * MT * 512;
    f32x4* Ub = (f32x4*)(a->ws + WS_U); float* Lb = (float*)(a->ws + WS_LSUM);
    const int c = tid & (DK - 1), tq = tid / DK;
    float lb = 0.f, lg = 0.f, qscale = 1.f; int qcol, zcol;
    if (HG) { qscale = 0.08838834764831845f; qcol = h * 128 + c; zcol = (dir ? 1536 : 1024) + h * 128 + c;
        if (layer >= 2) { const float l0 = a->in[12][(0 * 2 + dir) * 512 + h * 128 + c], l1 = a->in[12][(1 * 2 + dir) * 512 + h * 128 + c]; lb = 1.f / (1.f + __expf(l0 - l1)); } }
    else { qcol = h * 64 + c; zcol = 256 + h * 64 + c; const float x = a->in[19][((layer >> 1) * 2 + dir) * 4 + h]; lg = -__logf(1.f + __expf(-x)); }
    const int vcol = 512 + h * 128;
    const int rowbase = b * TPB;
    const int tv = lane, c8v = wid;
    unsigned short rq[TPT], rz[TPT]; bf16x8 rv[2];
#define SC_JB(ci) (dir ? ((ci) < 4 ? 255 - 64 * (ci) : 2303 - 64 * ((ci) - 4)) : 64 * (ci))
#define SC_LOAD(ci) do { const int jb_ = SC_JB(ci), sg_ = dir ? -1 : 1; \
        _Pragma("unroll") for (int i = 0; i < TPT; ++i) { const bf16* pr_ = P + (size_t)(rowbase + jb_ + sg_ * (tq * TPT + i)) * NP; if (MODE) rq[i] = pr_[qcol]; rz[i] = pr_[zcol]; } \
        { const bf16* pv_ = P + (size_t)(rowbase + jb_ + sg_ * tv) * NP + vcol; rv[0] = *(const bf16x8*)(pv_ + c8v * 8); rv[1] = *(const bf16x8*)(pv_ + (c8v + 8) * 8); } } while (0)
    f32x4 Sacc[DK / 16];
#pragma unroll
    for (int i = 0; i < DK / 16; ++i) Sacc[i] = (f32x4){0.f, 0.f, 0.f, 0.f};
    const int c0 = 9 * seg;
    SC_LOAD(c0);
    if (MODE) {
        for (int s_ = 0; s_ < seg; ++s_) {
#pragma unroll
            for (int i = 0; i < DK / 16; ++i) { f32x4 v = Sacc[i];
                if (s_ > 0) { const f32x4 l4 = *(const f32x4*)(Lb + (size_t)(item * 3 + s_) * 128 + 16 * i + 4 * q4); v[0] *= __expf(l4[0]); v[1] *= __expf(l4[1]); v[2] *= __expf(l4[2]); v[3] *= __expf(l4[3]); }
                Sacc[i] = v + Ub[((size_t)(item * 3 + s_) * (DK / 16) + i) * 512 + tid]; }
        }
    }
    float lsum = 0.f;
    for (int ci = c0; ci < c0 + 9; ++ci) {
#pragma unroll
        for (int u = 0; u < 2; ++u)
#pragma unroll
            for (int e = 0; e < 8; ++e) *(LAS unsigned short*)(LvT + ((c8v + 8 * u) * 8 + e) * TS + tv * 2) = (unsigned short)rv[u][e];
        float zf[TPT], qf[TPT];
#pragma unroll
        for (int i = 0; i < TPT; ++i) { zf[i] = bf2f(rz[i]); if (MODE) qf[i] = bf2f(rq[i]) * qscale; }
        const int jb = SC_JB(ci), sg = dir ? -1 : 1;
        if (ci + 1 < c0 + 9) SC_LOAD(ci + 1);
        float kk_[TPT], e1v[TPT], e2v[TPT]; float Eref, Ebr, dlast;
        if (HG) {
            float fv[TPT];
#pragma unroll
            for (int i = 0; i < TPT; ++i) { const float z = fminf(fmaxf(zf[i], -30.f), 30.f);
                const float t = __expf(-fabsf(z)), r = __builtin_amdgcn_rcpf(1.f + t), tr = t * r;
                const float sig = z >= 0.f ? r : tr, sigm = z >= 0.f ? tr : r;
                kk_[i] = (1.f - lb) * sigm; fv[i] = lb + (1.f - lb) * sig; }
            float run = 1.f;
            if (tq < 2) {
#pragma unroll
                for (int i = TPT - 1; i >= 0; --i) { e2v[i] = run; run *= fv[i]; }
            } else {
#pragma unroll
                for (int i = 0; i < TPT; ++i) { run *= fv[i]; e1v[i] = run; }
            }
            Ltot[tq * 128 + c] = run;
            __syncthreads();
            const float t0 = Ltot[c], t1 = Ltot[128 + c], t2 = Ltot[256 + c], t3 = Ltot[384 + c];
            Eref = t0 * t1; Ebr = t2 * t3; dlast = Eref * Ebr;
            const float mul = (tq == 0) ? t1 : ((tq == 3) ? t2 : 1.f);
            if (tq < 2) {
#pragma unroll
                for (int i = 0; i < TPT; ++i) { e2v[i] = fmaxf(e2v[i] * mul, 1e-30f); if (MODE) e1v[i] = __builtin_amdgcn_rcpf(e2v[i]); }
            } else {
#pragma unroll
                for (int i = 0; i < TPT; ++i) { e1v[i] = fmaxf(e1v[i] * mul, 1e-30f); e2v[i] = __builtin_amdgcn_rcpf(e1v[i]); }
            }
            lsum += __logf(fmaxf(dlast, 1e-37f));
        } else {
#pragma unroll
            for (int i = 0; i < TPT; ++i) { kk_[i] = zf[i]; e1v[i] = __expf((float)(tq * TPT + i - 31) * lg); e2v[i] = __builtin_amdgcn_rcpf(e1v[i]); }
            Eref = __expf(32.f * lg); Ebr = Eref; dlast = Eref * Ebr;
            lsum += 64.f * lg;
        }
        unsigned short kh[TPT];
        if (MODE) {
#pragma unroll
            for (int i = 0; i < TPT; ++i) { const int tau = tq * TPT + i;
                const float qt = qf[i] * e1v[i], kt = kk_[i] * e2v[i];
                const unsigned wq = cvtpk2(qt, qt * Eref), wk = cvtpk2(kt, kt * Ebr);
                *(LAS unsigned short*)(Lqt + tau * QS + c * 2) = (unsigned short)(wq & 0xffff);
                *(LAS unsigned short*)(Lqh + tau * QS + c * 2) = (unsigned short)(wq >> 16);
                *(LAS unsigned short*)(Lkt + tau * QS + c * 2) = (unsigned short)(wk & 0xffff);
                kh[i] = (unsigned short)(wk >> 16); }
        } else {
#pragma unroll
            for (int i = 0; i < TPT; ++i) kh[i] = (unsigned short)(cvtpk2(kk_[i] * e2v[i] * Ebr, 0.f) & 0xffff);
        }
#pragma unroll
        for (int i8 = 0; i8 < TPT / 8; ++i8) { u32x4 w; w.x = kh[8 * i8] | ((unsigned)kh[8 * i8 + 1] << 16); w.y = kh[8 * i8 + 2] | ((unsigned)kh[8 * i8 + 3] << 16);
            w.z = kh[8 * i8 + 4] | ((unsigned)kh[8 * i8 + 5] << 16); w.w = kh[8 * i8 + 6] | ((unsigned)kh[8 * i8 + 7] << 16);
            *(LAS u32x4*)(LkhT + c * TS + (tq * TPT + 8 * i8) * 2) = w; }
        if (tq == 0) Lbl[c] = dlast;
        __syncthreads();
        const int dvl = 16 * wid + l15;
        const bf16x8 bv0 = *(const LAS bf16x8*)(LvT + dvl * TS + (8 * q4) * 2), bv1 = *(const LAS bf16x8*)(LvT + dvl * TS + (32 + 8 * q4) * 2);
        if (MODE) {
#pragma unroll
            for (int tt = 0; tt < 2; ++tt) { const int idx = 2 * wid + tt, si = idx >> 2, ti = idx & 3;
                f32x4 acc = (f32x4){0.f, 0.f, 0.f, 0.f};
#pragma unroll
                for (int kk = 0; kk < DK / 32; ++kk) { const bf16x8 A = *(const LAS bf16x8*)(Lkt + (16 * si + l15) * QS + (32 * kk + 8 * q4) * 2);
                    const bf16x8 B = *(const LAS bf16x8*)(Lqt + (16 * ti + l15) * QS + (32 * kk + 8 * q4) * 2); acc = mfma16(A, B, acc); }
                const int t = 16 * ti + l15, s0 = 16 * si + 4 * q4;
                u32x2 w; w.x = pk2(s0 + 0 <= t ? acc[0] : 0.f, s0 + 1 <= t ? acc[1] : 0.f); w.y = pk2(s0 + 2 <= t ? acc[2] : 0.f, s0 + 3 <= t ? acc[3] : 0.f);
                *(LAS u32x2*)(Latt + t * TS + s0 * 2) = w; }
            __syncthreads();
            bf16x8 Sb[DK / 32];
#pragma unroll
            for (int kk = 0; kk < DK / 32; ++kk) { u32x4 w; w.x = pk2(Sacc[2 * kk][0], Sacc[2 * kk][1]); w.y = pk2(Sacc[2 * kk][2], Sacc[2 * kk][3]);
                w.z = pk2(Sacc[2 * kk + 1][0], Sacc[2 * kk + 1][1]); w.w = pk2(Sacc[2 * kk + 1][2], Sacc[2 * kk + 1][3]); Sb[kk] = __builtin_bit_cast(bf16x8, w); }
#pragma unroll
            for (int ti = 0; ti < 4; ++ti) {
                f32x4 acc = (f32x4){0.f, 0.f, 0.f, 0.f};
                { const bf16x8 A = *(const LAS bf16x8*)(Latt + (16 * ti + l15) * TS + (8 * q4) * 2); acc = mfma16(A, bv0, acc); }
                if (ti >= 2) { const bf16x8 A = *(const LAS bf16x8*)(Latt + (16 * ti + l15) * TS + (32 + 8 * q4) * 2); acc = mfma16(A, bv1, acc); }
#pragma unroll
                for (int kk = 0; kk < DK / 32; ++kk) {
                    const s16x4 lo = *(const LAS s16x4*)(Lqh + (16 * ti + l15) * QS + (32 * kk + 4 * q4) * 2), hi = *(const LAS s16x4*)(Lqh + (16 * ti + l15) * QS + (32 * kk + 16 + 4 * q4) * 2);
                    const bf16x8 A = (bf16x8){lo[0], lo[1], lo[2], lo[3], hi[0], hi[1], hi[2], hi[3]};
                    acc = mfma16(A, Sb[kk], acc); }
#pragma unroll
                for (int r = 0; r < 4; ++r) { const int t = 16 * ti + 4 * q4 + r;
                    OSC[(size_t)(rowbase + jb + sg * t) * 512 + h * 128 + dvl] = (bf16)f2bf(acc[r]); }
            }
        }
#pragma unroll
        for (int i = 0; i < DK / 16; ++i) {
            const f32x4 d4 = *(const LAS f32x4*)(Lbl + 16 * i + 4 * q4);
            f32x4 s = Sacc[i] * d4;
            const bf16x8 A0 = *(const LAS bf16x8*)(LkhT + (16 * i + l15) * TS + (8 * q4) * 2), A1 = *(const LAS bf16x8*)(LkhT + (16 * i + l15) * TS + (32 + 8 * q4) * 2);
            s = mfma16(A0, bv0, s); s = mfma16(A1, bv1, s); Sacc[i] = s; }
        __syncthreads();
    }
    if (!MODE) {
#pragma unroll
        for (int i = 0; i < DK / 16; ++i) Ub[((size_t)(item * 3 + seg) * (DK / 16) + i) * 512 + tid] = Sacc[i];
        if (tq == 0) Lb[(size_t)(item * 3 + seg) * 128 + c] = lsum;
    }
#undef SC_JB
#undef SC_LOAD
}

#define SBAR() __builtin_amdgcn_sched_barrier(0)
__device__ __forceinline__ int crow(int r, int hi) { return (r & 3) + 8 * (r >> 2) + 4 * hi; }
__device__ __forceinline__ unsigned cvtpk(float lo, float hi) { unsigned r; asm volatile("v_cvt_pk_bf16_f32 %0, %1, %2" : "=v"(r) : "v"(lo), "v"(hi)); return r; }
__device__ __forceinline__ void partialSM(f32x16& p0, f32x16& p1, float& m_reg, float& mn, float& alpha, float C, float thr_raw) {
    float pmax = p0[0];
#pragma unroll
    for (int r = 1; r < 16; ++r) pmax = fmaxf(pmax, p0[r]);
#pragma unroll
    for (int r = 0; r < 16; ++r) pmax = fmaxf(pmax, p1[r]);
    { auto rr = __builtin_amdgcn_permlane32_swap(__float_as_uint(pmax), __float_as_uint(pmax), false, false);
      pmax = fmaxf(__uint_as_float(rr[0]), __uint_as_float(rr[1])); }
    if (__builtin_expect(__all(pmax - m_reg <= thr_raw), 1)) { mn = m_reg; alpha = 1.f; }
    else { mn = fmaxf(m_reg, pmax); alpha = __builtin_amdgcn_exp2f((m_reg - mn) * C); m_reg = mn; }
    const float mnC = -mn * C;
#pragma unroll
    for (int r = 0; r < 16; ++r) p0[r] = fmaf(p0[r], C, mnC);
#pragma unroll
    for (int r = 0; r < 16; ++r) p1[r] = fmaf(p1[r], C, mnC);
#pragma unroll
    for (int r = 0; r < 16; ++r) p0[r] = __builtin_amdgcn_exp2f(p0[r]);
}
__device__ __forceinline__ void finishSM(f32x16& p0, f32x16& p1, float alpha, float& l_reg, bf16x8& pa0, bf16x8& pa1, bf16x8& pa2, bf16x8& pa3) {
#pragma unroll
    for (int r = 0; r < 16; ++r) p1[r] = __builtin_amdgcn_exp2f(p1[r]);
    float ps = 0;
#pragma unroll
    for (int r = 0; r < 16; ++r) ps += p0[r];
#pragma unroll
    for (int r = 0; r < 16; ++r) ps += p1[r];
    { auto rr = __builtin_amdgcn_permlane32_swap(__float_as_uint(ps), __float_as_uint(ps), false, false);
      ps = __uint_as_float(rr[0]) + __uint_as_float(rr[1]); }
    l_reg = l_reg * alpha + ps;
#define PK4(P, BASE, OUT) do { unsigned a0 = cvtpk(P[BASE + 0], P[BASE + 1]), a1 = cvtpk(P[BASE + 2], P[BASE + 3]);   \
    unsigned b0 = cvtpk(P[BASE + 4], P[BASE + 5]), b1 = cvtpk(P[BASE + 6], P[BASE + 7]);                              \
    auto r0 = __builtin_amdgcn_permlane32_swap(a0, b0, false, false); auto r1 = __builtin_amdgcn_permlane32_swap(a1, b1, false, false); \
    u32x4 w = {r0[0], r1[0], r0[1], r1[1]}; OUT = __builtin_bit_cast(bf16x8, w); } while (0)
    PK4(p0, 0, pa0); PK4(p0, 8, pa1); PK4(p1, 0, pa2); PK4(p1, 8, pa3);
#undef PK4
}
template <int ND0, int KROWB>
__device__ __forceinline__ void qkt(f32x16& p0, f32x16& p1, const char* Ks, const bf16x8* qr, int r32, int hi) {
    p0 = f32x16{}; p1 = f32x16{};
#pragma unroll
    for (int d0 = 0; d0 < ND0; ++d0) { const int cb = (d0 * 16 + hi * 8) * 2;
        const bf16x8 b0 = *reinterpret_cast<const bf16x8*>(Ks + r32 * KROWB + (cb ^ ((r32 & 7) << 4)));
        const bf16x8 b1 = *reinterpret_cast<const bf16x8*>(Ks + (32 + r32) * KROWB + (cb ^ ((r32 & 7) << 4)));
        p0 = __builtin_amdgcn_mfma_f32_32x32x16_bf16(b0, qr[d0], p0, 0, 0, 0);
        p1 = __builtin_amdgcn_mfma_f32_32x32x16_bf16(b1, qr[d0], p1, 0, 0, 0); }
}
template <int NCB> __device__ __forceinline__ int v_st(int k, int c) { const int kk = (k & ~0xC) | ((k & 4) << 1) | ((k & 8) >> 1); return ((kk >> 3) * NCB + (c >> 5)) * 512 + ((kk & 7) * 32 + (c & 31)) * 2; }
__device__ __forceinline__ int v_rd_base(int lane) { return ((lane & 3) << 3) | (((lane >> 2) & 3) << 6) | (((lane >> 4) & 1) << 5) | (((lane >> 5) & 1) << 8); }
template <int OFF> __device__ __forceinline__ s16x4 tr_read(int vb) {
    s16x4 r; asm volatile("ds_read_b64_tr_b16 %0, %1 offset:%2" : "=&v"(r) : "v"(vb), "i"(OFF) : "memory"); return r;
}
template <int NCB, int D0> __device__ __forceinline__ void pv_one(f32x16& od, int vb, bf16x8 pa0, bf16x8 pa1, bf16x8 pa2, bf16x8 pa3) {
#define VOFF(ks, half) (D0 * 512 + (ks) * (NCB * 1024) + (half) * (NCB * 512))
    const s16x4 l0 = tr_read<VOFF(0, 0)>(vb), h0 = tr_read<VOFF(0, 1)>(vb), l1 = tr_read<VOFF(1, 0)>(vb), h1 = tr_read<VOFF(1, 1)>(vb);
    const s16x4 l2 = tr_read<VOFF(2, 0)>(vb), h2 = tr_read<VOFF(2, 1)>(vb), l3 = tr_read<VOFF(3, 0)>(vb), h3 = tr_read<VOFF(3, 1)>(vb);
#undef VOFF
    asm volatile("s_waitcnt lgkmcnt(0)" ::: "memory"); SBAR();
#define PK(L, H) (bf16x8){L[0], L[1], L[2], L[3], H[0], H[1], H[2], H[3]}
    od = __builtin_amdgcn_mfma_f32_32x32x16_bf16(pa0, PK(l0, h0), od, 0, 0, 0);
    od = __builtin_amdgcn_mfma_f32_32x32x16_bf16(pa1, PK(l1, h1), od, 0, 0, 0);
    od = __builtin_amdgcn_mfma_f32_32x32x16_bf16(pa2, PK(l2, h2), od, 0, 0, 0);
    od = __builtin_amdgcn_mfma_f32_32x32x16_bf16(pa3, PK(l3, h3), od, 0, 0, 0);
#undef PK
}
template <int NCB> __device__ __forceinline__ void pv_all(f32x16* o, int vb, bf16x8 pa0, bf16x8 pa1, bf16x8 pa2, bf16x8 pa3) {
    pv_one<NCB, 0>(o[0], vb, pa0, pa1, pa2, pa3); pv_one<NCB, 1>(o[1], vb, pa0, pa1, pa2, pa3);
    if constexpr (NCB == 4) { pv_one<NCB, 2>(o[2], vb, pa0, pa1, pa2, pa3); pv_one<NCB, 3>(o[3], vb, pa0, pa1, pa2, pa3); }
}

template <int DQK, int DV, int KROWB>
__device__ __forceinline__ void attn_core(const bf16x8* qr, const bf16* kA, int sA, const bf16* kB, int sB, const bf16* vP, int sV,
                                          int NT, float C, float thr_raw, char* lds, f32x16* o, float& l_out, const int tid) {
    constexpr int NCB = DV / 32, SHM_V = 64 * DV * 2, SHM_K = 64 * KROWB, ND0 = DQK / 16;
    constexpr int PPR = DQK / 8, NPK = 64 * PPR, NKS = (NPK + 511) / 512, VPR = DV / 8, NVS = 64 * VPR / 512;
    const int wid = tid >> 6, lane = tid & 63, r32 = lane & 31, hi = lane >> 5;
    char* V_lds = lds; char* K_lds = lds + 2 * SHM_V;
    float* wsf = (float*)(lds + 2 * SHM_V + 2 * SHM_K) + wid * 64; float* al_l = wsf + 32;
    float m_reg = -1e30f, l_reg = 0;
    const bf16* kp[NKS]; int kadv[NKS], kst[NKS]; bool kval[NKS];
#pragma unroll
    for (int i = 0; i < NKS; ++i) { int p = tid + 512 * i; kval[i] = p < NPK; if (!kval[i]) p -= 512; const int row = p / PPR, c8 = p - row * PPR;
        if (c8 < 8) { kp[i] = kA + (size_t)row * sA + c8 * 8; kadv[i] = 64 * sA; } else { kp[i] = kB + (size_t)row * sB + (c8 - 8) * 8; kadv[i] = 64 * sB; }
        kst[i] = row * KROWB + ((c8 * 16) ^ ((row & 7) << 4)); }
    const bf16* vp[NVS]; int vst[NVS];
#pragma unroll
    for (int i = 0; i < NVS; ++i) { const int p = tid + 512 * i, row = p / VPR, c8 = p % VPR; vp[i] = vP + (size_t)row * sV + c8 * 8; vst[i] = v_st<NCB>(row, c8 * 8); }
    const int vadv = 64 * sV;
    const int vb0 = (int)(uintptr_t)V_lds + v_rd_base(lane);
    struct { bf16x8 ks[NKS]; bf16x8 vs[NVS]; } sr_[1];
#define SLOAD(i, t) do { _Pragma("unroll") for (int s_ = 0; s_ < NKS; ++s_) sr_[i].ks[s_] = *(const bf16x8*)(kp[s_] + (size_t)(t) * kadv[s_]); \
        _Pragma("unroll") for (int s_ = 0; s_ < NVS; ++s_) sr_[i].vs[s_] = *(const bf16x8*)(vp[s_] + (size_t)(t) * vadv); } while (0)
#define SWRITE(b, i) do { _Pragma("unroll") for (int s_ = 0; s_ < NVS; ++s_) *(bf16x8*)(V_lds + (b) * SHM_V + vst[s_]) = sr_[i].vs[s_]; \
        _Pragma("unroll") for (int s_ = 0; s_ < NKS; ++s_) if (kval[s_]) *(bf16x8*)(K_lds + (b) * SHM_K + kst[s_]) = sr_[i].ks[s_]; } while (0)
#define RESC(a) do { if (__any((a) < 1.f)) { if (hi == 0) al_l[r32] = (a); asm volatile("s_waitcnt lgkmcnt(0)" ::: "memory"); \
        _Pragma("unroll") for (int d = 0; d < NCB; ++d) _Pragma("unroll") for (int r = 0; r < 16; ++r) o[d][r] *= al_l[crow(r, hi)]; } } while (0)
    f32x16 pA0, pA1, pB0, pB1; float mnA, mnB, alA, alB; bf16x8 pa0, pa1, pa2, pa3;
    constexpr int SE = 0, SO = 0;
    SLOAD(SE, 0); SWRITE(0, SE); __syncthreads();
    qkt<ND0, KROWB>(pA0, pA1, K_lds, qr, r32, hi); partialSM(pA0, pA1, m_reg, mnA, alA, C, thr_raw);
    SLOAD(SO, 1);
    SWRITE(1, SO); __syncthreads();
    for (int j = 1; j + 1 < NT; j += 2) {
        SBAR(); qkt<ND0, KROWB>(pB0, pB1, K_lds + SHM_K, qr, r32, hi);
        finishSM(pA0, pA1, alA, l_reg, pa0, pa1, pa2, pa3); SBAR();
        SLOAD(SO, j + 1); SBAR();
        pv_all<NCB>(o, vb0, pa0, pa1, pa2, pa3); partialSM(pB0, pB1, m_reg, mnB, alB, C, thr_raw);
        __syncthreads(); SWRITE(0, SE);
        RESC(alB); __syncthreads();
        SBAR(); qkt<ND0, KROWB>(pA0, pA1, K_lds, qr, r32, hi);
        finishSM(pB0, pB1, alB, l_reg, pa0, pa1, pa2, pa3); SBAR();
        SLOAD(SE, j + 2); SBAR();
        pv_all<NCB>(o, vb0 + SHM_V, pa0, pa1, pa2, pa3); partialSM(pA0, pA1, m_reg, mnA, alA, C, thr_raw);
        __syncthreads(); SWRITE(1, SO);
        RESC(alA); __syncthreads();
    }
    SBAR(); qkt<ND0, KROWB>(pB0, pB1, K_lds + SHM_K, qr, r32, hi);
    finishSM(pA0, pA1, alA, l_reg, pa0, pa1, pa2, pa3); SBAR();
    pv_all<NCB>(o, vb0, pa0, pa1, pa2, pa3); partialSM(pB0, pB1, m_reg, mnB, alB, C, thr_raw);
    __syncthreads(); RESC(alB);
    finishSM(pB0, pB1, alB, l_reg, pa0, pa1, pa2, pa3); SBAR();
    pv_all<NCB>(o, vb0 + SHM_V, pa0, pa1, pa2, pa3);
    l_out = l_reg;
#undef SLOAD
#undef SWRITE
#undef RESC
}

__device__ __forceinline__ void mla_item(KArgP a, int b, int h, int qb, char* lds) {
    const int tid = ptid(), wid = tid >> 6, lane = tid & 63, r32 = lane & 31, hi = lane >> 5;
    const bf16* Qb = (const bf16*)((const unsigned char*)a->out + OUT_Q); const bf16* KV = (const bf16*)((const unsigned char*)a->out + OUT_KV);
    const bf16* KR = (const bf16*)(a->ws + WS_KR); bf16* MIX = (bf16*)(a->ws + WS_MIX);
    const int row0 = b * TPB + qb * 256, krow0 = b * TPB, NT = qb ? 36 : 4;
    const int row = row0 + wid * 32 + r32;
    const bf16* Qw = Qb + (size_t)row * 768 + h * 96;
    bf16x8 qr[6];
#pragma unroll
    for (int d0 = 0; d0 < 4; ++d0) qr[d0] = *(const bf16x8*)(Qw + d0 * 16 + hi * 8);
    const int t = (qb - 1) * 256 + wid * 32 + r32;
#pragma unroll
    for (int d0 = 4; d0 < 6; ++d0) {
        const bf16x8 x1 = *(const bf16x8*)(Qw + d0 * 16), x2 = *(const bf16x8*)(Qw + d0 * 16 + 8);
        if (qb) { const float pos = (float)(d0 == 4 ? (t >> 6) : (t & 63)); unsigned short ov[8];
#pragma unroll
            for (int i = 0; i < 8; ++i) { float s, c; sincos_r(pos * inv_freq(i, 8), s, c); const float f1 = bf2f((unsigned short)x1[i]), f2 = bf2f((unsigned short)x2[i]);
                ov[i] = (unsigned short)f2bf(hi ? (f1 * s + f2 * c) : (f1 * c - f2 * s)); }
            qr[d0] = (bf16x8){(short)ov[0], (short)ov[1], (short)ov[2], (short)ov[3], (short)ov[4], (short)ov[5], (short)ov[6], (short)ov[7]};
        } else qr[d0] = hi ? x2 : x1;
    }
    f32x16 o[2] = {}; float l_reg;
    const float scale = 0.10206207261596575f;
    attn_core<96, 64, 256>(qr, KV + (size_t)krow0 * 1024 + h * 128, 1024, KR + (size_t)krow0 * 32, 32, KV + (size_t)krow0 * 1024 + h * 128 + 64, 1024,
                           NT, scale * 1.4426950408889634f, 8.f / scale, lds, o, l_reg, tid);
    float* li_l = (float*)(lds + 2 * 64 * 64 * 2 + 2 * 64 * 256) + wid * 64;
    if (hi == 0) li_l[r32] = l_reg; asm volatile("s_waitcnt lgkmcnt(0)" ::: "memory");
#pragma unroll
    for (int r = 0; r < 16; ++r) { const int orow = crow(r, hi); const float rl = __builtin_amdgcn_rcpf(li_l[orow]);
        bf16* op = MIX + (size_t)(row0 + wid * 32 + orow) * 1024 + 512 + h * 64 + r32;
        op[0] = (bf16)f2bf(o[0][r] * rl); op[32] = (bf16)f2bf(o[1][r] * rl); }
}
__device__ __forceinline__ void diff_item(KArgP a, int layer, int b, int h, int qb, char* lds) {
    const int row0 = b * TPB + qb * 256, krow0 = b * TPB, NT = qb ? 36 : 4, o_ = layer >> 1;
    const float scale = 0.125f;
#pragma unroll 1
    for (int m = 0; m < 2; ++m) {
        f32x16 o[4] = {};
        float l_reg;
        {
            const int tid = ptid(), wid = tid >> 6, lane = tid & 63, r32 = lane & 31, hi = lane >> 5;
            const bf16* P = (const bf16*)(a->ws + WS_P);
            const bf16* Qw = P + (size_t)(row0 + wid * 32 + r32) * NP_O + 1536 + h * 128 + m * 64;
            bf16x8 qr[4];
#pragma unroll
            for (int d0 = 0; d0 < 4; ++d0) qr[d0] = *(const bf16x8*)(Qw + d0 * 16 + hi * 8);
            const bf16* Kp = P + (size_t)krow0 * NP_O + 2048 + h * 128 + m * 64;
            attn_core<64, 128, 128>(qr, Kp, NP_O, Kp, NP_O, P + (size_t)krow0 * NP_O + 2560 + h * 128, NP_O,
                                    NT, scale * 1.4426950408889634f, 8.f / scale, lds, o, l_reg, tid);
        }
        const int tid = ptid(), wid = tid >> 6, lane = tid & 63, r32 = lane & 31, hi = lane >> 5;
        float* li_l = (float*)(lds + 2 * 64 * 128 * 2 + 2 * 64 * 128) + wid * 64;
        if (hi == 0) li_l[r32] = l_reg; asm volatile("s_waitcnt lgkmcnt(0)" ::: "memory");
        float* dsb = (float*)a->out + (size_t)blockIdx.x * 64 * 512 + tid; asm volatile("" : "+v"(dsb));
        if (m == 0) {
#pragma unroll
            for (int r = 0; r < 16; ++r) { const float rl = __builtin_amdgcn_rcpf(li_l[crow(r, hi)]);
#pragma unroll
                for (int d = 0; d < 4; ++d) dsb[(size_t)(d * 16 + r) * 512] = o[d][r] * rl; }
        } else {
            bf16* MIX = (bf16*)(a->ws + WS_MIX);
            const float* lp = a->in[20] + o_ * 256;
            const float lam_init = 0.8f - 0.6f * __expf(-0.3f * (float)layer);
            const float lam = __expf(wave_sum(lp[lane] * lp[64 + lane])) - __expf(wave_sum(lp[128 + lane] * lp[192 + lane])) + lam_init;
            const float* sg = a->in[21] + o_ * 128;
#pragma unroll
            for (int r = 0; r < 16; ++r) { const float rl = __builtin_amdgcn_rcpf(li_l[crow(r, hi)]); float s = 0.f; float v[4];
#pragma unroll
                for (int d = 0; d < 4; ++d) { v[d] = dsb[(size_t)(d * 16 + r) * 512] - lam * (o[d][r] * rl); s += v[d] * v[d]; }
                s += __shfl_xor(s, 16); s += __shfl_xor(s, 8); s += __shfl_xor(s, 4); s += __shfl_xor(s, 2); s += __shfl_xor(s, 1);
                const float rs = __builtin_amdgcn_rsqf(s * (1.f / 128.f) + EPSN) * (1.f - lam_init);
                bf16* op = MIX + (size_t)(row0 + wid * 32 + crow(r, hi)) * 1024 + 512 + h * 128 + r32;
#pragma unroll
                for (int d = 0; d < 4; ++d) op[32 * d] = (bf16)f2bf(v[d] * rs * sg[32 * d + r32]);
                asm volatile("" ::: "memory"); }
        }
        asm volatile("s_waitcnt vmcnt(0) lgkmcnt(0)" ::: "memory");
    }
}

__device__ __forceinline__ void phase_mixer(KArgP a, int layer, unsigned char* ldsg) {
    LAS unsigned char* lds = (LAS unsigned char*)ldsg;
    volatile LAS unsigned* flag = (volatile LAS unsigned*)(lds + LDS_MAIN);
    unsigned* ctr = (unsigned*)(a->ws + WS_CTL) + layer; layer &= 7;
    const bool even = !(layer & 1), need_ctx = layer < 3;
    constexpr int NSC = 256;
    const int n_lat = even ? 512 : 256, n_ctx = need_ctx ? (even ? 64 : 32) : 0, total = NSC + n_lat + n_ctx;
    for (;;) {
        __syncthreads();
        if (ptid() == 0) *flag = atomicAdd(ctr, 1u);
        __syncthreads();
        const int qi_ = (int)*flag;
        if (qi_ >= total) break;
        const int item = qi_ < n_lat ? NSC + qi_ : (qi_ < n_lat + NSC ? qi_ - n_lat : qi_);
#ifdef PROBE_ITEM
        const unsigned long long it0_ = __builtin_amdgcn_s_memrealtime();
#endif
#ifndef SKIP_SCAN
        if (item < NSC) { if (even) scan_item<128, true, 1>(a, layer, item & 63, item >> 6, lds); else scan_item<64, false, 1>(a, layer, item & 63, item >> 6, lds); }
#else
        if (item < NSC) {}
#endif
        else { int b_, h_, qb_;
            if (item < NSC + n_lat) { const int i = item - NSC; qb_ = 1 + (i & 7); if (even) { b_ = i >> 6; h_ = (i >> 3) & 7; } else { b_ = i >> 5; h_ = (i >> 3) & 3; } }
            else { const int i = item - NSC - n_lat; qb_ = 0; if (even) { b_ = i >> 3; h_ = i & 7; } else { b_ = i >> 2; h_ = i & 3; } }
#ifndef SKIP_ATTN
            if (even) mla_item(a, b_, h_, qb_, (char*)ldsg); else diff_item(a, layer, b_, h_, qb_, (char*)ldsg);
#endif
        }
#ifdef PROBE_ITEM
        __syncthreads();
        if (otid() == 0) { volatile LAS unsigned long long* pc_ = (volatile LAS unsigned long long*)(lds + LDS_MAIN + 128); const int k_ = item < NSC ? 0 : (even ? 1 : 2); pc_[k_] += __builtin_amdgcn_s_memrealtime() - it0_; }
#endif
    }
}

#define XB_TMO      128
#define XB_XCNT(j)  (256  + 64 * (j))
#define XB_XSUB(j)  (1280 + 64 * (j))
#define XB_XGEN(j)  (2304 + 64 * (j))
#define XB_TOP      3328
#define XB_TOPGEN   3392
#define XCD_BAR_WORDS 3456
#define XB_SPIN_CAP (1u << 18)

__device__ __forceinline__ unsigned xb_ld(unsigned* p)              { return __hip_atomic_load(p, __ATOMIC_RELAXED, __HIP_MEMORY_SCOPE_AGENT); }
__device__ __forceinline__ unsigned xb_add(unsigned* p, unsigned v) { return __hip_atomic_fetch_add(p, v, __ATOMIC_RELAXED, __HIP_MEMORY_SCOPE_AGENT); }
__device__ __forceinline__ unsigned xb_xcc_id() { return (unsigned)__builtin_amdgcn_s_getreg((3 << 11) | 20) & 0xFu; }
#define XB_SPIN(cond, bar) do { unsigned _sp = 0; while (cond) { __builtin_amdgcn_s_sleep(1); \
    if ((++_sp & 255u) == 0u) { if (xb_ld(&(bar)[XB_TMO])) break; if (_sp > XB_SPIN_CAP) { atomicAdd(&(bar)[XB_TMO], 1u); break; } } } } while (0)

struct XcdBarrier {
    unsigned* bar; unsigned x;
    volatile LAS unsigned* st;
};

__device__ __forceinline__ XcdBarrier xcd_barrier_post(unsigned* bar, volatile LAS unsigned* st) {
    XcdBarrier b; b.bar = bar; b.x = xb_xcc_id(); b.st = st;
    if (threadIdx.x == 0) (void)xb_add(&bar[XB_XCNT(b.x)], 1u);
    return b;
}
__device__ __forceinline__ void xcd_barrier_complete(unsigned* bar, unsigned x, unsigned& nloc, unsigned& nx) {
    const unsigned G = gridDim.x * gridDim.y * gridDim.z;
    unsigned sum, cnt, mine, sp = 0u;
    for (;;) {
        sum = 0u; cnt = 0u; mine = 0u;
#pragma unroll
        for (unsigned j = 0; j < 16; ++j) { const unsigned c = xb_ld(&bar[XB_XCNT(j)]); sum += c; cnt += (c > 0u) ? 1u : 0u; mine = (j == x) ? c : mine; }
        if (sum == G) break;
        __builtin_amdgcn_s_sleep(1);
        if ((++sp & 255u) == 0u) { if (xb_ld(&bar[XB_TMO])) break; if (sp > XB_SPIN_CAP) { atomicAdd(&bar[XB_TMO], 1u); break; } }
    }
    nloc = mine > 0u ? mine : 1u; nx = cnt > 0u ? cnt : 1u;
}

__device__ __forceinline__ void xcd_barrier(const XcdBarrier& b) {
    asm volatile("s_waitcnt vmcnt(0)" ::: "memory");
    __syncthreads();
    if (threadIdx.x == 0) {
        unsigned* bar = b.bar;
        __builtin_amdgcn_s_waitcnt(0);
        unsigned nloc = b.st[0], nx = b.st[1];
        if (nloc == 0u) { xcd_barrier_complete(bar, b.x, nloc, nx); b.st[0] = nloc; b.st[1] = nx; }
        const unsigned old = xb_add(&bar[XB_XSUB(b.x)], 1u);
        const unsigned gen = old / nloc;
        if (old + 1u == (gen + 1u) * nloc) {
            __builtin_amdgcn_fence(__ATOMIC_RELEASE, "agent");
            asm volatile("s_waitcnt vmcnt(0)" ::: "memory");
            const unsigned og = xb_add(&bar[XB_TOP], 1u);
            const unsigned tg = og / nx;
            if (og + 1u == (tg + 1u) * nx) xb_add(&bar[XB_TOPGEN], 1u);
            else XB_SPIN(xb_ld(&bar[XB_TOPGEN]) == tg, bar);
            __builtin_amdgcn_fence(__ATOMIC_ACQUIRE, "agent");
            xb_add(&bar[XB_XGEN(b.x)], 1u);
            asm volatile("s_waitcnt vmcnt(0)" ::: "memory");
        } else {
            XB_SPIN(xb_ld(&bar[XB_XGEN(b.x)]) == gen, bar);
            __builtin_amdgcn_fence(__ATOMIC_ACQUIRE, "agent");
            asm volatile("s_waitcnt vmcnt(0)" ::: "memory");
        }
    }
    __syncthreads();
}

__global__ void __launch_bounds__(512, 2) mega_fwd(Args a_) {
    extern __shared__ __attribute__((aligned(16))) unsigned char lds_raw[];
    LAS unsigned char* lds = (LAS unsigned char*)lds_raw;
    ((LAS int*)(lds + LDS_MAIN + 1024))[threadIdx.x] = (int)threadIdx.x;
    if (threadIdx.x < 4) ((LAS unsigned*)(lds + LDS_MAIN + 64))[threadIdx.x] = 0u;
    if (threadIdx.x < 8) ((LAS unsigned*)(lds + LDS_MAIN + 128))[threadIdx.x] = 0u;
    __syncthreads();
    XcdBarrier xbar; xbar.bar = nullptr; xbar.x = 0; xbar.st = nullptr; bool xb_ready = false;
    cg::grid_group grid = cg::this_grid();
    int ph = 0;
#ifdef PROBE_MASK
    unsigned long long pr_last = __builtin_amdgcn_s_memrealtime(), pr_acc = 0ull;
#define PROBE_STAMP(k) { const unsigned long long now_ = __builtin_amdgcn_s_memrealtime(); if ((PROBE_MASK >> (k)) & 1) pr_acc += now_ - pr_last; pr_last = now_; }
#else
#define PROBE_STAMP(k)
#endif
    const int plo = a_.lo, phi = a_.hi;
#define PH_BEGIN if (ph >= plo && ph < phi) { KArgP a = kargs(); int bx = (int)blockIdx.x, G = (int)gridDim.x; asm volatile("" : "+s"(bx), "+s"(G)); (void)bx; (void)G;
#ifdef PROBE_SYNC2
#define PH_ENDT(k)   if (ph + 1 < phi) { grid.sync(); grid.sync(); } } ++ph;
#else
#define PH_ENDT(k) if (ph + 1 < phi) { if (!xb_ready) { grid.sync(); xbar = xcd_barrier_post((unsigned*)(a->ws + WS_CTL) + 4096, (volatile LAS unsigned*)(lds + LDS_MAIN + 64)); xb_ready = true; } else xcd_barrier(xbar); } PROBE_STAMP(k) } ++ph;
#endif

    PH_BEGIN phase_prep(a, lds); PH_ENDT(0)

    for (int layer = 0; layer < 4; ++layer) {
        const bool even = !(layer & 1);
        const int np = even ? NP_E : NP_O;
        PH_BEGIN phase_norm(a, layer, 0, layer > 0); convert_weights(a, layer, lds, 0, bx * 8 + (otid() >> 6), G * 8); PH_ENDT(1)
#ifndef SKIP_G1
        PH_BEGIN { bf16* H = (bf16*)(a->ws + WS_H); bf16* MIX = (bf16*)(a->ws + WS_MIX); bf16* P = (bf16*)(a->ws + WS_P); bf16* X = (bf16*)(a->ws + WS_X); unsigned char* Wb = a->ws + WS_W; const float* mod = (const float*)(a->ws + WS_MOD) + (size_t)layer * 9 * 6144; (void)H; (void)MIX; (void)P; (void)X; (void)mod; pg8::Gemm g{H, (const bf16*)(Wb + W_IN), MT, np, 1024, 1024}; pg8::StaticOrder S; S.init(MT, np, G, bx);
                   pg8::EpiBf16<0> E{P, np, nullptr, 0, 0, 1.f};
                   pg8::gemm_phase<pg8::EpiBf16<0>, pg8::StaticOrder, true, true>(lds, g, S, E); } PH_ENDT(2)
#else
        ++ph;
#endif
        PH_BEGIN if (even) phase_post_even(a, layer); else phase_post_odd(a, layer); PH_ENDT(3)
#ifndef SKIP_G3
        if (even) {
            PH_BEGIN { bf16* H = (bf16*)(a->ws + WS_H); bf16* MIX = (bf16*)(a->ws + WS_MIX); bf16* P = (bf16*)(a->ws + WS_P); bf16* X = (bf16*)(a->ws + WS_X); unsigned char* Wb = a->ws + WS_W; const float* mod = (const float*)(a->ws + WS_MOD) + (size_t)layer * 9 * 6144; (void)H; (void)MIX; (void)P; (void)X; (void)mod; pg8::Gemm g{(const bf16*)(a->ws + WS_CQN), (const bf16*)(Wb + W_UQ), MT, 768, 384, 384}; pg8::StaticOrder S; S.init(MT, 768, G, bx);
                       pg8::EpiBf16<0> E{(bf16*)((unsigned char*)a->out + OUT_Q), 768, nullptr, 0, 0, 1.f};
                       pg8::gemm_phase<pg8::EpiBf16<0>, pg8::StaticOrder, true, true>(lds, g, S, E); }
                     { unsigned char* Wb = a->ws + WS_W; pg8::Gemm g{(const bf16*)(a->ws + WS_CKVN), (const bf16*)(Wb + W_UKV), MT, 1024, 256, 256}; pg8::StaticOrder S; S.init(MT, 1024, G, bx);
                       pg8::EpiBf16<0> E{(bf16*)((unsigned char*)a->out + OUT_KV), 1024, nullptr, 0, 0, 1.f};
                       pg8::gemm_phase<pg8::EpiBf16<0>, pg8::StaticOrder, true, true>(lds, g, S, E); }
                     for (int it = bx; it < 192; it += G) scan_item<128, true, 0>(a, layer, it & 63, it >> 6, lds);
                     if (bx >= 192) convert_weights(a, layer, lds, 1, (bx - 192) * 8 + (otid() >> 6), (G - 192) * 8);
            PH_ENDT(4)
        } else { ++ph; }
#else
        ++ph;
#endif
        if (!even) {
        PH_BEGIN for (int it = bx; it < 192; it += G) scan_item<64, false, 0>(a, layer, it & 63, it >> 6, lds);
                 if (bx >= 192) convert_weights(a, layer, lds, 1, (bx - 192) * 8 + (otid() >> 6), (G - 192) * 8); PH_ENDT(5)
        } else { ++ph; }
#ifdef PROBE_MIX2
        PH_BEGIN phase_mixer(a, layer + 8, lds_raw); grid.sync(); PH_ENDT(6)
        --ph;
#endif
        PH_BEGIN phase_mixer(a, layer, lds_raw); PH_ENDT(6 + 7 * (layer & 1))
        PH_BEGIN phase_readout(a, layer); PH_ENDT(7)
#ifndef SKIP_G6
        PH_BEGIN { bf16* H = (bf16*)(a->ws + WS_H); bf16* MIX = (bf16*)(a->ws + WS_MIX); bf16* P = (bf16*)(a->ws + WS_P); bf16* X = (bf16*)(a->ws + WS_X); unsigned char* Wb = a->ws + WS_W; const float* mod = (const float*)(a->ws + WS_MOD) + (size_t)layer * 9 * 6144; (void)H; (void)MIX; (void)P; (void)X; (void)mod; pg8::Gemm g{MIX, (const bf16*)(Wb + W_OUT), MT, 1024, 1024, 1024}; pg8::StaticOrder S; S.init(NB * NLAT, 1024, G, bx, 1);
                   pg8::EpiResid E{X, mod, 2048, layer == 0 ? a->in[0] : nullptr};
                   pg8::gemm_phase<pg8::EpiResid, pg8::StaticOrder, true, true>(lds, g, S, E);
                   if (layer < 3) { pg8::Gemm g2{MIX, (const bf16*)(Wb + W_OUT), MT, 1024, 512, 1024}; pg8::CtxSplitOrder S2{G, bx, 512};
                       pg8::EpiResidSplit E2{X, (float*)(a->ws + WS_T), mod, 2048, layer == 0 ? a->in[2] : nullptr};
                       pg8::gemm_phase<pg8::EpiResidSplit, pg8::CtxSplitOrder, true, true>(lds, g2, S2, E2); } } PH_ENDT(8)
#else
        ++ph;
#endif
        PH_BEGIN phase_norm(a, layer, 1, layer < 3); PH_ENDT(9)
#ifndef SKIP_G8
        PH_BEGIN { bf16* H = (bf16*)(a->ws + WS_H); bf16* MIX = (bf16*)(a->ws + WS_MIX); bf16* P = (bf16*)(a->ws + WS_P); bf16* X = (bf16*)(a->ws + WS_X); unsigned char* Wb = a->ws + WS_W; const float* mod = (const float*)(a->ws + WS_MOD) + (size_t)layer * 9 * 6144; (void)H; (void)MIX; (void)P; (void)X; (void)mod; pg8::Gemm g{H, (const bf16*)(Wb + W_GU), MT, 2 * FF, 1024, 1024}; pg8::StaticOrder S; if (layer < 3) S.init(MT, 2 * FF, G, bx); else S.init(NB * NLAT, 2 * FF, G, bx, 1);
                   pg8::EpiSwiGLU E{P, FF};
                   pg8::gemm_phase<pg8::EpiSwiGLU, pg8::StaticOrder, true, true>(lds, g, S, E); } PH_ENDT(10)
#else
        ++ph;
#endif
#ifndef SKIP_G9
        PH_BEGIN { bf16* H = (bf16*)(a->ws + WS_H); bf16* MIX = (bf16*)(a->ws + WS_MIX); bf16* P = (bf16*)(a->ws + WS_P); bf16* X = (bf16*)(a->ws + WS_X); unsigned char* Wb = a->ws + WS_W; const float* mod = (const float*)(a->ws + WS_MOD) + (size_t)layer * 9 * 6144; (void)H; (void)MIX; (void)P; (void)X; (void)mod; pg8::Gemm g{P, (const bf16*)(Wb + W_DN), MT, 1024, FF, FF}; pg8::StaticOrder S; S.init(NB * NLAT, 1024, G, bx, 1);
                   pg8::EpiResid E{X, mod, 5120, nullptr};
                   pg8::gemm_phase<pg8::EpiResid, pg8::StaticOrder, true, true>(lds, g, S, E);
                   if (layer < 3) { pg8::Gemm g2{P, (const bf16*)(Wb + W_DN), MT, 1024, FF / 2, FF}; pg8::CtxSplitOrder S2{G, bx, FF / 2};
                       pg8::EpiResidSplit E2{X, (float*)(a->ws + WS_T), mod, 5120, nullptr};
                       pg8::gemm_phase<pg8::EpiResidSplit, pg8::CtxSplitOrder, true, true>(lds, g2, S2, E2); } } PH_ENDT(11)
#else
        ++ph;
#endif
    }
    PH_BEGIN phase_final(a); PH_ENDT(12)
#undef PH_BEGIN
#undef PH_ENDT
#ifdef PROBE_ITEM
    pr_acc += ((volatile LAS unsigned long long*)(lds + LDS_MAIN + 128))[PROBE_ITEM - 1];
#endif
#ifdef PROBE_MASK
    if (blockIdx.x == 0) { const unsigned long long t0_ = __builtin_amdgcn_s_memrealtime(); while (__builtin_amdgcn_s_memrealtime() - t0_ < pr_acc) __builtin_amdgcn_s_sleep(8); }
#endif
}
constexpr int NPH = 1 + 4 * 11 + 1;

extern "C" void kernel_launch(void* const* d_in, const int* in_sizes, int n_in, void* d_out, int out_size, void* d_ws, size_t ws_size, hipStream_t stream) {
    static int grid = 0;
    if (grid == 0) {
        if (n_in != 23 || ws_size < WS_END || out_size != NB * NLAT * DM) { fprintf(stderr, "kernel_launch: unexpected shapes: n_in %d ws %zu (need %zu) out %d\n", n_in, ws_size, (size_t)WS_END, out_size); grid = -1; return; }
        int dev = 0, cus = 0, per_cu = 0;
        hipGetDevice(&dev); hipDeviceGetAttribute(&cus, hipDeviceAttributeMultiprocessorCount, dev);
        if (hipFuncSetAttribute((const void*)mega_fwd, hipFuncAttributeMaxDynamicSharedMemorySize, LDS_BYTES) != hipSuccess) { fprintf(stderr, "kernel_launch: hipFuncSetAttribute failed\n"); grid = -1; return; }
        if (hipOccupancyMaxActiveBlocksPerMultiprocessor(&per_cu, (const void*)mega_fwd, 512, LDS_BYTES) != hipSuccess || per_cu < 1) { fprintf(stderr, "kernel_launch: occupancy query says %d\n", per_cu); per_cu = 1; }
        (void)hipGetLastError();
        grid = cus;
    }
    if (grid < 0) return;
    Args a{};
    for (int i = 0; i < 23; ++i) a.in[i] = (const float*)d_in[i];
    a.out = (float*)d_out; a.ws = (unsigned char*)d_ws; a.lo = 0; a.hi = NPH;
    void* kargv[] = {&a};
    hipError_t e = hipLaunchCooperativeKernel((const void*)mega_fwd, dim3(grid), dim3(512), kargv, LDS_BYTES, stream);
    if (e != hipSuccess) fprintf(stderr, "kernel_launch: cooperative launch failed: %s (grid %d)\n", hipGetErrorString(e), grid);
}
```

```cpp
#include <hip/hip_runtime.h>
#include <hip/hip_cooperative_groups.h>
#include <cstdio>
#include <cstdint>
namespace cg = cooperative_groups;
#define otid() ({ int t_ = (int)threadIdx.x; asm volatile("" : "+v"(t_)); t_; })
extern __shared__ __attribute__((aligned(16))) unsigned char g_lds_dyn[];
#define ptid() (*(volatile __attribute__((address_space(3))) int*)((__attribute__((address_space(3))) unsigned char*)g_lds_dyn + 131072 + 1024 + 4 * (int)threadIdx.x))
namespace pg8 {
#define PG8_LAS __attribute__((address_space(3)))
typedef unsigned short bf16_t;
typedef short bf16x8 __attribute__((ext_vector_type(8)));
typedef float f32x4 __attribute__((ext_vector_type(4)));
typedef unsigned u32x4 __attribute__((ext_vector_type(4)));
constexpr int BM = 256, BK = 64, HALF = 128, HTB = HALF * BK * 2  , STAGE_BYTES = 8 * HTB, NXCD = 8, WGM = 8;

__host__ __device__ __forceinline__ int lds_byte(int r, int c) { const int st = (r >> 4) * 2 + (c >> 5), rr = r & 15, cc = c & 31, ob = rr * 64 + cc * 2; return st * 1024 + (ob ^ (((ob >> 9) & 1) << 5)); }
__host__ __device__ __forceinline__ void stage_rc(int b, int& R, int& C) { const int st = b / 1024, sb = b % 1024, swz = sb ^ (((sb >> 9) & 1) << 5); R = (st >> 1) * 16 + swz / 64; C = (st & 1) * 32 + (swz % 64) / 2; }
__host__ __device__ __forceinline__ int perm32(int rho) { const int n = rho >> 4, i = rho & 15; return 8 * (i >> 2) + 4 * n + (i & 3); }

struct Unit { int pm, pn, koff; };
struct Gemm { const bf16_t* A; const bf16_t* Bt; int M, N, K, ld; };

struct StaticOrder {
    int nM, nN, nwg, G, c, mode;
    __host__ __device__ void init(int M, int N, int G_, int c_, int mode_ = 0) { nM = M / BM; nN = N / BM; nwg = nM * nN; G = G_; c = c_; mode = mode_; }
    __host__ __device__ bool next(int i, Unit& u) const {
        const long L = (long)i * G + c; if (L >= nwg) return false;
        int wgid = (int)L; { const int q = nwg / NXCD, r = nwg % NXCD, xcd = wgid % NXCD, off = wgid / NXCD; wgid = (xcd < r ? xcd * (q + 1) : r * (q + 1) + (xcd - r) * q) + off; }
        const int nig = WGM * nN, gid = wgid / nig, fm = gid * WGM, gsz = (nM - fm) < WGM ? (nM - fm) : WGM;
        u.pm = fm + ((wgid % nig) % gsz); u.pn = (wgid % nig) / gsz; u.koff = 0; if (mode == 1) u.pm = (u.pm >> 3) * 9 + 1 + (u.pm & 7); return true;
    }
    __device__ __forceinline__ void a_ready(const Unit&) const {}
    __device__ __forceinline__ void done(const Unit&) const {}
};
struct CtxSplitOrder {
    int G, c, khalf;
    __device__ bool next(int i, Unit& u) const { const int L = i * G + c; if (L >= 64) return false; u.koff = (L & 1) * khalf; u.pn = (L >> 1) & 3; u.pm = (L >> 3) * 9; return true; }
    __device__ __forceinline__ void a_ready(const Unit&) const {}
    __device__ __forceinline__ void done(const Unit&) const {}
};

__device__ __forceinline__ unsigned cvt_pk_bf16(float lo, float hi) { unsigned r; asm volatile("v_cvt_pk_bf16_f32 %0, %1, %2" : "=v"(r) : "v"(lo), "v"(hi)); return r; }
typedef float f32x2 __attribute__((ext_vector_type(2)));
__device__ __forceinline__ f32x2 gelu_pk(f32x2 v) {
    const f32x2 av = __builtin_elementwise_abs(v), d = av * 0.2316418882f + 1.0f;
    f32x2 t; t.x = __builtin_amdgcn_rcpf(d.x); t.y = __builtin_amdgcn_rcpf(d.y);
    f32x2 q = t * 0.5307027145f + (-0.7265760135f); q = q * t + 0.7107068705f; q = q * t + (-0.142248368f); q = q * t + 0.127414796f; q = q * t;
    const f32x2 s = (v * v) * (-0.72134752044f);
    f32x2 e; e.x = __builtin_amdgcn_exp2f(s.x); e.y = __builtin_amdgcn_exp2f(s.y);
    const f32x2 m = v * (q * e), r = v - m;
    f32x2 o; o.x = v.x < 0.f ? m.x : r.x; o.y = v.y < 0.f ? m.y : r.y; return o;
}

template <int ACT  > struct EpiBf16 {
    static constexpr bool PERM = true, AFTER_DRAIN = false; static_assert(ACT == 0 || ACT == 1, "EpiBf16: ACT is 0 (none) or 1 (gelu_pk)");
    bf16_t* O; int ldc; const float* bias; int split_cols; size_t split_stride; float scale0;
    __device__ __forceinline__ void operator()(const f32x4 (&acc)[2][2][4][2], const Unit& u, int wr, int wc, int fr, int fq) const {
        const int row0 = u.pm * BM + wr * 64 + fr; int colt = u.pn * BM; bf16_t* base = O;
        float sc = 1.f; if (split_cols) { const int t = colt / split_cols; base += (size_t)t * split_stride; colt -= t * split_cols; if (t == 0) sc = scale0; }
        const int col0 = colt + wc * 32 + 8 * fq, bcol0 = u.pn * BM + wc * 32 + 8 * fq;
        f32x4 bv[2][2];
#pragma unroll
        for (int bj = 0; bj < 2; ++bj)
#pragma unroll
            for (int n = 0; n < 2; ++n) bv[bj][n] = bias ? *(const f32x4*)(bias + bcol0 + bj * HALF + 4 * n) : (f32x4){0.f, 0.f, 0.f, 0.f};
#pragma unroll
        for (int ai = 0; ai < 2; ++ai)
#pragma unroll
            for (int m = 0; m < 4; ++m) { bf16_t* rowp = base + (size_t)(row0 + ai * HALF + m * 16) * ldc + col0;
#pragma unroll
                for (int bj = 0; bj < 2; ++bj) { f32x4 v0 = acc[ai][bj][m][0] + bv[bj][0], v1 = acc[ai][bj][m][1] + bv[bj][1];
                    if (ACT == 1) { f32x2 a = gelu_pk((f32x2){v0[0], v0[1]}), b = gelu_pk((f32x2){v0[2], v0[3]}), c = gelu_pk((f32x2){v1[0], v1[1]}), d = gelu_pk((f32x2){v1[2], v1[3]});
                        v0 = (f32x4){a.x, a.y, b.x, b.y}; v1 = (f32x4){c.x, c.y, d.x, d.y}; }
                    v0 = v0 * sc; v1 = v1 * sc; u32x4 w; w.x = cvt_pk_bf16(v0[0], v0[1]); w.y = cvt_pk_bf16(v0[2], v0[3]); w.z = cvt_pk_bf16(v1[0], v1[1]); w.w = cvt_pk_bf16(v1[2], v1[3]);
                    { bf16_t* sp_ = rowp + bj * HALF; asm volatile("global_store_dwordx4 %0, %1, off sc1\n\ts_nop 1" :: "v"(sp_), "v"(w) : "memory"); } } }
    }
};
struct EpiResidSplit {
    static constexpr bool PERM = false, AFTER_DRAIN = false;
    bf16_t* X; float* T; const float* mod; int goff; const float* cin;
    __device__ __forceinline__ void operator()(const f32x4 (&acc)[2][2][4][2], const Unit& u, int wr, int wc, int fr, int fq) const {
        typedef unsigned u32x2_t __attribute__((ext_vector_type(2)));
        const float* gp = mod + 8 * 6144 + goff;
        const int col0 = u.pn * BM + wc * 32 + 4 * fq;
        const bool first = (u.koff == 0);
        bf16_t* xb = X + (size_t)(u.pm * BM) * 1024; float* tb = T + (size_t)((u.pm / 9) * BM) * 1024;
        const float* rbase = cin ? cin + (size_t)((u.pm / 9) * BM) * 1024 : nullptr;
#pragma unroll
        for (int bj = 0; bj < 2; ++bj)
#pragma unroll
            for (int n = 0; n < 2; ++n) { const f32x4 gv = *(const f32x4*)(gp + col0 + bj * HALF + n * 16);
#pragma unroll
                for (int ai = 0; ai < 2; ++ai)
#pragma unroll
                    for (int m = 0; m < 4; ++m) { const size_t o = (size_t)(ai * HALF + wr * 64 + m * 16 + fr) * 1024 + col0 + bj * HALF + n * 16;
                        f32x4 v = gv * acc[ai][bj][m][n];
                        if (first) { f32x4 x;
                            if (rbase) x = *(const f32x4*)(rbase + o);
                            else { const u32x2_t w = *(const u32x2_t*)(xb + o); x = (f32x4){__uint_as_float(w.x << 16), __uint_as_float(w.x & 0xffff0000u), __uint_as_float(w.y << 16), __uint_as_float(w.y & 0xffff0000u)}; }
                            v = v + x; u32x2_t r; r.x = cvt_pk_bf16(v[0], v[1]); r.y = cvt_pk_bf16(v[2], v[3]); *(u32x2_t*)(xb + o) = r; }
                        else *(f32x4*)(tb + o) = v; } }
    }
};
struct EpiSwiGLU {
    static constexpr bool PERM = true, AFTER_DRAIN = false;
    bf16_t* O; int ldc;
    __device__ __forceinline__ void operator()(const f32x4 (&acc)[2][2][4][2], const Unit& u, int wr, int wc, int fr, int fq) const {
        const int row0 = u.pm * BM + wr * 64 + fr; const int col0 = u.pn * HALF + wc * 32 + 8 * fq;
#pragma unroll
        for (int ai = 0; ai < 2; ++ai)
#pragma unroll
            for (int m = 0; m < 4; ++m) { bf16_t* rowp = O + (size_t)(row0 + ai * HALF + m * 16) * ldc + col0;
                float h[8];
#pragma unroll
                for (int n = 0; n < 2; ++n)
#pragma unroll
                    for (int i = 0; i < 4; ++i) { const float g = acc[ai][0][m][n][i], up = acc[ai][1][m][n][i];
                        h[n * 4 + i] = g * __builtin_amdgcn_rcpf(1.0f + __expf(-g)) * up; }
                u32x4 w; w.x = cvt_pk_bf16(h[0], h[1]); w.y = cvt_pk_bf16(h[2], h[3]); w.z = cvt_pk_bf16(h[4], h[5]); w.w = cvt_pk_bf16(h[6], h[7]);
                asm volatile("global_store_dwordx4 %0, %1, off sc1\n\ts_nop 1" :: "v"(rowp), "v"(w) : "memory"); }
    }
};
struct EpiResid {
    static constexpr bool PERM = false, AFTER_DRAIN = false;
    bf16_t* X; const float* mod; int goff; const float* xin;
    __device__ __forceinline__ void operator()(const f32x4 (&acc)[2][2][4][2], const Unit& u, int wr, int wc, int fr, int fq) const {
        typedef unsigned u32x2_t __attribute__((ext_vector_type(2)));
        const int widx = (u.pm % 9 == 0) ? 8 : (u.pm / 9);
        const float* gp = mod + widx * 6144 + goff;
        const int col0 = u.pn * BM + wc * 32 + 4 * fq;
        const float* rb = xin ? xin + (size_t)((u.pm / 9) * 2048 + (u.pm % 9 - 1) * 256) * 1024 : nullptr;
        bf16_t* wb = X + (size_t)(u.pm * BM) * 1024;
#pragma unroll
        for (int bj = 0; bj < 2; ++bj)
#pragma unroll
            for (int n = 0; n < 2; ++n) { const f32x4 gv = *(const f32x4*)(gp + col0 + bj * HALF + n * 16);
#pragma unroll
                for (int ai = 0; ai < 2; ++ai)
#pragma unroll
                    for (int m = 0; m < 4; ++m) { const size_t o = (size_t)(ai * HALF + wr * 64 + m * 16 + fr) * 1024 + col0 + bj * HALF + n * 16;
                        f32x4 x;
                        if (rb) x = *(const f32x4*)(rb + o);
                        else { const u32x2_t w = *(const u32x2_t*)(wb + o); x = (f32x4){__uint_as_float(w.x << 16), __uint_as_float(w.x & 0xffff0000u), __uint_as_float(w.y << 16), __uint_as_float(w.y & 0xffff0000u)}; }
                        x = x + gv * acc[ai][bj][m][n];
                        u32x2_t r; r.x = cvt_pk_bf16(x[0], x[1]); r.y = cvt_pk_bf16(x[2], x[3]); *(u32x2_t*)(wb + o) = r; } }
    }
};
template <class Epi, class Sched, bool ALIGN_EPI = false, bool SP2 = false>
__device__ __forceinline__ void gemm_phase(PG8_LAS unsigned char* lds, const Gemm g, const Sched& S, const Epi& E) {
    const int tid = otid(), wid = __builtin_amdgcn_readfirstlane(tid >> 6), lane = tid & 63, wr = wid >> 2, wc = wid & 3, fr = lane & 15, fq = lane >> 4;
    const int K = g.ld, nt = g.K / BK;
    unsigned voffA[2], voffB[2];
#pragma unroll
    for (int i = 0; i < 2; ++i) { int R, C; stage_rc(tid * 16 + i * 8192, R, C); const int Rb = Epi::PERM ? ((R & ~31) + perm32(R & 31)) : R;
        voffA[i] = (unsigned)(R * K + C) * 2u; voffB[i] = (unsigned)(Rb * K + C) * 2u; }
    const size_t kstep = (size_t)(BK * 2);
    const size_t hstep = (size_t)HALF * K * 2;
    const size_t tstep = 2 * hstep;
    const unsigned ldsw = (unsigned)wid * 1024u;
    const int aoff = lds_byte(wr * 64 + fr, fq * 8), boff = lds_byte(wc * 32 + fr, fq * 8);
#define PG8_SA(b, h) (((b) * 2 + (h)) * HTB)
#define PG8_SB(b, h) ((4 + (b) * 2 + (h)) * HTB)
#define PG8_STAGE(bufoff, gbase, voff) do { _Pragma("unroll") for (int _i = 0; _i < 2; ++_i) \
        __builtin_amdgcn_global_load_lds((const unsigned*)((const char*)(gbase) + (voff)[_i]), (PG8_LAS unsigned*)(lds + (bufoff) + ldsw + _i * 8192), 16, 0, 0); } while (0)
#define PG8_LDA(dst, b, h) do { _Pragma("unroll") for (int m = 0; m < 4; ++m) _Pragma("unroll") for (int k = 0; k < 2; ++k) dst[m][k] = *(const PG8_LAS bf16x8*)(lds + PG8_SA(b, h) + aoff + m * 2048 + k * 1024); } while (0)
#define PG8_LDB(dst, b, h) do { _Pragma("unroll") for (int n = 0; n < 2; ++n) _Pragma("unroll") for (int k = 0; k < 2; ++k) dst[n][k] = *(const PG8_LAS bf16x8*)(lds + PG8_SB(b, h) + boff + n * 2048 + k * 1024); } while (0)
#define PG8_MMA(ai, bj, At, Bt) do { __builtin_amdgcn_s_setprio(1); _Pragma("unroll") for (int m = 0; m < 4; ++m) _Pragma("unroll") for (int n = 0; n < 2; ++n) _Pragma("unroll") for (int k = 0; k < 2; ++k) \
        acc[ai][bj][m][n] = __builtin_amdgcn_mfma_f32_16x16x32_bf16(Bt[n][k], At[m][k], acc[ai][bj][m][n], 0, 0, 0); __builtin_amdgcn_s_setprio(0); } while (0)
#define PG8_WAIT_V(n) asm volatile("s_waitcnt vmcnt(" #n ")" ::: "memory")
#define PG8_WAIT_L(n) asm volatile("s_waitcnt lgkmcnt(" #n ")" ::: "memory")
#define PG8_BAR __builtin_amdgcn_s_barrier()
#define PG8_SCHED __builtin_amdgcn_sched_barrier(0)
    Unit cur, nxt; int ui = 0;
    if (!S.next(0, cur)) return;
    f32x4 acc[2][2][4][2];
#pragma unroll
    for (int a = 0; a < 2; ++a)
#pragma unroll
        for (int b = 0; b < 2; ++b)
#pragma unroll
            for (int m = 0; m < 4; ++m)
#pragma unroll
                for (int n = 0; n < 2; ++n) acc[a][b][m][n] = (f32x4){0.f, 0.f, 0.f, 0.f};
    bf16x8 At[4][2], B0[2][2], B1[2][2];
    const char* cA = (const char*)g.A + (size_t)cur.pm * tstep + (size_t)cur.koff * 2; const char* cB = (const char*)g.Bt + (size_t)cur.pn * tstep + (size_t)cur.koff * 2;
    S.a_ready(cur);
    if constexpr (SP2) {
        PG8_STAGE(PG8_SB(0, 0), cB, voffB); PG8_STAGE(PG8_SB(0, 1), cB + hstep, voffB); PG8_STAGE(PG8_SA(0, 0), cA, voffA); PG8_STAGE(PG8_SA(0, 1), cA + hstep, voffA);
        if (wr == 1) PG8_BAR;
        PG8_WAIT_V(2); PG8_BAR;
        PG8_STAGE(PG8_SB(1, 0), cB + kstep, voffB); PG8_STAGE(PG8_SA(1, 0), cA + kstep, voffA); PG8_STAGE(PG8_SB(1, 1), cB + hstep + kstep, voffB);
        PG8_WAIT_V(6); PG8_BAR;
    } else {
        PG8_STAGE(PG8_SB(0, 0), cB, voffB); PG8_STAGE(PG8_SA(0, 0), cA, voffA); PG8_STAGE(PG8_SB(0, 1), cB + hstep, voffB); PG8_STAGE(PG8_SA(0, 1), cA + hstep, voffA);
        if (wr == 1) PG8_BAR;
        PG8_WAIT_V(4); PG8_BAR;
        PG8_STAGE(PG8_SB(1, 0), cB + kstep, voffB); PG8_STAGE(PG8_SA(1, 0), cA + kstep, voffA); PG8_STAGE(PG8_SB(1, 1), cB + hstep + kstep, voffB);
        PG8_WAIT_V(6); PG8_BAR;
    }
    for (;;) {
        const bool has_next = S.next(ui + 1, nxt);
        const char* nA = has_next ? (const char*)g.A + (size_t)nxt.pm * tstep + (size_t)nxt.koff * 2 : cA; const char* nB = has_next ? (const char*)g.Bt + (size_t)nxt.pn * tstep + (size_t)nxt.koff * 2 : cB;
        for (int t = 0; t < nt; t += 2) {
            const bool last = (t == nt - 2);
            const char* a1 = cA + (size_t)(t + 1) * kstep;
            const char* a2 = last ? nA : cA + (size_t)(t + 2) * kstep; const char* b2 = last ? nB : cB + (size_t)(t + 2) * kstep;
            const char* a3 = a2 + kstep; const char* b3 = b2 + kstep;
            if (last && has_next) S.a_ready(nxt);
            if constexpr (SP2) {
            PG8_LDB(B0, 0, 0); PG8_LDB(B1, 0, 1); PG8_SCHED; PG8_LDA(At, 0, 0); PG8_STAGE(PG8_SA(1, 1), a1 + hstep, voffA);
            PG8_WAIT_V(8); PG8_WAIT_L(0); PG8_BAR; PG8_MMA(0, 0, At, B0); PG8_MMA(0, 1, At, B1); PG8_BAR; PG8_SCHED;
            PG8_LDA(At, 0, 1); PG8_STAGE(PG8_SB(0, 0), b2, voffB); PG8_STAGE(PG8_SB(0, 1), b2 + hstep, voffB); PG8_STAGE(PG8_SA(0, 0), a2, voffA);
            PG8_WAIT_V(8); PG8_WAIT_L(0); PG8_BAR; PG8_MMA(1, 0, At, B0); PG8_MMA(1, 1, At, B1); PG8_BAR; PG8_SCHED;
            PG8_LDB(B0, 1, 0); PG8_LDB(B1, 1, 1); PG8_SCHED; PG8_LDA(At, 1, 0); PG8_STAGE(PG8_SA(0, 1), a2 + hstep, voffA);
            PG8_WAIT_V(8); PG8_WAIT_L(0); PG8_BAR; PG8_MMA(0, 0, At, B0); PG8_MMA(0, 1, At, B1); PG8_BAR; PG8_SCHED;
            PG8_LDA(At, 1, 1); PG8_STAGE(PG8_SB(1, 0), b3, voffB); PG8_STAGE(PG8_SB(1, 1), b3 + hstep, voffB); PG8_STAGE(PG8_SA(1, 0), a3, voffA);
            PG8_WAIT_V(8); PG8_WAIT_L(0); PG8_BAR; PG8_MMA(1, 0, At, B0); PG8_MMA(1, 1, At, B1); PG8_BAR; PG8_SCHED;
            } else {
            PG8_LDB(B0, 0, 0); PG8_SCHED; PG8_LDA(At, 0, 0); PG8_STAGE(PG8_SA(1, 1), a1 + hstep, voffA);
            PG8_WAIT_L(8); PG8_BAR; PG8_WAIT_L(0); PG8_MMA(0, 0, At, B0); PG8_BAR; PG8_SCHED;
            PG8_LDB(B1, 0, 1); PG8_STAGE(PG8_SB(0, 0), b2, voffB);
            PG8_BAR; PG8_WAIT_L(0); PG8_MMA(0, 1, At, B1); PG8_BAR;
            PG8_LDA(At, 0, 1); PG8_STAGE(PG8_SA(0, 0), a2, voffA);
            PG8_BAR; PG8_WAIT_L(0); PG8_MMA(1, 0, At, B0); PG8_BAR; PG8_SCHED;
            PG8_STAGE(PG8_SB(0, 1), b2 + hstep, voffB);
            PG8_WAIT_V(6); PG8_BAR; PG8_MMA(1, 1, At, B1); PG8_BAR;
            PG8_LDB(B0, 1, 0); PG8_SCHED; PG8_LDA(At, 1, 0); PG8_STAGE(PG8_SA(0, 1), a2 + hstep, voffA);
            PG8_WAIT_L(8); PG8_BAR; PG8_WAIT_L(0); PG8_MMA(0, 0, At, B0); PG8_BAR; PG8_SCHED;
            PG8_LDB(B1, 1, 1); PG8_STAGE(PG8_SB(1, 0), b3, voffB);
            PG8_BAR; PG8_WAIT_L(0); PG8_MMA(0, 1, At, B1); PG8_BAR;
            PG8_LDA(At, 1, 1); PG8_STAGE(PG8_SA(1, 0), a3, voffA);
            PG8_BAR; PG8_WAIT_L(0); PG8_MMA(1, 0, At, B0); PG8_BAR; PG8_SCHED;
            PG8_STAGE(PG8_SB(1, 1), b3 + hstep, voffB);
            PG8_WAIT_V(6); PG8_BAR; PG8_MMA(1, 1, At, B1); PG8_BAR;
            }
        }
        if constexpr (ALIGN_EPI) { if (wr == 0) PG8_BAR; }
        if constexpr (!Epi::AFTER_DRAIN) { E(acc, cur, wr, wc, fr, fq); S.done(cur); }
        if (!has_next) break;
#pragma unroll
        for (int a = 0; a < 2; ++a)
#pragma unroll
            for (int b = 0; b < 2; ++b)
#pragma unroll
                for (int m = 0; m < 4; ++m)
#pragma unroll
                    for (int n = 0; n < 2; ++n) acc[a][b][m][n] = (f32x4){0.f, 0.f, 0.f, 0.f};
        cur = nxt; cA = nA; cB = nB; ++ui;
        if constexpr (ALIGN_EPI) { if (wr == 1) PG8_BAR; }
    }
    PG8_WAIT_V(0);
    if constexpr (!ALIGN_EPI) { if (wr == 0) PG8_BAR; }
    PG8_BAR;
    if constexpr (Epi::AFTER_DRAIN) { E.fused(acc, cur, wr, wc, fr, fq, lds, wid, lane); S.done(cur); }
#undef PG8_SA
#undef PG8_SB
#undef PG8_STAGE
#undef PG8_LDA
#undef PG8_LDB
#undef PG8_MMA
#undef PG8_WAIT_V
#undef PG8_WAIT_L
#undef PG8_BAR
#undef PG8_SCHED
}
}

typedef unsigned short bf16;
typedef short bf16x8 __attribute__((ext_vector_type(8)));
typedef short s16x4 __attribute__((ext_vector_type(4)));
typedef float f32x4 __attribute__((ext_vector_type(4)));
typedef float f32x16 __attribute__((ext_vector_type(16)));
typedef unsigned u32x4 __attribute__((ext_vector_type(4)));
typedef unsigned u32x2 __attribute__((ext_vector_type(2)));
#define LAS __attribute__((address_space(3)))

constexpr int NB = 8, TPB = 2304, MT = NB * TPB, DM = 1024, NLAT = 2048;
constexpr int NP_E = 3328, NP_O = 3072, FF = 2816;
constexpr float EPSN = 1e-6f;
constexpr size_t MiB = 1u << 20;
constexpr size_t WS_CTL = 0, WS_MOD = 1 * MiB, WS_X = 2 * MiB, WS_H = 74 * MiB, WS_MIX = 110 * MiB, WS_P = 146 * MiB, WS_W = 263 * MiB,
                 WS_OSC = 290 * MiB, WS_KR = 326 * MiB, WS_U = 328 * MiB, WS_T = 342 * MiB, WS_END = 350 * MiB;
constexpr size_t WS_LSUM = 128 * 1024;
constexpr size_t WS_CQN = WS_MIX, WS_CKVN = WS_MIX + 14 * MiB, WS_DSCR = WS_H;
constexpr size_t W_IN = 0, W_OUT = 13 * MiB / 2, W_GU = 17 * MiB / 2, W_DN = 39 * MiB / 2, W_UQ = 25 * MiB, W_UKV = 25 * MiB + 768 * 1024;
constexpr size_t OUT_KV = 0, OUT_Q = 36 * MiB;
constexpr int LDS_MAIN = 131072, LDS_BYTES = LDS_MAIN + 1024 + 2048;

struct Args { const float* in[23]; float* out; unsigned char* ws; int lo, hi; };
typedef __attribute__((address_space(4))) const Args* KArgP;
__device__ __forceinline__ KArgP kargs() { KArgP p = (KArgP)__builtin_amdgcn_kernarg_segment_ptr(); asm volatile("" : "+s"(p)); return p; }

__device__ __forceinline__ float bf2f(unsigned short h) { return __uint_as_float((unsigned)h << 16); }
__device__ __forceinline__ unsigned f2bf(float f) { unsigned u = __float_as_uint(f); return (u + 0x7fffu + ((u >> 16) & 1u)) >> 16; }
__device__ __forceinline__ unsigned pk2(float lo, float hi) { return f2bf(lo) | (f2bf(hi) << 16); }
__device__ __forceinline__ float wave_sum(float v) {
#pragma unroll
    for (int o = 1; o < 64; o <<= 1) v += __shfl_xor(v, o);
    return v;
}
__device__ __forceinline__ float silu_f(float g) { return g / (1.0f + __expf(-g)); }
__device__ __forceinline__ void sincos_r(float ang, float& s, float& c) {
    float r = ang * 0.15915494309189535f; r = r - __builtin_floorf(r);
    s = __builtin_amdgcn_sinf(r); c = __builtin_amdgcn_cosf(r);
}
__device__ __forceinline__ float inv_freq(int i, int half) { return __builtin_amdgcn_exp2f(-(float)i / (float)half * 13.287712379549449f); }

__device__ __forceinline__ void mod_item(KArgP a, int l, int cg, LAS unsigned char* lds) {
    const int tid = otid();
    float* MOD = (float*)(a->ws + WS_MOD);
    LAS float* S = (LAS float*)lds;
    LAS float* R = S + 1024 * 12;
    for (int i = tid; i < 9 * 1024; i += 512) { const int w = i >> 10, k = i & 1023; const float v = (w < 8) ? a->in[1][w * 1024 + k] : a->in[3][k]; S[k * 12 + w] = silu_f(v); }
    __syncthreads();
    const int nl = tid & 63, kp = tid >> 6, n0 = cg * 256;
    f32x4 acc[9];
#pragma unroll
    for (int w = 0; w < 9; ++w) acc[w] = (f32x4){0.f, 0.f, 0.f, 0.f};
    const float* wp = a->in[4] + (size_t)l * 1024 * 6144 + n0 + 4 * nl;
#pragma unroll 8
    for (int k = kp * 128; k < kp * 128 + 128; ++k) {
        const f32x4 wv = *(const f32x4*)(wp + (size_t)k * 6144);
        const f32x4 s0 = *(const LAS f32x4*)(S + k * 12), s1 = *(const LAS f32x4*)(S + k * 12 + 4); const float s8 = S[k * 12 + 8];
        acc[0] += wv * s0[0]; acc[1] += wv * s0[1]; acc[2] += wv * s0[2]; acc[3] += wv * s0[3];
        acc[4] += wv * s1[0]; acc[5] += wv * s1[1]; acc[6] += wv * s1[2]; acc[7] += wv * s1[3]; acc[8] += wv * s8;
    }
#pragma unroll
    for (int w = 0; w < 9; ++w) *(LAS f32x4*)(R + (kp * 9 + w) * 256 + 4 * nl) = acc[w];
    __syncthreads();
    for (int i = tid; i < 9 * 256; i += 512) { const int w = i >> 8, n2 = i & 255; float v = a->in[5][l * 6144 + n0 + n2];
#pragma unroll
        for (int p = 0; p < 8; ++p) v += R[(p * 9 + w) * 256 + n2];
        MOD[(size_t)(l * 9 + w) * 6144 + n0 + n2] = v; }
    __syncthreads();
}
__device__ __forceinline__ void convert_weights(KArgP a, int layer, LAS unsigned char* lds, int part, int gw, int NGW);
__device__ __forceinline__ void phase_prep(KArgP a, LAS unsigned char* lds) {
    const int tid = otid(), G = gridDim.x;
    if (blockIdx.x == 0) { if (tid < 64) ((unsigned*)(a->ws + WS_CTL))[tid] = 0u; for (int i = tid; i < 3456; i += 512) ((unsigned*)(a->ws + WS_CTL))[4096 + i] = 0u; }
    for (int item = blockIdx.x; item < 96; item += G) mod_item(a, item / 24, item % 24, lds);
    if ((int)blockIdx.x >= 96 && G > 96) {
        convert_weights(a, 0, lds, 0, ((int)blockIdx.x - 96) * 8 + (otid() >> 6), (G - 96) * 8); convert_weights(a, 0, lds, 1, ((int)blockIdx.x - 96) * 8 + (otid() >> 6), (G - 96) * 8); }
}

__device__ __forceinline__ void transpose_item(const float* W, int K, int N, bf16* WT, int k0, int n0, int drow0, LAS float* scr, int lane) {
    float tv_[32];
#pragma unroll
    for (int i = 0; i < 32; ++i) { const int kk = 2 * i + (lane >> 5); tv_[i] = W[(size_t)(k0 + kk) * N + n0 + (lane & 31)]; }
#pragma unroll
    for (int i = 0; i < 32; ++i) { const int kk = 2 * i + (lane >> 5); scr[kk * 33 + (lane & 31)] = tv_[i]; }
    asm volatile("s_waitcnt lgkmcnt(0)" ::: "memory");
    const int c = lane & 7;
#pragma unroll
    for (int j = 0; j < 4; ++j) { const int n = (lane >> 3) + 8 * j; const LAS float* s = scr + (8 * c) * 33 + n;
        u32x4 o; o.x = pk2(s[0 * 33], s[1 * 33]); o.y = pk2(s[2 * 33], s[3 * 33]); o.z = pk2(s[4 * 33], s[5 * 33]); o.w = pk2(s[6 * 33], s[7 * 33]);
        *(u32x4*)(WT + (size_t)(drow0 + n) * K + k0 + 8 * c) = o; }
    asm volatile("s_waitcnt lgkmcnt(0)" ::: "memory");
}
__device__ __forceinline__ void convert_weights(KArgP a, int layer, LAS unsigned char* lds, int part, int gw, int NGW) {
    const int lane = otid() & 63, wave = otid() >> 6;
    LAS float* scr = (LAS float*)(lds + wave * 8448);
    const bool even = !(layer & 1); const int e = layer >> 1;
    unsigned char* Wb = a->ws + WS_W;
    if (part == 0) {
        const int nin = even ? 3232 : 3072;
        const float* w_in = even ? a->in[11] + (size_t)e * 1024 * 3232 : a->in[18] + (size_t)e * 1024 * 3072;
        const int nbin = nin / 32;
        const int I_IN = 16 * nbin, I_OUT = 512, I_UQ = even ? 6 * 24 : 0, I_UKV = even ? 4 * 32 : 0;
        const int NIT = I_IN + I_OUT + I_UQ + I_UKV;
        for (int it = gw; it < NIT; it += NGW) {
            int r = it;
            if (r < I_IN) { const int kb = r / nbin, nb = r % nbin; transpose_item(w_in, 1024, nin, (bf16*)(Wb + W_IN), 64 * kb, 32 * nb, 32 * nb, scr, lane); continue; } r -= I_IN;
            if (r < I_OUT) { const int kb = r / 32, nb = r % 32; transpose_item(a->in[7] + (size_t)layer * 1024 * 1024, 1024, 1024, (bf16*)(Wb + W_OUT), 64 * kb, 32 * nb, 32 * nb, scr, lane); continue; } r -= I_OUT;
            if (r < I_UQ) { const int kb = r / 24, nb = r % 24; transpose_item(a->in[15] + (size_t)e * 384 * 768, 384, 768, (bf16*)(Wb + W_UQ), 64 * kb, 32 * nb, 32 * nb, scr, lane); continue; } r -= I_UQ;
            { const int kb = r / 32, nb = r % 32; transpose_item(a->in[17] + (size_t)e * 256 * 1024, 256, 1024, (bf16*)(Wb + W_UKV), 64 * kb, 32 * nb, 32 * nb, scr, lane); }
        }
    } else {
        constexpr int I_G = 16 * 88, I_D = 44 * 32;
        for (int it = gw; it < 2 * I_G + I_D; it += NGW) {
            int r = it;
            if (r < I_G) { const int kb = r / 88, nb = r % 88, n0 = 32 * nb; transpose_item(a->in[8] + (size_t)layer * 1024 * FF, 1024, FF, (bf16*)(Wb + W_GU), 64 * kb, n0, (n0 >> 7) * 256 + (n0 & 127), scr, lane); continue; } r -= I_G;
            if (r < I_G) { const int kb = r / 88, nb = r % 88, n0 = 32 * nb; transpose_item(a->in[9] + (size_t)layer * 1024 * FF, 1024, FF, (bf16*)(Wb + W_GU), 64 * kb, n0, (n0 >> 7) * 256 + 128 + (n0 & 127), scr, lane); continue; } r -= I_G;
            { const int kb = r / 32, nb = r % 32; transpose_item(a->in[10] + (size_t)layer * FF * 1024, FF, 1024, (bf16*)(Wb + W_DN), 64 * kb, 32 * nb, 32 * nb, scr, lane); }
        }
    }
}

__device__ __forceinline__ f32x4 ld4_bf16(const bf16* p) { const u32x2 w = *(const u32x2*)p; return (f32x4){__uint_as_float(w.x << 16), __uint_as_float(w.x & 0xffff0000u), __uint_as_float(w.y << 16), __uint_as_float(w.y & 0xffff0000u)}; }
__device__ __forceinline__ void phase_norm(KArgP a, int layer, int which, bool addT) {
    const int lane = otid() & 63, wave = otid() >> 6;
    const int gw = blockIdx.x * 8 + wave, NGW = gridDim.x * 8;
    bf16* X = (bf16*)(a->ws + WS_X); bf16* H = (bf16*)(a->ws + WS_H); const float* T = (const float*)(a->ws + WS_T);
    const float* g = a->in[6] + (layer * 2 + which) * 1024;
    const float* mod = (const float*)(a->ws + WS_MOD) + (size_t)layer * 9 * 6144;
    const int shoff = which ? 3072 : 0, scoff = which ? 4096 : 1024;
    const bool from_inputs = (layer == 0 && which == 0);
    constexpr int RB = 3;
    for (int r0 = gw; r0 < MT; r0 += RB * NGW) {
        f32x4 v[RB][4];
#pragma unroll
        for (int k = 0; k < RB; ++k) { const int row = r0 + k * NGW; if (row < MT) {
            if (from_inputs) { const int b = row / TPB, j = row - b * TPB; const float* xr = (j < 256 ? a->in[2] + (size_t)(b * 256 + j) * 1024 : a->in[0] + (size_t)(b * NLAT + j - 256) * 1024) + 8 * lane;
#pragma unroll
                for (int q = 0; q < 2; ++q) { v[k][2 * q] = *(const f32x4*)(xr + 512 * q); v[k][2 * q + 1] = *(const f32x4*)(xr + 512 * q + 4); } }
            else {
#pragma unroll
                for (int q = 0; q < 2; ++q) { const u32x4 w = *(const u32x4*)(X + (size_t)row * 1024 + 8 * lane + 512 * q);
                    v[k][2 * q] = (f32x4){__uint_as_float(w.x << 16), __uint_as_float(w.x & 0xffff0000u), __uint_as_float(w.y << 16), __uint_as_float(w.y & 0xffff0000u)};
                    v[k][2 * q + 1] = (f32x4){__uint_as_float(w.z << 16), __uint_as_float(w.z & 0xffff0000u), __uint_as_float(w.w << 16), __uint_as_float(w.w & 0xffff0000u)}; } } } }
#pragma unroll
        for (int k = 0; k < RB; ++k) { const int row = r0 + k * NGW; if (row < MT) {
            const int b = row / TPB, j = row - b * TPB, widx = (j < 256) ? 8 : b;
            if (addT && j < 256) { const float* tr = T + (size_t)(b * 256 + j) * 1024 + 8 * lane;
#pragma unroll
                for (int q = 0; q < 2; ++q) { v[k][2 * q] = v[k][2 * q] + *(const f32x4*)(tr + 512 * q); v[k][2 * q + 1] = v[k][2 * q + 1] + *(const f32x4*)(tr + 512 * q + 4);
                    u32x4 w; w.x = pk2(v[k][2 * q][0], v[k][2 * q][1]); w.y = pk2(v[k][2 * q][2], v[k][2 * q][3]); w.z = pk2(v[k][2 * q + 1][0], v[k][2 * q + 1][1]); w.w = pk2(v[k][2 * q + 1][2], v[k][2 * q + 1][3]);
                    *(u32x4*)(X + (size_t)row * 1024 + 8 * lane + 512 * q) = w; } }
            float ss = 0.f;
#pragma unroll
            for (int q = 0; q < 4; ++q) ss += (v[k][q][0] * v[k][q][0] + v[k][q][1] * v[k][q][1]) + (v[k][q][2] * v[k][q][2] + v[k][q][3] * v[k][q][3]);
            const float rstd = __builtin_amdgcn_rsqf(wave_sum(ss) * (1.f / 1024.f) + EPSN);
#pragma unroll
            for (int q = 0; q < 2; ++q) { const int col = 8 * lane + 512 * q; f32x4 y[2];
#pragma unroll
                for (int hh = 0; hh < 2; ++hh) { const f32x4 gv = *(const f32x4*)(g + col + 4 * hh), sc = *(const f32x4*)(mod + widx * 6144 + scoff + col + 4 * hh), sh = *(const f32x4*)(mod + widx * 6144 + shoff + col + 4 * hh);
                    y[hh] = v[k][2 * q + hh] * rstd * gv * (sc + 1.0f) + sh; }
                u32x4 w; w.x = pk2(y[0][0], y[0][1]); w.y = pk2(y[0][2], y[0][3]); w.z = pk2(y[1][0], y[1][1]); w.w = pk2(y[1][2], y[1][3]);
                { bf16* sp_ = H + (size_t)row * 1024 + col; asm volatile("global_store_dwordx4 %0, %1, off sc1\n\ts_nop 1" :: "v"(sp_), "v"(w) : "memory"); } } } }
    }
}

__device__ __forceinline__ void phase_post_even(KArgP a, int layer) {
    const int lane = otid() & 63, wave = otid() >> 6;
    const int gw = blockIdx.x * 8 + wave, NGW = gridDim.x * 8, e = layer >> 1;
    const bf16* P = (const bf16*)(a->ws + WS_P); bf16* CQN = (bf16*)(a->ws + WS_CQN); bf16* CKVN = (bf16*)(a->ws + WS_CKVN); bf16* KR = (bf16*)(a->ws + WS_KR);
    const float* qg = a->in[14] + e * 384; const float* kg = a->in[16] + e * 256;
    for (int row = gw; row < MT; row += NGW) {
        const int b = row / TPB, j = row - b * TPB;
        const bf16* pr = P + (size_t)row * NP_E;
        {   float x[6]; float ss = 0.f;
#pragma unroll
            for (int k = 0; k < 3; ++k) { const unsigned w = *(const unsigned*)(pr + 2560 + 2 * lane + 128 * k); x[2 * k] = bf2f((unsigned short)(w & 0xffff)); x[2 * k + 1] = bf2f((unsigned short)(w >> 16)); ss += x[2 * k] * x[2 * k] + x[2 * k + 1] * x[2 * k + 1]; }
            const float rstd = __builtin_amdgcn_rsqf(wave_sum(ss) * (1.f / 384.f) + EPSN);
#pragma unroll
            for (int k = 0; k < 3; ++k) { const int col = 2 * lane + 128 * k; *(unsigned*)(CQN + (size_t)row * 384 + col) = pk2(x[2 * k] * rstd * qg[col], x[2 * k + 1] * rstd * qg[col + 1]); } }
        {   float x[4]; float ss = 0.f;
#pragma unroll
            for (int k = 0; k < 2; ++k) { const unsigned w = *(const unsigned*)(pr + 2944 + 2 * lane + 128 * k); x[2 * k] = bf2f((unsigned short)(w & 0xffff)); x[2 * k + 1] = bf2f((unsigned short)(w >> 16)); ss += x[2 * k] * x[2 * k] + x[2 * k + 1] * x[2 * k + 1]; }
            const float rstd = __builtin_amdgcn_rsqf(wave_sum(ss) * (1.f / 256.f) + EPSN);
#pragma unroll
            for (int k = 0; k < 2; ++k) { const int col = 2 * lane + 128 * k; *(unsigned*)(CKVN + (size_t)row * 256 + col) = pk2(x[2 * k] * rstd * kg[col], x[2 * k + 1] * rstd * kg[col + 1]); } }
        {   const int d = lane & 31; const float x = bf2f(pr[3200 + d]); const float xp = __shfl_xor(x, 8);
            float o = x;
            if (j >= 256) { const int t = j - 256, blk = d >> 4, wi = d & 15, i8 = wi & 7; const float pos = (float)(blk ? (t & 63) : (t >> 6));
                float s, c; sincos_r(pos * inv_freq(i8, 8), s, c);
                o = (wi < 8) ? (x * c - xp * s) : (xp * s + x * c); }
            if (lane < 32) KR[(size_t)row * 32 + d] = (bf16)f2bf(o); }
    }
}
__device__ __forceinline__ void phase_post_odd(KArgP a, int layer) {
    const int lane = otid() & 63, wave = otid() >> 6;
    const int gw = blockIdx.x * 8 + wave, NGW = gridDim.x * 8;
    bf16* P = (bf16*)(a->ws + WS_P);
    for (int row = gw; row < MT; row += NGW) {
        const int b = row / TPB, j = row - b * TPB; const bool lat = j >= 256; const int t = j - 256;
        bf16* pr = P + (size_t)row * NP_O;
#pragma unroll
        for (int u = 0; u < 2; ++u) { const int pid = lane + 64 * u, h = pid >> 5, i = pid & 31, d1 = h * 64 + i, d2 = d1 + 32;
            float s = 0.f, c = 1.f; if (lat) sincos_r((float)t * inv_freq(i, 32), s, c);
            const float q1 = bf2f(pr[d1]), q2 = bf2f(pr[d2]), k1 = bf2f(pr[256 + d1]) * 0.125f, k2 = bf2f(pr[256 + d2]) * 0.125f;
            if (lat) { pr[d1] = (bf16)f2bf(q1 * c - q2 * s); pr[d2] = (bf16)f2bf(q1 * s + q2 * c); }
            pr[256 + d1] = (bf16)f2bf(k1 * c - k2 * s); pr[256 + d2] = (bf16)f2bf(k1 * s + k2 * c); }
        if (lat) {
#pragma unroll
            for (int u = 0; u < 4; ++u) { const int pid = lane + 64 * u, vec = pid >> 5, pp = pid & 31, blk = pp >> 4, i = pp & 15, d1 = vec * 64 + blk * 32 + i, d2 = d1 + 16;
                const float pos = (float)(blk ? (t & 63) : (t >> 6)); float s, c; sincos_r(pos * inv_freq(i, 16), s, c);
                const float q1 = bf2f(pr[1536 + d1]), q2 = bf2f(pr[1536 + d2]), k1 = bf2f(pr[2048 + d1]), k2 = bf2f(pr[2048 + d2]);
                pr[1536 + d1] = (bf16)f2bf(q1 * c - q2 * s); pr[1536 + d2] = (bf16)f2bf(q1 * s + q2 * c);
                pr[2048 + d1] = (bf16)f2bf(k1 * c - k2 * s); pr[2048 + d2] = (bf16)f2bf(k1 * s + k2 * c); } }
    }
}

__device__ __forceinline__ void phase_readout(KArgP a, int layer) {
    const int lane = otid() & 63, wave = otid() >> 6;
    const int gw = blockIdx.x * 8 + wave, NGW = gridDim.x * 8;
    const bool even = !(layer & 1); const int np = even ? NP_E : NP_O, gcol = even ? 2048 : 1024;
    const bf16* P = (const bf16*)(a->ws + WS_P); const bf16* OF = (const bf16*)(a->ws + WS_OSC); const bf16* OB = OF + (size_t)MT * 512;
    bf16* MIX = (bf16*)(a->ws + WS_MIX);
    float g0 = 1.f, g1 = 1.f; if (even) { g0 = a->in[13][(layer >> 1) * 128 + 2 * lane]; g1 = a->in[13][(layer >> 1) * 128 + 2 * lane + 1]; }
    constexpr int RB = 3;
    for (int r0 = gw; r0 < MT; r0 += RB * NGW) {
        unsigned wf[RB][4], wb[RB][4], wg[RB][4];
#pragma unroll
        for (int k = 0; k < RB; ++k) { const int row = r0 + k * NGW; if (row < MT) {
#pragma unroll
            for (int h = 0; h < 4; ++h) { const int col = h * 128 + 2 * lane;
                wf[k][h] = *(const unsigned*)(OF + (size_t)row * 512 + col); wb[k][h] = *(const unsigned*)(OB + (size_t)row * 512 + col); wg[k][h] = *(const unsigned*)(P + (size_t)row * np + gcol + col); } } }
#pragma unroll
        for (int k = 0; k < RB; ++k) { const int row = r0 + k * NGW; if (row < MT) {
#pragma unroll
            for (int h = 0; h < 4; ++h) { const int col = h * 128 + 2 * lane;
                const float o0 = bf2f((unsigned short)(wf[k][h] & 0xffff)) + bf2f((unsigned short)(wb[k][h] & 0xffff)), o1 = bf2f((unsigned short)(wf[k][h] >> 16)) + bf2f((unsigned short)(wb[k][h] >> 16));
                const float rstd = __builtin_amdgcn_rsqf(wave_sum(o0 * o0 + o1 * o1) * (1.f / 128.f) + EPSN);
                const float y0 = o0 * rstd * g0 * silu_f(bf2f((unsigned short)(wg[k][h] & 0xffff))), y1 = o1 * rstd * g1 * silu_f(bf2f((unsigned short)(wg[k][h] >> 16)));
                *(unsigned*)(MIX + (size_t)row * 1024 + col) = pk2(y0, y1); } } }
    }
}
__device__ __forceinline__ void phase_final(KArgP a) {
    const int lane = otid() & 63, wave = otid() >> 6;
    const int gw = blockIdx.x * 8 + wave, NGW = gridDim.x * 8;
    const bf16* X = (const bf16*)(a->ws + WS_X); const float* g = a->in[22];
    constexpr int RB = 4;
    for (int r0 = gw; r0 < NB * NLAT; r0 += RB * NGW) {
        f32x4 v[RB][4];
#pragma unroll
        for (int k = 0; k < RB; ++k) { const int r = r0 + k * NGW; if (r < NB * NLAT) { const int row = (r >> 11) * TPB + 256 + (r & 2047);
#pragma unroll
            for (int q = 0; q < 4; ++q) v[k][q] = ld4_bf16(X + (size_t)row * 1024 + 4 * lane + 256 * q); } }
#pragma unroll
        for (int k = 0; k < RB; ++k) { const int r = r0 + k * NGW; if (r < NB * NLAT) { float ss = 0.f;
#pragma unroll
            for (int q = 0; q < 4; ++q) ss += (v[k][q][0] * v[k][q][0] + v[k][q][1] * v[k][q][1]) + (v[k][q][2] * v[k][q][2] + v[k][q][3] * v[k][q][3]);
            const float rstd = __builtin_amdgcn_rsqf(wave_sum(ss) * (1.f / 1024.f) + EPSN);
#pragma unroll
            for (int q = 0; q < 4; ++q) { const int col = 4 * lane + 256 * q; const f32x4 gv = *(const f32x4*)(g + col);
                *(f32x4*)(a->out + (size_t)r * 1024 + col) = v[k][q] * rstd * gv; } } }
    }
}
__device__ __forceinline__ unsigned cvtpk2(float lo, float hi) { unsigned r; asm("v_cvt_pk_bf16_f32 %0, %1, %2" : "=v"(r) : "v"(lo), "v"(hi)); return r; }
__device__ __forceinline__ f32x4 mfma16(bf16x8 a, bf16x8 b, f32x4 c) { return __builtin_amdgcn_mfma_f32_16x16x32_bf16(a, b, c, 0, 0, 0); }

template <int DK, bool HG, int MODE>
__device__ __forceinline__ void scan_item(KArgP a, int layer, int item, int seg, LAS unsigned char* lds) {
    const int tid = otid(), wid = tid >> 6, lane = tid & 63, l15 = lane & 15, q4 = lane >> 4;
    const int h = item & 3, dir = (item >> 2) & 1, b = item >> 3;
    constexpr int TPT = DK / 8, QS = DK * 2 + 16, TS = 144;
    constexpr int NP = HG ? NP_E : NP_O;
    LAS unsigned char* Lqt = lds; LAS unsigned char* Lkt = Lqt + 64 * QS; LAS unsigned char* Lqh = Lkt + 64 * QS;
    LAS unsigned char* LkhT = Lqh + 64 * QS; LAS unsigned char* LvT = LkhT + DK * TS; LAS unsigned char* Latt = LvT + 128 * TS;
    LAS float* Ltot = (LAS float*)(Latt + 64 * TS); LAS float* Lbl = Ltot + 512;
    const bf16* P = (const bf16*)(a->ws + WS_P);
    bf16* OSC = (bf16*)(a->ws + WS_OSC) + (size_t)dir * MT * 512;
    f32x4* Ub = (f32x4*)(a->ws + WS_U); float* Lb = (float*)(a->ws + WS_LSUM);
    const int c = tid & (DK - 1), tq = tid / DK;
    float lb = 0.f, lg = 0.f, qscale = 1.f; int qcol, zcol;
    if (HG) { qscale = 0.08838834764831845f; qcol = h * 128 + c; zcol = (dir ? 1536 : 1024) + h * 128 + c;
        if (layer >= 2) { const float l0 = a->in[12][(0 * 2 + dir) * 512 + h * 128 + c], l1 = a->in[12][(1 * 2 + dir) * 512 + h * 128 + c]; lb = 1.f / (1.f + __expf(l0 - l1)); } }
    else { qcol = h * 64 + c; zcol = 256 + h * 64 + c; const float x = a->in[19][((layer >> 1) * 2 + dir) * 4 + h]; lg = -__logf(1.f + __expf(-x)); }
    const int vcol = 512 + h * 128;
    const int rowbase = b * TPB;
    const int tv = lane, c8v = wid;
    unsigned short rq[TPT], rz[TPT]; bf16x8 rv[2];
#define SC_JB(ci) (dir ? ((ci) < 4 ? 255 - 64 * (ci) : 2303 - 64 * ((ci) - 4)) : 64 * (ci))
#define SC_LOAD(ci) do { const int jb_ = SC_JB(ci), sg_ = dir ? -1 : 1; \
        _Pragma("unroll") for (int i = 0; i < TPT; ++i) { const bf16* pr_ = P + (size_t)(rowbase + jb_ + sg_ * (tq * TPT + i)) * NP; if (MODE) rq[i] = pr_[qcol]; rz[i] = pr_[zcol]; } \
        { const bf16* pv_ = P + (size_t)(rowbase + jb_ + sg_ * tv) * NP + vcol; rv[0] = *(const bf16x8*)(pv_ + c8v * 8); rv[1] = *(const bf16x8*)(pv_ + (c8v + 8) * 8); } } while (0)
    f32x4 Sacc[DK / 16];
#pragma unroll
    for (int i = 0; i < DK / 16; ++i) Sacc[i] = (f32x4){0.f, 0.f, 0.f, 0.f};
    const int c0 = 9 * seg;
    SC_LOAD(c0);
    if (MODE) {
        for (int s_ = 0; s_ < seg; ++s_) {
#pragma unroll
            for (int i = 0; i < DK / 16; ++i) { f32x4 v = Sacc[i];
                if (s_ > 0) { const f32x4 l4 = *(const f32x4*)(Lb + (size_t)(item * 3 + s_) * 128 + 16 * i + 4 * q4); v[0] *= __expf(l4[0]); v[1] *= __expf(l4[1]); v[2] *= __expf(l4[2]); v[3] *= __expf(l4[3]); }
                Sacc[i] = v + Ub[((size_t)(item * 3 + s_) * (DK / 16) + i) * 512 + tid]; }
        }
    }
    float lsum = 0.f;
    for (int ci = c0; ci < c0 + 9; ++ci) {
#pragma unroll
        for (int u = 0; u < 2; ++u)
#pragma unroll
            for (int e = 0; e < 8; ++e) *(LAS unsigned short*)(LvT + ((c8v + 8 * u) * 8 + e) * TS + tv * 2) = (unsigned short)rv[u][e];
        float zf[TPT], qf[TPT];
#pragma unroll
        for (int i = 0; i < TPT; ++i) { zf[i] = bf2f(rz[i]); if (MODE) qf[i] = bf2f(rq[i]) * qscale; }
        const int jb = SC_JB(ci), sg = dir ? -1 : 1;
        if (ci + 1 < c0 + 9) SC_LOAD(ci + 1);
        float kk_[TPT], e1v[TPT], e2v[TPT]; float Eref, Ebr, dlast;
        if (HG) {
            float fv[TPT];
#pragma unroll
            for (int i = 0; i < TPT; ++i) { const float z = fminf(fmaxf(zf[i], -30.f), 30.f);
                const float t = __expf(-fabsf(z)), r = __builtin_amdgcn_rcpf(1.f + t), tr = t * r;
                const float sig = z >= 0.f ? r : tr, sigm = z >= 0.f ? tr : r;
                kk_[i] = (1.f - lb) * sigm; fv[i] = lb + (1.f - lb) * sig; }
            float run = 1.f;
            if (tq < 2) {
#pragma unroll
                for (int i = TPT - 1; i >= 0; --i) { e2v[i] = run; run *= fv[i]; }
            } else {
#pragma unroll
                for (int i = 0; i < TPT; ++i) { run *= fv[i]; e1v[i] = run; }
            }
            Ltot[tq * 128 + c] = run;
            __syncthreads();
            const float t0 = Ltot[c], t1 = Ltot[128 + c], t2 = Ltot[256 + c], t3 = Ltot[384 + c];
            Eref = t0 * t1; Ebr = t2 * t3; dlast = Eref * Ebr;
            const float mul = (tq == 0) ? t1 : ((tq == 3) ? t2 : 1.f);
            if (tq < 2) {
#pragma unroll
                for (int i = 0; i < TPT; ++i) { e2v[i] = fmaxf(e2v[i] * mul, 1e-30f); if (MODE) e1v[i] = __builtin_amdgcn_rcpf(e2v[i]); }
            } else {
#pragma unroll
                for (int i = 0; i < TPT; ++i) { e1v[i] = fmaxf(e1v[i] * mul, 1e-30f); e2v[i] = __builtin_amdgcn_rcpf(e1v[i]); }
            }
            lsum += __logf(fmaxf(dlast, 1e-37f));
        } else {
#pragma unroll
            for (int i = 0; i < TPT; ++i) { kk_[i] = zf[i]; e1v[i] = __expf((float)(tq * TPT + i - 31) * lg); e2v[i] = __builtin_amdgcn_rcpf(e1v[i]); }
            Eref = __expf(32.f * lg); Ebr = Eref; dlast = Eref * Ebr;
            lsum += 64.f * lg;
        }
        unsigned short kh[TPT];
        if (MODE) {
#pragma unroll
            for (int i = 0; i < TPT; ++i) { const int tau = tq * TPT + i;
                const float qt = qf[i] * e1v[i], kt = kk_[i] * e2v[i];
                const unsigned wq = cvtpk2(qt, qt * Eref), wk = cvtpk2(kt, kt * Ebr);
                *(LAS unsigned short*)(Lqt + tau * QS + c * 2) = (unsigned short)(wq & 0xffff);
                *(LAS unsigned short*)(Lqh + tau * QS + c * 2) = (unsigned short)(wq >> 16);
                *(LAS unsigned short*)(Lkt + tau * QS + c * 2) = (unsigned short)(wk & 0xffff);
                kh[i] = (unsigned short)(wk >> 16); }
        } else {
#pragma unroll
            for (int i = 0; i < TPT; ++i) kh[i] = (unsigned short)(cvtpk2(kk_[i] * e2v[i] * Ebr, 0.f) & 0xffff);
        }
#pragma unroll
        for (int i8 = 0; i8 < TPT / 8; ++i8) { u32x4 w; w.x = kh[8 * i8] | ((unsigned)kh[8 * i8 + 1] << 16); w.y = kh[8 * i8 + 2] | ((unsigned)kh[8 * i8 + 3] << 16);
            w.z = kh[8 * i8 + 4] | ((unsigned)kh[8 * i8 + 5] << 16); w.w = kh[8 * i8 + 6] | ((unsigned)kh[8 * i8 + 7] << 16);
            *(LAS u32x4*)(LkhT + c * TS + (tq * TPT + 8 * i8) * 2) = w; }
        if (tq == 0) Lbl[c] = dlast;
        __syncthreads();
        const int dvl = 16 * wid + l15;
        const bf16x8 bv0 = *(const LAS bf16x8*)(LvT + dvl * TS + (8 * q4) * 2), bv1 = *(const LAS bf16x8*)(LvT + dvl * TS + (32 + 8 * q4) * 2);
        if (MODE) {
#pragma unroll
            for (int tt = 0; tt < 2; ++tt) { const int idx = 2 * wid + tt, si = idx >> 2, ti = idx & 3;
                f32x4 acc = (f32x4){0.f, 0.f, 0.f, 0.f};
#pragma unroll
                for (int kk = 0; kk < DK / 32; ++kk) { const bf16x8 A = *(const LAS bf16x8*)(Lkt + (16 * si + l15) * QS + (32 * kk + 8 * q4) * 2);
                    const bf16x8 B = *(const LAS bf16x8*)(Lqt + (16 * ti + l15) * QS + (32 * kk + 8 * q4) * 2); acc = mfma16(A, B, acc); }
                const int t = 16 * ti + l15, s0 = 16 * si + 4 * q4;
                u32x2 w; w.x = pk2(s0 + 0 <= t ? acc[0] : 0.f, s0 + 1 <= t ? acc[1] : 0.f); w.y = pk2(s0 + 2 <= t ? acc[2] : 0.f, s0 + 3 <= t ? acc[3] : 0.f);
                *(LAS u32x2*)(Latt + t * TS + s0 * 2) = w; }
            __syncthreads();
            bf16x8 Sb[DK / 32];
#pragma unroll
            for (int kk = 0; kk < DK / 32; ++kk) { u32x4 w; w.x = pk2(Sacc[2 * kk][0], Sacc[2 * kk][1]); w.y = pk2(Sacc[2 * kk][2], Sacc[2 * kk][3]);
                w.z = pk2(Sacc[2 * kk + 1][0], Sacc[2 * kk + 1][1]); w.w = pk2(Sacc[2 * kk + 1][2], Sacc[2 * kk + 1][3]); Sb[kk] = __builtin_bit_cast(bf16x8, w); }
#pragma unroll
            for (int ti = 0; ti < 4; ++ti) {
                f32x4 acc = (f32x4){0.f, 0.f, 0.f, 0.f};
                { const bf16x8 A = *(const LAS bf16x8*)(Latt + (16 * ti + l15) * TS + (8 * q4) * 2); acc = mfma16(A, bv0, acc); }
                if (ti >= 2) { const bf16x8 A = *(const LAS bf16x8*)(Latt + (16 * ti + l15) * TS + (32 + 8 * q4) * 2); acc = mfma16(A, bv1, acc); }
#pragma unroll
                for (int kk = 0; kk < DK / 32; ++kk) {
                    const s16x4 lo = *(const LAS s16x4*)(Lqh + (16 * ti + l15) * QS + (32 * kk + 4 * q4) * 2), hi = *(const LAS s16x4*)(Lqh + (16 * ti + l15) * QS + (32 * kk + 16 + 4 * q4) * 2);
                    const bf16x8 A = (bf16x8){lo[0], lo[1], lo[2], lo[3], hi[0], hi[1], hi[2], hi[3]};
                    acc = mfma16(A, Sb[kk], acc); }
#pragma unroll
                for (int r = 0; r < 4; ++r) { const int t = 16 * ti + 4 * q4 + r;
                    OSC[(size_t)(rowbase + jb + sg * t) * 512 + h * 128 + dvl] = (bf16)f2bf(acc[r]); }
            }
        }
#pragma unroll
        for (int i = 0; i < DK / 16; ++i) {
            const f32x4 d4 = *(const LAS f32x4*)(Lbl + 16 * i + 4 * q4);
            f32x4 s = Sacc[i] * d4;
            const bf16x8 A0 = *(const LAS bf16x8*)(LkhT + (16 * i + l15) * TS + (8 * q4) * 2), A1 = *(const LAS bf16x8*)(LkhT + (16 * i + l15) * TS + (32 + 8 * q4) * 2);
            s = mfma16(A0, bv0, s); s = mfma16(A1, bv1, s); Sacc[i] = s; }
        __syncthreads();
    }
    if (!MODE) {
#pragma unroll
        for (int i = 0; i < DK / 16; ++i) Ub[((size_t)(item * 3 + seg) * (DK / 16) + i) * 512 + tid] = Sacc[i];
        if (tq == 0) Lb[(size_t)(item * 3 + seg) * 128 + c] = lsum;
    }
#undef SC_JB
#undef SC_LOAD
}

#define SBAR() __builtin_amdgcn_sched_barrier(0)
__device__ __forceinline__ int crow(int r, int hi) { return (r & 3) + 8 * (r >> 2) + 4 * hi; }
__device__ __forceinline__ unsigned cvtpk(float lo, float hi) { unsigned r; asm volatile("v_cvt_pk_bf16_f32 %0, %1, %2" : "=v"(r) : "v"(lo), "v"(hi)); return r; }
__device__ __forceinline__ void partialSM(f32x16& p0, f32x16& p1, float& m_reg, float& mn, float& alpha, float C, float thr_raw) {
    float pmax = p0[0];
#pragma unroll
    for (int r = 1; r < 16; ++r) pmax = fmaxf(pmax, p0[r]);
#pragma unroll
    for (int r = 0; r < 16; ++r) pmax = fmaxf(pmax, p1[r]);
    { auto rr = __builtin_amdgcn_permlane32_swap(__float_as_uint(pmax), __float_as_uint(pmax), false, false);
      pmax = fmaxf(__uint_as_float(rr[0]), __uint_as_float(rr[1])); }
    if (__builtin_expect(__all(pmax - m_reg <= thr_raw), 1)) { mn = m_reg; alpha = 1.f; }
    else { mn = fmaxf(m_reg, pmax); alpha = __builtin_amdgcn_exp2f((m_reg - mn) * C); m_reg = mn; }
    const float mnC = -mn * C;
#pragma unroll
    for (int r = 0; r < 16; ++r) p0[r] = fmaf(p0[r], C, mnC);
#pragma unroll
    for (int r = 0; r < 16; ++r) p1[r] = fmaf(p1[r], C, mnC);
#pragma unroll
    for (int r = 0; r < 16; ++r) p0[r] = __builtin_amdgcn_exp2f(p0[r]);
}
__device__ __forceinline__ void finishSM(f32x16& p0, f32x16& p1, float alpha, float& l_reg, bf16x8& pa0, bf16x8& pa1, bf16x8& pa2, bf16x8& pa3) {
#pragma unroll
    for (int r = 0; r < 16; ++r) p1[r] = __builtin_amdgcn_exp2f(p1[r]);
    float ps = 0;
#pragma unroll
    for (int r = 0; r < 16; ++r) ps += p0[r];
#pragma unroll
    for (int r = 0; r < 16; ++r) ps += p1[r];
    { auto rr = __builtin_amdgcn_permlane32_swap(__float_as_uint(ps), __float_as_uint(ps), false, false);
      ps = __uint_as_float(rr[0]) + __uint_as_float(rr[1]); }
    l_reg = l_reg * alpha + ps;
#define PK4(P, BASE, OUT) do { unsigned a0 = cvtpk(P[BASE + 0], P[BASE + 1]), a1 = cvtpk(P[BASE + 2], P[BASE + 3]);   \
    unsigned b0 = cvtpk(P[BASE + 4], P[BASE + 5]), b1 = cvtpk(P[BASE + 6], P[BASE + 7]);                              \
    auto r0 = __builtin_amdgcn_permlane32_swap(a0, b0, false, false); auto r1 = __builtin_amdgcn_permlane32_swap(a1, b1, false, false); \
    u32x4 w = {r0[0], r1[0], r0[1], r1[1]}; OUT = __builtin_bit_cast(bf16x8, w); } while (0)
    PK4(p0, 0, pa0); PK4(p0, 8, pa1); PK4(p1, 0, pa2); PK4(p1, 8, pa3);
#undef PK4
}
template <int ND0, int KROWB>
__device__ __forceinline__ void qkt(f32x16& p0, f32x16& p1, const char* Ks, const bf16x8* qr, int r32, int hi) {
    p0 = f32x16{}; p1 = f32x16{};
#pragma unroll
    for (int d0 = 0; d0 < ND0; ++d0) { const int cb = (d0 * 16 + hi * 8) * 2;
        const bf16x8 b0 = *reinterpret_cast<const bf16x8*>(Ks + r32 * KROWB + (cb ^ ((r32 & 7) << 4)));
        const bf16x8 b1 = *reinterpret_cast<const bf16x8*>(Ks + (32 + r32) * KROWB + (cb ^ ((r32 & 7) << 4)));
        p0 = __builtin_amdgcn_mfma_f32_32x32x16_bf16(b0, qr[d0], p0, 0, 0, 0);
        p1 = __builtin_amdgcn_mfma_f32_32x32x16_bf16(b1, qr[d0], p1, 0, 0, 0); }
}
template <int NCB> __device__ __forceinline__ int v_st(int k, int c) { const int kk = (k & ~0xC) | ((k & 4) << 1) | ((k & 8) >> 1); return ((kk >> 3) * NCB + (c >> 5)) * 512 + ((kk & 7) * 32 + (c & 31)) * 2; }
__device__ __forceinline__ int v_rd_base(int lane) { return ((lane & 3) << 3) | (((lane >> 2) & 3) << 6) | (((lane >> 4) & 1) << 5) | (((lane >> 5) & 1) << 8); }
template <int OFF> __device__ __forceinline__ s16x4 tr_read(int vb) {
    s16x4 r; asm volatile("ds_read_b64_tr_b16 %0, %1 offset:%2" : "=&v"(r) : "v"(vb), "i"(OFF) : "memory"); return r;
}
template <int NCB, int D0> __device__ __forceinline__ void pv_one(f32x16& od, int vb, bf16x8 pa0, bf16x8 pa1, bf16x8 pa2, bf16x8 pa3) {
#define VOFF(ks, half) (D0 * 512 + (ks) * (NCB * 1024) + (half) * (NCB * 512))
    const s16x4 l0 = tr_read<VOFF(0, 0)>(vb), h0 = tr_read<VOFF(0, 1)>(vb), l1 = tr_read<VOFF(1, 0)>(vb), h1 = tr_read<VOFF(1, 1)>(vb);
    const s16x4 l2 = tr_read<VOFF(2, 0)>(vb), h2 = tr_read<VOFF(2, 1)>(vb), l3 = tr_read<VOFF(3, 0)>(vb), h3 = tr_read<VOFF(3, 1)>(vb);
#undef VOFF
    asm volatile("s_waitcnt lgkmcnt(0)" ::: "memory"); SBAR();
#define PK(L, H) (bf16x8){L[0], L[1], L[2], L[3], H[0], H[1], H[2], H[3]}
    od = __builtin_amdgcn_mfma_f32_32x32x16_bf16(pa0, PK(l0, h0), od, 0, 0, 0);
    od = __builtin_amdgcn_mfma_f32_32x32x16_bf16(pa1, PK(l1, h1), od, 0, 0, 0);
    od = __builtin_amdgcn_mfma_f32_32x32x16_bf16(pa2, PK(l2, h2), od, 0, 0, 0);
    od = __builtin_amdgcn_mfma_f32_32x32x16_bf16(pa3, PK(l3, h3), od, 0, 0, 0);
#undef PK
}
template <int NCB> __device__ __forceinline__ void pv_all(f32x16* o, int vb, bf16x8 pa0, bf16x8 pa1, bf16x8 pa2, bf16x8 pa3) {
    pv_one<NCB, 0>(o[0], vb, pa0, pa1, pa2, pa3); pv_one<NCB, 1>(o[1], vb, pa0, pa1, pa2, pa3);
    if constexpr (NCB == 4) { pv_one<NCB, 2>(o[2], vb, pa0, pa1, pa2, pa3); pv_one<NCB, 3>(o[3], vb, pa0, pa1, pa2, pa3); }
}

template <int DQK, int DV, int KROWB>
__device__ __forceinline__ void attn_core(const bf16x8* qr, const bf16* kA, int sA, const bf16* kB, int sB, const bf16* vP, int sV,
                                          int NT, float C, float thr_raw, char* lds, f32x16* o, float& l_out, const int tid) {
    constexpr int NCB = DV / 32, SHM_V = 64 * DV * 2, SHM_K = 64 * KROWB, ND0 = DQK / 16;
    constexpr int PPR = DQK / 8, NPK = 64 * PPR, NKS = (NPK + 511) / 512, VPR = DV / 8, NVS = 64 * VPR / 512;
    const int wid = tid >> 6, lane = tid & 63, r32 = lane & 31, hi = lane >> 5;
    char* V_lds = lds; char* K_lds = lds + 2 * SHM_V;
    float* wsf = (float*)(lds + 2 * SHM_V + 2 * SHM_K) + wid * 64; float* al_l = wsf + 32;
    float m_reg = -1e30f, l_reg = 0;
    const bf16* kp[NKS]; int kadv[NKS], kst[NKS]; bool kval[NKS];
#pragma unroll
    for (int i = 0; i < NKS; ++i) { int p = tid + 512 * i; kval[i] = p < NPK; if (!kval[i]) p -= 512; const int row = p / PPR, c8 = p - row * PPR;
        if (c8 < 8) { kp[i] = kA + (size_t)row * sA + c8 * 8; kadv[i] = 64 * sA; } else { kp[i] = kB + (size_t)row * sB + (c8 - 8) * 8; kadv[i] = 64 * sB; }
        kst[i] = row * KROWB + ((c8 * 16) ^ ((row & 7) << 4)); }
    const bf16* vp[NVS]; int vst[NVS];
#pragma unroll
    for (int i = 0; i < NVS; ++i) { const int p = tid + 512 * i, row = p / VPR, c8 = p % VPR; vp[i] = vP + (size_t)row * sV + c8 * 8; vst[i] = v_st<NCB>(row, c8 * 8); }
    const int vadv = 64 * sV;
    const int vb0 = (int)(uintptr_t)V_lds + v_rd_base(lane);
    struct { bf16x8 ks[NKS]; bf16x8 vs[NVS]; } sr_[1];
#define SLOAD(i, t) do { _Pragma("unroll") for (int s_ = 0; s_ < NKS; ++s_) sr_[i].ks[s_] = *(const bf16x8*)(kp[s_] + (size_t)(t) * kadv[s_]); \
        _Pragma("unroll") for (int s_ = 0; s_ < NVS; ++s_) sr_[i].vs[s_] = *(const bf16x8*)(vp[s_] + (size_t)(t) * vadv); } while (0)
#define SWRITE(b, i) do { _Pragma("unroll") for (int s_ = 0; s_ < NVS; ++s_) *(bf16x8*)(V_lds + (b) * SHM_V + vst[s_]) = sr_[i].vs[s_]; \
        _Pragma("unroll") for (int s_ = 0; s_ < NKS; ++s_) if (kval[s_]) *(bf16x8*)(K_lds + (b) * SHM_K + kst[s_]) = sr_[i].ks[s_]; } while (0)
#define RESC(a) do { if (__any((a) < 1.f)) { if (hi == 0) al_l[r32] = (a); asm volatile("s_waitcnt lgkmcnt(0)" ::: "memory"); \
        _Pragma("unroll") for (int d = 0; d < NCB; ++d) _Pragma("unroll") for (int r = 0; r < 16; ++r) o[d][r] *= al_l[crow(r, hi)]; } } while (0)
    f32x16 pA0, pA1, pB0, pB1; float mnA, mnB, alA, alB; bf16x8 pa0, pa1, pa2, pa3;
    constexpr int SE = 0, SO = 0;
    SLOAD(SE, 0); SWRITE(0, SE); __syncthreads();
    qkt<ND0, KROWB>(pA0, pA1, K_lds, qr, r32, hi); partialSM(pA0, pA1, m_reg, mnA, alA, C, thr_raw);
    SLOAD(SO, 1);
    SWRITE(1, SO); __syncthreads();
    for (int j = 1; j + 1 < NT; j += 2) {
        SBAR(); qkt<ND0, KROWB>(pB0, pB1, K_lds + SHM_K, qr, r32, hi);
        finishSM(pA0, pA1, alA, l_reg, pa0, pa1, pa2, pa3); SBAR();
        SLOAD(SO, j + 1); SBAR();
        pv_all<NCB>(o, vb0, pa0, pa1, pa2, pa3); partialSM(pB0, pB1, m_reg, mnB, alB, C, thr_raw);
        __syncthreads(); SWRITE(0, SE);
        RESC(alB); __syncthreads();
        SBAR(); qkt<ND0, KROWB>(pA0, pA1, K_lds, qr, r32, hi);
        finishSM(pB0, pB1, alB, l_reg, pa0, pa1, pa2, pa3); SBAR();
        SLOAD(SE, j + 2); SBAR();
        pv_all<NCB>(o, vb0 + SHM_V, pa0, pa1, pa2, pa3); partialSM(pA0, pA1, m_reg, mnA, alA, C, thr_raw);
        __syncthreads(); SWRITE(1, SO);
        RESC(alA); __syncthreads();
    }
    SBAR(); qkt<ND0, KROWB>(pB0, pB1, K_lds + SHM_K, qr, r32, hi);
    finishSM(pA0, pA1, alA, l_reg, pa0, pa1, pa2, pa3); SBAR();
    pv_all<NCB>(o, vb0, pa0, pa1, pa2, pa3); partialSM(pB0, pB1, m_reg, mnB, alB, C, thr_raw);
    __syncthreads(); RESC(alB);
    finishSM(pB0, pB1, alB, l_reg, pa0, pa1, pa2, pa3); SBAR();
    pv_all<NCB>(o, vb0 + SHM_V, pa0, pa1, pa2, pa3);
    l_out = l_reg;
#undef SLOAD
#undef SWRITE
#undef RESC
}

__device__ __forceinline__ void mla_item(KArgP a, int b, int h, int qb, char* lds) {
    const int tid = ptid(), wid = tid >> 6, lane = tid & 63, r32 = lane & 31, hi = lane >> 5;
    const bf16* Qb = (const bf16*)((const unsigned char*)a->out + OUT_Q); const bf16* KV = (const bf16*)((const unsigned char*)a->out + OUT_KV);
    const bf16* KR = (const bf16*)(a->ws + WS_KR); bf16* MIX = (bf16*)(a->ws + WS_MIX);
    const int row0 = b * TPB + qb * 256, krow0 = b * TPB, NT = qb ? 36 : 4;
    const int row = row0 + wid * 32 + r32;
    const bf16* Qw = Qb + (size_t)row * 768 + h * 96;
    bf16x8 qr[6];
#pragma unroll
    for (int d0 = 0; d0 < 4; ++d0) qr[d0] = *(const bf16x8*)(Qw + d0 * 16 + hi * 8);
    const int t = (qb - 1) * 256 + wid * 32 + r32;
#pragma unroll
    for (int d0 = 4; d0 < 6; ++d0) {
        const bf16x8 x1 = *(const bf16x8*)(Qw + d0 * 16), x2 = *(const bf16x8*)(Qw + d0 * 16 + 8);
        if (qb) { const float pos = (float)(d0 == 4 ? (t >> 6) : (t & 63)); unsigned short ov[8];
#pragma unroll
            for (int i = 0; i < 8; ++i) { float s, c; sincos_r(pos * inv_freq(i, 8), s, c); const float f1 = bf2f((unsigned short)x1[i]), f2 = bf2f((unsigned short)x2[i]);
                ov[i] = (unsigned short)f2bf(hi ? (f1 * s + f2 * c) : (f1 * c - f2 * s)); }
            qr[d0] = (bf16x8){(short)ov[0], (short)ov[1], (short)ov[2], (short)ov[3], (short)ov[4], (short)ov[5], (short)ov[6], (short)ov[7]};
        } else qr[d0] = hi ? x2 : x1;
    }
    f32x16 o[2] = {}; float l_reg;
    const float scale = 0.10206207261596575f;
    attn_core<96, 64, 256>(qr, KV + (size_t)krow0 * 1024 + h * 128, 1024, KR + (size_t)krow0 * 32, 32, KV + (size_t)krow0 * 1024 + h * 128 + 64, 1024,
                           NT, scale * 1.4426950408889634f, 8.f / scale, lds, o, l_reg, tid);
    float* li_l = (float*)(lds + 2 * 64 * 64 * 2 + 2 * 64 * 256) + wid * 64;
    if (hi == 0) li_l[r32] = l_reg; asm volatile("s_waitcnt lgkmcnt(0)" ::: "memory");
#pragma unroll
    for (int r = 0; r < 16; ++r) { const int orow = crow(r, hi); const float rl = __builtin_amdgcn_rcpf(li_l[orow]);
        bf16* op = MIX + (size_t)(row0 + wid * 32 + orow) * 1024 + 512 + h * 64 + r32;
        op[0] = (bf16)f2bf(o[0][r] * rl); op[32] = (bf16)f2bf(o[1][r] * rl); }
}
__device__ __forceinline__ void diff_item(KArgP a, int layer, int b, int h, int qb, char* lds) {
    const int row0 = b * TPB + qb * 256, krow0 = b * TPB, NT = qb ? 36 : 4, o_ = layer >> 1;
    const float scale = 0.125f;
#pragma unroll 1
    for (int m = 0; m < 2; ++m) {
        f32x16 o[4] = {};
        float l_reg;
        {
            const int tid = ptid(), wid = tid >> 6, lane = tid & 63, r32 = lane & 31, hi = lane >> 5;
            const bf16* P = (const bf16*)(a->ws + WS_P);
            const bf16* Qw = P + (size_t)(row0 + wid * 32 + r32) * NP_O + 1536 + h * 128 + m * 64;
            bf16x8 qr[4];
#pragma unroll
            for (int d0 = 0; d0 < 4; ++d0) qr[d0] = *(const bf16x8*)(Qw + d0 * 16 + hi * 8);
            const bf16* Kp = P + (size_t)krow0 * NP_O + 2048 + h * 128 + m * 64;
            attn_core<64, 128, 128>(qr, Kp, NP_O, Kp, NP_O, P + (size_t)krow0 * NP_O + 2560 + h * 128, NP_O,
                                    NT, scale * 1.4426950408889634f, 8.f / scale, lds, o, l_reg, tid);
        }
        const int tid = ptid(), wid = tid >> 6, lane = tid & 63, r32 = lane & 31, hi = lane >> 5;
        float* li_l = (float*)(lds + 2 * 64 * 128 * 2 + 2 * 64 * 128) + wid * 64;
        if (hi == 0) li_l[r32] = l_reg; asm volatile("s_waitcnt lgkmcnt(0)" ::: "memory");
        float* dsb = (float*)a->out + (size_t)blockIdx.x * 64 * 512 + tid; asm volatile("" : "+v"(dsb));
        if (m == 0) {
#pragma unroll
            for (int r = 0; r < 16; ++r) { const float rl = __builtin_amdgcn_rcpf(li_l[crow(r, hi)]);
#pragma unroll
                for (int d = 0; d < 4; ++d) dsb[(size_t)(d * 16 + r) * 512] = o[d][r] * rl; }
        } else {
            bf16* MIX = (bf16*)(a->ws + WS_MIX);
            const float* lp = a->in[20] + o_ * 256;
            const float lam_init = 0.8f - 0.6f * __expf(-0.3f * (float)layer);
            const float lam = __expf(wave_sum(lp[lane] * lp[64 + lane])) - __expf(wave_sum(lp[128 + lane] * lp[192 + lane])) + lam_init;
            const float* sg = a->in[21] + o_ * 128;
#pragma unroll
            for (int r = 0; r < 16; ++r) { const float rl = __builtin_amdgcn_rcpf(li_l[crow(r, hi)]); float s = 0.f; float v[4];
#pragma unroll
                for (int d = 0; d < 4; ++d) { v[d] = dsb[(size_t)(d * 16 + r) * 512] - lam * (o[d][r] * rl); s += v[d] * v[d]; }
                s += __shfl_xor(s, 16); s += __shfl_xor(s, 8); s += __shfl_xor(s, 4); s += __shfl_xor(s, 2); s += __shfl_xor(s, 1);
                const float rs = __builtin_amdgcn_rsqf(s * (1.f / 128.f) + EPSN) * (1.f - lam_init);
                bf16* op = MIX + (size_t)(row0 + wid * 32 + crow(r, hi)) * 1024 + 512 + h * 128 + r32;
#pragma unroll
                for (int d = 0; d < 4; ++d) op[32 * d] = (bf16)f2bf(v[d] * rs * sg[32 * d + r32]);
                asm volatile("" ::: "memory"); }
        }
        asm volatile("s_waitcnt vmcnt(0) lgkmcnt(0)" ::: "memory");
    }
}

__device__ __forceinline__ void phase_mixer(KArgP a, int layer, unsigned char* ldsg) {
    LAS unsigned char* lds = (LAS unsigned char*)ldsg;
    volatile LAS unsigned* flag = (volatile LAS unsigned*)(lds + LDS_MAIN);
    unsigned* ctr = (unsigned*)(a->ws + WS_CTL) + layer; layer &= 7;
    const bool even = !(layer & 1), need_ctx = layer < 3;
    constexpr int NSC = 256;
    const int n_lat = even ? 512 : 256, n_ctx = need_ctx ? (even ? 64 : 32) : 0, total = NSC + n_lat + n_ctx;
    for (;;) {
        __syncthreads();
        if (ptid() == 0) *flag = atomicAdd(ctr, 1u);
        __syncthreads();
        const int qi_ = (int)*flag;
        if (qi_ >= total) break;
        const int item = qi_ < n_lat ? NSC + qi_ : (qi_ < n_lat + NSC ? qi_ - n_lat : qi_);
#ifdef PROBE_ITEM
        const unsigned long long it0_ = __builtin_amdgcn_s_memrealtime();
#endif
#ifndef SKIP_SCAN
        if (item < NSC) { if (even) scan_item<128, true, 1>(a, layer, item & 63, item >> 6, lds); else scan_item<64, false, 1>(a, layer, item & 63, item >> 6, lds); }
#else
        if (item < NSC) {}
#endif
        else { int b_, h_, qb_;
            if (item < NSC + n_lat) { const int i = item - NSC; qb_ = 1 + (i & 7); if (even) { b_ = i >> 6; h_ = (i >> 3) & 7; } else { b_ = i >> 5; h_ = (i >> 3) & 3; } }
            else { const int i = item - NSC - n_lat; qb_ = 0; if (even) { b_ = i >> 3; h_ = i & 7; } else { b_ = i >> 2; h_ = i & 3; } }
#ifndef SKIP_ATTN
            if (even) mla_item(a, b_, h_, qb_, (char*)ldsg); else diff_item(a, layer, b_, h_, qb_, (char*)ldsg);
#endif
        }
#ifdef PROBE_ITEM
        __syncthreads();
        if (otid() == 0) { volatile LAS unsigned long long* pc_ = (volatile LAS unsigned long long*)(lds + LDS_MAIN + 128); const int k_ = item < NSC ? 0 : (even ? 1 : 2); pc_[k_] += __builtin_amdgcn_s_memrealtime() - it0_; }
#endif
    }
}

#define XB_TMO      128
#define XB_XCNT(j)  (256  + 64 * (j))
#define XB_XSUB(j)  (1280 + 64 * (j))
#define XB_XGEN(j)  (2304 + 64 * (j))
#define XB_TOP      3328
#define XB_TOPGEN   3392
#define XCD_BAR_WORDS 3456
#define XB_SPIN_CAP (1u << 18)

__device__ __forceinline__ unsigned xb_ld(unsigned* p)              { return __hip_atomic_load(p, __ATOMIC_RELAXED, __HIP_MEMORY_SCOPE_AGENT); }
__device__ __forceinline__ unsigned xb_add(unsigned* p, unsigned v) { return __hip_atomic_fetch_add(p, v, __ATOMIC_RELAXED, __HIP_MEMORY_SCOPE_AGENT); }
__device__ __forceinline__ unsigned xb_xcc_id() { return (unsigned)__builtin_amdgcn_s_getreg((3 << 11) | 20) & 0xFu; }
#define XB_SPIN(cond, bar) do { unsigned _sp = 0; while (cond) { __builtin_amdgcn_s_sleep(1); \
    if ((++_sp & 255u) == 0u) { if (xb_ld(&(bar)[XB_TMO])) break; if (_sp > XB_SPIN_CAP) { atomicAdd(&(bar)[XB_TMO], 1u); break; } } } } while (0)

struct XcdBarrier {
    unsigned* bar; unsigned x;
    volatile LAS unsigned* st;
};

__device__ __forceinline__ XcdBarrier xcd_barrier_post(unsigned* bar, volatile LAS unsigned* st) {
    XcdBarrier b; b.bar = bar; b.x = xb_xcc_id(); b.st = st;
    if (threadIdx.x == 0) (void)xb_add(&bar[XB_XCNT(b.x)], 1u);
    return b;
}
__device__ __forceinline__ void xcd_barrier_complete(unsigned* bar, unsigned x, unsigned& nloc, unsigned& nx) {
    const unsigned G = gridDim.x * gridDim.y * gridDim.z;
    unsigned sum, cnt, mine, sp = 0u;
    for (;;) {
        sum = 0u; cnt = 0u; mine = 0u;
#pragma unroll
        for (unsigned j = 0; j < 16; ++j) { const unsigned c = xb_ld(&bar[XB_XCNT(j)]); sum += c; cnt += (c > 0u) ? 1u : 0u; mine = (j == x) ? c : mine; }
        if (sum == G) break;
        __builtin_amdgcn_s_sleep(1);
        if ((++sp & 255u) == 0u) { if (xb_ld(&bar[XB_TMO])) break; if (sp > XB_SPIN_CAP) { atomicAdd(&bar[XB_TMO], 1u); break; } }
    }
    nloc = mine > 0u ? mine : 1u; nx = cnt > 0u ? cnt : 1u;
}

__device__ __forceinline__ void xcd_barrier(const XcdBarrier& b) {
    asm volatile("s_waitcnt vmcnt(0)" ::: "memory");
    __syncthreads();
    if (threadIdx.x == 0) {
        unsigned* bar = b.bar;
        __builtin_amdgcn_s_waitcnt(0);
        unsigned nloc = b.st[0], nx = b.st[1];
        if (nloc == 0u) { xcd_barrier_complete(bar, b.x, nloc, nx); b.st[0] = nloc; b.st[1] = nx; }
        const unsigned old = xb_add(&bar[XB_XSUB(b.x)], 1u);
        const unsigned gen = old / nloc;
        if (old + 1u == (gen + 1u) * nloc) {
            __builtin_amdgcn_fence(__ATOMIC_RELEASE, "agent");
            asm volatile("s_waitcnt vmcnt(0)" ::: "memory");
            const unsigned og = xb_add(&bar[XB_TOP], 1u);
            const unsigned tg = og / nx;
            if (og + 1u == (tg + 1u) * nx) xb_add(&bar[XB_TOPGEN], 1u);
            else XB_SPIN(xb_ld(&bar[XB_TOPGEN]) == tg, bar);
            __builtin_amdgcn_fence(__ATOMIC_ACQUIRE, "agent");
            xb_add(&bar[XB_XGEN(b.x)], 1u);
            asm volatile("s_waitcnt vmcnt(0)" ::: "memory");
        } else {
            XB_SPIN(xb_ld(&bar[XB_XGEN(b.x)]) == gen, bar);
            __builtin_amdgcn_fence(__ATOMIC_ACQUIRE, "agent");
            asm volatile("s_waitcnt vmcnt(0)" ::: "memory");
        }
    }
    __syncthreads();
}

__global__ void __launch_bounds__(512, 2) mega_fwd(Args a_) {
    extern __shared__ __attribute__((aligned(16))) unsigned char lds_raw[];
    LAS unsigned char* lds = (LAS unsigned char*)lds_raw;
    ((LAS int*)(lds + LDS_MAIN + 1024))[threadIdx.x] = (int)threadIdx.x;
    if (threadIdx.x < 4) ((LAS unsigned*)(lds + LDS_MAIN + 64))[threadIdx.x] = 0u;
    if (threadIdx.x < 8) ((LAS unsigned*)(lds + LDS_MAIN + 128))[threadIdx.x] = 0u;
    __syncthreads();
    XcdBarrier xbar; xbar.bar = nullptr; xbar.x = 0; xbar.st = nullptr; bool xb_ready = false;
    cg::grid_group grid = cg::this_grid();
    int ph = 0;
#ifdef PROBE_MASK
    unsigned long long pr_last = __builtin_amdgcn_s_memrealtime(), pr_acc = 0ull;
#define PROBE_STAMP(k) { const unsigned long long now_ = __builtin_amdgcn_s_memrealtime(); if ((PROBE_MASK >> (k)) & 1) pr_acc += now_ - pr_last; pr_last = now_; }
#else
#define PROBE_STAMP(k)
#endif
    const int plo = a_.lo, phi = a_.hi;
#define PH_BEGIN if (ph >= plo && ph < phi) { KArgP a = kargs(); int bx = (int)blockIdx.x, G = (int)gridDim.x; asm volatile("" : "+s"(bx), "+s"(G)); (void)bx; (void)G;
#ifdef PROBE_SYNC2
#define PH_ENDT(k)   if (ph + 1 < phi) { grid.sync(); grid.sync(); } } ++ph;
#else
#define PH_ENDT(k) if (ph + 1 < phi) { if (!xb_ready) { grid.sync(); xbar = xcd_barrier_post((unsigned*)(a->ws + WS_CTL) + 4096, (volatile LAS unsigned*)(lds + LDS_MAIN + 64)); xb_ready = true; } else xcd_barrier(xbar); } PROBE_STAMP(k) } ++ph;
#endif

    PH_BEGIN phase_prep(a, lds); PH_ENDT(0)

    for (int layer = 0; layer < 4; ++layer) {
        const bool even = !(layer & 1);
        const int np = even ? NP_E : NP_O;
        PH_BEGIN phase_norm(a, layer, 0, layer > 0); if (layer > 0 || G <= 96) convert_weights(a, layer, lds, 0, bx * 8 + (otid() >> 6), G * 8); PH_ENDT(1)
#ifndef SKIP_G1
        PH_BEGIN { bf16* H = (bf16*)(a->ws + WS_H); bf16* MIX = (bf16*)(a->ws + WS_MIX); bf16* P = (bf16*)(a->ws + WS_P); bf16* X = (bf16*)(a->ws + WS_X); unsigned char* Wb = a->ws + WS_W; const float* mod = (const float*)(a->ws + WS_MOD) + (size_t)layer * 9 * 6144; (void)H; (void)MIX; (void)P; (void)X; (void)mod; pg8::Gemm g{H, (const bf16*)(Wb + W_IN), MT, np, 1024, 1024}; pg8::StaticOrder S; S.init(MT, np, G, bx);
                   pg8::EpiBf16<0> E{P, np, nullptr, 0, 0, 1.f};
                   pg8::gemm_phase<pg8::EpiBf16<0>, pg8::StaticOrder, true, true>(lds, g, S, E); } PH_ENDT(2)
#else
        ++ph;
#endif
        PH_BEGIN if (even) phase_post_even(a, layer); else phase_post_odd(a, layer); PH_ENDT(3)
#ifndef SKIP_G3
        if (even) {
            PH_BEGIN { bf16* H = (bf16*)(a->ws + WS_H); bf16* MIX = (bf16*)(a->ws + WS_MIX); bf16* P = (bf16*)(a->ws + WS_P); bf16* X = (bf16*)(a->ws + WS_X); unsigned char* Wb = a->ws + WS_W; const float* mod = (const float*)(a->ws + WS_MOD) + (size_t)layer * 9 * 6144; (void)H; (void)MIX; (void)P; (void)X; (void)mod; pg8::Gemm g{(const bf16*)(a->ws + WS_CQN), (const bf16*)(Wb + W_UQ), MT, 768, 384, 384}; pg8::StaticOrder S; S.init(MT, 768, G, bx);
                       pg8::EpiBf16<0> E{(bf16*)((unsigned char*)a->out + OUT_Q), 768, nullptr, 0, 0, 1.f};
                       pg8::gemm_phase<pg8::EpiBf16<0>, pg8::StaticOrder, true, true>(lds, g, S, E); }
                     { unsigned char* Wb = a->ws + WS_W; pg8::Gemm g{(const bf16*)(a->ws + WS_CKVN), (const bf16*)(Wb + W_UKV), MT, 1024, 256, 256}; pg8::StaticOrder S; S.init(MT, 1024, G, bx);
                       pg8::EpiBf16<0> E{(bf16*)((unsigned char*)a->out + OUT_KV), 1024, nullptr, 0, 0, 1.f};
                       pg8::gemm_phase<pg8::EpiBf16<0>, pg8::StaticOrder, true, true>(lds, g, S, E); }
                     for (int it = bx; it < 192; it += G) scan_item<128, true, 0>(a, layer, it & 63, it >> 6, lds);
                     if (bx >= 192 && layer > 0) convert_weights(a, layer, lds, 1, (bx - 192) * 8 + (otid() >> 6), (G - 192) * 8);
            PH_ENDT(4)
        } else { ++ph; }
#else
        ++ph;
#endif
        if (!even) {
        PH_BEGIN for (int it = bx; it < 192; it += G) scan_item<64, false, 0>(a, layer, it & 63, it >> 6, lds);
                 if (bx >= 192) convert_weights(a, layer, lds, 1, (bx - 192) * 8 + (otid() >> 6), (G - 192) * 8); PH_ENDT(5)
        } else { ++ph; }
#ifdef PROBE_MIX2
        PH_BEGIN phase_mixer(a, layer + 8, lds_raw); grid.sync(); PH_ENDT(6)
        --ph;
#endif
        PH_BEGIN phase_mixer(a, layer, lds_raw); PH_ENDT(6 + 7 * (layer & 1))
        PH_BEGIN phase_readout(a, layer); PH_ENDT(7)
#ifndef SKIP_G6
        PH_BEGIN { bf16* H = (bf16*)(a->ws + WS_H); bf16* MIX = (bf16*)(a->ws + WS_MIX); bf16* P = (bf16*)(a->ws + WS_P); bf16* X = (bf16*)(a->ws + WS_X); unsigned char* Wb = a->ws + WS_W; const float* mod = (const float*)(a->ws + WS_MOD) + (size_t)layer * 9 * 6144; (void)H; (void)MIX; (void)P; (void)X; (void)mod; pg8::Gemm g{MIX, (const bf16*)(Wb + W_OUT), MT, 1024, 1024, 1024}; pg8::StaticOrder S; S.init(NB * NLAT, 1024, G, bx, 1);
                   pg8::EpiResid E{X, mod, 2048, layer == 0 ? a->in[0] : nullptr};
                   pg8::gemm_phase<pg8::EpiResid, pg8::StaticOrder, true, true>(lds, g, S, E);
                   if (layer < 3) { pg8::Gemm g2{MIX, (const bf16*)(Wb + W_OUT), MT, 1024, 512, 1024}; pg8::CtxSplitOrder S2{G, bx, 512};
                       pg8::EpiResidSplit E2{X, (float*)(a->ws + WS_T), mod, 2048, layer == 0 ? a->in[2] : nullptr};
                       pg8::gemm_phase<pg8::EpiResidSplit, pg8::CtxSplitOrder, true, true>(lds, g2, S2, E2); } } PH_ENDT(8)
#else
        ++ph;
#endif
        PH_BEGIN phase_norm(a, layer, 1, layer < 3); PH_ENDT(9)
#ifndef SKIP_G8
        PH_BEGIN { bf16* H = (bf16*)(a->ws + WS_H); bf16* MIX = (bf16*)(a->ws + WS_MIX); bf16* P = (bf16*)(a->ws + WS_P); bf16* X = (bf16*)(a->ws + WS_X); unsigned char* Wb = a->ws + WS_W; const float* mod = (const float*)(a->ws + WS_MOD) + (size_t)layer * 9 * 6144; (void)H; (void)MIX; (void)P; (void)X; (void)mod; pg8::Gemm g{H, (const bf16*)(Wb + W_GU), MT, 2 * FF, 1024, 1024}; pg8::StaticOrder S; if (layer < 3) S.init(MT, 2 * FF, G, bx); else S.init(NB * NLAT, 2 * FF, G, bx, 1);
                   pg8::EpiSwiGLU E{P, FF};
                   pg8::gemm_phase<pg8::EpiSwiGLU, pg8::StaticOrder, true, true>(lds, g, S, E); } PH_ENDT(10)
#else
        ++ph;
#endif
#ifndef SKIP_G9
        PH_BEGIN { bf16* H = (bf16*)(a->ws + WS_H); bf16* MIX = (bf16*)(a->ws + WS_MIX); bf16* P = (bf16*)(a->ws + WS_P); bf16* X = (bf16*)(a->ws + WS_X); unsigned char* Wb = a->ws + WS_W; const float* mod = (const float*)(a->ws + WS_MOD) + (size_t)layer * 9 * 6144; (void)H; (void)MIX; (void)P; (void)X; (void)mod; pg8::Gemm g{P, (const bf16*)(Wb + W_DN), MT, 1024, FF, FF}; pg8::StaticOrder S; S.init(NB * NLAT, 1024, G, bx, 1);
                   pg8::EpiResid E{X, mod, 5120, nullptr};
                   pg8::gemm_phase<pg8::EpiResid, pg8::StaticOrder, true, true>(lds, g, S, E);
                   if (layer < 3) { pg8::Gemm g2{P, (const bf16*)(Wb + W_DN), MT, 1024, FF / 2, FF}; pg8::CtxSplitOrder S2{G, bx, FF / 2};
                       pg8::EpiResidSplit E2{X, (float*)(a->ws + WS_T), mod, 5120, nullptr};
                       pg8::gemm_phase<pg8::EpiResidSplit, pg8::CtxSplitOrder, true, true>(lds, g2, S2, E2); } } PH_ENDT(11)
#else
        ++ph;
#endif
    }
    PH_BEGIN phase_final(a); PH_ENDT(12)
#undef PH_BEGIN
#undef PH_ENDT
#ifdef PROBE_ITEM
    pr_acc += ((volatile LAS unsigned long long*)(lds + LDS_MAIN + 128))[PROBE_ITEM - 1];
#endif
#ifdef PROBE_MASK
    if (blockIdx.x == 0) { const unsigned long long t0_ = __builtin_amdgcn_s_memrealtime(); while (__builtin_amdgcn_s_memrealtime() - t0_ < pr_acc) __builtin_amdgcn_s_sleep(8); }
#endif
}
constexpr int NPH = 1 + 4 * 11 + 1;

extern "C" void kernel_launch(void* const* d_in, const int* in_sizes, int n_in, void* d_out, int out_size, void* d_ws, size_t ws_size, hipStream_t stream) {
    static int grid = 0;
    if (grid == 0) {
        if (n_in != 23 || ws_size < WS_END || out_size != NB * NLAT * DM) { fprintf(stderr, "kernel_launch: unexpected shapes: n_in %d ws %zu (need %zu) out %d\n", n_in, ws_size, (size_t)WS_END, out_size); grid = -1; return; }
        int dev = 0, cus = 0, per_cu = 0;
        hipGetDevice(&dev); hipDeviceGetAttribute(&cus, hipDeviceAttributeMultiprocessorCount, dev);
        if (hipFuncSetAttribute((const void*)mega_fwd, hipFuncAttributeMaxDynamicSharedMemorySize, LDS_BYTES) != hipSuccess) { fprintf(stderr, "kernel_launch: hipFuncSetAttribute failed\n"); grid = -1; return; }
        if (hipOccupancyMaxActiveBlocksPerMultiprocessor(&per_cu, (const void*)mega_fwd, 512, LDS_BYTES) != hipSuccess || per_cu < 1) { fprintf(stderr, "kernel_launch: occupancy query says %d\n", per_cu); per_cu = 1; }
        (void)hipGetLastError();
        grid = cus;
    }
    if (grid < 0) return;
    Args a{};
    for (int i = 0; i < 23; ++i) a.in[i] = (const float*)d_in[i];
    a.out = (float*)d_out; a.ws = (unsigned char*)d_ws; a.lo = 0; a.hi = NPH;
    void* kargv[] = {&a};
    hipError_t e = hipLaunchCooperativeKernel((const void*)mega_fwd, dim3(grid), dim3(512), kargv, LDS_BYTES, stream);
    if (e != hipSuccess) fprintf(stderr, "kernel_launch: cooperative launch failed: %s (grid %d)\n", hipGetErrorString(e), grid);
}
```

```cpp
#include <hip/hip_runtime.h>
#include <hip/hip_cooperative_groups.h>
#include <cstdio>
#include <cstdint>
namespace cg = cooperative_groups;
#define otid() ({ int t_ = (int)threadIdx.x; asm volatile("" : "+v"(t_)); t_; })
extern __shared__ __attribute__((aligned(16))) unsigned char g_lds_dyn[];
#define ptid() (*(volatile __attribute__((address_space(3))) int*)((__attribute__((address_space(3))) unsigned char*)g_lds_dyn + 131072 + 1024 + 4 * (int)threadIdx.x))
namespace pg8 {
#define PG8_LAS __attribute__((address_space(3)))
typedef unsigned short bf16_t;
typedef short bf16x8 __attribute__((ext_vector_type(8)));
typedef float f32x4 __attribute__((ext_vector_type(4)));
typedef unsigned u32x4 __attribute__((ext_vector_type(4)));
constexpr int BM = 256, BK = 64, HALF = 128, HTB = HALF * BK * 2  , STAGE_BYTES = 8 * HTB, NXCD = 8, WGM = 8;

__host__ __device__ __forceinline__ int lds_byte(int r, int c) { const int st = (r >> 4) * 2 + (c >> 5), rr = r & 15, cc = c & 31, ob = rr * 64 + cc * 2; return st * 1024 + (ob ^ (((ob >> 9) & 1) << 5)); }
__host__ __device__ __forceinline__ void stage_rc(int b, int& R, int& C) { const int st = b / 1024, sb = b % 1024, swz = sb ^ (((sb >> 9) & 1) << 5); R = (st >> 1) * 16 + swz / 64; C = (st & 1) * 32 + (swz % 64) / 2; }
__host__ __device__ __forceinline__ int perm32(int rho) { const int n = rho >> 4, i = rho & 15; return 8 * (i >> 2) + 4 * n + (i & 3); }

struct Unit { int pm, pn, koff; };
struct Gemm { const bf16_t* A; const bf16_t* Bt; int M, N, K, ld; };

struct StaticOrder {
    int nM, nN, nwg, G, c, mode;
    __host__ __device__ void init(int M, int N, int G_, int c_, int mode_ = 0) { nM = M / BM; nN = N / BM; nwg = nM * nN; G = G_; c = c_; mode = mode_; }
    __host__ __device__ bool next(int i, Unit& u) const {
        const long L = (long)i * G + c; if (L >= nwg) return false;
        int wgid = (int)L; { const int q = nwg / NXCD, r = nwg % NXCD, xcd = wgid % NXCD, off = wgid / NXCD; wgid = (xcd < r ? xcd * (q + 1) : r * (q + 1) + (xcd - r) * q) + off; }
        const int nig = WGM * nN, gid = wgid / nig, fm = gid * WGM, gsz = (nM - fm) < WGM ? (nM - fm) : WGM;
        u.pm = fm + ((wgid % nig) % gsz); u.pn = (wgid % nig) / gsz; u.koff = 0; if (mode == 1) u.pm = (u.pm >> 3) * 9 + 1 + (u.pm & 7); return true;
    }
    __device__ __forceinline__ void a_ready(const Unit&) const {}
    __device__ __forceinline__ void done(const Unit&) const {}
};
struct CtxSplitOrder {
    int G, c, khalf;
    __device__ bool next(int i, Unit& u) const { const int L = i * G + c; if (L >= 64) return false; u.koff = (L & 1) * khalf; u.pn = (L >> 1) & 3; u.pm = (L >> 3) * 9; return true; }
    __device__ __forceinline__ void a_ready(const Unit&) const {}
    __device__ __forceinline__ void done(const Unit&) const {}
};

__device__ __forceinline__ unsigned cvt_pk_bf16(float lo, float hi) { unsigned r; asm volatile("v_cvt_pk_bf16_f32 %0, %1, %2" : "=v"(r) : "v"(lo), "v"(hi)); return r; }
typedef float f32x2 __attribute__((ext_vector_type(2)));
__device__ __forceinline__ f32x2 gelu_pk(f32x2 v) {
    const f32x2 av = __builtin_elementwise_abs(v), d = av * 0.2316418882f + 1.0f;
    f32x2 t; t.x = __builtin_amdgcn_rcpf(d.x); t.y = __builtin_amdgcn_rcpf(d.y);
    f32x2 q = t * 0.5307027145f + (-0.7265760135f); q = q * t + 0.7107068705f; q = q * t + (-0.142248368f); q = q * t + 0.127414796f; q = q * t;
    const f32x2 s = (v * v) * (-0.72134752044f);
    f32x2 e; e.x = __builtin_amdgcn_exp2f(s.x); e.y = __builtin_amdgcn_exp2f(s.y);
    const f32x2 m = v * (q * e), r = v - m;
    f32x2 o; o.x = v.x < 0.f ? m.x : r.x; o.y = v.y < 0.f ? m.y : r.y; return o;
}

template <int ACT  > struct EpiBf16 {
    static constexpr bool PERM = true, AFTER_DRAIN = false; static_assert(ACT == 0 || ACT == 1, "EpiBf16: ACT is 0 (none) or 1 (gelu_pk)");
    bf16_t* O; int ldc; const float* bias; int split_cols; size_t split_stride; float scale0;
    __device__ __forceinline__ void operator()(const f32x4 (&acc)[2][2][4][2], const Unit& u, int wr, int wc, int fr, int fq) const {
        const int row0 = u.pm * BM + wr * 64 + fr; int colt = u.pn * BM; bf16_t* base = O;
        float sc = 1.f; if (split_cols) { const int t = colt / split_cols; base += (size_t)t * split_stride; colt -= t * split_cols; if (t == 0) sc = scale0; }
        const int col0 = colt + wc * 32 + 8 * fq, bcol0 = u.pn * BM + wc * 32 + 8 * fq;
        f32x4 bv[2][2];
#pragma unroll
        for (int bj = 0; bj < 2; ++bj)
#pragma unroll
            for (int n = 0; n < 2; ++n) bv[bj][n] = bias ? *(const f32x4*)(bias + bcol0 + bj * HALF + 4 * n) : (f32x4){0.f, 0.f, 0.f, 0.f};
#pragma unroll
        for (int ai = 0; ai < 2; ++ai)
#pragma unroll
            for (int m = 0; m < 4; ++m) { bf16_t* rowp = base + (size_t)(row0 + ai * HALF + m * 16) * ldc + col0;
#pragma unroll
                for (int bj = 0; bj < 2; ++bj) { f32x4 v0 = acc[ai][bj][m][0] + bv[bj][0], v1 = acc[ai][bj][m][1] + bv[bj][1];
                    if (ACT == 1) { f32x2 a = gelu_pk((f32x2){v0[0], v0[1]}), b = gelu_pk((f32x2){v0[2], v0[3]}), c = gelu_pk((f32x2){v1[0], v1[1]}), d = gelu_pk((f32x2){v1[2], v1[3]});
                        v0 = (f32x4){a.x, a.y, b.x, b.y}; v1 = (f32x4){c.x, c.y, d.x, d.y}; }
                    v0 = v0 * sc; v1 = v1 * sc; u32x4 w; w.x = cvt_pk_bf16(v0[0], v0[1]); w.y = cvt_pk_bf16(v0[2], v0[3]); w.z = cvt_pk_bf16(v1[0], v1[1]); w.w = cvt_pk_bf16(v1[2], v1[3]);
                    { bf16_t* sp_ = rowp + bj * HALF; asm volatile("global_store_dwordx4 %0, %1, off sc1\n\ts_nop 1" :: "v"(sp_), "v"(w) : "memory"); } } }
    }
};
struct EpiResidSplit {
    static constexpr bool PERM = false, AFTER_DRAIN = false;
    bf16_t* X; float* T; const float* mod; int goff; const float* cin;
    __device__ __forceinline__ void operator()(const f32x4 (&acc)[2][2][4][2], const Unit& u, int wr, int wc, int fr, int fq) const {
        typedef unsigned u32x2_t __attribute__((ext_vector_type(2)));
        const float* gp = mod + 8 * 6144 + goff;
        const int col0 = u.pn * BM + wc * 32 + 4 * fq;
        const bool first = (u.koff == 0);
        bf16_t* xb = X + (size_t)(u.pm * BM) * 1024; float* tb = T + (size_t)((u.pm / 9) * BM) * 1024;
        const float* rbase = cin ? cin + (size_t)((u.pm / 9) * BM) * 1024 : nullptr;
#pragma unroll
        for (int bj = 0; bj < 2; ++bj)
#pragma unroll
            for (int n = 0; n < 2; ++n) { const f32x4 gv = *(const f32x4*)(gp + col0 + bj * HALF + n * 16);
#pragma unroll
                for (int ai = 0; ai < 2; ++ai)
#pragma unroll
                    for (int m = 0; m < 4; ++m) { const size_t o = (size_t)(ai * HALF + wr * 64 + m * 16 + fr) * 1024 + col0 + bj * HALF + n * 16;
                        f32x4 v = gv * acc[ai][bj][m][n];
                        if (first) { f32x4 x;
                            if (rbase) x = *(const f32x4*)(rbase + o);
                            else { const u32x2_t w = *(const u32x2_t*)(xb + o); x = (f32x4){__uint_as_float(w.x << 16), __uint_as_float(w.x & 0xffff0000u), __uint_as_float(w.y << 16), __uint_as_float(w.y & 0xffff0000u)}; }
                            v = v + x; u32x2_t r; r.x = cvt_pk_bf16(v[0], v[1]); r.y = cvt_pk_bf16(v[2], v[3]); *(u32x2_t*)(xb + o) = r; }
                        else *(f32x4*)(tb + o) = v; } }
    }
};
struct EpiSwiGLU {
    static constexpr bool PERM = true, AFTER_DRAIN = false;
    bf16_t* O; int ldc;
    __device__ __forceinline__ void operator()(const f32x4 (&acc)[2][2][4][2], const Unit& u, int wr, int wc, int fr, int fq) const {
        const int row0 = u.pm * BM + wr * 64 + fr; const int col0 = u.pn * HALF + wc * 32 + 8 * fq;
#pragma unroll
        for (int ai = 0; ai < 2; ++ai)
#pragma unroll
            for (int m = 0; m < 4; ++m) { bf16_t* rowp = O + (size_t)(row0 + ai * HALF + m * 16) * ldc + col0;
                float h[8];
#pragma unroll
                for (int n = 0; n < 2; ++n)
#pragma unroll
                    for (int i = 0; i < 4; ++i) { const float g = acc[ai][0][m][n][i], up = acc[ai][1][m][n][i];
                        h[n * 4 + i] = g * __builtin_amdgcn_rcpf(1.0f + __expf(-g)) * up; }
                u32x4 w; w.x = cvt_pk_bf16(h[0], h[1]); w.y = cvt_pk_bf16(h[2], h[3]); w.z = cvt_pk_bf16(h[4], h[5]); w.w = cvt_pk_bf16(h[6], h[7]);
                asm volatile("global_store_dwordx4 %0, %1, off sc1\n\ts_nop 1" :: "v"(rowp), "v"(w) : "memory"); }
    }
};
struct EpiResid {
    static constexpr bool PERM = true, AFTER_DRAIN = false;
    bf16_t* X; const float* mod; int goff; const float* xin;
    __device__ __forceinline__ void operator()(const f32x4 (&acc)[2][2][4][2], const Unit& u, int wr, int wc, int fr, int fq) const {
        const int widx = (u.pm % 9 == 0) ? 8 : (u.pm / 9);
        const float* gp = mod + widx * 6144 + goff;
        const int col0 = u.pn * BM + wc * 32 + 8 * fq;
        const float* rb = xin ? xin + (size_t)((u.pm / 9) * 2048 + (u.pm % 9 - 1) * 256) * 1024 : nullptr;
        bf16_t* wb = X + (size_t)(u.pm * BM) * 1024;
#pragma unroll
        for (int bj = 0; bj < 2; ++bj) { const f32x4 g0 = *(const f32x4*)(gp + col0 + bj * HALF), g1 = *(const f32x4*)(gp + col0 + bj * HALF + 4);
#pragma unroll
            for (int ai = 0; ai < 2; ++ai)
#pragma unroll
                for (int m = 0; m < 4; ++m) { const size_t o = (size_t)(ai * HALF + wr * 64 + m * 16 + fr) * 1024 + col0 + bj * HALF;
                    f32x4 x0, x1;
                    if (rb) { x0 = *(const f32x4*)(rb + o); x1 = *(const f32x4*)(rb + o + 4); }
                    else { const u32x4 w = *(const u32x4*)(wb + o);
                        x0 = (f32x4){__uint_as_float(w.x << 16), __uint_as_float(w.x & 0xffff0000u), __uint_as_float(w.y << 16), __uint_as_float(w.y & 0xffff0000u)};
                        x1 = (f32x4){__uint_as_float(w.z << 16), __uint_as_float(w.z & 0xffff0000u), __uint_as_float(w.w << 16), __uint_as_float(w.w & 0xffff0000u)}; }
                    x0 = x0 + g0 * acc[ai][bj][m][0]; x1 = x1 + g1 * acc[ai][bj][m][1];
                    u32x4 r; r.x = cvt_pk_bf16(x0[0], x0[1]); r.y = cvt_pk_bf16(x0[2], x0[3]); r.z = cvt_pk_bf16(x1[0], x1[1]); r.w = cvt_pk_bf16(x1[2], x1[3]);
                    *(u32x4*)(wb + o) = r; } }
    }
};
template <class Epi, class Sched, bool ALIGN_EPI = false, bool SP2 = false>
__device__ __forceinline__ void gemm_phase(PG8_LAS unsigned char* lds, const Gemm g, const Sched& S, const Epi& E) {
    const int tid = otid(), wid = __builtin_amdgcn_readfirstlane(tid >> 6), lane = tid & 63, wr = wid >> 2, wc = wid & 3, fr = lane & 15, fq = lane >> 4;
    const int K = g.ld, nt = g.K / BK;
    unsigned voffA[2], voffB[2];
#pragma unroll
    for (int i = 0; i < 2; ++i) { int R, C; stage_rc(tid * 16 + i * 8192, R, C); const int Rb = Epi::PERM ? ((R & ~31) + perm32(R & 31)) : R;
        voffA[i] = (unsigned)(R * K + C) * 2u; voffB[i] = (unsigned)(Rb * K + C) * 2u; }
    const size_t kstep = (size_t)(BK * 2);
    const size_t hstep = (size_t)HALF * K * 2;
    const size_t tstep = 2 * hstep;
    const unsigned ldsw = (unsigned)wid * 1024u;
    const int aoff = lds_byte(wr * 64 + fr, fq * 8), boff = lds_byte(wc * 32 + fr, fq * 8);
#define PG8_SA(b, h) (((b) * 2 + (h)) * HTB)
#define PG8_SB(b, h) ((4 + (b) * 2 + (h)) * HTB)
#define PG8_STAGE(bufoff, gbase, voff) do { _Pragma("unroll") for (int _i = 0; _i < 2; ++_i) \
        __builtin_amdgcn_global_load_lds((const unsigned*)((const char*)(gbase) + (voff)[_i]), (PG8_LAS unsigned*)(lds + (bufoff) + ldsw + _i * 8192), 16, 0, 0); } while (0)
#define PG8_LDA(dst, b, h) do { _Pragma("unroll") for (int m = 0; m < 4; ++m) _Pragma("unroll") for (int k = 0; k < 2; ++k) dst[m][k] = *(const PG8_LAS bf16x8*)(lds + PG8_SA(b, h) + aoff + m * 2048 + k * 1024); } while (0)
#define PG8_LDB(dst, b, h) do { _Pragma("unroll") for (int n = 0; n < 2; ++n) _Pragma("unroll") for (int k = 0; k < 2; ++k) dst[n][k] = *(const PG8_LAS bf16x8*)(lds + PG8_SB(b, h) + boff + n * 2048 + k * 1024); } while (0)
#define PG8_MMA(ai, bj, At, Bt) do { __builtin_amdgcn_s_setprio(1); _Pragma("unroll") for (int m = 0; m < 4; ++m) _Pragma("unroll") for (int n = 0; n < 2; ++n) _Pragma("unroll") for (int k = 0; k < 2; ++k) \
        acc[ai][bj][m][n] = __builtin_amdgcn_mfma_f32_16x16x32_bf16(Bt[n][k], At[m][k], acc[ai][bj][m][n], 0, 0, 0); __builtin_amdgcn_s_setprio(0); } while (0)
#define PG8_WAIT_V(n) asm volatile("s_waitcnt vmcnt(" #n ")" ::: "memory")
#define PG8_WAIT_L(n) asm volatile("s_waitcnt lgkmcnt(" #n ")" ::: "memory")
#define PG8_BAR __builtin_amdgcn_s_barrier()
#define PG8_SCHED __builtin_amdgcn_sched_barrier(0)
    Unit cur, nxt; int ui = 0;
    if (!S.next(0, cur)) return;
    f32x4 acc[2][2][4][2];
#pragma unroll
    for (int a = 0; a < 2; ++a)
#pragma unroll
        for (int b = 0; b < 2; ++b)
#pragma unroll
            for (int m = 0; m < 4; ++m)
#pragma unroll
                for (int n = 0; n < 2; ++n) acc[a][b][m][n] = (f32x4){0.f, 0.f, 0.f, 0.f};
    bf16x8 At[4][2], B0[2][2], B1[2][2];
    const char* cA = (const char*)g.A + (size_t)cur.pm * tstep + (size_t)cur.koff * 2; const char* cB = (const char*)g.Bt + (size_t)cur.pn * tstep + (size_t)cur.koff * 2;
    S.a_ready(cur);
    if constexpr (SP2) {
        PG8_STAGE(PG8_SB(0, 0), cB, voffB); PG8_STAGE(PG8_SB(0, 1), cB + hstep, voffB); PG8_STAGE(PG8_SA(0, 0), cA, voffA); PG8_STAGE(PG8_SA(0, 1), cA + hstep, voffA);
        if (wr == 1) PG8_BAR;
        PG8_WAIT_V(2); PG8_BAR;
        PG8_STAGE(PG8_SB(1, 0), cB + kstep, voffB); PG8_STAGE(PG8_SA(1, 0), cA + kstep, voffA); PG8_STAGE(PG8_SB(1, 1), cB + hstep + kstep, voffB);
        PG8_WAIT_V(6); PG8_BAR;
    } else {
        PG8_STAGE(PG8_SB(0, 0), cB, voffB); PG8_STAGE(PG8_SA(0, 0), cA, voffA); PG8_STAGE(PG8_SB(0, 1), cB + hstep, voffB); PG8_STAGE(PG8_SA(0, 1), cA + hstep, voffA);
        if (wr == 1) PG8_BAR;
        PG8_WAIT_V(4); PG8_BAR;
        PG8_STAGE(PG8_SB(1, 0), cB + kstep, voffB); PG8_STAGE(PG8_SA(1, 0), cA + kstep, voffA); PG8_STAGE(PG8_SB(1, 1), cB + hstep + kstep, voffB);
        PG8_WAIT_V(6); PG8_BAR;
    }
    for (;;) {
        const bool has_next = S.next(ui + 1, nxt);
        const char* nA = has_next ? (const char*)g.A + (size_t)nxt.pm * tstep + (size_t)nxt.koff * 2 : cA; const char* nB = has_next ? (const char*)g.Bt + (size_t)nxt.pn * tstep + (size_t)nxt.koff * 2 : cB;
        for (int t = 0; t < nt; t += 2) {
            const bool last = (t == nt - 2);
            const char* a1 = cA + (size_t)(t + 1) * kstep;
            const char* a2 = last ? nA : cA + (size_t)(t + 2) * kstep; const char* b2 = last ? nB : cB + (size_t)(t + 2) * kstep;
            const char* a3 = a2 + kstep; const char* b3 = b2 + kstep;
            if (last && has_next) S.a_ready(nxt);
            if constexpr (SP2) {
            PG8_LDB(B0, 0, 0); PG8_LDB(B1, 0, 1); PG8_SCHED; PG8_LDA(At, 0, 0); PG8_STAGE(PG8_SA(1, 1), a1 + hstep, voffA);
            PG8_WAIT_V(8); PG8_WAIT_L(0); PG8_BAR; PG8_MMA(0, 0, At, B0); PG8_MMA(0, 1, At, B1); PG8_BAR; PG8_SCHED;
            PG8_LDA(At, 0, 1); PG8_STAGE(PG8_SB(0, 0), b2, voffB); PG8_STAGE(PG8_SB(0, 1), b2 + hstep, voffB); PG8_STAGE(PG8_SA(0, 0), a2, voffA);
            PG8_WAIT_V(8); PG8_WAIT_L(0); PG8_BAR; PG8_MMA(1, 0, At, B0); PG8_MMA(1, 1, At, B1); PG8_BAR; PG8_SCHED;
            PG8_LDB(B0, 1, 0); PG8_LDB(B1, 1, 1); PG8_SCHED; PG8_LDA(At, 1, 0); PG8_STAGE(PG8_SA(0, 1), a2 + hstep, voffA);
            PG8_WAIT_V(8); PG8_WAIT_L(0); PG8_BAR; PG8_MMA(0, 0, At, B0); PG8_MMA(0, 1, At, B1); PG8_BAR; PG8_SCHED;
            PG8_LDA(At, 1, 1); PG8_STAGE(PG8_SB(1, 0), b3, voffB); PG8_STAGE(PG8_SB(1, 1), b3 + hstep, voffB); PG8_STAGE(PG8_SA(1, 0), a3, voffA);
            PG8_WAIT_V(8); PG8_WAIT_L(0); PG8_BAR; PG8_MMA(1, 0, At, B0); PG8_MMA(1, 1, At, B1); PG8_BAR; PG8_SCHED;
            } else {
            PG8_LDB(B0, 0, 0); PG8_SCHED; PG8_LDA(At, 0, 0); PG8_STAGE(PG8_SA(1, 1), a1 + hstep, voffA);
            PG8_WAIT_L(8); PG8_BAR; PG8_WAIT_L(0); PG8_MMA(0, 0, At, B0); PG8_BAR; PG8_SCHED;
            PG8_LDB(B1, 0, 1); PG8_STAGE(PG8_SB(0, 0), b2, voffB);
            PG8_BAR; PG8_WAIT_L(0); PG8_MMA(0, 1, At, B1); PG8_BAR;
            PG8_LDA(At, 0, 1); PG8_STAGE(PG8_SA(0, 0), a2, voffA);
            PG8_BAR; PG8_WAIT_L(0); PG8_MMA(1, 0, At, B0); PG8_BAR; PG8_SCHED;
            PG8_STAGE(PG8_SB(0, 1), b2 + hstep, voffB);
            PG8_WAIT_V(6); PG8_BAR; PG8_MMA(1, 1, At, B1); PG8_BAR;
            PG8_LDB(B0, 1, 0); PG8_SCHED; PG8_LDA(At, 1, 0); PG8_STAGE(PG8_SA(0, 1), a2 + hstep, voffA);
            PG8_WAIT_L(8); PG8_BAR; PG8_WAIT_L(0); PG8_MMA(0, 0, At, B0); PG8_BAR; PG8_SCHED;
            PG8_LDB(B1, 1, 1); PG8_STAGE(PG8_SB(1, 0), b3, voffB);
            PG8_BAR; PG8_WAIT_L(0); PG8_MMA(0, 1, At, B1); PG8_BAR;
            PG8_LDA(At, 1, 1); PG8_STAGE(PG8_SA(1, 0), a3, voffA);
            PG8_BAR; PG8_WAIT_L(0); PG8_MMA(1, 0, At, B0); PG8_BAR; PG8_SCHED;
            PG8_STAGE(PG8_SB(1, 1), b3 + hstep, voffB);
            PG8_WAIT_V(6); PG8_BAR; PG8_MMA(1, 1, At, B1); PG8_BAR;
            }
        }
        if constexpr (ALIGN_EPI) { if (wr == 0) PG8_BAR; }
        if constexpr (!Epi::AFTER_DRAIN) { E(acc, cur, wr, wc, fr, fq); S.done(cur); }
        if (!has_next) break;
#pragma unroll
        for (int a = 0; a < 2; ++a)
#pragma unroll
            for (int b = 0; b < 2; ++b)
#pragma unroll
                for (int m = 0; m < 4; ++m)
#pragma unroll
                    for (int n = 0; n < 2; ++n) acc[a][b][m][n] = (f32x4){0.f, 0.f, 0.f, 0.f};
        cur = nxt; cA = nA; cB = nB; ++ui;
        if constexpr (ALIGN_EPI) { if (wr == 1) PG8_BAR; }
    }
    PG8_WAIT_V(0);
    if constexpr (!ALIGN_EPI) { if (wr == 0) PG8_BAR; }
    PG8_BAR;
    if constexpr (Epi::AFTER_DRAIN) { E.fused(acc, cur, wr, wc, fr, fq, lds, wid, lane); S.done(cur); }
#undef PG8_SA
#undef PG8_SB
#undef PG8_STAGE
#undef PG8_LDA
#undef PG8_LDB
#undef PG8_MMA
#undef PG8_WAIT_V
#undef PG8_WAIT_L
#undef PG8_BAR
#undef PG8_SCHED
}
}

typedef unsigned short bf16;
typedef short bf16x8 __attribute__((ext_vector_type(8)));
typedef short s16x4 __attribute__((ext_vector_type(4)));
typedef float f32x4 __attribute__((ext_vector_type(4)));
typedef float f32x16 __attribute__((ext_vector_type(16)));
typedef unsigned u32x4 __attribute__((ext_vector_type(4)));
typedef unsigned u32x2 __attribute__((ext_vector_type(2)));
#define LAS __attribute__((address_space(3)))

constexpr int NB = 8, TPB = 2304, MT = NB * TPB, DM = 1024, NLAT = 2048;
constexpr int NP_E = 3328, NP_O = 3072, FF = 2816;
constexpr float EPSN = 1e-6f;
constexpr size_t MiB = 1u << 20;
constexpr size_t WS_CTL = 0, WS_MOD = 1 * MiB, WS_X = 2 * MiB, WS_H = 74 * MiB, WS_MIX = 110 * MiB, WS_P = 146 * MiB, WS_W = 263 * MiB,
                 WS_OSC = 290 * MiB, WS_KR = 326 * MiB, WS_U = 328 * MiB, WS_T = 342 * MiB, WS_END = 350 * MiB;
constexpr size_t WS_LSUM = 128 * 1024;
constexpr size_t WS_CQN = WS_MIX, WS_CKVN = WS_MIX + 14 * MiB, WS_DSCR = WS_H;
constexpr size_t W_IN = 0, W_OUT = 13 * MiB / 2, W_GU = 17 * MiB / 2, W_DN = 39 * MiB / 2, W_UQ = 25 * MiB, W_UKV = 25 * MiB + 768 * 1024;
constexpr size_t OUT_KV = 0, OUT_Q = 36 * MiB;
constexpr int LDS_MAIN = 131072, LDS_BYTES = LDS_MAIN + 1024 + 2048;

struct Args { const float* in[23]; float* out; unsigned char* ws; int lo, hi; };
typedef __attribute__((address_space(4))) const Args* KArgP;
__device__ __forceinline__ KArgP kargs() { KArgP p = (KArgP)__builtin_amdgcn_kernarg_segment_ptr(); asm volatile("" : "+s"(p)); return p; }

__device__ __forceinline__ float bf2f(unsigned short h) { return __uint_as_float((unsigned)h << 16); }
__device__ __forceinline__ unsigned f2bf(float f) { unsigned u = __float_as_uint(f); return (u + 0x7fffu + ((u >> 16) & 1u)) >> 16; }
__device__ __forceinline__ unsigned pk2(float lo, float hi) { return f2bf(lo) | (f2bf(hi) << 16); }
__device__ __forceinline__ float wave_sum(float v) {
#pragma unroll
    for (int o = 1; o < 64; o <<= 1) v += __shfl_xor(v, o);
    return v;
}
__device__ __forceinline__ float silu_f(float g) { return g / (1.0f + __expf(-g)); }
__device__ __forceinline__ void sincos_r(float ang, float& s, float& c) {
    float r = ang * 0.15915494309189535f; r = r - __builtin_floorf(r);
    s = __builtin_amdgcn_sinf(r); c = __builtin_amdgcn_cosf(r);
}
__device__ __forceinline__ float inv_freq(int i, int half) { return __builtin_amdgcn_exp2f(-(float)i / (float)half * 13.287712379549449f); }

__device__ __forceinline__ void mod_item(KArgP a, int l, int cg, LAS unsigned char* lds) {
    const int tid = otid();
    float* MOD = (float*)(a->ws + WS_MOD);
    LAS float* S = (LAS float*)lds;
    LAS float* R = S + 1024 * 12;
    for (int i = tid; i < 9 * 1024; i += 512) { const int w = i >> 10, k = i & 1023; const float v = (w < 8) ? a->in[1][w * 1024 + k] : a->in[3][k]; S[k * 12 + w] = silu_f(v); }
    __syncthreads();
    const int nl = tid & 63, kp = tid >> 6, n0 = cg * 256;
    f32x4 acc[9];
#pragma unroll
    for (int w = 0; w < 9; ++w) acc[w] = (f32x4){0.f, 0.f, 0.f, 0.f};
    const float* wp = a->in[4] + (size_t)l * 1024 * 6144 + n0 + 4 * nl;
#pragma unroll 8
    for (int k = kp * 128; k < kp * 128 + 128; ++k) {
        const f32x4 wv = *(const f32x4*)(wp + (size_t)k * 6144);
        const f32x4 s0 = *(const LAS f32x4*)(S + k * 12), s1 = *(const LAS f32x4*)(S + k * 12 + 4); const float s8 = S[k * 12 + 8];
        acc[0] += wv * s0[0]; acc[1] += wv * s0[1]; acc[2] += wv * s0[2]; acc[3] += wv * s0[3];
        acc[4] += wv * s1[0]; acc[5] += wv * s1[1]; acc[6] += wv * s1[2]; acc[7] += wv * s1[3]; acc[8] += wv * s8;
    }
#pragma unroll
    for (int w = 0; w < 9; ++w) *(LAS f32x4*)(R + (kp * 9 + w) * 256 + 4 * nl) = acc[w];
    __syncthreads();
    for (int i = tid; i < 9 * 256; i += 512) { const int w = i >> 8, n2 = i & 255; float v = a->in[5][l * 6144 + n0 + n2];
#pragma unroll
        for (int p = 0; p < 8; ++p) v += R[(p * 9 + w) * 256 + n2];
        MOD[(size_t)(l * 9 + w) * 6144 + n0 + n2] = v; }
    __syncthreads();
}
__device__ __forceinline__ void convert_weights(KArgP a, int layer, LAS unsigned char* lds, int part, int gw, int NGW);
__device__ __forceinline__ void phase_prep(KArgP a, LAS unsigned char* lds) {
    const int tid = otid(), G = gridDim.x;
    if (blockIdx.x == 0) { if (tid < 64) ((unsigned*)(a->ws + WS_CTL))[tid] = 0u; for (int i = tid; i < 3456; i += 512) ((unsigned*)(a->ws + WS_CTL))[4096 + i] = 0u; }
    for (int item = blockIdx.x; item < 96; item += G) mod_item(a, item / 24, item % 24, lds);
    if ((int)blockIdx.x >= 96 && G > 96) {
        convert_weights(a, 0, lds, 0, ((int)blockIdx.x - 96) * 8 + (otid() >> 6), (G - 96) * 8); convert_weights(a, 0, lds, 1, ((int)blockIdx.x - 96) * 8 + (otid() >> 6), (G - 96) * 8); }
}

__device__ __forceinline__ void transpose_item(const float* W, int K, int N, bf16* WT, int k0, int n0, int drow0, LAS float* scr, int lane) {
    float tv_[32];
#pragma unroll
    for (int i = 0; i < 32; ++i) { const int kk = 2 * i + (lane >> 5); tv_[i] = W[(size_t)(k0 + kk) * N + n0 + (lane & 31)]; }
#pragma unroll
    for (int i = 0; i < 32; ++i) { const int kk = 2 * i + (lane >> 5); scr[kk * 33 + (lane & 31)] = tv_[i]; }
    asm volatile("s_waitcnt lgkmcnt(0)" ::: "memory");
    const int c = lane & 7;
#pragma unroll
    for (int j = 0; j < 4; ++j) { const int n = (lane >> 3) + 8 * j; const LAS float* s = scr + (8 * c) * 33 + n;
        u32x4 o; o.x = pk2(s[0 * 33], s[1 * 33]); o.y = pk2(s[2 * 33], s[3 * 33]); o.z = pk2(s[4 * 33], s[5 * 33]); o.w = pk2(s[6 * 33], s[7 * 33]);
        *(u32x4*)(WT + (size_t)(drow0 + n) * K + k0 + 8 * c) = o; }
    asm volatile("s_waitcnt lgkmcnt(0)" ::: "memory");
}
__device__ __forceinline__ void convert_weights(KArgP a, int layer, LAS unsigned char* lds, int part, int gw, int NGW) {
    const int lane = otid() & 63, wave = otid() >> 6;
    LAS float* scr = (LAS float*)(lds + wave * 8448);
    const bool even = !(layer & 1); const int e = layer >> 1;
    unsigned char* Wb = a->ws + WS_W;
    if (part == 0) {
        const int nin = even ? 3232 : 3072;
        const float* w_in = even ? a->in[11] + (size_t)e * 1024 * 3232 : a->in[18] + (size_t)e * 1024 * 3072;
        const int nbin = nin / 32;
        const int I_IN = 16 * nbin, I_OUT = 512, I_UQ = even ? 6 * 24 : 0, I_UKV = even ? 4 * 32 : 0;
        const int NIT = I_IN + I_OUT + I_UQ + I_UKV;
        for (int it = gw; it < NIT; it += NGW) {
            int r = it;
            if (r < I_IN) { const int kb = r / nbin, nb = r % nbin; transpose_item(w_in, 1024, nin, (bf16*)(Wb + W_IN), 64 * kb, 32 * nb, 32 * nb, scr, lane); continue; } r -= I_IN;
            if (r < I_OUT) { const int kb = r / 32, nb = r % 32; transpose_item(a->in[7] + (size_t)layer * 1024 * 1024, 1024, 1024, (bf16*)(Wb + W_OUT), 64 * kb, 32 * nb, 32 * nb, scr, lane); continue; } r -= I_OUT;
            if (r < I_UQ) { const int kb = r / 24, nb = r % 24; transpose_item(a->in[15] + (size_t)e * 384 * 768, 384, 768, (bf16*)(Wb + W_UQ), 64 * kb, 32 * nb, 32 * nb, scr, lane); continue; } r -= I_UQ;
            { const int kb = r / 32, nb = r % 32; transpose_item(a->in[17] + (size_t)e * 256 * 1024, 256, 1024, (bf16*)(Wb + W_UKV), 64 * kb, 32 * nb, 32 * nb, scr, lane); }
        }
    } else {
        constexpr int I_G = 16 * 88, I_D = 44 * 32;
        for (int it = gw; it < 2 * I_G + I_D; it += NGW) {
            int r = it;
            if (r < I_G) { const int kb = r / 88, nb = r % 88, n0 = 32 * nb; transpose_item(a->in[8] + (size_t)layer * 1024 * FF, 1024, FF, (bf16*)(Wb + W_GU), 64 * kb, n0, (n0 >> 7) * 256 + (n0 & 127), scr, lane); continue; } r -= I_G;
            if (r < I_G) { const int kb = r / 88, nb = r % 88, n0 = 32 * nb; transpose_item(a->in[9] + (size_t)layer * 1024 * FF, 1024, FF, (bf16*)(Wb + W_GU), 64 * kb, n0, (n0 >> 7) * 256 + 128 + (n0 & 127), scr, lane); continue; } r -= I_G;
            { const int kb = r / 32, nb = r % 32; transpose_item(a->in[10] + (size_t)layer * FF * 1024, FF, 1024, (bf16*)(Wb + W_DN), 64 * kb, 32 * nb, 32 * nb, scr, lane); }
        }
    }
}

__device__ __forceinline__ f32x4 ld4_bf16(const bf16* p) { const u32x2 w = *(const u32x2*)p; return (f32x4){__uint_as_float(w.x << 16), __uint_as_float(w.x & 0xffff0000u), __uint_as_float(w.y << 16), __uint_as_float(w.y & 0xffff0000u)}; }
__device__ __forceinline__ void phase_norm(KArgP a, int layer, int which, bool addT) {
    const int lane = otid() & 63, wave = otid() >> 6;
    const int gw = blockIdx.x * 8 + wave, NGW = gridDim.x * 8;
    bf16* X = (bf16*)(a->ws + WS_X); bf16* H = (bf16*)(a->ws + WS_H); const float* T = (const float*)(a->ws + WS_T);
    const float* g = a->in[6] + (layer * 2 + which) * 1024;
    const float* mod = (const float*)(a->ws + WS_MOD) + (size_t)layer * 9 * 6144;
    const int shoff = which ? 3072 : 0, scoff = which ? 4096 : 1024;
    const bool from_inputs = (layer == 0 && which == 0);
    constexpr int RB = 3;
    for (int r0 = gw; r0 < MT; r0 += RB * NGW) {
        f32x4 v[RB][4];
#pragma unroll
        for (int k = 0; k < RB; ++k) { const int row = r0 + k * NGW; if (row < MT) {
            if (from_inputs) { const int b = row / TPB, j = row - b * TPB; const float* xr = (j < 256 ? a->in[2] + (size_t)(b * 256 + j) * 1024 : a->in[0] + (size_t)(b * NLAT + j - 256) * 1024) + 8 * lane;
#pragma unroll
                for (int q = 0; q < 2; ++q) { v[k][2 * q] = *(const f32x4*)(xr + 512 * q); v[k][2 * q + 1] = *(const f32x4*)(xr + 512 * q + 4); } }
            else {
#pragma unroll
                for (int q = 0; q < 2; ++q) { const u32x4 w = *(const u32x4*)(X + (size_t)row * 1024 + 8 * lane + 512 * q);
                    v[k][2 * q] = (f32x4){__uint_as_float(w.x << 16), __uint_as_float(w.x & 0xffff0000u), __uint_as_float(w.y << 16), __uint_as_float(w.y & 0xffff0000u)};
                    v[k][2 * q + 1] = (f32x4){__uint_as_float(w.z << 16), __uint_as_float(w.z & 0xffff0000u), __uint_as_float(w.w << 16), __uint_as_float(w.w & 0xffff0000u)}; } } } }
#pragma unroll
        for (int k = 0; k < RB; ++k) { const int row = r0 + k * NGW; if (row < MT) {
            const int b = row / TPB, j = row - b * TPB, widx = (j < 256) ? 8 : b;
            if (addT && j < 256) { const float* tr = T + (size_t)(b * 256 + j) * 1024 + 8 * lane;
#pragma unroll
                for (int q = 0; q < 2; ++q) { v[k][2 * q] = v[k][2 * q] + *(const f32x4*)(tr + 512 * q); v[k][2 * q + 1] = v[k][2 * q + 1] + *(const f32x4*)(tr + 512 * q + 4);
                    u32x4 w; w.x = pk2(v[k][2 * q][0], v[k][2 * q][1]); w.y = pk2(v[k][2 * q][2], v[k][2 * q][3]); w.z = pk2(v[k][2 * q + 1][0], v[k][2 * q + 1][1]); w.w = pk2(v[k][2 * q + 1][2], v[k][2 * q + 1][3]);
                    *(u32x4*)(X + (size_t)row * 1024 + 8 * lane + 512 * q) = w; } }
            float ss = 0.f;
#pragma unroll
            for (int q = 0; q < 4; ++q) ss += (v[k][q][0] * v[k][q][0] + v[k][q][1] * v[k][q][1]) + (v[k][q][2] * v[k][q][2] + v[k][q][3] * v[k][q][3]);
            const float rstd = __builtin_amdgcn_rsqf(wave_sum(ss) * (1.f / 1024.f) + EPSN);
#pragma unroll
            for (int q = 0; q < 2; ++q) { const int col = 8 * lane + 512 * q; f32x4 y[2];
#pragma unroll
                for (int hh = 0; hh < 2; ++hh) { const f32x4 gv = *(const f32x4*)(g + col + 4 * hh), sc = *(const f32x4*)(mod + widx * 6144 + scoff + col + 4 * hh), sh = *(const f32x4*)(mod + widx * 6144 + shoff + col + 4 * hh);
                    y[hh] = v[k][2 * q + hh] * rstd * gv * (sc + 1.0f) + sh; }
                u32x4 w; w.x = pk2(y[0][0], y[0][1]); w.y = pk2(y[0][2], y[0][3]); w.z = pk2(y[1][0], y[1][1]); w.w = pk2(y[1][2], y[1][3]);
                { bf16* sp_ = H + (size_t)row * 1024 + col; asm volatile("global_store_dwordx4 %0, %1, off sc1\n\ts_nop 1" :: "v"(sp_), "v"(w) : "memory"); } } } }
    }
}

__device__ __forceinline__ void phase_post_even(KArgP a, int layer) {
    const int lane = otid() & 63, wave = otid() >> 6;
    const int gw = blockIdx.x * 8 + wave, NGW = gridDim.x * 8, e = layer >> 1;
    const bf16* P = (const bf16*)(a->ws + WS_P); bf16* CQN = (bf16*)(a->ws + WS_CQN); bf16* CKVN = (bf16*)(a->ws + WS_CKVN); bf16* KR = (bf16*)(a->ws + WS_KR);
    const float* qg = a->in[14] + e * 384; const float* kg = a->in[16] + e * 256;
    for (int row = gw; row < MT; row += NGW) {
        const int b = row / TPB, j = row - b * TPB;
        const bf16* pr = P + (size_t)row * NP_E;
        {   float x[6]; float ss = 0.f;
#pragma unroll
            for (int k = 0; k < 3; ++k) { const unsigned w = *(const unsigned*)(pr + 2560 + 2 * lane + 128 * k); x[2 * k] = bf2f((unsigned short)(w & 0xffff)); x[2 * k + 1] = bf2f((unsigned short)(w >> 16)); ss += x[2 * k] * x[2 * k] + x[2 * k + 1] * x[2 * k + 1]; }
            const float rstd = __builtin_amdgcn_rsqf(wave_sum(ss) * (1.f / 384.f) + EPSN);
#pragma unroll
            for (int k = 0; k < 3; ++k) { const int col = 2 * lane + 128 * k; *(unsigned*)(CQN + (size_t)row * 384 + col) = pk2(x[2 * k] * rstd * qg[col], x[2 * k + 1] * rstd * qg[col + 1]); } }
        {   float x[4]; float ss = 0.f;
#pragma unroll
            for (int k = 0; k < 2; ++k) { const unsigned w = *(const unsigned*)(pr + 2944 + 2 * lane + 128 * k); x[2 * k] = bf2f((unsigned short)(w & 0xffff)); x[2 * k + 1] = bf2f((unsigned short)(w >> 16)); ss += x[2 * k] * x[2 * k] + x[2 * k + 1] * x[2 * k + 1]; }
            const float rstd = __builtin_amdgcn_rsqf(wave_sum(ss) * (1.f / 256.f) + EPSN);
#pragma unroll
            for (int k = 0; k < 2; ++k) { const int col = 2 * lane + 128 * k; *(unsigned*)(CKVN + (size_t)row * 256 + col) = pk2(x[2 * k] * rstd * kg[col], x[2 * k + 1] * rstd * kg[col + 1]); } }
        {   const int d = lane & 31; const float x = bf2f(pr[3200 + d]); const float xp = __shfl_xor(x, 8);
            float o = x;
            if (j >= 256) { const int t = j - 256, blk = d >> 4, wi = d & 15, i8 = wi & 7; const float pos = (float)(blk ? (t & 63) : (t >> 6));
                float s, c; sincos_r(pos * inv_freq(i8, 8), s, c);
                o = (wi < 8) ? (x * c - xp * s) : (xp * s + x * c); }
            if (lane < 32) KR[(size_t)row * 32 + d] = (bf16)f2bf(o); }
    }
}
__device__ __forceinline__ void phase_post_odd(KArgP a, int layer) {
    const int lane = otid() & 63, wave = otid() >> 6;
    const int gw = blockIdx.x * 8 + wave, NGW = gridDim.x * 8;
    bf16* P = (bf16*)(a->ws + WS_P);
    for (int row = gw; row < MT; row += NGW) {
        const int b = row / TPB, j = row - b * TPB; const bool lat = j >= 256; const int t = j - 256;
        bf16* pr = P + (size_t)row * NP_O;
#pragma unroll
        for (int u = 0; u < 2; ++u) { const int pid = lane + 64 * u, h = pid >> 5, i = pid & 31, d1 = h * 64 + i, d2 = d1 + 32;
            float s = 0.f, c = 1.f; if (lat) sincos_r((float)t * inv_freq(i, 32), s, c);
            const float q1 = bf2f(pr[d1]), q2 = bf2f(pr[d2]), k1 = bf2f(pr[256 + d1]) * 0.125f, k2 = bf2f(pr[256 + d2]) * 0.125f;
            if (lat) { pr[d1] = (bf16)f2bf(q1 * c - q2 * s); pr[d2] = (bf16)f2bf(q1 * s + q2 * c); }
            pr[256 + d1] = (bf16)f2bf(k1 * c - k2 * s); pr[256 + d2] = (bf16)f2bf(k1 * s + k2 * c); }
        if (lat) {
#pragma unroll
            for (int u = 0; u < 4; ++u) { const int pid = lane + 64 * u, vec = pid >> 5, pp = pid & 31, blk = pp >> 4, i = pp & 15, d1 = vec * 64 + blk * 32 + i, d2 = d1 + 16;
                const float pos = (float)(blk ? (t & 63) : (t >> 6)); float s, c; sincos_r(pos * inv_freq(i, 16), s, c);
                const float q1 = bf2f(pr[1536 + d1]), q2 = bf2f(pr[1536 + d2]), k1 = bf2f(pr[2048 + d1]), k2 = bf2f(pr[2048 + d2]);
                pr[1536 + d1] = (bf16)f2bf(q1 * c - q2 * s); pr[1536 + d2] = (bf16)f2bf(q1 * s + q2 * c);
                pr[2048 + d1] = (bf16)f2bf(k1 * c - k2 * s); pr[2048 + d2] = (bf16)f2bf(k1 * s + k2 * c); } }
    }
}

__device__ __forceinline__ void phase_readout(KArgP a, int layer) {
    const int lane = otid() & 63, wave = otid() >> 6;
    const int gw = blockIdx.x * 8 + wave, NGW = gridDim.x * 8;
    const bool even = !(layer & 1); const int np = even ? NP_E : NP_O, gcol = even ? 2048 : 1024;
    const bf16* P = (const bf16*)(a->ws + WS_P); const bf16* OF = (const bf16*)(a->ws + WS_OSC); const bf16* OB = OF + (size_t)MT * 512;
    bf16* MIX = (bf16*)(a->ws + WS_MIX);
    float g0 = 1.f, g1 = 1.f; if (even) { g0 = a->in[13][(layer >> 1) * 128 + 2 * lane]; g1 = a->in[13][(layer >> 1) * 128 + 2 * lane + 1]; }
    constexpr int RB = 3;
    for (int r0 = gw; r0 < MT; r0 += RB * NGW) {
        unsigned wf[RB][4], wb[RB][4], wg[RB][4];
#pragma unroll
        for (int k = 0; k < RB; ++k) { const int row = r0 + k * NGW; if (row < MT) {
#pragma unroll
            for (int h = 0; h < 4; ++h) { const int col = h * 128 + 2 * lane;
                wf[k][h] = *(const unsigned*)(OF + (size_t)row * 512 + col); wb[k][h] = *(const unsigned*)(OB + (size_t)row * 512 + col); wg[k][h] = *(const unsigned*)(P + (size_t)row * np + gcol + col); } } }
#pragma unroll
        for (int k = 0; k < RB; ++k) { const int row = r0 + k * NGW; if (row < MT) {
#pragma unroll
            for (int h = 0; h < 4; ++h) { const int col = h * 128 + 2 * lane;
                const float o0 = bf2f((unsigned short)(wf[k][h] & 0xffff)) + bf2f((unsigned short)(wb[k][h] & 0xffff)), o1 = bf2f((unsigned short)(wf[k][h] >> 16)) + bf2f((unsigned short)(wb[k][h] >> 16));
                const float rstd = __builtin_amdgcn_rsqf(wave_sum(o0 * o0 + o1 * o1) * (1.f / 128.f) + EPSN);
                const float y0 = o0 * rstd * g0 * silu_f(bf2f((unsigned short)(wg[k][h] & 0xffff))), y1 = o1 * rstd * g1 * silu_f(bf2f((unsigned short)(wg[k][h] >> 16)));
                *(unsigned*)(MIX + (size_t)row * 1024 + col) = pk2(y0, y1); } } }
    }
}
__device__ __forceinline__ void phase_final(KArgP a) {
    const int lane = otid() & 63, wave = otid() >> 6;
    const int gw = blockIdx.x * 8 + wave, NGW = gridDim.x * 8;
    const bf16* X = (const bf16*)(a->ws + WS_X); const float* g = a->in[22];
    constexpr int RB = 4;
    for (int r0 = gw; r0 < NB * NLAT; r0 += RB * NGW) {
        f32x4 v[RB][4];
#pragma unroll
        for (int k = 0; k < RB; ++k) { const int r = r0 + k * NGW; if (r < NB * NLAT) { const int row = (r >> 11) * TPB + 256 + (r & 2047);
#pragma unroll
            for (int q = 0; q < 4; ++q) v[k][q] = ld4_bf16(X + (size_t)row * 1024 + 4 * lane + 256 * q); } }
#pragma unroll
        for (int k = 0; k < RB; ++k) { const int r = r0 + k * NGW; if (r < NB * NLAT) { float ss = 0.f;
#pragma unroll
            for (int q = 0; q < 4; ++q) ss += (v[k][q][0] * v[k][q][0] + v[k][q][1] * v[k][q][1]) + (v[k][q][2] * v[k][q][2] + v[k][q][3] * v[k][q][3]);
            const float rstd = __builtin_amdgcn_rsqf(wave_sum(ss) * (1.f / 1024.f) + EPSN);
#pragma unroll
            for (int q = 0; q < 4; ++q) { const int col = 4 * lane + 256 * q; const f32x4 gv = *(const f32x4*)(g + col);
                *(f32x4*)(a->out + (size_t)r * 1024 + col) = v[k][q] * rstd * gv; } } }
    }
}
__device__ __forceinline__ unsigned cvtpk2(float lo, float hi) { unsigned r; asm("v_cvt_pk_bf16_f32 %0, %1, %2" : "=v"(r) : "v"(lo), "v"(hi)); return r; }
__device__ __forceinline__ f32x4 mfma16(bf16x8 a, bf16x8 b, f32x4 c) { return __builtin_amdgcn_mfma_f32_16x16x32_bf16(a, b, c, 0, 0, 0); }

template <int DK, bool HG, int MODE>
__device__ __forceinline__ void scan_item(KArgP a, int layer, int item, int seg, LAS unsigned char* lds) {
    const int tid = otid(), wid = tid >> 6, lane = tid & 63, l15 = lane & 15, q4 = lane >> 4;
    const int h = item & 3, dir = (item >> 2) & 1, b = item >> 3;
    constexpr int TPT = DK / 8, QS = DK * 2 + 16, TS = 144;
    constexpr int NP = HG ? NP_E : NP_O;
    LAS unsigned char* Lqt = lds; LAS unsigned char* Lkt = Lqt + 64 * QS; LAS unsigned char* Lqh = Lkt + 64 * QS;
    LAS unsigned char* LkhT = Lqh + 64 * QS; LAS unsigned char* LvT = LkhT + DK * TS; LAS unsigned char* Latt = LvT + 128 * TS;
    LAS float* Ltot = (LAS float*)(Latt + 64 * TS); LAS float* Lbl = Ltot + 512;
    const bf16* P = (const bf16*)(a->ws + WS_P);
    bf16* OSC = (bf16*)(a->ws + WS_OSC) + (size_t)dir * MT * 512;
    f32x4* Ub = (f32x4*)(a->ws + WS_U); float* Lb = (float*)(a->ws + WS_LSUM);
    const int c = tid & (DK - 1), tq = tid / DK;
    float lb = 0.f, lg = 0.f, qscale = 1.f; int qcol, zcol;
    if (HG) { qscale = 0.08838834764831845f; qcol = h * 128 + c; zcol = (dir ? 1536 : 1024) + h * 128 + c;
        if (layer >= 2) { const float l0 = a->in[12][(0 * 2 + dir) * 512 + h * 128 + c], l1 = a->in[12][(1 * 2 + dir) * 512 + h * 128 + c]; lb = 1.f / (1.f + __expf(l0 - l1)); } }
    else { qcol = h * 64 + c; zcol = 256 + h * 64 + c; const float x = a->in[19][((layer >> 1) * 2 + dir) * 4 + h]; lg = -__logf(1.f + __expf(-x)); }
    const int vcol = 512 + h * 128;
    const int rowbase = b * TPB;
    const int tv = lane, c8v = wid;
    unsigned short rq[TPT], rz[TPT]; bf16x8 rv[2];
#define SC_JB(ci) (dir ? ((ci) < 4 ? 255 - 64 * (ci) : 2303 - 64 * ((ci) - 4)) : 64 * (ci))
#define SC_LOAD(ci) do { const int jb_ = SC_JB(ci), sg_ = dir ? -1 : 1; \
        _Pragma("unroll") for (int i = 0; i < TPT; ++i) { const bf16* pr_ = P + (size_t)(rowbase + jb_ + sg_ * (tq * TPT + i)) * NP; if (MODE) rq[i] = pr_[qcol]; rz[i] = pr_[zcol]; } \
        { const bf16* pv_ = P + (size_t)(rowbase + jb_ + sg_ * tv) * NP + vcol; rv[0] = *(const bf16x8*)(pv_ + c8v * 8); rv[1] = *(const bf16x8*)(pv_ + (c8v + 8) * 8); } } while (0)
    f32x4 Sacc[DK / 16];
#pragma unroll
    for (int i = 0; i < DK / 16; ++i) Sacc[i] = (f32x4){0.f, 0.f, 0.f, 0.f};
    const int c0 = 9 * seg;
    SC_LOAD(c0);
    if (MODE) {
        for (int s_ = 0; s_ < seg; ++s_) {
#pragma unroll
            for (int i = 0; i < DK / 16; ++i) { f32x4 v = Sacc[i];
                if (s_ > 0) { const f32x4 l4 = *(const f32x4*)(Lb + (size_t)(item * 3 + s_) * 128 + 16 * i + 4 * q4); v[0] *= __expf(l4[0]); v[1] *= __expf(l4[1]); v[2] *= __expf(l4[2]); v[3] *= __expf(l4[3]); }
                Sacc[i] = v + Ub[((size_t)(item * 3 + s_) * (DK / 16) + i) * 512 + tid]; }
        }
    }
    float lsum = 0.f;
    for (int ci = c0; ci < c0 + 9; ++ci) {
#pragma unroll
        for (int u = 0; u < 2; ++u)
#pragma unroll
            for (int e = 0; e < 8; ++e) *(LAS unsigned short*)(LvT + ((c8v + 8 * u) * 8 + e) * TS + tv * 2) = (unsigned short)rv[u][e];
        float zf[TPT], qf[TPT];
#pragma unroll
        for (int i = 0; i < TPT; ++i) { zf[i] = bf2f(rz[i]); if (MODE) qf[i] = bf2f(rq[i]) * qscale; }
        const int jb = SC_JB(ci), sg = dir ? -1 : 1;
        if (ci + 1 < c0 + 9) SC_LOAD(ci + 1);
        float kk_[TPT], e1v[TPT], e2v[TPT]; float Eref, Ebr, dlast;
        if (HG) {
            float fv[TPT];
#pragma unroll
            for (int i = 0; i < TPT; ++i) { const float z = fminf(fmaxf(zf[i], -30.f), 30.f);
                const float t = __expf(-fabsf(z)), r = __builtin_amdgcn_rcpf(1.f + t), tr = t * r;
                const float sig = z >= 0.f ? r : tr, sigm = z >= 0.f ? tr : r;
                kk_[i] = (1.f - lb) * sigm; fv[i] = lb + (1.f - lb) * sig; }
            float run = 1.f;
            if (tq < 2) {
#pragma unroll
                for (int i = TPT - 1; i >= 0; --i) { e2v[i] = run; run *= fv[i]; }
            } else {
#pragma unroll
                for (int i = 0; i < TPT; ++i) { run *= fv[i]; e1v[i] = run; }
            }
            Ltot[tq * 128 + c] = run;
            __syncthreads();
            const float t0 = Ltot[c], t1 = Ltot[128 + c], t2 = Ltot[256 + c], t3 = Ltot[384 + c];
            Eref = t0 * t1; Ebr = t2 * t3; dlast = Eref * Ebr;
            const float mul = (tq == 0) ? t1 : ((tq == 3) ? t2 : 1.f);
            if (tq < 2) {
#pragma unroll
                for (int i = 0; i < TPT; ++i) { e2v[i] = fmaxf(e2v[i] * mul, 1e-30f); if (MODE) e1v[i] = __builtin_amdgcn_rcpf(e2v[i]); }
            } else {
#pragma unroll
                for (int i = 0; i < TPT; ++i) { e1v[i] = fmaxf(e1v[i] * mul, 1e-30f); e2v[i] = __builtin_amdgcn_rcpf(e1v[i]); }
            }
            lsum += __logf(fmaxf(dlast, 1e-37f));
        } else {
#pragma unroll
            for (int i = 0; i < TPT; ++i) { kk_[i] = zf[i]; e1v[i] = __expf((float)(tq * TPT + i - 31) * lg); e2v[i] = __builtin_amdgcn_rcpf(e1v[i]); }
            Eref = __expf(32.f * lg); Ebr = Eref; dlast = Eref * Ebr;
            lsum += 64.f * lg;
        }
        unsigned short kh[TPT];
        if (MODE) {
#pragma unroll
            for (int i = 0; i < TPT; ++i) { const int tau = tq * TPT + i;
                const float qt = qf[i] * e1v[i], kt = kk_[i] * e2v[i];
                const unsigned wq = cvtpk2(qt, qt * Eref), wk = cvtpk2(kt, kt * Ebr);
                *(LAS unsigned short*)(Lqt + tau * QS + c * 2) = (unsigned short)(wq & 0xffff);
                *(LAS unsigned short*)(Lqh + tau * QS + c * 2) = (unsigned short)(wq >> 16);
                *(LAS unsigned short*)(Lkt + tau * QS + c * 2) = (unsigned short)(wk & 0xffff);
                kh[i] = (unsigned short)(wk >> 16); }
        } else {
#pragma unroll
            for (int i = 0; i < TPT; ++i) kh[i] = (unsigned short)(cvtpk2(kk_[i] * e2v[i] * Ebr, 0.f) & 0xffff);
        }
#pragma unroll
        for (int i8 = 0; i8 < TPT / 8; ++i8) { u32x4 w; w.x = kh[8 * i8] | ((unsigned)kh[8 * i8 + 1] << 16); w.y = kh[8 * i8 + 2] | ((unsigned)kh[8 * i8 + 3] << 16);
            w.z = kh[8 * i8 + 4] | ((unsigned)kh[8 * i8 + 5] << 16); w.w = kh[8 * i8 + 6] | ((unsigned)kh[8 * i8 + 7] << 16);
            *(LAS u32x4*)(LkhT + c * TS + (tq * TPT + 8 * i8) * 2) = w; }
        if (tq == 0) Lbl[c] = dlast;
        __syncthreads();
        const int dvl = 16 * wid + l15;
        const bf16x8 bv0 = *(const LAS bf16x8*)(LvT + dvl * TS + (8 * q4) * 2), bv1 = *(const LAS bf16x8*)(LvT + dvl * TS + (32 + 8 * q4) * 2);
        if (MODE) {
#pragma unroll
            for (int tt = 0; tt < 2; ++tt) { const int idx = 2 * wid + tt, si = idx >> 2, ti = idx & 3;
                f32x4 acc = (f32x4){0.f, 0.f, 0.f, 0.f};
#pragma unroll
                for (int kk = 0; kk < DK / 32; ++kk) { const bf16x8 A = *(const LAS bf16x8*)(Lkt + (16 * si + l15) * QS + (32 * kk + 8 * q4) * 2);
                    const bf16x8 B = *(const LAS bf16x8*)(Lqt + (16 * ti + l15) * QS + (32 * kk + 8 * q4) * 2); acc = mfma16(A, B, acc); }
                const int t = 16 * ti + l15, s0 = 16 * si + 4 * q4;
                u32x2 w; w.x = pk2(s0 + 0 <= t ? acc[0] : 0.f, s0 + 1 <= t ? acc[1] : 0.f); w.y = pk2(s0 + 2 <= t ? acc[2] : 0.f, s0 + 3 <= t ? acc[3] : 0.f);
                *(LAS u32x2*)(Latt + t * TS + s0 * 2) = w; }
            __syncthreads();
            bf16x8 Sb[DK / 32];
#pragma unroll
            for (int kk = 0; kk < DK / 32; ++kk) { u32x4 w; w.x = pk2(Sacc[2 * kk][0], Sacc[2 * kk][1]); w.y = pk2(Sacc[2 * kk][2], Sacc[2 * kk][3]);
                w.z = pk2(Sacc[2 * kk + 1][0], Sacc[2 * kk + 1][1]); w.w = pk2(Sacc[2 * kk + 1][2], Sacc[2 * kk + 1][3]); Sb[kk] = __builtin_bit_cast(bf16x8, w); }
#pragma unroll
            for (int ti = 0; ti < 4; ++ti) {
                f32x4 acc = (f32x4){0.f, 0.f, 0.f, 0.f};
                { const bf16x8 A = *(const LAS bf16x8*)(Latt + (16 * ti + l15) * TS + (8 * q4) * 2); acc = mfma16(A, bv0, acc); }
                if (ti >= 2) { const bf16x8 A = *(const LAS bf16x8*)(Latt + (16 * ti + l15) * TS + (32 + 8 * q4) * 2); acc = mfma16(A, bv1, acc); }
#pragma unroll
                for (int kk = 0; kk < DK / 32; ++kk) {
                    const s16x4 lo = *(const LAS s16x4*)(Lqh + (16 * ti + l15) * QS + (32 * kk + 4 * q4) * 2), hi = *(const LAS s16x4*)(Lqh + (16 * ti + l15) * QS + (32 * kk + 16 + 4 * q4) * 2);
                    const bf16x8 A = (bf16x8){lo[0], lo[1], lo[2], lo[3], hi[0], hi[1], hi[2], hi[3]};
                    acc = mfma16(A, Sb[kk], acc); }
#pragma unroll
                for (int r = 0; r < 4; ++r) { const int t = 16 * ti + 4 * q4 + r;
                    OSC[(size_t)(rowbase + jb + sg * t) * 512 + h * 128 + dvl] = (bf16)f2bf(acc[r]); }
            }
        }
#pragma unroll
        for (int i = 0; i < DK / 16; ++i) {
            const f32x4 d4 = *(const LAS f32x4*)(Lbl + 16 * i + 4 * q4);
            f32x4 s = Sacc[i] * d4;
            const bf16x8 A0 = *(const LAS bf16x8*)(LkhT + (16 * i + l15) * TS + (8 * q4) * 2), A1 = *(const LAS bf16x8*)(LkhT + (16 * i + l15) * TS + (32 + 8 * q4) * 2);
            s = mfma16(A0, bv0, s); s = mfma16(A1, bv1, s); Sacc[i] = s; }
        __syncthreads();
    }
    if (!MODE) {
#pragma unroll
        for (int i = 0; i < DK / 16; ++i) Ub[((size_t)(item * 3 + seg) * (DK / 16) + i) * 512 + tid] = Sacc[i];
        if (tq == 0) Lb[(size_t)(item * 3 + seg) * 128 + c] = lsum;
    }
#undef SC_JB
#undef SC_LOAD
}

#define SBAR() __builtin_amdgcn_sched_barrier(0)
__device__ __forceinline__ int crow(int r, int hi) { return (r & 3) + 8 * (r >> 2) + 4 * hi; }
__device__ __forceinline__ unsigned cvtpk(float lo, float hi) { unsigned r; asm volatile("v_cvt_pk_bf16_f32 %0, %1, %2" : "=v"(r) : "v"(lo), "v"(hi)); return r; }
__device__ __forceinline__ void partialSM(f32x16& p0, f32x16& p1, float& m_reg, float& mn, float& alpha, float C, float thr_raw) {
    float pmax = p0[0];
#pragma unroll
    for (int r = 1; r < 16; ++r) pmax = fmaxf(pmax, p0[r]);
#pragma unroll
    for (int r = 0; r < 16; ++r) pmax = fmaxf(pmax, p1[r]);
    { auto rr = __builtin_amdgcn_permlane32_swap(__float_as_uint(pmax), __float_as_uint(pmax), false, false);
      pmax = fmaxf(__uint_as_float(rr[0]), __uint_as_float(rr[1])); }
    if (__builtin_expect(__all(pmax - m_reg <= thr_raw), 1)) { mn = m_reg; alpha = 1.f; }
    else { mn = fmaxf(m_reg, pmax); alpha = __builtin_amdgcn_exp2f((m_reg - mn) * C); m_reg = mn; }
    const float mnC = -mn * C;
#pragma unroll
    for (int r = 0; r < 16; ++r) p0[r] = fmaf(p0[r], C, mnC);
#pragma unroll
    for (int r = 0; r < 16; ++r) p1[r] = fmaf(p1[r], C, mnC);
#pragma unroll
    for (int r = 0; r < 16; ++r) p0[r] = __builtin_amdgcn_exp2f(p0[r]);
}
__device__ __forceinline__ void finishSM(f32x16& p0, f32x16& p1, float alpha, float& l_reg, bf16x8& pa0, bf16x8& pa1, bf16x8& pa2, bf16x8& pa3) {
#pragma unroll
    for (int r = 0; r < 16; ++r) p1[r] = __builtin_amdgcn_exp2f(p1[r]);
    float ps = 0;
#pragma unroll
    for (int r = 0; r < 16; ++r) ps += p0[r];
#pragma unroll
    for (int r = 0; r < 16; ++r) ps += p1[r];
    { auto rr = __builtin_amdgcn_permlane32_swap(__float_as_uint(ps), __float_as_uint(ps), false, false);
      ps = __uint_as_float(rr[0]) + __uint_as_float(rr[1]); }
    l_reg = l_reg * alpha + ps;
#define PK4(P, BASE, OUT) do { unsigned a0 = cvtpk(P[BASE + 0], P[BASE + 1]), a1 = cvtpk(P[BASE + 2], P[BASE + 3]);   \
    unsigned b0 = cvtpk(P[BASE + 4], P[BASE + 5]), b1 = cvtpk(P[BASE + 6], P[BASE + 7]);                              \
    auto r0 = __builtin_amdgcn_permlane32_swap(a0, b0, false, false); auto r1 = __builtin_amdgcn_permlane32_swap(a1, b1, false, false); \
    u32x4 w = {r0[0], r1[0], r0[1], r1[1]}; OUT = __builtin_bit_cast(bf16x8, w); } while (0)
    PK4(p0, 0, pa0); PK4(p0, 8, pa1); PK4(p1, 0, pa2); PK4(p1, 8, pa3);
#undef PK4
}
template <int ND0, int KROWB>
__device__ __forceinline__ void qkt(f32x16& p0, f32x16& p1, const char* Ks, const bf16x8* qr, int r32, int hi) {
    p0 = f32x16{}; p1 = f32x16{};
#pragma unroll
    for (int d0 = 0; d0 < ND0; ++d0) { const int cb = (d0 * 16 + hi * 8) * 2;
        const bf16x8 b0 = *reinterpret_cast<const bf16x8*>(Ks + r32 * KROWB + (cb ^ ((r32 & 7) << 4)));
        const bf16x8 b1 = *reinterpret_cast<const bf16x8*>(Ks + (32 + r32) * KROWB + (cb ^ ((r32 & 7) << 4)));
        p0 = __builtin_amdgcn_mfma_f32_32x32x16_bf16(b0, qr[d0], p0, 0, 0, 0);
        p1 = __builtin_amdgcn_mfma_f32_32x32x16_bf16(b1, qr[d0], p1, 0, 0, 0); }
}
template <int NCB> __device__ __forceinline__ int v_st(int k, int c) { const int kk = (k & ~0xC) | ((k & 4) << 1) | ((k & 8) >> 1); return ((kk >> 3) * NCB + (c >> 5)) * 512 + ((kk & 7) * 32 + (c & 31)) * 2; }
__device__ __forceinline__ int v_rd_base(int lane) { return ((lane & 3) << 3) | (((lane >> 2) & 3) << 6) | (((lane >> 4) & 1) << 5) | (((lane >> 5) & 1) << 8); }
template <int OFF> __device__ __forceinline__ s16x4 tr_read(int vb) {
    s16x4 r; asm volatile("ds_read_b64_tr_b16 %0, %1 offset:%2" : "=&v"(r) : "v"(vb), "i"(OFF) : "memory"); return r;
}
template <int NCB, int D0> __device__ __forceinline__ void pv_one(f32x16& od, int vb, bf16x8 pa0, bf16x8 pa1, bf16x8 pa2, bf16x8 pa3) {
#define VOFF(ks, half) (D0 * 512 + (ks) * (NCB * 1024) + (half) * (NCB * 512))
    const s16x4 l0 = tr_read<VOFF(0, 0)>(vb), h0 = tr_read<VOFF(0, 1)>(vb), l1 = tr_read<VOFF(1, 0)>(vb), h1 = tr_read<VOFF(1, 1)>(vb);
    const s16x4 l2 = tr_read<VOFF(2, 0)>(vb), h2 = tr_read<VOFF(2, 1)>(vb), l3 = tr_read<VOFF(3, 0)>(vb), h3 = tr_read<VOFF(3, 1)>(vb);
#undef VOFF
    asm volatile("s_waitcnt lgkmcnt(0)" ::: "memory"); SBAR();
#define PK(L, H) (bf16x8){L[0], L[1], L[2], L[3], H[0], H[1], H[2], H[3]}
    od = __builtin_amdgcn_mfma_f32_32x32x16_bf16(pa0, PK(l0, h0), od, 0, 0, 0);
    od = __builtin_amdgcn_mfma_f32_32x32x16_bf16(pa1, PK(l1, h1), od, 0, 0, 0);
    od = __builtin_amdgcn_mfma_f32_32x32x16_bf16(pa2, PK(l2, h2), od, 0, 0, 0);
    od = __builtin_amdgcn_mfma_f32_32x32x16_bf16(pa3, PK(l3, h3), od, 0, 0, 0);
#undef PK
}
template <int NCB> __device__ __forceinline__ void pv_all(f32x16* o, int vb, bf16x8 pa0, bf16x8 pa1, bf16x8 pa2, bf16x8 pa3) {
    pv_one<NCB, 0>(o[0], vb, pa0, pa1, pa2, pa3); pv_one<NCB, 1>(o[1], vb, pa0, pa1, pa2, pa3);
    if constexpr (NCB == 4) { pv_one<NCB, 2>(o[2], vb, pa0, pa1, pa2, pa3); pv_one<NCB, 3>(o[3], vb, pa0, pa1, pa2, pa3); }
}

template <int DQK, int DV, int KROWB>
__device__ __forceinline__ void attn_core(const bf16x8* qr, const bf16* kA, int sA, const bf16* kB, int sB, const bf16* vP, int sV,
                                          int NT, float C, float thr_raw, char* lds, f32x16* o, float& l_out, const int tid) {
    constexpr int NCB = DV / 32, SHM_V = 64 * DV * 2, SHM_K = 64 * KROWB, ND0 = DQK / 16;
    constexpr int PPR = DQK / 8, NPK = 64 * PPR, NKS = (NPK + 511) / 512, VPR = DV / 8, NVS = 64 * VPR / 512;
    const int wid = tid >> 6, lane = tid & 63, r32 = lane & 31, hi = lane >> 5;
    char* V_lds = lds; char* K_lds = lds + 2 * SHM_V;
    float* wsf = (float*)(lds + 2 * SHM_V + 2 * SHM_K) + wid * 64; float* al_l = wsf + 32;
    float m_reg = -1e30f, l_reg = 0;
    const bf16* kp[NKS]; int kadv[NKS], kst[NKS]; bool kval[NKS];
#pragma unroll
    for (int i = 0; i < NKS; ++i) { int p = tid + 512 * i; kval[i] = p < NPK; if (!kval[i]) p -= 512; const int row = p / PPR, c8 = p - row * PPR;
        if (c8 < 8) { kp[i] = kA + (size_t)row * sA + c8 * 8; kadv[i] = 64 * sA; } else { kp[i] = kB + (size_t)row * sB + (c8 - 8) * 8; kadv[i] = 64 * sB; }
        kst[i] = row * KROWB + ((c8 * 16) ^ ((row & 7) << 4)); }
    const bf16* vp[NVS]; int vst[NVS];
#pragma unroll
    for (int i = 0; i < NVS; ++i) { const int p = tid + 512 * i, row = p / VPR, c8 = p % VPR; vp[i] = vP + (size_t)row * sV + c8 * 8; vst[i] = v_st<NCB>(row, c8 * 8); }
    const int vadv = 64 * sV;
    const int vb0 = (int)(uintptr_t)V_lds + v_rd_base(lane);
    struct { bf16x8 ks[NKS]; bf16x8 vs[NVS]; } sr_[1];
#define SLOAD(i, t) do { _Pragma("unroll") for (int s_ = 0; s_ < NKS; ++s_) sr_[i].ks[s_] = *(const bf16x8*)(kp[s_] + (size_t)(t) * kadv[s_]); \
        _Pragma("unroll") for (int s_ = 0; s_ < NVS; ++s_) sr_[i].vs[s_] = *(const bf16x8*)(vp[s_] + (size_t)(t) * vadv); } while (0)
#define SWRITE(b, i) do { _Pragma("unroll") for (int s_ = 0; s_ < NVS; ++s_) *(bf16x8*)(V_lds + (b) * SHM_V + vst[s_]) = sr_[i].vs[s_]; \
        _Pragma("unroll") for (int s_ = 0; s_ < NKS; ++s_) if (kval[s_]) *(bf16x8*)(K_lds + (b) * SHM_K + kst[s_]) = sr_[i].ks[s_]; } while (0)
#define RESC(a) do { if (__any((a) < 1.f)) { if (hi == 0) al_l[r32] = (a); asm volatile("s_waitcnt lgkmcnt(0)" ::: "memory"); \
        _Pragma("unroll") for (int d = 0; d < NCB; ++d) _Pragma("unroll") for (int r = 0; r < 16; ++r) o[d][r] *= al_l[crow(r, hi)]; } } while (0)
    f32x16 pA0, pA1, pB0, pB1; float mnA, mnB, alA, alB; bf16x8 pa0, pa1, pa2, pa3;
    constexpr int SE = 0, SO = 0;
    SLOAD(SE, 0); SWRITE(0, SE); __syncthreads();
    qkt<ND0, KROWB>(pA0, pA1, K_lds, qr, r32, hi); partialSM(pA0, pA1, m_reg, mnA, alA, C, thr_raw);
    SLOAD(SO, 1);
    SWRITE(1, SO); __syncthreads();
    for (int j = 1; j + 1 < NT; j += 2) {
        SBAR(); qkt<ND0, KROWB>(pB0, pB1, K_lds + SHM_K, qr, r32, hi);
        finishSM(pA0, pA1, alA, l_reg, pa0, pa1, pa2, pa3); SBAR();
        SLOAD(SO, j + 1); SBAR();
        pv_all<NCB>(o, vb0, pa0, pa1, pa2, pa3); partialSM(pB0, pB1, m_reg, mnB, alB, C, thr_raw);
        __syncthreads(); SWRITE(0, SE);
        RESC(alB); __syncthreads();
        SBAR(); qkt<ND0, KROWB>(pA0, pA1, K_lds, qr, r32, hi);
        finishSM(pB0, pB1, alB, l_reg, pa0, pa1, pa2, pa3); SBAR();
        SLOAD(SE, j + 2); SBAR();
        pv_all<NCB>(o, vb0 + SHM_V, pa0, pa1, pa2, pa3); partialSM(pA0, pA1, m_reg, mnA, alA, C, thr_raw);
        __syncthreads(); SWRITE(1, SO);
        RESC(alA); __syncthreads();
    }
    SBAR(); qkt<ND0, KROWB>(pB0, pB1, K_lds + SHM_K, qr, r32, hi);
    finishSM(pA0, pA1, alA, l_reg, pa0, pa1, pa2, pa3); SBAR();
    pv_all<NCB>(o, vb0, pa0, pa1, pa2, pa3); partialSM(pB0, pB1, m_reg, mnB, alB, C, thr_raw);
    __syncthreads(); RESC(alB);
    finishSM(pB0, pB1, alB, l_reg, pa0, pa1, pa2, pa3); SBAR();
    pv_all<NCB>(o, vb0 + SHM_V, pa0, pa1, pa2, pa3);
    l_out = l_reg;
#undef SLOAD
#undef SWRITE
#undef RESC
}

__device__ __forceinline__ void mla_item(KArgP a, int b, int h, int qb, char* lds) {
    const int tid = ptid(), wid = tid >> 6, lane = tid & 63, r32 = lane & 31, hi = lane >> 5;
    const bf16* Qb = (const bf16*)((const unsigned char*)a->out + OUT_Q); const bf16* KV = (const bf16*)((const unsigned char*)a->out + OUT_KV);
    const bf16* KR = (const bf16*)(a->ws + WS_KR); bf16* MIX = (bf16*)(a->ws + WS_MIX);
    const int row0 = b * TPB + qb * 256, krow0 = b * TPB, NT = qb ? 36 : 4;
    const int row = row0 + wid * 32 + r32;
    const bf16* Qw = Qb + (size_t)row * 768 + h * 96;
    bf16x8 qr[6];
#pragma unroll
    for (int d0 = 0; d0 < 4; ++d0) qr[d0] = *(const bf16x8*)(Qw + d0 * 16 + hi * 8);
    const int t = (qb - 1) * 256 + wid * 32 + r32;
#pragma unroll
    for (int d0 = 4; d0 < 6; ++d0) {
        const bf16x8 x1 = *(const bf16x8*)(Qw + d0 * 16), x2 = *(const bf16x8*)(Qw + d0 * 16 + 8);
        if (qb) { const float pos = (float)(d0 == 4 ? (t >> 6) : (t & 63)); unsigned short ov[8];
#pragma unroll
            for (int i = 0; i < 8; ++i) { float s, c; sincos_r(pos * inv_freq(i, 8), s, c); const float f1 = bf2f((unsigned short)x1[i]), f2 = bf2f((unsigned short)x2[i]);
                ov[i] = (unsigned short)f2bf(hi ? (f1 * s + f2 * c) : (f1 * c - f2 * s)); }
            qr[d0] = (bf16x8){(short)ov[0], (short)ov[1], (short)ov[2], (short)ov[3], (short)ov[4], (short)ov[5], (short)ov[6], (short)ov[7]};
        } else qr[d0] = hi ? x2 : x1;
    }
    f32x16 o[2] = {}; float l_reg;
    const float scale = 0.10206207261596575f;
    attn_core<96, 64, 256>(qr, KV + (size_t)krow0 * 1024 + h * 128, 1024, KR + (size_t)krow0 * 32, 32, KV + (size_t)krow0 * 1024 + h * 128 + 64, 1024,
                           NT, scale * 1.4426950408889634f, 8.f / scale, lds, o, l_reg, tid);
    float* li_l = (float*)(lds + 2 * 64 * 64 * 2 + 2 * 64 * 256) + wid * 64;
    if (hi == 0) li_l[r32] = l_reg; asm volatile("s_waitcnt lgkmcnt(0)" ::: "memory");
#pragma unroll
    for (int r = 0; r < 16; ++r) { const int orow = crow(r, hi); const float rl = __builtin_amdgcn_rcpf(li_l[orow]);
        bf16* op = MIX + (size_t)(row0 + wid * 32 + orow) * 1024 + 512 + h * 64 + r32;
        op[0] = (bf16)f2bf(o[0][r] * rl); op[32] = (bf16)f2bf(o[1][r] * rl); }
}
__device__ __forceinline__ void diff_item(KArgP a, int layer, int b, int h, int qb, char* lds) {
    const int row0 = b * TPB + qb * 256, krow0 = b * TPB, NT = qb ? 36 : 4, o_ = layer >> 1;
    const float scale = 0.125f;
#pragma unroll 1
    for (int m = 0; m < 2; ++m) {
        f32x16 o[4] = {};
        float l_reg;
        {
            const int tid = ptid(), wid = tid >> 6, lane = tid & 63, r32 = lane & 31, hi = lane >> 5;
            const bf16* P = (const bf16*)(a->ws + WS_P);
            const bf16* Qw = P + (size_t)(row0 + wid * 32 + r32) * NP_O + 1536 + h * 128 + m * 64;
            bf16x8 qr[4];
#pragma unroll
            for (int d0 = 0; d0 < 4; ++d0) qr[d0] = *(const bf16x8*)(Qw + d0 * 16 + hi * 8);
            const bf16* Kp = P + (size_t)krow0 * NP_O + 2048 + h * 128 + m * 64;
            attn_core<64, 128, 128>(qr, Kp, NP_O, Kp, NP_O, P + (size_t)krow0 * NP_O + 2560 + h * 128, NP_O,
                                    NT, scale * 1.4426950408889634f, 8.f / scale, lds, o, l_reg, tid);
        }
        const int tid = ptid(), wid = tid >> 6, lane = tid & 63, r32 = lane & 31, hi = lane >> 5;
        float* li_l = (float*)(lds + 2 * 64 * 128 * 2 + 2 * 64 * 128) + wid * 64;
        if (hi == 0) li_l[r32] = l_reg; asm volatile("s_waitcnt lgkmcnt(0)" ::: "memory");
        float* dsb = (float*)a->out + (size_t)blockIdx.x * 64 * 512 + tid; asm volatile("" : "+v"(dsb));
        if (m == 0) {
#pragma unroll
            for (int r = 0; r < 16; ++r) { const float rl = __builtin_amdgcn_rcpf(li_l[crow(r, hi)]);
#pragma unroll
                for (int d = 0; d < 4; ++d) dsb[(size_t)(d * 16 + r) * 512] = o[d][r] * rl; }
        } else {
            bf16* MIX = (bf16*)(a->ws + WS_MIX);
            const float* lp = a->in[20] + o_ * 256;
            const float lam_init = 0.8f - 0.6f * __expf(-0.3f * (float)layer);
            const float lam = __expf(wave_sum(lp[lane] * lp[64 + lane])) - __expf(wave_sum(lp[128 + lane] * lp[192 + lane])) + lam_init;
            const float* sg = a->in[21] + o_ * 128;
#pragma unroll
            for (int r = 0; r < 16; ++r) { const float rl = __builtin_amdgcn_rcpf(li_l[crow(r, hi)]); float s = 0.f; float v[4];
#pragma unroll
                for (int d = 0; d < 4; ++d) { v[d] = dsb[(size_t)(d * 16 + r) * 512] - lam * (o[d][r] * rl); s += v[d] * v[d]; }
                s += __shfl_xor(s, 16); s += __shfl_xor(s, 8); s += __shfl_xor(s, 4); s += __shfl_xor(s, 2); s += __shfl_xor(s, 1);
                const float rs = __builtin_amdgcn_rsqf(s * (1.f / 128.f) + EPSN) * (1.f - lam_init);
                bf16* op = MIX + (size_t)(row0 + wid * 32 + crow(r, hi)) * 1024 + 512 + h * 128 + r32;
#pragma unroll
                for (int d = 0; d < 4; ++d) op[32 * d] = (bf16)f2bf(v[d] * rs * sg[32 * d + r32]);
                asm volatile("" ::: "memory"); }
        }
        asm volatile("s_waitcnt vmcnt(0) lgkmcnt(0)" ::: "memory");
    }
}

__device__ __forceinline__ void phase_mixer(KArgP a, int layer, unsigned char* ldsg) {
    LAS unsigned char* lds = (LAS unsigned char*)ldsg;
    volatile LAS unsigned* flag = (volatile LAS unsigned*)(lds + LDS_MAIN);
    unsigned* ctr = (unsigned*)(a->ws + WS_CTL) + layer; layer &= 7;
    const bool even = !(layer & 1), need_ctx = layer < 3;
    constexpr int NSC = 256;
    const int n_lat = even ? 512 : 256, n_ctx = need_ctx ? (even ? 64 : 32) : 0, total = NSC + n_lat + n_ctx;
    for (;;) {
        __syncthreads();
        if (ptid() == 0) *flag = atomicAdd(ctr, 1u);
        __syncthreads();
        const int qi_ = (int)*flag;
        if (qi_ >= total) break;
        const int item = qi_ < n_lat ? NSC + qi_ : (qi_ < n_lat + NSC ? qi_ - n_lat : qi_);
#ifdef PROBE_ITEM
        const unsigned long long it0_ = __builtin_amdgcn_s_memrealtime();
#endif
#ifndef SKIP_SCAN
        if (item < NSC) { if (even) scan_item<128, true, 1>(a, layer, item & 63, item >> 6, lds); else scan_item<64, false, 1>(a, layer, item & 63, item >> 6, lds); }
#else
        if (item < NSC) {}
#endif
        else { int b_, h_, qb_;
            if (item < NSC + n_lat) { const int i = item - NSC; qb_ = 1 + (i & 7); if (even) { b_ = i >> 6; h_ = (i >> 3) & 7; } else { b_ = i >> 5; h_ = (i >> 3) & 3; } }
            else { const int i = item - NSC - n_lat; qb_ = 0; if (even) { b_ = i >> 3; h_ = i & 7; } else { b_ = i >> 2; h_ = i & 3; } }
#ifndef SKIP_ATTN
            if (even) mla_item(a, b_, h_, qb_, (char*)ldsg); else diff_item(a, layer, b_, h_, qb_, (char*)ldsg);
#endif
        }
#ifdef PROBE_ITEM
        __syncthreads();
        if (otid() == 0) { volatile LAS unsigned long long* pc_ = (volatile LAS unsigned long long*)(lds + LDS_MAIN + 128); const int k_ = item < NSC ? 0 : (even ? 1 : 2); pc_[k_] += __builtin_amdgcn_s_memrealtime() - it0_; }
#endif
    }
}

#define XB_TMO      128
#define XB_XCNT(j)  (256  + 64 * (j))
#define XB_XSUB(j)  (1280 + 64 * (j))
#define XB_XGEN(j)  (2304 + 64 * (j))
#define XB_TOP      3328
#define XB_TOPGEN   3392
#define XCD_BAR_WORDS 3456
#define XB_SPIN_CAP (1u << 18)

__device__ __forceinline__ unsigned xb_ld(unsigned* p)              { return __hip_atomic_load(p, __ATOMIC_RELAXED, __HIP_MEMORY_SCOPE_AGENT); }
__device__ __forceinline__ unsigned xb_add(unsigned* p, unsigned v) { return __hip_atomic_fetch_add(p, v, __ATOMIC_RELAXED, __HIP_MEMORY_SCOPE_AGENT); }
__device__ __forceinline__ unsigned xb_xcc_id() { return (unsigned)__builtin_amdgcn_s_getreg((3 << 11) | 20) & 0xFu; }
#define XB_SPIN(cond, bar) do { unsigned _sp = 0; while (cond) { __builtin_amdgcn_s_sleep(1); \
    if ((++_sp & 255u) == 0u) { if (xb_ld(&(bar)[XB_TMO])) break; if (_sp > XB_SPIN_CAP) { atomicAdd(&(bar)[XB_TMO], 1u); break; } } } } while (0)

struct XcdBarrier {
    unsigned* bar; unsigned x;
    volatile LAS unsigned* st;
};

__device__ __forceinline__ XcdBarrier xcd_barrier_post(unsigned* bar, volatile LAS unsigned* st) {
    XcdBarrier b; b.bar = bar; b.x = xb_xcc_id(); b.st = st;
    if (threadIdx.x == 0) (void)xb_add(&bar[XB_XCNT(b.x)], 1u);
    return b;
}
__device__ __forceinline__ void xcd_barrier_complete(unsigned* bar, unsigned x, unsigned& nloc, unsigned& nx) {
    const unsigned G = gridDim.x * gridDim.y * gridDim.z;
    unsigned sum, cnt, mine, sp = 0u;
    for (;;) {
        sum = 0u; cnt = 0u; mine = 0u;
#pragma unroll
        for (unsigned j = 0; j < 16; ++j) { const unsigned c = xb_ld(&bar[XB_XCNT(j)]); sum += c; cnt += (c > 0u) ? 1u : 0u; mine = (j == x) ? c : mine; }
        if (sum == G) break;
        __builtin_amdgcn_s_sleep(1);
        if ((++sp & 255u) == 0u) { if (xb_ld(&bar[XB_TMO])) break; if (sp > XB_SPIN_CAP) { atomicAdd(&bar[XB_TMO], 1u); break; } }
    }
    nloc = mine > 0u ? mine : 1u; nx = cnt > 0u ? cnt : 1u;
}

__device__ __forceinline__ void xcd_barrier(const XcdBarrier& b) {
    asm volatile("s_waitcnt vmcnt(0)" ::: "memory");
    __syncthreads();
    if (threadIdx.x == 0) {
        unsigned* bar = b.bar;
        __builtin_amdgcn_s_waitcnt(0);
        unsigned nloc = b.st[0], nx = b.st[1];
        if (nloc == 0u) { xcd_barrier_complete(bar, b.x, nloc, nx); b.st[0] = nloc; b.st[1] = nx; }
        const unsigned old = xb_add(&bar[XB_XSUB(b.x)], 1u);
        const unsigned gen = old / nloc;
        if (old + 1u == (gen + 1u) * nloc) {
            __builtin_amdgcn_fence(__ATOMIC_RELEASE, "agent");
            asm volatile("s_waitcnt vmcnt(0)" ::: "memory");
            const unsigned og = xb_add(&bar[XB_TOP], 1u);
            const unsigned tg = og / nx;
            if (og + 1u == (tg + 1u) * nx) xb_add(&bar[XB_TOPGEN], 1u);
            else XB_SPIN(xb_ld(&bar[XB_TOPGEN]) == tg, bar);
            __builtin_amdgcn_fence(__ATOMIC_ACQUIRE, "agent");
            xb_add(&bar[XB_XGEN(b.x)], 1u);
            asm volatile("s_waitcnt vmcnt(0)" ::: "memory");
        } else {
            XB_SPIN(xb_ld(&bar[XB_XGEN(b.x)]) == gen, bar);
            __builtin_amdgcn_fence(__ATOMIC_ACQUIRE, "agent");
            asm volatile("s_waitcnt vmcnt(0)" ::: "memory");
        }
    }
    __syncthreads();
}

__global__ void __launch_bounds__(512, 2) mega_fwd(Args a_) {
    extern __shared__ __attribute__((aligned(16))) unsigned char lds_raw[];
    LAS unsigned char* lds = (LAS unsigned char*)lds_raw;
    ((LAS int*)(lds + LDS_MAIN + 1024))[threadIdx.x] = (int)threadIdx.x;
    if (threadIdx.x < 4) ((LAS unsigned*)(lds + LDS_MAIN + 64))[threadIdx.x] = 0u;
    if (threadIdx.x < 8) ((LAS unsigned*)(lds + LDS_MAIN + 128))[threadIdx.x] = 0u;
    __syncthreads();
    XcdBarrier xbar; xbar.bar = nullptr; xbar.x = 0; xbar.st = nullptr; bool xb_ready = false;
    cg::grid_group grid = cg::this_grid();
    int ph = 0;
#ifdef PROBE_MASK
    unsigned long long pr_last = __builtin_amdgcn_s_memrealtime(), pr_acc = 0ull;
#define PROBE_STAMP(k) { const unsigned long long now_ = __builtin_amdgcn_s_memrealtime(); if ((PROBE_MASK >> (k)) & 1) pr_acc += now_ - pr_last; pr_last = now_; }
#else
#define PROBE_STAMP(k)
#endif
    const int plo = a_.lo, phi = a_.hi;
#define PH_BEGIN if (ph >= plo && ph < phi) { KArgP a = kargs(); int bx = (int)blockIdx.x, G = (int)gridDim.x; asm volatile("" : "+s"(bx), "+s"(G)); (void)bx; (void)G;
#ifdef PROBE_SYNC2
#define PH_ENDT(k)   if (ph + 1 < phi) { grid.sync(); grid.sync(); } } ++ph;
#else
#define PH_ENDT(k) if (ph + 1 < phi) { if (!xb_ready) { grid.sync(); xbar = xcd_barrier_post((unsigned*)(a->ws + WS_CTL) + 4096, (volatile LAS unsigned*)(lds + LDS_MAIN + 64)); xb_ready = true; } else xcd_barrier(xbar); } PROBE_STAMP(k) } ++ph;
#endif

    PH_BEGIN phase_prep(a, lds); PH_ENDT(0)

    for (int layer = 0; layer < 4; ++layer) {
        const bool even = !(layer & 1);
        const int np = even ? NP_E : NP_O;
        PH_BEGIN phase_norm(a, layer, 0, layer > 0); if (layer > 0 || G <= 96) convert_weights(a, layer, lds, 0, bx * 8 + (otid() >> 6), G * 8); PH_ENDT(1)
#ifndef SKIP_G1
        PH_BEGIN { bf16* H = (bf16*)(a->ws + WS_H); bf16* MIX = (bf16*)(a->ws + WS_MIX); bf16* P = (bf16*)(a->ws + WS_P); bf16* X = (bf16*)(a->ws + WS_X); unsigned char* Wb = a->ws + WS_W; const float* mod = (const float*)(a->ws + WS_MOD) + (size_t)layer * 9 * 6144; (void)H; (void)MIX; (void)P; (void)X; (void)mod; pg8::Gemm g{H, (const bf16*)(Wb + W_IN), MT, np, 1024, 1024}; pg8::StaticOrder S; S.init(MT, np, G, bx);
                   pg8::EpiBf16<0> E{P, np, nullptr, 0, 0, 1.f};
                   pg8::gemm_phase<pg8::EpiBf16<0>, pg8::StaticOrder, true, true>(lds, g, S, E); } PH_ENDT(2)
#else
        ++ph;
#endif
        PH_BEGIN if (even) phase_post_even(a, layer); else phase_post_odd(a, layer); PH_ENDT(3)
#ifndef SKIP_G3
        if (even) {
            PH_BEGIN { bf16* H = (bf16*)(a->ws + WS_H); bf16* MIX = (bf16*)(a->ws + WS_MIX); bf16* P = (bf16*)(a->ws + WS_P); bf16* X = (bf16*)(a->ws + WS_X); unsigned char* Wb = a->ws + WS_W; const float* mod = (const float*)(a->ws + WS_MOD) + (size_t)layer * 9 * 6144; (void)H; (void)MIX; (void)P; (void)X; (void)mod; pg8::Gemm g{(const bf16*)(a->ws + WS_CQN), (const bf16*)(Wb + W_UQ), MT, 768, 384, 384}; pg8::StaticOrder S; S.init(MT, 768, G, bx);
                       pg8::EpiBf16<0> E{(bf16*)((unsigned char*)a->out + OUT_Q), 768, nullptr, 0, 0, 1.f};
                       pg8::gemm_phase<pg8::EpiBf16<0>, pg8::StaticOrder, true, true>(lds, g, S, E); }
                     { unsigned char* Wb = a->ws + WS_W; pg8::Gemm g{(const bf16*)(a->ws + WS_CKVN), (const bf16*)(Wb + W_UKV), MT, 1024, 256, 256}; pg8::StaticOrder S; S.init(MT, 1024, G, bx);
                       pg8::EpiBf16<0> E{(bf16*)((unsigned char*)a->out + OUT_KV), 1024, nullptr, 0, 0, 1.f};
                       pg8::gemm_phase<pg8::EpiBf16<0>, pg8::StaticOrder, true, true>(lds, g, S, E); }
                     for (int it = bx; it < 192; it += G) scan_item<128, true, 0>(a, layer, it & 63, it >> 6, lds);
                     if (bx >= 192 && layer > 0) convert_weights(a, layer, lds, 1, (bx - 192) * 8 + (otid() >> 6), (G - 192) * 8);
            PH_ENDT(4)
        } else { ++ph; }
#else
        ++ph;
#endif
        if (!even) {
        PH_BEGIN for (int it = bx; it < 192; it += G) scan_item<64, false, 0>(a, layer, it & 63, it >> 6, lds);
                 if (bx >= 192) convert_weights(a, layer, lds, 1, (bx - 192) * 8 + (otid() >> 6), (G - 192) * 8); PH_ENDT(5)
        } else { ++ph; }
#ifdef PROBE_MIX2
        PH_BEGIN phase_mixer(a, layer + 8, lds_raw); grid.sync(); PH_ENDT(6)
        --ph;
#endif
        PH_BEGIN phase_mixer(a, layer, lds_raw); PH_ENDT(6 + 7 * (layer & 1))
        PH_BEGIN phase_readout(a, layer); PH_ENDT(7)
#ifndef SKIP_G6
        PH_BEGIN { bf16* H = (bf16*)(a->ws + WS_H); bf16* MIX = (bf16*)(a->ws + WS_MIX); bf16* P = (bf16*)(a->ws + WS_P); bf16* X = (bf16*)(a->ws + WS_X); unsigned char* Wb = a->ws + WS_W; const float* mod = (const float*)(a->ws + WS_MOD) + (size_t)layer * 9 * 6144; (void)H; (void)MIX; (void)P; (void)X; (void)mod; pg8::Gemm g{MIX, (const bf16*)(Wb + W_OUT), MT, 1024, 1024, 1024}; pg8::StaticOrder S; S.init(NB * NLAT, 1024, G, bx, 1);
                   pg8::EpiResid E{X, mod, 2048, layer == 0 ? a->in[0] : nullptr};
                   pg8::gemm_phase<pg8::EpiResid, pg8::StaticOrder, true, true>(lds, g, S, E);
                   if (layer < 3) { pg8::Gemm g2{MIX, (const bf16*)(Wb + W_OUT), MT, 1024, 512, 1024}; pg8::CtxSplitOrder S2{G, bx, 512};
                       pg8::EpiResidSplit E2{X, (float*)(a->ws + WS_T), mod, 2048, layer == 0 ? a->in[2] : nullptr};
                       pg8::gemm_phase<pg8::EpiResidSplit, pg8::CtxSplitOrder, true, true>(lds, g2, S2, E2); } } PH_ENDT(8)
#else
        ++ph;
#endif
        PH_BEGIN phase_norm(a, layer, 1, layer < 3); PH_ENDT(9)
#ifndef SKIP_G8
        PH_BEGIN { bf16* H = (bf16*)(a->ws + WS_H); bf16* MIX = (bf16*)(a->ws + WS_MIX); bf16* P = (bf16*)(a->ws + WS_P); bf16* X = (bf16*)(a->ws + WS_X); unsigned char* Wb = a->ws + WS_W; const float* mod = (const float*)(a->ws + WS_MOD) + (size_t)layer * 9 * 6144; (void)H; (void)MIX; (void)P; (void)X; (void)mod; pg8::Gemm g{H, (const bf16*)(Wb + W_GU), MT, 2 * FF, 1024, 1024}; pg8::StaticOrder S; if (layer < 3) S.init(MT, 2 * FF, G, bx); else S.init(NB * NLAT, 2 * FF, G, bx, 1);
                   pg8::EpiSwiGLU E{P, FF};
                   pg8::gemm_phase<pg8::EpiSwiGLU, pg8::StaticOrder, true, true>(lds, g, S, E); } PH_ENDT(10)
#else
        ++ph;
#endif
#ifndef SKIP_G9
        PH_BEGIN { bf16* H = (bf16*)(a->ws + WS_H); bf16* MIX = (bf16*)(a->ws + WS_MIX); bf16* P = (bf16*)(a->ws + WS_P); bf16* X = (bf16*)(a->ws + WS_X); unsigned char* Wb = a->ws + WS_W; const float* mod = (const float*)(a->ws + WS_MOD) + (size_t)layer * 9 * 6144; (void)H; (void)MIX; (void)P; (void)X; (void)mod; pg8::Gemm g{P, (const bf16*)(Wb + W_DN), MT, 1024, FF, FF}; pg8::StaticOrder S; S.init(NB * NLAT, 1024, G, bx, 1);
                   pg8::EpiResid E{X, mod, 5120, nullptr};
                   pg8::gemm_phase<pg8::EpiResid, pg8::StaticOrder, true, true>(lds, g, S, E);
                   if (layer < 3) { pg8::Gemm g2{P, (const bf16*)(Wb + W_DN), MT, 1024, FF / 2, FF}; pg8::CtxSplitOrder S2{G, bx, FF / 2};
                       pg8::EpiResidSplit E2{X, (float*)(a->ws + WS_T), mod, 5120, nullptr};
                       pg8::gemm_phase<pg8::EpiResidSplit, pg8::CtxSplitOrder, true, true>(lds, g2, S2, E2); } } PH_ENDT(11)
#else
        ++ph;
#endif
    }
    PH_BEGIN phase_final(a); PH_ENDT(12)
#undef PH_BEGIN
#undef PH_ENDT
#ifdef PROBE_ITEM
    pr_acc += ((volatile LAS unsigned long long*)(lds + LDS_MAIN + 128))[PROBE_ITEM - 1];
#endif
#ifdef PROBE_MASK
    if (blockIdx.x == 0) { const unsigned long long t0_ = __builtin_amdgcn_s_memrealtime(); while (__builtin_amdgcn_s_memrealtime() - t0_ < pr_acc) __builtin_amdgcn_s_sleep(8); }
#endif
}
constexpr int NPH = 1 + 4 * 11 + 1;

extern "C" void kernel_launch(void* const* d_in, const int* in_sizes, int n_in, void* d_out, int out_size, void* d_ws, size_t ws_size, hipStream_t stream) {
    static int grid = 0;
    if (grid == 0) {
        if (n_in != 23 || ws_size < WS_END || out_size != NB * NLAT * DM) { fprintf(stderr, "kernel_launch: unexpected shapes: n_in %d ws %zu (need %zu) out %d\n", n_in, ws_size, (size_t)WS_END, out_size); grid = -1; return; }
        int dev = 0, cus = 0, per_cu = 0;
        hipGetDevice(&dev); hipDeviceGetAttribute(&cus, hipDeviceAttributeMultiprocessorCount, dev);
        if (hipFuncSetAttribute((const void*)mega_fwd, hipFuncAttributeMaxDynamicSharedMemorySize, LDS_BYTES) != hipSuccess) { fprintf(stderr, "kernel_launch: hipFuncSetAttribute failed\n"); grid = -1; return; }
        if (hipOccupancyMaxActiveBlocksPerMultiprocessor(&per_cu, (const void*)mega_fwd, 512, LDS_BYTES) != hipSuccess || per_cu < 1) { fprintf(stderr, "kernel_launch: occupancy query says %d\n", per_cu); per_cu = 1; }
        (void)hipGetLastError();
        grid = cus;
    }
    if (grid < 0) return;
    Args a{};
    for (int i = 0; i < 23; ++i) a.in[i] = (const float*)d_in[i];
    a.out = (float*)d_out; a.ws = (unsigned char*)d_ws; a.lo = 0; a.hi = NPH;
    void* kargv[] = {&a};
    hipError_t e = hipLaunchCooperativeKernel((const void*)mega_fwd, dim3(grid), dim3(512), kargv, LDS_BYTES, stream);
    if (e != hipSuccess) fprintf(stderr, "kernel_launch: cooperative launch failed: %s (grid %d)\n", hipGetErrorString(e), grid);
}
```

```cpp
#include <hip/hip_runtime.h>
#include <hip/hip_cooperative_groups.h>
#include <cstdio>
#include <cstdint>
namespace cg = cooperative_groups;
#define otid() ({ int t_ = (int)threadIdx.x; asm volatile("" : "+v"(t_)); t_; })
extern __shared__ __attribute__((aligned(16))) unsigned char g_lds_dyn[];
#define ptid() (*(volatile __attribute__((address_space(3))) int*)((__attribute__((address_space(3))) unsigned char*)g_lds_dyn + 131072 + 1024 + 4 * (int)threadIdx.x))
namespace pg8 {
#define PG8_LAS __attribute__((address_space(3)))
typedef unsigned short bf16_t;
typedef short bf16x8 __attribute__((ext_vector_type(8)));
typedef float f32x4 __attribute__((ext_vector_type(4)));
typedef unsigned u32x4 __attribute__((ext_vector_type(4)));
constexpr int BM = 256, BK = 64, HALF = 128, HTB = HALF * BK * 2  , STAGE_BYTES = 8 * HTB, NXCD = 8, WGM = 8;

__host__ __device__ __forceinline__ int lds_byte(int r, int c) { const int st = (r >> 4) * 2 + (c >> 5), rr = r & 15, cc = c & 31, ob = rr * 64 + cc * 2; return st * 1024 + (ob ^ (((ob >> 9) & 1) << 5)); }
__host__ __device__ __forceinline__ void stage_rc(int b, int& R, int& C) { const int st = b / 1024, sb = b % 1024, swz = sb ^ (((sb >> 9) & 1) << 5); R = (st >> 1) * 16 + swz / 64; C = (st & 1) * 32 + (swz % 64) / 2; }
__host__ __device__ __forceinline__ int perm32(int rho) { const int n = rho >> 4, i = rho & 15; return 8 * (i >> 2) + 4 * n + (i & 3); }

struct Unit { int pm, pn, koff; };
struct Gemm { const bf16_t* A; const bf16_t* Bt; int M, N, K, ld; };

struct StaticOrder {
    int nM, nN, nwg, G, c, mode;
    __host__ __device__ void init(int M, int N, int G_, int c_, int mode_ = 0) { nM = M / BM; nN = N / BM; nwg = nM * nN; G = G_; c = c_; mode = mode_; }
    __host__ __device__ bool next(int i, Unit& u) const {
        const long L = (long)i * G + c; if (L >= nwg) return false;
        int wgid = (int)L; { const int q = nwg / NXCD, r = nwg % NXCD, xcd = wgid % NXCD, off = wgid / NXCD; wgid = (xcd < r ? xcd * (q + 1) : r * (q + 1) + (xcd - r) * q) + off; }
        const int nig = WGM * nN, gid = wgid / nig, fm = gid * WGM, gsz = (nM - fm) < WGM ? (nM - fm) : WGM;
        u.pm = fm + ((wgid % nig) % gsz); u.pn = (wgid % nig) / gsz; u.koff = 0; if (mode == 1) u.pm = (u.pm >> 3) * 9 + 1 + (u.pm & 7); return true;
    }
    __device__ __forceinline__ void a_ready(const Unit&) const {}
    __device__ __forceinline__ void done(const Unit&) const {}
};
struct CtxSplitOrder {
    int G, c, khalf;
    __device__ bool next(int i, Unit& u) const { const int L = i * G + c; if (L >= 64) return false; u.koff = (L & 1) * khalf; u.pn = (L >> 1) & 3; u.pm = (L >> 3) * 9; return true; }
    __device__ __forceinline__ void a_ready(const Unit&) const {}
    __device__ __forceinline__ void done(const Unit&) const {}
};

__device__ __forceinline__ unsigned cvt_pk_bf16(float lo, float hi) { unsigned r; asm volatile("v_cvt_pk_bf16_f32 %0, %1, %2" : "=v"(r) : "v"(lo), "v"(hi)); return r; }
typedef float f32x2 __attribute__((ext_vector_type(2)));
__device__ __forceinline__ f32x2 gelu_pk(f32x2 v) {
    const f32x2 av = __builtin_elementwise_abs(v), d = av * 0.2316418882f + 1.0f;
    f32x2 t; t.x = __builtin_amdgcn_rcpf(d.x); t.y = __builtin_amdgcn_rcpf(d.y);
    f32x2 q = t * 0.5307027145f + (-0.7265760135f); q = q * t + 0.7107068705f; q = q * t + (-0.142248368f); q = q * t + 0.127414796f; q = q * t;
    const f32x2 s = (v * v) * (-0.72134752044f);
    f32x2 e; e.x = __builtin_amdgcn_exp2f(s.x); e.y = __builtin_amdgcn_exp2f(s.y);
    const f32x2 m = v * (q * e), r = v - m;
    f32x2 o; o.x = v.x < 0.f ? m.x : r.x; o.y = v.y < 0.f ? m.y : r.y; return o;
}

template <int ACT  > struct EpiBf16 {
    static constexpr bool PERM = true, AFTER_DRAIN = false; static_assert(ACT == 0 || ACT == 1, "EpiBf16: ACT is 0 (none) or 1 (gelu_pk)");
    bf16_t* O; int ldc; const float* bias; int split_cols; size_t split_stride; float scale0;
    __device__ __forceinline__ void operator()(const f32x4 (&acc)[2][2][4][2], const Unit& u, int wr, int wc, int fr, int fq) const {
        const int row0 = u.pm * BM + wr * 64 + fr; int colt = u.pn * BM; bf16_t* base = O;
        float sc = 1.f; if (split_cols) { const int t = colt / split_cols; base += (size_t)t * split_stride; colt -= t * split_cols; if (t == 0) sc = scale0; }
        const int col0 = colt + wc * 32 + 8 * fq, bcol0 = u.pn * BM + wc * 32 + 8 * fq;
        f32x4 bv[2][2];
#pragma unroll
        for (int bj = 0; bj < 2; ++bj)
#pragma unroll
            for (int n = 0; n < 2; ++n) bv[bj][n] = bias ? *(const f32x4*)(bias + bcol0 + bj * HALF + 4 * n) : (f32x4){0.f, 0.f, 0.f, 0.f};
#pragma unroll
        for (int ai = 0; ai < 2; ++ai)
#pragma unroll
            for (int m = 0; m < 4; ++m) { bf16_t* rowp = base + (size_t)(row0 + ai * HALF + m * 16) * ldc + col0;
#pragma unroll
                for (int bj = 0; bj < 2; ++bj) { f32x4 v0 = acc[ai][bj][m][0] + bv[bj][0], v1 = acc[ai][bj][m][1] + bv[bj][1];
                    if (ACT == 1) { f32x2 a = gelu_pk((f32x2){v0[0], v0[1]}), b = gelu_pk((f32x2){v0[2], v0[3]}), c = gelu_pk((f32x2){v1[0], v1[1]}), d = gelu_pk((f32x2){v1[2], v1[3]});
                        v0 = (f32x4){a.x, a.y, b.x, b.y}; v1 = (f32x4){c.x, c.y, d.x, d.y}; }
                    v0 = v0 * sc; v1 = v1 * sc; u32x4 w; w.x = cvt_pk_bf16(v0[0], v0[1]); w.y = cvt_pk_bf16(v0[2], v0[3]); w.z = cvt_pk_bf16(v1[0], v1[1]); w.w = cvt_pk_bf16(v1[2], v1[3]);
                    { bf16_t* sp_ = rowp + bj * HALF; asm volatile("global_store_dwordx4 %0, %1, off sc1\n\ts_nop 1" :: "v"(sp_), "v"(w) : "memory"); } } }
    }
};
struct EpiResidSplit {
    static constexpr bool PERM = true, AFTER_DRAIN = false;
    bf16_t* X; float* T; const float* mod; int goff; const float* cin;
    __device__ __forceinline__ void operator()(const f32x4 (&acc)[2][2][4][2], const Unit& u, int wr, int wc, int fr, int fq) const {
        const float* gp = mod + 8 * 6144 + goff;
        const int col0 = u.pn * BM + wc * 32 + 8 * fq;
        const bool first = (u.koff == 0);
        bf16_t* xb = X + (size_t)(u.pm * BM) * 1024; float* tb = T + (size_t)((u.pm / 9) * BM) * 1024;
        const float* rbase = cin ? cin + (size_t)((u.pm / 9) * BM) * 1024 : nullptr;
#pragma unroll
        for (int bj = 0; bj < 2; ++bj) { const f32x4 g0 = *(const f32x4*)(gp + col0 + bj * HALF), g1 = *(const f32x4*)(gp + col0 + bj * HALF + 4);
#pragma unroll
            for (int ai = 0; ai < 2; ++ai)
#pragma unroll
                for (int m = 0; m < 4; ++m) { const size_t o = (size_t)(ai * HALF + wr * 64 + m * 16 + fr) * 1024 + col0 + bj * HALF;
                    f32x4 v0 = g0 * acc[ai][bj][m][0], v1 = g1 * acc[ai][bj][m][1];
                    if (first) { f32x4 x0, x1;
                        if (rbase) { x0 = *(const f32x4*)(rbase + o); x1 = *(const f32x4*)(rbase + o + 4); }
                        else { const u32x4 w = *(const u32x4*)(xb + o);
                            x0 = (f32x4){__uint_as_float(w.x << 16), __uint_as_float(w.x & 0xffff0000u), __uint_as_float(w.y << 16), __uint_as_float(w.y & 0xffff0000u)};
                            x1 = (f32x4){__uint_as_float(w.z << 16), __uint_as_float(w.z & 0xffff0000u), __uint_as_float(w.w << 16), __uint_as_float(w.w & 0xffff0000u)}; }
                        v0 = v0 + x0; v1 = v1 + x1;
                        u32x4 r; r.x = cvt_pk_bf16(v0[0], v0[1]); r.y = cvt_pk_bf16(v0[2], v0[3]); r.z = cvt_pk_bf16(v1[0], v1[1]); r.w = cvt_pk_bf16(v1[2], v1[3]);
                        *(u32x4*)(xb + o) = r; }
                    else { *(f32x4*)(tb + o) = v0; *(f32x4*)(tb + o + 4) = v1; } } }
    }
};
struct EpiSwiGLU {
    static constexpr bool PERM = true, AFTER_DRAIN = false;
    bf16_t* O; int ldc;
    __device__ __forceinline__ void operator()(const f32x4 (&acc)[2][2][4][2], const Unit& u, int wr, int wc, int fr, int fq) const {
        const int row0 = u.pm * BM + wr * 64 + fr; const int col0 = u.pn * HALF + wc * 32 + 8 * fq;
#pragma unroll
        for (int ai = 0; ai < 2; ++ai)
#pragma unroll
            for (int m = 0; m < 4; ++m) { bf16_t* rowp = O + (size_t)(row0 + ai * HALF + m * 16) * ldc + col0;
                float h[8];
#pragma unroll
                for (int n = 0; n < 2; ++n)
#pragma unroll
                    for (int i = 0; i < 4; ++i) { const float g = acc[ai][0][m][n][i], up = acc[ai][1][m][n][i];
                        h[n * 4 + i] = g * __builtin_amdgcn_rcpf(1.0f + __expf(-g)) * up; }
                u32x4 w; w.x = cvt_pk_bf16(h[0], h[1]); w.y = cvt_pk_bf16(h[2], h[3]); w.z = cvt_pk_bf16(h[4], h[5]); w.w = cvt_pk_bf16(h[6], h[7]);
                asm volatile("global_store_dwordx4 %0, %1, off sc1\n\ts_nop 1" :: "v"(rowp), "v"(w) : "memory"); }
    }
};
struct EpiResid {
    static constexpr bool PERM = true, AFTER_DRAIN = false;
    bf16_t* X; const float* mod; int goff; const float* xin;
    __device__ __forceinline__ void operator()(const f32x4 (&acc)[2][2][4][2], const Unit& u, int wr, int wc, int fr, int fq) const {
        const int widx = (u.pm % 9 == 0) ? 8 : (u.pm / 9);
        const float* gp = mod + widx * 6144 + goff;
        const int col0 = u.pn * BM + wc * 32 + 8 * fq;
        const float* rb = xin ? xin + (size_t)((u.pm / 9) * 2048 + (u.pm % 9 - 1) * 256) * 1024 : nullptr;
        bf16_t* wb = X + (size_t)(u.pm * BM) * 1024;
#pragma unroll
        for (int bj = 0; bj < 2; ++bj) { const f32x4 g0 = *(const f32x4*)(gp + col0 + bj * HALF), g1 = *(const f32x4*)(gp + col0 + bj * HALF + 4);
#pragma unroll
            for (int ai = 0; ai < 2; ++ai)
#pragma unroll
                for (int m = 0; m < 4; ++m) { const size_t o = (size_t)(ai * HALF + wr * 64 + m * 16 + fr) * 1024 + col0 + bj * HALF;
                    f32x4 x0, x1;
                    if (rb) { x0 = *(const f32x4*)(rb + o); x1 = *(const f32x4*)(rb + o + 4); }
                    else { const u32x4 w = *(const u32x4*)(wb + o);
                        x0 = (f32x4){__uint_as_float(w.x << 16), __uint_as_float(w.x & 0xffff0000u), __uint_as_float(w.y << 16), __uint_as_float(w.y & 0xffff0000u)};
                        x1 = (f32x4){__uint_as_float(w.z << 16), __uint_as_float(w.z & 0xffff0000u), __uint_as_float(w.w << 16), __uint_as_float(w.w & 0xffff0000u)}; }
                    x0 = x0 + g0 * acc[ai][bj][m][0]; x1 = x1 + g1 * acc[ai][bj][m][1];
                    u32x4 r; r.x = cvt_pk_bf16(x0[0], x0[1]); r.y = cvt_pk_bf16(x0[2], x0[3]); r.z = cvt_pk_bf16(x1[0], x1[1]); r.w = cvt_pk_bf16(x1[2], x1[3]);
                    *(u32x4*)(wb + o) = r; } }
    }
};
template <class Epi, class Sched, bool ALIGN_EPI = false, bool SP2 = false>
__device__ __forceinline__ void gemm_phase(PG8_LAS unsigned char* lds, const Gemm g, const Sched& S, const Epi& E) {
    const int tid = otid(), wid = __builtin_amdgcn_readfirstlane(tid >> 6), lane = tid & 63, wr = wid >> 2, wc = wid & 3, fr = lane & 15, fq = lane >> 4;
    const int K = g.ld, nt = g.K / BK;
    unsigned voffA[2], voffB[2];
#pragma unroll
    for (int i = 0; i < 2; ++i) { int R, C; stage_rc(tid * 16 + i * 8192, R, C); const int Rb = Epi::PERM ? ((R & ~31) + perm32(R & 31)) : R;
        voffA[i] = (unsigned)(R * K + C) * 2u; voffB[i] = (unsigned)(Rb * K + C) * 2u; }
    const size_t kstep = (size_t)(BK * 2);
    const size_t hstep = (size_t)HALF * K * 2;
    const size_t tstep = 2 * hstep;
    const unsigned ldsw = (unsigned)wid * 1024u;
    const int aoff = lds_byte(wr * 64 + fr, fq * 8), boff = lds_byte(wc * 32 + fr, fq * 8);
#define PG8_SA(b, h) (((b) * 2 + (h)) * HTB)
#define PG8_SB(b, h) ((4 + (b) * 2 + (h)) * HTB)
#define PG8_STAGE(bufoff, gbase, voff) do { _Pragma("unroll") for (int _i = 0; _i < 2; ++_i) \
        __builtin_amdgcn_global_load_lds((const unsigned*)((const char*)(gbase) + (voff)[_i]), (PG8_LAS unsigned*)(lds + (bufoff) + ldsw + _i * 8192), 16, 0, 0); } while (0)
#define PG8_LDA(dst, b, h) do { _Pragma("unroll") for (int m = 0; m < 4; ++m) _Pragma("unroll") for (int k = 0; k < 2; ++k) dst[m][k] = *(const PG8_LAS bf16x8*)(lds + PG8_SA(b, h) + aoff + m * 2048 + k * 1024); } while (0)
#define PG8_LDB(dst, b, h) do { _Pragma("unroll") for (int n = 0; n < 2; ++n) _Pragma("unroll") for (int k = 0; k < 2; ++k) dst[n][k] = *(const PG8_LAS bf16x8*)(lds + PG8_SB(b, h) + boff + n * 2048 + k * 1024); } while (0)
#define PG8_MMA(ai, bj, At, Bt) do { __builtin_amdgcn_s_setprio(1); _Pragma("unroll") for (int m = 0; m < 4; ++m) _Pragma("unroll") for (int n = 0; n < 2; ++n) _Pragma("unroll") for (int k = 0; k < 2; ++k) \
        acc[ai][bj][m][n] = __builtin_amdgcn_mfma_f32_16x16x32_bf16(Bt[n][k], At[m][k], acc[ai][bj][m][n], 0, 0, 0); __builtin_amdgcn_s_setprio(0); } while (0)
#define PG8_WAIT_V(n) asm volatile("s_waitcnt vmcnt(" #n ")" ::: "memory")
#define PG8_WAIT_L(n) asm volatile("s_waitcnt lgkmcnt(" #n ")" ::: "memory")
#define PG8_BAR __builtin_amdgcn_s_barrier()
#define PG8_SCHED __builtin_amdgcn_sched_barrier(0)
    Unit cur, nxt; int ui = 0;
    if (!S.next(0, cur)) return;
    f32x4 acc[2][2][4][2];
#pragma unroll
    for (int a = 0; a < 2; ++a)
#pragma unroll
        for (int b = 0; b < 2; ++b)
#pragma unroll
            for (int m = 0; m < 4; ++m)
#pragma unroll
                for (int n = 0; n < 2; ++n) acc[a][b][m][n] = (f32x4){0.f, 0.f, 0.f, 0.f};
    bf16x8 At[4][2], B0[2][2], B1[2][2];
    const char* cA = (const char*)g.A + (size_t)cur.pm * tstep + (size_t)cur.koff * 2; const char* cB = (const char*)g.Bt + (size_t)cur.pn * tstep + (size_t)cur.koff * 2;
    S.a_ready(cur);
    if constexpr (SP2) {
        PG8_STAGE(PG8_SB(0, 0), cB, voffB); PG8_STAGE(PG8_SB(0, 1), cB + hstep, voffB); PG8_STAGE(PG8_SA(0, 0), cA, voffA); PG8_STAGE(PG8_SA(0, 1), cA + hstep, voffA);
        if (wr == 1) PG8_BAR;
        PG8_WAIT_V(2); PG8_BAR;
        PG8_STAGE(PG8_SB(1, 0), cB + kstep, voffB); PG8_STAGE(PG8_SA(1, 0), cA + kstep, voffA); PG8_STAGE(PG8_SB(1, 1), cB + hstep + kstep, voffB);
        PG8_WAIT_V(6); PG8_BAR;
    } else {
        PG8_STAGE(PG8_SB(0, 0), cB, voffB); PG8_STAGE(PG8_SA(0, 0), cA, voffA); PG8_STAGE(PG8_SB(0, 1), cB + hstep, voffB); PG8_STAGE(PG8_SA(0, 1), cA + hstep, voffA);
        if (wr == 1) PG8_BAR;
        PG8_WAIT_V(4); PG8_BAR;
        PG8_STAGE(PG8_SB(1, 0), cB + kstep, voffB); PG8_STAGE(PG8_SA(1, 0), cA + kstep, voffA); PG8_STAGE(PG8_SB(1, 1), cB + hstep + kstep, voffB);
        PG8_WAIT_V(6); PG8_BAR;
    }
    for (;;) {
        const bool has_next = S.next(ui + 1, nxt);
        const char* nA = has_next ? (const char*)g.A + (size_t)nxt.pm * tstep + (size_t)nxt.koff * 2 : cA; const char* nB = has_next ? (const char*)g.Bt + (size_t)nxt.pn * tstep + (size_t)nxt.koff * 2 : cB;
        for (int t = 0; t < nt; t += 2) {
            const bool last = (t == nt - 2);
            const char* a1 = cA + (size_t)(t + 1) * kstep;
            const char* a2 = last ? nA : cA + (size_t)(t + 2) * kstep; const char* b2 = last ? nB : cB + (size_t)(t + 2) * kstep;
            const char* a3 = a2 + kstep; const char* b3 = b2 + kstep;
            if (last && has_next) S.a_ready(nxt);
            if constexpr (SP2) {
            PG8_LDB(B0, 0, 0); PG8_LDB(B1, 0, 1); PG8_SCHED; PG8_LDA(At, 0, 0); PG8_STAGE(PG8_SA(1, 1), a1 + hstep, voffA);
            PG8_WAIT_V(8); PG8_WAIT_L(0); PG8_BAR; PG8_MMA(0, 0, At, B0); PG8_MMA(0, 1, At, B1); PG8_BAR; PG8_SCHED;
            PG8_LDA(At, 0, 1); PG8_STAGE(PG8_SB(0, 0), b2, voffB); PG8_STAGE(PG8_SB(0, 1), b2 + hstep, voffB); PG8_STAGE(PG8_SA(0, 0), a2, voffA);
            PG8_WAIT_V(8); PG8_WAIT_L(0); PG8_BAR; PG8_MMA(1, 0, At, B0); PG8_MMA(1, 1, At, B1); PG8_BAR; PG8_SCHED;
            PG8_LDB(B0, 1, 0); PG8_LDB(B1, 1, 1); PG8_SCHED; PG8_LDA(At, 1, 0); PG8_STAGE(PG8_SA(0, 1), a2 + hstep, voffA);
            PG8_WAIT_V(8); PG8_WAIT_L(0); PG8_BAR; PG8_MMA(0, 0, At, B0); PG8_MMA(0, 1, At, B1); PG8_BAR; PG8_SCHED;
            PG8_LDA(At, 1, 1); PG8_STAGE(PG8_SB(1, 0), b3, voffB); PG8_STAGE(PG8_SB(1, 1), b3 + hstep, voffB); PG8_STAGE(PG8_SA(1, 0), a3, voffA);
            PG8_WAIT_V(8); PG8_WAIT_L(0); PG8_BAR; PG8_MMA(1, 0, At, B0); PG8_MMA(1, 1, At, B1); PG8_BAR; PG8_SCHED;
            } else {
            PG8_LDB(B0, 0, 0); PG8_SCHED; PG8_LDA(At, 0, 0); PG8_STAGE(PG8_SA(1, 1), a1 + hstep, voffA);
            PG8_WAIT_L(8); PG8_BAR; PG8_WAIT_L(0); PG8_MMA(0, 0, At, B0); PG8_BAR; PG8_SCHED;
            PG8_LDB(B1, 0, 1); PG8_STAGE(PG8_SB(0, 0), b2, voffB);
            PG8_BAR; PG8_WAIT_L(0); PG8_MMA(0, 1, At, B1); PG8_BAR;
            PG8_LDA(At, 0, 1); PG8_STAGE(PG8_SA(0, 0), a2, voffA);
            PG8_BAR; PG8_WAIT_L(0); PG8_MMA(1, 0, At, B0); PG8_BAR; PG8_SCHED;
            PG8_STAGE(PG8_SB(0, 1), b2 + hstep, voffB);
            PG8_WAIT_V(6); PG8_BAR; PG8_MMA(1, 1, At, B1); PG8_BAR;
            PG8_LDB(B0, 1, 0); PG8_SCHED; PG8_LDA(At, 1, 0); PG8_STAGE(PG8_SA(0, 1), a2 + hstep, voffA);
            PG8_WAIT_L(8); PG8_BAR; PG8_WAIT_L(0); PG8_MMA(0, 0, At, B0); PG8_BAR; PG8_SCHED;
            PG8_LDB(B1, 1, 1); PG8_STAGE(PG8_SB(1, 0), b3, voffB);
            PG8_BAR; PG8_WAIT_L(0); PG8_MMA(0, 1, At, B1); PG8_BAR;
            PG8_LDA(At, 1, 1); PG8_STAGE(PG8_SA(1, 0), a3, voffA);
            PG8_BAR; PG8_WAIT_L(0); PG8_MMA(1, 0, At, B0); PG8_BAR; PG8_SCHED;
            PG8_STAGE(PG8_SB(1, 1), b3 + hstep, voffB);
            PG8_WAIT_V(6); PG8_BAR; PG8_MMA(1, 1, At, B1); PG8_BAR;
            }
        }
        if constexpr (ALIGN_EPI) { if (wr == 0) PG8_BAR; }
        if constexpr (!Epi::AFTER_DRAIN) { E(acc, cur, wr, wc, fr, fq); S.done(cur); }
        if (!has_next) break;
#pragma unroll
        for (int a = 0; a < 2; ++a)
#pragma unroll
            for (int b = 0; b < 2; ++b)
#pragma unroll
                for (int m = 0; m < 4; ++m)
#pragma unroll
                    for (int n = 0; n < 2; ++n) acc[a][b][m][n] = (f32x4){0.f, 0.f, 0.f, 0.f};
        cur = nxt; cA = nA; cB = nB; ++ui;
        if constexpr (ALIGN_EPI) { if (wr == 1) PG8_BAR; }
    }
    PG8_WAIT_V(0);
    if constexpr (!ALIGN_EPI) { if (wr == 0) PG8_BAR; }
    PG8_BAR;
    if constexpr (Epi::AFTER_DRAIN) { E.fused(acc, cur, wr, wc, fr, fq, lds, wid, lane); S.done(cur); }
#undef PG8_SA
#undef PG8_SB
#undef PG8_STAGE
#undef PG8_LDA
#undef PG8_LDB
#undef PG8_MMA
#undef PG8_WAIT_V
#undef PG8_WAIT_L
#undef PG8_BAR
#undef PG8_SCHED
}
}

typedef unsigned short bf16;
typedef short bf16x8 __attribute__((ext_vector_type(8)));
typedef short s16x4 __attribute__((ext_vector_type(4)));
typedef float f32x4 __attribute__((ext_vector_type(4)));
typedef float f32x16 __attribute__((ext_vector_type(16)));
typedef unsigned u32x4 __attribute__((ext_vector_type(4)));
typedef unsigned u32x2 __attribute__((ext_vector_type(2)));
#define LAS __attribute__((address_space(3)))

constexpr int NB = 8, TPB = 2304, MT = NB * TPB, DM = 1024, NLAT = 2048;
constexpr int NP_E = 3328, NP_O = 3072, FF = 2816;
constexpr float EPSN = 1e-6f;
constexpr size_t MiB = 1u << 20;
constexpr size_t WS_CTL = 0, WS_MOD = 1 * MiB, WS_X = 2 * MiB, WS_H = 74 * MiB, WS_MIX = 110 * MiB, WS_P = 146 * MiB, WS_W = 263 * MiB,
                 WS_OSC = 290 * MiB, WS_KR = 326 * MiB, WS_U = 328 * MiB, WS_T = 342 * MiB, WS_END = 350 * MiB;
constexpr size_t WS_LSUM = 128 * 1024;
constexpr size_t WS_CQN = WS_MIX, WS_CKVN = WS_MIX + 14 * MiB, WS_DSCR = WS_H;
constexpr size_t W_IN = 0, W_OUT = 13 * MiB / 2, W_GU = 17 * MiB / 2, W_DN = 39 * MiB / 2, W_UQ = 25 * MiB, W_UKV = 25 * MiB + 768 * 1024;
constexpr size_t OUT_KV = 0, OUT_Q = 36 * MiB;
constexpr int LDS_MAIN = 131072, LDS_BYTES = LDS_MAIN + 1024 + 2048;

struct Args { const float* in[23]; float* out; unsigned char* ws; int lo, hi; };
typedef __attribute__((address_space(4))) const Args* KArgP;
__device__ __forceinline__ KArgP kargs() { KArgP p = (KArgP)__builtin_amdgcn_kernarg_segment_ptr(); asm volatile("" : "+s"(p)); return p; }

__device__ __forceinline__ float bf2f(unsigned short h) { return __uint_as_float((unsigned)h << 16); }
__device__ __forceinline__ unsigned f2bf(float f) { unsigned u = __float_as_uint(f); return (u + 0x7fffu + ((u >> 16) & 1u)) >> 16; }
__device__ __forceinline__ unsigned pk2(float lo, float hi) { return f2bf(lo) | (f2bf(hi) << 16); }
__device__ __forceinline__ float wave_sum(float v) {
#pragma unroll
    for (int o = 1; o < 64; o <<= 1) v += __shfl_xor(v, o);
    return v;
}
__device__ __forceinline__ float silu_f(float g) { return g / (1.0f + __expf(-g)); }
__device__ __forceinline__ void sincos_r(float ang, float& s, float& c) {
    float r = ang * 0.15915494309189535f; r = r - __builtin_floorf(r);
    s = __builtin_amdgcn_sinf(r); c = __builtin_amdgcn_cosf(r);
}
__device__ __forceinline__ float inv_freq(int i, int half) { return __builtin_amdgcn_exp2f(-(float)i / (float)half * 13.287712379549449f); }

__device__ __forceinline__ void mod_item(KArgP a, int l, int cg, LAS unsigned char* lds) {
    const int tid = otid();
    float* MOD = (float*)(a->ws + WS_MOD);
    LAS float* S = (LAS float*)lds;
    LAS float* R = S + 1024 * 12;
    for (int i = tid; i < 9 * 1024; i += 512) { const int w = i >> 10, k = i & 1023; const float v = (w < 8) ? a->in[1][w * 1024 + k] : a->in[3][k]; S[k * 12 + w] = silu_f(v); }
    __syncthreads();
    const int nl = tid & 63, kp = tid >> 6, n0 = cg * 256;
    f32x4 acc[9];
#pragma unroll
    for (int w = 0; w < 9; ++w) acc[w] = (f32x4){0.f, 0.f, 0.f, 0.f};
    const float* wp = a->in[4] + (size_t)l * 1024 * 6144 + n0 + 4 * nl;
#pragma unroll 8
    for (int k = kp * 128; k < kp * 128 + 128; ++k) {
        const f32x4 wv = *(const f32x4*)(wp + (size_t)k * 6144);
        const f32x4 s0 = *(const LAS f32x4*)(S + k * 12), s1 = *(const LAS f32x4*)(S + k * 12 + 4); const float s8 = S[k * 12 + 8];
        acc[0] += wv * s0[0]; acc[1] += wv * s0[1]; acc[2] += wv * s0[2]; acc[3] += wv * s0[3];
        acc[4] += wv * s1[0]; acc[5] += wv * s1[1]; acc[6] += wv * s1[2]; acc[7] += wv * s1[3]; acc[8] += wv * s8;
    }
#pragma unroll
    for (int w = 0; w < 9; ++w) *(LAS f32x4*)(R + (kp * 9 + w) * 256 + 4 * nl) = acc[w];
    __syncthreads();
    for (int i = tid; i < 9 * 256; i += 512) { const int w = i >> 8, n2 = i & 255; float v = a->in[5][l * 6144 + n0 + n2];
#pragma unroll
        for (int p = 0; p < 8; ++p) v += R[(p * 9 + w) * 256 + n2];
        MOD[(size_t)(l * 9 + w) * 6144 + n0 + n2] = v; }
    __syncthreads();
}
__device__ __forceinline__ void convert_weights(KArgP a, int layer, LAS unsigned char* lds, int part, int gw, int NGW);
__device__ __forceinline__ void phase_prep(KArgP a, LAS unsigned char* lds) {
    const int tid = otid(), G = gridDim.x;
    if (blockIdx.x == 0) { if (tid < 64) ((unsigned*)(a->ws + WS_CTL))[tid] = 0u; for (int i = tid; i < 3456; i += 512) ((unsigned*)(a->ws + WS_CTL))[4096 + i] = 0u; }
    for (int item = blockIdx.x; item < 96; item += G) mod_item(a, item / 24, item % 24, lds);
    if ((int)blockIdx.x >= 96 && G > 96) {
        convert_weights(a, 0, lds, 0, ((int)blockIdx.x - 96) * 8 + (otid() >> 6), (G - 96) * 8); convert_weights(a, 0, lds, 1, ((int)blockIdx.x - 96) * 8 + (otid() >> 6), (G - 96) * 8); }
}

__device__ __forceinline__ void transpose_item(const float* W, int K, int N, bf16* WT, int k0, int n0, int drow0, LAS float* scr, int lane) {
    float tv_[32];
#pragma unroll
    for (int i = 0; i < 32; ++i) { const int kk = 2 * i + (lane >> 5); tv_[i] = W[(size_t)(k0 + kk) * N + n0 + (lane & 31)]; }
#pragma unroll
    for (int i = 0; i < 32; ++i) { const int kk = 2 * i + (lane >> 5); scr[kk * 33 + (lane & 31)] = tv_[i]; }
    asm volatile("s_waitcnt lgkmcnt(0)" ::: "memory");
    const int c = lane & 7;
#pragma unroll
    for (int j = 0; j < 4; ++j) { const int n = (lane >> 3) + 8 * j; const LAS float* s = scr + (8 * c) * 33 + n;
        u32x4 o; o.x = pk2(s[0 * 33], s[1 * 33]); o.y = pk2(s[2 * 33], s[3 * 33]); o.z = pk2(s[4 * 33], s[5 * 33]); o.w = pk2(s[6 * 33], s[7 * 33]);
        *(u32x4*)(WT + (size_t)(drow0 + n) * K + k0 + 8 * c) = o; }
    asm volatile("s_waitcnt lgkmcnt(0)" ::: "memory");
}
__device__ __forceinline__ void convert_weights(KArgP a, int layer, LAS unsigned char* lds, int part, int gw, int NGW) {
    const int lane = otid() & 63, wave = otid() >> 6;
    LAS float* scr = (LAS float*)(lds + wave * 8448);
    const bool even = !(layer & 1); const int e = layer >> 1;
    unsigned char* Wb = a->ws + WS_W;
    if (part == 0) {
        const int nin = even ? 3232 : 3072;
        const float* w_in = even ? a->in[11] + (size_t)e * 1024 * 3232 : a->in[18] + (size_t)e * 1024 * 3072;
        const int nbin = nin / 32;
        const int I_IN = 16 * nbin, I_OUT = 512, I_UQ = even ? 6 * 24 : 0, I_UKV = even ? 4 * 32 : 0;
        const int NIT = I_IN + I_OUT + I_UQ + I_UKV;
        for (int it = gw; it < NIT; it += NGW) {
            int r = it;
            if (r < I_IN) { const int kb = r / nbin, nb = r % nbin; transpose_item(w_in, 1024, nin, (bf16*)(Wb + W_IN), 64 * kb, 32 * nb, 32 * nb, scr, lane); continue; } r -= I_IN;
            if (r < I_OUT) { const int kb = r / 32, nb = r % 32; transpose_item(a->in[7] + (size_t)layer * 1024 * 1024, 1024, 1024, (bf16*)(Wb + W_OUT), 64 * kb, 32 * nb, 32 * nb, scr, lane); continue; } r -= I_OUT;
            if (r < I_UQ) { const int kb = r / 24, nb = r % 24; transpose_item(a->in[15] + (size_t)e * 384 * 768, 384, 768, (bf16*)(Wb + W_UQ), 64 * kb, 32 * nb, 32 * nb, scr, lane); continue; } r -= I_UQ;
            { const int kb = r / 32, nb = r % 32; transpose_item(a->in[17] + (size_t)e * 256 * 1024, 256, 1024, (bf16*)(Wb + W_UKV), 64 * kb, 32 * nb, 32 * nb, scr, lane); }
        }
    } else {
        constexpr int I_G = 16 * 88, I_D = 44 * 32;
        for (int it = gw; it < 2 * I_G + I_D; it += NGW) {
            int r = it;
            if (r < I_G) { const int kb = r / 88, nb = r % 88, n0 = 32 * nb; transpose_item(a->in[8] + (size_t)layer * 1024 * FF, 1024, FF, (bf16*)(Wb + W_GU), 64 * kb, n0, (n0 >> 7) * 256 + (n0 & 127), scr, lane); continue; } r -= I_G;
            if (r < I_G) { const int kb = r / 88, nb = r % 88, n0 = 32 * nb; transpose_item(a->in[9] + (size_t)layer * 1024 * FF, 1024, FF, (bf16*)(Wb + W_GU), 64 * kb, n0, (n0 >> 7) * 256 + 128 + (n0 & 127), scr, lane); continue; } r -= I_G;
            { const int kb = r / 32, nb = r % 32; transpose_item(a->in[10] + (size_t)layer * FF * 1024, FF, 1024, (bf16*)(Wb + W_DN), 64 * kb, 32 * nb, 32 * nb, scr, lane); }
        }
    }
}

__device__ __forceinline__ f32x4 ld4_bf16(const bf16* p) { const u32x2 w = *(const u32x2*)p; return (f32x4){__uint_as_float(w.x << 16), __uint_as_float(w.x & 0xffff0000u), __uint_as_float(w.y << 16), __uint_as_float(w.y & 0xffff0000u)}; }
__device__ __forceinline__ void phase_norm(KArgP a, int layer, int which, bool addT) {
    const int lane = otid() & 63, wave = otid() >> 6;
    const int gw = blockIdx.x * 8 + wave, NGW = gridDim.x * 8;
    bf16* X = (bf16*)(a->ws + WS_X); bf16* H = (bf16*)(a->ws + WS_H); const float* T = (const float*)(a->ws + WS_T);
    const float* g = a->in[6] + (layer * 2 + which) * 1024;
    const float* mod = (const float*)(a->ws + WS_MOD) + (size_t)layer * 9 * 6144;
    const int shoff = which ? 3072 : 0, scoff = which ? 4096 : 1024;
    const bool from_inputs = (layer == 0 && which == 0);
    constexpr int RB = 3;
    for (int r0 = gw; r0 < MT; r0 += RB * NGW) {
        f32x4 v[RB][4];
#pragma unroll
        for (int k = 0; k < RB; ++k) { const int row = r0 + k * NGW; if (row < MT) {
            if (from_inputs) { const int b = row / TPB, j = row - b * TPB; const float* xr = (j < 256 ? a->in[2] + (size_t)(b * 256 + j) * 1024 : a->in[0] + (size_t)(b * NLAT + j - 256) * 1024) + 8 * lane;
#pragma unroll
                for (int q = 0; q < 2; ++q) { v[k][2 * q] = *(const f32x4*)(xr + 512 * q); v[k][2 * q + 1] = *(const f32x4*)(xr + 512 * q + 4); } }
            else {
#pragma unroll
                for (int q = 0; q < 2; ++q) { const u32x4 w = *(const u32x4*)(X + (size_t)row * 1024 + 8 * lane + 512 * q);
                    v[k][2 * q] = (f32x4){__uint_as_float(w.x << 16), __uint_as_float(w.x & 0xffff0000u), __uint_as_float(w.y << 16), __uint_as_float(w.y & 0xffff0000u)};
                    v[k][2 * q + 1] = (f32x4){__uint_as_float(w.z << 16), __uint_as_float(w.z & 0xffff0000u), __uint_as_float(w.w << 16), __uint_as_float(w.w & 0xffff0000u)}; } } } }
#pragma unroll
        for (int k = 0; k < RB; ++k) { const int row = r0 + k * NGW; if (row < MT) {
            const int b = row / TPB, j = row - b * TPB, widx = (j < 256) ? 8 : b;
            if (addT && j < 256) { const float* tr = T + (size_t)(b * 256 + j) * 1024 + 8 * lane;
#pragma unroll
                for (int q = 0; q < 2; ++q) { v[k][2 * q] = v[k][2 * q] + *(const f32x4*)(tr + 512 * q); v[k][2 * q + 1] = v[k][2 * q + 1] + *(const f32x4*)(tr + 512 * q + 4);
                    u32x4 w; w.x = pk2(v[k][2 * q][0], v[k][2 * q][1]); w.y = pk2(v[k][2 * q][2], v[k][2 * q][3]); w.z = pk2(v[k][2 * q + 1][0], v[k][2 * q + 1][1]); w.w = pk2(v[k][2 * q + 1][2], v[k][2 * q + 1][3]);
                    *(u32x4*)(X + (size_t)row * 1024 + 8 * lane + 512 * q) = w; } }
            float ss = 0.f;
#pragma unroll
            for (int q = 0; q < 4; ++q) ss += (v[k][q][0] * v[k][q][0] + v[k][q][1] * v[k][q][1]) + (v[k][q][2] * v[k][q][2] + v[k][q][3] * v[k][q][3]);
            const float rstd = __builtin_amdgcn_rsqf(wave_sum(ss) * (1.f / 1024.f) + EPSN);
#pragma unroll
            for (int q = 0; q < 2; ++q) { const int col = 8 * lane + 512 * q; f32x4 y[2];
#pragma unroll
                for (int hh = 0; hh < 2; ++hh) { const f32x4 gv = *(const f32x4*)(g + col + 4 * hh), sc = *(const f32x4*)(mod + widx * 6144 + scoff + col + 4 * hh), sh = *(const f32x4*)(mod + widx * 6144 + shoff + col + 4 * hh);
                    y[hh] = v[k][2 * q + hh] * rstd * gv * (sc + 1.0f) + sh; }
                u32x4 w; w.x = pk2(y[0][0], y[0][1]); w.y = pk2(y[0][2], y[0][3]); w.z = pk2(y[1][0], y[1][1]); w.w = pk2(y[1][2], y[1][3]);
                { bf16* sp_ = H + (size_t)row * 1024 + col; asm volatile("global_store_dwordx4 %0, %1, off sc1\n\ts_nop 1" :: "v"(sp_), "v"(w) : "memory"); } } } }
    }
}

__device__ __forceinline__ void phase_post_even(KArgP a, int layer) {
    const int lane = otid() & 63, wave = otid() >> 6;
    const int gw = blockIdx.x * 8 + wave, NGW = gridDim.x * 8, e = layer >> 1;
    const bf16* P = (const bf16*)(a->ws + WS_P); bf16* CQN = (bf16*)(a->ws + WS_CQN); bf16* CKVN = (bf16*)(a->ws + WS_CKVN); bf16* KR = (bf16*)(a->ws + WS_KR);
    const float* qg = a->in[14] + e * 384; const float* kg = a->in[16] + e * 256;
    for (int row = gw; row < MT; row += NGW) {
        const int b = row / TPB, j = row - b * TPB;
        const bf16* pr = P + (size_t)row * NP_E;
        {   float x[6]; float ss = 0.f;
#pragma unroll
            for (int k = 0; k < 3; ++k) { const unsigned w = *(const unsigned*)(pr + 2560 + 2 * lane + 128 * k); x[2 * k] = bf2f((unsigned short)(w & 0xffff)); x[2 * k + 1] = bf2f((unsigned short)(w >> 16)); ss += x[2 * k] * x[2 * k] + x[2 * k + 1] * x[2 * k + 1]; }
            const float rstd = __builtin_amdgcn_rsqf(wave_sum(ss) * (1.f / 384.f) + EPSN);
#pragma unroll
            for (int k = 0; k < 3; ++k) { const int col = 2 * lane + 128 * k; *(unsigned*)(CQN + (size_t)row * 384 + col) = pk2(x[2 * k] * rstd * qg[col], x[2 * k + 1] * rstd * qg[col + 1]); } }
        {   float x[4]; float ss = 0.f;
#pragma unroll
            for (int k = 0; k < 2; ++k) { const unsigned w = *(const unsigned*)(pr + 2944 + 2 * lane + 128 * k); x[2 * k] = bf2f((unsigned short)(w & 0xffff)); x[2 * k + 1] = bf2f((unsigned short)(w >> 16)); ss += x[2 * k] * x[2 * k] + x[2 * k + 1] * x[2 * k + 1]; }
            const float rstd = __builtin_amdgcn_rsqf(wave_sum(ss) * (1.f / 256.f) + EPSN);
#pragma unroll
            for (int k = 0; k < 2; ++k) { const int col = 2 * lane + 128 * k; *(unsigned*)(CKVN + (size_t)row * 256 + col) = pk2(x[2 * k] * rstd * kg[col], x[2 * k + 1] * rstd * kg[col + 1]); } }
        {   const int d = lane & 31; const float x = bf2f(pr[3200 + d]); const float xp = __shfl_xor(x, 8);
            float o = x;
            if (j >= 256) { const int t = j - 256, blk = d >> 4, wi = d & 15, i8 = wi & 7; const float pos = (float)(blk ? (t & 63) : (t >> 6));
                float s, c; sincos_r(pos * inv_freq(i8, 8), s, c);
                o = (wi < 8) ? (x * c - xp * s) : (xp * s + x * c); }
            if (lane < 32) KR[(size_t)row * 32 + d] = (bf16)f2bf(o); }
    }
}
__device__ __forceinline__ void phase_post_odd(KArgP a, int layer) {
    const int lane = otid() & 63, wave = otid() >> 6;
    const int gw = blockIdx.x * 8 + wave, NGW = gridDim.x * 8;
    bf16* P = (bf16*)(a->ws + WS_P);
    for (int row = gw; row < MT; row += NGW) {
        const int b = row / TPB, j = row - b * TPB; const bool lat = j >= 256; const int t = j - 256;
        bf16* pr = P + (size_t)row * NP_O;
#pragma unroll
        for (int u = 0; u < 2; ++u) { const int pid = lane + 64 * u, h = pid >> 5, i = pid & 31, d1 = h * 64 + i, d2 = d1 + 32;
            float s = 0.f, c = 1.f; if (lat) sincos_r((float)t * inv_freq(i, 32), s, c);
            const float q1 = bf2f(pr[d1]), q2 = bf2f(pr[d2]), k1 = bf2f(pr[256 + d1]) * 0.125f, k2 = bf2f(pr[256 + d2]) * 0.125f;
            if (lat) { pr[d1] = (bf16)f2bf(q1 * c - q2 * s); pr[d2] = (bf16)f2bf(q1 * s + q2 * c); }
            pr[256 + d1] = (bf16)f2bf(k1 * c - k2 * s); pr[256 + d2] = (bf16)f2bf(k1 * s + k2 * c); }
        if (lat) {
#pragma unroll
            for (int u = 0; u < 4; ++u) { const int pid = lane + 64 * u, vec = pid >> 5, pp = pid & 31, blk = pp >> 4, i = pp & 15, d1 = vec * 64 + blk * 32 + i, d2 = d1 + 16;
                const float pos = (float)(blk ? (t & 63) : (t >> 6)); float s, c; sincos_r(pos * inv_freq(i, 16), s, c);
                const float q1 = bf2f(pr[1536 + d1]), q2 = bf2f(pr[1536 + d2]), k1 = bf2f(pr[2048 + d1]), k2 = bf2f(pr[2048 + d2]);
                pr[1536 + d1] = (bf16)f2bf(q1 * c - q2 * s); pr[1536 + d2] = (bf16)f2bf(q1 * s + q2 * c);
                pr[2048 + d1] = (bf16)f2bf(k1 * c - k2 * s); pr[2048 + d2] = (bf16)f2bf(k1 * s + k2 * c); } }
    }
}

__device__ __forceinline__ void phase_readout(KArgP a, int layer) {
    const int lane = otid() & 63, wave = otid() >> 6;
    const int gw = blockIdx.x * 8 + wave, NGW = gridDim.x * 8;
    const bool even = !(layer & 1); const int np = even ? NP_E : NP_O, gcol = even ? 2048 : 1024;
    const bf16* P = (const bf16*)(a->ws + WS_P); const bf16* OF = (const bf16*)(a->ws + WS_OSC); const bf16* OB = OF + (size_t)MT * 512;
    bf16* MIX = (bf16*)(a->ws + WS_MIX);
    const int col = 8 * lane;
    float gn[8];
#pragma unroll
    for (int i = 0; i < 8; ++i) gn[i] = even ? a->in[13][(layer >> 1) * 128 + ((col + i) & 127)] : 1.f;
    constexpr int RB = 3;
    for (int r0 = gw; r0 < MT; r0 += RB * NGW) {
        u32x4 wf[RB], wb[RB], wg[RB];
#pragma unroll
        for (int k = 0; k < RB; ++k) { const int row = r0 + k * NGW; if (row < MT) {
            wf[k] = *(const u32x4*)(OF + (size_t)row * 512 + col); wb[k] = *(const u32x4*)(OB + (size_t)row * 512 + col); wg[k] = *(const u32x4*)(P + (size_t)row * np + gcol + col); } }
#pragma unroll
        for (int k = 0; k < RB; ++k) { const int row = r0 + k * NGW; if (row < MT) {
            float o[8], gt[8]; float ss = 0.f;
#pragma unroll
            for (int i = 0; i < 4; ++i) { const unsigned f = wf[k][i], bb = wb[k][i], gg = wg[k][i];
                o[2 * i] = __uint_as_float(f << 16) + __uint_as_float(bb << 16); o[2 * i + 1] = __uint_as_float(f & 0xffff0000u) + __uint_as_float(bb & 0xffff0000u);
                gt[2 * i] = __uint_as_float(gg << 16); gt[2 * i + 1] = __uint_as_float(gg & 0xffff0000u);
                ss += o[2 * i] * o[2 * i] + o[2 * i + 1] * o[2 * i + 1]; }
            ss += __shfl_xor(ss, 1); ss += __shfl_xor(ss, 2); ss += __shfl_xor(ss, 4); ss += __shfl_xor(ss, 8);
            const float rstd = __builtin_amdgcn_rsqf(ss * (1.f / 128.f) + EPSN);
            u32x4 w;
#pragma unroll
            for (int i = 0; i < 4; ++i) w[i] = pk2(o[2 * i] * rstd * gn[2 * i] * silu_f(gt[2 * i]), o[2 * i + 1] * rstd * gn[2 * i + 1] * silu_f(gt[2 * i + 1]));
            *(u32x4*)(MIX + (size_t)row * 1024 + col) = w; } }
    }
}
__device__ __forceinline__ void phase_final(KArgP a) {
    const int lane = otid() & 63, wave = otid() >> 6;
    const int gw = blockIdx.x * 8 + wave, NGW = gridDim.x * 8;
    const bf16* X = (const bf16*)(a->ws + WS_X); const float* g = a->in[22];
    constexpr int RB = 4;
    for (int r0 = gw; r0 < NB * NLAT; r0 += RB * NGW) {
        f32x4 v[RB][4];
#pragma unroll
        for (int k = 0; k < RB; ++k) { const int r = r0 + k * NGW; if (r < NB * NLAT) { const int row = (r >> 11) * TPB + 256 + (r & 2047);
#pragma unroll
            for (int q = 0; q < 2; ++q) { const u32x4 w = *(const u32x4*)(X + (size_t)row * 1024 + 8 * lane + 512 * q);
                v[k][2 * q] = (f32x4){__uint_as_float(w.x << 16), __uint_as_float(w.x & 0xffff0000u), __uint_as_float(w.y << 16), __uint_as_float(w.y & 0xffff0000u)};
                v[k][2 * q + 1] = (f32x4){__uint_as_float(w.z << 16), __uint_as_float(w.z & 0xffff0000u), __uint_as_float(w.w << 16), __uint_as_float(w.w & 0xffff0000u)}; } } }
#pragma unroll
        for (int k = 0; k < RB; ++k) { const int r = r0 + k * NGW; if (r < NB * NLAT) { float ss = 0.f;
#pragma unroll
            for (int q = 0; q < 4; ++q) ss += (v[k][q][0] * v[k][q][0] + v[k][q][1] * v[k][q][1]) + (v[k][q][2] * v[k][q][2] + v[k][q][3] * v[k][q][3]);
            const float rstd = __builtin_amdgcn_rsqf(wave_sum(ss) * (1.f / 1024.f) + EPSN);
#pragma unroll
            for (int q = 0; q < 4; ++q) { const int col = 8 * lane + 512 * (q >> 1) + 4 * (q & 1); const f32x4 gv = *(const f32x4*)(g + col);
                *(f32x4*)(a->out + (size_t)r * 1024 + col) = v[k][q] * rstd * gv; } } }
    }
}
__device__ __forceinline__ unsigned cvtpk2(float lo, float hi) { unsigned r; asm("v_cvt_pk_bf16_f32 %0, %1, %2" : "=v"(r) : "v"(lo), "v"(hi)); return r; }
__device__ __forceinline__ f32x4 mfma16(bf16x8 a, bf16x8 b, f32x4 c) { return __builtin_amdgcn_mfma_f32_16x16x32_bf16(a, b, c, 0, 0, 0); }

template <int DK, bool HG, int MODE>
__device__ __forceinline__ void scan_item(KArgP a, int layer, int item, int seg, LAS unsigned char* lds) {
    const int tid = otid(), wid = tid >> 6, lane = tid & 63, l15 = lane & 15, q4 = lane >> 4;
    const int h = item & 3, dir = (item >> 2) & 1, b = item >> 3;
    constexpr int TPT = DK / 8, QS = DK * 2 + 16, TS = 144;
    constexpr int NP = HG ? NP_E : NP_O;
    LAS unsigned char* Lqt = lds; LAS unsigned char* Lkt = Lqt + 64 * QS; LAS unsigned char* Lqh = Lkt + 64 * QS;
    LAS unsigned char* LkhT = Lqh + 64 * QS; LAS unsigned char* LvT = LkhT + DK * TS; LAS unsigned char* Latt = LvT + 128 * TS;
    LAS float* Ltot = (LAS float*)(Latt + 64 * TS); LAS float* Lbl = Ltot + 512;
    const bf16* P = (const bf16*)(a->ws + WS_P);
    bf16* OSC = (bf16*)(a->ws + WS_OSC) + (size_t)dir * MT * 512;
    f32x4* Ub = (f32x4*)(a->ws + WS_U); float* Lb = (float*)(a->ws + WS_LSUM);
    const int c = tid & (DK - 1), tq = tid / DK;
    float lb = 0.f, lg = 0.f, qscale = 1.f; int qcol, zcol;
    if (HG) { qscale = 0.08838834764831845f; qcol = h * 128 + c; zcol = (dir ? 1536 : 1024) + h * 128 + c;
        if (layer >= 2) { const float l0 = a->in[12][(0 * 2 + dir) * 512 + h * 128 + c], l1 = a->in[12][(1 * 2 + dir) * 512 + h * 128 + c]; lb = 1.f / (1.f + __expf(l0 - l1)); } }
    else { qcol = h * 64 + c; zcol = 256 + h * 64 + c; const float x = a->in[19][((layer >> 1) * 2 + dir) * 4 + h]; lg = -__logf(1.f + __expf(-x)); }
    const int vcol = 512 + h * 128;
    const int rowbase = b * TPB;
    const int tv = lane, c8v = wid;
    unsigned short rq[TPT], rz[TPT]; bf16x8 rv[2];
#define SC_JB(ci) (dir ? ((ci) < 4 ? 255 - 64 * (ci) : 2303 - 64 * ((ci) - 4)) : 64 * (ci))
#define SC_LOAD(ci) do { const int jb_ = SC_JB(ci), sg_ = dir ? -1 : 1; \
        _Pragma("unroll") for (int i = 0; i < TPT; ++i) { const bf16* pr_ = P + (size_t)(rowbase + jb_ + sg_ * (tq * TPT + i)) * NP; if (MODE) rq[i] = pr_[qcol]; rz[i] = pr_[zcol]; } \
        { const bf16* pv_ = P + (size_t)(rowbase + jb_ + sg_ * tv) * NP + vcol; rv[0] = *(const bf16x8*)(pv_ + c8v * 8); rv[1] = *(const bf16x8*)(pv_ + (c8v + 8) * 8); } } while (0)
    f32x4 Sacc[DK / 16];
#pragma unroll
    for (int i = 0; i < DK / 16; ++i) Sacc[i] = (f32x4){0.f, 0.f, 0.f, 0.f};
    const int c0 = 9 * seg;
    SC_LOAD(c0);
    if (MODE) {
        for (int s_ = 0; s_ < seg; ++s_) {
#pragma unroll
            for (int i = 0; i < DK / 16; ++i) { f32x4 v = Sacc[i];
                if (s_ > 0) { const f32x4 l4 = *(const f32x4*)(Lb + (size_t)(item * 3 + s_) * 128 + 16 * i + 4 * q4); v[0] *= __expf(l4[0]); v[1] *= __expf(l4[1]); v[2] *= __expf(l4[2]); v[3] *= __expf(l4[3]); }
                Sacc[i] = v + Ub[((size_t)(item * 3 + s_) * (DK / 16) + i) * 512 + tid]; }
        }
    }
    float lsum = 0.f;
    for (int ci = c0; ci < c0 + 9; ++ci) {
#pragma unroll
        for (int u = 0; u < 2; ++u)
#pragma unroll
            for (int e = 0; e < 8; ++e) *(LAS unsigned short*)(LvT + ((c8v + 8 * u) * 8 + e) * TS + tv * 2) = (unsigned short)rv[u][e];
        float zf[TPT], qf[TPT];
#pragma unroll
        for (int i = 0; i < TPT; ++i) { zf[i] = bf2f(rz[i]); if (MODE) qf[i] = bf2f(rq[i]) * qscale; }
        const int jb = SC_JB(ci), sg = dir ? -1 : 1;
        if (ci + 1 < c0 + 9) SC_LOAD(ci + 1);
        float kk_[TPT], e1v[TPT], e2v[TPT]; float Eref, Ebr, dlast;
        if (HG) {
            float fv[TPT];
#pragma unroll
            for (int i = 0; i < TPT; ++i) { const float z = fminf(fmaxf(zf[i], -30.f), 30.f);
                const float t = __expf(-fabsf(z)), r = __builtin_amdgcn_rcpf(1.f + t), tr = t * r;
                const float sig = z >= 0.f ? r : tr, sigm = z >= 0.f ? tr : r;
                kk_[i] = (1.f - lb) * sigm; fv[i] = lb + (1.f - lb) * sig; }
            float run = 1.f;
            if (tq < 2) {
#pragma unroll
                for (int i = TPT - 1; i >= 0; --i) { e2v[i] = run; run *= fv[i]; }
            } else {
#pragma unroll
                for (int i = 0; i < TPT; ++i) { run *= fv[i]; e1v[i] = run; }
            }
            Ltot[tq * 128 + c] = run;
            __syncthreads();
            const float t0 = Ltot[c], t1 = Ltot[128 + c], t2 = Ltot[256 + c], t3 = Ltot[384 + c];
            Eref = t0 * t1; Ebr = t2 * t3; dlast = Eref * Ebr;
            const float mul = (tq == 0) ? t1 : ((tq == 3) ? t2 : 1.f);
            if (tq < 2) {
#pragma unroll
                for (int i = 0; i < TPT; ++i) { e2v[i] = fmaxf(e2v[i] * mul, 1e-30f); if (MODE) e1v[i] = __builtin_amdgcn_rcpf(e2v[i]); }
            } else {
#pragma unroll
                for (int i = 0; i < TPT; ++i) { e1v[i] = fmaxf(e1v[i] * mul, 1e-30f); e2v[i] = __builtin_amdgcn_rcpf(e1v[i]); }
            }
            lsum += __logf(fmaxf(dlast, 1e-37f));
        } else {
#pragma unroll
            for (int i = 0; i < TPT; ++i) { kk_[i] = zf[i]; e1v[i] = __expf((float)(tq * TPT + i - 31) * lg); e2v[i] = __builtin_amdgcn_rcpf(e1v[i]); }
            Eref = __expf(32.f * lg); Ebr = Eref; dlast = Eref * Ebr;
            lsum += 64.f * lg;
        }
        unsigned short kh[TPT];
        if (MODE) {
#pragma unroll
            for (int i = 0; i < TPT; ++i) { const int tau = tq * TPT + i;
                const float qt = qf[i] * e1v[i], kt = kk_[i] * e2v[i];
                const unsigned wq = cvtpk2(qt, qt * Eref), wk = cvtpk2(kt, kt * Ebr);
                *(LAS unsigned short*)(Lqt + tau * QS + c * 2) = (unsigned short)(wq & 0xffff);
                *(LAS unsigned short*)(Lqh + tau * QS + c * 2) = (unsigned short)(wq >> 16);
                *(LAS unsigned short*)(Lkt + tau * QS + c * 2) = (unsigned short)(wk & 0xffff);
                kh[i] = (unsigned short)(wk >> 16); }
        } else {
#pragma unroll
            for (int i = 0; i < TPT; ++i) kh[i] = (unsigned short)(cvtpk2(kk_[i] * e2v[i] * Ebr, 0.f) & 0xffff);
        }
#pragma unroll
        for (int i8 = 0; i8 < TPT / 8; ++i8) { u32x4 w; w.x = kh[8 * i8] | ((unsigned)kh[8 * i8 + 1] << 16); w.y = kh[8 * i8 + 2] | ((unsigned)kh[8 * i8 + 3] << 16);
            w.z = kh[8 * i8 + 4] | ((unsigned)kh[8 * i8 + 5] << 16); w.w = kh[8 * i8 + 6] | ((unsigned)kh[8 * i8 + 7] << 16);
            *(LAS u32x4*)(LkhT + c * TS + (tq * TPT + 8 * i8) * 2) = w; }
        if (tq == 0) Lbl[c] = dlast;
        __syncthreads();
        const int dvl = 16 * wid + l15;
        const bf16x8 bv0 = *(const LAS bf16x8*)(LvT + dvl * TS + (8 * q4) * 2), bv1 = *(const LAS bf16x8*)(LvT + dvl * TS + (32 + 8 * q4) * 2);
        if (MODE) {
#pragma unroll
            for (int tt = 0; tt < 2; ++tt) { const int idx = 2 * wid + tt, si = idx >> 2, ti = idx & 3;
                f32x4 acc = (f32x4){0.f, 0.f, 0.f, 0.f};
#pragma unroll
                for (int kk = 0; kk < DK / 32; ++kk) { const bf16x8 A = *(const LAS bf16x8*)(Lkt + (16 * si + l15) * QS + (32 * kk + 8 * q4) * 2);
                    const bf16x8 B = *(const LAS bf16x8*)(Lqt + (16 * ti + l15) * QS + (32 * kk + 8 * q4) * 2); acc = mfma16(A, B, acc); }
                const int t = 16 * ti + l15, s0 = 16 * si + 4 * q4;
                u32x2 w; w.x = pk2(s0 + 0 <= t ? acc[0] : 0.f, s0 + 1 <= t ? acc[1] : 0.f); w.y = pk2(s0 + 2 <= t ? acc[2] : 0.f, s0 + 3 <= t ? acc[3] : 0.f);
                *(LAS u32x2*)(Latt + t * TS + s0 * 2) = w; }
            __syncthreads();
            bf16x8 Sb[DK / 32];
#pragma unroll
            for (int kk = 0; kk < DK / 32; ++kk) { u32x4 w; w.x = pk2(Sacc[2 * kk][0], Sacc[2 * kk][1]); w.y = pk2(Sacc[2 * kk][2], Sacc[2 * kk][3]);
                w.z = pk2(Sacc[2 * kk + 1][0], Sacc[2 * kk + 1][1]); w.w = pk2(Sacc[2 * kk + 1][2], Sacc[2 * kk + 1][3]); Sb[kk] = __builtin_bit_cast(bf16x8, w); }
#pragma unroll
            for (int ti = 0; ti < 4; ++ti) {
                f32x4 acc = (f32x4){0.f, 0.f, 0.f, 0.f};
                { const bf16x8 A = *(const LAS bf16x8*)(Latt + (16 * ti + l15) * TS + (8 * q4) * 2); acc = mfma16(A, bv0, acc); }
                if (ti >= 2) { const bf16x8 A = *(const LAS bf16x8*)(Latt + (16 * ti + l15) * TS + (32 + 8 * q4) * 2); acc = mfma16(A, bv1, acc); }
#pragma unroll
                for (int kk = 0; kk < DK / 32; ++kk) {
                    const s16x4 lo = *(const LAS s16x4*)(Lqh + (16 * ti + l15) * QS + (32 * kk + 4 * q4) * 2), hi = *(const LAS s16x4*)(Lqh + (16 * ti + l15) * QS + (32 * kk + 16 + 4 * q4) * 2);
                    const bf16x8 A = (bf16x8){lo[0], lo[1], lo[2], lo[3], hi[0], hi[1], hi[2], hi[3]};
                    acc = mfma16(A, Sb[kk], acc); }
#pragma unroll
                for (int r = 0; r < 4; ++r) { const int t = 16 * ti + 4 * q4 + r;
                    OSC[(size_t)(rowbase + jb + sg * t) * 512 + h * 128 + dvl] = (bf16)f2bf(acc[r]); }
            }
        }
#pragma unroll
        for (int i = 0; i < DK / 16; ++i) {
            const f32x4 d4 = *(const LAS f32x4*)(Lbl + 16 * i + 4 * q4);
            f32x4 s = Sacc[i] * d4;
            const bf16x8 A0 = *(const LAS bf16x8*)(LkhT + (16 * i + l15) * TS + (8 * q4) * 2), A1 = *(const LAS bf16x8*)(LkhT + (16 * i + l15) * TS + (32 + 8 * q4) * 2);
            s = mfma16(A0, bv0, s); s = mfma16(A1, bv1, s); Sacc[i] = s; }
        __syncthreads();
    }
    if (!MODE) {
#pragma unroll
        for (int i = 0; i < DK / 16; ++i) Ub[((size_t)(item * 3 + seg) * (DK / 16) + i) * 512 + tid] = Sacc[i];
        if (tq == 0) Lb[(size_t)(item * 3 + seg) * 128 + c] = lsum;
    }
#undef SC_JB
#undef SC_LOAD
}

#define SBAR() __builtin_amdgcn_sched_barrier(0)
__device__ __forceinline__ int crow(int r, int hi) { return (r & 3) + 8 * (r >> 2) + 4 * hi; }
__device__ __forceinline__ unsigned cvtpk(float lo, float hi) { unsigned r; asm volatile("v_cvt_pk_bf16_f32 %0, %1, %2" : "=v"(r) : "v"(lo), "v"(hi)); return r; }
__device__ __forceinline__ void partialSM(f32x16& p0, f32x16& p1, float& m_reg, float& mn, float& alpha, float C, float thr_raw) {
    float pmax = p0[0];
#pragma unroll
    for (int r = 1; r < 16; ++r) pmax = fmaxf(pmax, p0[r]);
#pragma unroll
    for (int r = 0; r < 16; ++r) pmax = fmaxf(pmax, p1[r]);
    { auto rr = __builtin_amdgcn_permlane32_swap(__float_as_uint(pmax), __float_as_uint(pmax), false, false);
      pmax = fmaxf(__uint_as_float(rr[0]), __uint_as_float(rr[1])); }
    if (__builtin_expect(__all(pmax - m_reg <= thr_raw), 1)) { mn = m_reg; alpha = 1.f; }
    else { mn = fmaxf(m_reg, pmax); alpha = __builtin_amdgcn_exp2f((m_reg - mn) * C); m_reg = mn; }
    const float mnC = -mn * C;
#pragma unroll
    for (int r = 0; r < 16; ++r) p0[r] = fmaf(p0[r], C, mnC);
#pragma unroll
    for (int r = 0; r < 16; ++r) p1[r] = fmaf(p1[r], C, mnC);
#pragma unroll
    for (int r = 0; r < 16; ++r) p0[r] = __builtin_amdgcn_exp2f(p0[r]);
}
__device__ __forceinline__ void finishSM(f32x16& p0, f32x16& p1, float alpha, float& l_reg, bf16x8& pa0, bf16x8& pa1, bf16x8& pa2, bf16x8& pa3) {
#pragma unroll
    for (int r = 0; r < 16; ++r) p1[r] = __builtin_amdgcn_exp2f(p1[r]);
    float ps = 0;
#pragma unroll
    for (int r = 0; r < 16; ++r) ps += p0[r];
#pragma unroll
    for (int r = 0; r < 16; ++r) ps += p1[r];
    { auto rr = __builtin_amdgcn_permlane32_swap(__float_as_uint(ps), __float_as_uint(ps), false, false);
      ps = __uint_as_float(rr[0]) + __uint_as_float(rr[1]); }
    l_reg = l_reg * alpha + ps;
#define PK4(P, BASE, OUT) do { unsigned a0 = cvtpk(P[BASE + 0], P[BASE + 1]), a1 = cvtpk(P[BASE + 2], P[BASE + 3]);   \
    unsigned b0 = cvtpk(P[BASE + 4], P[BASE + 5]), b1 = cvtpk(P[BASE + 6], P[BASE + 7]);                              \
    auto r0 = __builtin_amdgcn_permlane32_swap(a0, b0, false, false); auto r1 = __builtin_amdgcn_permlane32_swap(a1, b1, false, false); \
    u32x4 w = {r0[0], r1[0], r0[1], r1[1]}; OUT = __builtin_bit_cast(bf16x8, w); } while (0)
    PK4(p0, 0, pa0); PK4(p0, 8, pa1); PK4(p1, 0, pa2); PK4(p1, 8, pa3);
#undef PK4
}
template <int ND0, int KROWB>
__device__ __forceinline__ void qkt(f32x16& p0, f32x16& p1, const char* Ks, const bf16x8* qr, int r32, int hi) {
    p0 = f32x16{}; p1 = f32x16{};
#pragma unroll
    for (int d0 = 0; d0 < ND0; ++d0) { const int cb = (d0 * 16 + hi * 8) * 2;
        const bf16x8 b0 = *reinterpret_cast<const bf16x8*>(Ks + r32 * KROWB + (cb ^ ((r32 & 7) << 4)));
        const bf16x8 b1 = *reinterpret_cast<const bf16x8*>(Ks + (32 + r32) * KROWB + (cb ^ ((r32 & 7) << 4)));
        p0 = __builtin_amdgcn_mfma_f32_32x32x16_bf16(b0, qr[d0], p0, 0, 0, 0);
        p1 = __builtin_amdgcn_mfma_f32_32x32x16_bf16(b1, qr[d0], p1, 0, 0, 0); }
}
template <int NCB> __device__ __forceinline__ int v_st(int k, int c) { const int kk = (k & ~0xC) | ((k & 4) << 1) | ((k & 8) >> 1); return ((kk >> 3) * NCB + (c >> 5)) * 512 + ((kk & 7) * 32 + (c & 31)) * 2; }
__device__ __forceinline__ int v_rd_base(int lane) { return ((lane & 3) << 3) | (((lane >> 2) & 3) << 6) | (((lane >> 4) & 1) << 5) | (((lane >> 5) & 1) << 8); }
template <int OFF> __device__ __forceinline__ s16x4 tr_read(int vb) {
    s16x4 r; asm volatile("ds_read_b64_tr_b16 %0, %1 offset:%2" : "=&v"(r) : "v"(vb), "i"(OFF) : "memory"); return r;
}
template <int NCB, int D0> __device__ __forceinline__ void pv_one(f32x16& od, int vb, bf16x8 pa0, bf16x8 pa1, bf16x8 pa2, bf16x8 pa3) {
#define VOFF(ks, half) (D0 * 512 + (ks) * (NCB * 1024) + (half) * (NCB * 512))
    const s16x4 l0 = tr_read<VOFF(0, 0)>(vb), h0 = tr_read<VOFF(0, 1)>(vb), l1 = tr_read<VOFF(1, 0)>(vb), h1 = tr_read<VOFF(1, 1)>(vb);
    const s16x4 l2 = tr_read<VOFF(2, 0)>(vb), h2 = tr_read<VOFF(2, 1)>(vb), l3 = tr_read<VOFF(3, 0)>(vb), h3 = tr_read<VOFF(3, 1)>(vb);
#undef VOFF
    asm volatile("s_waitcnt lgkmcnt(0)" ::: "memory"); SBAR();
#define PK(L, H) (bf16x8){L[0], L[1], L[2], L[3], H[0], H[1], H[2], H[3]}
    od = __builtin_amdgcn_mfma_f32_32x32x16_bf16(pa0, PK(l0, h0), od, 0, 0, 0);
    od = __builtin_amdgcn_mfma_f32_32x32x16_bf16(pa1, PK(l1, h1), od, 0, 0, 0);
    od = __builtin_amdgcn_mfma_f32_32x32x16_bf16(pa2, PK(l2, h2), od, 0, 0, 0);
    od = __builtin_amdgcn_mfma_f32_32x32x16_bf16(pa3, PK(l3, h3), od, 0, 0, 0);
#undef PK
}
template <int NCB> __device__ __forceinline__ void pv_all(f32x16* o, int vb, bf16x8 pa0, bf16x8 pa1, bf16x8 pa2, bf16x8 pa3) {
    pv_one<NCB, 0>(o[0], vb, pa0, pa1, pa2, pa3); pv_one<NCB, 1>(o[1], vb, pa0, pa1, pa2, pa3);
    if constexpr (NCB == 4) { pv_one<NCB, 2>(o[2], vb, pa0, pa1, pa2, pa3); pv_one<NCB, 3>(o[3], vb, pa0, pa1, pa2, pa3); }
}

template <int DQK, int DV, int KROWB>
__device__ __forceinline__ void attn_core(const bf16x8* qr, const bf16* kA, int sA, const bf16* kB, int sB, const bf16* vP, int sV,
                                          int NT, float C, float thr_raw, char* lds, f32x16* o, float& l_out, const int tid) {
    constexpr int NCB = DV / 32, SHM_V = 64 * DV * 2, SHM_K = 64 * KROWB, ND0 = DQK / 16;
    constexpr int PPR = DQK / 8, NPK = 64 * PPR, NKS = (NPK + 511) / 512, VPR = DV / 8, NVS = 64 * VPR / 512;
    const int wid = tid >> 6, lane = tid & 63, r32 = lane & 31, hi = lane >> 5;
    char* V_lds = lds; char* K_lds = lds + 2 * SHM_V;
    float* wsf = (float*)(lds + 2 * SHM_V + 2 * SHM_K) + wid * 64; float* al_l = wsf + 32;
    float m_reg = -1e30f, l_reg = 0;
    const bf16* kp[NKS]; int kadv[NKS], kst[NKS]; bool kval[NKS];
#pragma unroll
    for (int i = 0; i < NKS; ++i) { int p = tid + 512 * i; kval[i] = p < NPK; if (!kval[i]) p -= 512; const int row = p / PPR, c8 = p - row * PPR;
        if (c8 < 8) { kp[i] = kA + (size_t)row * sA + c8 * 8; kadv[i] = 64 * sA; } else { kp[i] = kB + (size_t)row * sB + (c8 - 8) * 8; kadv[i] = 64 * sB; }
        kst[i] = row * KROWB + ((c8 * 16) ^ ((row & 7) << 4)); }
    const bf16* vp[NVS]; int vst[NVS];
#pragma unroll
    for (int i = 0; i < NVS; ++i) { const int p = tid + 512 * i, row = p / VPR, c8 = p % VPR; vp[i] = vP + (size_t)row * sV + c8 * 8; vst[i] = v_st<NCB>(row, c8 * 8); }
    const int vadv = 64 * sV;
    const int vb0 = (int)(uintptr_t)V_lds + v_rd_base(lane);
    struct { bf16x8 ks[NKS]; bf16x8 vs[NVS]; } sr_[1];
#define SLOAD(i, t) do { _Pragma("unroll") for (int s_ = 0; s_ < NKS; ++s_) sr_[i].ks[s_] = *(const bf16x8*)(kp[s_] + (size_t)(t) * kadv[s_]); \
        _Pragma("unroll") for (int s_ = 0; s_ < NVS; ++s_) sr_[i].vs[s_] = *(const bf16x8*)(vp[s_] + (size_t)(t) * vadv); } while (0)
#define SWRITE(b, i) do { _Pragma("unroll") for (int s_ = 0; s_ < NVS; ++s_) *(bf16x8*)(V_lds + (b) * SHM_V + vst[s_]) = sr_[i].vs[s_]; \
        _Pragma("unroll") for (int s_ = 0; s_ < NKS; ++s_) if (kval[s_]) *(bf16x8*)(K_lds + (b) * SHM_K + kst[s_]) = sr_[i].ks[s_]; } while (0)
#define RESC(a) do { if (__any((a) < 1.f)) { if (hi == 0) al_l[r32] = (a); asm volatile("s_waitcnt lgkmcnt(0)" ::: "memory"); \
        _Pragma("unroll") for (int d = 0; d < NCB; ++d) _Pragma("unroll") for (int r = 0; r < 16; ++r) o[d][r] *= al_l[crow(r, hi)]; } } while (0)
    f32x16 pA0, pA1, pB0, pB1; float mnA, mnB, alA, alB; bf16x8 pa0, pa1, pa2, pa3;
    constexpr int SE = 0, SO = 0;
    SLOAD(SE, 0); SWRITE(0, SE); __syncthreads();
    qkt<ND0, KROWB>(pA0, pA1, K_lds, qr, r32, hi); partialSM(pA0, pA1, m_reg, mnA, alA, C, thr_raw);
    SLOAD(SO, 1);
    SWRITE(1, SO); __syncthreads();
    for (int j = 1; j + 1 < NT; j += 2) {
        SBAR(); qkt<ND0, KROWB>(pB0, pB1, K_lds + SHM_K, qr, r32, hi);
        finishSM(pA0, pA1, alA, l_reg, pa0, pa1, pa2, pa3); SBAR();
        SLOAD(SO, j + 1); SBAR();
        pv_all<NCB>(o, vb0, pa0, pa1, pa2, pa3); partialSM(pB0, pB1, m_reg, mnB, alB, C, thr_raw);
        __syncthreads(); SWRITE(0, SE);
        RESC(alB); __syncthreads();
        SBAR(); qkt<ND0, KROWB>(pA0, pA1, K_lds, qr, r32, hi);
        finishSM(pB0, pB1, alB, l_reg, pa0, pa1, pa2, pa3); SBAR();
        SLOAD(SE, j + 2); SBAR();
        pv_all<NCB>(o, vb0 + SHM_V, pa0, pa1, pa2, pa3); partialSM(pA0, pA1, m_reg, mnA, alA, C, thr_raw);
        __syncthreads(); SWRITE(1, SO);
        RESC(alA); __syncthreads();
    }
    SBAR(); qkt<ND0, KROWB>(pB0, pB1, K_lds + SHM_K, qr, r32, hi);
    finishSM(pA0, pA1, alA, l_reg, pa0, pa1, pa2, pa3); SBAR();
    pv_all<NCB>(o, vb0, pa0, pa1, pa2, pa3); partialSM(pB0, pB1, m_reg, mnB, alB, C, thr_raw);
    __syncthreads(); RESC(alB);
    finishSM(pB0, pB1, alB, l_reg, pa0, pa1, pa2, pa3); SBAR();
    pv_all<NCB>(o, vb0 + SHM_V, pa0, pa1, pa2, pa3);
    l_out = l_reg;
#undef SLOAD
#undef SWRITE
#undef RESC
}

__device__ __forceinline__ void mla_item(KArgP a, int b, int h, int qb, char* lds) {
    const int tid = ptid(), wid = tid >> 6, lane = tid & 63, r32 = lane & 31, hi = lane >> 5;
    const bf16* Qb = (const bf16*)((const unsigned char*)a->out + OUT_Q); const bf16* KV = (const bf16*)((const unsigned char*)a->out + OUT_KV);
    const bf16* KR = (const bf16*)(a->ws + WS_KR); bf16* MIX = (bf16*)(a->ws + WS_MIX);
    const int row0 = b * TPB + qb * 256, krow0 = b * TPB, NT = qb ? 36 : 4;
    const int row = row0 + wid * 32 + r32;
    const bf16* Qw = Qb + (size_t)row * 768 + h * 96;
    bf16x8 qr[6];
#pragma unroll
    for (int d0 = 0; d0 < 4; ++d0) qr[d0] = *(const bf16x8*)(Qw + d0 * 16 + hi * 8);
    const int t = (qb - 1) * 256 + wid * 32 + r32;
#pragma unroll
    for (int d0 = 4; d0 < 6; ++d0) {
        const bf16x8 x1 = *(const bf16x8*)(Qw + d0 * 16), x2 = *(const bf16x8*)(Qw + d0 * 16 + 8);
        if (qb) { const float pos = (float)(d0 == 4 ? (t >> 6) : (t & 63)); unsigned short ov[8];
#pragma unroll
            for (int i = 0; i < 8; ++i) { float s, c; sincos_r(pos * inv_freq(i, 8), s, c); const float f1 = bf2f((unsigned short)x1[i]), f2 = bf2f((unsigned short)x2[i]);
                ov[i] = (unsigned short)f2bf(hi ? (f1 * s + f2 * c) : (f1 * c - f2 * s)); }
            qr[d0] = (bf16x8){(short)ov[0], (short)ov[1], (short)ov[2], (short)ov[3], (short)ov[4], (short)ov[5], (short)ov[6], (short)ov[7]};
        } else qr[d0] = hi ? x2 : x1;
    }
    f32x16 o[2] = {}; float l_reg;
    const float scale = 0.10206207261596575f;
    attn_core<96, 64, 256>(qr, KV + (size_t)krow0 * 1024 + h * 128, 1024, KR + (size_t)krow0 * 32, 32, KV + (size_t)krow0 * 1024 + h * 128 + 64, 1024,
                           NT, scale * 1.4426950408889634f, 8.f / scale, lds, o, l_reg, tid);
    float* li_l = (float*)(lds + 2 * 64 * 64 * 2 + 2 * 64 * 256) + wid * 64;
    if (hi == 0) li_l[r32] = l_reg; asm volatile("s_waitcnt lgkmcnt(0)" ::: "memory");
#pragma unroll
    for (int r = 0; r < 16; ++r) { const int orow = crow(r, hi); const float rl = __builtin_amdgcn_rcpf(li_l[orow]);
        bf16* op = MIX + (size_t)(row0 + wid * 32 + orow) * 1024 + 512 + h * 64 + r32;
        op[0] = (bf16)f2bf(o[0][r] * rl); op[32] = (bf16)f2bf(o[1][r] * rl); }
}
__device__ __forceinline__ void diff_item(KArgP a, int layer, int b, int h, int qb, char* lds) {
    const int row0 = b * TPB + qb * 256, krow0 = b * TPB, NT = qb ? 36 : 4, o_ = layer >> 1;
    const float scale = 0.125f;
#pragma unroll 1
    for (int m = 0; m < 2; ++m) {
        f32x16 o[4] = {};
        float l_reg;
        {
            const int tid = ptid(), wid = tid >> 6, lane = tid & 63, r32 = lane & 31, hi = lane >> 5;
            const bf16* P = (const bf16*)(a->ws + WS_P);
            const bf16* Qw = P + (size_t)(row0 + wid * 32 + r32) * NP_O + 1536 + h * 128 + m * 64;
            bf16x8 qr[4];
#pragma unroll
            for (int d0 = 0; d0 < 4; ++d0) qr[d0] = *(const bf16x8*)(Qw + d0 * 16 + hi * 8);
            const bf16* Kp = P + (size_t)krow0 * NP_O + 2048 + h * 128 + m * 64;
            attn_core<64, 128, 128>(qr, Kp, NP_O, Kp, NP_O, P + (size_t)krow0 * NP_O + 2560 + h * 128, NP_O,
                                    NT, scale * 1.4426950408889634f, 8.f / scale, lds, o, l_reg, tid);
        }
        const int tid = ptid(), wid = tid >> 6, lane = tid & 63, r32 = lane & 31, hi = lane >> 5;
        float* li_l = (float*)(lds + 2 * 64 * 128 * 2 + 2 * 64 * 128) + wid * 64;
        if (hi == 0) li_l[r32] = l_reg; asm volatile("s_waitcnt lgkmcnt(0)" ::: "memory");
        float* dsb = (float*)a->out + (size_t)blockIdx.x * 64 * 512 + tid; asm volatile("" : "+v"(dsb));
        if (m == 0) {
#pragma unroll
            for (int r = 0; r < 16; ++r) { const float rl = __builtin_amdgcn_rcpf(li_l[crow(r, hi)]);
#pragma unroll
                for (int d = 0; d < 4; ++d) dsb[(size_t)(d * 16 + r) * 512] = o[d][r] * rl; }
        } else {
            bf16* MIX = (bf16*)(a->ws + WS_MIX);
            const float* lp = a->in[20] + o_ * 256;
            const float lam_init = 0.8f - 0.6f * __expf(-0.3f * (float)layer);
            const float lam = __expf(wave_sum(lp[lane] * lp[64 + lane])) - __expf(wave_sum(lp[128 + lane] * lp[192 + lane])) + lam_init;
            const float* sg = a->in[21] + o_ * 128;
#pragma unroll
            for (int r = 0; r < 16; ++r) { const float rl = __builtin_amdgcn_rcpf(li_l[crow(r, hi)]); float s = 0.f; float v[4];
#pragma unroll
                for (int d = 0; d < 4; ++d) { v[d] = dsb[(size_t)(d * 16 + r) * 512] - lam * (o[d][r] * rl); s += v[d] * v[d]; }
                s += __shfl_xor(s, 16); s += __shfl_xor(s, 8); s += __shfl_xor(s, 4); s += __shfl_xor(s, 2); s += __shfl_xor(s, 1);
                const float rs = __builtin_amdgcn_rsqf(s * (1.f / 128.f) + EPSN) * (1.f - lam_init);
                bf16* op = MIX + (size_t)(row0 + wid * 32 + crow(r, hi)) * 1024 + 512 + h * 128 + r32;
#pragma unroll
                for (int d = 0; d < 4; ++d) op[32 * d] = (bf16)f2bf(v[d] * rs * sg[32 * d + r32]);
                asm volatile("" ::: "memory"); }
        }
        asm volatile("s_waitcnt vmcnt(0) lgkmcnt(0)" ::: "memory");
    }
}

__device__ __forceinline__ void phase_mixer(KArgP a, int layer, unsigned char* ldsg) {
    LAS unsigned char* lds = (LAS unsigned char*)ldsg;
    volatile LAS unsigned* flag = (volatile LAS unsigned*)(lds + LDS_MAIN);
    unsigned* ctr = (unsigned*)(a->ws + WS_CTL) + layer; layer &= 7;
    const bool even = !(layer & 1), need_ctx = layer < 3;
    constexpr int NSC = 256;
    const int n_lat = even ? 512 : 256, n_ctx = need_ctx ? (even ? 64 : 32) : 0, total = NSC + n_lat + n_ctx;
    for (;;) {
        __syncthreads();
        if (ptid() == 0) *flag = atomicAdd(ctr, 1u);
        __syncthreads();
        const int qi_ = (int)*flag;
        if (qi_ >= total) break;
        const int item = qi_ < n_lat ? NSC + qi_ : (qi_ < n_lat + NSC ? qi_ - n_lat : qi_);
#ifdef PROBE_ITEM
        const unsigned long long it0_ = __builtin_amdgcn_s_memrealtime();
#endif
#ifndef SKIP_SCAN
        if (item < NSC) { if (even) scan_item<128, true, 1>(a, layer, item & 63, item >> 6, lds); else scan_item<64, false, 1>(a, layer, item & 63, item >> 6, lds); }
#else
        if (item < NSC) {}
#endif
        else { int b_, h_, qb_;
            if (item < NSC + n_lat) { const int i = item - NSC; qb_ = 1 + (i & 7); if (even) { b_ = i >> 6; h_ = (i >> 3) & 7; } else { b_ = i >> 5; h_ = (i >> 3) & 3; } }
            else { const int i = item - NSC - n_lat; qb_ = 0; if (even) { b_ = i >> 3; h_ = i & 7; } else { b_ = i >> 2; h_ = i & 3; } }
#ifndef SKIP_ATTN
            if (even) mla_item(a, b_, h_, qb_, (char*)ldsg); else diff_item(a, layer, b_, h_, qb_, (char*)ldsg);
#endif
        }
#ifdef PROBE_ITEM
        __syncthreads();
        if (otid() == 0) { volatile LAS unsigned long long* pc_ = (volatile LAS unsigned long long*)(lds + LDS_MAIN + 128); const int k_ = item < NSC ? 0 : (even ? 1 : 2); pc_[k_] += __builtin_amdgcn_s_memrealtime() - it0_; }
#endif
    }
}

#define XB_TMO      128
#define XB_XCNT(j)  (256  + 64 * (j))
#define XB_XSUB(j)  (1280 + 64 * (j))
#define XB_XGEN(j)  (2304 + 64 * (j))
#define XB_TOP      3328
#define XB_TOPGEN   3392
#define XCD_BAR_WORDS 3456
#define XB_SPIN_CAP (1u << 18)

__device__ __forceinline__ unsigned xb_ld(unsigned* p)              { return __hip_atomic_load(p, __ATOMIC_RELAXED, __HIP_MEMORY_SCOPE_AGENT); }
__device__ __forceinline__ unsigned xb_add(unsigned* p, unsigned v) { return __hip_atomic_fetch_add(p, v, __ATOMIC_RELAXED, __HIP_MEMORY_SCOPE_AGENT); }
__device__ __forceinline__ unsigned xb_xcc_id() { return (unsigned)__builtin_amdgcn_s_getreg((3 << 11) | 20) & 0xFu; }
#define XB_SPIN(cond, bar) do { unsigned _sp = 0; while (cond) { __builtin_amdgcn_s_sleep(1); \
    if ((++_sp & 255u) == 0u) { if (xb_ld(&(bar)[XB_TMO])) break; if (_sp > XB_SPIN_CAP) { atomicAdd(&(bar)[XB_TMO], 1u); break; } } } } while (0)

struct XcdBarrier {
    unsigned* bar; unsigned x;
    volatile LAS unsigned* st;
};

__device__ __forceinline__ XcdBarrier xcd_barrier_post(unsigned* bar, volatile LAS unsigned* st) {
    XcdBarrier b; b.bar = bar; b.x = xb_xcc_id(); b.st = st;
    if (threadIdx.x == 0) (void)xb_add(&bar[XB_XCNT(b.x)], 1u);
    return b;
}
__device__ __forceinline__ void xcd_barrier_complete(unsigned* bar, unsigned x, unsigned& nloc, unsigned& nx) {
    const unsigned G = gridDim.x * gridDim.y * gridDim.z;
    unsigned sum, cnt, mine, sp = 0u;
    for (;;) {
        sum = 0u; cnt = 0u; mine = 0u;
#pragma unroll
        for (unsigned j = 0; j < 16; ++j) { const unsigned c = xb_ld(&bar[XB_XCNT(j)]); sum += c; cnt += (c > 0u) ? 1u : 0u; mine = (j == x) ? c : mine; }
        if (sum == G) break;
        __builtin_amdgcn_s_sleep(1);
        if ((++sp & 255u) == 0u) { if (xb_ld(&bar[XB_TMO])) break; if (sp > XB_SPIN_CAP) { atomicAdd(&bar[XB_TMO], 1u); break; } }
    }
    nloc = mine > 0u ? mine : 1u; nx = cnt > 0u ? cnt : 1u;
}

__device__ __forceinline__ void xcd_barrier(const XcdBarrier& b) {
    asm volatile("s_waitcnt vmcnt(0)" ::: "memory");
    __syncthreads();
    if (threadIdx.x == 0) {
        unsigned* bar = b.bar;
        __builtin_amdgcn_s_waitcnt(0);
        unsigned nloc = b.st[0], nx = b.st[1];
        if (nloc == 0u) { xcd_barrier_complete(bar, b.x, nloc, nx); b.st[0] = nloc; b.st[1] = nx; }
        const unsigned old = xb_add(&bar[XB_XSUB(b.x)], 1u);
        const unsigned gen = old / nloc;
        if (old + 1u == (gen + 1u) * nloc) {
            __builtin_amdgcn_fence(__ATOMIC_RELEASE, "agent");
            asm volatile("s_waitcnt vmcnt(0)" ::: "memory");
            const unsigned og = xb_add(&bar[XB_TOP], 1u);
            const unsigned tg = og / nx;
            if (og + 1u == (tg + 1u) * nx) xb_add(&bar[XB_TOPGEN], 1u);
            else XB_SPIN(xb_ld(&bar[XB_TOPGEN]) == tg, bar);
            __builtin_amdgcn_fence(__ATOMIC_ACQUIRE, "agent");
            xb_add(&bar[XB_XGEN(b.x)], 1u);
            asm volatile("s_waitcnt vmcnt(0)" ::: "memory");
        } else {
            XB_SPIN(xb_ld(&bar[XB_XGEN(b.x)]) == gen, bar);
            __builtin_amdgcn_fence(__ATOMIC_ACQUIRE, "agent");
            asm volatile("s_waitcnt vmcnt(0)" ::: "memory");
        }
    }
    __syncthreads();
}

__global__ void __launch_bounds__(512, 2) mega_fwd(Args a_) {
    extern __shared__ __attribute__((aligned(16))) unsigned char lds_raw[];
    LAS unsigned char* lds = (LAS unsigned char*)lds_raw;
    ((LAS int*)(lds + LDS_MAIN + 1024))[threadIdx.x] = (int)threadIdx.x;
    if (threadIdx.x < 4) ((LAS unsigned*)(lds + LDS_MAIN + 64))[threadIdx.x] = 0u;
    if (threadIdx.x < 8) ((LAS unsigned*)(lds + LDS_MAIN + 128))[threadIdx.x] = 0u;
    __syncthreads();
    XcdBarrier xbar; xbar.bar = nullptr; xbar.x = 0; xbar.st = nullptr; bool xb_ready = false;
    cg::grid_group grid = cg::this_grid();
    int ph = 0;
#ifdef PROBE_MASK
    unsigned long long pr_last = __builtin_amdgcn_s_memrealtime(), pr_acc = 0ull;
#define PROBE_STAMP(k) { const unsigned long long now_ = __builtin_amdgcn_s_memrealtime(); if ((PROBE_MASK >> (k)) & 1) pr_acc += now_ - pr_last; pr_last = now_; }
#else
#define PROBE_STAMP(k)
#endif
    const int plo = a_.lo, phi = a_.hi;
#define PH_BEGIN if (ph >= plo && ph < phi) { KArgP a = kargs(); int bx = (int)blockIdx.x, G = (int)gridDim.x; asm volatile("" : "+s"(bx), "+s"(G)); (void)bx; (void)G;
#ifdef PROBE_SYNC2
#define PH_ENDT(k)   if (ph + 1 < phi) { grid.sync(); grid.sync(); } } ++ph;
#else
#define PH_ENDT(k) if (ph + 1 < phi) { if (!xb_ready) { grid.sync(); xbar = xcd_barrier_post((unsigned*)(a->ws + WS_CTL) + 4096, (volatile LAS unsigned*)(lds + LDS_MAIN + 64)); xb_ready = true; } else xcd_barrier(xbar); } PROBE_STAMP(k) } ++ph;
#endif

    PH_BEGIN phase_prep(a, lds); PH_ENDT(0)

    for (int layer = 0; layer < 4; ++layer) {
        const bool even = !(layer & 1);
        const int np = even ? NP_E : NP_O;
        PH_BEGIN phase_norm(a, layer, 0, layer > 0); if (layer > 0 || G <= 96) convert_weights(a, layer, lds, 0, bx * 8 + (otid() >> 6), G * 8); PH_ENDT(1)
#ifndef SKIP_G1
        PH_BEGIN { bf16* H = (bf16*)(a->ws + WS_H); bf16* MIX = (bf16*)(a->ws + WS_MIX); bf16* P = (bf16*)(a->ws + WS_P); bf16* X = (bf16*)(a->ws + WS_X); unsigned char* Wb = a->ws + WS_W; const float* mod = (const float*)(a->ws + WS_MOD) + (size_t)layer * 9 * 6144; (void)H; (void)MIX; (void)P; (void)X; (void)mod; pg8::Gemm g{H, (const bf16*)(Wb + W_IN), MT, np, 1024, 1024}; pg8::StaticOrder S; S.init(MT, np, G, bx);
                   pg8::EpiBf16<0> E{P, np, nullptr, 0, 0, 1.f};
                   pg8::gemm_phase<pg8::EpiBf16<0>, pg8::StaticOrder, true, true>(lds, g, S, E); } PH_ENDT(2)
#else
        ++ph;
#endif
        PH_BEGIN if (even) phase_post_even(a, layer); else phase_post_odd(a, layer); PH_ENDT(3)
#ifndef SKIP_G3
        if (even) {
            PH_BEGIN { bf16* H = (bf16*)(a->ws + WS_H); bf16* MIX = (bf16*)(a->ws + WS_MIX); bf16* P = (bf16*)(a->ws + WS_P); bf16* X = (bf16*)(a->ws + WS_X); unsigned char* Wb = a->ws + WS_W; const float* mod = (const float*)(a->ws + WS_MOD) + (size_t)layer * 9 * 6144; (void)H; (void)MIX; (void)P; (void)X; (void)mod; pg8::Gemm g{(const bf16*)(a->ws + WS_CQN), (const bf16*)(Wb + W_UQ), MT, 768, 384, 384}; pg8::StaticOrder S; S.init(MT, 768, G, bx);
                       pg8::EpiBf16<0> E{(bf16*)((unsigned char*)a->out + OUT_Q), 768, nullptr, 0, 0, 1.f};
                       pg8::gemm_phase<pg8::EpiBf16<0>, pg8::StaticOrder, true, true>(lds, g, S, E); }
                     { unsigned char* Wb = a->ws + WS_W; pg8::Gemm g{(const bf16*)(a->ws + WS_CKVN), (const bf16*)(Wb + W_UKV), MT, 1024, 256, 256}; pg8::StaticOrder S; S.init(MT, 1024, G, bx);
                       pg8::EpiBf16<0> E{(bf16*)((unsigned char*)a->out + OUT_KV), 1024, nullptr, 0, 0, 1.f};
                       pg8::gemm_phase<pg8::EpiBf16<0>, pg8::StaticOrder, true, true>(lds, g, S, E); }
                     for (int it = bx; it < 192; it += G) scan_item<128, true, 0>(a, layer, it & 63, it >> 6, lds);
                     if (bx >= 192 && layer > 0) convert_weights(a, layer, lds, 1, (bx - 192) * 8 + (otid() >> 6), (G - 192) * 8);
            PH_ENDT(4)
        } else { ++ph; }
#else
        ++ph;
#endif
        if (!even) {
        PH_BEGIN for (int it = bx; it < 192; it += G) scan_item<64, false, 0>(a, layer, it & 63, it >> 6, lds);
                 if (bx >= 192) convert_weights(a, layer, lds, 1, (bx - 192) * 8 + (otid() >> 6), (G - 192) * 8); PH_ENDT(5)
        } else { ++ph; }
#ifdef PROBE_MIX2
        PH_BEGIN phase_mixer(a, layer + 8, lds_raw); grid.sync(); PH_ENDT(6)
        --ph;
#endif
        PH_BEGIN phase_mixer(a, layer, lds_raw); PH_ENDT(6 + 7 * (layer & 1))
        PH_BEGIN phase_readout(a, layer); PH_ENDT(7)
#ifndef SKIP_G6
        PH_BEGIN { bf16* H = (bf16*)(a->ws + WS_H); bf16* MIX = (bf16*)(a->ws + WS_MIX); bf16* P = (bf16*)(a->ws + WS_P); bf16* X = (bf16*)(a->ws + WS_X); unsigned char* Wb = a->ws + WS_W; const float* mod = (const float*)(a->ws + WS_MOD) + (size_t)layer * 9 * 6144; (void)H; (void)MIX; (void)P; (void)X; (void)mod; pg8::Gemm g{MIX, (const bf16*)(Wb + W_OUT), MT, 1024, 1024, 1024}; pg8::StaticOrder S; S.init(NB * NLAT, 1024, G, bx, 1);
                   pg8::EpiResid E{X, mod, 2048, layer == 0 ? a->in[0] : nullptr};
                   pg8::gemm_phase<pg8::EpiResid, pg8::StaticOrder, true, true>(lds, g, S, E);
                   if (layer < 3) { pg8::Gemm g2{MIX, (const bf16*)(Wb + W_OUT), MT, 1024, 512, 1024}; pg8::CtxSplitOrder S2{G, bx, 512};
                       pg8::EpiResidSplit E2{X, (float*)(a->ws + WS_T), mod, 2048, layer == 0 ? a->in[2] : nullptr};
                       pg8::gemm_phase<pg8::EpiResidSplit, pg8::CtxSplitOrder, true, true>(lds, g2, S2, E2); } } PH_ENDT(8)
#else
        ++ph;
#endif
        PH_BEGIN phase_norm(a, layer, 1, layer < 3); PH_ENDT(9)
#ifndef SKIP_G8
        PH_BEGIN { bf16* H = (bf16*)(a->ws + WS_H); bf16* MIX = (bf16*)(a->ws + WS_MIX); bf16* P = (bf16*)(a->ws + WS_P); bf16* X = (bf16*)(a->ws + WS_X); unsigned char* Wb = a->ws + WS_W; const float* mod = (const float*)(a->ws + WS_MOD) + (size_t)layer * 9 * 6144; (void)H; (void)MIX; (void)P; (void)X; (void)mod; pg8::Gemm g{H, (const bf16*)(Wb + W_GU), MT, 2 * FF, 1024, 1024}; pg8::StaticOrder S; if (layer < 3) S.init(MT, 2 * FF, G, bx); else S.init(NB * NLAT, 2 * FF, G, bx, 1);
                   pg8::EpiSwiGLU E{P, FF};
                   pg8::gemm_phase<pg8::EpiSwiGLU, pg8::StaticOrder, true, true>(lds, g, S, E); } PH_ENDT(10)
#else
        ++ph;
#endif
#ifndef SKIP_G9
        PH_BEGIN { bf16* H = (bf16*)(a->ws + WS_H); bf16* MIX = (bf16*)(a->ws + WS_MIX); bf16* P = (bf16*)(a->ws + WS_P); bf16* X = (bf16*)(a->ws + WS_X); unsigned char* Wb = a->ws + WS_W; const float* mod = (const float*)(a->ws + WS_MOD) + (size_t)layer * 9 * 6144; (void)H; (void)MIX; (void)P; (void)X; (void)mod; pg8::Gemm g{P, (const bf16*)(Wb + W_DN), MT, 1024, FF, FF}; pg8::StaticOrder S; S.init(NB * NLAT, 1024, G, bx, 1);
                   pg8::EpiResid E{X, mod, 5120, nullptr};
                   pg8::gemm_phase<pg8::EpiResid, pg8::StaticOrder, true, true>(lds, g, S, E);
                   if (layer < 3) { pg8::Gemm g2{P, (const bf16*)(Wb + W_DN), MT, 1024, FF / 2, FF}; pg8::CtxSplitOrder S2{G, bx, FF / 2};
                       pg8::EpiResidSplit E2{X, (float*)(a->ws + WS_T), mod, 5120, nullptr};
                       pg8::gemm_phase<pg8::EpiResidSplit, pg8::CtxSplitOrder, true, true>(lds, g2, S2, E2); } } PH_ENDT(11)
#else
        ++ph;
#endif
    }
    PH_BEGIN phase_final(a); PH_ENDT(12)
#undef PH_BEGIN
#undef PH_ENDT
#ifdef PROBE_ITEM
    pr_acc += ((volatile LAS unsigned long long*)(lds + LDS_MAIN + 128))[PROBE_ITEM - 1];
#endif
#ifdef PROBE_MASK
    if (blockIdx.x == 0) { const unsigned long long t0_ = __builtin_amdgcn_s_memrealtime(); while (__builtin_amdgcn_s_memrealtime() - t0_ < pr_acc) __builtin_amdgcn_s_sleep(8); }
#endif
}
constexpr int NPH = 1 + 4 * 11 + 1;

extern "C" void kernel_launch(void* const* d_in, const int* in_sizes, int n_in, void* d_out, int out_size, void* d_ws, size_t ws_size, hipStream_t stream) {
    static int grid = 0;
    if (grid == 0) {
        if (n_in != 23 || ws_size < WS_END || out_size != NB * NLAT * DM) { fprintf(stderr, "kernel_launch: unexpected shapes: n_in %d ws %zu (need %zu) out %d\n", n_in, ws_size, (size_t)WS_END, out_size); grid = -1; return; }
        int dev = 0, cus = 0, per_cu = 0;
        hipGetDevice(&dev); hipDeviceGetAttribute(&cus, hipDeviceAttributeMultiprocessorCount, dev);
        if (hipFuncSetAttribute((const void*)mega_fwd, hipFuncAttributeMaxDynamicSharedMemorySize, LDS_BYTES) != hipSuccess) { fprintf(stderr, "kernel_launch: hipFuncSetAttribute failed\n"); grid = -1; return; }
        if (hipOccupancyMaxActiveBlocksPerMultiprocessor(&per_cu, (const void*)mega_fwd, 512, LDS_BYTES) != hipSuccess || per_cu < 1) { fprintf(stderr, "kernel_launch: occupancy query says %d\n", per_cu); per_cu = 1; }
        (void)hipGetLastError();
        grid = cus;
    }
    if (grid < 0) return;
    Args a{};
    for (int i = 0; i < 23; ++i) a.in[i] = (const float*)d_in[i];
    a.out = (float*)d_out; a.ws = (unsigned char*)d_ws; a.lo = 0; a.hi = NPH;
    void* kargv[] = {&a};
    hipError_t e = hipLaunchCooperativeKernel((const void*)mega_fwd, dim3(grid), dim3(512), kargv, LDS_BYTES, stream);
    if (e != hipSuccess) fprintf(stderr, "kernel_launch: cooperative launch failed: %s (grid %d)\n", hipGetErrorString(e), grid);
}
```

```cpp
#include <hip/hip_runtime.h>
#include <hip/hip_cooperative_groups.h>
#include <cstdio>
#include <cstdint>
namespace cg = cooperative_groups;
#define otid() ({ int t_ = (int)threadIdx.x; asm volatile("" : "+v"(t_)); t_; })
extern __shared__ __attribute__((aligned(16))) unsigned char g_lds_dyn[];
#define ptid() (*(volatile __attribute__((address_space(3))) int*)((__attribute__((address_space(3))) unsigned char*)g_lds_dyn + 131072 + 1024 + 4 * (int)threadIdx.x))
namespace pg8 {
#define PG8_LAS __attribute__((address_space(3)))
typedef unsigned short bf16_t;
typedef short bf16x8 __attribute__((ext_vector_type(8)));
typedef float f32x4 __attribute__((ext_vector_type(4)));
typedef unsigned u32x4 __attribute__((ext_vector_type(4)));
constexpr int BM = 256, BK = 64, HALF = 128, HTB = HALF * BK * 2  , STAGE_BYTES = 8 * HTB, NXCD = 8, WGM = 8;

__host__ __device__ __forceinline__ int lds_byte(int r, int c) { const int st = (r >> 4) * 2 + (c >> 5), rr = r & 15, cc = c & 31, ob = rr * 64 + cc * 2; return st * 1024 + (ob ^ (((ob >> 9) & 1) << 5)); }
__host__ __device__ __forceinline__ void stage_rc(int b, int& R, int& C) { const int st = b / 1024, sb = b % 1024, swz = sb ^ (((sb >> 9) & 1) << 5); R = (st >> 1) * 16 + swz / 64; C = (st & 1) * 32 + (swz % 64) / 2; }
__host__ __device__ __forceinline__ int perm32(int rho) { const int n = rho >> 4, i = rho & 15; return 8 * (i >> 2) + 4 * n + (i & 3); }

struct Unit { int pm, pn, koff; };
struct Gemm { const bf16_t* A; const bf16_t* Bt; int M, N, K, ld; };

struct StaticOrder {
    int nM, nN, nwg, G, c, mode;
    __host__ __device__ void init(int M, int N, int G_, int c_, int mode_ = 0) { nM = M / BM; nN = N / BM; nwg = nM * nN; G = G_; c = c_; mode = mode_; }
    __host__ __device__ bool next(int i, Unit& u) const {
        const long L = (long)i * G + c; if (L >= nwg) return false;
        int wgid = (int)L; { const int q = nwg / NXCD, r = nwg % NXCD, xcd = wgid % NXCD, off = wgid / NXCD; wgid = (xcd < r ? xcd * (q + 1) : r * (q + 1) + (xcd - r) * q) + off; }
        const int nig = WGM * nN, gid = wgid / nig, fm = gid * WGM, gsz = (nM - fm) < WGM ? (nM - fm) : WGM;
        u.pm = fm + ((wgid % nig) % gsz); u.pn = (wgid % nig) / gsz; u.koff = 0; if (mode == 1) u.pm = (u.pm >> 3) * 9 + 1 + (u.pm & 7); return true;
    }
    __device__ __forceinline__ void a_ready(const Unit&) const {}
    __device__ __forceinline__ void done(const Unit&) const {}
};
struct CtxSplitOrder {
    int G, c, khalf;
    __device__ bool next(int i, Unit& u) const { const int L = i * G + c; if (L >= 64) return false; u.koff = (L & 1) * khalf; u.pn = (L >> 1) & 3; u.pm = (L >> 3) * 9; return true; }
    __device__ __forceinline__ void a_ready(const Unit&) const {}
    __device__ __forceinline__ void done(const Unit&) const {}
};

__device__ __forceinline__ unsigned cvt_pk_bf16(float lo, float hi) { unsigned r; asm volatile("v_cvt_pk_bf16_f32 %0, %1, %2" : "=v"(r) : "v"(lo), "v"(hi)); return r; }
typedef float f32x2 __attribute__((ext_vector_type(2)));
__device__ __forceinline__ f32x2 gelu_pk(f32x2 v) {
    const f32x2 av = __builtin_elementwise_abs(v), d = av * 0.2316418882f + 1.0f;
    f32x2 t; t.x = __builtin_amdgcn_rcpf(d.x); t.y = __builtin_amdgcn_rcpf(d.y);
    f32x2 q = t * 0.5307027145f + (-0.7265760135f); q = q * t + 0.7107068705f; q = q * t + (-0.142248368f); q = q * t + 0.127414796f; q = q * t;
    const f32x2 s = (v * v) * (-0.72134752044f);
    f32x2 e; e.x = __builtin_amdgcn_exp2f(s.x); e.y = __builtin_amdgcn_exp2f(s.y);
    const f32x2 m = v * (q * e), r = v - m;
    f32x2 o; o.x = v.x < 0.f ? m.x : r.x; o.y = v.y < 0.f ? m.y : r.y; return o;
}

template <int ACT  > struct EpiBf16 {
    static constexpr bool PERM = true, AFTER_DRAIN = false; static_assert(ACT == 0 || ACT == 1, "EpiBf16: ACT is 0 (none) or 1 (gelu_pk)");
    bf16_t* O; int ldc; const float* bias; int split_cols; size_t split_stride; float scale0;
    __device__ __forceinline__ void operator()(const f32x4 (&acc)[2][2][4][2], const Unit& u, int wr, int wc, int fr, int fq) const {
        const int row0 = u.pm * BM + wr * 64 + fr; int colt = u.pn * BM; bf16_t* base = O;
        float sc = 1.f; if (split_cols) { const int t = colt / split_cols; base += (size_t)t * split_stride; colt -= t * split_cols; if (t == 0) sc = scale0; }
        const int col0 = colt + wc * 32 + 8 * fq, bcol0 = u.pn * BM + wc * 32 + 8 * fq;
        f32x4 bv[2][2];
#pragma unroll
        for (int bj = 0; bj < 2; ++bj)
#pragma unroll
            for (int n = 0; n < 2; ++n) bv[bj][n] = bias ? *(const f32x4*)(bias + bcol0 + bj * HALF + 4 * n) : (f32x4){0.f, 0.f, 0.f, 0.f};
#pragma unroll
        for (int ai = 0; ai < 2; ++ai)
#pragma unroll
            for (int m = 0; m < 4; ++m) { bf16_t* rowp = base + (size_t)(row0 + ai * HALF + m * 16) * ldc + col0;
#pragma unroll
                for (int bj = 0; bj < 2; ++bj) { f32x4 v0 = acc[ai][bj][m][0] + bv[bj][0], v1 = acc[ai][bj][m][1] + bv[bj][1];
                    if (ACT == 1) { f32x2 a = gelu_pk((f32x2){v0[0], v0[1]}), b = gelu_pk((f32x2){v0[2], v0[3]}), c = gelu_pk((f32x2){v1[0], v1[1]}), d = gelu_pk((f32x2){v1[2], v1[3]});
                        v0 = (f32x4){a.x, a.y, b.x, b.y}; v1 = (f32x4){c.x, c.y, d.x, d.y}; }
                    v0 = v0 * sc; v1 = v1 * sc; u32x4 w; w.x = cvt_pk_bf16(v0[0], v0[1]); w.y = cvt_pk_bf16(v0[2], v0[3]); w.z = cvt_pk_bf16(v1[0], v1[1]); w.w = cvt_pk_bf16(v1[2], v1[3]);
                    { bf16_t* sp_ = rowp + bj * HALF; asm volatile("global_store_dwordx4 %0, %1, off sc1\n\ts_nop 1" :: "v"(sp_), "v"(w) : "memory"); } } }
    }
};
struct EpiResidSplit {
    static constexpr bool PERM = true, AFTER_DRAIN = false;
    bf16_t* X; float* T; const float* mod; int goff; const float* cin;
    __device__ __forceinline__ void operator()(const f32x4 (&acc)[2][2][4][2], const Unit& u, int wr, int wc, int fr, int fq) const {
        const float* gp = mod + 8 * 6144 + goff;
        const int col0 = u.pn * BM + wc * 32 + 8 * fq;
        const bool first = (u.koff == 0);
        bf16_t* xb = X + (size_t)(u.pm * BM) * 1024; float* tb = T + (size_t)((u.pm / 9) * BM) * 1024;
        const float* rbase = cin ? cin + (size_t)((u.pm / 9) * BM) * 1024 : nullptr;
#pragma unroll
        for (int bj = 0; bj < 2; ++bj) { const f32x4 g0 = *(const f32x4*)(gp + col0 + bj * HALF), g1 = *(const f32x4*)(gp + col0 + bj * HALF + 4);
#pragma unroll
            for (int ai = 0; ai < 2; ++ai)
#pragma unroll
                for (int m = 0; m < 4; ++m) { const size_t o = (size_t)(ai * HALF + wr * 64 + m * 16 + fr) * 1024 + col0 + bj * HALF;
                    f32x4 v0 = g0 * acc[ai][bj][m][0], v1 = g1 * acc[ai][bj][m][1];
                    if (first) { f32x4 x0, x1;
                        if (rbase) { x0 = *(const f32x4*)(rbase + o); x1 = *(const f32x4*)(rbase + o + 4); }
                        else { const u32x4 w = *(const u32x4*)(xb + o);
                            x0 = (f32x4){__uint_as_float(w.x << 16), __uint_as_float(w.x & 0xffff0000u), __uint_as_float(w.y << 16), __uint_as_float(w.y & 0xffff0000u)};
                            x1 = (f32x4){__uint_as_float(w.z << 16), __uint_as_float(w.z & 0xffff0000u), __uint_as_float(w.w << 16), __uint_as_float(w.w & 0xffff0000u)}; }
                        v0 = v0 + x0; v1 = v1 + x1;
                        u32x4 r; r.x = cvt_pk_bf16(v0[0], v0[1]); r.y = cvt_pk_bf16(v0[2], v0[3]); r.z = cvt_pk_bf16(v1[0], v1[1]); r.w = cvt_pk_bf16(v1[2], v1[3]);
                        *(u32x4*)(xb + o) = r; }
                    else { *(f32x4*)(tb + o) = v0; *(f32x4*)(tb + o + 4) = v1; } } }
    }
};
struct EpiSwiGLU {
    static constexpr bool PERM = true, AFTER_DRAIN = false;
    bf16_t* O; int ldc;
    __device__ __forceinline__ void operator()(const f32x4 (&acc)[2][2][4][2], const Unit& u, int wr, int wc, int fr, int fq) const {
        const int row0 = u.pm * BM + wr * 64 + fr; const int col0 = u.pn * HALF + wc * 32 + 8 * fq;
#pragma unroll
        for (int ai = 0; ai < 2; ++ai)
#pragma unroll
            for (int m = 0; m < 4; ++m) { bf16_t* rowp = O + (size_t)(row0 + ai * HALF + m * 16) * ldc + col0;
                float h[8];
#pragma unroll
                for (int n = 0; n < 2; ++n)
#pragma unroll
                    for (int i = 0; i < 4; ++i) { const float g = acc[ai][0][m][n][i], up = acc[ai][1][m][n][i];
                        h[n * 4 + i] = g * __builtin_amdgcn_rcpf(1.0f + __expf(-g)) * up; }
                u32x4 w; w.x = cvt_pk_bf16(h[0], h[1]); w.y = cvt_pk_bf16(h[2], h[3]); w.z = cvt_pk_bf16(h[4], h[5]); w.w = cvt_pk_bf16(h[6], h[7]);
                asm volatile("global_store_dwordx4 %0, %1, off sc1\n\ts_nop 1" :: "v"(rowp), "v"(w) : "memory"); }
    }
};
struct EpiResid {
    static constexpr bool PERM = true, AFTER_DRAIN = false;
    bf16_t* X; const float* mod; int goff; const float* xin;
    __device__ __forceinline__ void operator()(const f32x4 (&acc)[2][2][4][2], const Unit& u, int wr, int wc, int fr, int fq) const {
        const int widx = (u.pm % 9 == 0) ? 8 : (u.pm / 9);
        const float* gp = mod + widx * 6144 + goff;
        const int col0 = u.pn * BM + wc * 32 + 8 * fq;
        const float* rb = xin ? xin + (size_t)((u.pm / 9) * 2048 + (u.pm % 9 - 1) * 256) * 1024 : nullptr;
        bf16_t* wb = X + (size_t)(u.pm * BM) * 1024;
#pragma unroll
        for (int bj = 0; bj < 2; ++bj) { const f32x4 g0 = *(const f32x4*)(gp + col0 + bj * HALF), g1 = *(const f32x4*)(gp + col0 + bj * HALF + 4);
#pragma unroll
            for (int ai = 0; ai < 2; ++ai)
#pragma unroll
                for (int m = 0; m < 4; ++m) { const size_t o = (size_t)(ai * HALF + wr * 64 + m * 16 + fr) * 1024 + col0 + bj * HALF;
                    f32x4 x0, x1;
                    if (rb) { x0 = *(const f32x4*)(rb + o); x1 = *(const f32x4*)(rb + o + 4); }
                    else { const u32x4 w = *(const u32x4*)(wb + o);
                        x0 = (f32x4){__uint_as_float(w.x << 16), __uint_as_float(w.x & 0xffff0000u), __uint_as_float(w.y << 16), __uint_as_float(w.y & 0xffff0000u)};
                        x1 = (f32x4){__uint_as_float(w.z << 16), __uint_as_float(w.z & 0xffff0000u), __uint_as_float(w.w << 16), __uint_as_float(w.w & 0xffff0000u)}; }
                    x0 = x0 + g0 * acc[ai][bj][m][0]; x1 = x1 + g1 * acc[ai][bj][m][1];
                    u32x4 r; r.x = cvt_pk_bf16(x0[0], x0[1]); r.y = cvt_pk_bf16(x0[2], x0[3]); r.z = cvt_pk_bf16(x1[0], x1[1]); r.w = cvt_pk_bf16(x1[2], x1[3]);
                    *(u32x4*)(wb + o) = r; } }
    }
};
template <class Epi, class Sched, bool ALIGN_EPI = false, bool SP2 = false>
__device__ __forceinline__ void gemm_phase(PG8_LAS unsigned char* lds, const Gemm g, const Sched& S, const Epi& E) {
    const int tid = otid(), wid = __builtin_amdgcn_readfirstlane(tid >> 6), lane = tid & 63, wr = wid >> 2, wc = wid & 3, fr = lane & 15, fq = lane >> 4;
    const int K = g.ld, nt = g.K / BK;
    unsigned voffA[2], voffB[2];
#pragma unroll
    for (int i = 0; i < 2; ++i) { int R, C; stage_rc(tid * 16 + i * 8192, R, C); const int Rb = Epi::PERM ? ((R & ~31) + perm32(R & 31)) : R;
        voffA[i] = (unsigned)(R * K + C) * 2u; voffB[i] = (unsigned)(Rb * K + C) * 2u; }
    const size_t kstep = (size_t)(BK * 2);
    const size_t hstep = (size_t)HALF * K * 2;
    const size_t tstep = 2 * hstep;
    const unsigned ldsw = (unsigned)wid * 1024u;
    const int aoff = lds_byte(wr * 64 + fr, fq * 8), boff = lds_byte(wc * 32 + fr, fq * 8);
#define PG8_SA(b, h) (((b) * 2 + (h)) * HTB)
#define PG8_SB(b, h) ((4 + (b) * 2 + (h)) * HTB)
#define PG8_STAGE(bufoff, gbase, voff) do { _Pragma("unroll") for (int _i = 0; _i < 2; ++_i) \
        __builtin_amdgcn_global_load_lds((const unsigned*)((const char*)(gbase) + (voff)[_i]), (PG8_LAS unsigned*)(lds + (bufoff) + ldsw + _i * 8192), 16, 0, 0); } while (0)
#define PG8_LDA(dst, b, h) do { _Pragma("unroll") for (int m = 0; m < 4; ++m) _Pragma("unroll") for (int k = 0; k < 2; ++k) dst[m][k] = *(const PG8_LAS bf16x8*)(lds + PG8_SA(b, h) + aoff + m * 2048 + k * 1024); } while (0)
#define PG8_LDB(dst, b, h) do { _Pragma("unroll") for (int n = 0; n < 2; ++n) _Pragma("unroll") for (int k = 0; k < 2; ++k) dst[n][k] = *(const PG8_LAS bf16x8*)(lds + PG8_SB(b, h) + boff + n * 2048 + k * 1024); } while (0)
#define PG8_MMA(ai, bj, At, Bt) do { __builtin_amdgcn_s_setprio(1); _Pragma("unroll") for (int m = 0; m < 4; ++m) _Pragma("unroll") for (int n = 0; n < 2; ++n) _Pragma("unroll") for (int k = 0; k < 2; ++k) \
        acc[ai][bj][m][n] = __builtin_amdgcn_mfma_f32_16x16x32_bf16(Bt[n][k], At[m][k], acc[ai][bj][m][n], 0, 0, 0); __builtin_amdgcn_s_setprio(0); } while (0)
#define PG8_WAIT_V(n) asm volatile("s_waitcnt vmcnt(" #n ")" ::: "memory")
#define PG8_WAIT_L(n) asm volatile("s_waitcnt lgkmcnt(" #n ")" ::: "memory")
#define PG8_BAR __builtin_amdgcn_s_barrier()
#define PG8_SCHED __builtin_amdgcn_sched_barrier(0)
    Unit cur, nxt; int ui = 0;
    if (!S.next(0, cur)) return;
    f32x4 acc[2][2][4][2];
#pragma unroll
    for (int a = 0; a < 2; ++a)
#pragma unroll
        for (int b = 0; b < 2; ++b)
#pragma unroll
            for (int m = 0; m < 4; ++m)
#pragma unroll
                for (int n = 0; n < 2; ++n) acc[a][b][m][n] = (f32x4){0.f, 0.f, 0.f, 0.f};
    bf16x8 At[4][2], B0[2][2], B1[2][2];
    const char* cA = (const char*)g.A + (size_t)cur.pm * tstep + (size_t)cur.koff * 2; const char* cB = (const char*)g.Bt + (size_t)cur.pn * tstep + (size_t)cur.koff * 2;
    S.a_ready(cur);
    if constexpr (SP2) {
        PG8_STAGE(PG8_SB(0, 0), cB, voffB); PG8_STAGE(PG8_SB(0, 1), cB + hstep, voffB); PG8_STAGE(PG8_SA(0, 0), cA, voffA); PG8_STAGE(PG8_SA(0, 1), cA + hstep, voffA);
        if (wr == 1) PG8_BAR;
        PG8_WAIT_V(2); PG8_BAR;
        PG8_STAGE(PG8_SB(1, 0), cB + kstep, voffB); PG8_STAGE(PG8_SA(1, 0), cA + kstep, voffA); PG8_STAGE(PG8_SB(1, 1), cB + hstep + kstep, voffB);
        PG8_WAIT_V(6); PG8_BAR;
    } else {
        PG8_STAGE(PG8_SB(0, 0), cB, voffB); PG8_STAGE(PG8_SA(0, 0), cA, voffA); PG8_STAGE(PG8_SB(0, 1), cB + hstep, voffB); PG8_STAGE(PG8_SA(0, 1), cA + hstep, voffA);
        if (wr == 1) PG8_BAR;
        PG8_WAIT_V(4); PG8_BAR;
        PG8_STAGE(PG8_SB(1, 0), cB + kstep, voffB); PG8_STAGE(PG8_SA(1, 0), cA + kstep, voffA); PG8_STAGE(PG8_SB(1, 1), cB + hstep + kstep, voffB);
        PG8_WAIT_V(6); PG8_BAR;
    }
    for (;;) {
        const bool has_next = S.next(ui + 1, nxt);
        const char* nA = has_next ? (const char*)g.A + (size_t)nxt.pm * tstep + (size_t)nxt.koff * 2 : cA; const char* nB = has_next ? (const char*)g.Bt + (size_t)nxt.pn * tstep + (size_t)nxt.koff * 2 : cB;
        for (int t = 0; t < nt; t += 2) {
            const bool last = (t == nt - 2);
            const char* a1 = cA + (size_t)(t + 1) * kstep;
            const char* a2 = last ? nA : cA + (size_t)(t + 2) * kstep; const char* b2 = last ? nB : cB + (size_t)(t + 2) * kstep;
            const char* a3 = a2 + kstep; const char* b3 = b2 + kstep;
            if (last && has_next) S.a_ready(nxt);
            if constexpr (SP2) {
            PG8_LDB(B0, 0, 0); PG8_LDB(B1, 0, 1); PG8_SCHED; PG8_LDA(At, 0, 0); PG8_STAGE(PG8_SA(1, 1), a1 + hstep, voffA);
            PG8_WAIT_V(8); PG8_WAIT_L(0); PG8_BAR; PG8_MMA(0, 0, At, B0); PG8_MMA(0, 1, At, B1); PG8_BAR; PG8_SCHED;
            PG8_LDA(At, 0, 1); PG8_STAGE(PG8_SB(0, 0), b2, voffB); PG8_STAGE(PG8_SB(0, 1), b2 + hstep, voffB); PG8_STAGE(PG8_SA(0, 0), a2, voffA);
            PG8_WAIT_V(8); PG8_WAIT_L(0); PG8_BAR; PG8_MMA(1, 0, At, B0); PG8_MMA(1, 1, At, B1); PG8_BAR; PG8_SCHED;
            PG8_LDB(B0, 1, 0); PG8_LDB(B1, 1, 1); PG8_SCHED; PG8_LDA(At, 1, 0); PG8_STAGE(PG8_SA(0, 1), a2 + hstep, voffA);
            PG8_WAIT_V(8); PG8_WAIT_L(0); PG8_BAR; PG8_MMA(0, 0, At, B0); PG8_MMA(0, 1, At, B1); PG8_BAR; PG8_SCHED;
            PG8_LDA(At, 1, 1); PG8_STAGE(PG8_SB(1, 0), b3, voffB); PG8_STAGE(PG8_SB(1, 1), b3 + hstep, voffB); PG8_STAGE(PG8_SA(1, 0), a3, voffA);
            PG8_WAIT_V(8); PG8_WAIT_L(0); PG8_BAR; PG8_MMA(1, 0, At, B0); PG8_MMA(1, 1, At, B1); PG8_BAR; PG8_SCHED;
            } else {
            PG8_LDB(B0, 0, 0); PG8_SCHED; PG8_LDA(At, 0, 0); PG8_STAGE(PG8_SA(1, 1), a1 + hstep, voffA);
            PG8_WAIT_L(8); PG8_BAR; PG8_WAIT_L(0); PG8_MMA(0, 0, At, B0); PG8_BAR; PG8_SCHED;
            PG8_LDB(B1, 0, 1); PG8_STAGE(PG8_SB(0, 0), b2, voffB);
            PG8_BAR; PG8_WAIT_L(0); PG8_MMA(0, 1, At, B1); PG8_BAR;
            PG8_LDA(At, 0, 1); PG8_STAGE(PG8_SA(0, 0), a2, voffA);
            PG8_BAR; PG8_WAIT_L(0); PG8_MMA(1, 0, At, B0); PG8_BAR; PG8_SCHED;
            PG8_STAGE(PG8_SB(0, 1), b2 + hstep, voffB);
            PG8_WAIT_V(6); PG8_BAR; PG8_MMA(1, 1, At, B1); PG8_BAR;
            PG8_LDB(B0, 1, 0); PG8_SCHED; PG8_LDA(At, 1, 0); PG8_STAGE(PG8_SA(0, 1), a2 + hstep, voffA);
            PG8_WAIT_L(8); PG8_BAR; PG8_WAIT_L(0); PG8_MMA(0, 0, At, B0); PG8_BAR; PG8_SCHED;
            PG8_LDB(B1, 1, 1); PG8_STAGE(PG8_SB(1, 0), b3, voffB);
            PG8_BAR; PG8_WAIT_L(0); PG8_MMA(0, 1, At, B1); PG8_BAR;
            PG8_LDA(At, 1, 1); PG8_STAGE(PG8_SA(1, 0), a3, voffA);
            PG8_BAR; PG8_WAIT_L(0); PG8_MMA(1, 0, At, B0); PG8_BAR; PG8_SCHED;
            PG8_STAGE(PG8_SB(1, 1), b3 + hstep, voffB);
            PG8_WAIT_V(6); PG8_BAR; PG8_MMA(1, 1, At, B1); PG8_BAR;
            }
        }
        if constexpr (ALIGN_EPI) { if (wr == 0) PG8_BAR; }
        if constexpr (!Epi::AFTER_DRAIN) { E(acc, cur, wr, wc, fr, fq); S.done(cur); }
        if (!has_next) break;
#pragma unroll
        for (int a = 0; a < 2; ++a)
#pragma unroll
            for (int b = 0; b < 2; ++b)
#pragma unroll
                for (int m = 0; m < 4; ++m)
#pragma unroll
                    for (int n = 0; n < 2; ++n) acc[a][b][m][n] = (f32x4){0.f, 0.f, 0.f, 0.f};
        cur = nxt; cA = nA; cB = nB; ++ui;
        if constexpr (ALIGN_EPI) { if (wr == 1) PG8_BAR; }
    }
    PG8_WAIT_V(0);
    if constexpr (!ALIGN_EPI) { if (wr == 0) PG8_BAR; }
    PG8_BAR;
    if constexpr (Epi::AFTER_DRAIN) { E.fused(acc, cur, wr, wc, fr, fq, lds, wid, lane); S.done(cur); }
#undef PG8_SA
#undef PG8_SB
#undef PG8_STAGE
#undef PG8_LDA
#undef PG8_LDB
#undef PG8_MMA
#undef PG8_WAIT_V
#undef PG8_WAIT_L
#undef PG8_BAR
#undef PG8_SCHED
}
}

typedef unsigned short bf16;
typedef short bf16x8 __attribute__((ext_vector_type(8)));
typedef short s16x4 __attribute__((ext_vector_type(4)));
typedef float f32x4 __attribute__((ext_vector_type(4)));
typedef float f32x16 __attribute__((ext_vector_type(16)));
typedef unsigned u32x4 __attribute__((ext_vector_type(4)));
typedef unsigned u32x2 __attribute__((ext_vector_type(2)));
#define LAS __attribute__((address_space(3)))

constexpr int NB = 8, TPB = 2304, MT = NB * TPB, DM = 1024, NLAT = 2048;
constexpr int NP_E = 3328, NP_O = 3072, FF = 2816;
constexpr float EPSN = 1e-6f;
constexpr size_t MiB = 1u << 20;
constexpr size_t WS_CTL = 0, WS_MOD = 1 * MiB, WS_X = 2 * MiB, WS_H = 74 * MiB, WS_MIX = 110 * MiB, WS_P = 146 * MiB, WS_W = 263 * MiB,
                 WS_OSC = 290 * MiB, WS_KR = 326 * MiB, WS_U = 328 * MiB, WS_T = 342 * MiB, WS_END = 350 * MiB;
constexpr size_t WS_LSUM = 128 * 1024;
constexpr size_t WS_CQN = WS_MIX, WS_CKVN = WS_MIX + 14 * MiB, WS_DSCR = WS_H;
constexpr size_t W_IN = 0, W_OUT = 13 * MiB / 2, W_GU = 17 * MiB / 2, W_DN = 39 * MiB / 2, W_UQ = 25 * MiB, W_UKV = 25 * MiB + 768 * 1024;
constexpr size_t OUT_KV = 0, OUT_Q = 36 * MiB;
constexpr int LDS_MAIN = 131072, LDS_BYTES = LDS_MAIN + 1024 + 2048;

struct Args { const float* in[23]; float* out; unsigned char* ws; int lo, hi; };
typedef __attribute__((address_space(4))) const Args* KArgP;
__device__ __forceinline__ KArgP kargs() { KArgP p = (KArgP)__builtin_amdgcn_kernarg_segment_ptr(); asm volatile("" : "+s"(p)); return p; }

__device__ __forceinline__ float bf2f(unsigned short h) { return __uint_as_float((unsigned)h << 16); }
__device__ __forceinline__ unsigned f2bf(float f) { unsigned u = __float_as_uint(f); return (u + 0x7fffu + ((u >> 16) & 1u)) >> 16; }
__device__ __forceinline__ unsigned pk2(float lo, float hi) { return f2bf(lo) | (f2bf(hi) << 16); }
__device__ __forceinline__ float wave_sum(float v) {
#pragma unroll
    for (int o = 1; o < 64; o <<= 1) v += __shfl_xor(v, o);
    return v;
}
__device__ __forceinline__ float silu_f(float g) { return g / (1.0f + __expf(-g)); }
__device__ __forceinline__ void sincos_r(float ang, float& s, float& c) {
    float r = ang * 0.15915494309189535f; r = r - __builtin_floorf(r);
    s = __builtin_amdgcn_sinf(r); c = __builtin_amdgcn_cosf(r);
}
__device__ __forceinline__ float inv_freq(int i, int half) { return __builtin_amdgcn_exp2f(-(float)i / (float)half * 13.287712379549449f); }

__device__ __forceinline__ void mod_item(KArgP a, int l, int cg, LAS unsigned char* lds) {
    const int tid = otid();
    float* MOD = (float*)(a->ws + WS_MOD);
    LAS float* S = (LAS float*)lds;
    LAS float* R = S + 1024 * 12;
    for (int i = tid; i < 9 * 1024; i += 512) { const int w = i >> 10, k = i & 1023; const float v = (w < 8) ? a->in[1][w * 1024 + k] : a->in[3][k]; S[k * 12 + w] = silu_f(v); }
    __syncthreads();
    const int nl = tid & 63, kp = tid >> 6, n0 = cg * 256;
    f32x4 acc[9];
#pragma unroll
    for (int w = 0; w < 9; ++w) acc[w] = (f32x4){0.f, 0.f, 0.f, 0.f};
    const float* wp = a->in[4] + (size_t)l * 1024 * 6144 + n0 + 4 * nl;
#pragma unroll 8
    for (int k = kp * 128; k < kp * 128 + 128; ++k) {
        const f32x4 wv = *(const f32x4*)(wp + (size_t)k * 6144);
        const f32x4 s0 = *(const LAS f32x4*)(S + k * 12), s1 = *(const LAS f32x4*)(S + k * 12 + 4); const float s8 = S[k * 12 + 8];
        acc[0] += wv * s0[0]; acc[1] += wv * s0[1]; acc[2] += wv * s0[2]; acc[3] += wv * s0[3];
        acc[4] += wv * s1[0]; acc[5] += wv * s1[1]; acc[6] += wv * s1[2]; acc[7] += wv * s1[3]; acc[8] += wv * s8;
    }
#pragma unroll
    for (int w = 0; w < 9; ++w) *(LAS f32x4*)(R + (kp * 9 + w) * 256 + 4 * nl) = acc[w];
    __syncthreads();
    for (int i = tid; i < 9 * 256; i += 512) { const int w = i >> 8, n2 = i & 255; float v = a->in[5][l * 6144 + n0 + n2];
#pragma unroll
        for (int p = 0; p < 8; ++p) v += R[(p * 9 + w) * 256 + n2];
        MOD[(size_t)(l * 9 + w) * 6144 + n0 + n2] = v; }
    __syncthreads();
}
__device__ __forceinline__ void convert_weights(KArgP a, int layer, LAS unsigned char* lds, int part, int gw, int NGW);
__device__ __forceinline__ void phase_prep(KArgP a, LAS unsigned char* lds) {
    const int tid = otid(), G = gridDim.x;
    if (blockIdx.x == 0) { if (tid < 64) ((unsigned*)(a->ws + WS_CTL))[tid] = 0u; for (int i = tid; i < 3456; i += 512) ((unsigned*)(a->ws + WS_CTL))[4096 + i] = 0u; }
    for (int item = blockIdx.x; item < 96; item += G) mod_item(a, item / 24, item % 24, lds);
    if ((int)blockIdx.x >= 96 && G > 96) {
        convert_weights(a, 0, lds, 0, ((int)blockIdx.x - 96) * 8 + (otid() >> 6), (G - 96) * 8); convert_weights(a, 0, lds, 1, ((int)blockIdx.x - 96) * 8 + (otid() >> 6), (G - 96) * 8); }
}

__device__ __forceinline__ void transpose_item(const float* W, int K, int N, bf16* WT, int k0, int n0, int drow0, LAS float* scr, int lane) {
    float tv_[32];
#pragma unroll
    for (int i = 0; i < 32; ++i) { const int kk = 2 * i + (lane >> 5); tv_[i] = W[(size_t)(k0 + kk) * N + n0 + (lane & 31)]; }
#pragma unroll
    for (int i = 0; i < 32; ++i) { const int kk = 2 * i + (lane >> 5); scr[kk * 33 + (lane & 31)] = tv_[i]; }
    asm volatile("s_waitcnt lgkmcnt(0)" ::: "memory");
    const int c = lane & 7;
#pragma unroll
    for (int j = 0; j < 4; ++j) { const int n = (lane >> 3) + 8 * j; const LAS float* s = scr + (8 * c) * 33 + n;
        u32x4 o; o.x = pk2(s[0 * 33], s[1 * 33]); o.y = pk2(s[2 * 33], s[3 * 33]); o.z = pk2(s[4 * 33], s[5 * 33]); o.w = pk2(s[6 * 33], s[7 * 33]);
        *(u32x4*)(WT + (size_t)(drow0 + n) * K + k0 + 8 * c) = o; }
    asm volatile("s_waitcnt lgkmcnt(0)" ::: "memory");
}
__device__ __forceinline__ void convert_weights(KArgP a, int layer, LAS unsigned char* lds, int part, int gw, int NGW) {
    const int lane = otid() & 63, wave = otid() >> 6;
    LAS float* scr = (LAS float*)(lds + wave * 8448);
    const bool even = !(layer & 1); const int e = layer >> 1;
    unsigned char* Wb = a->ws + WS_W;
    if (part == 0) {
        const int nin = even ? 3232 : 3072;
        const float* w_in = even ? a->in[11] + (size_t)e * 1024 * 3232 : a->in[18] + (size_t)e * 1024 * 3072;
        const int nbin = nin / 32;
        const int I_IN = 16 * nbin, I_OUT = 512, I_UQ = even ? 6 * 24 : 0, I_UKV = even ? 4 * 32 : 0;
        const int NIT = I_IN + I_OUT + I_UQ + I_UKV;
        for (int it = gw; it < NIT; it += NGW) {
            int r = it;
            if (r < I_IN) { const int kb = r / nbin, nb = r % nbin; transpose_item(w_in, 1024, nin, (bf16*)(Wb + W_IN), 64 * kb, 32 * nb, 32 * nb, scr, lane); continue; } r -= I_IN;
            if (r < I_OUT) { const int kb = r / 32, nb = r % 32; transpose_item(a->in[7] + (size_t)layer * 1024 * 1024, 1024, 1024, (bf16*)(Wb + W_OUT), 64 * kb, 32 * nb, 32 * nb, scr, lane); continue; } r -= I_OUT;
            if (r < I_UQ) { const int kb = r / 24, nb = r % 24; transpose_item(a->in[15] + (size_t)e * 384 * 768, 384, 768, (bf16*)(Wb + W_UQ), 64 * kb, 32 * nb, 32 * nb, scr, lane); continue; } r -= I_UQ;
            { const int kb = r / 32, nb = r % 32; transpose_item(a->in[17] + (size_t)e * 256 * 1024, 256, 1024, (bf16*)(Wb + W_UKV), 64 * kb, 32 * nb, 32 * nb, scr, lane); }
        }
    } else {
        constexpr int I_G = 16 * 88, I_D = 44 * 32;
        for (int it = gw; it < 2 * I_G + I_D; it += NGW) {
            int r = it;
            if (r < I_G) { const int kb = r / 88, nb = r % 88, n0 = 32 * nb; transpose_item(a->in[8] + (size_t)layer * 1024 * FF, 1024, FF, (bf16*)(Wb + W_GU), 64 * kb, n0, (n0 >> 7) * 256 + (n0 & 127), scr, lane); continue; } r -= I_G;
            if (r < I_G) { const int kb = r / 88, nb = r % 88, n0 = 32 * nb; transpose_item(a->in[9] + (size_t)layer * 1024 * FF, 1024, FF, (bf16*)(Wb + W_GU), 64 * kb, n0, (n0 >> 7) * 256 + 128 + (n0 & 127), scr, lane); continue; } r -= I_G;
            { const int kb = r / 32, nb = r % 32; transpose_item(a->in[10] + (size_t)layer * FF * 1024, FF, 1024, (bf16*)(Wb + W_DN), 64 * kb, 32 * nb, 32 * nb, scr, lane); }
        }
    }
}

__device__ __forceinline__ f32x4 ld4_bf16(const bf16* p) { const u32x2 w = *(const u32x2*)p; return (f32x4){__uint_as_float(w.x << 16), __uint_as_float(w.x & 0xffff0000u), __uint_as_float(w.y << 16), __uint_as_float(w.y & 0xffff0000u)}; }
__device__ __forceinline__ void phase_norm(KArgP a, int layer, int which, bool addT) {
    const int lane = otid() & 63, wave = otid() >> 6;
    const int gw = blockIdx.x * 8 + wave, NGW = gridDim.x * 8;
    bf16* X = (bf16*)(a->ws + WS_X); bf16* H = (bf16*)(a->ws + WS_H); const float* T = (const float*)(a->ws + WS_T);
    const float* g = a->in[6] + (layer * 2 + which) * 1024;
    const float* mod = (const float*)(a->ws + WS_MOD) + (size_t)layer * 9 * 6144;
    const int shoff = which ? 3072 : 0, scoff = which ? 4096 : 1024;
    const bool from_inputs = (layer == 0 && which == 0);
    constexpr int RB = 3;
    for (int r0 = gw; r0 < MT; r0 += RB * NGW) {
        f32x4 v[RB][4];
#pragma unroll
        for (int k = 0; k < RB; ++k) { const int row = r0 + k * NGW; if (row < MT) {
            if (from_inputs) { const int b = row / TPB, j = row - b * TPB; const float* xr = (j < 256 ? a->in[2] + (size_t)(b * 256 + j) * 1024 : a->in[0] + (size_t)(b * NLAT + j - 256) * 1024) + 8 * lane;
#pragma unroll
                for (int q = 0; q < 2; ++q) { v[k][2 * q] = *(const f32x4*)(xr + 512 * q); v[k][2 * q + 1] = *(const f32x4*)(xr + 512 * q + 4); } }
            else {
#pragma unroll
                for (int q = 0; q < 2; ++q) { const u32x4 w = *(const u32x4*)(X + (size_t)row * 1024 + 8 * lane + 512 * q);
                    v[k][2 * q] = (f32x4){__uint_as_float(w.x << 16), __uint_as_float(w.x & 0xffff0000u), __uint_as_float(w.y << 16), __uint_as_float(w.y & 0xffff0000u)};
                    v[k][2 * q + 1] = (f32x4){__uint_as_float(w.z << 16), __uint_as_float(w.z & 0xffff0000u), __uint_as_float(w.w << 16), __uint_as_float(w.w & 0xffff0000u)}; } } } }
#pragma unroll
        for (int k = 0; k < RB; ++k) { const int row = r0 + k * NGW; if (row < MT) {
            const int b = row / TPB, j = row - b * TPB, widx = (j < 256) ? 8 : b;
            if (addT && j < 256) { const float* tr = T + (size_t)(b * 256 + j) * 1024 + 8 * lane;
#pragma unroll
                for (int q = 0; q < 2; ++q) { v[k][2 * q] = v[k][2 * q] + *(const f32x4*)(tr + 512 * q); v[k][2 * q + 1] = v[k][2 * q + 1] + *(const f32x4*)(tr + 512 * q + 4);
                    u32x4 w; w.x = pk2(v[k][2 * q][0], v[k][2 * q][1]); w.y = pk2(v[k][2 * q][2], v[k][2 * q][3]); w.z = pk2(v[k][2 * q + 1][0], v[k][2 * q + 1][1]); w.w = pk2(v[k][2 * q + 1][2], v[k][2 * q + 1][3]);
                    *(u32x4*)(X + (size_t)row * 1024 + 8 * lane + 512 * q) = w; } }
            float ss = 0.f;
#pragma unroll
            for (int q = 0; q < 4; ++q) ss += (v[k][q][0] * v[k][q][0] + v[k][q][1] * v[k][q][1]) + (v[k][q][2] * v[k][q][2] + v[k][q][3] * v[k][q][3]);
            const float rstd = __builtin_amdgcn_rsqf(wave_sum(ss) * (1.f / 1024.f) + EPSN);
#pragma unroll
            for (int q = 0; q < 2; ++q) { const int col = 8 * lane + 512 * q; f32x4 y[2];
#pragma unroll
                for (int hh = 0; hh < 2; ++hh) { const f32x4 gv = *(const f32x4*)(g + col + 4 * hh), sc = *(const f32x4*)(mod + widx * 6144 + scoff + col + 4 * hh), sh = *(const f32x4*)(mod + widx * 6144 + shoff + col + 4 * hh);
                    y[hh] = v[k][2 * q + hh] * rstd * gv * (sc + 1.0f) + sh; }
                u32x4 w; w.x = pk2(y[0][0], y[0][1]); w.y = pk2(y[0][2], y[0][3]); w.z = pk2(y[1][0], y[1][1]); w.w = pk2(y[1][2], y[1][3]);
                { bf16* sp_ = H + (size_t)row * 1024 + col; asm volatile("global_store_dwordx4 %0, %1, off sc1\n\ts_nop 1" :: "v"(sp_), "v"(w) : "memory"); } } } }
    }
}

__device__ __forceinline__ void phase_post_even(KArgP a, int layer) {
    const int lane = otid() & 63, wave = otid() >> 6;
    const int gw = blockIdx.x * 8 + wave, NGW = gridDim.x * 8, e = layer >> 1;
    const bf16* P = (const bf16*)(a->ws + WS_P); bf16* CQN = (bf16*)(a->ws + WS_CQN); bf16* CKVN = (bf16*)(a->ws + WS_CKVN); bf16* KR = (bf16*)(a->ws + WS_KR);
    const float* qg = a->in[14] + e * 384; const float* kg = a->in[16] + e * 256;
    for (int row = gw; row < MT; row += NGW) {
        const int b = row / TPB, j = row - b * TPB;
        const bf16* pr = P + (size_t)row * NP_E;
        {   float x[6]; float ss = 0.f;
#pragma unroll
            for (int k = 0; k < 3; ++k) { const unsigned w = *(const unsigned*)(pr + 2560 + 2 * lane + 128 * k); x[2 * k] = bf2f((unsigned short)(w & 0xffff)); x[2 * k + 1] = bf2f((unsigned short)(w >> 16)); ss += x[2 * k] * x[2 * k] + x[2 * k + 1] * x[2 * k + 1]; }
            const float rstd = __builtin_amdgcn_rsqf(wave_sum(ss) * (1.f / 384.f) + EPSN);
#pragma unroll
            for (int k = 0; k < 3; ++k) { const int col = 2 * lane + 128 * k; *(unsigned*)(CQN + (size_t)row * 384 + col) = pk2(x[2 * k] * rstd * qg[col], x[2 * k + 1] * rstd * qg[col + 1]); } }
        {   float x[4]; float ss = 0.f;
#pragma unroll
            for (int k = 0; k < 2; ++k) { const unsigned w = *(const unsigned*)(pr + 2944 + 2 * lane + 128 * k); x[2 * k] = bf2f((unsigned short)(w & 0xffff)); x[2 * k + 1] = bf2f((unsigned short)(w >> 16)); ss += x[2 * k] * x[2 * k] + x[2 * k + 1] * x[2 * k + 1]; }
            const float rstd = __builtin_amdgcn_rsqf(wave_sum(ss) * (1.f / 256.f) + EPSN);
#pragma unroll
            for (int k = 0; k < 2; ++k) { const int col = 2 * lane + 128 * k; *(unsigned*)(CKVN + (size_t)row * 256 + col) = pk2(x[2 * k] * rstd * kg[col], x[2 * k + 1] * rstd * kg[col + 1]); } }
        {   const int d = lane & 31; const float x = bf2f(pr[3200 + d]); const float xp = __shfl_xor(x, 8);
            float o = x;
            if (j >= 256) { const int t = j - 256, blk = d >> 4, wi = d & 15, i8 = wi & 7; const float pos = (float)(blk ? (t & 63) : (t >> 6));
                float s, c; sincos_r(pos * inv_freq(i8, 8), s, c);
                o = (wi < 8) ? (x * c - xp * s) : (xp * s + x * c); }
            if (lane < 32) KR[(size_t)row * 32 + d] = (bf16)f2bf(o); }
    }
}
__device__ __forceinline__ void phase_post_odd(KArgP a, int layer) {
    const int lane = otid() & 63, wave = otid() >> 6;
    const int gw = blockIdx.x * 8 + wave, NGW = gridDim.x * 8;
    bf16* P = (bf16*)(a->ws + WS_P);
    for (int row = gw; row < MT; row += NGW) {
        const int b = row / TPB, j = row - b * TPB; const bool lat = j >= 256; const int t = j - 256;
        bf16* pr = P + (size_t)row * NP_O;
#pragma unroll
        for (int u = 0; u < 2; ++u) { const int pid = lane + 64 * u, h = pid >> 5, i = pid & 31, d1 = h * 64 + i, d2 = d1 + 32;
            float s = 0.f, c = 1.f; if (lat) sincos_r((float)t * inv_freq(i, 32), s, c);
            const float q1 = bf2f(pr[d1]), q2 = bf2f(pr[d2]), k1 = bf2f(pr[256 + d1]) * 0.125f, k2 = bf2f(pr[256 + d2]) * 0.125f;
            if (lat) { pr[d1] = (bf16)f2bf(q1 * c - q2 * s); pr[d2] = (bf16)f2bf(q1 * s + q2 * c); }
            pr[256 + d1] = (bf16)f2bf(k1 * c - k2 * s); pr[256 + d2] = (bf16)f2bf(k1 * s + k2 * c); }
        if (lat) {
#pragma unroll
            for (int u = 0; u < 4; ++u) { const int pid = lane + 64 * u, vec = pid >> 5, pp = pid & 31, blk = pp >> 4, i = pp & 15, d1 = vec * 64 + blk * 32 + i, d2 = d1 + 16;
                const float pos = (float)(blk ? (t & 63) : (t >> 6)); float s, c; sincos_r(pos * inv_freq(i, 16), s, c);
                const float q1 = bf2f(pr[1536 + d1]), q2 = bf2f(pr[1536 + d2]), k1 = bf2f(pr[2048 + d1]), k2 = bf2f(pr[2048 + d2]);
                pr[1536 + d1] = (bf16)f2bf(q1 * c - q2 * s); pr[1536 + d2] = (bf16)f2bf(q1 * s + q2 * c);
                pr[2048 + d1] = (bf16)f2bf(k1 * c - k2 * s); pr[2048 + d2] = (bf16)f2bf(k1 * s + k2 * c); } }
    }
}

__device__ __forceinline__ void phase_readout(KArgP a, int layer) {
    const int lane = otid() & 63, wave = otid() >> 6;
    const int gw = blockIdx.x * 8 + wave, NGW = gridDim.x * 8;
    const bool even = !(layer & 1); const int np = even ? NP_E : NP_O, gcol = even ? 2048 : 1024;
    const bf16* P = (const bf16*)(a->ws + WS_P); const bf16* OF = (const bf16*)(a->ws + WS_OSC); const bf16* OB = OF + (size_t)MT * 512;
    bf16* MIX = (bf16*)(a->ws + WS_MIX);
    const int col = 8 * lane;
    float gn[8];
#pragma unroll
    for (int i = 0; i < 8; ++i) gn[i] = even ? a->in[13][(layer >> 1) * 128 + ((col + i) & 127)] : 1.f;
    constexpr int RB = 3;
    for (int r0 = gw; r0 < MT; r0 += RB * NGW) {
        u32x4 wf[RB], wb[RB], wg[RB];
#pragma unroll
        for (int k = 0; k < RB; ++k) { const int row = r0 + k * NGW; if (row < MT) {
            wf[k] = *(const u32x4*)(OF + (size_t)row * 512 + col); wb[k] = *(const u32x4*)(OB + (size_t)row * 512 + col); wg[k] = *(const u32x4*)(P + (size_t)row * np + gcol + col); } }
#pragma unroll
        for (int k = 0; k < RB; ++k) { const int row = r0 + k * NGW; if (row < MT) {
            float o[8], gt[8]; float ss = 0.f;
#pragma unroll
            for (int i = 0; i < 4; ++i) { const unsigned f = wf[k][i], bb = wb[k][i], gg = wg[k][i];
                o[2 * i] = __uint_as_float(f << 16) + __uint_as_float(bb << 16); o[2 * i + 1] = __uint_as_float(f & 0xffff0000u) + __uint_as_float(bb & 0xffff0000u);
                gt[2 * i] = __uint_as_float(gg << 16); gt[2 * i + 1] = __uint_as_float(gg & 0xffff0000u);
                ss += o[2 * i] * o[2 * i] + o[2 * i + 1] * o[2 * i + 1]; }
            ss += __shfl_xor(ss, 1); ss += __shfl_xor(ss, 2); ss += __shfl_xor(ss, 4); ss += __shfl_xor(ss, 8);
            const float rstd = __builtin_amdgcn_rsqf(ss * (1.f / 128.f) + EPSN);
            u32x4 w;
#pragma unroll
            for (int i = 0; i < 4; ++i) w[i] = pk2(o[2 * i] * rstd * gn[2 * i] * silu_f(gt[2 * i]), o[2 * i + 1] * rstd * gn[2 * i + 1] * silu_f(gt[2 * i + 1]));
            *(u32x4*)(MIX + (size_t)row * 1024 + col) = w; } }
    }
}
__device__ __forceinline__ void phase_final(KArgP a) {
    const int lane = otid() & 63, wave = otid() >> 6;
    const int gw = blockIdx.x * 8 + wave, NGW = gridDim.x * 8;
    const bf16* X = (const bf16*)(a->ws + WS_X); const float* g = a->in[22];
    constexpr int RB = 4;
    for (int r0 = gw; r0 < NB * NLAT; r0 += RB * NGW) {
        f32x4 v[RB][4];
#pragma unroll
        for (int k = 0; k < RB; ++k) { const int r = r0 + k * NGW; if (r < NB * NLAT) { const int row = (r >> 11) * TPB + 256 + (r & 2047);
#pragma unroll
            for (int q = 0; q < 2; ++q) { const u32x4 w = *(const u32x4*)(X + (size_t)row * 1024 + 8 * lane + 512 * q);
                v[k][2 * q] = (f32x4){__uint_as_float(w.x << 16), __uint_as_float(w.x & 0xffff0000u), __uint_as_float(w.y << 16), __uint_as_float(w.y & 0xffff0000u)};
                v[k][2 * q + 1] = (f32x4){__uint_as_float(w.z << 16), __uint_as_float(w.z & 0xffff0000u), __uint_as_float(w.w << 16), __uint_as_float(w.w & 0xffff0000u)}; } } }
#pragma unroll
        for (int k = 0; k < RB; ++k) { const int r = r0 + k * NGW; if (r < NB * NLAT) { float ss = 0.f;
#pragma unroll
            for (int q = 0; q < 4; ++q) ss += (v[k][q][0] * v[k][q][0] + v[k][q][1] * v[k][q][1]) + (v[k][q][2] * v[k][q][2] + v[k][q][3] * v[k][q][3]);
            const float rstd = __builtin_amdgcn_rsqf(wave_sum(ss) * (1.f / 1024.f) + EPSN);
#pragma unroll
            for (int q = 0; q < 4; ++q) { const int col = 8 * lane + 512 * (q >> 1) + 4 * (q & 1); const f32x4 gv = *(const f32x4*)(g + col);
                *(f32x4*)(a->out + (size_t)r * 1024 + col) = v[k][q] * rstd * gv; } } }
    }
}
__device__ __forceinline__ unsigned cvtpk2(float lo, float hi) { unsigned r; asm("v_cvt_pk_bf16_f32 %0, %1, %2" : "=v"(r) : "v"(lo), "v"(hi)); return r; }
__device__ __forceinline__ f32x4 mfma16(bf16x8 a, bf16x8 b, f32x4 c) { return __builtin_amdgcn_mfma_f32_16x16x32_bf16(a, b, c, 0, 0, 0); }

template <int DK, bool HG, int MODE>
__device__ __forceinline__ void scan_item(KArgP a, int layer, int item, int seg, LAS unsigned char* lds) {
    const int tid = otid(), wid = tid >> 6, lane = tid & 63, l15 = lane & 15, q4 = lane >> 4;
    const int h = item & 3, dir = (item >> 2) & 1, b = item >> 3;
    constexpr int TPT = DK / 8, QS = DK * 2 + 16, TS = 144;
    constexpr int NP = HG ? NP_E : NP_O;
    LAS unsigned char* Lqt = lds; LAS unsigned char* Lkt = Lqt + 64 * QS; LAS unsigned char* Lqh = Lkt + 64 * QS;
    LAS unsigned char* LkhT = Lqh + 64 * QS; LAS unsigned char* LvT = LkhT + DK * TS; LAS unsigned char* Latt = LvT + 128 * TS;
    LAS float* Ltot = (LAS float*)(Latt + 64 * TS); LAS float* Lbl = Ltot + 512;
    const bf16* P = (const bf16*)(a->ws + WS_P);
    bf16* OSC = (bf16*)(a->ws + WS_OSC) + (size_t)dir * MT * 512;
    f32x4* Ub = (f32x4*)(a->ws + WS_U); float* Lb = (float*)(a->ws + WS_LSUM);
    const int c = tid & (DK - 1), tq = tid / DK;
    float lb = 0.f, lg = 0.f, qscale = 1.f; int qcol, zcol;
    if (HG) { qscale = 0.08838834764831845f; qcol = h * 128 + c; zcol = (dir ? 1536 : 1024) + h * 128 + c;
        if (layer >= 2) { const float l0 = a->in[12][(0 * 2 + dir) * 512 + h * 128 + c], l1 = a->in[12][(1 * 2 + dir) * 512 + h * 128 + c]; lb = 1.f / (1.f + __expf(l0 - l1)); } }
    else { qcol = h * 64 + c; zcol = 256 + h * 64 + c; const float x = a->in[19][((layer >> 1) * 2 + dir) * 4 + h]; lg = -__logf(1.f + __expf(-x)); }
    const int vcol = 512 + h * 128;
    const int rowbase = b * TPB;
    const int tv = lane, c8v = wid;
    unsigned short rq[TPT], rz[TPT]; bf16x8 rv[2];
#define SC_JB(ci) (dir ? ((ci) < 4 ? 255 - 64 * (ci) : 2303 - 64 * ((ci) - 4)) : 64 * (ci))
#define SC_LOAD(ci) do { const int jb_ = SC_JB(ci), sg_ = dir ? -1 : 1; \
        _Pragma("unroll") for (int i = 0; i < TPT; ++i) { const bf16* pr_ = P + (size_t)(rowbase + jb_ + sg_ * (tq * TPT + i)) * NP; if (MODE) rq[i] = pr_[qcol]; rz[i] = pr_[zcol]; } \
        { const bf16* pv_ = P + (size_t)(rowbase + jb_ + sg_ * tv) * NP + vcol; rv[0] = *(const bf16x8*)(pv_ + c8v * 8); rv[1] = *(const bf16x8*)(pv_ + (c8v + 8) * 8); } } while (0)
    f32x4 Sacc[DK / 16];
#pragma unroll
    for (int i = 0; i < DK / 16; ++i) Sacc[i] = (f32x4){0.f, 0.f, 0.f, 0.f};
    const int c0 = 9 * seg;
    SC_LOAD(c0);
    if (MODE) {
        for (int s_ = 0; s_ < seg; ++s_) {
#pragma unroll
            for (int i = 0; i < DK / 16; ++i) { f32x4 v = Sacc[i];
                if (s_ > 0) { const f32x4 l4 = *(const f32x4*)(Lb + (size_t)(item * 3 + s_) * 128 + 16 * i + 4 * q4); v[0] *= __expf(l4[0]); v[1] *= __expf(l4[1]); v[2] *= __expf(l4[2]); v[3] *= __expf(l4[3]); }
                Sacc[i] = v + Ub[((size_t)(item * 3 + s_) * (DK / 16) + i) * 512 + tid]; }
        }
    }
    float lsum = 0.f;
    for (int ci = c0; ci < c0 + 9; ++ci) {
#pragma unroll
        for (int u = 0; u < 2; ++u)
#pragma unroll
            for (int e = 0; e < 8; ++e) *(LAS unsigned short*)(LvT + ((c8v + 8 * u) * 8 + e) * TS + tv * 2) = (unsigned short)rv[u][e];
        float zf[TPT], qf[TPT];
#pragma unroll
        for (int i = 0; i < TPT; ++i) { zf[i] = bf2f(rz[i]); if (MODE) qf[i] = bf2f(rq[i]) * qscale; }
        const int jb = SC_JB(ci), sg = dir ? -1 : 1;
        if (ci + 1 < c0 + 9) SC_LOAD(ci + 1);
        float kk_[TPT], e1v[TPT], e2v[TPT]; float Eref, Ebr, dlast;
        if (HG) {
            float fv[TPT];
#pragma unroll
            for (int i = 0; i < TPT; ++i) { const float z = fminf(fmaxf(zf[i], -30.f), 30.f);
                const float t = __expf(-fabsf(z)), r = __builtin_amdgcn_rcpf(1.f + t), tr = t * r;
                const float sig = z >= 0.f ? r : tr, sigm = z >= 0.f ? tr : r;
                kk_[i] = (1.f - lb) * sigm; fv[i] = lb + (1.f - lb) * sig; }
            float run = 1.f;
            if (tq < 2) {
#pragma unroll
                for (int i = TPT - 1; i >= 0; --i) { e2v[i] = run; run *= fv[i]; }
            } else {
#pragma unroll
                for (int i = 0; i < TPT; ++i) { run *= fv[i]; e1v[i] = run; }
            }
            Ltot[tq * 128 + c] = run;
            __syncthreads();
            const float t0 = Ltot[c], t1 = Ltot[128 + c], t2 = Ltot[256 + c], t3 = Ltot[384 + c];
            Eref = t0 * t1; Ebr = t2 * t3; dlast = Eref * Ebr;
            const float mul = (tq == 0) ? t1 : ((tq == 3) ? t2 : 1.f);
            if (tq < 2) {
#pragma unroll
                for (int i = 0; i < TPT; ++i) { e2v[i] = fmaxf(e2v[i] * mul, 1e-30f); if (MODE) e1v[i] = __builtin_amdgcn_rcpf(e2v[i]); }
            } else {
#pragma unroll
                for (int i = 0; i < TPT; ++i) { e1v[i] = fmaxf(e1v[i] * mul, 1e-30f); e2v[i] = __builtin_amdgcn_rcpf(e1v[i]); }
            }
            lsum += __logf(fmaxf(dlast, 1e-37f));
        } else {
#pragma unroll
            for (int i = 0; i < TPT; ++i) { kk_[i] = zf[i]; e1v[i] = __expf((float)(tq * TPT + i - 31) * lg); e2v[i] = __builtin_amdgcn_rcpf(e1v[i]); }
            Eref = __expf(32.f * lg); Ebr = Eref; dlast = Eref * Ebr;
            lsum += 64.f * lg;
        }
        unsigned short kh[TPT];
        if (MODE) {
#pragma unroll
            for (int i = 0; i < TPT; ++i) { const int tau = tq * TPT + i;
                const float qt = qf[i] * e1v[i], kt = kk_[i] * e2v[i];
                const unsigned wq = cvtpk2(qt, qt * Eref), wk = cvtpk2(kt, kt * Ebr);
                *(LAS unsigned short*)(Lqt + tau * QS + c * 2) = (unsigned short)(wq & 0xffff);
                *(LAS unsigned short*)(Lqh + tau * QS + c * 2) = (unsigned short)(wq >> 16);
                *(LAS unsigned short*)(Lkt + tau * QS + c * 2) = (unsigned short)(wk & 0xffff);
                kh[i] = (unsigned short)(wk >> 16); }
        } else {
#pragma unroll
            for (int i = 0; i < TPT; ++i) kh[i] = (unsigned short)(cvtpk2(kk_[i] * e2v[i] * Ebr, 0.f) & 0xffff);
        }
#pragma unroll
        for (int i8 = 0; i8 < TPT / 8; ++i8) { u32x4 w; w.x = kh[8 * i8] | ((unsigned)kh[8 * i8 + 1] << 16); w.y = kh[8 * i8 + 2] | ((unsigned)kh[8 * i8 + 3] << 16);
            w.z = kh[8 * i8 + 4] | ((unsigned)kh[8 * i8 + 5] << 16); w.w = kh[8 * i8 + 6] | ((unsigned)kh[8 * i8 + 7] << 16);
            *(LAS u32x4*)(LkhT + c * TS + (tq * TPT + 8 * i8) * 2) = w; }
        if (tq == 0) Lbl[c] = dlast;
        __syncthreads();
        const int dvl = 16 * wid + l15;
        const bf16x8 bv0 = *(const LAS bf16x8*)(LvT + dvl * TS + (8 * q4) * 2), bv1 = *(const LAS bf16x8*)(LvT + dvl * TS + (32 + 8 * q4) * 2);
        if (MODE) {
#pragma unroll
            for (int tt = 0; tt < 2; ++tt) { const int idx = 2 * wid + tt, si = idx >> 2, ti = idx & 3;
                f32x4 acc = (f32x4){0.f, 0.f, 0.f, 0.f};
#pragma unroll
                for (int kk = 0; kk < DK / 32; ++kk) { const bf16x8 A = *(const LAS bf16x8*)(Lkt + (16 * si + l15) * QS + (32 * kk + 8 * q4) * 2);
                    const bf16x8 B = *(const LAS bf16x8*)(Lqt + (16 * ti + l15) * QS + (32 * kk + 8 * q4) * 2); acc = mfma16(A, B, acc); }
                const int t = 16 * ti + l15, s0 = 16 * si + 4 * q4;
                u32x2 w; w.x = pk2(s0 + 0 <= t ? acc[0] : 0.f, s0 + 1 <= t ? acc[1] : 0.f); w.y = pk2(s0 + 2 <= t ? acc[2] : 0.f, s0 + 3 <= t ? acc[3] : 0.f);
                *(LAS u32x2*)(Latt + t * TS + s0 * 2) = w; }
            __syncthreads();
            bf16x8 Sb[DK / 32];
#pragma unroll
            for (int kk = 0; kk < DK / 32; ++kk) { u32x4 w; w.x = pk2(Sacc[2 * kk][0], Sacc[2 * kk][1]); w.y = pk2(Sacc[2 * kk][2], Sacc[2 * kk][3]);
                w.z = pk2(Sacc[2 * kk + 1][0], Sacc[2 * kk + 1][1]); w.w = pk2(Sacc[2 * kk + 1][2], Sacc[2 * kk + 1][3]); Sb[kk] = __builtin_bit_cast(bf16x8, w); }
#pragma unroll
            for (int ti = 0; ti < 4; ++ti) {
                f32x4 acc = (f32x4){0.f, 0.f, 0.f, 0.f};
                { const bf16x8 A = *(const LAS bf16x8*)(Latt + (16 * ti + l15) * TS + (8 * q4) * 2); acc = mfma16(A, bv0, acc); }
                if (ti >= 2) { const bf16x8 A = *(const LAS bf16x8*)(Latt + (16 * ti + l15) * TS + (32 + 8 * q4) * 2); acc = mfma16(A, bv1, acc); }
#pragma unroll
                for (int kk = 0; kk < DK / 32; ++kk) {
                    const s16x4 lo = *(const LAS s16x4*)(Lqh + (16 * ti + l15) * QS + (32 * kk + 4 * q4) * 2), hi = *(const LAS s16x4*)(Lqh + (16 * ti + l15) * QS + (32 * kk + 16 + 4 * q4) * 2);
                    const bf16x8 A = (bf16x8){lo[0], lo[1], lo[2], lo[3], hi[0], hi[1], hi[2], hi[3]};
                    acc = mfma16(A, Sb[kk], acc); }
#pragma unroll
                for (int r = 0; r < 4; ++r) { const int t = 16 * ti + 4 * q4 + r;
                    OSC[(size_t)(rowbase + jb + sg * t) * 512 + h * 128 + dvl] = (bf16)f2bf(acc[r]); }
            }
        }
#pragma unroll
        for (int i = 0; i < DK / 16; ++i) {
            const f32x4 d4 = *(const LAS f32x4*)(Lbl + 16 * i + 4 * q4);
            f32x4 s = Sacc[i] * d4;
            const bf16x8 A0 = *(const LAS bf16x8*)(LkhT + (16 * i + l15) * TS + (8 * q4) * 2), A1 = *(const LAS bf16x8*)(LkhT + (16 * i + l15) * TS + (32 + 8 * q4) * 2);
            s = mfma16(A0, bv0, s); s = mfma16(A1, bv1, s); Sacc[i] = s; }
        __syncthreads();
    }
    if (!MODE) {
#pragma unroll
        for (int i = 0; i < DK / 16; ++i) Ub[((size_t)(item * 3 + seg) * (DK / 16) + i) * 512 + tid] = Sacc[i];
        if (tq == 0) Lb[(size_t)(item * 3 + seg) * 128 + c] = lsum;
    }
#undef SC_JB
#undef SC_LOAD
}

#define SBAR() __builtin_amdgcn_sched_barrier(0)
__device__ __forceinline__ int crow(int r, int hi) { return (r & 3) + 8 * (r >> 2) + 4 * hi; }
__device__ __forceinline__ unsigned cvtpk(float lo, float hi) { unsigned r; asm volatile("v_cvt_pk_bf16_f32 %0, %1, %2" : "=v"(r) : "v"(lo), "v"(hi)); return r; }
__device__ __forceinline__ void partialSM(f32x16& p0, f32x16& p1, float& m_reg, float& mn, float& alpha, float C, float thr_raw) {
    float pmax = p0[0];
#pragma unroll
    for (int r = 1; r < 16; ++r) pmax = fmaxf(pmax, p0[r]);
#pragma unroll
    for (int r = 0; r < 16; ++r) pmax = fmaxf(pmax, p1[r]);
    { auto rr = __builtin_amdgcn_permlane32_swap(__float_as_uint(pmax), __float_as_uint(pmax), false, false);
      pmax = fmaxf(__uint_as_float(rr[0]), __uint_as_float(rr[1])); }
    if (__builtin_expect(__all(pmax - m_reg <= thr_raw), 1)) { mn = m_reg; alpha = 1.f; }
    else { mn = fmaxf(m_reg, pmax); alpha = __builtin_amdgcn_exp2f((m_reg - mn) * C); m_reg = mn; }
    const float mnC = -mn * C;
#pragma unroll
    for (int r = 0; r < 16; ++r) p0[r] = fmaf(p0[r], C, mnC);
#pragma unroll
    for (int r = 0; r < 16; ++r) p1[r] = fmaf(p1[r], C, mnC);
#pragma unroll
    for (int r = 0; r < 16; ++r) p0[r] = __builtin_amdgcn_exp2f(p0[r]);
}
__device__ __forceinline__ void finishSM(f32x16& p0, f32x16& p1, float alpha, float& l_reg, bf16x8& pa0, bf16x8& pa1, bf16x8& pa2, bf16x8& pa3) {
#pragma unroll
    for (int r = 0; r < 16; ++r) p1[r] = __builtin_amdgcn_exp2f(p1[r]);
    float ps = 0;
#pragma unroll
    for (int r = 0; r < 16; ++r) ps += p0[r];
#pragma unroll
    for (int r = 0; r < 16; ++r) ps += p1[r];
    { auto rr = __builtin_amdgcn_permlane32_swap(__float_as_uint(ps), __float_as_uint(ps), false, false);
      ps = __uint_as_float(rr[0]) + __uint_as_float(rr[1]); }
    l_reg = l_reg * alpha + ps;
#define PK4(P, BASE, OUT) do { unsigned a0 = cvtpk(P[BASE + 0], P[BASE + 1]), a1 = cvtpk(P[BASE + 2], P[BASE + 3]);   \
    unsigned b0 = cvtpk(P[BASE + 4], P[BASE + 5]), b1 = cvtpk(P[BASE + 6], P[BASE + 7]);                              \
    auto r0 = __builtin_amdgcn_permlane32_swap(a0, b0, false, false); auto r1 = __builtin_amdgcn_permlane32_swap(a1, b1, false, false); \
    u32x4 w = {r0[0], r1[0], r0[1], r1[1]}; OUT = __builtin_bit_cast(bf16x8, w); } while (0)
    PK4(p0, 0, pa0); PK4(p0, 8, pa1); PK4(p1, 0, pa2); PK4(p1, 8, pa3);
#undef PK4
}
template <int ND0, int KROWB>
__device__ __forceinline__ void qkt(f32x16& p0, f32x16& p1, const char* Ks, const bf16x8* qr, int r32, int hi) {
    p0 = f32x16{}; p1 = f32x16{};
#pragma unroll
    for (int d0 = 0; d0 < ND0; ++d0) { const int cb = (d0 * 16 + hi * 8) * 2;
        constexpr bool KSWZ_ = (KROWB % 128) == 0;
        const int cs_ = KSWZ_ ? (cb ^ ((r32 & 7) << 4)) : cb;
        const bf16x8 b0 = *reinterpret_cast<const bf16x8*>(Ks + r32 * KROWB + cs_);
        const bf16x8 b1 = *reinterpret_cast<const bf16x8*>(Ks + (32 + r32) * KROWB + cs_);
        p0 = __builtin_amdgcn_mfma_f32_32x32x16_bf16(b0, qr[d0], p0, 0, 0, 0);
        p1 = __builtin_amdgcn_mfma_f32_32x32x16_bf16(b1, qr[d0], p1, 0, 0, 0); }
}
template <int NCB> __device__ __forceinline__ int v_st(int k, int c) { const int kk = (k & ~0xC) | ((k & 4) << 1) | ((k & 8) >> 1); return ((kk >> 3) * NCB + (c >> 5)) * 512 + ((kk & 7) * 32 + (c & 31)) * 2; }
__device__ __forceinline__ int v_rd_base(int lane) { return ((lane & 3) << 3) | (((lane >> 2) & 3) << 6) | (((lane >> 4) & 1) << 5) | (((lane >> 5) & 1) << 8); }
template <int OFF> __device__ __forceinline__ s16x4 tr_read(int vb) {
    s16x4 r; asm volatile("ds_read_b64_tr_b16 %0, %1 offset:%2" : "=&v"(r) : "v"(vb), "i"(OFF) : "memory"); return r;
}
template <int NCB, int D0> __device__ __forceinline__ void pv_one(f32x16& od, int vb, bf16x8 pa0, bf16x8 pa1, bf16x8 pa2, bf16x8 pa3) {
#define VOFF(ks, half) (D0 * 512 + (ks) * (NCB * 1024) + (half) * (NCB * 512))
    const s16x4 l0 = tr_read<VOFF(0, 0)>(vb), h0 = tr_read<VOFF(0, 1)>(vb), l1 = tr_read<VOFF(1, 0)>(vb), h1 = tr_read<VOFF(1, 1)>(vb);
    const s16x4 l2 = tr_read<VOFF(2, 0)>(vb), h2 = tr_read<VOFF(2, 1)>(vb), l3 = tr_read<VOFF(3, 0)>(vb), h3 = tr_read<VOFF(3, 1)>(vb);
#undef VOFF
    asm volatile("s_waitcnt lgkmcnt(0)" ::: "memory"); SBAR();
#define PK(L, H) (bf16x8){L[0], L[1], L[2], L[3], H[0], H[1], H[2], H[3]}
    od = __builtin_amdgcn_mfma_f32_32x32x16_bf16(pa0, PK(l0, h0), od, 0, 0, 0);
    od = __builtin_amdgcn_mfma_f32_32x32x16_bf16(pa1, PK(l1, h1), od, 0, 0, 0);
    od = __builtin_amdgcn_mfma_f32_32x32x16_bf16(pa2, PK(l2, h2), od, 0, 0, 0);
    od = __builtin_amdgcn_mfma_f32_32x32x16_bf16(pa3, PK(l3, h3), od, 0, 0, 0);
#undef PK
}
template <int NCB> __device__ __forceinline__ void pv_all(f32x16* o, int vb, bf16x8 pa0, bf16x8 pa1, bf16x8 pa2, bf16x8 pa3) {
    pv_one<NCB, 0>(o[0], vb, pa0, pa1, pa2, pa3); pv_one<NCB, 1>(o[1], vb, pa0, pa1, pa2, pa3);
    if constexpr (NCB == 4) { pv_one<NCB, 2>(o[2], vb, pa0, pa1, pa2, pa3); pv_one<NCB, 3>(o[3], vb, pa0, pa1, pa2, pa3); }
}

template <int DQK, int DV, int KROWB>
__device__ __forceinline__ void attn_core(const bf16x8* qr, const bf16* kA, int sA, const bf16* kB, int sB, const bf16* vP, int sV,
                                          int NT, float C, float thr_raw, char* lds, f32x16* o, float& l_out, const int tid) {
    constexpr int NCB = DV / 32, SHM_V = 64 * DV * 2, SHM_K = 64 * KROWB, ND0 = DQK / 16;
    constexpr int PPR = DQK / 8, NPK = 64 * PPR, NKS = (NPK + 511) / 512, VPR = DV / 8, NVS = 64 * VPR / 512;
    const int wid = tid >> 6, lane = tid & 63, r32 = lane & 31, hi = lane >> 5;
    char* V_lds = lds; char* K_lds = lds + 2 * SHM_V;
    float* wsf = (float*)(lds + 2 * SHM_V + 2 * SHM_K) + wid * 64; float* al_l = wsf + 32;
    float m_reg = -1e30f, l_reg = 0;
    const bf16* kp[NKS]; int kadv[NKS], kst[NKS]; bool kval[NKS];
#pragma unroll
    for (int i = 0; i < NKS; ++i) { int p = tid + 512 * i; kval[i] = p < NPK; if (!kval[i]) p -= 512; const int row = p / PPR, c8 = p - row * PPR;
        if (c8 < 8) { kp[i] = kA + (size_t)row * sA + c8 * 8; kadv[i] = 64 * sA; } else { kp[i] = kB + (size_t)row * sB + (c8 - 8) * 8; kadv[i] = 64 * sB; }
        kst[i] = row * KROWB + (((KROWB % 128) == 0) ? ((c8 * 16) ^ ((row & 7) << 4)) : (c8 * 16)); }
    const bf16* vp[NVS]; int vst[NVS];
#pragma unroll
    for (int i = 0; i < NVS; ++i) { const int p = tid + 512 * i, row = p / VPR, c8 = p % VPR; vp[i] = vP + (size_t)row * sV + c8 * 8; vst[i] = v_st<NCB>(row, c8 * 8); }
    const int vadv = 64 * sV;
    const int vb0 = (int)(uintptr_t)V_lds + v_rd_base(lane);
    struct { bf16x8 ks[NKS]; bf16x8 vs[NVS]; } sr_[1];
#define SLOAD(i, t) do { _Pragma("unroll") for (int s_ = 0; s_ < NKS; ++s_) sr_[i].ks[s_] = *(const bf16x8*)(kp[s_] + (size_t)(t) * kadv[s_]); \
        _Pragma("unroll") for (int s_ = 0; s_ < NVS; ++s_) sr_[i].vs[s_] = *(const bf16x8*)(vp[s_] + (size_t)(t) * vadv); } while (0)
#define SWRITE(b, i) do { _Pragma("unroll") for (int s_ = 0; s_ < NVS; ++s_) *(bf16x8*)(V_lds + (b) * SHM_V + vst[s_]) = sr_[i].vs[s_]; \
        _Pragma("unroll") for (int s_ = 0; s_ < NKS; ++s_) if (kval[s_]) *(bf16x8*)(K_lds + (b) * SHM_K + kst[s_]) = sr_[i].ks[s_]; } while (0)
#define RESC(a) do { if (__any((a) < 1.f)) { if (hi == 0) al_l[r32] = (a); asm volatile("s_waitcnt lgkmcnt(0)" ::: "memory"); \
        _Pragma("unroll") for (int d = 0; d < NCB; ++d) _Pragma("unroll") for (int r = 0; r < 16; ++r) o[d][r] *= al_l[crow(r, hi)]; } } while (0)
    f32x16 pA0, pA1, pB0, pB1; float mnA, mnB, alA, alB; bf16x8 pa0, pa1, pa2, pa3;
    constexpr int SE = 0, SO = 0;
    SLOAD(SE, 0); SWRITE(0, SE); __syncthreads();
    qkt<ND0, KROWB>(pA0, pA1, K_lds, qr, r32, hi); partialSM(pA0, pA1, m_reg, mnA, alA, C, thr_raw);
    SLOAD(SO, 1);
    SWRITE(1, SO); __syncthreads();
    for (int j = 1; j + 1 < NT; j += 2) {
        SBAR(); qkt<ND0, KROWB>(pB0, pB1, K_lds + SHM_K, qr, r32, hi);
        finishSM(pA0, pA1, alA, l_reg, pa0, pa1, pa2, pa3); SBAR();
        SLOAD(SO, j + 1); SBAR();
        pv_all<NCB>(o, vb0, pa0, pa1, pa2, pa3); partialSM(pB0, pB1, m_reg, mnB, alB, C, thr_raw);
        __syncthreads(); SWRITE(0, SE);
        RESC(alB); __syncthreads();
        SBAR(); qkt<ND0, KROWB>(pA0, pA1, K_lds, qr, r32, hi);
        finishSM(pB0, pB1, alB, l_reg, pa0, pa1, pa2, pa3); SBAR();
        SLOAD(SE, j + 2); SBAR();
        pv_all<NCB>(o, vb0 + SHM_V, pa0, pa1, pa2, pa3); partialSM(pA0, pA1, m_reg, mnA, alA, C, thr_raw);
        __syncthreads(); SWRITE(1, SO);
        RESC(alA); __syncthreads();
    }
    SBAR(); qkt<ND0, KROWB>(pB0, pB1, K_lds + SHM_K, qr, r32, hi);
    finishSM(pA0, pA1, alA, l_reg, pa0, pa1, pa2, pa3); SBAR();
    pv_all<NCB>(o, vb0, pa0, pa1, pa2, pa3); partialSM(pB0, pB1, m_reg, mnB, alB, C, thr_raw);
    __syncthreads(); RESC(alB);
    finishSM(pB0, pB1, alB, l_reg, pa0, pa1, pa2, pa3); SBAR();
    pv_all<NCB>(o, vb0 + SHM_V, pa0, pa1, pa2, pa3);
    l_out = l_reg;
#undef SLOAD
#undef SWRITE
#undef RESC
}

__device__ __forceinline__ void mla_item(KArgP a, int b, int h, int qb, char* lds) {
    const int tid = ptid(), wid = tid >> 6, lane = tid & 63, r32 = lane & 31, hi = lane >> 5;
    const bf16* Qb = (const bf16*)((const unsigned char*)a->out + OUT_Q); const bf16* KV = (const bf16*)((const unsigned char*)a->out + OUT_KV);
    const bf16* KR = (const bf16*)(a->ws + WS_KR); bf16* MIX = (bf16*)(a->ws + WS_MIX);
    const int row0 = b * TPB + qb * 256, krow0 = b * TPB, NT = qb ? 36 : 4;
    const int row = row0 + wid * 32 + r32;
    const bf16* Qw = Qb + (size_t)row * 768 + h * 96;
    bf16x8 qr[6];
#pragma unroll
    for (int d0 = 0; d0 < 4; ++d0) qr[d0] = *(const bf16x8*)(Qw + d0 * 16 + hi * 8);
    const int t = (qb - 1) * 256 + wid * 32 + r32;
#pragma unroll
    for (int d0 = 4; d0 < 6; ++d0) {
        const bf16x8 x1 = *(const bf16x8*)(Qw + d0 * 16), x2 = *(const bf16x8*)(Qw + d0 * 16 + 8);
        if (qb) { const float pos = (float)(d0 == 4 ? (t >> 6) : (t & 63)); unsigned short ov[8];
#pragma unroll
            for (int i = 0; i < 8; ++i) { float s, c; sincos_r(pos * inv_freq(i, 8), s, c); const float f1 = bf2f((unsigned short)x1[i]), f2 = bf2f((unsigned short)x2[i]);
                ov[i] = (unsigned short)f2bf(hi ? (f1 * s + f2 * c) : (f1 * c - f2 * s)); }
            qr[d0] = (bf16x8){(short)ov[0], (short)ov[1], (short)ov[2], (short)ov[3], (short)ov[4], (short)ov[5], (short)ov[6], (short)ov[7]};
        } else qr[d0] = hi ? x2 : x1;
    }
    f32x16 o[2] = {}; float l_reg;
    const float scale = 0.10206207261596575f;
    attn_core<96, 64, 256>(qr, KV + (size_t)krow0 * 1024 + h * 128, 1024, KR + (size_t)krow0 * 32, 32, KV + (size_t)krow0 * 1024 + h * 128 + 64, 1024,
                           NT, scale * 1.4426950408889634f, 8.f / scale, lds, o, l_reg, tid);
    float* li_l = (float*)(lds + 2 * 64 * 64 * 2 + 2 * 64 * 256) + wid * 64;
    if (hi == 0) li_l[r32] = l_reg; asm volatile("s_waitcnt lgkmcnt(0)" ::: "memory");
#pragma unroll
    for (int r = 0; r < 16; ++r) { const int orow = crow(r, hi); const float rl = __builtin_amdgcn_rcpf(li_l[orow]);
        bf16* op = MIX + (size_t)(row0 + wid * 32 + orow) * 1024 + 512 + h * 64 + r32;
        op[0] = (bf16)f2bf(o[0][r] * rl); op[32] = (bf16)f2bf(o[1][r] * rl); }
}
__device__ __forceinline__ void diff_item(KArgP a, int layer, int b, int h, int qb, char* lds) {
    const int row0 = b * TPB + qb * 256, krow0 = b * TPB, NT = qb ? 36 : 4, o_ = layer >> 1;
    const float scale = 0.125f;
#pragma unroll 1
    for (int m = 0; m < 2; ++m) {
        f32x16 o[4] = {};
        float l_reg;
        {
            const int tid = ptid(), wid = tid >> 6, lane = tid & 63, r32 = lane & 31, hi = lane >> 5;
            const bf16* P = (const bf16*)(a->ws + WS_P);
            const bf16* Qw = P + (size_t)(row0 + wid * 32 + r32) * NP_O + 1536 + h * 128 + m * 64;
            bf16x8 qr[4];
#pragma unroll
            for (int d0 = 0; d0 < 4; ++d0) qr[d0] = *(const bf16x8*)(Qw + d0 * 16 + hi * 8);
            const bf16* Kp = P + (size_t)krow0 * NP_O + 2048 + h * 128 + m * 64;
            attn_core<64, 128, 144>(qr, Kp, NP_O, Kp, NP_O, P + (size_t)krow0 * NP_O + 2560 + h * 128, NP_O,
                                    NT, scale * 1.4426950408889634f, 8.f / scale, lds, o, l_reg, tid);
        }
        const int tid = ptid(), wid = tid >> 6, lane = tid & 63, r32 = lane & 31, hi = lane >> 5;
        float* li_l = (float*)(lds + 2 * 64 * 128 * 2 + 2 * 64 * 144) + wid * 64;
        if (hi == 0) li_l[r32] = l_reg; asm volatile("s_waitcnt lgkmcnt(0)" ::: "memory");
        float* dsb = (float*)a->out + (size_t)blockIdx.x * 64 * 512 + tid; asm volatile("" : "+v"(dsb));
        if (m == 0) {
#pragma unroll
            for (int r = 0; r < 16; ++r) { const float rl = __builtin_amdgcn_rcpf(li_l[crow(r, hi)]);
#pragma unroll
                for (int d = 0; d < 4; ++d) dsb[(size_t)(d * 16 + r) * 512] = o[d][r] * rl; }
        } else {
            bf16* MIX = (bf16*)(a->ws + WS_MIX);
            const float* lp = a->in[20] + o_ * 256;
            const float lam_init = 0.8f - 0.6f * __expf(-0.3f * (float)layer);
            const float lam = __expf(wave_sum(lp[lane] * lp[64 + lane])) - __expf(wave_sum(lp[128 + lane] * lp[192 + lane])) + lam_init;
            const float* sg = a->in[21] + o_ * 128;
#pragma unroll
            for (int r = 0; r < 16; ++r) { const float rl = __builtin_amdgcn_rcpf(li_l[crow(r, hi)]); float s = 0.f; float v[4];
#pragma unroll
                for (int d = 0; d < 4; ++d) { v[d] = dsb[(size_t)(d * 16 + r) * 512] - lam * (o[d][r] * rl); s += v[d] * v[d]; }
                s += __shfl_xor(s, 16); s += __shfl_xor(s, 8); s += __shfl_xor(s, 4); s += __shfl_xor(s, 2); s += __shfl_xor(s, 1);
                const float rs = __builtin_amdgcn_rsqf(s * (1.f / 128.f) + EPSN) * (1.f - lam_init);
                bf16* op = MIX + (size_t)(row0 + wid * 32 + crow(r, hi)) * 1024 + 512 + h * 128 + r32;
#pragma unroll
                for (int d = 0; d < 4; ++d) op[32 * d] = (bf16)f2bf(v[d] * rs * sg[32 * d + r32]);
                asm volatile("" ::: "memory"); }
        }
        asm volatile("s_waitcnt vmcnt(0) lgkmcnt(0)" ::: "memory");
    }
}

__device__ __forceinline__ void phase_mixer(KArgP a, int layer, unsigned char* ldsg) {
    LAS unsigned char* lds = (LAS unsigned char*)ldsg;
    volatile LAS unsigned* flag = (volatile LAS unsigned*)(lds + LDS_MAIN);
    unsigned* ctr = (unsigned*)(a->ws + WS_CTL) + layer; layer &= 7;
    const bool even = !(layer & 1), need_ctx = layer < 3;
    constexpr int NSC = 256;
    const int n_lat = even ? 512 : 256, n_ctx = need_ctx ? (even ? 64 : 32) : 0, total = NSC + n_lat + n_ctx;
    for (;;) {
        __syncthreads();
        if (ptid() == 0) *flag = atomicAdd(ctr, 1u);
        __syncthreads();
        const int qi_ = (int)*flag;
        if (qi_ >= total) break;
        const int item = qi_ < n_lat ? NSC + qi_ : (qi_ < n_lat + NSC ? qi_ - n_lat : qi_);
#ifdef PROBE_ITEM
        const unsigned long long it0_ = __builtin_amdgcn_s_memrealtime();
#endif
#ifndef SKIP_SCAN
        if (item < NSC) { if (even) scan_item<128, true, 1>(a, layer, item & 63, item >> 6, lds); else scan_item<64, false, 1>(a, layer, item & 63, item >> 6, lds); }
#else
        if (item < NSC) {}
#endif
        else { int b_, h_, qb_;
            if (item < NSC + n_lat) { const int i = item - NSC; qb_ = 1 + (i & 7); if (even) { b_ = i >> 6; h_ = (i >> 3) & 7; } else { b_ = i >> 5; h_ = (i >> 3) & 3; } }
            else { const int i = item - NSC - n_lat; qb_ = 0; if (even) { b_ = i >> 3; h_ = i & 7; } else { b_ = i >> 2; h_ = i & 3; } }
#ifndef SKIP_ATTN
            if (even) mla_item(a, b_, h_, qb_, (char*)ldsg); else diff_item(a, layer, b_, h_, qb_, (char*)ldsg);
#endif
        }
#ifdef PROBE_ITEM
        __syncthreads();
        if (otid() == 0) { volatile LAS unsigned long long* pc_ = (volatile LAS unsigned long long*)(lds + LDS_MAIN + 128); const int k_ = item < NSC ? 0 : (even ? 1 : 2); pc_[k_] += __builtin_amdgcn_s_memrealtime() - it0_; }
#endif
    }
}

#define XB_TMO      128
#define XB_XCNT(j)  (256  + 64 * (j))
#define XB_XSUB(j)  (1280 + 64 * (j))
#define XB_XGEN(j)  (2304 + 64 * (j))
#define XB_TOP      3328
#define XB_TOPGEN   3392
#define XCD_BAR_WORDS 3456
#define XB_SPIN_CAP (1u << 18)

__device__ __forceinline__ unsigned xb_ld(unsigned* p)              { return __hip_atomic_load(p, __ATOMIC_RELAXED, __HIP_MEMORY_SCOPE_AGENT); }
__device__ __forceinline__ unsigned xb_add(unsigned* p, unsigned v) { return __hip_atomic_fetch_add(p, v, __ATOMIC_RELAXED, __HIP_MEMORY_SCOPE_AGENT); }
__device__ __forceinline__ unsigned xb_xcc_id() { return (unsigned)__builtin_amdgcn_s_getreg((3 << 11) | 20) & 0xFu; }
#define XB_SPIN(cond, bar) do { unsigned _sp = 0; while (cond) { __builtin_amdgcn_s_sleep(1); \
    if ((++_sp & 255u) == 0u) { if (xb_ld(&(bar)[XB_TMO])) break; if (_sp > XB_SPIN_CAP) { atomicAdd(&(bar)[XB_TMO], 1u); break; } } } } while (0)

struct XcdBarrier {
    unsigned* bar; unsigned x;
    volatile LAS unsigned* st;
};

__device__ __forceinline__ XcdBarrier xcd_barrier_post(unsigned* bar, volatile LAS unsigned* st) {
    XcdBarrier b; b.bar = bar; b.x = xb_xcc_id(); b.st = st;
    if (threadIdx.x == 0) (void)xb_add(&bar[XB_XCNT(b.x)], 1u);
    return b;
}
__device__ __forceinline__ void xcd_barrier_complete(unsigned* bar, unsigned x, unsigned& nloc, unsigned& nx) {
    const unsigned G = gridDim.x * gridDim.y * gridDim.z;
    unsigned sum, cnt, mine, sp = 0u;
    for (;;) {
        sum = 0u; cnt = 0u; mine = 0u;
#pragma unroll
        for (unsigned j = 0; j < 16; ++j) { const unsigned c = xb_ld(&bar[XB_XCNT(j)]); sum += c; cnt += (c > 0u) ? 1u : 0u; mine = (j == x) ? c : mine; }
        if (sum == G) break;
        __builtin_amdgcn_s_sleep(1);
        if ((++sp & 255u) == 0u) { if (xb_ld(&bar[XB_TMO])) break; if (sp > XB_SPIN_CAP) { atomicAdd(&bar[XB_TMO], 1u); break; } }
    }
    nloc = mine > 0u ? mine : 1u; nx = cnt > 0u ? cnt : 1u;
}

__device__ __forceinline__ void xcd_barrier(const XcdBarrier& b) {
    asm volatile("s_waitcnt vmcnt(0)" ::: "memory");
    __syncthreads();
    if (threadIdx.x == 0) {
        unsigned* bar = b.bar;
        __builtin_amdgcn_s_waitcnt(0);
        unsigned nloc = b.st[0], nx = b.st[1];
        if (nloc == 0u) { xcd_barrier_complete(bar, b.x, nloc, nx); b.st[0] = nloc; b.st[1] = nx; }
        const unsigned old = xb_add(&bar[XB_XSUB(b.x)], 1u);
        const unsigned gen = old / nloc;
        if (old + 1u == (gen + 1u) * nloc) {
            __builtin_amdgcn_fence(__ATOMIC_RELEASE, "agent");
            asm volatile("s_waitcnt vmcnt(0)" ::: "memory");
            const unsigned og = xb_add(&bar[XB_TOP], 1u);
            const unsigned tg = og / nx;
            if (og + 1u == (tg + 1u) * nx) xb_add(&bar[XB_TOPGEN], 1u);
            else XB_SPIN(xb_ld(&bar[XB_TOPGEN]) == tg, bar);
            __builtin_amdgcn_fence(__ATOMIC_ACQUIRE, "agent");
            xb_add(&bar[XB_XGEN(b.x)], 1u);
            asm volatile("s_waitcnt vmcnt(0)" ::: "memory");
        } else {
            XB_SPIN(xb_ld(&bar[XB_XGEN(b.x)]) == gen, bar);
            __builtin_amdgcn_fence(__ATOMIC_ACQUIRE, "agent");
            asm volatile("s_waitcnt vmcnt(0)" ::: "memory");
        }
    }
    __syncthreads();
}

__global__ void __launch_bounds__(512, 2) mega_fwd(Args a_) {
    extern __shared__ __attribute__((aligned(16))) unsigned char lds_raw[];
    LAS unsigned char* lds = (LAS unsigned char*)lds_raw;
    ((LAS int*)(lds + LDS_MAIN + 1024))[threadIdx.x] = (int)threadIdx.x;
    if (threadIdx.x < 4) ((LAS unsigned*)(lds + LDS_MAIN + 64))[threadIdx.x] = 0u;
    if (threadIdx.x < 8) ((LAS unsigned*)(lds + LDS_MAIN + 128))[threadIdx.x] = 0u;
    __syncthreads();
    XcdBarrier xbar; xbar.bar = nullptr; xbar.x = 0; xbar.st = nullptr; bool xb_ready = false;
    cg::grid_group grid = cg::this_grid();
    int ph = 0;
#ifdef PROBE_MASK
    unsigned long long pr_last = __builtin_amdgcn_s_memrealtime(), pr_acc = 0ull;
#define PROBE_STAMP(k) { const unsigned long long now_ = __builtin_amdgcn_s_memrealtime(); if ((PROBE_MASK >> (k)) & 1) pr_acc += now_ - pr_last; pr_last = now_; }
#else
#define PROBE_STAMP(k)
#endif
    const int plo = a_.lo, phi = a_.hi;
#define PH_BEGIN if (ph >= plo && ph < phi) { KArgP a = kargs(); int bx = (int)blockIdx.x, G = (int)gridDim.x; asm volatile("" : "+s"(bx), "+s"(G)); (void)bx; (void)G;
#ifdef PROBE_SYNC2
#define PH_ENDT(k)   if (ph + 1 < phi) { grid.sync(); grid.sync(); } } ++ph;
#else
#define PH_ENDT(k) if (ph + 1 < phi) { if (!xb_ready) { grid.sync(); xbar = xcd_barrier_post((unsigned*)(a->ws + WS_CTL) + 4096, (volatile LAS unsigned*)(lds + LDS_MAIN + 64)); xb_ready = true; } else xcd_barrier(xbar); } PROBE_STAMP(k) } ++ph;
#endif

    PH_BEGIN phase_prep(a, lds); PH_ENDT(0)

    for (int layer = 0; layer < 4; ++layer) {
        const bool even = !(layer & 1);
        const int np = even ? NP_E : NP_O;
        PH_BEGIN phase_norm(a, layer, 0, layer > 0); if (layer > 0 || G <= 96) convert_weights(a, layer, lds, 0, bx * 8 + (otid() >> 6), G * 8); PH_ENDT(1)
#ifndef SKIP_G1
        PH_BEGIN { bf16* H = (bf16*)(a->ws + WS_H); bf16* MIX = (bf16*)(a->ws + WS_MIX); bf16* P = (bf16*)(a->ws + WS_P); bf16* X = (bf16*)(a->ws + WS_X); unsigned char* Wb = a->ws + WS_W; const float* mod = (const float*)(a->ws + WS_MOD) + (size_t)layer * 9 * 6144; (void)H; (void)MIX; (void)P; (void)X; (void)mod; pg8::Gemm g{H, (const bf16*)(Wb + W_IN), MT, np, 1024, 1024}; pg8::StaticOrder S; S.init(MT, np, G, bx);
                   pg8::EpiBf16<0> E{P, np, nullptr, 0, 0, 1.f};
                   pg8::gemm_phase<pg8::EpiBf16<0>, pg8::StaticOrder, true, true>(lds, g, S, E); } PH_ENDT(2)
#else
        ++ph;
#endif
        PH_BEGIN if (even) phase_post_even(a, layer); else phase_post_odd(a, layer); PH_ENDT(3)
#ifndef SKIP_G3
        if (even) {
            PH_BEGIN { bf16* H = (bf16*)(a->ws + WS_H); bf16* MIX = (bf16*)(a->ws + WS_MIX); bf16* P = (bf16*)(a->ws + WS_P); bf16* X = (bf16*)(a->ws + WS_X); unsigned char* Wb = a->ws + WS_W; const float* mod = (const float*)(a->ws + WS_MOD) + (size_t)layer * 9 * 6144; (void)H; (void)MIX; (void)P; (void)X; (void)mod; pg8::Gemm g{(const bf16*)(a->ws + WS_CQN), (const bf16*)(Wb + W_UQ), MT, 768, 384, 384}; pg8::StaticOrder S; S.init(MT, 768, G, bx);
                       pg8::EpiBf16<0> E{(bf16*)((unsigned char*)a->out + OUT_Q), 768, nullptr, 0, 0, 1.f};
                       pg8::gemm_phase<pg8::EpiBf16<0>, pg8::StaticOrder, true, true>(lds, g, S, E); }
                     { unsigned char* Wb = a->ws + WS_W; pg8::Gemm g{(const bf16*)(a->ws + WS_CKVN), (const bf16*)(Wb + W_UKV), MT, 1024, 256, 256}; pg8::StaticOrder S; S.init(MT, 1024, G, bx);
                       pg8::EpiBf16<0> E{(bf16*)((unsigned char*)a->out + OUT_KV), 1024, nullptr, 0, 0, 1.f};
                       pg8::gemm_phase<pg8::EpiBf16<0>, pg8::StaticOrder, true, true>(lds, g, S, E); }
                     for (int it = bx; it < 192; it += G) scan_item<128, true, 0>(a, layer, it & 63, it >> 6, lds);
                     if (bx >= 192 && layer > 0) convert_weights(a, layer, lds, 1, (bx - 192) * 8 + (otid() >> 6), (G - 192) * 8);
            PH_ENDT(4)
        } else { ++ph; }
#else
        ++ph;
#endif
        if (!even) {
        PH_BEGIN for (int it = bx; it < 192; it += G) scan_item<64, false, 0>(a, layer, it & 63, it >> 6, lds);
                 if (bx >= 192) convert_weights(a, layer, lds, 1, (bx - 192) * 8 + (otid() >> 6), (G - 192) * 8); PH_ENDT(5)
        } else { ++ph; }
#ifdef PROBE_MIX2
        PH_BEGIN phase_mixer(a, layer + 8, lds_raw); grid.sync(); PH_ENDT(6)
        --ph;
#endif
        PH_BEGIN phase_mixer(a, layer, lds_raw); PH_ENDT(6 + 7 * (layer & 1))
        PH_BEGIN phase_readout(a, layer); PH_ENDT(7)
#ifndef SKIP_G6
        PH_BEGIN { bf16* H = (bf16*)(a->ws + WS_H); bf16* MIX = (bf16*)(a->ws + WS_MIX); bf16* P = (bf16*)(a->ws + WS_P); bf16* X = (bf16*)(a->ws + WS_X); unsigned char* Wb = a->ws + WS_W; const float* mod = (const float*)(a->ws + WS_MOD) + (size_t)layer * 9 * 6144; (void)H; (void)MIX; (void)P; (void)X; (void)mod; pg8::Gemm g{MIX, (const bf16*)(Wb + W_OUT), MT, 1024, 1024, 1024}; pg8::StaticOrder S; S.init(NB * NLAT, 1024, G, bx, 1);
                   pg8::EpiResid E{X, mod, 2048, layer == 0 ? a->in[0] : nullptr};
                   pg8::gemm_phase<pg8::EpiResid, pg8::StaticOrder, true, true>(lds, g, S, E);
                   if (layer < 3) { pg8::Gemm g2{MIX, (const bf16*)(Wb + W_OUT), MT, 1024, 512, 1024}; pg8::CtxSplitOrder S2{G, bx, 512};
                       pg8::EpiResidSplit E2{X, (float*)(a->ws + WS_T), mod, 2048, layer == 0 ? a->in[2] : nullptr};
                       pg8::gemm_phase<pg8::EpiResidSplit, pg8::CtxSplitOrder, true, true>(lds, g2, S2, E2); } } PH_ENDT(8)
#else
        ++ph;
#endif
        PH_BEGIN phase_norm(a, layer, 1, layer < 3); PH_ENDT(9)
#ifndef SKIP_G8
        PH_BEGIN { bf16* H = (bf16*)(a->ws + WS_H); bf16* MIX = (bf16*)(a->ws + WS_MIX); bf16* P = (bf16*)(a->ws + WS_P); bf16* X = (bf16*)(a->ws + WS_X); unsigned char* Wb = a->ws + WS_W; const float* mod = (const float*)(a->ws + WS_MOD) + (size_t)layer * 9 * 6144; (void)H; (void)MIX; (void)P; (void)X; (void)mod; pg8::Gemm g{H, (const bf16*)(Wb + W_GU), MT, 2 * FF, 1024, 1024}; pg8::StaticOrder S; if (layer < 3) S.init(MT, 2 * FF, G, bx); else S.init(NB * NLAT, 2 * FF, G, bx, 1);
                   pg8::EpiSwiGLU E{P, FF};
                   pg8::gemm_phase<pg8::EpiSwiGLU, pg8::StaticOrder, true, true>(lds, g, S, E); } PH_ENDT(10)
#else
        ++ph;
#endif
#ifndef SKIP_G9
        PH_BEGIN { bf16* H = (bf16*)(a->ws + WS_H); bf16* MIX = (bf16*)(a->ws + WS_MIX); bf16* P = (bf16*)(a->ws + WS_P); bf16* X = (bf16*)(a->ws + WS_X); unsigned char* Wb = a->ws + WS_W; const float* mod = (const float*)(a->ws + WS_MOD) + (size_t)layer * 9 * 6144; (void)H; (void)MIX; (void)P; (void)X; (void)mod; pg8::Gemm g{P, (const bf16*)(Wb + W_DN), MT, 1024, FF, FF}; pg8::StaticOrder S; S.init(NB * NLAT, 1024, G, bx, 1);
                   pg8::EpiResid E{X, mod, 5120, nullptr};
                   pg8::gemm_phase<pg8::EpiResid, pg8::StaticOrder, true, true>(lds, g, S, E);
                   if (layer < 3) { pg8::Gemm g2{P, (const bf16*)(Wb + W_DN), MT, 1024, FF / 2, FF}; pg8::CtxSplitOrder S2{G, bx, FF / 2};
                       pg8::EpiResidSplit E2{X, (float*)(a->ws + WS_T), mod, 5120, nullptr};
                       pg8::gemm_phase<pg8::EpiResidSplit, pg8::CtxSplitOrder, true, true>(lds, g2, S2, E2); } } PH_ENDT(11)
#else
        ++ph;
#endif
    }
    PH_BEGIN phase_final(a); PH_ENDT(12)
#undef PH_BEGIN
#undef PH_ENDT
#ifdef PROBE_ITEM
    pr_acc += ((volatile LAS unsigned long long*)(lds + LDS_MAIN + 128))[PROBE_ITEM - 1];
#endif
#ifdef PROBE_MASK
    if (blockIdx.x == 0) { const unsigned long long t0_ = __builtin_amdgcn_s_memrealtime(); while (__builtin_amdgcn_s_memrealtime() - t0_ < pr_acc) __builtin_amdgcn_s_sleep(8); }
#endif
}
constexpr int NPH = 1 + 4 * 11 + 1;

extern "C" void kernel_launch(void* const* d_in, const int* in_sizes, int n_in, void* d_out, int out_size, void* d_ws, size_t ws_size, hipStream_t stream) {
    static int grid = 0;
    if (grid == 0) {
        if (n_in != 23 || ws_size < WS_END || out_size != NB * NLAT * DM) { fprintf(stderr, "kernel_launch: unexpected shapes: n_in %d ws %zu (need %zu) out %d\n", n_in, ws_size, (size_t)WS_END, out_size); grid = -1; return; }
        int dev = 0, cus = 0, per_cu = 0;
        hipGetDevice(&dev); hipDeviceGetAttribute(&cus, hipDeviceAttributeMultiprocessorCount, dev);
        if (hipFuncSetAttribute((const void*)mega_fwd, hipFuncAttributeMaxDynamicSharedMemorySize, LDS_BYTES) != hipSuccess) { fprintf(stderr, "kernel_launch: hipFuncSetAttribute failed\n"); grid = -1; return; }
        if (hipOccupancyMaxActiveBlocksPerMultiprocessor(&per_cu, (const void*)mega_fwd, 512, LDS_BYTES) != hipSuccess || per_cu < 1) { fprintf(stderr, "kernel_launch: occupancy query says %d\n", per_cu); per_cu = 1; }
        (void)hipGetLastError();
        grid = cus;
    }
    if (grid < 0) return;
    Args a{};
    for (int i = 0; i < 23; ++i) a.in[i] = (const float*)d_in[i];
    a.out = (float*)d_out; a.ws = (unsigned char*)d_ws; a.lo = 0; a.hi = NPH;
    void* kargv[] = {&a};
    hipError_t e = hipLaunchCooperativeKernel((const void*)mega_fwd, dim3(grid), dim3(512), kargv, LDS_BYTES, stream);
    if (e != hipSuccess) fprintf(stderr, "kernel_launch: cooperative launch failed: %s (grid %d)\n", hipGetErrorString(e), grid);
}
```
